# Optimizing an MI355X kernel written in HIP

```python
import math
import jax, jax.numpy as jnp
from jax import lax
import numpy as np

D_MODEL = 1024
BATCH = 8
SEQ = 2048
DEPTH = 1

SSD_HEADS = 8
SSD_HEAD_DIM = 64
SSD_INNER = SSD_HEADS * SSD_HEAD_DIM
SSD_GROUPS = 2
SSD_STATE = 128
SSD_CONV = 4
SSD_CHUNK = 128
SSD_XBC = SSD_INNER + 2 * SSD_GROUPS * SSD_STATE
DT_MIN = 0.001
DT_MAX = 0.1
MLA_HEADS = 8
MLA_NOPE = 64
MLA_ROPE = 32
MLA_QK = MLA_NOPE + MLA_ROPE
MLA_V = 64
MLA_Q_RANK = 256
MLA_KV_RANK = 128
MLA_INNER = MLA_HEADS * MLA_V
ROPE_THETA = 10000.0
ATTN_BLOCK = 128
MAX_POS_OFFSET = 4096
D_MIX = SSD_INNER + MLA_INNER
IN_SPLITS = (SSD_INNER, SSD_XBC, SSD_HEADS, MLA_Q_RANK, MLA_KV_RANK, MLA_ROPE)
D_IN_PROJ = sum(IN_SPLITS)
MOE_GROUPS = 4
MOE_EXPERTS_PER_GROUP = 8
MOE_EXPERTS = MOE_GROUPS * MOE_EXPERTS_PER_GROUP
MOE_TOP_K = 2
MOE_FF = 256
N_MOD = 6
EPS = 1e-6

kernel_name = "hymba_ssd_mla_hmoe_block"


def rms_norm(x, g):
    xf = x.astype(jnp.float32)
    y = xf * lax.rsqrt(jnp.mean(xf * xf, axis=-1, keepdims=True) + EPS)
    return (y * g.astype(jnp.float32)).astype(x.dtype)


def causal_depthwise_conv(u, w, b):
    k_w, ch = w.shape
    y = lax.conv_general_dilated(u, w[:, None, :].astype(u.dtype), window_strides=(1,),
                                 padding=[(k_w - 1, 0)],
                                 dimension_numbers=('NWC', 'WIO', 'NWC'),
                                 feature_group_count=ch)
    return y + b


def segsum(a):
    n = a.shape[-1]
    cs = jnp.cumsum(a, axis=-1)
    diff = cs[..., :, None] - cs[..., None, :]
    mask = jnp.tril(jnp.ones((n, n), dtype=bool))
    return jnp.where(mask, diff, -jnp.inf)


def ssd_chunked(x, dt, a, bm, cm):
    b, s, h, p = x.shape
    g, n = bm.shape[-2:]
    r = h // g
    nc = s // SSD_CHUNK
    f32 = jnp.float32
    xd = (x.astype(f32) * dt[..., None]).reshape(b, nc, SSD_CHUNK, g, r, p)
    adt = jnp.moveaxis((dt * a).reshape(b, nc, SSD_CHUNK, g, r), 2, -1)
    bc = bm.astype(f32).reshape(b, nc, SSD_CHUNK, g, n)
    cc = cm.astype(f32).reshape(b, nc, SSD_CHUNK, g, n)
    a_cs = jnp.cumsum(adt, axis=-1)
    decay = jnp.exp(segsum(adt))
    cb = jnp.einsum('bclgn,bcsgn->bcgls', cc, bc)
    y_diag = jnp.einsum('bcgrls,bcsgrp->bclgrp', cb[:, :, :, None] * decay, xd)
    decay_states = jnp.exp(a_cs[..., -1:] - a_cs)
    states = jnp.einsum('bclgn,bcgrl,bclgrp->bcgrpn', bc, decay_states, xd)
    chunk_decay = jnp.exp(a_cs[..., -1])

    def step(carry, inp):
        st, dec = inp
        return carry * dec[..., None, None] + st, carry

    init = jnp.zeros((b, g, r, p, n), f32)
    _, prev = lax.scan(step, init, (jnp.moveaxis(states, 1, 0), jnp.moveaxis(chunk_decay, 1, 0)))
    prev = jnp.moveaxis(prev, 0, 1)
    y_off = jnp.einsum('bclgn,bcgrpn,bcgrl->bclgrp', cc, prev, jnp.exp(a_cs))
    return (y_diag + y_off).reshape(b, s, h, p)


def rope_tables(positions):
    inv = 1.0 / (ROPE_THETA ** (jnp.arange(0, MLA_ROPE, 2, dtype=jnp.float32) / MLA_ROPE))
    ang = positions.astype(jnp.float32)[..., None] * inv
    return jnp.cos(ang), jnp.sin(ang)


def apply_rope(x, cos, sin):
    xf = x.astype(jnp.float32)
    x1, x2 = jnp.split(xf, 2, axis=-1)
    return jnp.concatenate([x1 * cos - x2 * sin, x2 * cos + x1 * sin], axis=-1).astype(x.dtype)


def causal_attention_blocked(q, k, v):
    b, s, h, d = q.shape
    nb = s // ATTN_BLOCK
    scale = d ** -0.5
    qb = jnp.moveaxis(q.reshape(b, nb, ATTN_BLOCK, h, d), 1, 0)
    k_idx = jnp.arange(s)

    def one_block(args):
        q_blk, i = args
        sc = jnp.einsum('bqhd,bkhd->bhqk', q_blk, k).astype(jnp.float32) * scale
        q_idx = i * ATTN_BLOCK + jnp.arange(ATTN_BLOCK)
        sc = jnp.where(k_idx[None, :] <= q_idx[:, None], sc, -jnp.inf)
        pr = jax.nn.softmax(sc, axis=-1).astype(v.dtype)
        return jnp.einsum('bhqk,bkhd->bqhd', pr, v)

    out = lax.map(one_block, (qb, jnp.arange(nb)))
    return jnp.moveaxis(out, 0, 1).reshape(b, s, h, v.shape[-1])


def hybrid_mixer(h, cos, sin, w_in, conv_w, conv_b, dt_bias, a_log, d_skip, ssd_norm,
                 q_norm, w_uq, kv_norm, w_ukv, mla_out_norm, w_out):
    b, s, _ = h.shape
    u = h @ w_in
    cuts = list(np.cumsum(IN_SPLITS)[:-1])
    z, xbc, dt_raw, cq, ckv, k_rope = jnp.split(u, cuts, axis=-1)
    xbc = jax.nn.silu(causal_depthwise_conv(xbc, conv_w, conv_b))
    xs, bs, cs = jnp.split(xbc, [SSD_INNER, SSD_INNER + SSD_GROUPS * SSD_STATE], axis=-1)
    xs = xs.reshape(b, s, SSD_HEADS, SSD_HEAD_DIM)
    bs = bs.reshape(b, s, SSD_GROUPS, SSD_STATE)
    cs = cs.reshape(b, s, SSD_GROUPS, SSD_STATE)
    dt = jax.nn.softplus(dt_raw.astype(jnp.float32) + dt_bias.astype(jnp.float32))
    a = -jnp.exp(a_log.astype(jnp.float32))
    y_ssd = ssd_chunked(xs, dt, a, bs, cs) + d_skip.astype(jnp.float32)[:, None] * xs.astype(jnp.float32)
    y_ssd = y_ssd.reshape(b, s, SSD_INNER).astype(h.dtype)
    y_ssd = rms_norm(y_ssd * jax.nn.silu(z), ssd_norm)
    q = jnp.einsum('bsr,rhd->bshd', rms_norm(cq, q_norm), w_uq)
    q_nope, q_pe = jnp.split(q, [MLA_NOPE], axis=-1)
    kv = jnp.einsum('bsr,rhd->bshd', rms_norm(ckv, kv_norm), w_ukv)
    k_nope, v = jnp.split(kv, [MLA_NOPE], axis=-1)
    q_pe = apply_rope(q_pe, cos[:, :, None, :], sin[:, :, None, :])
    k_pe = apply_rope(k_rope, cos, sin)
    q_full = jnp.concatenate([q_nope, q_pe], axis=-1)
    k_full = jnp.concatenate(
        [k_nope, jnp.broadcast_to(k_pe[:, :, None, :], (b, s, MLA_HEADS, MLA_ROPE))], axis=-1)
    y_mla = causal_attention_blocked(q_full, k_full, v).reshape(b, s, MLA_INNER)
    y_mla = rms_norm(y_mla, mla_out_norm)
    return jnp.concatenate([y_ssd, y_mla], axis=-1) @ w_out


def hierarchical_moe(h, w_group_router, b_group_router, w_expert_router, b_expert_router,
                     w_gate, w_up, w_down):
    b, s, d = h.shape
    t = h.reshape(b * s, d)
    n_tok = t.shape[0]
    g_prob = jax.nn.softmax((t @ w_group_router).astype(jnp.float32)
                            + b_group_router.astype(jnp.float32), axis=-1)
    g_w, g_idx = lax.top_k(g_prob, 1)
    e_logits = (t @ w_expert_router).astype(jnp.float32).reshape(
        n_tok, MOE_GROUPS, MOE_EXPERTS_PER_GROUP) + b_expert_router.astype(jnp.float32)
    e_sel = jnp.take_along_axis(e_logits, g_idx[:, :, None], axis=1)[:, 0]
    e_prob = jax.nn.softmax(e_sel, axis=-1)
    e_w, e_idx = lax.top_k(e_prob, MOE_TOP_K)
    e_w = e_w / jnp.sum(e_w, axis=-1, keepdims=True)
    w = g_w * e_w
    flat_idx = g_idx * MOE_EXPERTS_PER_GROUP + e_idx
    combine = jnp.einsum('tk,tke->te', w, jax.nn.one_hot(flat_idx, MOE_EXPERTS, dtype=jnp.float32))
    gate = jnp.einsum('td,edf->tef', t, w_gate)
    up = jnp.einsum('td,edf->tef', t, w_up)
    hid = (jax.nn.silu(gate) * up * combine[:, :, None].astype(t.dtype))
    out = jnp.einsum('tef,efd->td', hid, w_down)
    return out.reshape(b, s, d).astype(h.dtype)


def setup_inputs(seed: int = 0) -> dict:
    key = jax.random.key(seed)
    ks = jax.random.split(key, 32)
    f32 = jnp.float32
    L = DEPTH

    def nrm(k, shape, scale):
        return jax.random.normal(k, shape, f32) * scale

    def gain(k, n):
        return 1.0 + 0.02 * jax.random.normal(k, (L, n), f32)

    x = nrm(ks[0], (BATCH, SEQ, D_MODEL), 1.0)
    c = nrm(ks[1], (BATCH, D_MODEL), 1.0)
    offset = jax.random.randint(ks[2], (BATCH, 1), 0, MAX_POS_OFFSET, dtype=jnp.int32)
    positions = offset + jnp.arange(SEQ, dtype=jnp.int32)[None, :]
    dt_init = jnp.exp(jax.random.uniform(ks[11], (L, SSD_HEADS), f32,
                                         math.log(DT_MIN), math.log(DT_MAX)))
    return {
        "x": x,
        "c": c,
        "positions": positions,
        "ada_w": nrm(ks[3], (L, D_MODEL, N_MOD * D_MODEL), 0.5 * D_MODEL ** -0.5),
        "ada_b": nrm(ks[4], (L, N_MOD * D_MODEL), 0.02),
        "pre_norm_mix": gain(ks[5], D_MODEL),
        "post_norm_mix": gain(ks[6], D_MODEL),
        "pre_norm_ffn": gain(ks[7], D_MODEL),
        "post_norm_ffn": gain(ks[8], D_MODEL),
        "w_in": nrm(ks[9], (L, D_MODEL, D_IN_PROJ), D_MODEL ** -0.5),
        "conv_w": nrm(ks[10], (L, SSD_CONV, SSD_XBC), SSD_CONV ** -0.5),
        "conv_b": nrm(ks[12], (L, SSD_XBC), 0.01),
        "dt_bias": dt_init + jnp.log(-jnp.expm1(-dt_init)),
        "a_log": jnp.log(jax.random.uniform(ks[13], (L, SSD_HEADS), f32, 1.0, 16.0)),
        "d_skip": 1.0 + 0.1 * jax.random.normal(ks[14], (L, SSD_HEADS), f32),
        "ssd_norm": gain(ks[15], SSD_INNER),
        "q_norm": gain(ks[16], MLA_Q_RANK),
        "w_uq": nrm(ks[17], (L, MLA_Q_RANK, MLA_HEADS, MLA_QK), MLA_Q_RANK ** -0.5),
        "kv_norm": gain(ks[18], MLA_KV_RANK),
        "w_ukv": nrm(ks[19], (L, MLA_KV_RANK, MLA_HEADS, MLA_NOPE + MLA_V), MLA_KV_RANK ** -0.5),
        "mla_out_norm": gain(ks[20], MLA_INNER),
        "w_out": nrm(ks[21], (L, D_MIX, D_MODEL), D_MIX ** -0.5),
        "w_group_router": nrm(ks[22], (L, D_MODEL, MOE_GROUPS), D_MODEL ** -0.5),
        "b_group_router": nrm(ks[23], (L, MOE_GROUPS), 0.01),
        "w_expert_router": nrm(ks[24], (L, D_MODEL, MOE_EXPERTS), D_MODEL ** -0.5),
        "b_expert_router": nrm(ks[25], (L, MOE_GROUPS, MOE_EXPERTS_PER_GROUP), 0.01),
        "w_gate": nrm(ks[26], (L, MOE_EXPERTS, D_MODEL, MOE_FF), D_MODEL ** -0.5),
        "w_up": nrm(ks[27], (L, MOE_EXPERTS, D_MODEL, MOE_FF), D_MODEL ** -0.5),
        "w_down": nrm(ks[28], (L, MOE_EXPERTS, MOE_FF, D_MODEL), MOE_FF ** -0.5),
    }


def reference(x, c, positions, ada_w, ada_b, pre_norm_mix, post_norm_mix, pre_norm_ffn,
              post_norm_ffn, w_in, conv_w, conv_b, dt_bias, a_log, d_skip, ssd_norm,
              q_norm, w_uq, kv_norm, w_ukv, mla_out_norm, w_out, w_group_router,
              b_group_router, w_expert_router, b_expert_router, w_gate, w_up, w_down):
    cos, sin = rope_tables(positions)
    c_act = jax.nn.silu(c)
    for l in range(DEPTH):
        mod = (c_act @ ada_w[l] + ada_b[l])[:, None, :]
        sh1, sc1, g1, sh2, sc2, g2 = jnp.split(mod, N_MOD, axis=-1)
        h = rms_norm(x, pre_norm_mix[l]) * (1.0 + sc1) + sh1
        y = hybrid_mixer(h, cos, sin, w_in[l], conv_w[l], conv_b[l], dt_bias[l], a_log[l],
                         d_skip[l], ssd_norm[l], q_norm[l], w_uq[l], kv_norm[l], w_ukv[l],
                         mla_out_norm[l], w_out[l])
        x = x + g1 * rms_norm(y, post_norm_mix[l])
        h = rms_norm(x, pre_norm_ffn[l]) * (1.0 + sc2) + sh2
        y = hierarchical_moe(h, w_group_router[l], b_group_router[l], w_expert_router[l],
                             b_expert_router[l], w_gate[l], w_up[l], w_down[l])
        x = x + g2 * rms_norm(y, post_norm_ffn[l])
    return x
```

```cpp
#include <hip/hip_runtime.h>
#include <stdint.h>
#include <math.h>

constexpr int D = 1024, NB = 8, SEQ = 2048, M = NB * SEQ;
constexpr int SSD_H = 8, SSD_P = 64, SSD_INNER = 512, SSD_G = 2, SSD_N = 128, SSD_XBC = 1024;
constexpr int MLA_H = 8, NOPE = 64, ROPE = 32, QK = 96, VD = 64, QR = 256, KVR = 128;
constexpr int NIN = 1960;
constexpr int OFF_Z = 0, OFF_XBC = 512, OFF_DT = 1536, OFF_CQ = 1544, OFF_CKV = 1800, OFF_KR = 1928;
constexpr int NEXP = 32, FF = 256;
constexpr float EPS = 1e-6f;

__device__ __forceinline__ float silu_f(float v) { return v / (1.f + expf(-v)); }

__device__ __forceinline__ float block_sum(float v, float* red) {
    for (int o = 32; o > 0; o >>= 1) v += __shfl_xor(v, o);
    const int w = threadIdx.x >> 6, nw = blockDim.x >> 6;
    __syncthreads();
    if ((threadIdx.x & 63) == 0) red[w] = v;
    __syncthreads();
    float s = 0.f;
    for (int i = 0; i < nw; ++i) s += red[i];
    return s;
}

__global__ void k_mod(const float* c, const float* ada_w, const float* ada_b, float* mod) {
    const int j = blockIdx.x * blockDim.x + threadIdx.x, b = blockIdx.y;
    if (j >= 6 * D) return;
    float acc = ada_b[j];
    for (int k = 0; k < D; ++k) acc += silu_f(c[b * D + k]) * ada_w[(size_t)k * 6 * D + j];
    mod[b * 6 * D + j] = acc;
}

__global__ void k_prenorm(const float* in, const float* g, const float* mod, int sh_off, int sc_off, float* out) {
    __shared__ float red[32];
    const int t = blockIdx.x, b = t / SEQ;
    const float* r = in + (size_t)t * D;
    float s = 0.f;
    for (int i = threadIdx.x; i < D; i += blockDim.x) s += r[i] * r[i];
    s = block_sum(s, red);
    const float inv = rsqrtf(s / D + EPS);
    for (int i = threadIdx.x; i < D; i += blockDim.x)
        out[(size_t)t * D + i] = r[i] * inv * g[i] * (1.f + mod[b * 6 * D + sc_off + i]) + mod[b * 6 * D + sh_off + i];
}

__global__ void k_post(const float* base, const float* y, const float* g, const float* mod, int gate_off, float* out) {
    __shared__ float red[32];
    const int t = blockIdx.x, b = t / SEQ;
    const float* r = y + (size_t)t * D;
    float s = 0.f;
    for (int i = threadIdx.x; i < D; i += blockDim.x) s += r[i] * r[i];
    s = block_sum(s, red);
    const float inv = rsqrtf(s / D + EPS);
    for (int i = threadIdx.x; i < D; i += blockDim.x)
        out[(size_t)t * D + i] = base[(size_t)t * D + i] + mod[b * 6 * D + gate_off + i] * (r[i] * inv * g[i]);
}

__global__ void k_rms_slice(const float* in, int ldi, int off, int n, const float* g, float* out, int ldo, int ooff) {
    __shared__ float red[32];
    const int t = blockIdx.x;
    const float* r = in + (size_t)t * ldi + off;
    float s = 0.f;
    for (int i = threadIdx.x; i < n; i += blockDim.x) s += r[i] * r[i];
    s = block_sum(s, red);
    const float inv = rsqrtf(s / n + EPS);
    for (int i = threadIdx.x; i < n; i += blockDim.x) out[(size_t)t * ldo + ooff + i] = r[i] * inv * g[i];
}

__global__ void k_gate_norm(const float* y, const float* u, const float* g, float* out, int ldo) {
    __shared__ float red[32];
    const int t = blockIdx.x;
    float s = 0.f;
    for (int i = threadIdx.x; i < SSD_INNER; i += blockDim.x) {
        const float v = y[(size_t)t * SSD_INNER + i] * silu_f(u[(size_t)t * NIN + OFF_Z + i]);
        s += v * v;
    }
    s = block_sum(s, red);
    const float inv = rsqrtf(s / SSD_INNER + EPS);
    for (int i = threadIdx.x; i < SSD_INNER; i += blockDim.x) {
        const float v = y[(size_t)t * SSD_INNER + i] * silu_f(u[(size_t)t * NIN + OFF_Z + i]);
        out[(size_t)t * ldo + i] = v * inv * g[i];
    }
}

__global__ void k_gemm(const float* A, int lda, const float* B, int ldb, float* C, int ldc, int Mr, int N, int K) {
    __shared__ float As[16][65];
    __shared__ float Bs[16][65];
    const int tx = threadIdx.x & 15, ty = threadIdx.x >> 4;
    const int m0 = blockIdx.y * 64, n0 = blockIdx.x * 64;
    float acc[4][4] = {};
    for (int k0 = 0; k0 < K; k0 += 16) {
        for (int i = threadIdx.x; i < 64 * 16; i += 256) {
            const int r = i >> 4, kk = i & 15;
            As[kk][r] = A[(size_t)(m0 + r) * lda + k0 + kk];
        }
        for (int i = threadIdx.x; i < 64 * 16; i += 256) {
            const int kk = i >> 6, cc = i & 63;
            Bs[kk][cc] = (n0 + cc < N) ? B[(size_t)(k0 + kk) * ldb + n0 + cc] : 0.f;
        }
        __syncthreads();
#pragma unroll
        for (int kk = 0; kk < 16; ++kk) {
            float a[4], b[4];
#pragma unroll
            for (int i = 0; i < 4; ++i) { a[i] = As[kk][ty * 4 + i]; b[i] = Bs[kk][tx * 4 + i]; }
#pragma unroll
            for (int i = 0; i < 4; ++i)
#pragma unroll
                for (int j = 0; j < 4; ++j) acc[i][j] += a[i] * b[j];
        }
        __syncthreads();
    }
#pragma unroll
    for (int i = 0; i < 4; ++i)
#pragma unroll
        for (int j = 0; j < 4; ++j) {
            const int n = n0 + tx * 4 + j;
            if (n < N) C[(size_t)(m0 + ty * 4 + i) * ldc + n] = acc[i][j];
        }
}

__global__ void k_conv(const float* u, const float* cw, const float* cb, float* xc) {
    const size_t idx = (size_t)blockIdx.x * blockDim.x + threadIdx.x;
    if (idx >= (size_t)M * SSD_XBC) return;
    const int ch = (int)(idx % SSD_XBC), t = (int)(idx / SSD_XBC), s = t % SEQ;
    float acc = cb[ch];
    for (int k = 0; k < 4; ++k) {
        const int ss = s - 3 + k;
        if (ss >= 0) acc += cw[k * SSD_XBC + ch] * u[(size_t)(t - 3 + k) * NIN + OFF_XBC + ch];
    }
    xc[idx] = silu_f(acc);
}

__global__ void k_ssd_seq(const float* u, const float* xc, const float* dt_bias, const float* a_log, const float* d_skip, float* y) {
    const int b = blockIdx.x / SSD_H, h = blockIdx.x % SSD_H, g = h / (SSD_H / SSD_G);
    const int p = threadIdx.x >> 3, nq = threadIdx.x & 7;
    const float a = -expf(a_log[h]), dsk = d_skip[h], dtb = dt_bias[h];
    float st[16];
#pragma unroll
    for (int i = 0; i < 16; ++i) st[i] = 0.f;
    for (int s = 0; s < SEQ; ++s) {
        const size_t t = (size_t)b * SEQ + s;
        const float raw = u[t * NIN + OFF_DT + h] + dtb;
        const float dt = raw > 20.f ? raw : log1pf(expf(raw));
        const float da = expf(dt * a);
        const float xv = xc[t * SSD_XBC + h * SSD_P + p];
        const float xd = xv * dt;
        const float* Bp = xc + t * SSD_XBC + SSD_INNER + g * SSD_N + nq * 16;
        const float* Cp = xc + t * SSD_XBC + SSD_INNER + SSD_G * SSD_N + g * SSD_N + nq * 16;
        float acc = 0.f;
#pragma unroll
        for (int i = 0; i < 16; ++i) { st[i] = st[i] * da + xd * Bp[i]; acc += Cp[i] * st[i]; }
        acc += __shfl_xor(acc, 1); acc += __shfl_xor(acc, 2); acc += __shfl_xor(acc, 4);
        if (nq == 0) y[t * SSD_INNER + h * SSD_P + p] = acc + dsk * xv;
    }
}

__global__ void k_rope(float* q, const float* u, const int* pos, float* kpe) {
    const int idx = blockIdx.x * blockDim.x + threadIdx.x;
    if (idx >= M * 9 * 16) return;
    const int i = idx % 16, hh = (idx / 16) % 9, t = idx / (16 * 9);
    const float inv = 1.0f / powf(10000.0f, (float)(2 * i) / 32.0f);
    const float ang = (float)pos[t] * inv;
    float sn, cs; sincosf(ang, &sn, &cs);
    if (hh < 8) {
        float* p = q + (size_t)t * (MLA_H * QK) + hh * QK + NOPE;
        const float x1 = p[i], x2 = p[16 + i];
        p[i] = x1 * cs - x2 * sn; p[16 + i] = x2 * cs + x1 * sn;
    } else {
        const float* p = u + (size_t)t * NIN + OFF_KR;
        const float x1 = p[i], x2 = p[16 + i];
        kpe[(size_t)t * ROPE + i] = x1 * cs - x2 * sn; kpe[(size_t)t * ROPE + 16 + i] = x2 * cs + x1 * sn;
    }
}

__global__ void __launch_bounds__(64) k_attn(const float* q, const float* kv, const float* kpe, float* o) {
    const int qi = blockIdx.x * 64 + threadIdx.x;
    const int h = blockIdx.y, b = blockIdx.z;
    const size_t t = (size_t)b * SEQ + qi;
    float qr[QK];
#pragma unroll
    for (int d = 0; d < QK; ++d) qr[d] = q[t * (MLA_H * QK) + h * QK + d] * 0.10206207261596575f;
    float acc[VD];
#pragma unroll
    for (int d = 0; d < VD; ++d) acc[d] = 0.f;
    float mx = -INFINITY, l = 0.f;
    const int kmax = blockIdx.x * 64 + 63;
    for (int k = 0; k <= kmax; ++k) {
        const size_t tk = (size_t)b * SEQ + k;
        const float* kn = kv + tk * (MLA_H * 128) + h * 128;
        const float* kp = kpe + tk * ROPE;
        float s = 0.f;
#pragma unroll
        for (int d = 0; d < NOPE; ++d) s += qr[d] * kn[d];
#pragma unroll
        for (int d = 0; d < ROPE; ++d) s += qr[NOPE + d] * kp[d];
        if (k <= qi) {
            const float mn = fmaxf(mx, s);
            const float f = expf(mx - mn), pv = expf(s - mn);
            l = l * f + pv;
#pragma unroll
            for (int d = 0; d < VD; ++d) acc[d] = acc[d] * f + pv * kn[64 + d];
            mx = mn;
        }
    }
    const float il = 1.f / l;
#pragma unroll
    for (int d = 0; d < VD; ++d) o[t * (MLA_H * VD) + h * VD + d] = acc[d] * il;
}

__global__ void __launch_bounds__(256) k_moe(const float* h2, const float* wgr, const float* bgr, const float* wer, const float* ber,
                                             const float* wg, const float* wu, const float* wd, float* y2) {
    __shared__ float xs[D];
    __shared__ float logit[36];
    __shared__ float hid[2][FF];
    __shared__ int sel_e[2];
    __shared__ float sel_w[2];
    const int t = blockIdx.x, tid = threadIdx.x;
    for (int i = tid; i < D; i += 256) xs[i] = h2[(size_t)t * D + i];
    __syncthreads();
    {
        const int w = tid >> 6, lane = tid & 63;
        for (int cidx = w * 9; cidx < w * 9 + 9; ++cidx) {
            float s = 0.f;
            for (int k = lane; k < D; k += 64) s += xs[k] * (cidx < 4 ? wgr[k * 4 + cidx] : wer[k * 32 + (cidx - 4)]);
            for (int o = 32; o > 0; o >>= 1) s += __shfl_xor(s, o);
            if (lane == 0) logit[cidx] = s;
        }
    }
    __syncthreads();
    if (tid == 0) {
        float mxv = -INFINITY; int gi = 0;
        for (int i = 0; i < 4; ++i) { const float v = logit[i] + bgr[i]; logit[i] = v; if (v > mxv) { mxv = v; gi = i; } }
        float den = 0.f; for (int i = 0; i < 4; ++i) den += expf(logit[i] - mxv);
        const float gw = 1.f / den;
        float emx = -INFINITY; int i1 = 0;
        for (int i = 0; i < 8; ++i) { const float v = logit[4 + gi * 8 + i] + ber[gi * 8 + i]; logit[4 + gi * 8 + i] = v; if (v > emx) { emx = v; i1 = i; } }
        float e2 = -INFINITY; int i2 = 0;
        for (int i = 0; i < 8; ++i) { const float v = logit[4 + gi * 8 + i]; if (i != i1 && v > e2) { e2 = v; i2 = i; } }
        const float p1 = 1.f, p2 = expf(e2 - emx);
        sel_e[0] = gi * 8 + i1; sel_e[1] = gi * 8 + i2;
        sel_w[0] = gw * p1 / (p1 + p2); sel_w[1] = gw * p2 / (p1 + p2);
    }
    __syncthreads();
    for (int k2 = 0; k2 < 2; ++k2) {
        const int e = sel_e[k2];
        const float* G = wg + (size_t)e * D * FF; const float* U = wu + (size_t)e * D * FF;
        float ga = 0.f, ua = 0.f;
        for (int k = 0; k < D; ++k) { ga += xs[k] * G[(size_t)k * FF + tid]; ua += xs[k] * U[(size_t)k * FF + tid]; }
        hid[k2][tid] = silu_f(ga) * ua * sel_w[k2];
    }
    __syncthreads();
    for (int d = tid; d < D; d += 256) {
        float acc = 0.f;
        for (int k2 = 0; k2 < 2; ++k2) {
            const float* Wd = wd + (size_t)sel_e[k2] * FF * D;
            for (int f = 0; f < FF; ++f) acc += hid[k2][f] * Wd[(size_t)f * D + d];
        }
        y2[(size_t)t * D + d] = acc;
    }
}

extern "C" void kernel_launch(void* const* d_in, const int* in_sizes, int n_in, void* d_out, int out_size, void* d_ws, size_t ws_size,
                              hipStream_t stream) {
    const float* x = (const float*)d_in[0];
    const float* c = (const float*)d_in[1];
    const int* pos = (const int*)d_in[2];
    const float* ada_w = (const float*)d_in[3];
    const float* ada_b = (const float*)d_in[4];
    const float* pre_mix = (const float*)d_in[5];
    const float* post_mix = (const float*)d_in[6];
    const float* pre_ffn = (const float*)d_in[7];
    const float* post_ffn = (const float*)d_in[8];
    const float* w_in = (const float*)d_in[9];
    const float* conv_w = (const float*)d_in[10];
    const float* conv_b = (const float*)d_in[11];
    const float* dt_bias = (const float*)d_in[12];
    const float* a_log = (const float*)d_in[13];
    const float* d_skip = (const float*)d_in[14];
    const float* ssd_norm = (const float*)d_in[15];
    const float* q_norm = (const float*)d_in[16];
    const float* w_uq = (const float*)d_in[17];
    const float* kv_norm = (const float*)d_in[18];
    const float* w_ukv = (const float*)d_in[19];
    const float* mla_norm = (const float*)d_in[20];
    const float* w_out = (const float*)d_in[21];
    const float* wgr = (const float*)d_in[22];
    const float* bgr = (const float*)d_in[23];
    const float* wer = (const float*)d_in[24];
    const float* ber = (const float*)d_in[25];
    const float* w_gate = (const float*)d_in[26];
    const float* w_up = (const float*)d_in[27];
    const float* w_down = (const float*)d_in[28];
    float* out = (float*)d_out;
    char* ws = (char*)d_ws;
    const size_t MB = 1u << 20;
    float* R0 = (float*)(ws);
    float* RA = (float*)(ws + 128 * MB);
    float* RB = (float*)(ws + 192 * MB);
    float* mod = (float*)(ws + 252 * MB);
    float* kpe = (float*)(ws + 253 * MB);

    k_mod<<<dim3(6 * D / 256, NB), 256, 0, stream>>>(c, ada_w, ada_b, mod);
    float* hbuf = RA;
    k_prenorm<<<M, 256, 0, stream>>>(x, pre_mix, mod, 0 * D, 1 * D, hbuf);
    float* u = R0;
    k_gemm<<<dim3((NIN + 63) / 64, M / 64), 256, 0, stream>>>(hbuf, D, w_in, NIN, u, NIN, M, NIN, D);
    float* xc = RA;
    k_conv<<<(int)(((size_t)M * SSD_XBC + 255) / 256), 256, 0, stream>>>(u, conv_w, conv_b, xc);
    float* yssd = RB;
    k_ssd_seq<<<NB * SSD_H, 512, 0, stream>>>(u, xc, dt_bias, a_log, d_skip, yssd);
    float* ycat = out;
    k_gate_norm<<<M, 256, 0, stream>>>(yssd, u, ssd_norm, ycat, D);
    float* cqn = RB;
    float* ckvn = RB + (size_t)M * QR;
    k_rms_slice<<<M, 256, 0, stream>>>(u, NIN, OFF_CQ, QR, q_norm, cqn, QR, 0);
    k_rms_slice<<<M, 128, 0, stream>>>(u, NIN, OFF_CKV, KVR, kv_norm, ckvn, KVR, 0);
    float* q = RA;
    k_gemm<<<dim3(768 / 64, M / 64), 256, 0, stream>>>(cqn, QR, w_uq, 768, q, 768, M, 768, QR);
    k_rope<<<(M * 9 * 16 + 255) / 256, 256, 0, stream>>>(q, u, pos, kpe);
    float* kv = R0;
    k_gemm<<<dim3(1024 / 64, M / 64), 256, 0, stream>>>(ckvn, KVR, w_ukv, 1024, kv, 1024, M, 1024, KVR);
    float* oatt = R0 + (size_t)M * 1024;
    k_attn<<<dim3(SEQ / 64, MLA_H, NB), 64, 0, stream>>>(q, kv, kpe, oatt);
    k_rms_slice<<<M, 256, 0, stream>>>(oatt, 512, 0, 512, mla_norm, ycat, D, 512);
    float* y = RA;
    k_gemm<<<dim3(D / 64, M / 64), 256, 0, stream>>>(ycat, D, w_out, D, y, D, M, D, D);
    float* x1 = R0;
    k_post<<<M, 256, 0, stream>>>(x, y, post_mix, mod, 2 * D, x1);
    float* h2 = R0 + (size_t)M * D;
    k_prenorm<<<M, 256, 0, stream>>>(x1, pre_ffn, mod, 3 * D, 4 * D, h2);
    float* y2 = RA;
    k_moe<<<M, 256, 0, stream>>>(h2, wgr, bgr, wer, ber, w_gate, w_up, w_down, y2);
    k_post<<<M, 256, 0, stream>>>(x1, y2, post_ffn, mod, 5 * D, out);
}
```

```cpp
#include <hip/hip_runtime.h>
#include <hip/hip_cooperative_groups.h>
#include <stdint.h>
#include <math.h>
#include <cstdio>
namespace cg = cooperative_groups;

constexpr int D = 1024, NB = 8, SEQ = 2048, M = NB * SEQ;
constexpr int SSD_H = 8, SSD_P = 64, SSD_INNER = 512, SSD_G = 2, SSD_N = 128, SSD_XBC = 1024;
constexpr int MLA_H = 8, NOPE = 64, ROPE = 32, QK = 96, VD = 64, QR = 256, KVR = 128;
constexpr int NIN = 1960;
constexpr int OFF_Z = 0, OFF_XBC = 512, OFF_DT = 1536, OFF_CQ = 1544, OFF_CKV = 1800, OFF_KR = 1928;
constexpr int NEXP = 32, FF = 256;
constexpr float EPS = 1e-6f;
constexpr int NT = 512;
constexpr int LDS_BYTES = 144 * 1024;

struct Params {
    const float* in[29];
    const int* pos;
    float* out;
    char* ws;
};

__device__ __forceinline__ float silu_f(float v) { return v / (1.f + expf(-v)); }
__device__ __forceinline__ float wave_sum(float v) {
#pragma unroll
    for (int o = 32; o > 0; o >>= 1) v += __shfl_xor(v, o);
    return v;
}

__device__ void ph_mod(const float* c, const float* ada_w, const float* ada_b, float* mod) {
    for (int idx = blockIdx.x * NT + threadIdx.x; idx < NB * 6 * D; idx += gridDim.x * NT) {
        const int b = idx / (6 * D), j = idx % (6 * D);
        float acc = ada_b[j];
        for (int k = 0; k < D; ++k) acc += silu_f(c[b * D + k]) * ada_w[(size_t)k * 6 * D + j];
        mod[idx] = acc;
    }
}
__device__ void ph_prenorm(const float* in, const float* g, const float* mod, int sh_off, int sc_off, float* out) {
    const int lane = threadIdx.x & 63, gw = blockIdx.x * (NT / 64) + (threadIdx.x >> 6), ngw = gridDim.x * (NT / 64);
    for (int t = gw; t < M; t += ngw) {
        const int b = t / SEQ; const float* r = in + (size_t)t * D;
        float s = 0.f;
        for (int i = lane; i < D; i += 64) s += r[i] * r[i];
        const float inv = rsqrtf(wave_sum(s) / D + EPS);
        for (int i = lane; i < D; i += 64)
            out[(size_t)t * D + i] = r[i] * inv * g[i] * (1.f + mod[b * 6 * D + sc_off + i]) + mod[b * 6 * D + sh_off + i];
    }
}
__device__ void ph_post(const float* base, const float* y, const float* g, const float* mod, int gate_off, float* out) {
    const int lane = threadIdx.x & 63, gw = blockIdx.x * (NT / 64) + (threadIdx.x >> 6), ngw = gridDim.x * (NT / 64);
    for (int t = gw; t < M; t += ngw) {
        const int b = t / SEQ; const float* r = y + (size_t)t * D;
        float s = 0.f;
        for (int i = lane; i < D; i += 64) s += r[i] * r[i];
        const float inv = rsqrtf(wave_sum(s) / D + EPS);
        for (int i = lane; i < D; i += 64)
            out[(size_t)t * D + i] = base[(size_t)t * D + i] + mod[b * 6 * D + gate_off + i] * (r[i] * inv * g[i]);
    }
}
__device__ void ph_rms_slice(const float* in, int ldi, int off, int n, const float* g, float* out, int ldo, int ooff) {
    const int lane = threadIdx.x & 63, gw = blockIdx.x * (NT / 64) + (threadIdx.x >> 6), ngw = gridDim.x * (NT / 64);
    for (int t = gw; t < M; t += ngw) {
        const float* r = in + (size_t)t * ldi + off;
        float s = 0.f;
        for (int i = lane; i < n; i += 64) s += r[i] * r[i];
        const float inv = rsqrtf(wave_sum(s) / n + EPS);
        for (int i = lane; i < n; i += 64) out[(size_t)t * ldo + ooff + i] = r[i] * inv * g[i];
    }
}
__device__ void ph_gate_norm(const float* y, const float* u, const float* g, float* out, int ldo) {
    const int lane = threadIdx.x & 63, gw = blockIdx.x * (NT / 64) + (threadIdx.x >> 6), ngw = gridDim.x * (NT / 64);
    for (int t = gw; t < M; t += ngw) {
        float s = 0.f;
        for (int i = lane; i < SSD_INNER; i += 64) { const float v = y[(size_t)t * SSD_INNER + i] * silu_f(u[(size_t)t * NIN + OFF_Z + i]); s += v * v; }
        const float inv = rsqrtf(wave_sum(s) / SSD_INNER + EPS);
        for (int i = lane; i < SSD_INNER; i += 64) { const float v = y[(size_t)t * SSD_INNER + i] * silu_f(u[(size_t)t * NIN + OFF_Z + i]); out[(size_t)t * ldo + i] = v * inv * g[i]; }
    }
}
__device__ void ph_gemm(float* lds, const float* A, int lda, const float* B, int ldb, float* C, int ldc, int Mr, int N, int K) {
    float (*As)[129] = (float (*)[129])lds;
    float (*Bs)[65] = (float (*)[65])(lds + 16 * 129);
    const int tx = threadIdx.x & 15, ty = threadIdx.x >> 4;
    const int ntn = (N + 63) / 64, ntm = Mr / 128;
    for (int tile = blockIdx.x; tile < ntn * ntm; tile += gridDim.x) {
        const int m0 = (tile / ntn) * 128, n0 = (tile % ntn) * 64;
        float acc[4][4] = {};
        for (int k0 = 0; k0 < K; k0 += 16) {
            for (int i = threadIdx.x; i < 128 * 16; i += NT) { const int r = i >> 4, kk = i & 15; As[kk][r] = A[(size_t)(m0 + r) * lda + k0 + kk]; }
            for (int i = threadIdx.x; i < 64 * 16; i += NT) { const int kk = i >> 6, cc = i & 63; Bs[kk][cc] = (n0 + cc < N) ? B[(size_t)(k0 + kk) * ldb + n0 + cc] : 0.f; }
            __syncthreads();
#pragma unroll
            for (int kk = 0; kk < 16; ++kk) {
                float a[4], b[4];
#pragma unroll
                for (int i = 0; i < 4; ++i) { a[i] = As[kk][ty * 4 + i]; b[i] = Bs[kk][tx * 4 + i]; }
#pragma unroll
                for (int i = 0; i < 4; ++i)
#pragma unroll
                    for (int j = 0; j < 4; ++j) acc[i][j] += a[i] * b[j];
            }
            __syncthreads();
        }
#pragma unroll
        for (int i = 0; i < 4; ++i)
#pragma unroll
            for (int j = 0; j < 4; ++j) { const int n = n0 + tx * 4 + j; if (n < N) C[(size_t)(m0 + ty * 4 + i) * ldc + n] = acc[i][j]; }
    }
}
__device__ void ph_conv(const float* u, const float* cw, const float* cb, float* xc) {
    for (size_t idx = (size_t)blockIdx.x * NT + threadIdx.x; idx < (size_t)M * SSD_XBC; idx += (size_t)gridDim.x * NT) {
        const int ch = (int)(idx % SSD_XBC), t = (int)(idx / SSD_XBC), s = t % SEQ;
        float acc = cb[ch];
        for (int k = 0; k < 4; ++k) { const int ss = s - 3 + k; if (ss >= 0) acc += cw[k * SSD_XBC + ch] * u[(size_t)(t - 3 + k) * NIN + OFF_XBC + ch]; }
        xc[idx] = silu_f(acc);
    }
}
__device__ void ph_ssd_seq(const float* u, const float* xc, const float* dt_bias, const float* a_log, const float* d_skip, float* y) {
    for (int item = blockIdx.x; item < NB * SSD_H; item += gridDim.x) {
        const int b = item / SSD_H, h = item % SSD_H, g = h / (SSD_H / SSD_G);
        const int p = threadIdx.x >> 3, nq = threadIdx.x & 7;
        const float a = -expf(a_log[h]), dsk = d_skip[h], dtb = dt_bias[h];
        float st[16];
#pragma unroll
        for (int i = 0; i < 16; ++i) st[i] = 0.f;
        for (int s = 0; s < SEQ; ++s) {
            const size_t t = (size_t)b * SEQ + s;
            const float raw = u[t * NIN + OFF_DT + h] + dtb;
            const float dt = raw > 20.f ? raw : log1pf(expf(raw));
            const float da = expf(dt * a);
            const float xv = xc[t * SSD_XBC + h * SSD_P + p];
            const float xd = xv * dt;
            const float* Bp = xc + t * SSD_XBC + SSD_INNER + g * SSD_N + nq * 16;
            const float* Cp = xc + t * SSD_XBC + SSD_INNER + SSD_G * SSD_N + g * SSD_N + nq * 16;
            float acc = 0.f;
#pragma unroll
            for (int i = 0; i < 16; ++i) { st[i] = st[i] * da + xd * Bp[i]; acc += Cp[i] * st[i]; }
            acc += __shfl_xor(acc, 1); acc += __shfl_xor(acc, 2); acc += __shfl_xor(acc, 4);
            if (nq == 0) y[t * SSD_INNER + h * SSD_P + p] = acc + dsk * xv;
        }
    }
}
__device__ void ph_rope(float* q, const float* u, const int* pos, float* kpe) {
    for (int idx = blockIdx.x * NT + threadIdx.x; idx < M * 9 * 16; idx += gridDim.x * NT) {
        const int i = idx % 16, hh = (idx / 16) % 9, t = idx / (16 * 9);
        const float inv = 1.0f / powf(10000.0f, (float)(2 * i) / 32.0f);
        const float ang = (float)pos[t] * inv;
        float sn, cs; sincosf(ang, &sn, &cs);
        if (hh < 8) {
            float* p = q + (size_t)t * (MLA_H * QK) + hh * QK + NOPE;
            const float x1 = p[i], x2 = p[16 + i];
            p[i] = x1 * cs - x2 * sn; p[16 + i] = x2 * cs + x1 * sn;
        } else {
            const float* p = u + (size_t)t * NIN + OFF_KR;
            const float x1 = p[i], x2 = p[16 + i];
            kpe[(size_t)t * ROPE + i] = x1 * cs - x2 * sn; kpe[(size_t)t * ROPE + 16 + i] = x2 * cs + x1 * sn;
        }
    }
}
__device__ void ph_attn(const float* q, const float* kv, const float* kpe, float* o) {
    const int lane = threadIdx.x & 63, gw = blockIdx.x * (NT / 64) + (threadIdx.x >> 6), ngw = gridDim.x * (NT / 64);
    for (int item = gw; item < NB * MLA_H * (SEQ / 64); item += ngw) {
        const int qb = (SEQ / 64 - 1) - item / (NB * MLA_H), bh = item % (NB * MLA_H), b = bh / MLA_H, h = bh % MLA_H;
        const int qi = qb * 64 + lane;
        const size_t t = (size_t)b * SEQ + qi;
        float qr[QK];
#pragma unroll
        for (int d = 0; d < QK; ++d) qr[d] = q[t * (MLA_H * QK) + h * QK + d] * 0.10206207261596575f;
        float acc[VD];
#pragma unroll
        for (int d = 0; d < VD; ++d) acc[d] = 0.f;
        float mx = -INFINITY, l = 0.f;
        const int kmax = qb * 64 + 63;
        for (int k = 0; k <= kmax; ++k) {
            const size_t tk = (size_t)b * SEQ + k;
            const float* kn = kv + tk * (MLA_H * 128) + h * 128;
            const float* kp = kpe + tk * ROPE;
            float s = 0.f;
#pragma unroll
            for (int d = 0; d < NOPE; ++d) s += qr[d] * kn[d];
#pragma unroll
            for (int d = 0; d < ROPE; ++d) s += qr[NOPE + d] * kp[d];
            if (k <= qi) {
                const float mn = fmaxf(mx, s);
                const float f = expf(mx - mn), pv = expf(s - mn);
                l = l * f + pv;
#pragma unroll
                for (int d = 0; d < VD; ++d) acc[d] = acc[d] * f + pv * kn[64 + d];
                mx = mn;
            }
        }
        const float il = 1.f / l;
#pragma unroll
        for (int d = 0; d < VD; ++d) o[t * (MLA_H * VD) + h * VD + d] = acc[d] * il;
    }
}
__device__ void ph_moe(float* lds, const float* h2, const float* wgr, const float* bgr, const float* wer, const float* ber,
                       const float* wg, const float* wu, const float* wd, float* y2) {
    const int sb = threadIdx.x >> 8, tid = threadIdx.x & 255;
    float* xs = lds + sb * 2048;
    float* logit = xs + 1024;
    float* hid = xs + 1088;
    int* sel_e = (int*)(xs + 1600);
    float* sel_w = xs + 1604;
    for (int it = blockIdx.x; it < M / 2; it += gridDim.x) {
        const int t = it * 2 + sb;
        __syncthreads();
        for (int i = tid; i < D; i += 256) xs[i] = h2[(size_t)t * D + i];
        __syncthreads();
        {
            const int w = tid >> 6, lane = tid & 63;
            for (int cidx = w * 9; cidx < w * 9 + 9; ++cidx) {
                float s = 0.f;
                for (int k = lane; k < D; k += 64) s += xs[k] * (cidx < 4 ? wgr[k * 4 + cidx] : wer[k * 32 + (cidx - 4)]);
                s = wave_sum(s);
                if (lane == 0) logit[cidx] = s;
            }
        }
        __syncthreads();
        if (tid == 0) {
            float mxv = -INFINITY; int gi = 0;
            for (int i = 0; i < 4; ++i) { const float v = logit[i] + bgr[i]; logit[i] = v; if (v > mxv) { mxv = v; gi = i; } }
            float den = 0.f; for (int i = 0; i < 4; ++i) den += expf(logit[i] - mxv);
            const float gw = 1.f / den;
            float emx = -INFINITY; int i1 = 0;
            for (int i = 0; i < 8; ++i) { const float v = logit[4 + gi * 8 + i] + ber[gi * 8 + i]; logit[4 + gi * 8 + i] = v; if (v > emx) { emx = v; i1 = i; } }
            float e2 = -INFINITY; int i2 = 0;
            for (int i = 0; i < 8; ++i) { const float v = logit[4 + gi * 8 + i]; if (i != i1 && v > e2) { e2 = v; i2 = i; } }
            const float p2 = expf(e2 - emx);
            sel_e[0] = gi * 8 + i1; sel_e[1] = gi * 8 + i2;
            sel_w[0] = gw / (1.f + p2); sel_w[1] = gw * p2 / (1.f + p2);
        }
        __syncthreads();
        for (int k2 = 0; k2 < 2; ++k2) {
            const int e = sel_e[k2];
            const float* G = wg + (size_t)e * D * FF; const float* U = wu + (size_t)e * D * FF;
            float ga = 0.f, ua = 0.f;
            for (int k = 0; k < D; ++k) { ga += xs[k] * G[(size_t)k * FF + tid]; ua += xs[k] * U[(size_t)k * FF + tid]; }
            hid[k2 * FF + tid] = silu_f(ga) * ua * sel_w[k2];
        }
        __syncthreads();
        for (int d = tid; d < D; d += 256) {
            float acc = 0.f;
            for (int k2 = 0; k2 < 2; ++k2) {
                const float* Wd = wd + (size_t)sel_e[k2] * FF * D;
                for (int f = 0; f < FF; ++f) acc += hid[k2 * FF + f] * Wd[(size_t)f * D + d];
            }
            y2[(size_t)t * D + d] = acc;
        }
    }
}

__global__ void __launch_bounds__(NT, 2) mega_fwd(Params P) {
    extern __shared__ __attribute__((aligned(16))) unsigned char lds_raw[];
    float* lds = (float*)lds_raw;
    cg::grid_group grid = cg::this_grid();
    const float* x = P.in[0]; const float* c = P.in[1];
    const float* ada_w = P.in[3]; const float* ada_b = P.in[4];
    const float* pre_mix = P.in[5]; const float* post_mix = P.in[6]; const float* pre_ffn = P.in[7]; const float* post_ffn = P.in[8];
    const float* w_in = P.in[9]; const float* conv_w = P.in[10]; const float* conv_b = P.in[11];
    const float* dt_bias = P.in[12]; const float* a_log = P.in[13]; const float* d_skip = P.in[14]; const float* ssd_norm = P.in[15];
    const float* q_norm = P.in[16]; const float* w_uq = P.in[17]; const float* kv_norm = P.in[18]; const float* w_ukv = P.in[19];
    const float* mla_norm = P.in[20]; const float* w_out = P.in[21];
    const float* wgr = P.in[22]; const float* bgr = P.in[23]; const float* wer = P.in[24]; const float* ber = P.in[25];
    const float* w_gate = P.in[26]; const float* w_up = P.in[27]; const float* w_down = P.in[28];
    float* out = P.out; char* ws = P.ws;
    const size_t MB = 1u << 20;
    float* R0 = (float*)(ws);
    float* RA = (float*)(ws + 128 * MB);
    float* RB = (float*)(ws + 192 * MB);
    float* mod = (float*)(ws + 252 * MB);
    float* kpe = (float*)(ws + 253 * MB);

    ph_mod(c, ada_w, ada_b, mod);
    grid.sync();
    float* hbuf = RA;
    ph_prenorm(x, pre_mix, mod, 0 * D, 1 * D, hbuf);
    grid.sync();
    float* u = R0;
    ph_gemm(lds, hbuf, D, w_in, NIN, u, NIN, M, NIN, D);
    grid.sync();
    float* xc = RA;
    ph_conv(u, conv_w, conv_b, xc);
    float* cqn = RB + (size_t)M * SSD_INNER;
    float* ckvn = cqn + (size_t)M * QR;
    ph_rms_slice(u, NIN, OFF_CQ, QR, q_norm, cqn, QR, 0);
    ph_rms_slice(u, NIN, OFF_CKV, KVR, kv_norm, ckvn, KVR, 0);
    grid.sync();
    float* yssd = RB;
    ph_ssd_seq(u, xc, dt_bias, a_log, d_skip, yssd);
    grid.sync();
    float* ycat = out;
    ph_gate_norm(yssd, u, ssd_norm, ycat, D);
    grid.sync();
    float* q = RA;
    ph_gemm(lds, cqn, QR, w_uq, 768, q, 768, M, 768, QR);
    grid.sync();
    ph_rope(q, u, P.pos, kpe);
    grid.sync();
    float* kv = R0;
    ph_gemm(lds, ckvn, KVR, w_ukv, 1024, kv, 1024, M, 1024, KVR);
    grid.sync();
    float* oatt = R0 + (size_t)M * 1024;
    ph_attn(q, kv, kpe, oatt);
    grid.sync();
    ph_rms_slice(oatt, 512, 0, 512, mla_norm, ycat, D, 512);
    grid.sync();
    float* y = RA;
    ph_gemm(lds, ycat, D, w_out, D, y, D, M, D, D);
    grid.sync();
    float* x1 = R0;
    ph_post(x, y, post_mix, mod, 2 * D, x1);
    grid.sync();
    float* h2 = R0 + (size_t)M * D;
    ph_prenorm(x1, pre_ffn, mod, 3 * D, 4 * D, h2);
    grid.sync();
    float* y2 = RA;
    ph_moe(lds, h2, wgr, bgr, wer, ber, w_gate, w_up, w_down, y2);
    grid.sync();
    ph_post(x1, y2, post_ffn, mod, 5 * D, out);
}

extern "C" void kernel_launch(void* const* d_in, const int* in_sizes, int n_in, void* d_out, int out_size, void* d_ws, size_t ws_size,
                              hipStream_t stream) {
    static int grid_blocks = 0;
    if (!grid_blocks) {
        int dev = 0, cus = 0, per_cu = 0;
        (void)hipGetDevice(&dev);
        (void)hipDeviceGetAttribute(&cus, hipDeviceAttributeMultiprocessorCount, dev);
        (void)hipFuncSetAttribute((const void*)mega_fwd, hipFuncAttributeMaxDynamicSharedMemorySize, LDS_BYTES);
        (void)hipOccupancyMaxActiveBlocksPerMultiprocessor(&per_cu, (const void*)mega_fwd, NT, LDS_BYTES);
        if (per_cu < 1) { fprintf(stderr, "occupancy query returned %d\n", per_cu); per_cu = 1; }
        grid_blocks = cus * per_cu;
    }
    Params p{};
    for (int i = 0; i < 29; ++i) p.in[i] = (const float*)d_in[i];
    p.pos = (const int*)d_in[2];
    p.out = (float*)d_out;
    p.ws = (char*)d_ws;
    void* args[] = {&p};
    hipError_t e = hipLaunchCooperativeKernel((void*)mega_fwd, dim3(grid_blocks), dim3(NT), args, LDS_BYTES, stream);
    if (e != hipSuccess) fprintf(stderr, "cooperative launch failed: %s (grid %d)\n", hipGetErrorString(e), grid_blocks);
}
```

```cpp
#include <hip/hip_runtime.h>
#include <hip/hip_cooperative_groups.h>
#include <stdint.h>
#include <math.h>
#include <cstdio>
namespace cg = cooperative_groups;

constexpr int D = 1024, NB = 8, SEQ = 2048, M = NB * SEQ;
constexpr int SSD_H = 8, SSD_P = 64, SSD_INNER = 512, SSD_G = 2, SSD_N = 128, SSD_XBC = 1024;
constexpr int MLA_H = 8, NOPE = 64, ROPE = 32, QK = 96, VD = 64, QR = 256, KVR = 128;
constexpr int NIN = 1960;
constexpr int NU = 2048;
constexpr int OFF_Z = 0, OFF_XBC = 512, OFF_CQ = 1536, OFF_CKV = 1792, OFF_KR = 1920, OFF_DT = 1952;
constexpr int NEXP = 32, FF = 256;
constexpr float EPS = 1e-6f;
constexpr int NT = 512;
constexpr int LDS_BYTES = 144 * 1024;

typedef unsigned short bf16;
__device__ __forceinline__ float bf2f(bf16 v) { return __uint_as_float((unsigned)v << 16); }
__device__ __forceinline__ unsigned f2bf(float f) { unsigned u = __float_as_uint(f); return (u + 0x7fffu + ((u >> 16) & 1u)) >> 16; }
__device__ __forceinline__ unsigned pk2(float lo, float hi) { return f2bf(lo) | (f2bf(hi) << 16); }
typedef unsigned v4u __attribute__((ext_vector_type(4)));
typedef float f32x4v __attribute__((ext_vector_type(4)));

struct Params {
    const float* in[29];
    const int* pos;
    float* out;
    char* ws;
};

__device__ __forceinline__ float silu_f(float v) { return v / (1.f + expf(-v)); }
__device__ __forceinline__ float wave_sum(float v) {
#pragma unroll
    for (int o = 32; o > 0; o >>= 1) v += __shfl_xor(v, o);
    return v;
}

namespace pg8 {
#define PG8_LAS __attribute__((address_space(3)))
typedef unsigned short bf16_t;
typedef short bf16x8 __attribute__((ext_vector_type(8)));
typedef float f32x4 __attribute__((ext_vector_type(4)));
typedef unsigned u32x4 __attribute__((ext_vector_type(4)));
constexpr int BM = 256, BK = 64, HALF = 128, HTB = HALF * BK * 2  , STAGE_BYTES = 8 * HTB, NXCD = 8, WGM = 8;

__host__ __device__ __forceinline__ int lds_byte(int r, int c) { const int st = (r >> 4) * 2 + (c >> 5), rr = r & 15, cc = c & 31, ob = rr * 64 + cc * 2; return st * 1024 + (ob ^ (((ob >> 9) & 1) << 5)); }
__host__ __device__ __forceinline__ void stage_rc(int b, int& R, int& C) { const int st = b / 1024, sb = b % 1024, swz = sb ^ (((sb >> 9) & 1) << 5); R = (st >> 1) * 16 + swz / 64; C = (st & 1) * 32 + (swz % 64) / 2; }
__host__ __device__ __forceinline__ int perm32(int rho) { const int n = rho >> 4, i = rho & 15; return 8 * (i >> 2) + 4 * n + (i & 3); }

struct Unit { int pm, pn; };
struct Gemm { const bf16_t* A; const bf16_t* Bt; int M, N, K; };

struct StaticOrder {
    int nM, nN, nwg, G, c;
    __host__ __device__ void init(int M, int N, int G_, int c_) { nM = M / BM; nN = N / BM; nwg = nM * nN; G = G_; c = c_; }
    __host__ __device__ bool next(int i, Unit& u) const {
        const long L = (long)i * G + c; if (L >= nwg) return false;
        int wgid = (int)L; { const int q = nwg / NXCD, r = nwg % NXCD, xcd = wgid % NXCD, off = wgid / NXCD; wgid = (xcd < r ? xcd * (q + 1) : r * (q + 1) + (xcd - r) * q) + off; }
        const int nig = WGM * nN, gid = wgid / nig, fm = gid * WGM, gsz = (nM - fm) < WGM ? (nM - fm) : WGM;
        u.pm = fm + ((wgid % nig) % gsz); u.pn = (wgid % nig) / gsz; return true;
    }
    __device__ __forceinline__ void a_ready(const Unit&) const {}
    __device__ __forceinline__ void done(const Unit&) const {}
};


template <int ACT> struct EpiBf16 {
    static constexpr bool PERM = true, AFTER_DRAIN = false;
    bf16_t* O; int ldc;
    __device__ __forceinline__ void operator()(const f32x4 (&acc)[2][2][4][2], const Unit& u, int wr, int wc, int fr, int fq) const {
        const int row0 = u.pm * BM + wr * 64 + fr; const int col0 = u.pn * BM + wc * 32 + 8 * fq;
#pragma unroll
        for (int ai = 0; ai < 2; ++ai)
#pragma unroll
            for (int m = 0; m < 4; ++m) { bf16_t* rowp = O + (size_t)(row0 + ai * HALF + m * 16) * ldc + col0;
#pragma unroll
                for (int bj = 0; bj < 2; ++bj) { const f32x4 v0 = acc[ai][bj][m][0], v1 = acc[ai][bj][m][1];
                    u32x4 w; w.x = pk2(v0[0], v0[1]); w.y = pk2(v0[2], v0[3]); w.z = pk2(v1[0], v1[1]); w.w = pk2(v1[2], v1[3]);
                    *(u32x4*)(rowp + bj * HALF) = w; } }
    }
};
template <class Epi, class Sched, bool ALIGN_EPI = false, bool SP2 = false>
__device__ __forceinline__ void gemm_phase(PG8_LAS unsigned char* lds, const Gemm g, const Sched& S, const Epi& E) {
    const int tid = threadIdx.x, wid = __builtin_amdgcn_readfirstlane(tid >> 6), lane = tid & 63, wr = wid >> 2, wc = wid & 3, fr = lane & 15, fq = lane >> 4;
    const int K = g.K, nt = K / BK;
    unsigned voffA[2], voffB[2];
#pragma unroll
    for (int i = 0; i < 2; ++i) { int R, C; stage_rc(tid * 16 + i * 8192, R, C); const int Rb = Epi::PERM ? ((R & ~31) + perm32(R & 31)) : R;
        voffA[i] = (unsigned)(R * K + C) * 2u; voffB[i] = (unsigned)(Rb * K + C) * 2u; }
    const size_t kstep = (size_t)(BK * 2);
    const size_t hstep = (size_t)HALF * K * 2;
    const size_t tstep = 2 * hstep;
    const unsigned ldsw = (unsigned)wid * 1024u;
    const int aoff = lds_byte(wr * 64 + fr, fq * 8), boff = lds_byte(wc * 32 + fr, fq * 8);
#define PG8_SA(b, h) (((b) * 2 + (h)) * HTB)
#define PG8_SB(b, h) ((4 + (b) * 2 + (h)) * HTB)
#define PG8_STAGE(bufoff, gbase, voff) do { _Pragma("unroll") for (int _i = 0; _i < 2; ++_i) \
        __builtin_amdgcn_global_load_lds((const unsigned*)((const char*)(gbase) + (voff)[_i]), (PG8_LAS unsigned*)(lds + (bufoff) + ldsw + _i * 8192), 16, 0, 0); } while (0)
#define PG8_LDA(dst, b, h) do { _Pragma("unroll") for (int m = 0; m < 4; ++m) _Pragma("unroll") for (int k = 0; k < 2; ++k) dst[m][k] = *(const PG8_LAS bf16x8*)(lds + PG8_SA(b, h) + aoff + m * 2048 + k * 1024); } while (0)
#define PG8_LDB(dst, b, h) do { _Pragma("unroll") for (int n = 0; n < 2; ++n) _Pragma("unroll") for (int k = 0; k < 2; ++k) dst[n][k] = *(const PG8_LAS bf16x8*)(lds + PG8_SB(b, h) + boff + n * 2048 + k * 1024); } while (0)
#define PG8_MMA(ai, bj, At, Bt) do { __builtin_amdgcn_s_setprio(1); _Pragma("unroll") for (int m = 0; m < 4; ++m) _Pragma("unroll") for (int n = 0; n < 2; ++n) _Pragma("unroll") for (int k = 0; k < 2; ++k) \
        acc[ai][bj][m][n] = __builtin_amdgcn_mfma_f32_16x16x32_bf16(Bt[n][k], At[m][k], acc[ai][bj][m][n], 0, 0, 0); __builtin_amdgcn_s_setprio(0); } while (0)
#define PG8_WAIT_V(n) asm volatile("s_waitcnt vmcnt(" #n ")" ::: "memory")
#define PG8_WAIT_L(n) asm volatile("s_waitcnt lgkmcnt(" #n ")" ::: "memory")
#define PG8_BAR __builtin_amdgcn_s_barrier()
#define PG8_SCHED __builtin_amdgcn_sched_barrier(0)
    Unit cur, nxt; int ui = 0;
    if (!S.next(0, cur)) return;
    f32x4 acc[2][2][4][2];
#pragma unroll
    for (int a = 0; a < 2; ++a)
#pragma unroll
        for (int b = 0; b < 2; ++b)
#pragma unroll
            for (int m = 0; m < 4; ++m)
#pragma unroll
                for (int n = 0; n < 2; ++n) acc[a][b][m][n] = (f32x4){0.f, 0.f, 0.f, 0.f};
    bf16x8 At[4][2], B0[2][2], B1[2][2];
    const char* cA = (const char*)g.A + (size_t)cur.pm * tstep; const char* cB = (const char*)g.Bt + (size_t)cur.pn * tstep;
    S.a_ready(cur);
    if constexpr (SP2) {
        PG8_STAGE(PG8_SB(0, 0), cB, voffB); PG8_STAGE(PG8_SB(0, 1), cB + hstep, voffB); PG8_STAGE(PG8_SA(0, 0), cA, voffA); PG8_STAGE(PG8_SA(0, 1), cA + hstep, voffA);
        if (wr == 1) PG8_BAR;
        PG8_WAIT_V(2); PG8_BAR;
        PG8_STAGE(PG8_SB(1, 0), cB + kstep, voffB); PG8_STAGE(PG8_SA(1, 0), cA + kstep, voffA); PG8_STAGE(PG8_SB(1, 1), cB + hstep + kstep, voffB);
        PG8_WAIT_V(6); PG8_BAR;
    } else {
        PG8_STAGE(PG8_SB(0, 0), cB, voffB); PG8_STAGE(PG8_SA(0, 0), cA, voffA); PG8_STAGE(PG8_SB(0, 1), cB + hstep, voffB); PG8_STAGE(PG8_SA(0, 1), cA + hstep, voffA);
        if (wr == 1) PG8_BAR;
        PG8_WAIT_V(4); PG8_BAR;
        PG8_STAGE(PG8_SB(1, 0), cB + kstep, voffB); PG8_STAGE(PG8_SA(1, 0), cA + kstep, voffA); PG8_STAGE(PG8_SB(1, 1), cB + hstep + kstep, voffB);
        PG8_WAIT_V(6); PG8_BAR;
    }
    for (;;) {
        const bool has_next = S.next(ui + 1, nxt);
        const char* nA = has_next ? (const char*)g.A + (size_t)nxt.pm * tstep : cA; const char* nB = has_next ? (const char*)g.Bt + (size_t)nxt.pn * tstep : cB;
        for (int t = 0; t < nt; t += 2) {
            const bool last = (t == nt - 2);
            const char* a1 = cA + (size_t)(t + 1) * kstep;
            const char* a2 = last ? nA : cA + (size_t)(t + 2) * kstep; const char* b2 = last ? nB : cB + (size_t)(t + 2) * kstep;
            const char* a3 = a2 + kstep; const char* b3 = b2 + kstep;
            if (last && has_next) S.a_ready(nxt);
            if constexpr (SP2) {
            PG8_LDB(B0, 0, 0); PG8_LDB(B1, 0, 1); PG8_SCHED; PG8_LDA(At, 0, 0); PG8_STAGE(PG8_SA(1, 1), a1 + hstep, voffA);
            PG8_WAIT_V(8); PG8_WAIT_L(0); PG8_BAR; PG8_MMA(0, 0, At, B0); PG8_MMA(0, 1, At, B1); PG8_BAR; PG8_SCHED;
            PG8_LDA(At, 0, 1); PG8_STAGE(PG8_SB(0, 0), b2, voffB); PG8_STAGE(PG8_SB(0, 1), b2 + hstep, voffB); PG8_STAGE(PG8_SA(0, 0), a2, voffA);
            PG8_WAIT_V(8); PG8_WAIT_L(0); PG8_BAR; PG8_MMA(1, 0, At, B0); PG8_MMA(1, 1, At, B1); PG8_BAR; PG8_SCHED;
            PG8_LDB(B0, 1, 0); PG8_LDB(B1, 1, 1); PG8_SCHED; PG8_LDA(At, 1, 0); PG8_STAGE(PG8_SA(0, 1), a2 + hstep, voffA);
            PG8_WAIT_V(8); PG8_WAIT_L(0); PG8_BAR; PG8_MMA(0, 0, At, B0); PG8_MMA(0, 1, At, B1); PG8_BAR; PG8_SCHED;
            PG8_LDA(At, 1, 1); PG8_STAGE(PG8_SB(1, 0), b3, voffB); PG8_STAGE(PG8_SB(1, 1), b3 + hstep, voffB); PG8_STAGE(PG8_SA(1, 0), a3, voffA);
            PG8_WAIT_V(8); PG8_WAIT_L(0); PG8_BAR; PG8_MMA(1, 0, At, B0); PG8_MMA(1, 1, At, B1); PG8_BAR; PG8_SCHED;
            } else {
            PG8_LDB(B0, 0, 0); PG8_SCHED; PG8_LDA(At, 0, 0); PG8_STAGE(PG8_SA(1, 1), a1 + hstep, voffA);
            PG8_WAIT_L(8); PG8_BAR; PG8_WAIT_L(0); PG8_MMA(0, 0, At, B0); PG8_BAR; PG8_SCHED;
            PG8_LDB(B1, 0, 1); PG8_STAGE(PG8_SB(0, 0), b2, voffB);
            PG8_BAR; PG8_WAIT_L(0); PG8_MMA(0, 1, At, B1); PG8_BAR;
            PG8_LDA(At, 0, 1); PG8_STAGE(PG8_SA(0, 0), a2, voffA);
            PG8_BAR; PG8_WAIT_L(0); PG8_MMA(1, 0, At, B0); PG8_BAR; PG8_SCHED;
            PG8_STAGE(PG8_SB(0, 1), b2 + hstep, voffB);
            PG8_WAIT_V(6); PG8_BAR; PG8_MMA(1, 1, At, B1); PG8_BAR;
            PG8_LDB(B0, 1, 0); PG8_SCHED; PG8_LDA(At, 1, 0); PG8_STAGE(PG8_SA(0, 1), a2 + hstep, voffA);
            PG8_WAIT_L(8); PG8_BAR; PG8_WAIT_L(0); PG8_MMA(0, 0, At, B0); PG8_BAR; PG8_SCHED;
            PG8_LDB(B1, 1, 1); PG8_STAGE(PG8_SB(1, 0), b3, voffB);
            PG8_BAR; PG8_WAIT_L(0); PG8_MMA(0, 1, At, B1); PG8_BAR;
            PG8_LDA(At, 1, 1); PG8_STAGE(PG8_SA(1, 0), a3, voffA);
            PG8_BAR; PG8_WAIT_L(0); PG8_MMA(1, 0, At, B0); PG8_BAR; PG8_SCHED;
            PG8_STAGE(PG8_SB(1, 1), b3 + hstep, voffB);
            PG8_WAIT_V(6); PG8_BAR; PG8_MMA(1, 1, At, B1); PG8_BAR;
            }
        }
        if constexpr (ALIGN_EPI) { if (wr == 0) PG8_BAR; }
        if constexpr (!Epi::AFTER_DRAIN) { E(acc, cur, wr, wc, fr, fq); S.done(cur); }
        if (!has_next) break;
#pragma unroll
        for (int a = 0; a < 2; ++a)
#pragma unroll
            for (int b = 0; b < 2; ++b)
#pragma unroll
                for (int m = 0; m < 4; ++m)
#pragma unroll
                    for (int n = 0; n < 2; ++n) acc[a][b][m][n] = (f32x4){0.f, 0.f, 0.f, 0.f};
        cur = nxt; cA = nA; cB = nB; ++ui;
        if constexpr (ALIGN_EPI) { if (wr == 1) PG8_BAR; }
    }
    PG8_WAIT_V(0);
    if constexpr (!ALIGN_EPI) { if (wr == 0) PG8_BAR; }
    PG8_BAR;
    if constexpr (Epi::AFTER_DRAIN) { E.fused(acc, cur, wr, wc, fr, fq, lds, wid, lane); S.done(cur); }
#undef PG8_SA
#undef PG8_SB
#undef PG8_STAGE
#undef PG8_LDA
#undef PG8_LDB
#undef PG8_MMA
#undef PG8_WAIT_V
#undef PG8_WAIT_L
#undef PG8_BAR
#undef PG8_SCHED
}
}


template <class ColFn, class GainFn>
__device__ __forceinline__ void transpose_item(const float* src, int ldsrc, int Kreal, ColFn colfn, GainFn gain, bf16* dst, int K, int k0, int n0, float* scr, int lane) {
    const int n = n0 + (lane & 31); const int c = colfn(n);
#pragma unroll 8
    for (int i = 0; i < 32; ++i) { const int kk = 2 * i + (lane >> 5), k = k0 + kk;
        float v = 0.f; if (c >= 0 && k < Kreal) v = src[(size_t)k * ldsrc + c] * gain(k);
        scr[kk * 33 + (lane & 31)] = v; }
    asm volatile("s_waitcnt lgkmcnt(0)" ::: "memory");
    const int c8 = lane & 7;
#pragma unroll
    for (int j = 0; j < 4; ++j) { const int nn = (lane >> 3) + 8 * j; const float* s = scr + (8 * c8) * 33 + nn;
        v4u o; o.x = pk2(s[0 * 33], s[1 * 33]); o.y = pk2(s[2 * 33], s[3 * 33]); o.z = pk2(s[4 * 33], s[5 * 33]); o.w = pk2(s[6 * 33], s[7 * 33]);
        *(v4u*)(dst + (size_t)(n0 + nn) * K + k0 + 8 * c8) = o; }
    asm volatile("s_waitcnt lgkmcnt(0)" ::: "memory");
}
__device__ __forceinline__ int win_col(int n) {
    if (n < 1536) return n;
    if (n < 1792) return n - 1536 + 1544;
    if (n < 1920) return n - 1792 + 1800;
    if (n < 1952) return n - 1920 + 1928;
    if (n < 1960) return n - 1952 + 1536;
    return -1;
}
__device__ void ph_prep(float* lds, const Params& P, float* mod, bf16* WIN_T, bf16* WOUT_T, bf16* WUQ_T, bf16* WUKV_T) {
    const int tid = threadIdx.x, lane = tid & 63, wave = tid >> 6;
    if (blockIdx.x < 6 * D / 64) {
        float* sc = lds;
        float* part = lds + 8 * D;
        const float* c = P.in[1]; const float* ada_w = P.in[3]; const float* ada_b = P.in[4];
        for (int i = tid; i < NB * D; i += NT) sc[i] = silu_f(c[i]);
        __syncthreads();
        const int j = blockIdx.x * 64 + lane;
        float acc[NB];
#pragma unroll
        for (int b = 0; b < NB; ++b) acc[b] = 0.f;
        for (int k = wave * 128; k < wave * 128 + 128; ++k) {
            const float w = ada_w[(size_t)k * 6 * D + j];
#pragma unroll
            for (int b = 0; b < NB; ++b) acc[b] += sc[b * D + k] * w;
        }
#pragma unroll
        for (int b = 0; b < NB; ++b) part[(wave * NB + b) * 64 + lane] = acc[b];
        __syncthreads();
        { const int b = tid >> 6;
          float s = ada_b[j];
#pragma unroll
          for (int w = 0; w < 8; ++w) s += part[(w * NB + b) * 64 + lane];
          mod[b * 6 * D + j] = s; }
        __syncthreads();
    }
    float* scr = lds + wave * (64 * 33);
    const int gw = (gridDim.x - 1 - blockIdx.x) * (NT / 64) + wave, ngw = gridDim.x * (NT / 64);
    constexpr int I_IN = (D / 64) * (NU / 32), I_OUT = (D / 64) * (D / 32), I_UQ = (QR / 64) * (768 / 32), I_UKV = (256 / 64) * (1024 / 32);
    const float* ssd_norm = P.in[15]; const float* q_norm = P.in[16]; const float* kv_norm = P.in[18]; const float* mla_norm = P.in[20];
    for (int it = gw; it < I_IN + I_OUT + I_UQ + I_UKV; it += ngw) {
        int r = it;
        if (r < I_IN) { const int nb = NU / 32; transpose_item(P.in[9], NIN, D, [](int n) { return win_col(n); }, [](int) { return 1.f; }, WIN_T, D, (r / nb) * 64, (r % nb) * 32, scr, lane); continue; }
        r -= I_IN;
        if (r < I_OUT) { const int nb = D / 32; transpose_item(P.in[21], D, D, [](int n) { return n; }, [=](int k) { return k < 512 ? ssd_norm[k] : mla_norm[k - 512]; }, WOUT_T, D, (r / nb) * 64, (r % nb) * 32, scr, lane); continue; }
        r -= I_OUT;
        if (r < I_UQ) { const int nb = 768 / 32; transpose_item(P.in[17], 768, QR, [](int n) { return n; }, [=](int k) { return q_norm[k]; }, WUQ_T, QR, (r / nb) * 64, (r % nb) * 32, scr, lane); continue; }
        r -= I_UQ;
        { const int nb = 1024 / 32; transpose_item(P.in[19], 1024, KVR, [](int n) { return n; }, [=](int k) { return k < KVR ? kv_norm[k] : 0.f; }, WUKV_T, 256, (r / nb) * 64, (r % nb) * 32, scr, lane); }
    }
}

__device__ void ph_prenorm_bf16(const float* in, const float* g, const float* mod, int sh_off, int sc_off, bf16* out) {
    const int lane = threadIdx.x & 63, gw = blockIdx.x * (NT / 64) + (threadIdx.x >> 6), ngw = gridDim.x * (NT / 64);
    for (int t = gw; t < M; t += ngw) {
        const int b = t / SEQ; const f32x4v* r = (const f32x4v*)(in + (size_t)t * D) + lane;
        f32x4v v[4]; float s = 0.f;
#pragma unroll
        for (int j = 0; j < 4; ++j) { v[j] = r[64 * j]; s += (v[j].x * v[j].x + v[j].y * v[j].y) + (v[j].z * v[j].z + v[j].w * v[j].w); }
        const float inv = rsqrtf(wave_sum(s) / D + EPS);
        const f32x4v* gp = (const f32x4v*)g + lane; const f32x4v* scp = (const f32x4v*)(mod + b * 6 * D + sc_off) + lane; const f32x4v* shp = (const f32x4v*)(mod + b * 6 * D + sh_off) + lane;
        unsigned long long* o8 = (unsigned long long*)(out + (size_t)t * D) + lane;
#pragma unroll
        for (int j = 0; j < 4; ++j) { const f32x4v gg = gp[64 * j], sc = scp[64 * j], sh = shp[64 * j];
            const f32x4v h = v[j] * inv * gg * (sc + 1.f) + sh;
            o8[64 * j] = (unsigned long long)pk2(h.x, h.y) | ((unsigned long long)pk2(h.z, h.w) << 32); }
    }
}

__device__ __forceinline__ float ldf(const float* p) { return *p; }
__device__ __forceinline__ float ldf(const bf16* p) { return bf2f(*p); }
__device__ void ph_prenorm(const float* in, const float* g, const float* mod, int sh_off, int sc_off, float* out) {
    const int lane = threadIdx.x & 63, gw = blockIdx.x * (NT / 64) + (threadIdx.x >> 6), ngw = gridDim.x * (NT / 64);
    for (int t = gw; t < M; t += ngw) {
        const int b = t / SEQ; const float* r = in + (size_t)t * D;
        float s = 0.f;
        for (int i = lane; i < D; i += 64) s += r[i] * r[i];
        const float inv = rsqrtf(wave_sum(s) / D + EPS);
        for (int i = lane; i < D; i += 64)
            out[(size_t)t * D + i] = r[i] * inv * g[i] * (1.f + mod[b * 6 * D + sc_off + i]) + mod[b * 6 * D + sh_off + i];
    }
}
__device__ void ph_post(const float* base, const float* y, const float* g, const float* mod, int gate_off, float* out) {
    const int lane = threadIdx.x & 63, gw = blockIdx.x * (NT / 64) + (threadIdx.x >> 6), ngw = gridDim.x * (NT / 64);
    for (int t = gw; t < M; t += ngw) {
        const int b = t / SEQ; const float* r = y + (size_t)t * D;
        float s = 0.f;
        for (int i = lane; i < D; i += 64) s += r[i] * r[i];
        const float inv = rsqrtf(wave_sum(s) / D + EPS);
        for (int i = lane; i < D; i += 64)
            out[(size_t)t * D + i] = base[(size_t)t * D + i] + mod[b * 6 * D + gate_off + i] * (r[i] * inv * g[i]);
    }
}
template <class TI> __device__ void ph_rms_slice(const TI* in, int ldi, int off, int n, const float* g, float* out, int ldo, int ooff) {
    const int lane = threadIdx.x & 63, gw = blockIdx.x * (NT / 64) + (threadIdx.x >> 6), ngw = gridDim.x * (NT / 64);
    for (int t = gw; t < M; t += ngw) {
        const TI* r = in + (size_t)t * ldi + off;
        float s = 0.f;
        for (int i = lane; i < n; i += 64) { const float v = ldf(r + i); s += v * v; }
        const float inv = rsqrtf(wave_sum(s) / n + EPS);
        for (int i = lane; i < n; i += 64) out[(size_t)t * ldo + ooff + i] = ldf(r + i) * inv * g[i];
    }
}
__device__ void ph_gate_norm(const float* y, const bf16* u, const float* g, float* out, int ldo) {
    const int lane = threadIdx.x & 63, gw = blockIdx.x * (NT / 64) + (threadIdx.x >> 6), ngw = gridDim.x * (NT / 64);
    for (int t = gw; t < M; t += ngw) {
        float s = 0.f;
        for (int i = lane; i < SSD_INNER; i += 64) { const float v = y[(size_t)t * SSD_INNER + i] * silu_f(bf2f(u[(size_t)t * NU + OFF_Z + i])); s += v * v; }
        const float inv = rsqrtf(wave_sum(s) / SSD_INNER + EPS);
        for (int i = lane; i < SSD_INNER; i += 64) { const float v = y[(size_t)t * SSD_INNER + i] * silu_f(bf2f(u[(size_t)t * NU + OFF_Z + i])); out[(size_t)t * ldo + i] = v * inv * g[i]; }
    }
}
__device__ void ph_gemm(float* lds, const float* A, int lda, const float* B, int ldb, float* C, int ldc, int Mr, int N, int K) {
    float (*As)[129] = (float (*)[129])lds;
    float (*Bs)[65] = (float (*)[65])(lds + 16 * 129);
    const int tx = threadIdx.x & 15, ty = threadIdx.x >> 4;
    const int ntn = (N + 63) / 64, ntm = Mr / 128;
    for (int tile = blockIdx.x; tile < ntn * ntm; tile += gridDim.x) {
        const int m0 = (tile / ntn) * 128, n0 = (tile % ntn) * 64;
        float acc[4][4] = {};
        for (int k0 = 0; k0 < K; k0 += 16) {
            for (int i = threadIdx.x; i < 128 * 16; i += NT) { const int r = i >> 4, kk = i & 15; As[kk][r] = A[(size_t)(m0 + r) * lda + k0 + kk]; }
            for (int i = threadIdx.x; i < 64 * 16; i += NT) { const int kk = i >> 6, cc = i & 63; Bs[kk][cc] = (n0 + cc < N) ? B[(size_t)(k0 + kk) * ldb + n0 + cc] : 0.f; }
            __syncthreads();
#pragma unroll
            for (int kk = 0; kk < 16; ++kk) {
                float a[4], b[4];
#pragma unroll
                for (int i = 0; i < 4; ++i) { a[i] = As[kk][ty * 4 + i]; b[i] = Bs[kk][tx * 4 + i]; }
#pragma unroll
                for (int i = 0; i < 4; ++i)
#pragma unroll
                    for (int j = 0; j < 4; ++j) acc[i][j] += a[i] * b[j];
            }
            __syncthreads();
        }
#pragma unroll
        for (int i = 0; i < 4; ++i)
#pragma unroll
            for (int j = 0; j < 4; ++j) { const int n = n0 + tx * 4 + j; if (n < N) C[(size_t)(m0 + ty * 4 + i) * ldc + n] = acc[i][j]; }
    }
}
__device__ void ph_conv(const bf16* u, const float* cw, const float* cb, float* xc) {
    for (size_t idx = (size_t)blockIdx.x * NT + threadIdx.x; idx < (size_t)M * SSD_XBC; idx += (size_t)gridDim.x * NT) {
        const int ch = (int)(idx % SSD_XBC), t = (int)(idx / SSD_XBC), s = t % SEQ;
        float acc = cb[ch];
        for (int k = 0; k < 4; ++k) { const int ss = s - 3 + k; if (ss >= 0) acc += cw[k * SSD_XBC + ch] * bf2f(u[(size_t)(t - 3 + k) * NU + OFF_XBC + ch]); }
        xc[idx] = silu_f(acc);
    }
}
__device__ void ph_ssd_seq(const bf16* u, const float* xc, const float* dt_bias, const float* a_log, const float* d_skip, float* y) {
    for (int item = blockIdx.x; item < NB * SSD_H; item += gridDim.x) {
        const int b = item / SSD_H, h = item % SSD_H, g = h / (SSD_H / SSD_G);
        const int p = threadIdx.x >> 3, nq = threadIdx.x & 7;
        const float a = -expf(a_log[h]), dsk = d_skip[h], dtb = dt_bias[h];
        float st[16];
#pragma unroll
        for (int i = 0; i < 16; ++i) st[i] = 0.f;
        for (int s = 0; s < SEQ; ++s) {
            const size_t t = (size_t)b * SEQ + s;
            const float raw = bf2f(u[t * NU + OFF_DT + h]) + dtb;
            const float dt = raw > 20.f ? raw : log1pf(expf(raw));
            const float da = expf(dt * a);
            const float xv = xc[t * SSD_XBC + h * SSD_P + p];
            const float xd = xv * dt;
            const float* Bp = xc + t * SSD_XBC + SSD_INNER + g * SSD_N + nq * 16;
            const float* Cp = xc + t * SSD_XBC + SSD_INNER + SSD_G * SSD_N + g * SSD_N + nq * 16;
            float acc = 0.f;
#pragma unroll
            for (int i = 0; i < 16; ++i) { st[i] = st[i] * da + xd * Bp[i]; acc += Cp[i] * st[i]; }
            acc += __shfl_xor(acc, 1); acc += __shfl_xor(acc, 2); acc += __shfl_xor(acc, 4);
            if (nq == 0) y[t * SSD_INNER + h * SSD_P + p] = acc + dsk * xv;
        }
    }
}
__device__ void ph_rope(float* q, const bf16* u, const int* pos, float* kpe) {
    for (int idx = blockIdx.x * NT + threadIdx.x; idx < M * 9 * 16; idx += gridDim.x * NT) {
        const int i = idx % 16, hh = (idx / 16) % 9, t = idx / (16 * 9);
        const float inv = 1.0f / powf(10000.0f, (float)(2 * i) / 32.0f);
        const float ang = (float)pos[t] * inv;
        float sn, cs; sincosf(ang, &sn, &cs);
        if (hh < 8) {
            float* p = q + (size_t)t * (MLA_H * QK) + hh * QK + NOPE;
            const float x1 = p[i], x2 = p[16 + i];
            p[i] = x1 * cs - x2 * sn; p[16 + i] = x2 * cs + x1 * sn;
        } else {
            const bf16* p = u + (size_t)t * NU + OFF_KR;
            const float x1 = bf2f(p[i]), x2 = bf2f(p[16 + i]);
            kpe[(size_t)t * ROPE + i] = x1 * cs - x2 * sn; kpe[(size_t)t * ROPE + 16 + i] = x2 * cs + x1 * sn;
        }
    }
}
__device__ void ph_attn(const float* q, const float* kv, const float* kpe, float* o) {
    const int lane = threadIdx.x & 63, gw = blockIdx.x * (NT / 64) + (threadIdx.x >> 6), ngw = gridDim.x * (NT / 64);
    for (int item = gw; item < NB * MLA_H * (SEQ / 64); item += ngw) {
        const int qb = (SEQ / 64 - 1) - item / (NB * MLA_H), bh = item % (NB * MLA_H), b = bh / MLA_H, h = bh % MLA_H;
        const int qi = qb * 64 + lane;
        const size_t t = (size_t)b * SEQ + qi;
        float qr[QK];
#pragma unroll
        for (int d = 0; d < QK; ++d) qr[d] = q[t * (MLA_H * QK) + h * QK + d] * 0.10206207261596575f;
        float acc[VD];
#pragma unroll
        for (int d = 0; d < VD; ++d) acc[d] = 0.f;
        float mx = -INFINITY, l = 0.f;
        const int kmax = qb * 64 + 63;
        for (int k = 0; k <= kmax; ++k) {
            const size_t tk = (size_t)b * SEQ + k;
            const float* kn = kv + tk * (MLA_H * 128) + h * 128;
            const float* kp = kpe + tk * ROPE;
            float s = 0.f;
#pragma unroll
            for (int d = 0; d < NOPE; ++d) s += qr[d] * kn[d];
#pragma unroll
            for (int d = 0; d < ROPE; ++d) s += qr[NOPE + d] * kp[d];
            if (k <= qi) {
                const float mn = fmaxf(mx, s);
                const float f = expf(mx - mn), pv = expf(s - mn);
                l = l * f + pv;
#pragma unroll
                for (int d = 0; d < VD; ++d) acc[d] = acc[d] * f + pv * kn[64 + d];
                mx = mn;
            }
        }
        const float il = 1.f / l;
#pragma unroll
        for (int d = 0; d < VD; ++d) o[t * (MLA_H * VD) + h * VD + d] = acc[d] * il;
    }
}
__device__ void ph_moe(float* lds, const float* h2, const float* wgr, const float* bgr, const float* wer, const float* ber,
                       const float* wg, const float* wu, const float* wd, float* y2) {
    const int sb = threadIdx.x >> 8, tid = threadIdx.x & 255;
    float* xs = lds + sb * 2048;
    float* logit = xs + 1024;
    float* hid = xs + 1088;
    int* sel_e = (int*)(xs + 1600);
    float* sel_w = xs + 1604;
    for (int it = blockIdx.x; it < M / 2; it += gridDim.x) {
        const int t = it * 2 + sb;
        __syncthreads();
        for (int i = tid; i < D; i += 256) xs[i] = h2[(size_t)t * D + i];
        __syncthreads();
        {
            const int w = tid >> 6, lane = tid & 63;
            for (int cidx = w * 9; cidx < w * 9 + 9; ++cidx) {
                float s = 0.f;
                for (int k = lane; k < D; k += 64) s += xs[k] * (cidx < 4 ? wgr[k * 4 + cidx] : wer[k * 32 + (cidx - 4)]);
                s = wave_sum(s);
                if (lane == 0) logit[cidx] = s;
            }
        }
        __syncthreads();
        if (tid == 0) {
            float mxv = -INFINITY; int gi = 0;
            for (int i = 0; i < 4; ++i) { const float v = logit[i] + bgr[i]; logit[i] = v; if (v > mxv) { mxv = v; gi = i; } }
            float den = 0.f; for (int i = 0; i < 4; ++i) den += expf(logit[i] - mxv);
            const float gw = 1.f / den;
            float emx = -INFINITY; int i1 = 0;
            for (int i = 0; i < 8; ++i) { const float v = logit[4 + gi * 8 + i] + ber[gi * 8 + i]; logit[4 + gi * 8 + i] = v; if (v > emx) { emx = v; i1 = i; } }
            float e2 = -INFINITY; int i2 = 0;
            for (int i = 0; i < 8; ++i) { const float v = logit[4 + gi * 8 + i]; if (i != i1 && v > e2) { e2 = v; i2 = i; } }
            const float p2 = expf(e2 - emx);
            sel_e[0] = gi * 8 + i1; sel_e[1] = gi * 8 + i2;
            sel_w[0] = gw / (1.f + p2); sel_w[1] = gw * p2 / (1.f + p2);
        }
        __syncthreads();
        for (int k2 = 0; k2 < 2; ++k2) {
            const int e = sel_e[k2];
            const float* G = wg + (size_t)e * D * FF; const float* U = wu + (size_t)e * D * FF;
            float ga = 0.f, ua = 0.f;
            for (int k = 0; k < D; ++k) { ga += xs[k] * G[(size_t)k * FF + tid]; ua += xs[k] * U[(size_t)k * FF + tid]; }
            hid[k2 * FF + tid] = silu_f(ga) * ua * sel_w[k2];
        }
        __syncthreads();
        for (int d = tid; d < D; d += 256) {
            float acc = 0.f;
            for (int k2 = 0; k2 < 2; ++k2) {
                const float* Wd = wd + (size_t)sel_e[k2] * FF * D;
                for (int f = 0; f < FF; ++f) acc += hid[k2 * FF + f] * Wd[(size_t)f * D + d];
            }
            y2[(size_t)t * D + d] = acc;
        }
    }
}


__global__ void __launch_bounds__(NT, 2) mega_fwd(Params P) {
    extern __shared__ __attribute__((aligned(16))) unsigned char lds_raw[];
    float* lds = (float*)lds_raw;
    cg::grid_group grid = cg::this_grid();
    const float* x = P.in[0];
    const float* pre_mix = P.in[5]; const float* post_mix = P.in[6]; const float* pre_ffn = P.in[7]; const float* post_ffn = P.in[8];
    const float* conv_w = P.in[10]; const float* conv_b = P.in[11];
    const float* dt_bias = P.in[12]; const float* a_log = P.in[13]; const float* d_skip = P.in[14];
    const float* w_uq = P.in[17]; const float* w_ukv = P.in[19];
    const float* w_out = P.in[21];
    const float* wgr = P.in[22]; const float* bgr = P.in[23]; const float* wer = P.in[24]; const float* ber = P.in[25];
    const float* w_gate = P.in[26]; const float* w_up = P.in[27]; const float* w_down = P.in[28];
    float* out = P.out; char* ws = P.ws;
    const size_t MB = 1u << 20;
    float* mod = (float*)(ws + 1 * MB);
    bf16* WIN_T = (bf16*)(ws + 2 * MB);
    bf16* WOUT_T = (bf16*)(ws + 6 * MB);
    bf16* WUQ_T = (bf16*)(ws + 8 * MB);
    bf16* WUKV_T = (bf16*)(ws + 9 * MB);
    bf16* HB = (bf16*)(ws + 58 * MB);
    bf16* U = (bf16*)(ws + 90 * MB);
    float* RA = (float*)(ws + 154 * MB);
    float* RB = (float*)(ws + 218 * MB);
    float* RC = (float*)(ws + 10 * MB);

    ph_prep(lds, P, mod, WIN_T, WOUT_T, WUQ_T, WUKV_T);
    grid.sync();
    ph_prenorm_bf16(x, pre_mix, mod, 0 * D, 1 * D, HB);
    grid.sync();
    { pg8::Gemm g{HB, WIN_T, M, NU, D}; pg8::StaticOrder S; S.init(M, NU, gridDim.x, (int)blockIdx.x);
      pg8::EpiBf16<0> E{U, NU};
      pg8::gemm_phase<pg8::EpiBf16<0>, pg8::StaticOrder, true, true>((PG8_LAS unsigned char*)lds_raw, g, S, E); }
    grid.sync();
    float* xc = RA;
    ph_conv(U, conv_w, conv_b, xc);
    float* cqn = RC;
    float* ckvn = RC + (size_t)M * QR;
    ph_rms_slice(U, NU, OFF_CQ, QR, P.in[16], cqn, QR, 0);
    ph_rms_slice(U, NU, OFF_CKV, KVR, P.in[18], ckvn, KVR, 0);
    grid.sync();
    float* yssd = RB;
    ph_ssd_seq(U, xc, dt_bias, a_log, d_skip, yssd);
    grid.sync();
    float* ycat = out;
    ph_gate_norm(yssd, U, P.in[15], ycat, D);
    grid.sync();
    float* q = RA;
    ph_gemm(lds, cqn, QR, w_uq, 768, q, 768, M, 768, QR);
    float* kpe = RB;
    grid.sync();
    ph_rope(q, U, P.pos, kpe);
    grid.sync();
    float* kv = (float*)U;
    ph_gemm(lds, ckvn, KVR, w_ukv, 1024, kv, 1024, M, 1024, KVR);
    grid.sync();
    float* oatt = RB + (size_t)M * ROPE;
    ph_attn(q, kv, kpe, oatt);
    grid.sync();
    ph_rms_slice(oatt, 512, 0, 512, P.in[20], ycat, D, 512);
    grid.sync();
    float* y = RA;
    ph_gemm(lds, ycat, D, w_out, D, y, D, M, D, D);
    grid.sync();
    float* x1 = (float*)U;
    ph_post(x, y, post_mix, mod, 2 * D, x1);
    grid.sync();
    float* h2 = RA;
    ph_prenorm(x1, pre_ffn, mod, 3 * D, 4 * D, h2);
    grid.sync();
    float* y2 = (float*)(ws + 10 * MB);
    ph_moe(lds, h2, wgr, bgr, wer, ber, w_gate, w_up, w_down, y2);
    grid.sync();
    ph_post(x1, y2, post_ffn, mod, 5 * D, out);
}

extern "C" void kernel_launch(void* const* d_in, const int* in_sizes, int n_in, void* d_out, int out_size, void* d_ws, size_t ws_size,
                              hipStream_t stream) {
    static int grid_blocks = 0;
    if (!grid_blocks) {
        int dev = 0, cus = 0, per_cu = 0;
        (void)hipGetDevice(&dev);
        (void)hipDeviceGetAttribute(&cus, hipDeviceAttributeMultiprocessorCount, dev);
        (void)hipFuncSetAttribute((const void*)mega_fwd, hipFuncAttributeMaxDynamicSharedMemorySize, LDS_BYTES);
        (void)hipOccupancyMaxActiveBlocksPerMultiprocessor(&per_cu, (const void*)mega_fwd, NT, LDS_BYTES);
        if (per_cu < 1) { fprintf(stderr, "occupancy query returned %d\n", per_cu); per_cu = 1; }
        grid_blocks = cus * per_cu;
    }
    Params p{};
    for (int i = 0; i < 29; ++i) p.in[i] = (const float*)d_in[i];
    p.pos = (const int*)d_in[2];
    p.out = (float*)d_out;
    p.ws = (char*)d_ws;
    void* args[] = {&p};
    hipError_t e = hipLaunchCooperativeKernel((void*)mega_fwd, dim3(grid_blocks), dim3(NT), args, LDS_BYTES, stream);
    if (e != hipSuccess) fprintf(stderr, "cooperative launch failed: %s (grid %d)\n", hipGetErrorString(e), grid_blocks);
}
```

```cpp
#include <hip/hip_runtime.h>
#include <hip/hip_cooperative_groups.h>
#include <stdint.h>
#include <math.h>
#include <cstdio>
namespace cg = cooperative_groups;

constexpr int D = 1024, NB = 8, SEQ = 2048, M = NB * SEQ;
constexpr int SSD_H = 8, SSD_P = 64, SSD_INNER = 512, SSD_G = 2, SSD_N = 128, SSD_XBC = 1024;
constexpr int MLA_H = 8, NOPE = 64, ROPE = 32, QK = 96, VD = 64, QR = 256, KVR = 128;
constexpr int NIN = 1960;
constexpr int NU = 2048;
constexpr int OFF_Z = 0, OFF_XBC = 512, OFF_CQ = 1536, OFF_CKV = 1792, OFF_KR = 1920, OFF_DT = 1952;
constexpr int NEXP = 32, FF = 256;
constexpr float EPS = 1e-6f;
constexpr int NT = 512;
constexpr int LDS_BYTES = 144 * 1024;

typedef unsigned short bf16;
__device__ __forceinline__ float bf2f(bf16 v) { return __uint_as_float((unsigned)v << 16); }
__device__ __forceinline__ unsigned f2bf(float f) { unsigned u = __float_as_uint(f); return (u + 0x7fffu + ((u >> 16) & 1u)) >> 16; }
__device__ __forceinline__ unsigned pk2(float lo, float hi) { return f2bf(lo) | (f2bf(hi) << 16); }
typedef unsigned v4u __attribute__((ext_vector_type(4)));
typedef float f32x4v __attribute__((ext_vector_type(4)));

struct Params {
    const float* in[29];
    const int* pos;
    float* out;
    char* ws;
};

__device__ __forceinline__ float ldf(const float* p) { return *p; }
__device__ __forceinline__ float ldf(const bf16* p) { return bf2f(*p); }
__device__ __forceinline__ int tidx() { int t = threadIdx.x; asm volatile("" : "+v"(t)); return t; }
typedef const __attribute__((address_space(4))) Params* KArgs;
__device__ __forceinline__ KArgs kargs() { KArgs p = (KArgs)__builtin_amdgcn_kernarg_segment_ptr(); asm volatile("" : "+s"(p)); return p; }
#define IN(i) (kargs()->in[i])
__device__ __forceinline__ float silu_f(float v) { return v / (1.f + expf(-v)); }
__device__ __forceinline__ float wave_sum(float v) {
#pragma unroll
    for (int o = 32; o > 0; o >>= 1) v += __shfl_xor(v, o);
    return v;
}

namespace pg8 {
#define PG8_LAS __attribute__((address_space(3)))
typedef unsigned short bf16_t;
typedef short bf16x8 __attribute__((ext_vector_type(8)));
typedef float f32x4 __attribute__((ext_vector_type(4)));
typedef unsigned u32x4 __attribute__((ext_vector_type(4)));
constexpr int BM = 256, BK = 64, HALF = 128, HTB = HALF * BK * 2  , STAGE_BYTES = 8 * HTB, NXCD = 8, WGM = 8;

__host__ __device__ __forceinline__ int lds_byte(int r, int c) { const int st = (r >> 4) * 2 + (c >> 5), rr = r & 15, cc = c & 31, ob = rr * 64 + cc * 2; return st * 1024 + (ob ^ (((ob >> 9) & 1) << 5)); }
__host__ __device__ __forceinline__ void stage_rc(int b, int& R, int& C) { const int st = b / 1024, sb = b % 1024, swz = sb ^ (((sb >> 9) & 1) << 5); R = (st >> 1) * 16 + swz / 64; C = (st & 1) * 32 + (swz % 64) / 2; }
__host__ __device__ __forceinline__ int perm32(int rho) { const int n = rho >> 4, i = rho & 15; return 8 * (i >> 2) + 4 * n + (i & 3); }

struct Unit { int pm, pn; };
struct Gemm { const bf16_t* A; const bf16_t* Bt; int M, N, K; };

struct StaticOrder {
    int nM, nN, nwg, G, c;
    __host__ __device__ void init(int M, int N, int G_, int c_) { nM = M / BM; nN = N / BM; nwg = nM * nN; G = G_; c = c_; }
    __host__ __device__ bool next(int i, Unit& u) const {
        const long L = (long)i * G + c; if (L >= nwg) return false;
        int wgid = (int)L; { const int q = nwg / NXCD, r = nwg % NXCD, xcd = wgid % NXCD, off = wgid / NXCD; wgid = (xcd < r ? xcd * (q + 1) : r * (q + 1) + (xcd - r) * q) + off; }
        const int nig = WGM * nN, gid = wgid / nig, fm = gid * WGM, gsz = (nM - fm) < WGM ? (nM - fm) : WGM;
        u.pm = fm + ((wgid % nig) % gsz); u.pn = (wgid % nig) / gsz; return true;
    }
    __device__ __forceinline__ void a_ready(const Unit&) const {}
    __device__ __forceinline__ void done(const Unit&) const {}
};


template <int ACT> struct EpiBf16 {
    static constexpr bool PERM = true, AFTER_DRAIN = false;
    bf16_t* O; int ldc;
    __device__ __forceinline__ void operator()(const f32x4 (&acc)[2][2][4][2], const Unit& u, int wr, int wc, int fr, int fq) const {
        { const int l_ = tidx() & 63; fr = l_ & 15; fq = l_ >> 4; }
        const int row0 = u.pm * BM + wr * 64 + fr; const int col0 = u.pn * BM + wc * 32 + 8 * fq;
#pragma unroll
        for (int ai = 0; ai < 2; ++ai)
#pragma unroll
            for (int m = 0; m < 4; ++m) { bf16_t* rowp = O + (size_t)(row0 + ai * HALF + m * 16) * ldc + col0;
#pragma unroll
                for (int bj = 0; bj < 2; ++bj) { const f32x4 v0 = acc[ai][bj][m][0], v1 = acc[ai][bj][m][1];
                    u32x4 w; w.x = pk2(v0[0], v0[1]); w.y = pk2(v0[2], v0[3]); w.z = pk2(v1[0], v1[1]); w.w = pk2(v1[2], v1[3]);
                    *(u32x4*)(rowp + bj * HALF) = w; } }
    }
};

struct EpiQ {
    static constexpr bool PERM = true, AFTER_DRAIN = false;
    bf16_t* Q; const float* COS; const float* SIN;
    __device__ __forceinline__ void operator()(const f32x4 (&acc)[2][2][4][2], const Unit& u, int wr, int wc, int fr, int fq) const {
        { const int l_ = tidx() & 63; fr = l_ & 15; fq = l_ >> 4; }
        const int row0 = u.pm * BM + wr * 64 + fr;
#pragma unroll
        for (int bj = 0; bj < 2; ++bj) {
            const int colg = u.pn * BM + bj * HALF + wc * 32;
            const bool pe = ((colg >> 5) % 3) == 2;
#pragma unroll
            for (int ai = 0; ai < 2; ++ai)
#pragma unroll
                for (int m = 0; m < 4; ++m) {
                    const int row = row0 + ai * HALF + m * 16;
                    f32x4 v0 = acc[ai][bj][m][0], v1 = acc[ai][bj][m][1];
                    if (pe) {
                        f32x4 w0, w1;
#pragma unroll
                        for (int e = 0; e < 4; ++e) { w0[e] = __shfl_xor(v0[e], 32); w1[e] = __shfl_xor(v1[e], 32); }
                        const f32x4* cp = (const f32x4*)(COS + (size_t)row * 16 + (fq & 1) * 8); const f32x4* sp = (const f32x4*)(SIN + (size_t)row * 16 + (fq & 1) * 8);
                        const f32x4 c0 = cp[0], c1 = cp[1], s0 = sp[0], s1 = sp[1];
                        const float sg = (fq < 2) ? -1.f : 1.f;
                        v0 = v0 * c0 + w0 * s0 * sg; v1 = v1 * c1 + w1 * s1 * sg;
                    }
                    u32x4 w; w.x = pk2(v0[0], v0[1]); w.y = pk2(v0[2], v0[3]); w.z = pk2(v1[0], v1[1]); w.w = pk2(v1[2], v1[3]);
                    *(u32x4*)(Q + (size_t)row * 768 + colg + 8 * fq) = w;
                    if (pe) asm volatile("" ::: "memory");
                }
        }
    }
};
struct EpiKV {
    static constexpr bool PERM = true, AFTER_DRAIN = false;
    bf16_t* KF; bf16_t* VT;
    __device__ __forceinline__ void operator()(const f32x4 (&acc)[2][2][4][2], const Unit& u, int wr, int wc, int fr, int fq) const {
        { const int l_ = tidx() & 63; fr = l_ & 15; fq = l_ >> 4; }
        const int row0 = u.pm * BM + wr * 64 + fr;
#pragma unroll
        for (int bj = 0; bj < 2; ++bj) {
            const int colg = u.pn * BM + bj * HALF + wc * 32; const int h = colg >> 7, j0 = (colg & 127) + 8 * fq;
#pragma unroll
            for (int ai = 0; ai < 2; ++ai)
#pragma unroll
                for (int m = 0; m < 4; ++m) {
                    const int t = row0 + ai * HALF + m * 16; const int b = t >> 11, sq = t & 2047, tile = sq >> 6, key = sq & 63;
                    const size_t base = (size_t)((b * 8 + h) * 32 + tile);
                    bf16_t* dst = (j0 < 64) ? KF + base * 6144 + (j0 >> 3) * 512 + key * 8 : VT + base * 4096 + ((j0 - 64) >> 5) * 2048 + key * 32 + ((j0 - 64) & 31);
                    const f32x4 v0 = acc[ai][bj][m][0], v1 = acc[ai][bj][m][1];
                    u32x4 w; w.x = pk2(v0[0], v0[1]); w.y = pk2(v0[2], v0[3]); w.z = pk2(v1[0], v1[1]); w.w = pk2(v1[2], v1[3]);
                    *(u32x4*)dst = w;
                }
        }
    }
};

struct GroupedOrder {
    const PG8_LAS int* tp; int NCT, G, c;
    __device__ __forceinline__ bool next(int i, Unit& u) const {
        const int L = i * G + c, total = tp[32] * NCT; if (L >= total) return false;
        const int rtg = L / NCT, ct = L - rtg * NCT; int e = 0;
        for (int j = 1; j < 32; ++j) e += (tp[j] <= rtg) ? 1 : 0;
        u.pm = rtg; u.pn = e * NCT + ct; return true;
    }
    __device__ __forceinline__ void a_ready(const Unit&) const {}
    __device__ __forceinline__ void done(const Unit&) const {}
};
struct EpiGU {
    static constexpr bool PERM = true, AFTER_DRAIN = false;
    bf16_t* HID; const float* ROWW;
    __device__ __forceinline__ void operator()(const f32x4 (&acc)[2][2][4][2], const Unit& u, int wr, int wc, int fr, int fq) const {
        { const int l_ = tidx() & 63; fr = l_ & 15; fq = l_ >> 4; }
        const int row0 = u.pm * BM + wr * 64 + fr; const int col0 = (u.pn & 1) * 128 + wc * 32 + 8 * fq;
#pragma unroll
        for (int ai = 0; ai < 2; ++ai)
#pragma unroll
            for (int m = 0; m < 4; ++m) { const int row = row0 + ai * HALF + m * 16; const float w = ROWW[row];
                float hv[8];
#pragma unroll
                for (int n = 0; n < 2; ++n)
#pragma unroll
                    for (int e = 0; e < 4; ++e) { const float g = acc[ai][0][m][n][e], up = acc[ai][1][m][n][e]; hv[4 * n + e] = g * __builtin_amdgcn_rcpf(1.f + __expf(-g)) * up * w; }
                u32x4 o; o.x = pk2(hv[0], hv[1]); o.y = pk2(hv[2], hv[3]); o.z = pk2(hv[4], hv[5]); o.w = pk2(hv[6], hv[7]);
                *(u32x4*)(HID + (size_t)row * 256 + col0) = o; }
    }
};
struct EpiDown {
    static constexpr bool PERM = true, AFTER_DRAIN = false;
    bf16_t* YP;
    __device__ __forceinline__ void operator()(const f32x4 (&acc)[2][2][4][2], const Unit& u, int wr, int wc, int fr, int fq) const {
        { const int l_ = tidx() & 63; fr = l_ & 15; fq = l_ >> 4; }
        const int row0 = u.pm * BM + wr * 64 + fr; const int col0 = (u.pn & 3) * BM + wc * 32 + 8 * fq;
#pragma unroll
        for (int ai = 0; ai < 2; ++ai)
#pragma unroll
            for (int m = 0; m < 4; ++m) { bf16_t* rowp = YP + (size_t)(row0 + ai * HALF + m * 16) * 1024 + col0;
#pragma unroll
                for (int bj = 0; bj < 2; ++bj) { const f32x4 v0 = acc[ai][bj][m][0], v1 = acc[ai][bj][m][1];
                    u32x4 w; w.x = pk2(v0[0], v0[1]); w.y = pk2(v0[2], v0[3]); w.z = pk2(v1[0], v1[1]); w.w = pk2(v1[2], v1[3]);
                    *(u32x4*)(rowp + bj * HALF) = w; } }
    }
};
template <class Epi, class Sched, bool ALIGN_EPI = false, bool SP2 = false>
__device__ __forceinline__ void gemm_phase(PG8_LAS unsigned char* lds, const Gemm g, const Sched& S, const Epi& E) {
    const int tid = tidx(), wid = __builtin_amdgcn_readfirstlane(tid >> 6), lane = tid & 63, wr = wid >> 2, wc = wid & 3, fr = lane & 15, fq = lane >> 4;
    const int K = g.K, nt = K / BK;
    unsigned voffA[2], voffB[2];
#pragma unroll
    for (int i = 0; i < 2; ++i) { int R, C; stage_rc(tid * 16 + i * 8192, R, C); const int Rb = Epi::PERM ? ((R & ~31) + perm32(R & 31)) : R;
        voffA[i] = (unsigned)(R * K + C) * 2u; voffB[i] = (unsigned)(Rb * K + C) * 2u; }
    const size_t kstep = (size_t)(BK * 2);
    const size_t hstep = (size_t)HALF * K * 2;
    const size_t tstep = 2 * hstep;
    const unsigned ldsw = (unsigned)wid * 1024u;
    const int aoff = lds_byte(wr * 64 + fr, fq * 8), boff = lds_byte(wc * 32 + fr, fq * 8);
#define PG8_SA(b, h) (((b) * 2 + (h)) * HTB)
#define PG8_SB(b, h) ((4 + (b) * 2 + (h)) * HTB)
#define PG8_STAGE(bufoff, gbase, voff) do { _Pragma("unroll") for (int _i = 0; _i < 2; ++_i) \
        __builtin_amdgcn_global_load_lds((const unsigned*)((const char*)(gbase) + (voff)[_i]), (PG8_LAS unsigned*)(lds + (bufoff) + ldsw + _i * 8192), 16, 0, 0); } while (0)
#define PG8_LDA(dst, b, h) do { _Pragma("unroll") for (int m = 0; m < 4; ++m) _Pragma("unroll") for (int k = 0; k < 2; ++k) dst[m][k] = *(const PG8_LAS bf16x8*)(lds + PG8_SA(b, h) + aoff + m * 2048 + k * 1024); } while (0)
#define PG8_LDB(dst, b, h) do { _Pragma("unroll") for (int n = 0; n < 2; ++n) _Pragma("unroll") for (int k = 0; k < 2; ++k) dst[n][k] = *(const PG8_LAS bf16x8*)(lds + PG8_SB(b, h) + boff + n * 2048 + k * 1024); } while (0)
#define PG8_MMA(ai, bj, At, Bt) do { __builtin_amdgcn_s_setprio(1); _Pragma("unroll") for (int m = 0; m < 4; ++m) _Pragma("unroll") for (int n = 0; n < 2; ++n) _Pragma("unroll") for (int k = 0; k < 2; ++k) \
        acc[ai][bj][m][n] = __builtin_amdgcn_mfma_f32_16x16x32_bf16(Bt[n][k], At[m][k], acc[ai][bj][m][n], 0, 0, 0); __builtin_amdgcn_s_setprio(0); } while (0)
#define PG8_WAIT_V(n) asm volatile("s_waitcnt vmcnt(" #n ")" ::: "memory")
#define PG8_WAIT_L(n) asm volatile("s_waitcnt lgkmcnt(" #n ")" ::: "memory")
#define PG8_BAR __builtin_amdgcn_s_barrier()
#define PG8_SCHED __builtin_amdgcn_sched_barrier(0)
    Unit cur, nxt; int ui = 0;
    if (!S.next(0, cur)) return;
    f32x4 acc[2][2][4][2];
#pragma unroll
    for (int a = 0; a < 2; ++a)
#pragma unroll
        for (int b = 0; b < 2; ++b)
#pragma unroll
            for (int m = 0; m < 4; ++m)
#pragma unroll
                for (int n = 0; n < 2; ++n) acc[a][b][m][n] = (f32x4){0.f, 0.f, 0.f, 0.f};
    bf16x8 At[4][2], B0[2][2], B1[2][2];
    const char* cA = (const char*)g.A + (size_t)cur.pm * tstep; const char* cB = (const char*)g.Bt + (size_t)cur.pn * tstep;
    S.a_ready(cur);
    if constexpr (SP2) {
        PG8_STAGE(PG8_SB(0, 0), cB, voffB); PG8_STAGE(PG8_SB(0, 1), cB + hstep, voffB); PG8_STAGE(PG8_SA(0, 0), cA, voffA); PG8_STAGE(PG8_SA(0, 1), cA + hstep, voffA);
        if (wr == 1) PG8_BAR;
        PG8_WAIT_V(2); PG8_BAR;
        PG8_STAGE(PG8_SB(1, 0), cB + kstep, voffB); PG8_STAGE(PG8_SA(1, 0), cA + kstep, voffA); PG8_STAGE(PG8_SB(1, 1), cB + hstep + kstep, voffB);
        PG8_WAIT_V(6); PG8_BAR;
    } else {
        PG8_STAGE(PG8_SB(0, 0), cB, voffB); PG8_STAGE(PG8_SA(0, 0), cA, voffA); PG8_STAGE(PG8_SB(0, 1), cB + hstep, voffB); PG8_STAGE(PG8_SA(0, 1), cA + hstep, voffA);
        if (wr == 1) PG8_BAR;
        PG8_WAIT_V(4); PG8_BAR;
        PG8_STAGE(PG8_SB(1, 0), cB + kstep, voffB); PG8_STAGE(PG8_SA(1, 0), cA + kstep, voffA); PG8_STAGE(PG8_SB(1, 1), cB + hstep + kstep, voffB);
        PG8_WAIT_V(6); PG8_BAR;
    }
    for (;;) {
        const bool has_next = S.next(ui + 1, nxt);
        const char* nA = has_next ? (const char*)g.A + (size_t)nxt.pm * tstep : cA; const char* nB = has_next ? (const char*)g.Bt + (size_t)nxt.pn * tstep : cB;
        for (int t = 0; t < nt; t += 2) {
            const bool last = (t == nt - 2);
            const char* a1 = cA + (size_t)(t + 1) * kstep;
            const char* a2 = last ? nA : cA + (size_t)(t + 2) * kstep; const char* b2 = last ? nB : cB + (size_t)(t + 2) * kstep;
            const char* a3 = a2 + kstep; const char* b3 = b2 + kstep;
            if (last && has_next) S.a_ready(nxt);
            if constexpr (SP2) {
            PG8_LDB(B0, 0, 0); PG8_LDB(B1, 0, 1); PG8_SCHED; PG8_LDA(At, 0, 0); PG8_STAGE(PG8_SA(1, 1), a1 + hstep, voffA);
            PG8_WAIT_V(8); PG8_WAIT_L(0); PG8_BAR; PG8_MMA(0, 0, At, B0); PG8_MMA(0, 1, At, B1); PG8_BAR; PG8_SCHED;
            PG8_LDA(At, 0, 1); PG8_STAGE(PG8_SB(0, 0), b2, voffB); PG8_STAGE(PG8_SB(0, 1), b2 + hstep, voffB); PG8_STAGE(PG8_SA(0, 0), a2, voffA);
            PG8_WAIT_V(8); PG8_WAIT_L(0); PG8_BAR; PG8_MMA(1, 0, At, B0); PG8_MMA(1, 1, At, B1); PG8_BAR; PG8_SCHED;
            PG8_LDB(B0, 1, 0); PG8_LDB(B1, 1, 1); PG8_SCHED; PG8_LDA(At, 1, 0); PG8_STAGE(PG8_SA(0, 1), a2 + hstep, voffA);
            PG8_WAIT_V(8); PG8_WAIT_L(0); PG8_BAR; PG8_MMA(0, 0, At, B0); PG8_MMA(0, 1, At, B1); PG8_BAR; PG8_SCHED;
            PG8_LDA(At, 1, 1); PG8_STAGE(PG8_SB(1, 0), b3, voffB); PG8_STAGE(PG8_SB(1, 1), b3 + hstep, voffB); PG8_STAGE(PG8_SA(1, 0), a3, voffA);
            PG8_WAIT_V(8); PG8_WAIT_L(0); PG8_BAR; PG8_MMA(1, 0, At, B0); PG8_MMA(1, 1, At, B1); PG8_BAR; PG8_SCHED;
            } else {
            PG8_LDB(B0, 0, 0); PG8_SCHED; PG8_LDA(At, 0, 0); PG8_STAGE(PG8_SA(1, 1), a1 + hstep, voffA);
            PG8_WAIT_L(8); PG8_BAR; PG8_WAIT_L(0); PG8_MMA(0, 0, At, B0); PG8_BAR; PG8_SCHED;
            PG8_LDB(B1, 0, 1); PG8_STAGE(PG8_SB(0, 0), b2, voffB);
            PG8_BAR; PG8_WAIT_L(0); PG8_MMA(0, 1, At, B1); PG8_BAR;
            PG8_LDA(At, 0, 1); PG8_STAGE(PG8_SA(0, 0), a2, voffA);
            PG8_BAR; PG8_WAIT_L(0); PG8_MMA(1, 0, At, B0); PG8_BAR; PG8_SCHED;
            PG8_STAGE(PG8_SB(0, 1), b2 + hstep, voffB);
            PG8_WAIT_V(6); PG8_BAR; PG8_MMA(1, 1, At, B1); PG8_BAR;
            PG8_LDB(B0, 1, 0); PG8_SCHED; PG8_LDA(At, 1, 0); PG8_STAGE(PG8_SA(0, 1), a2 + hstep, voffA);
            PG8_WAIT_L(8); PG8_BAR; PG8_WAIT_L(0); PG8_MMA(0, 0, At, B0); PG8_BAR; PG8_SCHED;
            PG8_LDB(B1, 1, 1); PG8_STAGE(PG8_SB(1, 0), b3, voffB);
            PG8_BAR; PG8_WAIT_L(0); PG8_MMA(0, 1, At, B1); PG8_BAR;
            PG8_LDA(At, 1, 1); PG8_STAGE(PG8_SA(1, 0), a3, voffA);
            PG8_BAR; PG8_WAIT_L(0); PG8_MMA(1, 0, At, B0); PG8_BAR; PG8_SCHED;
            PG8_STAGE(PG8_SB(1, 1), b3 + hstep, voffB);
            PG8_WAIT_V(6); PG8_BAR; PG8_MMA(1, 1, At, B1); PG8_BAR;
            }
        }
        if constexpr (ALIGN_EPI) { if (wr == 0) PG8_BAR; }
        if constexpr (!Epi::AFTER_DRAIN) { E(acc, cur, wr, wc, fr, fq); S.done(cur); }
        if (!has_next) break;
#pragma unroll
        for (int a = 0; a < 2; ++a)
#pragma unroll
            for (int b = 0; b < 2; ++b)
#pragma unroll
                for (int m = 0; m < 4; ++m)
#pragma unroll
                    for (int n = 0; n < 2; ++n) acc[a][b][m][n] = (f32x4){0.f, 0.f, 0.f, 0.f};
        cur = nxt; cA = nA; cB = nB; ++ui;
        if constexpr (ALIGN_EPI) { if (wr == 1) PG8_BAR; }
    }
    PG8_WAIT_V(0);
    if constexpr (!ALIGN_EPI) { if (wr == 0) PG8_BAR; }
    PG8_BAR;
    if constexpr (Epi::AFTER_DRAIN) { E.fused(acc, cur, wr, wc, fr, fq, lds, wid, lane); S.done(cur); }
#undef PG8_SA
#undef PG8_SB
#undef PG8_STAGE
#undef PG8_LDA
#undef PG8_LDB
#undef PG8_MMA
#undef PG8_WAIT_V
#undef PG8_WAIT_L
#undef PG8_BAR
#undef PG8_SCHED
}
}


template <class ColFn, class GainFn>
__device__ __forceinline__ void transpose_item(const float* src, int ldsrc, int Kreal, ColFn colfn, GainFn gain, bf16* dst, int K, int k0, int n0, float* scr, int lane) {
    const int n = n0 + (lane & 31); const int c = colfn(n);
#pragma unroll 8
    for (int i = 0; i < 32; ++i) { const int kk = 2 * i + (lane >> 5), k = k0 + kk;
        float v = 0.f; if (c >= 0 && k < Kreal) v = src[(size_t)k * ldsrc + c] * gain(k);
        scr[kk * 33 + (lane & 31)] = v; }
    asm volatile("s_waitcnt lgkmcnt(0)" ::: "memory");
    const int c8 = lane & 7;
#pragma unroll
    for (int j = 0; j < 4; ++j) { const int nn = (lane >> 3) + 8 * j; const float* s = scr + (8 * c8) * 33 + nn;
        v4u o; o.x = pk2(s[0 * 33], s[1 * 33]); o.y = pk2(s[2 * 33], s[3 * 33]); o.z = pk2(s[4 * 33], s[5 * 33]); o.w = pk2(s[6 * 33], s[7 * 33]);
        *(v4u*)(dst + (size_t)(n0 + nn) * K + k0 + 8 * c8) = o; }
    asm volatile("s_waitcnt lgkmcnt(0)" ::: "memory");
}
__device__ __forceinline__ int win_col(int n) {
    if (n < 1536) return n;
    if (n < 1792) return n - 1536 + 1544;
    if (n < 1920) return n - 1792 + 1800;
    if (n < 1952) return n - 1920 + 1928;
    if (n < 1960) return n - 1952 + 1536;
    return -1;
}
__device__ void ph_prep(float* lds, float* mod, bf16* WIN_T, bf16* WOUT_T, bf16* WUQ_T, bf16* WUKV_T, bf16* WGU_T, bf16* WD_T, bf16* WRF, int* CNT) {
    const int tid = tidx(), lane = tid & 63, wave = tid >> 6;
    if (blockIdx.x < 6 * D / 64) {
        float* sc = lds;
        float* part = lds + 8 * D;
        const float* c = IN(1); const float* ada_w = IN(3); const float* ada_b = IN(4);
        for (int i = tid; i < NB * D; i += NT) sc[i] = silu_f(c[i]);
        __syncthreads();
        const int j = blockIdx.x * 64 + lane;
        float acc[NB];
#pragma unroll
        for (int b = 0; b < NB; ++b) acc[b] = 0.f;
        for (int k = wave * 128; k < wave * 128 + 128; ++k) {
            const float w = ada_w[(size_t)k * 6 * D + j];
#pragma unroll
            for (int b = 0; b < NB; ++b) acc[b] += sc[b * D + k] * w;
        }
#pragma unroll
        for (int b = 0; b < NB; ++b) part[(wave * NB + b) * 64 + lane] = acc[b];
        __syncthreads();
        { const int b = tid >> 6;
          float s = ada_b[j];
#pragma unroll
          for (int w = 0; w < 8; ++w) s += part[(w * NB + b) * 64 + lane];
          mod[b * 6 * D + j] = s; }
        __syncthreads();
    }
    float* scr = lds + wave * (64 * 33);
    const int gw = (gridDim.x - 1 - blockIdx.x) * (NT / 64) + wave, ngw = gridDim.x * (NT / 64);
    constexpr int I_IN = (D / 64) * (NU / 32), I_OUT = (D / 64) * (D / 32), I_UQ = (QR / 64) * (768 / 32), I_UKV = (256 / 64) * (1024 / 32);
    const float* ssd_norm = IN(15); const float* q_norm = IN(16); const float* kv_norm = IN(18); const float* mla_norm = IN(20);
    if (blockIdx.x == 0 && tid < 64) CNT[tid] = 0;
    for (int ch = blockIdx.x * NT + tid; ch < 32 * 3 * 64; ch += gridDim.x * NT) {
        const int ln = ch & 63, cb = (ch >> 6) % 3, sk = ch / 192; const int col = 16 * cb + (ln & 15);
        const float* wgr = IN(22); const float* wer = IN(24);
        unsigned hi4[4], lo4[4];
#pragma unroll
        for (int j = 0; j < 8; j += 2) { float v[2];
#pragma unroll
            for (int q = 0; q < 2; ++q) { const int k = 32 * sk + 8 * (ln >> 4) + j + q; v[q] = (col < 4) ? wgr[k * 4 + col] : (col < 36 ? wer[k * 32 + col - 4] : 0.f); }
            const unsigned h0 = f2bf(v[0]), h1 = f2bf(v[1]);
            hi4[j >> 1] = h0 | (h1 << 16); lo4[j >> 1] = pk2(v[0] - __uint_as_float(h0 << 16), v[1] - __uint_as_float(h1 << 16)); }
        v4u* dst = (v4u*)(WRF + ((size_t)(sk * 3 + cb) * 2) * 512 + ln * 8);
        dst[0] = (v4u){hi4[0], hi4[1], hi4[2], hi4[3]}; dst[64] = (v4u){lo4[0], lo4[1], lo4[2], lo4[3]};
    }
    constexpr int I_GU = NEXP * (D / 64) * (512 / 32), I_DN = NEXP * (FF / 64) * (D / 32);
    for (int it = gw; it < I_IN + I_OUT + I_UQ + I_UKV + I_GU + I_DN; it += ngw) {
        int r = it;
        if (r < I_IN) { const int nb = NU / 32; transpose_item(IN(9), NIN, D, [](int n) { return win_col(n); }, [](int) { return 1.f; }, WIN_T, D, (r / nb) * 64, (r % nb) * 32, scr, lane); continue; }
        r -= I_IN;
        if (r < I_OUT) { const int nb = D / 32; transpose_item(IN(21), D, D, [](int n) { return n; }, [=](int k) { return k < 512 ? ssd_norm[k] : mla_norm[k - 512]; }, WOUT_T, D, (r / nb) * 64, (r % nb) * 32, scr, lane); continue; }
        r -= I_OUT;
        if (r < I_UQ) { const int nb = 768 / 32; transpose_item(IN(17), 768, QR, [](int n) { return n; }, [=](int k) { return q_norm[k] * 0.14724444f; }, WUQ_T, QR, (r / nb) * 64, (r % nb) * 32, scr, lane); continue; }
        r -= I_UQ;
        if (r >= I_UQ + I_UKV - I_UQ) {
            r -= I_UKV;
            if (r < I_GU) { const int e = r / 256, q = r % 256, kb = q / 16, nb = q % 16;
                const int ct = nb >> 3, rr = (nb & 7) * 32; const float* src = (rr < 128 ? IN(26) : IN(27)) + (size_t)e * D * FF; const int cbase = 128 * ct + (rr & 127) - 32 * nb;
                transpose_item(src, FF, D, [=](int n) { return n + cbase; }, [](int) { return 1.f; }, WGU_T + (size_t)e * 512 * D, D, kb * 64, nb * 32, scr, lane); continue; }
            r -= I_GU;
            { const int e = r / 128, q = r % 128, kb = q / 32, nb = q % 32;
              transpose_item(IN(28) + (size_t)e * FF * D, D, FF, [](int n) { return n; }, [](int) { return 1.f; }, WD_T + (size_t)e * D * FF, FF, kb * 64, nb * 32, scr, lane); continue; }
        }
        { const int nb = 1024 / 32; transpose_item(IN(19), 1024, KVR, [](int n) { return n; }, [=](int k) { return k < KVR ? kv_norm[k] : 0.f; }, WUKV_T, 256, (r / nb) * 64, (r % nb) * 32, scr, lane); }
    }
}

__device__ void ph_prenorm_bf16(const float* in, const float* g, const float* mod, int sh_off, int sc_off, bf16* out) {
    const int lane = tidx() & 63, gw = blockIdx.x * (NT / 64) + (tidx() >> 6), ngw = gridDim.x * (NT / 64);
    for (int t = gw; t < M; t += ngw) {
        const int b = t / SEQ; const f32x4v* r = (const f32x4v*)(in + (size_t)t * D) + lane;
        f32x4v v[4]; float s = 0.f;
#pragma unroll
        for (int j = 0; j < 4; ++j) { v[j] = r[64 * j]; s += (v[j].x * v[j].x + v[j].y * v[j].y) + (v[j].z * v[j].z + v[j].w * v[j].w); }
        const float inv = rsqrtf(wave_sum(s) / D + EPS);
        const f32x4v* gp = (const f32x4v*)g + lane; const f32x4v* scp = (const f32x4v*)(mod + b * 6 * D + sc_off) + lane; const f32x4v* shp = (const f32x4v*)(mod + b * 6 * D + sh_off) + lane;
        unsigned long long* o8 = (unsigned long long*)(out + (size_t)t * D) + lane;
#pragma unroll
        for (int j = 0; j < 4; ++j) { const f32x4v gg = gp[64 * j], sc = scp[64 * j], sh = shp[64 * j];
            const f32x4v h = v[j] * inv * gg * (sc + 1.f) + sh;
            o8[64 * j] = (unsigned long long)pk2(h.x, h.y) | ((unsigned long long)pk2(h.z, h.w) << 32); }
    }
}


__device__ void ph_prep2(const bf16* U, const int* pos, const float* conv_w, const float* conv_b, const float* dt_bias,
                         bf16* CQN, bf16* CKVN, bf16* KF, float* COS, float* SIN, float* DT, bf16* XC) {
    const int lane = tidx() & 63, gw = blockIdx.x * (NT / 64) + (tidx() >> 6), ngw = gridDim.x * (NT / 64);
    const int rows_per = (M + ngw - 1) / ngw;
    for (int t = gw * rows_per; t < (gw + 1) * rows_per && t < M; ++t) {
        const int sq = t & (SEQ - 1), b = t >> 11;
        const bf16* ur = U + (size_t)t * NU;
        { const uint2 w = *(const uint2*)(ur + OFF_CQ + lane * 4);
          const float a0 = __uint_as_float(w.x << 16), a1 = __uint_as_float(w.x & 0xffff0000u), a2 = __uint_as_float(w.y << 16), a3 = __uint_as_float(w.y & 0xffff0000u);
          const float inv = rsqrtf(wave_sum(a0 * a0 + a1 * a1 + a2 * a2 + a3 * a3) * (1.f / QR) + EPS);
          uint2 o; o.x = pk2(a0 * inv, a1 * inv); o.y = pk2(a2 * inv, a3 * inv);
          *(uint2*)(CQN + (size_t)t * QR + lane * 4) = o; }
        { const unsigned w = *(const unsigned*)(ur + OFF_CKV + lane * 2);
          const float a0 = __uint_as_float(w << 16), a1 = __uint_as_float(w & 0xffff0000u);
          const float inv = rsqrtf(wave_sum(a0 * a0 + a1 * a1) * (1.f / KVR) + EPS);
          *(unsigned*)(CKVN + (size_t)t * 256 + lane * 2) = pk2(a0 * inv, a1 * inv);
          *(unsigned*)(CKVN + (size_t)t * 256 + 128 + lane * 2) = 0u; }
        { const int i = lane & 15;
          const float x1 = bf2f(ur[OFF_KR + i]), x2 = bf2f(ur[OFF_KR + 16 + i]);
          const float inv = exp2f(-(float)i * (13.287712379549449f / 16.0f));
          const float ang = (float)pos[t] * inv;
          float sn, cs; sincosf(ang, &sn, &cs);
          if (lane < 16) { COS[(size_t)t * 16 + i] = cs; SIN[(size_t)t * 16 + i] = sn; }
          const float r1 = x1 * cs - x2 * sn, r2 = x2 * cs + x1 * sn;
          const int cc = lane & 3, hh = (lane >> 2) & 7;
          float e[8];
#pragma unroll
          for (int j = 0; j < 8; ++j) { const float p1 = __shfl(r1, (cc & 1) * 8 + j), p2 = __shfl(r2, (cc & 1) * 8 + j); e[j] = (cc >> 1) ? p2 : p1; }
          if (lane < 32) { v4u o; o.x = pk2(e[0], e[1]); o.y = pk2(e[2], e[3]); o.z = pk2(e[4], e[5]); o.w = pk2(e[6], e[7]);
            *(v4u*)(KF + (size_t)((b * 8 + hh) * 32 + (sq >> 6)) * 6144 + (8 + cc) * 512 + (sq & 63) * 8) = o; } }
        if (lane < 8) { const float raw = bf2f(ur[OFF_DT + lane]) + dt_bias[lane]; DT[(size_t)t * 8 + lane] = raw > 20.f ? raw : log1pf(expf(raw)); }
        { const int ch = lane * 16;
          float acc[16];
          { const f32x4v* bp = (const f32x4v*)(conv_b + ch);
#pragma unroll
            for (int q4 = 0; q4 < 4; ++q4) { const f32x4v bb = bp[q4]; acc[4 * q4] = bb.x; acc[4 * q4 + 1] = bb.y; acc[4 * q4 + 2] = bb.z; acc[4 * q4 + 3] = bb.w; } }
#pragma unroll
          for (int k = 0; k < 4; ++k) {
              if (sq - 3 + k >= 0) {
                  const v4u* xp = (const v4u*)(U + (size_t)(t - 3 + k) * NU + OFF_XBC + ch);
                  const v4u xa = xp[0], xb = xp[1];
                  const f32x4v* wp = (const f32x4v*)(conv_w + k * SSD_XBC + ch);
                  const unsigned xw[8] = {xa.x, xa.y, xa.z, xa.w, xb.x, xb.y, xb.z, xb.w};
#pragma unroll
                  for (int q4 = 0; q4 < 4; ++q4) { const f32x4v ww = wp[q4];
                      acc[4 * q4] += ww.x * __uint_as_float(xw[2 * q4] << 16); acc[4 * q4 + 1] += ww.y * __uint_as_float(xw[2 * q4] & 0xffff0000u);
                      acc[4 * q4 + 2] += ww.z * __uint_as_float(xw[2 * q4 + 1] << 16); acc[4 * q4 + 3] += ww.w * __uint_as_float(xw[2 * q4 + 1] & 0xffff0000u); }
              }
          }
          v4u o0, o1;
          o0.x = pk2(silu_f(acc[0]), silu_f(acc[1])); o0.y = pk2(silu_f(acc[2]), silu_f(acc[3])); o0.z = pk2(silu_f(acc[4]), silu_f(acc[5])); o0.w = pk2(silu_f(acc[6]), silu_f(acc[7]));
          o1.x = pk2(silu_f(acc[8]), silu_f(acc[9])); o1.y = pk2(silu_f(acc[10]), silu_f(acc[11])); o1.z = pk2(silu_f(acc[12]), silu_f(acc[13])); o1.w = pk2(silu_f(acc[14]), silu_f(acc[15]));
          v4u* op = (v4u*)(XC + (size_t)t * SSD_XBC + ch); op[0] = o0; op[1] = o1; }
    }
}


typedef short bf16x8v __attribute__((ext_vector_type(8)));
__device__ void ph_rowrouter(float* ldsf, const bf16* Yb, const float* x, const float* post_gain, const float* pre_gain, const float* mod, const bf16* WRF,
                             const float* bgr, const float* ber, float* out, bf16* H2, int* CNT, int* RT_E, int* RT_S, float* RT_W) {
    const int tid = tidx(), lane = tid & 63, wave = tid >> 6, row = lane & 15, kg = lane >> 4;
    const int gw = blockIdx.x * (NT / 64) + wave, ngw = gridDim.x * (NT / 64);
    float* L = ldsf + wave * (16 * 48);
    for (int item = gw; item < M / 16; item += ngw) {
        const int t = item * 16 + row, b = t >> 11;
        const bf16* yr = Yb + (size_t)t * D + 8 * kg; const float* xr = x + (size_t)t * D + 8 * kg; float* orow = out + (size_t)t * D + 8 * kg;
        const float* g1 = mod + b * 6 * D + 2 * D + 8 * kg; const float* sc2 = mod + b * 6 * D + 4 * D + 8 * kg; const float* sh2 = mod + b * 6 * D + 3 * D + 8 * kg;
        float ssy = 0.f;
#pragma unroll 4
        for (int sk = 0; sk < 32; ++sk) { const v4u w = *(const v4u*)(yr + 32 * sk);
#pragma unroll
            for (int e = 0; e < 4; ++e) { const float a = __uint_as_float(w[e] << 16), c = __uint_as_float(w[e] & 0xffff0000u); ssy += a * a + c * c; } }
        ssy += __shfl_xor(ssy, 16); ssy += __shfl_xor(ssy, 32);
        const float invy = rsqrtf(ssy * (1.f / D) + EPS);
        float ss1 = 0.f;
#pragma unroll 2
        for (int sk = 0; sk < 32; ++sk) { const v4u w = *(const v4u*)(yr + 32 * sk);
            const f32x4v xa = *(const f32x4v*)(xr + 32 * sk), xb = *(const f32x4v*)(xr + 32 * sk + 4);
            const f32x4v ga = *(const f32x4v*)(g1 + 32 * sk), gb = *(const f32x4v*)(g1 + 32 * sk + 4);
            const f32x4v pa = *(const f32x4v*)(post_gain + 8 * kg + 32 * sk), pb = *(const f32x4v*)(post_gain + 8 * kg + 32 * sk + 4);
            f32x4v ya, yb; ya.x = __uint_as_float(w.x << 16); ya.y = __uint_as_float(w.x & 0xffff0000u); ya.z = __uint_as_float(w.y << 16); ya.w = __uint_as_float(w.y & 0xffff0000u);
            yb.x = __uint_as_float(w.z << 16); yb.y = __uint_as_float(w.z & 0xffff0000u); yb.z = __uint_as_float(w.w << 16); yb.w = __uint_as_float(w.w & 0xffff0000u);
            const f32x4v oa = xa + ga * (ya * invy * pa), ob = xb + gb * (yb * invy * pb);
            *(f32x4v*)(orow + 32 * sk) = oa; *(f32x4v*)(orow + 32 * sk + 4) = ob;
            ss1 += (oa.x * oa.x + oa.y * oa.y) + (oa.z * oa.z + oa.w * oa.w) + (ob.x * ob.x + ob.y * ob.y) + (ob.z * ob.z + ob.w * ob.w); }
        ss1 += __shfl_xor(ss1, 16); ss1 += __shfl_xor(ss1, 32);
        const float inv1 = rsqrtf(ss1 * (1.f / D) + EPS);
        f32x4v acc0 = {0.f, 0.f, 0.f, 0.f}, acc1 = acc0, acc2 = acc0;
        bf16* hrow = H2 + (size_t)t * D + 8 * kg;
#pragma unroll 2
        for (int sk = 0; sk < 32; ++sk) {
            const f32x4v xa = *(const f32x4v*)(orow + 32 * sk), xb = *(const f32x4v*)(orow + 32 * sk + 4);
            const f32x4v pa = *(const f32x4v*)(pre_gain + 8 * kg + 32 * sk), pb = *(const f32x4v*)(pre_gain + 8 * kg + 32 * sk + 4);
            const f32x4v ca = *(const f32x4v*)(sc2 + 32 * sk), cb = *(const f32x4v*)(sc2 + 32 * sk + 4);
            const f32x4v sa = *(const f32x4v*)(sh2 + 32 * sk), sb = *(const f32x4v*)(sh2 + 32 * sk + 4);
            const f32x4v ha = xa * inv1 * pa * (ca + 1.f) + sa, hb = xb * inv1 * pb * (cb + 1.f) + sb;
            const float hv[8] = {ha.x, ha.y, ha.z, ha.w, hb.x, hb.y, hb.z, hb.w};
            unsigned hw[4], lw[4];
#pragma unroll
            for (int e = 0; e < 4; ++e) { const unsigned h0 = f2bf(hv[2 * e]), h1 = f2bf(hv[2 * e + 1]); hw[e] = h0 | (h1 << 16);
                lw[e] = pk2(hv[2 * e] - __uint_as_float(h0 << 16), hv[2 * e + 1] - __uint_as_float(h1 << 16)); }
            const v4u hq = {hw[0], hw[1], hw[2], hw[3]}, lq = {lw[0], lw[1], lw[2], lw[3]};
            *(v4u*)(hrow + 32 * sk) = hq;
            const bf16x8v a_hi = __builtin_bit_cast(bf16x8v, hq), a_lo = __builtin_bit_cast(bf16x8v, lq);
            const v4u* bp = (const v4u*)(WRF + (size_t)(sk * 3) * 2 * 512 + lane * 8);
#define RSTEP(ACC, cb_) do { const bf16x8v bh_ = __builtin_bit_cast(bf16x8v, bp[(cb_) * 128]), bl_ = __builtin_bit_cast(bf16x8v, bp[(cb_) * 128 + 64]); \
                ACC = __builtin_amdgcn_mfma_f32_16x16x32_bf16(a_hi, bh_, ACC, 0, 0, 0); ACC = __builtin_amdgcn_mfma_f32_16x16x32_bf16(a_lo, bh_, ACC, 0, 0, 0); \
                ACC = __builtin_amdgcn_mfma_f32_16x16x32_bf16(a_hi, bl_, ACC, 0, 0, 0); } while (0)
            RSTEP(acc0, 0); RSTEP(acc1, 1); RSTEP(acc2, 2);
#undef RSTEP
        }
#pragma unroll
        for (int j = 0; j < 4; ++j) { L[(4 * kg + j) * 48 + row] = acc0[j]; L[(4 * kg + j) * 48 + 16 + row] = acc1[j]; L[(4 * kg + j) * 48 + 32 + row] = acc2[j]; }
        asm volatile("s_waitcnt lgkmcnt(0)" ::: "memory");
        if (lane < 16) {
            const float* lr = L + lane * 48;
            float mxv = -INFINITY; int gi = 0;
            for (int i = 0; i < 4; ++i) { const float v = lr[i] + bgr[i]; if (v > mxv) { mxv = v; gi = i; } }
            float den = 0.f; for (int i = 0; i < 4; ++i) den += expf(lr[i] + bgr[i] - mxv);
            const float gwt = 1.f / den;
            float v1 = -INFINITY, v2 = -INFINITY; int i1 = 0, i2 = 0;
            for (int i = 0; i < 8; ++i) { const float v = lr[4 + gi * 8 + i] + ber[gi * 8 + i];
                if (v > v1) { v2 = v1; i2 = i1; v1 = v; i1 = i; } else if (v > v2) { v2 = v; i2 = i; } }
            const float p2 = expf(v2 - v1);
            const int e1 = gi * 8 + i1, e2 = gi * 8 + i2, tt = item * 16 + lane;
            const int s1 = atomicAdd(&CNT[e1], 1), s2 = atomicAdd(&CNT[e2], 1);
            RT_E[tt] = e1 | (e2 << 8); RT_S[2 * tt] = s1; RT_S[2 * tt + 1] = s2; RT_W[2 * tt] = gwt / (1.f + p2); RT_W[2 * tt + 1] = gwt * p2 / (1.f + p2);
        }
        asm volatile("s_waitcnt lgkmcnt(0)" ::: "memory");
    }
}
__device__ __forceinline__ void moe_table(int* tp, const int* CNT) {
    const int tid = tidx();
    __syncthreads();
    if (tid < 64) { const int c = (tid < 32) ? __hip_atomic_load(CNT + tid, __ATOMIC_RELAXED, __HIP_MEMORY_SCOPE_AGENT) : 0; int v = (c + 255) >> 8;
        int inc = v;
#pragma unroll
        for (int o = 1; o < 64; o <<= 1) { const int n = __shfl_up(inc, o); if ((tid & 63) >= o) inc += n; }
        if (tid <= 32) tp[tid] = inc - v; }
    __syncthreads();
}
__device__ void ph_gather(int* tp, const bf16* H2, const int* RT_E, const int* RT_S, const float* RT_W, bf16* HG, float* ROWW, int* TOKROW) {
    const int lane = tidx() & 63, gw = blockIdx.x * (NT / 64) + (tidx() >> 6), ngw = gridDim.x * (NT / 64);
    for (int p = gw; p < 2 * M; p += ngw) { const int t = p >> 1, k = p & 1;
        const int e = (RT_E[t] >> (8 * k)) & 255; const int rowd = tp[e] * 256 + RT_S[p];
        const v4u* src = (const v4u*)(H2 + (size_t)t * D) + lane; v4u* dst = (v4u*)(HG + (size_t)rowd * D) + lane;
        dst[0] = src[0]; dst[64] = src[64];
        if (lane == 0) { ROWW[rowd] = RT_W[p]; TOKROW[p] = rowd; } }
}
__device__ void ph_moe_final(const bf16* YP, const int* TOKROW, const float* gain, const float* mod, float* out) {
    const int lane = tidx() & 63, gw = blockIdx.x * (NT / 64) + (tidx() >> 6), ngw = gridDim.x * (NT / 64);
    for (int t = gw; t < M; t += ngw) { const int b = t >> 11; const int r1 = TOKROW[2 * t], r2 = TOKROW[2 * t + 1];
        const v4u* p1 = (const v4u*)(YP + (size_t)r1 * D) + lane; const v4u* p2 = (const v4u*)(YP + (size_t)r2 * D) + lane;
        float y[16]; float ss = 0.f;
#pragma unroll
        for (int j = 0; j < 2; ++j) { const v4u a = p1[64 * j], c = p2[64 * j];
#pragma unroll
            for (int e = 0; e < 4; ++e) { const float v0 = __uint_as_float(a[e] << 16) + __uint_as_float(c[e] << 16), v1 = __uint_as_float(a[e] & 0xffff0000u) + __uint_as_float(c[e] & 0xffff0000u);
                y[8 * j + 2 * e] = v0; y[8 * j + 2 * e + 1] = v1; ss += v0 * v0 + v1 * v1; } }
        const float inv = rsqrtf(wave_sum(ss) * (1.f / D) + EPS);
#pragma unroll
        for (int j = 0; j < 2; ++j) { const int col = 512 * j + lane * 8; float* op = out + (size_t)t * D + col;
            const f32x4v g2a = *(const f32x4v*)(mod + b * 6 * D + 5 * D + col), g2b = *(const f32x4v*)(mod + b * 6 * D + 5 * D + col + 4);
            const f32x4v ga = *(const f32x4v*)(gain + col), gb = *(const f32x4v*)(gain + col + 4);
            f32x4v xa = *(f32x4v*)op, xb = *(f32x4v*)(op + 4);
            xa.x += g2a.x * (y[8 * j + 0] * inv * ga.x); xa.y += g2a.y * (y[8 * j + 1] * inv * ga.y); xa.z += g2a.z * (y[8 * j + 2] * inv * ga.z); xa.w += g2a.w * (y[8 * j + 3] * inv * ga.w);
            xb.x += g2b.x * (y[8 * j + 4] * inv * gb.x); xb.y += g2b.y * (y[8 * j + 5] * inv * gb.y); xb.z += g2b.z * (y[8 * j + 6] * inv * gb.z); xb.w += g2b.w * (y[8 * j + 7] * inv * gb.w);
            *(f32x4v*)op = xa; *(f32x4v*)(op + 4) = xb; }
    }
}
__device__ void ph_attn_ref(const bf16* Q, const bf16* KF, const bf16* VT, float* o) {
    const int lane = tidx() & 63, gw = blockIdx.x * (NT / 64) + (tidx() >> 6), ngw = gridDim.x * (NT / 64);
    for (int item = gw; item < NB * MLA_H * (SEQ / 64); item += ngw) {
        const int qb = (SEQ / 64 - 1) - item / (NB * MLA_H), bh = item % (NB * MLA_H), b = bh / MLA_H, h = bh % MLA_H;
        const int qi = qb * 64 + lane;
        const size_t t = (size_t)b * SEQ + qi;
        float qr[QK];
#pragma unroll
        for (int d = 0; d < QK; ++d) qr[d] = bf2f(Q[t * 768 + h * QK + d]);
        float acc[VD];
#pragma unroll
        for (int d = 0; d < VD; ++d) acc[d] = 0.f;
        float mx = -INFINITY, l = 0.f;
        const int kmax = qb * 64 + 63;
        for (int k = 0; k <= kmax; ++k) {
            const bf16* kt = KF + (size_t)(bh * 32 + (k >> 6)) * 6144 + (k & 63) * 8;
            const bf16* vt = VT + (size_t)(bh * 32 + (k >> 6)) * 4096 + (k & 63) * 32;
            float s = 0.f;
#pragma unroll
            for (int d = 0; d < QK; ++d) s += qr[d] * bf2f(kt[(d >> 3) * 512 + (d & 7)]);
            if (k <= qi) {
                const float mn = fmaxf(mx, s);
                const float f = exp2f(mx - mn), pv = exp2f(s - mn);
                l = l * f + pv;
#pragma unroll
                for (int d = 0; d < VD; ++d) acc[d] = acc[d] * f + pv * bf2f(vt[(d >> 5) * 2048 + (d & 31)]);
                mx = mn;
            }
        }
        const float il = 1.f / l;
#pragma unroll
        for (int d = 0; d < VD; ++d) o[t * (MLA_H * VD) + h * VD + d] = acc[d] * il;
    }
}

namespace att {
typedef short bf16x8 __attribute__((ext_vector_type(8)));
typedef short s16x4 __attribute__((ext_vector_type(4)));
typedef float f32x16 __attribute__((ext_vector_type(16)));
typedef unsigned u32x4 __attribute__((ext_vector_type(4)));
#define ALAS __attribute__((address_space(3)))
constexpr int KSLOT = 12288, VSLOT = 8192, NSLOT = 3;
constexpr int LDS_K = 0, LDS_V = NSLOT * KSLOT, LDS_WS = LDS_V + NSLOT * VSLOT, LDS_OST = LDS_WS + 8 * 256, LDS_END = LDS_OST + 8 * 4096;
constexpr float THR = 8.0f;
__device__ __forceinline__ int crow(int r, int hi) { return (r & 3) + 8 * (r >> 2) + 4 * hi; }
__device__ __forceinline__ unsigned cvtpk(float lo, float hi) { typedef float f2 __attribute__((ext_vector_type(2))); typedef __bf16 b2 __attribute__((ext_vector_type(2)));
    f2 v = {lo, hi}; b2 b = __builtin_convertvector(v, b2); return __builtin_bit_cast(unsigned, b); }
__device__ __forceinline__ s16x4 vtr(const ALAS char* p) { typedef short v4 __attribute__((ext_vector_type(4))); return __builtin_bit_cast(s16x4, __builtin_amdgcn_ds_read_tr16_b64_v4i16((ALAS v4*)p)); }
#define AWAIT_BAR(N) asm volatile("s_waitcnt vmcnt(" #N ") lgkmcnt(0)\n\ts_barrier" ::: "memory")

__device__ __forceinline__ void attn_unit(ALAS char* lds, int bh, int qb, const bf16* Q, const bf16* KF, const bf16* VT, bf16* YC, float* SSQ) {
    const int tid = tidx(), lane = tid & 63, r32 = lane & 31, hi = lane >> 5; const int wid = __builtin_amdgcn_readfirstlane(tid >> 6);
    const int b = bh >> 3, h = bh & 7;
    const char* Kt = (const char*)(KF + (size_t)bh * 32 * 6144); const char* Vt = (const char*)(VT + (size_t)bh * 32 * 4096);
    const int NTL = 4 * (qb + 1);
    bf16x8 qf[6];
    { const bf16* qp = Q + (size_t)(b * SEQ + qb * 256 + wid * 32 + r32) * 768 + h * QK + hi * 8;
#pragma unroll
      for (int d0 = 0; d0 < 6; ++d0) qf[d0] = *(const bf16x8*)(qp + d0 * 16); }
    const unsigned koff0 = wid * 1024 + lane * 16, koff1 = (8 + (wid & 3)) * 1024 + lane * 16, voff = wid * 1024 + lane * 16;
#define ADMA(t, slot) do { const char* kb_ = Kt + (size_t)(t) * KSLOT; const char* vb_ = Vt + (size_t)(t) * VSLOT; \
        __builtin_amdgcn_global_load_lds((const unsigned*)(kb_ + koff0), (ALAS unsigned*)(lds + LDS_K + (slot) * KSLOT + wid * 1024), 16, 0, 0); \
        __builtin_amdgcn_global_load_lds((const unsigned*)(kb_ + koff1), (ALAS unsigned*)(lds + LDS_K + (slot) * KSLOT + (8 + (wid & 3)) * 1024), 16, 0, 0); \
        __builtin_amdgcn_global_load_lds((const unsigned*)(vb_ + voff), (ALAS unsigned*)(lds + LDS_V + (slot) * VSLOT + wid * 1024), 16, 0, 0); } while (0)
    ADMA(0, 0); ADMA(1, 1);
    ALAS float* wsf = (ALAS float*)(lds + LDS_WS) + wid * 64;
    float mref = 0.f, l = 0.f;
    f32x16 o0 = {}, o1 = {}, negm = {};
    const int qrel = wid * 32 + r32;
    const int vlane = (4 * hi + ((lane & 15) >> 2)) * 64 + ((lane >> 4) & 1) * 32 + (lane & 3) * 8;
    int slot = 0;
    for (int t = 0; t < NTL; ++t) {
        if (t + 1 < NTL) { AWAIT_BAR(3); } else { AWAIT_BAR(0); }
        if (t + 2 < NTL) { const int s2 = (slot == 0) ? 2 : slot - 1; ADMA(t + 2, s2); }
        const ALAS char* Ks = lds + LDS_K + slot * KSLOT + hi * 1024 + r32 * 16;
        const ALAS char* Vs = lds + LDS_V + slot * VSLOT + vlane;
        f32x16 p0 = negm, p1 = negm;
#pragma unroll
        for (int d0 = 0; d0 < 6; ++d0) {
            const bf16x8 ka0 = *(const ALAS bf16x8*)(Ks + d0 * 2048), ka1 = *(const ALAS bf16x8*)(Ks + d0 * 2048 + 512);
            p0 = __builtin_amdgcn_mfma_f32_32x32x16_bf16(ka0, qf[d0], p0, 0, 0, 0);
            p1 = __builtin_amdgcn_mfma_f32_32x32x16_bf16(ka1, qf[d0], p1, 0, 0, 0);
        }
        const int jb = t - (NTL - 4);
        if (jb >= 0) {
#pragma unroll
            for (int r = 0; r < 16; ++r) { const int kv = 64 * jb + crow(r, hi); if (kv > qrel) p0[r] = -INFINITY; if (kv + 32 > qrel) p1[r] = -INFINITY; }
        }
        float rm = fmaxf(p0[0], p1[0]);
#pragma unroll
        for (int r = 1; r < 16; ++r) rm = fmaxf(rm, fmaxf(p0[r], p1[r]));
        { auto rr = __builtin_amdgcn_permlane32_swap(__float_as_uint(rm), __float_as_uint(rm), false, false); rm = fmaxf(__uint_as_float(rr[0]), __uint_as_float(rr[1])); }
        if (t == 0 || __any(rm > THR)) {
            const float dl = (t == 0) ? rm : fmaxf(rm, 0.f);
            mref += dl;
#pragma unroll
            for (int r = 0; r < 16; ++r) { p0[r] -= dl; p1[r] -= dl; }
#pragma unroll
            for (int r = 0; r < 16; ++r) negm[r] = -mref;
            const float f = exp2f(-dl); l *= f;
            if (t > 0) {
                if (hi == 0) wsf[r32] = f;
                asm volatile("s_waitcnt lgkmcnt(0)" ::: "memory");
#pragma unroll
                for (int r = 0; r < 16; ++r) { const float fr_ = wsf[crow(r, hi)]; o0[r] *= fr_; o1[r] *= fr_; }
            }
        }
        float ls = 0.f;
#pragma unroll
        for (int r = 0; r < 16; ++r) { p0[r] = exp2f(p0[r]); p1[r] = exp2f(p1[r]); ls += p0[r] + p1[r]; }
        l += ls;
        u32x4 pw0 = {cvtpk(p0[0], p0[1]), cvtpk(p0[2], p0[3]), cvtpk(p0[4], p0[5]), cvtpk(p0[6], p0[7])};
        u32x4 pw1 = {cvtpk(p0[8], p0[9]), cvtpk(p0[10], p0[11]), cvtpk(p0[12], p0[13]), cvtpk(p0[14], p0[15])};
        u32x4 pw2 = {cvtpk(p1[0], p1[1]), cvtpk(p1[2], p1[3]), cvtpk(p1[4], p1[5]), cvtpk(p1[6], p1[7])};
        u32x4 pw3 = {cvtpk(p1[8], p1[9]), cvtpk(p1[10], p1[11]), cvtpk(p1[12], p1[13]), cvtpk(p1[14], p1[15])};
#define PV_STEP(PW, ks) do { const bf16x8 pa_ = __builtin_bit_cast(bf16x8, PW); \
            { const s16x4 a_ = vtr(Vs + (ks) * 1024), b_ = vtr(Vs + (ks) * 1024 + 512); const bf16x8 vf_ = {a_[0], a_[1], a_[2], a_[3], b_[0], b_[1], b_[2], b_[3]}; \
              o0 = __builtin_amdgcn_mfma_f32_32x32x16_bf16(pa_, vf_, o0, 0, 0, 0); } \
            { const s16x4 a_ = vtr(Vs + 4096 + (ks) * 1024), b_ = vtr(Vs + 4096 + (ks) * 1024 + 512); const bf16x8 vf_ = {a_[0], a_[1], a_[2], a_[3], b_[0], b_[1], b_[2], b_[3]}; \
              o1 = __builtin_amdgcn_mfma_f32_32x32x16_bf16(pa_, vf_, o1, 0, 0, 0); } } while (0)
        PV_STEP(pw0, 0); PV_STEP(pw1, 1); PV_STEP(pw2, 2); PV_STEP(pw3, 3);
#undef PV_STEP
        slot = (slot == 2) ? 0 : slot + 1;
    }
    { auto rr = __builtin_amdgcn_permlane32_swap(__float_as_uint(l), __float_as_uint(l), false, false); l = __uint_as_float(rr[0]) + __uint_as_float(rr[1]); }
    if (hi == 0) wsf[32 + r32] = l;
    asm volatile("s_waitcnt lgkmcnt(0)" ::: "memory");
    ALAS bf16* stg = (ALAS bf16*)(lds + LDS_OST) + wid * 2048;
#pragma unroll
    for (int r = 0; r < 16; ++r) { const int orow = crow(r, hi); const float rl = 1.f / wsf[32 + orow];
        stg[orow * 64 + r32] = (bf16)f2bf(o0[r] * rl); stg[orow * 64 + 32 + r32] = (bf16)f2bf(o1[r] * rl); }
    asm volatile("s_waitcnt lgkmcnt(0)" ::: "memory");
    const size_t trow0 = (size_t)b * SEQ + qb * 256 + wid * 32;
#pragma unroll
    for (int i = 0; i < 4; ++i) { const int row = i * 8 + (lane >> 3), ch = lane & 7;
        const u32x4 v = *(const ALAS u32x4*)(stg + row * 64 + ch * 8);
        *(u32x4*)(YC + (trow0 + row) * 1024 + 512 + h * 64 + ch * 8) = v;
        float sq = 0.f;
#pragma unroll
        for (int e = 0; e < 4; ++e) { const float a = __uint_as_float(v[e] << 16), c = __uint_as_float(v[e] & 0xffff0000u); sq += a * a + c * c; }
        sq += __shfl_xor(sq, 1); sq += __shfl_xor(sq, 2); sq += __shfl_xor(sq, 4);
        if (ch == 0) SSQ[(trow0 + row) * 16 + 8 + h] = sq; }
    asm volatile("s_waitcnt lgkmcnt(0)\n\ts_barrier" ::: "memory");
#undef ADMA
}
__device__ __forceinline__ void attn_phase(ALAS char* lds, const bf16* Q, const bf16* KF, const bf16* VT, bf16* YC, float* SSQ) {
    const int G = gridDim.x, bid = blockIdx.x; const int vcu = (G % 8 == 0) ? (bid % 8) * (G / 8) + bid / 8 : bid;
    for (int p = vcu; p < 256; p += G) { const int bh = p >> 2, s = p & 3;
        attn_unit(lds, bh, 7 - s, Q, KF, VT, YC, SSQ);
        attn_unit(lds, bh, s, Q, KF, VT, YC, SSQ); }
}
#undef AWAIT_BAR
}
__device__ void ph_prenorm(const float* in, const float* g, const float* mod, int sh_off, int sc_off, float* out) {
    const int lane = tidx() & 63, gw = blockIdx.x * (NT / 64) + (tidx() >> 6), ngw = gridDim.x * (NT / 64);
    for (int t = gw; t < M; t += ngw) {
        const int b = t / SEQ; const float* r = in + (size_t)t * D;
        float s = 0.f;
        for (int i = lane; i < D; i += 64) s += r[i] * r[i];
        const float inv = rsqrtf(wave_sum(s) / D + EPS);
        for (int i = lane; i < D; i += 64)
            out[(size_t)t * D + i] = r[i] * inv * g[i] * (1.f + mod[b * 6 * D + sc_off + i]) + mod[b * 6 * D + sh_off + i];
    }
}
template <class TY> __device__ void ph_post(const float* base, const TY* y, const float* g, const float* mod, int gate_off, float* out) {
    const int lane = tidx() & 63, gw = blockIdx.x * (NT / 64) + (tidx() >> 6), ngw = gridDim.x * (NT / 64);
    for (int t = gw; t < M; t += ngw) {
        const int b = t / SEQ; const TY* r = y + (size_t)t * D;
        float s = 0.f;
        for (int i = lane; i < D; i += 64) { const float v = ldf(r + i); s += v * v; }
        const float inv = rsqrtf(wave_sum(s) / D + EPS);
        for (int i = lane; i < D; i += 64)
            out[(size_t)t * D + i] = base[(size_t)t * D + i] + mod[b * 6 * D + gate_off + i] * (ldf(r + i) * inv * g[i]);
    }
}
template <class TI> __device__ void ph_rms_slice(const TI* in, int ldi, int off, int n, const float* g, float* out, int ldo, int ooff) {
    const int lane = tidx() & 63, gw = blockIdx.x * (NT / 64) + (tidx() >> 6), ngw = gridDim.x * (NT / 64);
    for (int t = gw; t < M; t += ngw) {
        const TI* r = in + (size_t)t * ldi + off;
        float s = 0.f;
        for (int i = lane; i < n; i += 64) { const float v = ldf(r + i); s += v * v; }
        const float inv = rsqrtf(wave_sum(s) / n + EPS);
        for (int i = lane; i < n; i += 64) out[(size_t)t * ldo + ooff + i] = ldf(r + i) * inv * g[i];
    }
}
__device__ void ph_gate_norm(const float* y, const bf16* u, bf16* YC) {
    const int lane = tidx() & 63, gw = blockIdx.x * (NT / 64) + (tidx() >> 6), ngw = gridDim.x * (NT / 64);
    for (int t = gw; t < M; t += ngw) {
        float v[8]; float s = 0.f;
#pragma unroll
        for (int j = 0; j < 8; ++j) { const int i = lane + 64 * j; v[j] = y[(size_t)t * SSD_INNER + i] * silu_f(bf2f(u[(size_t)t * NU + OFF_Z + i])); s += v[j] * v[j]; }
        const float inv = rsqrtf(wave_sum(s) / SSD_INNER + EPS);
#pragma unroll
        for (int j = 0; j < 8; ++j) YC[(size_t)t * 1024 + lane + 64 * j] = (bf16)f2bf(v[j] * inv);
    }
}
__device__ void ph_mla_norm(bf16* YC, const float* SSQ) {
    const int lane = tidx() & 63, gw = blockIdx.x * (NT / 64) + (tidx() >> 6), ngw = gridDim.x * (NT / 64);
    for (int t = gw; t < M; t += ngw) {
        const f32x4v a = *(const f32x4v*)(SSQ + (size_t)t * 16 + 8), b = *(const f32x4v*)(SSQ + (size_t)t * 16 + 12);
        const float inv = rsqrtf(((a.x + a.y) + (a.z + a.w) + (b.x + b.y) + (b.z + b.w)) * (1.f / 512.f) + EPS);
        v4u* p = (v4u*)(YC + (size_t)t * 1024 + 512) + lane; v4u w = *p;
        w.x = pk2(__uint_as_float(w.x << 16) * inv, __uint_as_float(w.x & 0xffff0000u) * inv); w.y = pk2(__uint_as_float(w.y << 16) * inv, __uint_as_float(w.y & 0xffff0000u) * inv);
        w.z = pk2(__uint_as_float(w.z << 16) * inv, __uint_as_float(w.z & 0xffff0000u) * inv); w.w = pk2(__uint_as_float(w.w << 16) * inv, __uint_as_float(w.w & 0xffff0000u) * inv);
        *p = w;
    }
}
__device__ void ph_gemm(float* lds, const float* A, int lda, const float* B, int ldb, float* C, int ldc, int Mr, int N, int K) {
    float (*As)[129] = (float (*)[129])lds;
    float (*Bs)[65] = (float (*)[65])(lds + 16 * 129);
    const int tx = tidx() & 15, ty = tidx() >> 4;
    const int ntn = (N + 63) / 64, ntm = Mr / 128;
    for (int tile = blockIdx.x; tile < ntn * ntm; tile += gridDim.x) {
        const int m0 = (tile / ntn) * 128, n0 = (tile % ntn) * 64;
        float acc[4][4] = {};
        for (int k0 = 0; k0 < K; k0 += 16) {
            for (int i = tidx(); i < 128 * 16; i += NT) { const int r = i >> 4, kk = i & 15; As[kk][r] = A[(size_t)(m0 + r) * lda + k0 + kk]; }
            for (int i = tidx(); i < 64 * 16; i += NT) { const int kk = i >> 6, cc = i & 63; Bs[kk][cc] = (n0 + cc < N) ? B[(size_t)(k0 + kk) * ldb + n0 + cc] : 0.f; }
            __syncthreads();
#pragma unroll
            for (int kk = 0; kk < 16; ++kk) {
                float a[4], b[4];
#pragma unroll
                for (int i = 0; i < 4; ++i) { a[i] = As[kk][ty * 4 + i]; b[i] = Bs[kk][tx * 4 + i]; }
#pragma unroll
                for (int i = 0; i < 4; ++i)
#pragma unroll
                    for (int j = 0; j < 4; ++j) acc[i][j] += a[i] * b[j];
            }
            __syncthreads();
        }
#pragma unroll
        for (int i = 0; i < 4; ++i)
#pragma unroll
            for (int j = 0; j < 4; ++j) { const int n = n0 + tx * 4 + j; if (n < N) C[(size_t)(m0 + ty * 4 + i) * ldc + n] = acc[i][j]; }
    }
}
__device__ void ph_conv(const bf16* u, const float* cw, const float* cb, float* xc) {
    for (size_t idx = (size_t)blockIdx.x * NT + tidx(); idx < (size_t)M * SSD_XBC; idx += (size_t)gridDim.x * NT) {
        const int ch = (int)(idx % SSD_XBC), t = (int)(idx / SSD_XBC), s = t % SEQ;
        float acc = cb[ch];
        for (int k = 0; k < 4; ++k) { const int ss = s - 3 + k; if (ss >= 0) acc += cw[k * SSD_XBC + ch] * bf2f(u[(size_t)(t - 3 + k) * NU + OFF_XBC + ch]); }
        xc[idx] = silu_f(acc);
    }
}
__device__ void ph_ssd_seq(const float* DT, const bf16* xc, const float* dt_bias, const float* a_log, const float* d_skip, float* y) {
    for (int item = blockIdx.x; item < NB * SSD_H; item += gridDim.x) {
        const int b = item / SSD_H, h = item % SSD_H, g = h / (SSD_H / SSD_G);
        const int p = tidx() >> 3, nq = tidx() & 7;
        const float a = -expf(a_log[h]), dsk = d_skip[h];
        float st[16];
#pragma unroll
        for (int i = 0; i < 16; ++i) st[i] = 0.f;
        for (int s = 0; s < SEQ; ++s) {
            const size_t t = (size_t)b * SEQ + s;
            const float dt = DT[t * 8 + h];
            const float da = expf(dt * a);
            const float xv = bf2f(xc[t * SSD_XBC + h * SSD_P + p]);
            const float xd = xv * dt;
            const bf16* Bp = xc + t * SSD_XBC + SSD_INNER + g * SSD_N + nq * 16;
            const bf16* Cp = xc + t * SSD_XBC + SSD_INNER + SSD_G * SSD_N + g * SSD_N + nq * 16;
            float acc = 0.f;
#pragma unroll
            for (int i = 0; i < 16; ++i) { st[i] = st[i] * da + xd * bf2f(Bp[i]); acc += bf2f(Cp[i]) * st[i]; }
            acc += __shfl_xor(acc, 1); acc += __shfl_xor(acc, 2); acc += __shfl_xor(acc, 4);
            if (nq == 0) y[t * SSD_INNER + h * SSD_P + p] = acc + dsk * xv;
        }
    }
}
__device__ void ph_rope(float* q, const bf16* u, const int* pos, float* kpe) {
    for (int idx = blockIdx.x * NT + tidx(); idx < M * 9 * 16; idx += gridDim.x * NT) {
        const int i = idx % 16, hh = (idx / 16) % 9, t = idx / (16 * 9);
        const float inv = 1.0f / powf(10000.0f, (float)(2 * i) / 32.0f);
        const float ang = (float)pos[t] * inv;
        float sn, cs; sincosf(ang, &sn, &cs);
        if (hh < 8) {
            float* p = q + (size_t)t * (MLA_H * QK) + hh * QK + NOPE;
            const float x1 = p[i], x2 = p[16 + i];
            p[i] = x1 * cs - x2 * sn; p[16 + i] = x2 * cs + x1 * sn;
        } else {
            const bf16* p = u + (size_t)t * NU + OFF_KR;
            const float x1 = bf2f(p[i]), x2 = bf2f(p[16 + i]);
            kpe[(size_t)t * ROPE + i] = x1 * cs - x2 * sn; kpe[(size_t)t * ROPE + 16 + i] = x2 * cs + x1 * sn;
        }
    }
}
__device__ void ph_attn(const float* q, const float* kv, const float* kpe, float* o) {
    const int lane = tidx() & 63, gw = blockIdx.x * (NT / 64) + (tidx() >> 6), ngw = gridDim.x * (NT / 64);
    for (int item = gw; item < NB * MLA_H * (SEQ / 64); item += ngw) {
        const int qb = (SEQ / 64 - 1) - item / (NB * MLA_H), bh = item % (NB * MLA_H), b = bh / MLA_H, h = bh % MLA_H;
        const int qi = qb * 64 + lane;
        const size_t t = (size_t)b * SEQ + qi;
        float qr[QK];
#pragma unroll
        for (int d = 0; d < QK; ++d) qr[d] = q[t * (MLA_H * QK) + h * QK + d] * 0.10206207261596575f;
        float acc[VD];
#pragma unroll
        for (int d = 0; d < VD; ++d) acc[d] = 0.f;
        float mx = -INFINITY, l = 0.f;
        const int kmax = qb * 64 + 63;
        for (int k = 0; k <= kmax; ++k) {
            const size_t tk = (size_t)b * SEQ + k;
            const float* kn = kv + tk * (MLA_H * 128) + h * 128;
            const float* kp = kpe + tk * ROPE;
            float s = 0.f;
#pragma unroll
            for (int d = 0; d < NOPE; ++d) s += qr[d] * kn[d];
#pragma unroll
            for (int d = 0; d < ROPE; ++d) s += qr[NOPE + d] * kp[d];
            if (k <= qi) {
                const float mn = fmaxf(mx, s);
                const float f = expf(mx - mn), pv = expf(s - mn);
                l = l * f + pv;
#pragma unroll
                for (int d = 0; d < VD; ++d) acc[d] = acc[d] * f + pv * kn[64 + d];
                mx = mn;
            }
        }
        const float il = 1.f / l;
#pragma unroll
        for (int d = 0; d < VD; ++d) o[t * (MLA_H * VD) + h * VD + d] = acc[d] * il;
    }
}
__device__ void ph_moe(float* lds, const float* h2, const float* wgr, const float* bgr, const float* wer, const float* ber,
                       const float* wg, const float* wu, const float* wd, float* y2) {
    const int sb = tidx() >> 8, tid = tidx() & 255;
    float* xs = lds + sb * 2048;
    float* logit = xs + 1024;
    float* hid = xs + 1088;
    int* sel_e = (int*)(xs + 1600);
    float* sel_w = xs + 1604;
    for (int it = blockIdx.x; it < M / 2; it += gridDim.x) {
        const int t = it * 2 + sb;
        __syncthreads();
        for (int i = tid; i < D; i += 256) xs[i] = h2[(size_t)t * D + i];
        __syncthreads();
        {
            const int w = tid >> 6, lane = tid & 63;
            for (int cidx = w * 9; cidx < w * 9 + 9; ++cidx) {
                float s = 0.f;
                for (int k = lane; k < D; k += 64) s += xs[k] * (cidx < 4 ? wgr[k * 4 + cidx] : wer[k * 32 + (cidx - 4)]);
                s = wave_sum(s);
                if (lane == 0) logit[cidx] = s;
            }
        }
        __syncthreads();
        if (tid == 0) {
            float mxv = -INFINITY; int gi = 0;
            for (int i = 0; i < 4; ++i) { const float v = logit[i] + bgr[i]; logit[i] = v; if (v > mxv) { mxv = v; gi = i; } }
            float den = 0.f; for (int i = 0; i < 4; ++i) den += expf(logit[i] - mxv);
            const float gw = 1.f / den;
            float emx = -INFINITY; int i1 = 0;
            for (int i = 0; i < 8; ++i) { const float v = logit[4 + gi * 8 + i] + ber[gi * 8 + i]; logit[4 + gi * 8 + i] = v; if (v > emx) { emx = v; i1 = i; } }
            float e2 = -INFINITY; int i2 = 0;
            for (int i = 0; i < 8; ++i) { const float v = logit[4 + gi * 8 + i]; if (i != i1 && v > e2) { e2 = v; i2 = i; } }
            const float p2 = expf(e2 - emx);
            sel_e[0] = gi * 8 + i1; sel_e[1] = gi * 8 + i2;
            sel_w[0] = gw / (1.f + p2); sel_w[1] = gw * p2 / (1.f + p2);
        }
        __syncthreads();
        for (int k2 = 0; k2 < 2; ++k2) {
            const int e = sel_e[k2];
            const float* G = wg + (size_t)e * D * FF; const float* U = wu + (size_t)e * D * FF;
            float ga = 0.f, ua = 0.f;
            for (int k = 0; k < D; ++k) { ga += xs[k] * G[(size_t)k * FF + tid]; ua += xs[k] * U[(size_t)k * FF + tid]; }
            hid[k2 * FF + tid] = silu_f(ga) * ua * sel_w[k2];
        }
        __syncthreads();
        for (int d = tid; d < D; d += 256) {
            float acc = 0.f;
            for (int k2 = 0; k2 < 2; ++k2) {
                const float* Wd = wd + (size_t)sel_e[k2] * FF * D;
                for (int f = 0; f < FF; ++f) acc += hid[k2 * FF + f] * Wd[(size_t)f * D + d];
            }
            y2[(size_t)t * D + d] = acc;
        }
    }
}


__global__ void __launch_bounds__(NT, 2) mega_fwd(Params P) {
    extern __shared__ __attribute__((aligned(16))) unsigned char lds_raw[];
    float* lds = (float*)lds_raw;
    cg::grid_group grid = cg::this_grid();
    float* out = kargs()->out; char* ws = kargs()->ws;
    const size_t MB = 1u << 20;
    float* mod = (float*)(ws + 1 * MB);
    bf16* WIN_T = (bf16*)(ws + 2 * MB);
    bf16* WOUT_T = (bf16*)(ws + 6 * MB);
    bf16* WUQ_T = (bf16*)(ws + 8 * MB);
    bf16* WUKV_T = (bf16*)(ws + 9 * MB);
    bf16* HB = (bf16*)(ws + 58 * MB);
    bf16* U = (bf16*)(ws + 90 * MB);
    float* RA = (float*)(ws + 154 * MB);
    float* RB = (float*)(ws + 218 * MB);
    float* RC = (float*)(ws + 10 * MB);

    bf16* WGU_T = (bf16*)(ws + 10 * MB);
    bf16* WD_T = (bf16*)(ws + 42 * MB);
    bf16* WRF = (bf16*)(ws + 9 * MB + 512 * 1024);
    int* CNT = (int*)(ws + 4096);
    ph_prep(lds, mod, WIN_T, WOUT_T, WUQ_T, WUKV_T, WGU_T, WD_T, WRF, CNT);
    grid.sync();
    ph_prenorm_bf16(IN(0), IN(5), mod, 0 * D, 1 * D, HB);
    grid.sync();
    { pg8::Gemm g{HB, WIN_T, M, NU, D}; pg8::StaticOrder S; S.init(M, NU, gridDim.x, (int)blockIdx.x);
      pg8::EpiBf16<0> E{U, NU};
      pg8::gemm_phase<pg8::EpiBf16<0>, pg8::StaticOrder, true, true>((PG8_LAS unsigned char*)lds_raw, g, S, E); }
    grid.sync();
    bf16* XC = (bf16*)(ws + 154 * MB);
    bf16* Qb = (bf16*)(ws + 186 * MB);
    bf16* KF = (bf16*)(ws + 210 * MB);
    bf16* VT = (bf16*)(ws + 234 * MB);
    float* COS = (float*)(ws + 250 * MB); float* SIN = (float*)(ws + 251 * MB);
    float* DT = (float*)(ws + 1 * MB + 256 * 1024);
    bf16* CQN = (bf16*)((char*)out + 32 * MB);
    bf16* CKVN = (bf16*)((char*)out + 40 * MB);
    ph_prep2(U, kargs()->pos, IN(10), IN(11), IN(12), CQN, CKVN, KF, COS, SIN, DT, XC);
    grid.sync();
    { pg8::Gemm g{CQN, WUQ_T, M, 768, QR}; pg8::StaticOrder S; S.init(M, 768, gridDim.x, (int)blockIdx.x);
      pg8::EpiQ E{Qb, COS, SIN};
      pg8::gemm_phase<pg8::EpiQ, pg8::StaticOrder, true, false>((PG8_LAS unsigned char*)lds_raw, g, S, E); }
    { pg8::Gemm g{CKVN, WUKV_T, M, 1024, 256}; pg8::StaticOrder S; S.init(M, 1024, gridDim.x, (int)blockIdx.x);
      pg8::EpiKV E{KF, VT};
      pg8::gemm_phase<pg8::EpiKV, pg8::StaticOrder, true, true>((PG8_LAS unsigned char*)lds_raw, g, S, E); }
    grid.sync();
    float* yssd = (float*)out;
    ph_ssd_seq(DT, XC, IN(12), IN(13), IN(14), yssd);
    bf16* YC = (bf16*)(ws + 58 * MB);
    float* SSQ = (float*)(ws + 252 * MB);
    att::attn_phase((ALAS char*)lds_raw, Qb, KF, VT, YC, SSQ);
    grid.sync();
    ph_gate_norm(yssd, U, YC);
    ph_mla_norm(YC, SSQ);
    grid.sync();
    bf16* Yb = (bf16*)(ws + 154 * MB);
    { pg8::Gemm g{YC, WOUT_T, M, D, D}; pg8::StaticOrder S; S.init(M, D, gridDim.x, (int)blockIdx.x);
      pg8::EpiBf16<0> E{Yb, D};
      pg8::gemm_phase<pg8::EpiBf16<0>, pg8::StaticOrder, true, true>((PG8_LAS unsigned char*)lds_raw, g, S, E); }
    grid.sync();
    bf16* H2 = (bf16*)(ws + 58 * MB);
    int* RT_E = (int*)(ws + 250 * MB); int* RT_S = (int*)(ws + 250 * MB + 256 * 1024); float* RT_W = (float*)(ws + 250 * MB + 512 * 1024);
    int* TOKROW = (int*)(ws + 250 * MB + 768 * 1024); float* ROWW = (float*)(ws + 251 * MB);
    ph_rowrouter(lds, Yb, IN(0), IN(6), IN(7), mod, WRF, IN(23), IN(25), out, H2, CNT, RT_E, RT_S, RT_W);
    grid.sync();
    int* tp = (int*)(lds_raw + 131072 + 1024);
    moe_table(tp, CNT);
    bf16* HG = (bf16*)(ws + 90 * MB);
    ph_gather(tp, H2, RT_E, RT_S, RT_W, HG, ROWW, TOKROW);
    grid.sync();
    bf16* HID = (bf16*)(ws + 170 * MB);
    { pg8::Gemm g{HG, WGU_T, 0, 0, D}; pg8::GroupedOrder S{(const PG8_LAS int*)tp, 2, (int)gridDim.x, (int)blockIdx.x};
      pg8::EpiGU E{HID, ROWW};
      pg8::gemm_phase<pg8::EpiGU, pg8::GroupedOrder, true, true>((PG8_LAS unsigned char*)lds_raw, g, S, E); }
    grid.sync();
    bf16* YP = (bf16*)(ws + 90 * MB);
    { pg8::Gemm g{HID, WD_T, 0, 0, FF}; pg8::GroupedOrder S{(const PG8_LAS int*)tp, 4, (int)gridDim.x, (int)blockIdx.x};
      pg8::EpiDown E{YP};
      pg8::gemm_phase<pg8::EpiDown, pg8::GroupedOrder, true, true>((PG8_LAS unsigned char*)lds_raw, g, S, E); }
    grid.sync();
    ph_moe_final(YP, TOKROW, IN(8), mod, out);
}

extern "C" void kernel_launch(void* const* d_in, const int* in_sizes, int n_in, void* d_out, int out_size, void* d_ws, size_t ws_size,
                              hipStream_t stream) {
    static int grid_blocks = 0;
    if (!grid_blocks) {
        int dev = 0, cus = 0, per_cu = 0;
        (void)hipGetDevice(&dev);
        (void)hipDeviceGetAttribute(&cus, hipDeviceAttributeMultiprocessorCount, dev);
        (void)hipFuncSetAttribute((const void*)mega_fwd, hipFuncAttributeMaxDynamicSharedMemorySize, LDS_BYTES);
        (void)hipOccupancyMaxActiveBlocksPerMultiprocessor(&per_cu, (const void*)mega_fwd, NT, LDS_BYTES);
        if (per_cu < 1) { fprintf(stderr, "occupancy query returned %d\n", per_cu); per_cu = 1; }
        grid_blocks = cus * per_cu;
    }
    Params p{};
    for (int i = 0; i < 29; ++i) p.in[i] = (const float*)d_in[i];
    p.pos = (const int*)d_in[2];
    p.out = (float*)d_out;
    p.ws = (char*)d_ws;
    void* args[] = {&p};
    hipError_t e = hipLaunchCooperativeKernel((void*)mega_fwd, dim3(grid_blocks), dim3(NT), args, LDS_BYTES, stream);
    if (e != hipSuccess) fprintf(stderr, "cooperative launch failed: %s (grid %d)\n", hipGetErrorString(e), grid_blocks);
}
```

```cpp
#include <hip/hip_runtime.h>
#include <hip/hip_cooperative_groups.h>
#include <stdint.h>
#include <math.h>
#include <cstdio>
namespace cg = cooperative_groups;

constexpr int D = 1024, NB = 8, SEQ = 2048, M = NB * SEQ;
constexpr int SSD_H = 8, SSD_P = 64, SSD_INNER = 512, SSD_G = 2, SSD_N = 128, SSD_XBC = 1024;
constexpr int MLA_H = 8, NOPE = 64, ROPE = 32, QK = 96, VD = 64, QR = 256, KVR = 128;
constexpr int NIN = 1960;
constexpr int NU = 2048;
constexpr int OFF_Z = 0, OFF_XBC = 512, OFF_CQ = 1536, OFF_CKV = 1792, OFF_KR = 1920, OFF_DT = 1952;
constexpr int NEXP = 32, FF = 256;
constexpr float EPS = 1e-6f;
constexpr int NT = 512;
constexpr int LDS_BYTES = 152 * 1024;

typedef unsigned short bf16;
__device__ __forceinline__ float bf2f(bf16 v) { return __uint_as_float((unsigned)v << 16); }
__device__ __forceinline__ unsigned f2bf(float f) { unsigned u = __float_as_uint(f); return (u + 0x7fffu + ((u >> 16) & 1u)) >> 16; }
__device__ __forceinline__ unsigned pk2(float lo, float hi) { return f2bf(lo) | (f2bf(hi) << 16); }
typedef unsigned v4u __attribute__((ext_vector_type(4)));
typedef float f32x4v __attribute__((ext_vector_type(4)));

struct Params {
    const float* in[29];
    const int* pos;
    float* out;
    char* ws;
};

__device__ __forceinline__ float ldf(const float* p) { return *p; }
__device__ __forceinline__ float ldf(const bf16* p) { return bf2f(*p); }
extern __shared__ __attribute__((aligned(16))) unsigned char lds_raw[];
constexpr int WTAB_OFF = 152 * 1024 - 256;
__device__ __forceinline__ int hw_wave_key() { int k; asm volatile("s_getreg_b32 %0, hwreg(HW_REG_HW_ID, 0, 6)" : "=s"(k)); return k; }
__device__ __forceinline__ void tidx_init() { const int key = hw_wave_key(); ((volatile __attribute__((address_space(3))) int*)(lds_raw + WTAB_OFF))[key] = (int)(threadIdx.x >> 6); __syncthreads(); }
__device__ __forceinline__ int tidx() {
    const int key = hw_wave_key();
    int w = ((volatile __attribute__((address_space(3))) int*)(lds_raw + WTAB_OFF))[key];
    w = __builtin_amdgcn_readfirstlane(w);
    unsigned ones = ~0u; asm volatile("" : "+s"(ones));
    int t = w * 64 + (int)__builtin_amdgcn_mbcnt_hi(ones, __builtin_amdgcn_mbcnt_lo(ones, 0u));
    asm volatile("" : "+v"(t)); return t; }
typedef const __attribute__((address_space(4))) Params* KArgs;
__device__ __forceinline__ KArgs kargs() { KArgs p = (KArgs)__builtin_amdgcn_kernarg_segment_ptr(); asm volatile("" : "+s"(p)); return p; }
#define IN(i) (kargs()->in[i])
__device__ __forceinline__ float silu_f(float v) { return v / (1.f + expf(-v)); }
__device__ __forceinline__ float wave_sum(float v) {
#pragma unroll
    for (int o = 32; o > 0; o >>= 1) v += __shfl_xor(v, o);
    return v;
}

namespace pg8 {
#define PG8_LAS __attribute__((address_space(3)))
typedef unsigned short bf16_t;
typedef short bf16x8 __attribute__((ext_vector_type(8)));
typedef float f32x4 __attribute__((ext_vector_type(4)));
typedef unsigned u32x4 __attribute__((ext_vector_type(4)));
constexpr int BM = 256, BK = 64, HALF = 128, HTB = HALF * BK * 2  , STAGE_BYTES = 8 * HTB, NXCD = 8, WGM = 8;

__host__ __device__ __forceinline__ int lds_byte(int r, int c) { const int st = (r >> 4) * 2 + (c >> 5), rr = r & 15, cc = c & 31, ob = rr * 64 + cc * 2; return st * 1024 + (ob ^ (((ob >> 9) & 1) << 5)); }
__host__ __device__ __forceinline__ void stage_rc(int b, int& R, int& C) { const int st = b / 1024, sb = b % 1024, swz = sb ^ (((sb >> 9) & 1) << 5); R = (st >> 1) * 16 + swz / 64; C = (st & 1) * 32 + (swz % 64) / 2; }
__host__ __device__ __forceinline__ int perm32(int rho) { const int n = rho >> 4, i = rho & 15; return 8 * (i >> 2) + 4 * n + (i & 3); }

struct Unit { int pm, pn; };
struct Gemm { const bf16_t* A; const bf16_t* Bt; int M, N, K; };

struct StaticOrder {
    int nM, nN, nwg, G, c;
    __host__ __device__ void init(int M, int N, int G_, int c_) { nM = M / BM; nN = N / BM; nwg = nM * nN; G = G_; c = c_; }
    __host__ __device__ bool next(int i, Unit& u) const {
        const long L = (long)i * G + c; if (L >= nwg) return false;
        int wgid = (int)L; { const int q = nwg / NXCD, r = nwg % NXCD, xcd = wgid % NXCD, off = wgid / NXCD; wgid = (xcd < r ? xcd * (q + 1) : r * (q + 1) + (xcd - r) * q) + off; }
        const int nig = WGM * nN, gid = wgid / nig, fm = gid * WGM, gsz = (nM - fm) < WGM ? (nM - fm) : WGM;
        u.pm = fm + ((wgid % nig) % gsz); u.pn = (wgid % nig) / gsz; return true;
    }
    __device__ __forceinline__ void a_ready(const Unit&) const {}
    __device__ __forceinline__ void done(const Unit&) const {}
};


template <int ACT> struct EpiBf16 {
    static constexpr bool PERM = true, AFTER_DRAIN = false;
    bf16_t* O; int ldc;
    __device__ __forceinline__ void operator()(const f32x4 (&acc)[2][2][4][2], const Unit& u, int wr, int wc, int fr, int fq) const {
        { const int l_ = tidx() & 63; fr = l_ & 15; fq = l_ >> 4; }
        const int row0 = u.pm * BM + wr * 64 + fr; const int col0 = u.pn * BM + wc * 32 + 8 * fq;
#pragma unroll
        for (int ai = 0; ai < 2; ++ai)
#pragma unroll
            for (int m = 0; m < 4; ++m) { bf16_t* rowp = O + (size_t)(row0 + ai * HALF + m * 16) * ldc + col0;
#pragma unroll
                for (int bj = 0; bj < 2; ++bj) { const f32x4 v0 = acc[ai][bj][m][0], v1 = acc[ai][bj][m][1];
                    u32x4 w; w.x = pk2(v0[0], v0[1]); w.y = pk2(v0[2], v0[3]); w.z = pk2(v1[0], v1[1]); w.w = pk2(v1[2], v1[3]);
                    *(u32x4*)(rowp + bj * HALF) = w; } }
    }
};

struct EpiQ {
    static constexpr bool PERM = true, AFTER_DRAIN = false;
    bf16_t* Q; const float* COS; const float* SIN;
    __device__ __forceinline__ void operator()(const f32x4 (&acc)[2][2][4][2], const Unit& u, int wr, int wc, int fr, int fq) const {
        { const int l_ = tidx() & 63; fr = l_ & 15; fq = l_ >> 4; }
        const int row0 = u.pm * BM + wr * 64 + fr;
#pragma unroll
        for (int bj = 0; bj < 2; ++bj) {
            const int colg = u.pn * BM + bj * HALF + wc * 32;
            const bool pe = ((colg >> 5) % 3) == 2;
#pragma unroll
            for (int ai = 0; ai < 2; ++ai)
#pragma unroll
                for (int m = 0; m < 4; ++m) {
                    const int row = row0 + ai * HALF + m * 16;
                    f32x4 v0 = acc[ai][bj][m][0], v1 = acc[ai][bj][m][1];
                    if (pe) {
                        f32x4 w0, w1;
#pragma unroll
                        for (int e = 0; e < 4; ++e) { w0[e] = __shfl_xor(v0[e], 32); w1[e] = __shfl_xor(v1[e], 32); }
                        const f32x4* cp = (const f32x4*)(COS + (size_t)row * 16 + (fq & 1) * 8); const f32x4* sp = (const f32x4*)(SIN + (size_t)row * 16 + (fq & 1) * 8);
                        const f32x4 c0 = cp[0], c1 = cp[1], s0 = sp[0], s1 = sp[1];
                        const float sg = (fq < 2) ? -1.f : 1.f;
                        v0 = v0 * c0 + w0 * s0 * sg; v1 = v1 * c1 + w1 * s1 * sg;
                    }
                    u32x4 w; w.x = pk2(v0[0], v0[1]); w.y = pk2(v0[2], v0[3]); w.z = pk2(v1[0], v1[1]); w.w = pk2(v1[2], v1[3]);
                    *(u32x4*)(Q + (size_t)row * 768 + colg + 8 * fq) = w;
                    if (pe) asm volatile("" ::: "memory");
                }
        }
    }
};
struct EpiKV {
    static constexpr bool PERM = true, AFTER_DRAIN = false;
    bf16_t* KF; bf16_t* VT;
    __device__ __forceinline__ void operator()(const f32x4 (&acc)[2][2][4][2], const Unit& u, int wr, int wc, int fr, int fq) const {
        { const int l_ = tidx() & 63; fr = l_ & 15; fq = l_ >> 4; }
        const int row0 = u.pm * BM + wr * 64 + fr;
#pragma unroll
        for (int bj = 0; bj < 2; ++bj) {
            const int colg = u.pn * BM + bj * HALF + wc * 32; const int h = colg >> 7, j0 = (colg & 127) + 8 * fq;
#pragma unroll
            for (int ai = 0; ai < 2; ++ai)
#pragma unroll
                for (int m = 0; m < 4; ++m) {
                    const int t = row0 + ai * HALF + m * 16; const int b = t >> 11, sq = t & 2047, tile = sq >> 6, key = sq & 63;
                    const size_t base = (size_t)((b * 8 + h) * 32 + tile);
                    bf16_t* dst = (j0 < 64) ? KF + base * 6144 + (j0 >> 3) * 512 + key * 8 : VT + base * 4096 + ((j0 - 64) >> 5) * 2048 + key * 32 + ((j0 - 64) & 31);
                    const f32x4 v0 = acc[ai][bj][m][0], v1 = acc[ai][bj][m][1];
                    u32x4 w; w.x = pk2(v0[0], v0[1]); w.y = pk2(v0[2], v0[3]); w.z = pk2(v1[0], v1[1]); w.w = pk2(v1[2], v1[3]);
                    *(u32x4*)dst = w;
                }
        }
    }
};

struct GroupedOrder {
    const PG8_LAS int* tp; int NCT, G, c;
    __device__ __forceinline__ bool next(int i, Unit& u) const {
        const int L = i * G + c, total = tp[32] * NCT; if (L >= total) return false;
        const int rtg = L / NCT, ct = L - rtg * NCT; int e = 0;
        for (int j = 1; j < 32; ++j) e += (tp[j] <= rtg) ? 1 : 0;
        u.pm = rtg; u.pn = e * NCT + ct; return true;
    }
    __device__ __forceinline__ void a_ready(const Unit&) const {}
    __device__ __forceinline__ void done(const Unit&) const {}
};
struct EpiGU {
    static constexpr bool PERM = true, AFTER_DRAIN = false;
    bf16_t* HID; const float* ROWW;
    __device__ __forceinline__ void operator()(const f32x4 (&acc)[2][2][4][2], const Unit& u, int wr, int wc, int fr, int fq) const {
        { const int l_ = tidx() & 63; fr = l_ & 15; fq = l_ >> 4; }
        const int row0 = u.pm * BM + wr * 64 + fr; const int col0 = (u.pn & 1) * 128 + wc * 32 + 8 * fq;
#pragma unroll
        for (int ai = 0; ai < 2; ++ai)
#pragma unroll
            for (int m = 0; m < 4; ++m) { const int row = row0 + ai * HALF + m * 16; const float w = ROWW[row];
                float hv[8];
#pragma unroll
                for (int n = 0; n < 2; ++n)
#pragma unroll
                    for (int e = 0; e < 4; ++e) { const float g = acc[ai][0][m][n][e], up = acc[ai][1][m][n][e]; hv[4 * n + e] = g * __builtin_amdgcn_rcpf(1.f + __expf(-g)) * up * w; }
                u32x4 o; o.x = pk2(hv[0], hv[1]); o.y = pk2(hv[2], hv[3]); o.z = pk2(hv[4], hv[5]); o.w = pk2(hv[6], hv[7]);
                *(u32x4*)(HID + (size_t)row * 256 + col0) = o; }
    }
};
struct EpiDown {
    static constexpr bool PERM = true, AFTER_DRAIN = false;
    bf16_t* YP;
    __device__ __forceinline__ void operator()(const f32x4 (&acc)[2][2][4][2], const Unit& u, int wr, int wc, int fr, int fq) const {
        { const int l_ = tidx() & 63; fr = l_ & 15; fq = l_ >> 4; }
        const int row0 = u.pm * BM + wr * 64 + fr; const int col0 = (u.pn & 3) * BM + wc * 32 + 8 * fq;
#pragma unroll
        for (int ai = 0; ai < 2; ++ai)
#pragma unroll
            for (int m = 0; m < 4; ++m) { bf16_t* rowp = YP + (size_t)(row0 + ai * HALF + m * 16) * 1024 + col0;
#pragma unroll
                for (int bj = 0; bj < 2; ++bj) { const f32x4 v0 = acc[ai][bj][m][0], v1 = acc[ai][bj][m][1];
                    u32x4 w; w.x = pk2(v0[0], v0[1]); w.y = pk2(v0[2], v0[3]); w.z = pk2(v1[0], v1[1]); w.w = pk2(v1[2], v1[3]);
                    *(u32x4*)(rowp + bj * HALF) = w; } }
    }
};
template <class Epi, class Sched, bool ALIGN_EPI = false, bool SP2 = false>
__device__ __forceinline__ void gemm_phase(PG8_LAS unsigned char* lds, const Gemm g, const Sched& S, const Epi& E) {
    const int tid = tidx(), wid = __builtin_amdgcn_readfirstlane(tid >> 6), lane = tid & 63, wr = wid >> 2, wc = wid & 3, fr = lane & 15, fq = lane >> 4;
    const int K = g.K, nt = K / BK;
    unsigned voffA[2], voffB[2];
#pragma unroll
    for (int i = 0; i < 2; ++i) { int R, C; stage_rc(tid * 16 + i * 8192, R, C); const int Rb = Epi::PERM ? ((R & ~31) + perm32(R & 31)) : R;
        voffA[i] = (unsigned)(R * K + C) * 2u; voffB[i] = (unsigned)(Rb * K + C) * 2u; }
    const size_t kstep = (size_t)(BK * 2);
    const size_t hstep = (size_t)HALF * K * 2;
    const size_t tstep = 2 * hstep;
    const unsigned ldsw = (unsigned)wid * 1024u;
    const int aoff = lds_byte(wr * 64 + fr, fq * 8), boff = lds_byte(wc * 32 + fr, fq * 8);
#define PG8_SA(b, h) (((b) * 2 + (h)) * HTB)
#define PG8_SB(b, h) ((4 + (b) * 2 + (h)) * HTB)
#define PG8_STAGE(bufoff, gbase, voff) do { _Pragma("unroll") for (int _i = 0; _i < 2; ++_i) \
        __builtin_amdgcn_global_load_lds((const unsigned*)((const char*)(gbase) + (voff)[_i]), (PG8_LAS unsigned*)(lds + (bufoff) + ldsw + _i * 8192), 16, 0, 0); } while (0)
#define PG8_LDA(dst, b, h) do { _Pragma("unroll") for (int m = 0; m < 4; ++m) _Pragma("unroll") for (int k = 0; k < 2; ++k) dst[m][k] = *(const PG8_LAS bf16x8*)(lds + PG8_SA(b, h) + aoff + m * 2048 + k * 1024); } while (0)
#define PG8_LDB(dst, b, h) do { _Pragma("unroll") for (int n = 0; n < 2; ++n) _Pragma("unroll") for (int k = 0; k < 2; ++k) dst[n][k] = *(const PG8_LAS bf16x8*)(lds + PG8_SB(b, h) + boff + n * 2048 + k * 1024); } while (0)
#define PG8_MMA(ai, bj, At, Bt) do { __builtin_amdgcn_s_setprio(1); _Pragma("unroll") for (int m = 0; m < 4; ++m) _Pragma("unroll") for (int n = 0; n < 2; ++n) _Pragma("unroll") for (int k = 0; k < 2; ++k) \
        acc[ai][bj][m][n] = __builtin_amdgcn_mfma_f32_16x16x32_bf16(Bt[n][k], At[m][k], acc[ai][bj][m][n], 0, 0, 0); __builtin_amdgcn_s_setprio(0); } while (0)
#define PG8_WAIT_V(n) asm volatile("s_waitcnt vmcnt(" #n ")" ::: "memory")
#define PG8_WAIT_L(n) asm volatile("s_waitcnt lgkmcnt(" #n ")" ::: "memory")
#define PG8_BAR __builtin_amdgcn_s_barrier()
#define PG8_SCHED __builtin_amdgcn_sched_barrier(0)
    Unit cur, nxt; int ui = 0;
    if (!S.next(0, cur)) return;
    f32x4 acc[2][2][4][2];
#pragma unroll
    for (int a = 0; a < 2; ++a)
#pragma unroll
        for (int b = 0; b < 2; ++b)
#pragma unroll
            for (int m = 0; m < 4; ++m)
#pragma unroll
                for (int n = 0; n < 2; ++n) acc[a][b][m][n] = (f32x4){0.f, 0.f, 0.f, 0.f};
    bf16x8 At[4][2], B0[2][2], B1[2][2];
    const char* cA = (const char*)g.A + (size_t)cur.pm * tstep; const char* cB = (const char*)g.Bt + (size_t)cur.pn * tstep;
    S.a_ready(cur);
    if constexpr (SP2) {
        PG8_STAGE(PG8_SB(0, 0), cB, voffB); PG8_STAGE(PG8_SB(0, 1), cB + hstep, voffB); PG8_STAGE(PG8_SA(0, 0), cA, voffA); PG8_STAGE(PG8_SA(0, 1), cA + hstep, voffA);
        if (wr == 1) PG8_BAR;
        PG8_WAIT_V(2); PG8_BAR;
        PG8_STAGE(PG8_SB(1, 0), cB + kstep, voffB); PG8_STAGE(PG8_SA(1, 0), cA + kstep, voffA); PG8_STAGE(PG8_SB(1, 1), cB + hstep + kstep, voffB);
        PG8_WAIT_V(6); PG8_BAR;
    } else {
        PG8_STAGE(PG8_SB(0, 0), cB, voffB); PG8_STAGE(PG8_SA(0, 0), cA, voffA); PG8_STAGE(PG8_SB(0, 1), cB + hstep, voffB); PG8_STAGE(PG8_SA(0, 1), cA + hstep, voffA);
        if (wr == 1) PG8_BAR;
        PG8_WAIT_V(4); PG8_BAR;
        PG8_STAGE(PG8_SB(1, 0), cB + kstep, voffB); PG8_STAGE(PG8_SA(1, 0), cA + kstep, voffA); PG8_STAGE(PG8_SB(1, 1), cB + hstep + kstep, voffB);
        PG8_WAIT_V(6); PG8_BAR;
    }
    for (;;) {
        const bool has_next = S.next(ui + 1, nxt);
        const char* nA = has_next ? (const char*)g.A + (size_t)nxt.pm * tstep : cA; const char* nB = has_next ? (const char*)g.Bt + (size_t)nxt.pn * tstep : cB;
        for (int t = 0; t < nt; t += 2) {
            const bool last = (t == nt - 2);
            const char* a1 = cA + (size_t)(t + 1) * kstep;
            const char* a2 = last ? nA : cA + (size_t)(t + 2) * kstep; const char* b2 = last ? nB : cB + (size_t)(t + 2) * kstep;
            const char* a3 = a2 + kstep; const char* b3 = b2 + kstep;
            if (last && has_next) S.a_ready(nxt);
            if constexpr (SP2) {
            PG8_LDB(B0, 0, 0); PG8_LDB(B1, 0, 1); PG8_SCHED; PG8_LDA(At, 0, 0); PG8_STAGE(PG8_SA(1, 1), a1 + hstep, voffA);
            PG8_WAIT_V(8); PG8_WAIT_L(0); PG8_BAR; PG8_MMA(0, 0, At, B0); PG8_MMA(0, 1, At, B1); PG8_BAR; PG8_SCHED;
            PG8_LDA(At, 0, 1); PG8_STAGE(PG8_SB(0, 0), b2, voffB); PG8_STAGE(PG8_SB(0, 1), b2 + hstep, voffB); PG8_STAGE(PG8_SA(0, 0), a2, voffA);
            PG8_WAIT_V(8); PG8_WAIT_L(0); PG8_BAR; PG8_MMA(1, 0, At, B0); PG8_MMA(1, 1, At, B1); PG8_BAR; PG8_SCHED;
            PG8_LDB(B0, 1, 0); PG8_LDB(B1, 1, 1); PG8_SCHED; PG8_LDA(At, 1, 0); PG8_STAGE(PG8_SA(0, 1), a2 + hstep, voffA);
            PG8_WAIT_V(8); PG8_WAIT_L(0); PG8_BAR; PG8_MMA(0, 0, At, B0); PG8_MMA(0, 1, At, B1); PG8_BAR; PG8_SCHED;
            PG8_LDA(At, 1, 1); PG8_STAGE(PG8_SB(1, 0), b3, voffB); PG8_STAGE(PG8_SB(1, 1), b3 + hstep, voffB); PG8_STAGE(PG8_SA(1, 0), a3, voffA);
            PG8_WAIT_V(8); PG8_WAIT_L(0); PG8_BAR; PG8_MMA(1, 0, At, B0); PG8_MMA(1, 1, At, B1); PG8_BAR; PG8_SCHED;
            } else {
            PG8_LDB(B0, 0, 0); PG8_SCHED; PG8_LDA(At, 0, 0); PG8_STAGE(PG8_SA(1, 1), a1 + hstep, voffA);
            PG8_WAIT_L(8); PG8_BAR; PG8_WAIT_L(0); PG8_MMA(0, 0, At, B0); PG8_BAR; PG8_SCHED;
            PG8_LDB(B1, 0, 1); PG8_STAGE(PG8_SB(0, 0), b2, voffB);
            PG8_BAR; PG8_WAIT_L(0); PG8_MMA(0, 1, At, B1); PG8_BAR;
            PG8_LDA(At, 0, 1); PG8_STAGE(PG8_SA(0, 0), a2, voffA);
            PG8_BAR; PG8_WAIT_L(0); PG8_MMA(1, 0, At, B0); PG8_BAR; PG8_SCHED;
            PG8_STAGE(PG8_SB(0, 1), b2 + hstep, voffB);
            PG8_WAIT_V(6); PG8_BAR; PG8_MMA(1, 1, At, B1); PG8_BAR;
            PG8_LDB(B0, 1, 0); PG8_SCHED; PG8_LDA(At, 1, 0); PG8_STAGE(PG8_SA(0, 1), a2 + hstep, voffA);
            PG8_WAIT_L(8); PG8_BAR; PG8_WAIT_L(0); PG8_MMA(0, 0, At, B0); PG8_BAR; PG8_SCHED;
            PG8_LDB(B1, 1, 1); PG8_STAGE(PG8_SB(1, 0), b3, voffB);
            PG8_BAR; PG8_WAIT_L(0); PG8_MMA(0, 1, At, B1); PG8_BAR;
            PG8_LDA(At, 1, 1); PG8_STAGE(PG8_SA(1, 0), a3, voffA);
            PG8_BAR; PG8_WAIT_L(0); PG8_MMA(1, 0, At, B0); PG8_BAR; PG8_SCHED;
            PG8_STAGE(PG8_SB(1, 1), b3 + hstep, voffB);
            PG8_WAIT_V(6); PG8_BAR; PG8_MMA(1, 1, At, B1); PG8_BAR;
            }
        }
        if constexpr (ALIGN_EPI) { if (wr == 0) PG8_BAR; }
        if constexpr (!Epi::AFTER_DRAIN) { E(acc, cur, wr, wc, fr, fq); S.done(cur); }
        if (!has_next) break;
#pragma unroll
        for (int a = 0; a < 2; ++a)
#pragma unroll
            for (int b = 0; b < 2; ++b)
#pragma unroll
                for (int m = 0; m < 4; ++m)
#pragma unroll
                    for (int n = 0; n < 2; ++n) acc[a][b][m][n] = (f32x4){0.f, 0.f, 0.f, 0.f};
        cur = nxt; cA = nA; cB = nB; ++ui;
        if constexpr (ALIGN_EPI) { if (wr == 1) PG8_BAR; }
    }
    PG8_WAIT_V(0);
    if constexpr (!ALIGN_EPI) { if (wr == 0) PG8_BAR; }
    PG8_BAR;
    if constexpr (Epi::AFTER_DRAIN) { E.fused(acc, cur, wr, wc, fr, fq, lds, wid, lane); S.done(cur); }
#undef PG8_SA
#undef PG8_SB
#undef PG8_STAGE
#undef PG8_LDA
#undef PG8_LDB
#undef PG8_MMA
#undef PG8_WAIT_V
#undef PG8_WAIT_L
#undef PG8_BAR
#undef PG8_SCHED
}
}


template <class ColFn, class GainFn>
__device__ __forceinline__ void transpose_item(const float* src, int ldsrc, int Kreal, ColFn colfn, GainFn gain, bf16* dst, int K, int k0, int n0, float* scr, int lane) {
    const int n = n0 + (lane & 31); const int c = colfn(n);
#pragma unroll 8
    for (int i = 0; i < 32; ++i) { const int kk = 2 * i + (lane >> 5), k = k0 + kk;
        float v = 0.f; if (c >= 0 && k < Kreal) v = src[(size_t)k * ldsrc + c] * gain(k);
        scr[kk * 33 + (lane & 31)] = v; }
    asm volatile("s_waitcnt lgkmcnt(0)" ::: "memory");
    const int c8 = lane & 7;
#pragma unroll
    for (int j = 0; j < 4; ++j) { const int nn = (lane >> 3) + 8 * j; const float* s = scr + (8 * c8) * 33 + nn;
        v4u o; o.x = pk2(s[0 * 33], s[1 * 33]); o.y = pk2(s[2 * 33], s[3 * 33]); o.z = pk2(s[4 * 33], s[5 * 33]); o.w = pk2(s[6 * 33], s[7 * 33]);
        *(v4u*)(dst + (size_t)(n0 + nn) * K + k0 + 8 * c8) = o; }
    asm volatile("s_waitcnt lgkmcnt(0)" ::: "memory");
}
__device__ __forceinline__ int win_col(int n) {
    if (n < 1536) return n;
    if (n < 1792) return n - 1536 + 1544;
    if (n < 1920) return n - 1792 + 1800;
    if (n < 1952) return n - 1920 + 1928;
    if (n < 1960) return n - 1952 + 1536;
    return -1;
}
__device__ void ph_prep(float* lds, float* mod, bf16* WIN_T, bf16* WOUT_T, bf16* WUQ_T, bf16* WUKV_T, bf16* WGU_T, bf16* WD_T, bf16* WRF, int* CNT) {
    const int tid = tidx(), lane = tid & 63, wave = tid >> 6;
    if (blockIdx.x < 6 * D / 64) {
        float* sc = lds;
        float* part = lds + 8 * D;
        const float* c = IN(1); const float* ada_w = IN(3); const float* ada_b = IN(4);
        for (int i = tid; i < NB * D; i += NT) sc[i] = silu_f(c[i]);
        __syncthreads();
        const int j = blockIdx.x * 64 + lane;
        float acc[NB];
#pragma unroll
        for (int b = 0; b < NB; ++b) acc[b] = 0.f;
        for (int k = wave * 128; k < wave * 128 + 128; ++k) {
            const float w = ada_w[(size_t)k * 6 * D + j];
#pragma unroll
            for (int b = 0; b < NB; ++b) acc[b] += sc[b * D + k] * w;
        }
#pragma unroll
        for (int b = 0; b < NB; ++b) part[(wave * NB + b) * 64 + lane] = acc[b];
        __syncthreads();
        { const int b = tid >> 6;
          float s = ada_b[j];
#pragma unroll
          for (int w = 0; w < 8; ++w) s += part[(w * NB + b) * 64 + lane];
          mod[b * 6 * D + j] = s; }
        __syncthreads();
    }
    float* scr = lds + wave * (64 * 33);
    const int gw = (gridDim.x - 1 - blockIdx.x) * (NT / 64) + wave, ngw = gridDim.x * (NT / 64);
    constexpr int I_IN = (D / 64) * (NU / 32), I_OUT = (D / 64) * (D / 32), I_UQ = (QR / 64) * (768 / 32), I_UKV = (256 / 64) * (1024 / 32);
    const float* ssd_norm = IN(15); const float* q_norm = IN(16); const float* kv_norm = IN(18); const float* mla_norm = IN(20);
    if (blockIdx.x == 0 && tid < 64) CNT[tid] = 0;
    for (int ch = blockIdx.x * NT + tid; ch < 32 * 3 * 64; ch += gridDim.x * NT) {
        const int ln = ch & 63, cb = (ch >> 6) % 3, sk = ch / 192; const int col = 16 * cb + (ln & 15);
        const float* wgr = IN(22); const float* wer = IN(24);
        unsigned hi4[4], lo4[4];
#pragma unroll
        for (int j = 0; j < 8; j += 2) { float v[2];
#pragma unroll
            for (int q = 0; q < 2; ++q) { const int k = 32 * sk + 8 * (ln >> 4) + j + q; v[q] = (col < 4) ? wgr[k * 4 + col] : (col < 36 ? wer[k * 32 + col - 4] : 0.f); }
            const unsigned h0 = f2bf(v[0]), h1 = f2bf(v[1]);
            hi4[j >> 1] = h0 | (h1 << 16); lo4[j >> 1] = pk2(v[0] - __uint_as_float(h0 << 16), v[1] - __uint_as_float(h1 << 16)); }
        v4u* dst = (v4u*)(WRF + ((size_t)(sk * 3 + cb) * 2) * 512 + ln * 8);
        dst[0] = (v4u){hi4[0], hi4[1], hi4[2], hi4[3]}; dst[64] = (v4u){lo4[0], lo4[1], lo4[2], lo4[3]};
    }
    constexpr int I_GU = NEXP * (D / 64) * (512 / 32), I_DN = NEXP * (FF / 64) * (D / 32);
    for (int it = gw; it < I_IN + I_OUT + I_UQ + I_UKV + I_GU + I_DN; it += ngw) {
        int r = it;
        if (r < I_IN) { const int nb = NU / 32; transpose_item(IN(9), NIN, D, [](int n) { return win_col(n); }, [](int) { return 1.f; }, WIN_T, D, (r / nb) * 64, (r % nb) * 32, scr, lane); continue; }
        r -= I_IN;
        if (r < I_OUT) { const int nb = D / 32; transpose_item(IN(21), D, D, [](int n) { return n; }, [=](int k) { return k < 512 ? ssd_norm[k] : mla_norm[k - 512]; }, WOUT_T, D, (r / nb) * 64, (r % nb) * 32, scr, lane); continue; }
        r -= I_OUT;
        if (r < I_UQ) { const int nb = 768 / 32; transpose_item(IN(17), 768, QR, [](int n) { return n; }, [=](int k) { return q_norm[k] * 0.14724444f; }, WUQ_T, QR, (r / nb) * 64, (r % nb) * 32, scr, lane); continue; }
        r -= I_UQ;
        if (r >= I_UQ + I_UKV - I_UQ) {
            r -= I_UKV;
            if (r < I_GU) { const int e = r / 256, q = r % 256, kb = q / 16, nb = q % 16;
                const int ct = nb >> 3, rr = (nb & 7) * 32; const float* src = (rr < 128 ? IN(26) : IN(27)) + (size_t)e * D * FF; const int cbase = 128 * ct + (rr & 127) - 32 * nb;
                transpose_item(src, FF, D, [=](int n) { return n + cbase; }, [](int) { return 1.f; }, WGU_T + (size_t)e * 512 * D, D, kb * 64, nb * 32, scr, lane); continue; }
            r -= I_GU;
            { const int e = r / 128, q = r % 128, kb = q / 32, nb = q % 32;
              transpose_item(IN(28) + (size_t)e * FF * D, D, FF, [](int n) { return n; }, [](int) { return 1.f; }, WD_T + (size_t)e * D * FF, FF, kb * 64, nb * 32, scr, lane); continue; }
        }
        { const int nb = 1024 / 32; transpose_item(IN(19), 1024, KVR, [](int n) { return n; }, [=](int k) { return k < KVR ? kv_norm[k] : 0.f; }, WUKV_T, 256, (r / nb) * 64, (r % nb) * 32, scr, lane); }
    }
}

__device__ void ph_prenorm_bf16(const float* in, const float* g, const float* mod, int sh_off, int sc_off, bf16* out) {
    const int lane = tidx() & 63, gw = blockIdx.x * (NT / 64) + (tidx() >> 6), ngw = gridDim.x * (NT / 64);
    for (int t = gw; t < M; t += ngw) {
        const int b = t / SEQ; const f32x4v* r = (const f32x4v*)(in + (size_t)t * D) + lane;
        f32x4v v[4]; float s = 0.f;
#pragma unroll
        for (int j = 0; j < 4; ++j) { v[j] = r[64 * j]; s += (v[j].x * v[j].x + v[j].y * v[j].y) + (v[j].z * v[j].z + v[j].w * v[j].w); }
        const float inv = rsqrtf(wave_sum(s) / D + EPS);
        const f32x4v* gp = (const f32x4v*)g + lane; const f32x4v* scp = (const f32x4v*)(mod + b * 6 * D + sc_off) + lane; const f32x4v* shp = (const f32x4v*)(mod + b * 6 * D + sh_off) + lane;
        unsigned long long* o8 = (unsigned long long*)(out + (size_t)t * D) + lane;
#pragma unroll
        for (int j = 0; j < 4; ++j) { const f32x4v gg = gp[64 * j], sc = scp[64 * j], sh = shp[64 * j];
            const f32x4v h = v[j] * inv * gg * (sc + 1.f) + sh;
            o8[64 * j] = (unsigned long long)pk2(h.x, h.y) | ((unsigned long long)pk2(h.z, h.w) << 32); }
    }
}


__device__ void ph_prep2(const bf16* U, const int* pos, const float* conv_w, const float* conv_b, const float* dt_bias,
                         bf16* CQN, bf16* CKVN, bf16* KF, float* COS, float* SIN, float* DT, bf16* XC) {
    const int lane = tidx() & 63, gw = blockIdx.x * (NT / 64) + (tidx() >> 6), ngw = gridDim.x * (NT / 64);
    const int rows_per = (M + ngw - 1) / ngw;
    for (int t = gw * rows_per; t < (gw + 1) * rows_per && t < M; ++t) {
        const int sq = t & (SEQ - 1), b = t >> 11;
        const bf16* ur = U + (size_t)t * NU;
        { const uint2 w = *(const uint2*)(ur + OFF_CQ + lane * 4);
          const float a0 = __uint_as_float(w.x << 16), a1 = __uint_as_float(w.x & 0xffff0000u), a2 = __uint_as_float(w.y << 16), a3 = __uint_as_float(w.y & 0xffff0000u);
          const float inv = rsqrtf(wave_sum(a0 * a0 + a1 * a1 + a2 * a2 + a3 * a3) * (1.f / QR) + EPS);
          uint2 o; o.x = pk2(a0 * inv, a1 * inv); o.y = pk2(a2 * inv, a3 * inv);
          *(uint2*)(CQN + (size_t)t * QR + lane * 4) = o; }
        { const unsigned w = *(const unsigned*)(ur + OFF_CKV + lane * 2);
          const float a0 = __uint_as_float(w << 16), a1 = __uint_as_float(w & 0xffff0000u);
          const float inv = rsqrtf(wave_sum(a0 * a0 + a1 * a1) * (1.f / KVR) + EPS);
          *(unsigned*)(CKVN + (size_t)t * 256 + lane * 2) = pk2(a0 * inv, a1 * inv);
          *(unsigned*)(CKVN + (size_t)t * 256 + 128 + lane * 2) = 0u; }
        { const int i = lane & 15;
          const float x1 = bf2f(ur[OFF_KR + i]), x2 = bf2f(ur[OFF_KR + 16 + i]);
          const float inv = exp2f(-(float)i * (13.287712379549449f / 16.0f));
          const float ang = (float)pos[t] * inv;
          float sn, cs; sincosf(ang, &sn, &cs);
          if (lane < 16) { COS[(size_t)t * 16 + i] = cs; SIN[(size_t)t * 16 + i] = sn; }
          const float r1 = x1 * cs - x2 * sn, r2 = x2 * cs + x1 * sn;
          const int cc = lane & 3, hh = (lane >> 2) & 7;
          float e[8];
#pragma unroll
          for (int j = 0; j < 8; ++j) { const float p1 = __shfl(r1, (cc & 1) * 8 + j), p2 = __shfl(r2, (cc & 1) * 8 + j); e[j] = (cc >> 1) ? p2 : p1; }
          if (lane < 32) { v4u o; o.x = pk2(e[0], e[1]); o.y = pk2(e[2], e[3]); o.z = pk2(e[4], e[5]); o.w = pk2(e[6], e[7]);
            *(v4u*)(KF + (size_t)((b * 8 + hh) * 32 + (sq >> 6)) * 6144 + (8 + cc) * 512 + (sq & 63) * 8) = o; } }
        if (lane < 8) { const float raw = bf2f(ur[OFF_DT + lane]) + dt_bias[lane]; DT[(size_t)t * 8 + lane] = raw > 20.f ? raw : log1pf(expf(raw)); }
        { const int ch = lane * 16;
          float acc[16];
          { const f32x4v* bp = (const f32x4v*)(conv_b + ch);
#pragma unroll
            for (int q4 = 0; q4 < 4; ++q4) { const f32x4v bb = bp[q4]; acc[4 * q4] = bb.x; acc[4 * q4 + 1] = bb.y; acc[4 * q4 + 2] = bb.z; acc[4 * q4 + 3] = bb.w; } }
#pragma unroll
          for (int k = 0; k < 4; ++k) {
              if (sq - 3 + k >= 0) {
                  const v4u* xp = (const v4u*)(U + (size_t)(t - 3 + k) * NU + OFF_XBC + ch);
                  const v4u xa = xp[0], xb = xp[1];
                  const f32x4v* wp = (const f32x4v*)(conv_w + k * SSD_XBC + ch);
                  const unsigned xw[8] = {xa.x, xa.y, xa.z, xa.w, xb.x, xb.y, xb.z, xb.w};
#pragma unroll
                  for (int q4 = 0; q4 < 4; ++q4) { const f32x4v ww = wp[q4];
                      acc[4 * q4] += ww.x * __uint_as_float(xw[2 * q4] << 16); acc[4 * q4 + 1] += ww.y * __uint_as_float(xw[2 * q4] & 0xffff0000u);
                      acc[4 * q4 + 2] += ww.z * __uint_as_float(xw[2 * q4 + 1] << 16); acc[4 * q4 + 3] += ww.w * __uint_as_float(xw[2 * q4 + 1] & 0xffff0000u); }
              }
          }
          v4u o0, o1;
          o0.x = pk2(silu_f(acc[0]), silu_f(acc[1])); o0.y = pk2(silu_f(acc[2]), silu_f(acc[3])); o0.z = pk2(silu_f(acc[4]), silu_f(acc[5])); o0.w = pk2(silu_f(acc[6]), silu_f(acc[7]));
          o1.x = pk2(silu_f(acc[8]), silu_f(acc[9])); o1.y = pk2(silu_f(acc[10]), silu_f(acc[11])); o1.z = pk2(silu_f(acc[12]), silu_f(acc[13])); o1.w = pk2(silu_f(acc[14]), silu_f(acc[15]));
          { bf16* base = XC + (size_t)(t >> 7) * 131072; const int l = t & 127;
            if (ch < 512) { v4u* op = (v4u*)(base + (ch >> 6) * 8192 + ((ch & 63) >> 5) * 4096 + l * 32 + (ch & 31)); op[0] = o0; op[1] = o1; }
            else { const int c2 = ch - 512; bf16* q = base + 65536 + (c2 >> 7) * 16384 + ((c2 & 127) >> 3) * 1024 + l * 8; *(v4u*)q = o0; *(v4u*)(q + 1024) = o1; } } }
    }
}


typedef short bf16x8v __attribute__((ext_vector_type(8)));
__device__ void ph_rowrouter(float* ldsf, const bf16* Yb, const float* x, const float* post_gain, const float* pre_gain, const float* mod, const bf16* WRF,
                             const float* bgr, const float* ber, float* out, bf16* H2, int* CNT, int* RT_E, int* RT_S, float* RT_W) {
    const int tid = tidx(), lane = tid & 63, wave = tid >> 6, row = lane & 15, kg = lane >> 4;
    const int gw = blockIdx.x * (NT / 64) + wave, ngw = gridDim.x * (NT / 64);
    float* L = ldsf + wave * (16 * 48);
    for (int item = gw; item < M / 16; item += ngw) {
        const int t = item * 16 + row, b = t >> 11;
        const bf16* yr = Yb + (size_t)t * D + 8 * kg; const float* xr = x + (size_t)t * D + 8 * kg; float* orow = out + (size_t)t * D + 8 * kg;
        const float* g1 = mod + b * 6 * D + 2 * D + 8 * kg; const float* sc2 = mod + b * 6 * D + 4 * D + 8 * kg; const float* sh2 = mod + b * 6 * D + 3 * D + 8 * kg;
        float ssy = 0.f;
#pragma unroll 4
        for (int sk = 0; sk < 32; ++sk) { const v4u w = *(const v4u*)(yr + 32 * sk);
#pragma unroll
            for (int e = 0; e < 4; ++e) { const float a = __uint_as_float(w[e] << 16), c = __uint_as_float(w[e] & 0xffff0000u); ssy += a * a + c * c; } }
        ssy += __shfl_xor(ssy, 16); ssy += __shfl_xor(ssy, 32);
        const float invy = rsqrtf(ssy * (1.f / D) + EPS);
        float ss1 = 0.f;
#pragma unroll 2
        for (int sk = 0; sk < 32; ++sk) { const v4u w = *(const v4u*)(yr + 32 * sk);
            const f32x4v xa = *(const f32x4v*)(xr + 32 * sk), xb = *(const f32x4v*)(xr + 32 * sk + 4);
            const f32x4v ga = *(const f32x4v*)(g1 + 32 * sk), gb = *(const f32x4v*)(g1 + 32 * sk + 4);
            const f32x4v pa = *(const f32x4v*)(post_gain + 8 * kg + 32 * sk), pb = *(const f32x4v*)(post_gain + 8 * kg + 32 * sk + 4);
            f32x4v ya, yb; ya.x = __uint_as_float(w.x << 16); ya.y = __uint_as_float(w.x & 0xffff0000u); ya.z = __uint_as_float(w.y << 16); ya.w = __uint_as_float(w.y & 0xffff0000u);
            yb.x = __uint_as_float(w.z << 16); yb.y = __uint_as_float(w.z & 0xffff0000u); yb.z = __uint_as_float(w.w << 16); yb.w = __uint_as_float(w.w & 0xffff0000u);
            const f32x4v oa = xa + ga * (ya * invy * pa), ob = xb + gb * (yb * invy * pb);
            *(f32x4v*)(orow + 32 * sk) = oa; *(f32x4v*)(orow + 32 * sk + 4) = ob;
            ss1 += (oa.x * oa.x + oa.y * oa.y) + (oa.z * oa.z + oa.w * oa.w) + (ob.x * ob.x + ob.y * ob.y) + (ob.z * ob.z + ob.w * ob.w); }
        ss1 += __shfl_xor(ss1, 16); ss1 += __shfl_xor(ss1, 32);
        const float inv1 = rsqrtf(ss1 * (1.f / D) + EPS);
        f32x4v acc0 = {0.f, 0.f, 0.f, 0.f}, acc1 = acc0, acc2 = acc0;
        bf16* hrow = H2 + (size_t)t * D + 8 * kg;
#pragma unroll 2
        for (int sk = 0; sk < 32; ++sk) {
            const f32x4v xa = *(const f32x4v*)(orow + 32 * sk), xb = *(const f32x4v*)(orow + 32 * sk + 4);
            const f32x4v pa = *(const f32x4v*)(pre_gain + 8 * kg + 32 * sk), pb = *(const f32x4v*)(pre_gain + 8 * kg + 32 * sk + 4);
            const f32x4v ca = *(const f32x4v*)(sc2 + 32 * sk), cb = *(const f32x4v*)(sc2 + 32 * sk + 4);
            const f32x4v sa = *(const f32x4v*)(sh2 + 32 * sk), sb = *(const f32x4v*)(sh2 + 32 * sk + 4);
            const f32x4v ha = xa * inv1 * pa * (ca + 1.f) + sa, hb = xb * inv1 * pb * (cb + 1.f) + sb;
            const float hv[8] = {ha.x, ha.y, ha.z, ha.w, hb.x, hb.y, hb.z, hb.w};
            unsigned hw[4], lw[4];
#pragma unroll
            for (int e = 0; e < 4; ++e) { const unsigned h0 = f2bf(hv[2 * e]), h1 = f2bf(hv[2 * e + 1]); hw[e] = h0 | (h1 << 16);
                lw[e] = pk2(hv[2 * e] - __uint_as_float(h0 << 16), hv[2 * e + 1] - __uint_as_float(h1 << 16)); }
            const v4u hq = {hw[0], hw[1], hw[2], hw[3]}, lq = {lw[0], lw[1], lw[2], lw[3]};
            *(v4u*)(hrow + 32 * sk) = hq;
            const bf16x8v a_hi = __builtin_bit_cast(bf16x8v, hq), a_lo = __builtin_bit_cast(bf16x8v, lq);
            const v4u* bp = (const v4u*)(WRF + (size_t)(sk * 3) * 2 * 512 + lane * 8);
#define RSTEP(ACC, cb_) do { const bf16x8v bh_ = __builtin_bit_cast(bf16x8v, bp[(cb_) * 128]), bl_ = __builtin_bit_cast(bf16x8v, bp[(cb_) * 128 + 64]); \
                ACC = __builtin_amdgcn_mfma_f32_16x16x32_bf16(a_hi, bh_, ACC, 0, 0, 0); ACC = __builtin_amdgcn_mfma_f32_16x16x32_bf16(a_lo, bh_, ACC, 0, 0, 0); \
                ACC = __builtin_amdgcn_mfma_f32_16x16x32_bf16(a_hi, bl_, ACC, 0, 0, 0); } while (0)
            RSTEP(acc0, 0); RSTEP(acc1, 1); RSTEP(acc2, 2);
#undef RSTEP
        }
#pragma unroll
        for (int j = 0; j < 4; ++j) { L[(4 * kg + j) * 48 + row] = acc0[j]; L[(4 * kg + j) * 48 + 16 + row] = acc1[j]; L[(4 * kg + j) * 48 + 32 + row] = acc2[j]; }
        asm volatile("s_waitcnt lgkmcnt(0)" ::: "memory");
        if (lane < 16) {
            const float* lr = L + lane * 48;
            float mxv = -INFINITY; int gi = 0;
            for (int i = 0; i < 4; ++i) { const float v = lr[i] + bgr[i]; if (v > mxv) { mxv = v; gi = i; } }
            float den = 0.f; for (int i = 0; i < 4; ++i) den += expf(lr[i] + bgr[i] - mxv);
            const float gwt = 1.f / den;
            float v1 = -INFINITY, v2 = -INFINITY; int i1 = 0, i2 = 0;
            for (int i = 0; i < 8; ++i) { const float v = lr[4 + gi * 8 + i] + ber[gi * 8 + i];
                if (v > v1) { v2 = v1; i2 = i1; v1 = v; i1 = i; } else if (v > v2) { v2 = v; i2 = i; } }
            const float p2 = expf(v2 - v1);
            const int e1 = gi * 8 + i1, e2 = gi * 8 + i2, tt = item * 16 + lane;
            const int s1 = atomicAdd(&CNT[e1], 1), s2 = atomicAdd(&CNT[e2], 1);
            RT_E[tt] = e1 | (e2 << 8); RT_S[2 * tt] = s1; RT_S[2 * tt + 1] = s2; RT_W[2 * tt] = gwt / (1.f + p2); RT_W[2 * tt + 1] = gwt * p2 / (1.f + p2);
        }
        asm volatile("s_waitcnt lgkmcnt(0)" ::: "memory");
    }
}
__device__ __forceinline__ void moe_table(int* tp, const int* CNT) {
    const int tid = tidx();
    __syncthreads();
    if (tid < 64) { const int c = (tid < 32) ? __hip_atomic_load(CNT + tid, __ATOMIC_RELAXED, __HIP_MEMORY_SCOPE_AGENT) : 0; int v = (c + 255) >> 8;
        int inc = v;
#pragma unroll
        for (int o = 1; o < 64; o <<= 1) { const int n = __shfl_up(inc, o); if ((tid & 63) >= o) inc += n; }
        if (tid <= 32) tp[tid] = inc - v; }
    __syncthreads();
}
__device__ void ph_gather(int* tp, const bf16* H2, const int* RT_E, const int* RT_S, const float* RT_W, bf16* HG, float* ROWW, int* TOKROW) {
    const int lane = tidx() & 63, gw = blockIdx.x * (NT / 64) + (tidx() >> 6), ngw = gridDim.x * (NT / 64);
    for (int p = gw; p < 2 * M; p += ngw) { const int t = p >> 1, k = p & 1;
        const int e = (RT_E[t] >> (8 * k)) & 255; const int rowd = tp[e] * 256 + RT_S[p];
        const v4u* src = (const v4u*)(H2 + (size_t)t * D) + lane; v4u* dst = (v4u*)(HG + (size_t)rowd * D) + lane;
        dst[0] = src[0]; dst[64] = src[64];
        if (lane == 0) { ROWW[rowd] = RT_W[p]; TOKROW[p] = rowd; } }
}
__device__ void ph_moe_final(const bf16* YP, const int* TOKROW, const float* gain, const float* mod, float* out) {
    const int lane = tidx() & 63, gw = blockIdx.x * (NT / 64) + (tidx() >> 6), ngw = gridDim.x * (NT / 64);
    for (int t = gw; t < M; t += ngw) { const int b = t >> 11; const int r1 = TOKROW[2 * t], r2 = TOKROW[2 * t + 1];
        const v4u* p1 = (const v4u*)(YP + (size_t)r1 * D) + lane; const v4u* p2 = (const v4u*)(YP + (size_t)r2 * D) + lane;
        float y[16]; float ss = 0.f;
#pragma unroll
        for (int j = 0; j < 2; ++j) { const v4u a = p1[64 * j], c = p2[64 * j];
#pragma unroll
            for (int e = 0; e < 4; ++e) { const float v0 = __uint_as_float(a[e] << 16) + __uint_as_float(c[e] << 16), v1 = __uint_as_float(a[e] & 0xffff0000u) + __uint_as_float(c[e] & 0xffff0000u);
                y[8 * j + 2 * e] = v0; y[8 * j + 2 * e + 1] = v1; ss += v0 * v0 + v1 * v1; } }
        const float inv = rsqrtf(wave_sum(ss) * (1.f / D) + EPS);
#pragma unroll
        for (int j = 0; j < 2; ++j) { const int col = 512 * j + lane * 8; float* op = out + (size_t)t * D + col;
            const f32x4v g2a = *(const f32x4v*)(mod + b * 6 * D + 5 * D + col), g2b = *(const f32x4v*)(mod + b * 6 * D + 5 * D + col + 4);
            const f32x4v ga = *(const f32x4v*)(gain + col), gb = *(const f32x4v*)(gain + col + 4);
            f32x4v xa = *(f32x4v*)op, xb = *(f32x4v*)(op + 4);
            xa.x += g2a.x * (y[8 * j + 0] * inv * ga.x); xa.y += g2a.y * (y[8 * j + 1] * inv * ga.y); xa.z += g2a.z * (y[8 * j + 2] * inv * ga.z); xa.w += g2a.w * (y[8 * j + 3] * inv * ga.w);
            xb.x += g2b.x * (y[8 * j + 4] * inv * gb.x); xb.y += g2b.y * (y[8 * j + 5] * inv * gb.y); xb.z += g2b.z * (y[8 * j + 6] * inv * gb.z); xb.w += g2b.w * (y[8 * j + 7] * inv * gb.w);
            *(f32x4v*)op = xa; *(f32x4v*)(op + 4) = xb; }
    }
}
__device__ void ph_attn_ref(const bf16* Q, const bf16* KF, const bf16* VT, float* o) {
    const int lane = tidx() & 63, gw = blockIdx.x * (NT / 64) + (tidx() >> 6), ngw = gridDim.x * (NT / 64);
    for (int item = gw; item < NB * MLA_H * (SEQ / 64); item += ngw) {
        const int qb = (SEQ / 64 - 1) - item / (NB * MLA_H), bh = item % (NB * MLA_H), b = bh / MLA_H, h = bh % MLA_H;
        const int qi = qb * 64 + lane;
        const size_t t = (size_t)b * SEQ + qi;
        float qr[QK];
#pragma unroll
        for (int d = 0; d < QK; ++d) qr[d] = bf2f(Q[t * 768 + h * QK + d]);
        float acc[VD];
#pragma unroll
        for (int d = 0; d < VD; ++d) acc[d] = 0.f;
        float mx = -INFINITY, l = 0.f;
        const int kmax = qb * 64 + 63;
        for (int k = 0; k <= kmax; ++k) {
            const bf16* kt = KF + (size_t)(bh * 32 + (k >> 6)) * 6144 + (k & 63) * 8;
            const bf16* vt = VT + (size_t)(bh * 32 + (k >> 6)) * 4096 + (k & 63) * 32;
            float s = 0.f;
#pragma unroll
            for (int d = 0; d < QK; ++d) s += qr[d] * bf2f(kt[(d >> 3) * 512 + (d & 7)]);
            if (k <= qi) {
                const float mn = fmaxf(mx, s);
                const float f = exp2f(mx - mn), pv = exp2f(s - mn);
                l = l * f + pv;
#pragma unroll
                for (int d = 0; d < VD; ++d) acc[d] = acc[d] * f + pv * bf2f(vt[(d >> 5) * 2048 + (d & 31)]);
                mx = mn;
            }
        }
        const float il = 1.f / l;
#pragma unroll
        for (int d = 0; d < VD; ++d) o[t * (MLA_H * VD) + h * VD + d] = acc[d] * il;
    }
}

namespace att {
typedef short bf16x8 __attribute__((ext_vector_type(8)));
typedef short s16x4 __attribute__((ext_vector_type(4)));
typedef float f32x16 __attribute__((ext_vector_type(16)));
typedef unsigned u32x4 __attribute__((ext_vector_type(4)));
#define ALAS __attribute__((address_space(3)))
constexpr int KSLOT = 12288, VSLOT = 8192, NSLOT = 3;
constexpr int LDS_K = 0, LDS_V = NSLOT * KSLOT, LDS_WS = LDS_V + NSLOT * VSLOT, LDS_OST = LDS_WS + 8 * 256, LDS_END = LDS_OST + 8 * 4096;
constexpr float THR = 8.0f;
__device__ __forceinline__ int crow(int r, int hi) { return (r & 3) + 8 * (r >> 2) + 4 * hi; }
__device__ __forceinline__ unsigned cvtpk(float lo, float hi) { typedef float f2 __attribute__((ext_vector_type(2))); typedef __bf16 b2 __attribute__((ext_vector_type(2)));
    f2 v = {lo, hi}; b2 b = __builtin_convertvector(v, b2); return __builtin_bit_cast(unsigned, b); }
__device__ __forceinline__ s16x4 vtr(const ALAS char* p) { typedef short v4 __attribute__((ext_vector_type(4))); return __builtin_bit_cast(s16x4, __builtin_amdgcn_ds_read_tr16_b64_v4i16((ALAS v4*)p)); }
#define AWAIT_BAR(N) asm volatile("s_waitcnt vmcnt(" #N ") lgkmcnt(0)\n\ts_barrier" ::: "memory")

__device__ __forceinline__ void attn_unit(ALAS char* lds, int bh, int qb, const bf16* Q, const bf16* KF, const bf16* VT, bf16* YC, float* SSQ) {
    const int tid = tidx(), lane = tid & 63, r32 = lane & 31, hi = lane >> 5; const int wid = __builtin_amdgcn_readfirstlane(tid >> 6);
    const int b = bh >> 3, h = bh & 7;
    const char* Kt = (const char*)(KF + (size_t)bh * 32 * 6144); const char* Vt = (const char*)(VT + (size_t)bh * 32 * 4096);
    const int NTL = 4 * (qb + 1);
    bf16x8 qf[6];
    { const bf16* qp = Q + (size_t)(b * SEQ + qb * 256 + wid * 32 + r32) * 768 + h * QK + hi * 8;
#pragma unroll
      for (int d0 = 0; d0 < 6; ++d0) qf[d0] = *(const bf16x8*)(qp + d0 * 16); }
    const unsigned koff0 = wid * 1024 + lane * 16, koff1 = (8 + (wid & 3)) * 1024 + lane * 16, voff = wid * 1024 + lane * 16;
#define ADMA(t, slot) do { const char* kb_ = Kt + (size_t)(t) * KSLOT; const char* vb_ = Vt + (size_t)(t) * VSLOT; \
        __builtin_amdgcn_global_load_lds((const unsigned*)(kb_ + koff0), (ALAS unsigned*)(lds + LDS_K + (slot) * KSLOT + wid * 1024), 16, 0, 0); \
        __builtin_amdgcn_global_load_lds((const unsigned*)(kb_ + koff1), (ALAS unsigned*)(lds + LDS_K + (slot) * KSLOT + (8 + (wid & 3)) * 1024), 16, 0, 0); \
        __builtin_amdgcn_global_load_lds((const unsigned*)(vb_ + voff), (ALAS unsigned*)(lds + LDS_V + (slot) * VSLOT + wid * 1024), 16, 0, 0); } while (0)
    ADMA(0, 0); ADMA(1, 1);
    ALAS float* wsf = (ALAS float*)(lds + LDS_WS) + wid * 64;
    float mref = 0.f, l = 0.f;
    f32x16 o0 = {}, o1 = {}, negm = {};
    const int qrel = wid * 32 + r32;
    const int vlane = (4 * hi + ((lane & 15) >> 2)) * 64 + ((lane >> 4) & 1) * 32 + (lane & 3) * 8;
    int slot = 0;
    for (int t = 0; t < NTL; ++t) {
        if (t + 1 < NTL) { AWAIT_BAR(3); } else { AWAIT_BAR(0); }
        if (t + 2 < NTL) { const int s2 = (slot == 0) ? 2 : slot - 1; ADMA(t + 2, s2); }
        const ALAS char* Ks = lds + LDS_K + slot * KSLOT + hi * 1024 + r32 * 16;
        const ALAS char* Vs = lds + LDS_V + slot * VSLOT + vlane;
        f32x16 p0 = negm, p1 = negm;
#pragma unroll
        for (int d0 = 0; d0 < 6; ++d0) {
            const bf16x8 ka0 = *(const ALAS bf16x8*)(Ks + d0 * 2048), ka1 = *(const ALAS bf16x8*)(Ks + d0 * 2048 + 512);
            p0 = __builtin_amdgcn_mfma_f32_32x32x16_bf16(ka0, qf[d0], p0, 0, 0, 0);
            p1 = __builtin_amdgcn_mfma_f32_32x32x16_bf16(ka1, qf[d0], p1, 0, 0, 0);
        }
        const int jb = t - (NTL - 4);
        if (jb >= 0) {
#pragma unroll
            for (int r = 0; r < 16; ++r) { const int kv = 64 * jb + crow(r, hi); if (kv > qrel) p0[r] = -INFINITY; if (kv + 32 > qrel) p1[r] = -INFINITY; }
        }
        float rm = fmaxf(p0[0], p1[0]);
#pragma unroll
        for (int r = 1; r < 16; ++r) rm = fmaxf(rm, fmaxf(p0[r], p1[r]));
        { auto rr = __builtin_amdgcn_permlane32_swap(__float_as_uint(rm), __float_as_uint(rm), false, false); rm = fmaxf(__uint_as_float(rr[0]), __uint_as_float(rr[1])); }
        if (t == 0 || __any(rm > THR)) {
            const float dl = (t == 0) ? rm : fmaxf(rm, 0.f);
            mref += dl;
#pragma unroll
            for (int r = 0; r < 16; ++r) { p0[r] -= dl; p1[r] -= dl; }
#pragma unroll
            for (int r = 0; r < 16; ++r) negm[r] = -mref;
            const float f = exp2f(-dl); l *= f;
            if (t > 0) {
                if (hi == 0) wsf[r32] = f;
                asm volatile("s_waitcnt lgkmcnt(0)" ::: "memory");
#pragma unroll
                for (int r = 0; r < 16; ++r) { const float fr_ = wsf[crow(r, hi)]; o0[r] *= fr_; o1[r] *= fr_; }
            }
        }
        float ls = 0.f;
#pragma unroll
        for (int r = 0; r < 16; ++r) { p0[r] = exp2f(p0[r]); p1[r] = exp2f(p1[r]); ls += p0[r] + p1[r]; }
        l += ls;
        u32x4 pw0 = {cvtpk(p0[0], p0[1]), cvtpk(p0[2], p0[3]), cvtpk(p0[4], p0[5]), cvtpk(p0[6], p0[7])};
        u32x4 pw1 = {cvtpk(p0[8], p0[9]), cvtpk(p0[10], p0[11]), cvtpk(p0[12], p0[13]), cvtpk(p0[14], p0[15])};
        u32x4 pw2 = {cvtpk(p1[0], p1[1]), cvtpk(p1[2], p1[3]), cvtpk(p1[4], p1[5]), cvtpk(p1[6], p1[7])};
        u32x4 pw3 = {cvtpk(p1[8], p1[9]), cvtpk(p1[10], p1[11]), cvtpk(p1[12], p1[13]), cvtpk(p1[14], p1[15])};
#define PV_STEP(PW, ks) do { const bf16x8 pa_ = __builtin_bit_cast(bf16x8, PW); \
            { const s16x4 a_ = vtr(Vs + (ks) * 1024), b_ = vtr(Vs + (ks) * 1024 + 512); const bf16x8 vf_ = {a_[0], a_[1], a_[2], a_[3], b_[0], b_[1], b_[2], b_[3]}; \
              o0 = __builtin_amdgcn_mfma_f32_32x32x16_bf16(pa_, vf_, o0, 0, 0, 0); } \
            { const s16x4 a_ = vtr(Vs + 4096 + (ks) * 1024), b_ = vtr(Vs + 4096 + (ks) * 1024 + 512); const bf16x8 vf_ = {a_[0], a_[1], a_[2], a_[3], b_[0], b_[1], b_[2], b_[3]}; \
              o1 = __builtin_amdgcn_mfma_f32_32x32x16_bf16(pa_, vf_, o1, 0, 0, 0); } } while (0)
        PV_STEP(pw0, 0); PV_STEP(pw1, 1); PV_STEP(pw2, 2); PV_STEP(pw3, 3);
#undef PV_STEP
        slot = (slot == 2) ? 0 : slot + 1;
    }
    { auto rr = __builtin_amdgcn_permlane32_swap(__float_as_uint(l), __float_as_uint(l), false, false); l = __uint_as_float(rr[0]) + __uint_as_float(rr[1]); }
    if (hi == 0) wsf[32 + r32] = l;
    asm volatile("s_waitcnt lgkmcnt(0)" ::: "memory");
    ALAS bf16* stg = (ALAS bf16*)(lds + LDS_OST) + wid * 2048;
#pragma unroll
    for (int r = 0; r < 16; ++r) { const int orow = crow(r, hi); const float rl = 1.f / wsf[32 + orow];
        stg[orow * 64 + r32] = (bf16)f2bf(o0[r] * rl); stg[orow * 64 + 32 + r32] = (bf16)f2bf(o1[r] * rl); }
    asm volatile("s_waitcnt lgkmcnt(0)" ::: "memory");
    const size_t trow0 = (size_t)b * SEQ + qb * 256 + wid * 32;
#pragma unroll
    for (int i = 0; i < 4; ++i) { const int row = i * 8 + (lane >> 3), ch = lane & 7;
        const u32x4 v = *(const ALAS u32x4*)(stg + row * 64 + ch * 8);
        *(u32x4*)(YC + (trow0 + row) * 1024 + 512 + h * 64 + ch * 8) = v;
        float sq = 0.f;
#pragma unroll
        for (int e = 0; e < 4; ++e) { const float a = __uint_as_float(v[e] << 16), c = __uint_as_float(v[e] & 0xffff0000u); sq += a * a + c * c; }
        sq += __shfl_xor(sq, 1); sq += __shfl_xor(sq, 2); sq += __shfl_xor(sq, 4);
        if (ch == 0) SSQ[(trow0 + row) * 16 + 8 + h] = sq; }
    asm volatile("s_waitcnt lgkmcnt(0)\n\ts_barrier" ::: "memory");
#undef ADMA
}
__device__ __forceinline__ void attn_phase(ALAS char* lds, const bf16* Q, const bf16* KF, const bf16* VT, bf16* YC, float* SSQ) {
    const int G = gridDim.x, bid = blockIdx.x; const int vcu = (G % 8 == 0) ? (bid % 8) * (G / 8) + bid / 8 : bid;
    for (int p = vcu; p < 256; p += G) { const int bh = p >> 2, s = p & 3;
        attn_unit(lds, bh, 7 - s, Q, KF, VT, YC, SSQ);
        attn_unit(lds, bh, s, Q, KF, VT, YC, SSQ); }
}
#undef AWAIT_BAR
}
__device__ void ph_prenorm(const float* in, const float* g, const float* mod, int sh_off, int sc_off, float* out) {
    const int lane = tidx() & 63, gw = blockIdx.x * (NT / 64) + (tidx() >> 6), ngw = gridDim.x * (NT / 64);
    for (int t = gw; t < M; t += ngw) {
        const int b = t / SEQ; const float* r = in + (size_t)t * D;
        float s = 0.f;
        for (int i = lane; i < D; i += 64) s += r[i] * r[i];
        const float inv = rsqrtf(wave_sum(s) / D + EPS);
        for (int i = lane; i < D; i += 64)
            out[(size_t)t * D + i] = r[i] * inv * g[i] * (1.f + mod[b * 6 * D + sc_off + i]) + mod[b * 6 * D + sh_off + i];
    }
}
template <class TY> __device__ void ph_post(const float* base, const TY* y, const float* g, const float* mod, int gate_off, float* out) {
    const int lane = tidx() & 63, gw = blockIdx.x * (NT / 64) + (tidx() >> 6), ngw = gridDim.x * (NT / 64);
    for (int t = gw; t < M; t += ngw) {
        const int b = t / SEQ; const TY* r = y + (size_t)t * D;
        float s = 0.f;
        for (int i = lane; i < D; i += 64) { const float v = ldf(r + i); s += v * v; }
        const float inv = rsqrtf(wave_sum(s) / D + EPS);
        for (int i = lane; i < D; i += 64)
            out[(size_t)t * D + i] = base[(size_t)t * D + i] + mod[b * 6 * D + gate_off + i] * (ldf(r + i) * inv * g[i]);
    }
}
template <class TI> __device__ void ph_rms_slice(const TI* in, int ldi, int off, int n, const float* g, float* out, int ldo, int ooff) {
    const int lane = tidx() & 63, gw = blockIdx.x * (NT / 64) + (tidx() >> 6), ngw = gridDim.x * (NT / 64);
    for (int t = gw; t < M; t += ngw) {
        const TI* r = in + (size_t)t * ldi + off;
        float s = 0.f;
        for (int i = lane; i < n; i += 64) { const float v = ldf(r + i); s += v * v; }
        const float inv = rsqrtf(wave_sum(s) / n + EPS);
        for (int i = lane; i < n; i += 64) out[(size_t)t * ldo + ooff + i] = ldf(r + i) * inv * g[i];
    }
}

namespace ssd {
typedef short bf16x8 __attribute__((ext_vector_type(8)));
typedef short s16x4 __attribute__((ext_vector_type(4)));
typedef float f32x16 __attribute__((ext_vector_type(16)));
typedef unsigned u32x4 __attribute__((ext_vector_type(4)));
#define SLAS __attribute__((address_space(3)))
constexpr float LOG2E = 1.4426950408889634f;
__device__ __forceinline__ int crow(int r, int hi) { return (r & 3) + 8 * (r >> 2) + 4 * hi; }
__device__ __forceinline__ s16x4 vtr(const SLAS char* p) { typedef short v4 __attribute__((ext_vector_type(4))); return __builtin_bit_cast(s16x4, __builtin_amdgcn_ds_read_tr16_b64_v4i16((SLAS v4*)p)); }
__device__ __forceinline__ unsigned cvtpk(float lo, float hi) { typedef float f2 __attribute__((ext_vector_type(2))); typedef __bf16 b2 __attribute__((ext_vector_type(2)));
    f2 v = {lo, hi}; b2 b = __builtin_convertvector(v, b2); return __builtin_bit_cast(unsigned, b); }
#define SWAIT_BAR(N) asm volatile("s_waitcnt vmcnt(" #N ") lgkmcnt(0)\n\ts_barrier" ::: "memory")
#define SDMA(gsrc, ldst) __builtin_amdgcn_global_load_lds((const unsigned*)(gsrc), (SLAS unsigned*)(ldst), 16, 0, 0)

constexpr int SW_BUF = 49152, SW_TAB = 2 * SW_BUF;
__device__ __forceinline__ void state_sweep(SLAS char* lds, int b, int h, const bf16* XT, const float* DT, const float* a_log, float* ACS2, bf16* PREV) {
    const int tid = tidx(), lane = tid & 63, r32 = lane & 31, hi = lane >> 5; const int wid = __builtin_amdgcn_readfirstlane(tid >> 6);
    const int g = h >> 2, pt = wid & 1, nt = wid >> 1;
    const float a = -expf(a_log[h]);
    SLAS float* tab = (SLAS float*)(lds + SW_TAB);
    f32x16 st = {};
    const int trl = (4 * hi + ((lane & 15) >> 2));
    const int trc = 16 * ((lane >> 4) & 1) + 4 * (lane & 3);
#define SW_ISSUE(c_, buf_) do { const char* xs_ = (const char*)(XT + (size_t)(b * 16 + (c_)) * 131072 + h * 8192); const char* bs_ = (const char*)(XT + (size_t)(b * 16 + (c_)) * 131072 + 65536 + g * 16384); \
        _Pragma("unroll") for (int i_ = 0; i_ < 2; ++i_) SDMA(xs_ + (wid * 2 + i_) * 1024 + lane * 16, lds + (buf_) * SW_BUF + (wid * 2 + i_) * 1024); \
        _Pragma("unroll") for (int i_ = 0; i_ < 4; ++i_) SDMA(bs_ + (wid * 4 + i_) * 1024 + lane * 16, lds + (buf_) * SW_BUF + 16384 + (wid * 4 + i_) * 1024); } while (0)
    SW_ISSUE(0, 0);
    for (int c = 0; c < 16; ++c) {
        const int buf = c & 1;
        float cdec = 0.f, d0 = 0.f, d1 = 0.f;
        const size_t t0 = (size_t)(b * 16 + c) * 128;
        if (wid == 0) { d0 = DT[(t0 + 2 * lane) * 8 + h]; d1 = DT[(t0 + 2 * lane + 1) * 8 + h]; }
        if (c + 1 < 16) SW_ISSUE(c + 1, buf ^ 1);
        float cs0 = 0.f, cs1 = 0.f;
        if (wid == 0) {
            const float a0 = d0 * a, a1 = d1 * a; float inc = a0 + a1;
#pragma unroll
            for (int o = 1; o < 64; o <<= 1) { const float n = __shfl_up(inc, o); if (lane >= o) inc += n; }
            const float tot = __shfl(inc, 63); cs1 = inc; cs0 = inc - a1;
            tab[2 * lane] = cs0 * LOG2E; tab[2 * lane + 1] = cs1 * LOG2E;
            tab[128 + 2 * lane] = d0 * expf(tot - cs0); tab[128 + 2 * lane + 1] = d1 * expf(tot - cs1);
            if (lane == 0) tab[256] = expf(tot);
        }
        if (c + 1 < 16) { SWAIT_BAR(6); } else { SWAIT_BAR(0); }
        if (wid == 0) { ACS2[(t0 + 2 * lane) * 8 + h] = cs0 * LOG2E; ACS2[(t0 + 2 * lane + 1) * 8 + h] = cs1 * LOG2E; }
        cdec = tab[256];
        { SLAS char* xp = lds + buf * SW_BUF + tid * 32; const int l = (tid >> 1) & 127; const float w = tab[128 + l];
          u32x4 q0 = *(SLAS u32x4*)xp, q1 = *(SLAS u32x4*)(xp + 16);
#pragma unroll
          for (int e = 0; e < 4; ++e) { q0[e] = cvtpk(__uint_as_float(q0[e] << 16) * w, __uint_as_float(q0[e] & 0xffff0000u) * w); q1[e] = cvtpk(__uint_as_float(q1[e] << 16) * w, __uint_as_float(q1[e] & 0xffff0000u) * w); }
          *(SLAS u32x4*)xp = q0; *(SLAS u32x4*)(xp + 16) = q1; }
        asm volatile("s_waitcnt lgkmcnt(0)\n\ts_barrier" ::: "memory");
        f32x16 acc = {};
        { const SLAS char* bb = lds + buf * SW_BUF + 16384 + ((32 * nt + trc) >> 3) * 2048 + ((32 * nt + trc) & 7) * 2 + trl * 16;
          const SLAS char* xb = lds + buf * SW_BUF + pt * 8192 + trl * 64 + trc * 2;
#pragma unroll
          for (int ks = 0; ks < 8; ++ks) {
              const s16x4 a0 = vtr(bb + ks * 256), a1 = vtr(bb + ks * 256 + 128); const s16x4 x0 = vtr(xb + ks * 1024), x1 = vtr(xb + ks * 1024 + 512);
              const bf16x8 af = {a0[0], a0[1], a0[2], a0[3], a1[0], a1[1], a1[2], a1[3]}, xf = {x0[0], x0[1], x0[2], x0[3], x1[0], x1[1], x1[2], x1[3]};
              acc = __builtin_amdgcn_mfma_f32_32x32x16_bf16(af, xf, acc, 0, 0, 0); } }
        { bf16* pv = PREV + (size_t)((b * 16 + c) * 8 + h) * 8192 + (32 * pt + r32) * 8 + 4 * hi;
#pragma unroll
          for (int rg = 0; rg < 4; ++rg) { uint2 o; o.x = cvtpk(st[4 * rg], st[4 * rg + 1]); o.y = cvtpk(st[4 * rg + 2], st[4 * rg + 3]); *(uint2*)(pv + (4 * nt + rg) * 512) = o; } }
#pragma unroll
        for (int r = 0; r < 16; ++r) st[r] = st[r] * cdec + acc[r];
        asm volatile("s_waitcnt lgkmcnt(0)\n\ts_barrier" ::: "memory");
    }
#undef SW_ISSUE
}

constexpr int P2_C = 0, P2_B = 32768, P2_XP = 65536, P2_TAB = 131072, P2_STG = 135168, P2_END = 151552;
__device__ __forceinline__ void chunk_unit(SLAS char* lds, int b, int c, int g, const bf16* XT, const bf16* PREV, const float* DT, const float* ACS2, const float* d_skip,
                                           const bf16* U, bf16* YC, float* SSQS) {
    const int tid = tidx(), lane = tid & 63, r32 = lane & 31, hi = lane >> 5; const int wid = __builtin_amdgcn_readfirstlane(tid >> 6);
    const int lb = wid >> 1, ph = wid & 1;
    const char* xt = (const char*)(XT + (size_t)(b * 16 + c) * 131072);
    const size_t t0 = (size_t)(b * 16 + c) * 128;
#pragma unroll
    for (int i = 0; i < 4; ++i) { SDMA(xt + (98304 + g * 16384) * 2 + (wid * 4 + i) * 1024 + lane * 16, lds + P2_C + (wid * 4 + i) * 1024);
                                  SDMA(xt + (65536 + g * 16384) * 2 + (wid * 4 + i) * 1024 + lane * 16, lds + P2_B + (wid * 4 + i) * 1024); }
#define P2_ISSUE(hh_) do { const int h_ = 4 * g + (hh_); const char* xs_ = xt + h_ * 16384; const char* ps_ = (const char*)(PREV + (size_t)((b * 16 + c) * 8 + h_) * 8192); \
        SLAS char* d_ = lds + P2_XP + ((hh_) & 1) * 32768; \
        _Pragma("unroll") for (int i_ = 0; i_ < 2; ++i_) { SDMA(xs_ + (wid * 2 + i_) * 1024 + lane * 16, d_ + (wid * 2 + i_) * 1024); SDMA(ps_ + (wid * 2 + i_) * 1024 + lane * 16, d_ + 16384 + (wid * 2 + i_) * 1024); } } while (0)
    P2_ISSUE(0);
    { SLAS float* tab = (SLAS float*)(lds + P2_TAB); const int hh = tid >> 7, l = tid & 127;
      tab[hh * 256 + l] = ACS2[(t0 + l) * 8 + 4 * g + hh]; tab[hh * 256 + 128 + l] = DT[(t0 + l) * 8 + 4 * g + hh]; }
    P2_ISSUE(1);
    SWAIT_BAR(4);
    bf16x8 cf[8];
#pragma unroll
    for (int ks = 0; ks < 8; ++ks) cf[ks] = *(const SLAS bf16x8*)(lds + P2_C + (2 * ks + hi) * 2048 + (32 * lb + r32) * 16);
    f32x16 cbt[4];
#pragma unroll
    for (int sb = 0; sb < 4; ++sb) { cbt[sb] = f32x16{};
        if (sb <= lb) {
#pragma unroll
            for (int ks = 0; ks < 8; ++ks) { const bf16x8 bfr = *(const SLAS bf16x8*)(lds + P2_B + (2 * ks + hi) * 2048 + (32 * sb + r32) * 16);
                cbt[sb] = __builtin_amdgcn_mfma_f32_32x32x16_bf16(bfr, cf[ks], cbt[sb], 0, 0, 0); } } }
    const int vlane = (4 * hi + ((lane & 15) >> 2)) * 64 + ((lane >> 4) & 1) * 32 + (lane & 3) * 8;
    const int lrow = 32 * lb + r32;
    for (int hh = 0; hh < 4; ++hh) {
        const int h = 4 * g + hh;
        const SLAS char* xb = lds + P2_XP + (hh & 1) * 32768; const SLAS char* pb = xb + 16384;
        const SLAS float* tab = (const SLAS float*)(lds + P2_TAB) + hh * 256;
        const float dsk = d_skip[h];
        f32x16 o = {};
#pragma unroll
        for (int ks = 0; ks < 8; ++ks) { const bf16x8 pf = *(const SLAS bf16x8*)(pb + (2 * ks + hi) * 1024 + (32 * ph + r32) * 16);
            o = __builtin_amdgcn_mfma_f32_32x32x16_bf16(cf[ks], pf, o, 0, 0, 0); }
#pragma unroll
        for (int r = 0; r < 16; ++r) o[r] *= exp2f(tab[32 * lb + crow(r, hi)]);
        const float al = tab[lrow];
#pragma unroll
        for (int sb = 0; sb < 4; ++sb) {
            if (sb <= lb) {
                float pr[16];
#pragma unroll
                for (int r = 0; r < 16; ++r) { const int sidx = 32 * sb + crow(r, hi);
                    float v = cbt[sb][r] * exp2f(al - tab[sidx]) * tab[128 + sidx];
                    if (sb == lb) { v = (sidx <= lrow) ? v : 0.f; v += (sidx == lrow) ? dsk : 0.f; }
                    pr[r] = v; }
                const u32x4 pw0 = {cvtpk(pr[0], pr[1]), cvtpk(pr[2], pr[3]), cvtpk(pr[4], pr[5]), cvtpk(pr[6], pr[7])};
                const u32x4 pw1 = {cvtpk(pr[8], pr[9]), cvtpk(pr[10], pr[11]), cvtpk(pr[12], pr[13]), cvtpk(pr[14], pr[15])};
                const SLAS char* xv = xb + ph * 8192 + vlane + (2 * sb) * 1024;
                { const s16x4 a_ = vtr(xv), b_ = vtr(xv + 512); const bf16x8 vf = {a_[0], a_[1], a_[2], a_[3], b_[0], b_[1], b_[2], b_[3]};
                  o = __builtin_amdgcn_mfma_f32_32x32x16_bf16(__builtin_bit_cast(bf16x8, pw0), vf, o, 0, 0, 0); }
                { const s16x4 a_ = vtr(xv + 1024), b_ = vtr(xv + 1024 + 512); const bf16x8 vf = {a_[0], a_[1], a_[2], a_[3], b_[0], b_[1], b_[2], b_[3]};
                  o = __builtin_amdgcn_mfma_f32_32x32x16_bf16(__builtin_bit_cast(bf16x8, pw1), vf, o, 0, 0, 0); }
            }
        }
        SLAS bf16* stg = (SLAS bf16*)(lds + P2_STG) + wid * 1024;
#pragma unroll
        for (int r = 0; r < 16; ++r) stg[crow(r, hi) * 32 + r32] = (bf16)f2bf(o[r]);
        asm volatile("s_waitcnt lgkmcnt(0)" ::: "memory");
#pragma unroll
        for (int i = 0; i < 2; ++i) { const int row = i * 16 + (lane >> 2), ch = lane & 3; const size_t t = t0 + 32 * lb + row;
            const u32x4 ov = *(const SLAS u32x4*)(stg + row * 32 + ch * 8);
            const u32x4 zv = *(const u32x4*)(U + t * NU + OFF_Z + h * 64 + 32 * ph + 8 * ch);
            u32x4 w; float sq = 0.f;
#pragma unroll
            for (int e = 0; e < 4; ++e) { const float z0 = __uint_as_float(zv[e] << 16), z1 = __uint_as_float(zv[e] & 0xffff0000u);
                const float v0 = __uint_as_float(ov[e] << 16) * (z0 * __builtin_amdgcn_rcpf(1.f + __expf(-z0))), v1 = __uint_as_float(ov[e] & 0xffff0000u) * (z1 * __builtin_amdgcn_rcpf(1.f + __expf(-z1)));
                w[e] = cvtpk(v0, v1); const float r0 = __uint_as_float(w[e] << 16), r1 = __uint_as_float(w[e] & 0xffff0000u); sq += r0 * r0 + r1 * r1; }
            *(u32x4*)(YC + t * 1024 + h * 64 + 32 * ph + 8 * ch) = w;
            sq += __shfl_xor(sq, 1); sq += __shfl_xor(sq, 2);
            if (ch == 0) SSQS[t * 16 + h * 2 + ph] = sq; }
        if (hh < 3) {
            if (hh + 2 < 4) { asm volatile("s_waitcnt lgkmcnt(0)\n\ts_barrier" ::: "memory"); P2_ISSUE(hh + 2); SWAIT_BAR(4); }
            else { SWAIT_BAR(0); }
        }
    }
    asm volatile("s_waitcnt vmcnt(0) lgkmcnt(0)\n\ts_barrier" ::: "memory");
#undef P2_ISSUE
}
#undef SWAIT_BAR
#undef SDMA
}
__device__ void ph_gate_norm(const float* y, const bf16* u, bf16* YC) {
    const int lane = tidx() & 63, gw = blockIdx.x * (NT / 64) + (tidx() >> 6), ngw = gridDim.x * (NT / 64);
    for (int t = gw; t < M; t += ngw) {
        float v[8]; float s = 0.f;
#pragma unroll
        for (int j = 0; j < 8; ++j) { const int i = lane + 64 * j; v[j] = y[(size_t)t * SSD_INNER + i] * silu_f(bf2f(u[(size_t)t * NU + OFF_Z + i])); s += v[j] * v[j]; }
        const float inv = rsqrtf(wave_sum(s) / SSD_INNER + EPS);
#pragma unroll
        for (int j = 0; j < 8; ++j) YC[(size_t)t * 1024 + lane + 64 * j] = (bf16)f2bf(v[j] * inv);
    }
}
__device__ void ph_yc_norm(bf16* YC, const float* SSQS, const float* SSQ) {
    const int lane = tidx() & 63, gw = blockIdx.x * (NT / 64) + (tidx() >> 6), ngw = gridDim.x * (NT / 64);
    for (int t = gw; t < M; t += ngw) {
        float ss = 0.f, sm = 0.f;
#pragma unroll
        for (int q = 0; q < 4; ++q) { const f32x4v a = *(const f32x4v*)(SSQS + (size_t)t * 16 + 4 * q); ss += (a.x + a.y) + (a.z + a.w); }
        { const f32x4v a = *(const f32x4v*)(SSQ + (size_t)t * 16 + 8), b = *(const f32x4v*)(SSQ + (size_t)t * 16 + 12); sm = (a.x + a.y) + (a.z + a.w) + (b.x + b.y) + (b.z + b.w); }
        const float invs = rsqrtf(ss * (1.f / 512.f) + EPS), invm = rsqrtf(sm * (1.f / 512.f) + EPS);
#pragma unroll
        for (int hlf = 0; hlf < 2; ++hlf) { const float inv = hlf ? invm : invs;
            v4u* p = (v4u*)(YC + (size_t)t * 1024 + 512 * hlf) + lane; v4u w = *p;
            w.x = pk2(__uint_as_float(w.x << 16) * inv, __uint_as_float(w.x & 0xffff0000u) * inv); w.y = pk2(__uint_as_float(w.y << 16) * inv, __uint_as_float(w.y & 0xffff0000u) * inv);
            w.z = pk2(__uint_as_float(w.z << 16) * inv, __uint_as_float(w.z & 0xffff0000u) * inv); w.w = pk2(__uint_as_float(w.w << 16) * inv, __uint_as_float(w.w & 0xffff0000u) * inv);
            *p = w; }
    }
}
__device__ void ph_gemm(float* lds, const float* A, int lda, const float* B, int ldb, float* C, int ldc, int Mr, int N, int K) {
    float (*As)[129] = (float (*)[129])lds;
    float (*Bs)[65] = (float (*)[65])(lds + 16 * 129);
    const int tx = tidx() & 15, ty = tidx() >> 4;
    const int ntn = (N + 63) / 64, ntm = Mr / 128;
    for (int tile = blockIdx.x; tile < ntn * ntm; tile += gridDim.x) {
        const int m0 = (tile / ntn) * 128, n0 = (tile % ntn) * 64;
        float acc[4][4] = {};
        for (int k0 = 0; k0 < K; k0 += 16) {
            for (int i = tidx(); i < 128 * 16; i += NT) { const int r = i >> 4, kk = i & 15; As[kk][r] = A[(size_t)(m0 + r) * lda + k0 + kk]; }
            for (int i = tidx(); i < 64 * 16; i += NT) { const int kk = i >> 6, cc = i & 63; Bs[kk][cc] = (n0 + cc < N) ? B[(size_t)(k0 + kk) * ldb + n0 + cc] : 0.f; }
            __syncthreads();
#pragma unroll
            for (int kk = 0; kk < 16; ++kk) {
                float a[4], b[4];
#pragma unroll
                for (int i = 0; i < 4; ++i) { a[i] = As[kk][ty * 4 + i]; b[i] = Bs[kk][tx * 4 + i]; }
#pragma unroll
                for (int i = 0; i < 4; ++i)
#pragma unroll
                    for (int j = 0; j < 4; ++j) acc[i][j] += a[i] * b[j];
            }
            __syncthreads();
        }
#pragma unroll
        for (int i = 0; i < 4; ++i)
#pragma unroll
            for (int j = 0; j < 4; ++j) { const int n = n0 + tx * 4 + j; if (n < N) C[(size_t)(m0 + ty * 4 + i) * ldc + n] = acc[i][j]; }
    }
}
__device__ void ph_conv(const bf16* u, const float* cw, const float* cb, float* xc) {
    for (size_t idx = (size_t)blockIdx.x * NT + tidx(); idx < (size_t)M * SSD_XBC; idx += (size_t)gridDim.x * NT) {
        const int ch = (int)(idx % SSD_XBC), t = (int)(idx / SSD_XBC), s = t % SEQ;
        float acc = cb[ch];
        for (int k = 0; k < 4; ++k) { const int ss = s - 3 + k; if (ss >= 0) acc += cw[k * SSD_XBC + ch] * bf2f(u[(size_t)(t - 3 + k) * NU + OFF_XBC + ch]); }
        xc[idx] = silu_f(acc);
    }
}
__device__ void ph_ssd_seq(const float* DT, const bf16* xc, const float* dt_bias, const float* a_log, const float* d_skip, float* y) {
    for (int item = blockIdx.x; item < NB * SSD_H; item += gridDim.x) {
        const int b = item / SSD_H, h = item % SSD_H, g = h / (SSD_H / SSD_G);
        const int p = tidx() >> 3, nq = tidx() & 7;
        const float a = -expf(a_log[h]), dsk = d_skip[h];
        float st[16];
#pragma unroll
        for (int i = 0; i < 16; ++i) st[i] = 0.f;
        for (int s = 0; s < SEQ; ++s) {
            const size_t t = (size_t)b * SEQ + s;
            const float dt = DT[t * 8 + h];
            const float da = expf(dt * a);
            const float xv = bf2f(xc[t * SSD_XBC + h * SSD_P + p]);
            const float xd = xv * dt;
            const bf16* Bp = xc + t * SSD_XBC + SSD_INNER + g * SSD_N + nq * 16;
            const bf16* Cp = xc + t * SSD_XBC + SSD_INNER + SSD_G * SSD_N + g * SSD_N + nq * 16;
            float acc = 0.f;
#pragma unroll
            for (int i = 0; i < 16; ++i) { st[i] = st[i] * da + xd * bf2f(Bp[i]); acc += bf2f(Cp[i]) * st[i]; }
            acc += __shfl_xor(acc, 1); acc += __shfl_xor(acc, 2); acc += __shfl_xor(acc, 4);
            if (nq == 0) y[t * SSD_INNER + h * SSD_P + p] = acc + dsk * xv;
        }
    }
}
__device__ void ph_rope(float* q, const bf16* u, const int* pos, float* kpe) {
    for (int idx = blockIdx.x * NT + tidx(); idx < M * 9 * 16; idx += gridDim.x * NT) {
        const int i = idx % 16, hh = (idx / 16) % 9, t = idx / (16 * 9);
        const float inv = 1.0f / powf(10000.0f, (float)(2 * i) / 32.0f);
        const float ang = (float)pos[t] * inv;
        float sn, cs; sincosf(ang, &sn, &cs);
        if (hh < 8) {
            float* p = q + (size_t)t * (MLA_H * QK) + hh * QK + NOPE;
            const float x1 = p[i], x2 = p[16 + i];
            p[i] = x1 * cs - x2 * sn; p[16 + i] = x2 * cs + x1 * sn;
        } else {
            const bf16* p = u + (size_t)t * NU + OFF_KR;
            const float x1 = bf2f(p[i]), x2 = bf2f(p[16 + i]);
            kpe[(size_t)t * ROPE + i] = x1 * cs - x2 * sn; kpe[(size_t)t * ROPE + 16 + i] = x2 * cs + x1 * sn;
        }
    }
}
__device__ void ph_attn(const float* q, const float* kv, const float* kpe, float* o) {
    const int lane = tidx() & 63, gw = blockIdx.x * (NT / 64) + (tidx() >> 6), ngw = gridDim.x * (NT / 64);
    for (int item = gw; item < NB * MLA_H * (SEQ / 64); item += ngw) {
        const int qb = (SEQ / 64 - 1) - item / (NB * MLA_H), bh = item % (NB * MLA_H), b = bh / MLA_H, h = bh % MLA_H;
        const int qi = qb * 64 + lane;
        const size_t t = (size_t)b * SEQ + qi;
        float qr[QK];
#pragma unroll
        for (int d = 0; d < QK; ++d) qr[d] = q[t * (MLA_H * QK) + h * QK + d] * 0.10206207261596575f;
        float acc[VD];
#pragma unroll
        for (int d = 0; d < VD; ++d) acc[d] = 0.f;
        float mx = -INFINITY, l = 0.f;
        const int kmax = qb * 64 + 63;
        for (int k = 0; k <= kmax; ++k) {
            const size_t tk = (size_t)b * SEQ + k;
            const float* kn = kv + tk * (MLA_H * 128) + h * 128;
            const float* kp = kpe + tk * ROPE;
            float s = 0.f;
#pragma unroll
            for (int d = 0; d < NOPE; ++d) s += qr[d] * kn[d];
#pragma unroll
            for (int d = 0; d < ROPE; ++d) s += qr[NOPE + d] * kp[d];
            if (k <= qi) {
                const float mn = fmaxf(mx, s);
                const float f = expf(mx - mn), pv = expf(s - mn);
                l = l * f + pv;
#pragma unroll
                for (int d = 0; d < VD; ++d) acc[d] = acc[d] * f + pv * kn[64 + d];
                mx = mn;
            }
        }
        const float il = 1.f / l;
#pragma unroll
        for (int d = 0; d < VD; ++d) o[t * (MLA_H * VD) + h * VD + d] = acc[d] * il;
    }
}
__device__ void ph_moe(float* lds, const float* h2, const float* wgr, const float* bgr, const float* wer, const float* ber,
                       const float* wg, const float* wu, const float* wd, float* y2) {
    const int sb = tidx() >> 8, tid = tidx() & 255;
    float* xs = lds + sb * 2048;
    float* logit = xs + 1024;
    float* hid = xs + 1088;
    int* sel_e = (int*)(xs + 1600);
    float* sel_w = xs + 1604;
    for (int it = blockIdx.x; it < M / 2; it += gridDim.x) {
        const int t = it * 2 + sb;
        __syncthreads();
        for (int i = tid; i < D; i += 256) xs[i] = h2[(size_t)t * D + i];
        __syncthreads();
        {
            const int w = tid >> 6, lane = tid & 63;
            for (int cidx = w * 9; cidx < w * 9 + 9; ++cidx) {
                float s = 0.f;
                for (int k = lane; k < D; k += 64) s += xs[k] * (cidx < 4 ? wgr[k * 4 + cidx] : wer[k * 32 + (cidx - 4)]);
                s = wave_sum(s);
                if (lane == 0) logit[cidx] = s;
            }
        }
        __syncthreads();
        if (tid == 0) {
            float mxv = -INFINITY; int gi = 0;
            for (int i = 0; i < 4; ++i) { const float v = logit[i] + bgr[i]; logit[i] = v; if (v > mxv) { mxv = v; gi = i; } }
            float den = 0.f; for (int i = 0; i < 4; ++i) den += expf(logit[i] - mxv);
            const float gw = 1.f / den;
            float emx = -INFINITY; int i1 = 0;
            for (int i = 0; i < 8; ++i) { const float v = logit[4 + gi * 8 + i] + ber[gi * 8 + i]; logit[4 + gi * 8 + i] = v; if (v > emx) { emx = v; i1 = i; } }
            float e2 = -INFINITY; int i2 = 0;
            for (int i = 0; i < 8; ++i) { const float v = logit[4 + gi * 8 + i]; if (i != i1 && v > e2) { e2 = v; i2 = i; } }
            const float p2 = expf(e2 - emx);
            sel_e[0] = gi * 8 + i1; sel_e[1] = gi * 8 + i2;
            sel_w[0] = gw / (1.f + p2); sel_w[1] = gw * p2 / (1.f + p2);
        }
        __syncthreads();
        for (int k2 = 0; k2 < 2; ++k2) {
            const int e = sel_e[k2];
            const float* G = wg + (size_t)e * D * FF; const float* U = wu + (size_t)e * D * FF;
            float ga = 0.f, ua = 0.f;
            for (int k = 0; k < D; ++k) { ga += xs[k] * G[(size_t)k * FF + tid]; ua += xs[k] * U[(size_t)k * FF + tid]; }
            hid[k2 * FF + tid] = silu_f(ga) * ua * sel_w[k2];
        }
        __syncthreads();
        for (int d = tid; d < D; d += 256) {
            float acc = 0.f;
            for (int k2 = 0; k2 < 2; ++k2) {
                const float* Wd = wd + (size_t)sel_e[k2] * FF * D;
                for (int f = 0; f < FF; ++f) acc += hid[k2 * FF + f] * Wd[(size_t)f * D + d];
            }
            y2[(size_t)t * D + d] = acc;
        }
    }
}


constexpr size_t MiB = 1u << 20;
#define WSB(T, off) ((T*)(kargs()->ws + (size_t)(off)))
#define OUTB(T, off) ((T*)((char*)kargs()->out + (size_t)(off)))
#define B_CNT    WSB(int, 4096)
#define B_MOD    WSB(float, 1 * MiB)
#define B_DT     WSB(float, 1 * MiB + 256 * 1024)
#define B_ACS2   WSB(float, 1 * MiB + 768 * 1024)
#define B_WIN    WSB(bf16, 2 * MiB)
#define B_WOUT   WSB(bf16, 6 * MiB)
#define B_WUQ    WSB(bf16, 8 * MiB)
#define B_WUKV   WSB(bf16, 9 * MiB)
#define B_WRF    WSB(bf16, 9 * MiB + 512 * 1024)
#define B_WGU    WSB(bf16, 10 * MiB)
#define B_WD     WSB(bf16, 42 * MiB)
#define B_HB     WSB(bf16, 58 * MiB)
#define B_YC     WSB(bf16, 58 * MiB)
#define B_H2     WSB(bf16, 58 * MiB)
#define B_U      WSB(bf16, 90 * MiB)
#define B_HG     WSB(bf16, 90 * MiB)
#define B_YP     WSB(bf16, 90 * MiB)
#define B_XT     WSB(bf16, 154 * MiB)
#define B_YB     WSB(bf16, 154 * MiB)
#define B_HID    WSB(bf16, 170 * MiB)
#define B_Q      WSB(bf16, 186 * MiB)
#define B_KF     WSB(bf16, 210 * MiB)
#define B_VT     WSB(bf16, 234 * MiB)
#define B_COS    WSB(float, 250 * MiB)
#define B_SIN    WSB(float, 251 * MiB)
#define B_RTE    WSB(int, 250 * MiB)
#define B_RTS    WSB(int, 250 * MiB + 256 * 1024)
#define B_RTW    WSB(float, 250 * MiB + 512 * 1024)
#define B_TOKROW WSB(int, 250 * MiB + 768 * 1024)
#define B_ROWW   WSB(float, 251 * MiB)
#define B_SSQ    WSB(float, 252 * MiB)
#define B_SSQS   WSB(float, 253 * MiB)
#define B_PREV   OUTB(bf16, 0)
#define B_CQN    OUTB(bf16, 32 * MiB)
#define B_CKVN   OUTB(bf16, 40 * MiB)
#define LDS_TP   ((int*)(lds_raw + 131072 + 1024))

__global__ void __launch_bounds__(NT, 2) mega_fwd(Params P) {
    tidx_init();
    float* lds = (float*)lds_raw;
    cg::grid_group grid = cg::this_grid();
    ph_prep(lds, B_MOD, B_WIN, B_WOUT, B_WUQ, B_WUKV, B_WGU, B_WD, B_WRF, B_CNT);
    grid.sync();
    ph_prenorm_bf16(IN(0), IN(5), B_MOD, 0 * D, 1 * D, B_HB);
    grid.sync();
    { pg8::Gemm g{B_HB, B_WIN, M, NU, D}; pg8::StaticOrder S; S.init(M, NU, gridDim.x, (int)blockIdx.x);
      pg8::EpiBf16<0> E{B_U, NU};
      pg8::gemm_phase<pg8::EpiBf16<0>, pg8::StaticOrder, true, true>((PG8_LAS unsigned char*)lds_raw, g, S, E); }
    grid.sync();
    ph_prep2(B_U, kargs()->pos, IN(10), IN(11), IN(12), B_CQN, B_CKVN, B_KF, B_COS, B_SIN, B_DT, B_XT);
    grid.sync();
    {
      const int G = gridDim.x, bid = blockIdx.x; const bool split = G >= 128;
      if (!split || bid < 64) { for (int it = bid; it < 64; it += (split ? 64 : G)) ssd::state_sweep((SLAS char*)lds_raw, it >> 3, it & 7, B_XT, B_DT, IN(13), B_ACS2, B_PREV); }
      if (!split || bid >= 64) { const int Gg = split ? G - 64 : G, cg_ = split ? bid - 64 : bid;
        { pg8::Gemm g{B_CQN, B_WUQ, M, 768, QR}; pg8::StaticOrder S; S.init(M, 768, Gg, cg_);
          pg8::EpiQ E{B_Q, B_COS, B_SIN};
          pg8::gemm_phase<pg8::EpiQ, pg8::StaticOrder, true, false>((PG8_LAS unsigned char*)lds_raw, g, S, E); }
        { pg8::Gemm g{B_CKVN, B_WUKV, M, 1024, 256}; pg8::StaticOrder S; S.init(M, 1024, Gg, cg_);
          pg8::EpiKV E{B_KF, B_VT};
          pg8::gemm_phase<pg8::EpiKV, pg8::StaticOrder, true, false>((PG8_LAS unsigned char*)lds_raw, g, S, E); } } }
    grid.sync();
    att::attn_phase((ALAS char*)lds_raw, B_Q, B_KF, B_VT, B_YC, B_SSQ);
    { const int G = gridDim.x, bid = blockIdx.x; const int vcu = (G % 8 == 0) ? (bid % 8) * (G / 8) + bid / 8 : bid;
      for (int u = vcu; u < 256; u += G) ssd::chunk_unit((SLAS char*)lds_raw, u >> 5, (u >> 1) & 15, u & 1, B_XT, B_PREV, B_DT, B_ACS2, IN(14), B_U, B_YC, B_SSQS); }
    grid.sync();
    ph_yc_norm(B_YC, B_SSQS, B_SSQ);
    grid.sync();
    { pg8::Gemm g{B_YC, B_WOUT, M, D, D}; pg8::StaticOrder S; S.init(M, D, gridDim.x, (int)blockIdx.x);
      pg8::EpiBf16<0> E{B_YB, D};
      pg8::gemm_phase<pg8::EpiBf16<0>, pg8::StaticOrder, true, true>((PG8_LAS unsigned char*)lds_raw, g, S, E); }
    grid.sync();
    ph_rowrouter(lds, B_YB, IN(0), IN(6), IN(7), B_MOD, B_WRF, IN(23), IN(25), kargs()->out, B_H2, B_CNT, B_RTE, B_RTS, B_RTW);
    grid.sync();
    moe_table(LDS_TP, B_CNT);
    ph_gather(LDS_TP, B_H2, B_RTE, B_RTS, B_RTW, B_HG, B_ROWW, B_TOKROW);
    grid.sync();
    { pg8::Gemm g{B_HG, B_WGU, 0, 0, D}; pg8::GroupedOrder S{(const PG8_LAS int*)LDS_TP, 2, (int)gridDim.x, (int)blockIdx.x};
      pg8::EpiGU E{B_HID, B_ROWW};
      pg8::gemm_phase<pg8::EpiGU, pg8::GroupedOrder, true, true>((PG8_LAS unsigned char*)lds_raw, g, S, E); }
    grid.sync();
    { pg8::Gemm g{B_HID, B_WD, 0, 0, FF}; pg8::GroupedOrder S{(const PG8_LAS int*)LDS_TP, 4, (int)gridDim.x, (int)blockIdx.x};
      pg8::EpiDown E{B_YP};
      pg8::gemm_phase<pg8::EpiDown, pg8::GroupedOrder, true, true>((PG8_LAS unsigned char*)lds_raw, g, S, E); }
    grid.sync();
    ph_moe_final(B_YP, B_TOKROW, IN(8), B_MOD, kargs()->out);
}

extern "C" void kernel_launch(void* const* d_in, const int* in_sizes, int n_in, void* d_out, int out_size, void* d_ws, size_t ws_size,
                              hipStream_t stream) {
    static int grid_blocks = 0;
    if (!grid_blocks) {
        int dev = 0, cus = 0, per_cu = 0;
        (void)hipGetDevice(&dev);
        (void)hipDeviceGetAttribute(&cus, hipDeviceAttributeMultiprocessorCount, dev);
        (void)hipFuncSetAttribute((const void*)mega_fwd, hipFuncAttributeMaxDynamicSharedMemorySize, LDS_BYTES);
        (void)hipOccupancyMaxActiveBlocksPerMultiprocessor(&per_cu, (const void*)mega_fwd, NT, LDS_BYTES);
        if (per_cu < 1) { fprintf(stderr, "occupancy query returned %d\n", per_cu); per_cu = 1; }
        grid_blocks = cus * per_cu;
    }
    Params p{};
    for (int i = 0; i < 29; ++i) p.in[i] = (const float*)d_in[i];
    p.pos = (const int*)d_in[2];
    p.out = (float*)d_out;
    p.ws = (char*)d_ws;
    void* args[] = {&p};
    hipError_t e = hipLaunchCooperativeKernel((void*)mega_fwd, dim3(grid_blocks), dim3(NT), args, LDS_BYTES, stream);
    if (e != hipSuccess) fprintf(stderr, "cooperative launch failed: %s (grid %d)\n", hipGetErrorString(e), grid_blocks);
}
```

```cpp
#include <hip/hip_runtime.h>
#include <hip/hip_cooperative_groups.h>
#include <stdint.h>
#include <math.h>
#include <cstdio>
namespace cg = cooperative_groups;

constexpr int D = 1024, NB = 8, SEQ = 2048, M = NB * SEQ;
constexpr int SSD_H = 8, SSD_P = 64, SSD_INNER = 512, SSD_G = 2, SSD_N = 128, SSD_XBC = 1024;
constexpr int MLA_H = 8, NOPE = 64, ROPE = 32, QK = 96, VD = 64, QR = 256, KVR = 128;
constexpr int NIN = 1960;
constexpr int NU = 2048;
constexpr int OFF_Z = 0, OFF_XBC = 512, OFF_CQ = 1536, OFF_CKV = 1792, OFF_KR = 1920, OFF_DT = 1952;
constexpr int NEXP = 32, FF = 256;
constexpr float EPS = 1e-6f;
constexpr int NT = 512;
constexpr int LDS_BYTES = 152 * 1024;

typedef unsigned short bf16;
__device__ __forceinline__ float bf2f(bf16 v) { return __uint_as_float((unsigned)v << 16); }
__device__ __forceinline__ unsigned f2bf(float f) { unsigned u = __float_as_uint(f); return (u + 0x7fffu + ((u >> 16) & 1u)) >> 16; }
__device__ __forceinline__ unsigned pk2(float lo, float hi) { return f2bf(lo) | (f2bf(hi) << 16); }
typedef unsigned v4u __attribute__((ext_vector_type(4)));
typedef float f32x4v __attribute__((ext_vector_type(4)));

struct Params {
    const float* in[29];
    const int* pos;
    float* out;
    char* ws;
};

__device__ __forceinline__ float ldf(const float* p) { return *p; }
__device__ __forceinline__ float ldf(const bf16* p) { return bf2f(*p); }
extern __shared__ __attribute__((aligned(16))) unsigned char lds_raw[];
constexpr int WTAB_OFF = 152 * 1024 - 256;
__device__ __forceinline__ int hw_wave_key() { int k; asm volatile("s_getreg_b32 %0, hwreg(HW_REG_HW_ID, 0, 6)" : "=s"(k)); return k; }
__device__ __forceinline__ void tidx_init() { const int key = hw_wave_key(); ((volatile __attribute__((address_space(3))) int*)(lds_raw + WTAB_OFF))[key] = (int)(threadIdx.x >> 6); __syncthreads(); }
__device__ __forceinline__ int tidx() {
    const int key = hw_wave_key();
    int w = ((volatile __attribute__((address_space(3))) int*)(lds_raw + WTAB_OFF))[key];
    w = __builtin_amdgcn_readfirstlane(w);
    unsigned ones = ~0u; asm volatile("" : "+s"(ones));
    int t = w * 64 + (int)__builtin_amdgcn_mbcnt_hi(ones, __builtin_amdgcn_mbcnt_lo(ones, 0u));
    asm volatile("" : "+v"(t)); return t; }
typedef const __attribute__((address_space(4))) Params* KArgs;
__device__ __forceinline__ KArgs kargs() { KArgs p = (KArgs)__builtin_amdgcn_kernarg_segment_ptr(); asm volatile("" : "+s"(p)); return p; }
#define IN(i) (kargs()->in[i])
__device__ __forceinline__ float silu_f(float v) { return v / (1.f + expf(-v)); }
__device__ __forceinline__ float wave_sum(float v) {
#pragma unroll
    for (int o = 32; o > 0; o >>= 1) v += __shfl_xor(v, o);
    return v;
}

namespace pg8 {
#define PG8_LAS __attribute__((address_space(3)))
typedef unsigned short bf16_t;
typedef short bf16x8 __attribute__((ext_vector_type(8)));
typedef float f32x4 __attribute__((ext_vector_type(4)));
typedef unsigned u32x4 __attribute__((ext_vector_type(4)));
constexpr int BM = 256, BK = 64, HALF = 128, HTB = HALF * BK * 2  , STAGE_BYTES = 8 * HTB, NXCD = 8, WGM = 8;

__host__ __device__ __forceinline__ int lds_byte(int r, int c) { const int st = (r >> 4) * 2 + (c >> 5), rr = r & 15, cc = c & 31, ob = rr * 64 + cc * 2; return st * 1024 + (ob ^ (((ob >> 9) & 1) << 5)); }
__host__ __device__ __forceinline__ void stage_rc(int b, int& R, int& C) { const int st = b / 1024, sb = b % 1024, swz = sb ^ (((sb >> 9) & 1) << 5); R = (st >> 1) * 16 + swz / 64; C = (st & 1) * 32 + (swz % 64) / 2; }
__host__ __device__ __forceinline__ int perm32(int rho) { const int n = rho >> 4, i = rho & 15; return 8 * (i >> 2) + 4 * n + (i & 3); }

struct Unit { int pm, pn; };
struct Gemm { const bf16_t* A; const bf16_t* Bt; int M, N, K; };

struct StaticOrder {
    int nM, nN, nwg, G, c;
    __host__ __device__ void init(int M, int N, int G_, int c_) { nM = M / BM; nN = N / BM; nwg = nM * nN; G = G_; c = c_; }
    __host__ __device__ bool next(int i, Unit& u) const {
        const long L = (long)i * G + c; if (L >= nwg) return false;
        int wgid = (int)L; { const int q = nwg / NXCD, r = nwg % NXCD, xcd = wgid % NXCD, off = wgid / NXCD; wgid = (xcd < r ? xcd * (q + 1) : r * (q + 1) + (xcd - r) * q) + off; }
        const int nig = WGM * nN, gid = wgid / nig, fm = gid * WGM, gsz = (nM - fm) < WGM ? (nM - fm) : WGM;
        u.pm = fm + ((wgid % nig) % gsz); u.pn = (wgid % nig) / gsz; return true;
    }
    __device__ __forceinline__ void a_ready(const Unit&) const {}
    __device__ __forceinline__ void done(const Unit&) const {}
};


template <int ACT> struct EpiBf16 {
    static constexpr bool PERM = true, AFTER_DRAIN = false;
    bf16_t* O; int ldc;
    __device__ __forceinline__ void operator()(const f32x4 (&acc)[2][2][4][2], const Unit& u, int wr, int wc, int fr, int fq) const {
        { const int l_ = tidx() & 63; fr = l_ & 15; fq = l_ >> 4; }
        const int row0 = u.pm * BM + wr * 64 + fr; const int col0 = u.pn * BM + wc * 32 + 8 * fq;
#pragma unroll
        for (int ai = 0; ai < 2; ++ai)
#pragma unroll
            for (int m = 0; m < 4; ++m) { bf16_t* rowp = O + (size_t)(row0 + ai * HALF + m * 16) * ldc + col0;
#pragma unroll
                for (int bj = 0; bj < 2; ++bj) { const f32x4 v0 = acc[ai][bj][m][0], v1 = acc[ai][bj][m][1];
                    u32x4 w; w.x = pk2(v0[0], v0[1]); w.y = pk2(v0[2], v0[3]); w.z = pk2(v1[0], v1[1]); w.w = pk2(v1[2], v1[3]);
                    *(u32x4*)(rowp + bj * HALF) = w; } }
    }
};

struct EpiQ {
    static constexpr bool PERM = true, AFTER_DRAIN = false;
    bf16_t* Q; const float* COS; const float* SIN;
    __device__ __forceinline__ void operator()(const f32x4 (&acc)[2][2][4][2], const Unit& u, int wr, int wc, int fr, int fq) const {
        { const int l_ = tidx() & 63; fr = l_ & 15; fq = l_ >> 4; }
        const int row0 = u.pm * BM + wr * 64 + fr;
#pragma unroll
        for (int bj = 0; bj < 2; ++bj) {
            const int colg = u.pn * BM + bj * HALF + wc * 32;
            const bool pe = ((colg >> 5) % 3) == 2;
#pragma unroll
            for (int ai = 0; ai < 2; ++ai)
#pragma unroll
                for (int m = 0; m < 4; ++m) {
                    const int row = row0 + ai * HALF + m * 16;
                    f32x4 v0 = acc[ai][bj][m][0], v1 = acc[ai][bj][m][1];
                    if (pe) {
                        f32x4 w0, w1;
#pragma unroll
                        for (int e = 0; e < 4; ++e) { w0[e] = __shfl_xor(v0[e], 32); w1[e] = __shfl_xor(v1[e], 32); }
                        const f32x4* cp = (const f32x4*)(COS + (size_t)row * 16 + (fq & 1) * 8); const f32x4* sp = (const f32x4*)(SIN + (size_t)row * 16 + (fq & 1) * 8);
                        const f32x4 c0 = cp[0], c1 = cp[1], s0 = sp[0], s1 = sp[1];
                        const float sg = (fq < 2) ? -1.f : 1.f;
                        v0 = v0 * c0 + w0 * s0 * sg; v1 = v1 * c1 + w1 * s1 * sg;
                    }
                    u32x4 w; w.x = pk2(v0[0], v0[1]); w.y = pk2(v0[2], v0[3]); w.z = pk2(v1[0], v1[1]); w.w = pk2(v1[2], v1[3]);
                    *(u32x4*)(Q + (size_t)row * 768 + colg + 8 * fq) = w;
                    if (pe) asm volatile("" ::: "memory");
                }
        }
    }
};
struct EpiKV {
    static constexpr bool PERM = true, AFTER_DRAIN = false;
    bf16_t* KF; bf16_t* VT;
    __device__ __forceinline__ void operator()(const f32x4 (&acc)[2][2][4][2], const Unit& u, int wr, int wc, int fr, int fq) const {
        { const int l_ = tidx() & 63; fr = l_ & 15; fq = l_ >> 4; }
        const int row0 = u.pm * BM + wr * 64 + fr;
#pragma unroll
        for (int bj = 0; bj < 2; ++bj) {
            const int colg = u.pn * BM + bj * HALF + wc * 32; const int h = colg >> 7, j0 = (colg & 127) + 8 * fq;
#pragma unroll
            for (int ai = 0; ai < 2; ++ai)
#pragma unroll
                for (int m = 0; m < 4; ++m) {
                    const int t = row0 + ai * HALF + m * 16; const int b = t >> 11, sq = t & 2047, tile = sq >> 6, key = sq & 63;
                    const size_t base = (size_t)((b * 8 + h) * 32 + tile);
                    bf16_t* dst = (j0 < 64) ? KF + base * 6144 + (j0 >> 3) * 512 + key * 8 : VT + base * 4096 + ((j0 - 64) >> 5) * 2048 + key * 32 + ((j0 - 64) & 31);
                    const f32x4 v0 = acc[ai][bj][m][0], v1 = acc[ai][bj][m][1];
                    u32x4 w; w.x = pk2(v0[0], v0[1]); w.y = pk2(v0[2], v0[3]); w.z = pk2(v1[0], v1[1]); w.w = pk2(v1[2], v1[3]);
                    *(u32x4*)dst = w;
                }
        }
    }
};

struct GroupedOrder {
    const PG8_LAS int* tp; int NCT, G, c;
    __device__ __forceinline__ bool next(int i, Unit& u) const {
        const int L = i * G + c, total = tp[32] * NCT; if (L >= total) return false;
        const int rtg = L / NCT, ct = L - rtg * NCT; int e = 0;
        for (int j = 1; j < 32; ++j) e += (tp[j] <= rtg) ? 1 : 0;
        u.pm = rtg; u.pn = e * NCT + ct; return true;
    }
    __device__ __forceinline__ void a_ready(const Unit&) const {}
    __device__ __forceinline__ void done(const Unit&) const {}
};
struct EpiGU {
    static constexpr bool PERM = true, AFTER_DRAIN = false;
    bf16_t* HID; const float* ROWW;
    __device__ __forceinline__ void operator()(const f32x4 (&acc)[2][2][4][2], const Unit& u, int wr, int wc, int fr, int fq) const {
        { const int l_ = tidx() & 63; fr = l_ & 15; fq = l_ >> 4; }
        const int row0 = u.pm * BM + wr * 64 + fr; const int col0 = (u.pn & 1) * 128 + wc * 32 + 8 * fq;
#pragma unroll
        for (int ai = 0; ai < 2; ++ai)
#pragma unroll
            for (int m = 0; m < 4; ++m) { const int row = row0 + ai * HALF + m * 16; const float w = ROWW[row];
                float hv[8];
#pragma unroll
                for (int n = 0; n < 2; ++n)
#pragma unroll
                    for (int e = 0; e < 4; ++e) { const float g = acc[ai][0][m][n][e], up = acc[ai][1][m][n][e]; hv[4 * n + e] = g * __builtin_amdgcn_rcpf(1.f + __expf(-g)) * up * w; }
                u32x4 o; o.x = pk2(hv[0], hv[1]); o.y = pk2(hv[2], hv[3]); o.z = pk2(hv[4], hv[5]); o.w = pk2(hv[6], hv[7]);
                *(u32x4*)(HID + (size_t)row * 256 + col0) = o; }
    }
};
struct EpiDown {
    static constexpr bool PERM = true, AFTER_DRAIN = false;
    bf16_t* YP;
    __device__ __forceinline__ void operator()(const f32x4 (&acc)[2][2][4][2], const Unit& u, int wr, int wc, int fr, int fq) const {
        { const int l_ = tidx() & 63; fr = l_ & 15; fq = l_ >> 4; }
        const int row0 = u.pm * BM + wr * 64 + fr; const int col0 = (u.pn & 3) * BM + wc * 32 + 8 * fq;
#pragma unroll
        for (int ai = 0; ai < 2; ++ai)
#pragma unroll
            for (int m = 0; m < 4; ++m) { bf16_t* rowp = YP + (size_t)(row0 + ai * HALF + m * 16) * 1024 + col0;
#pragma unroll
                for (int bj = 0; bj < 2; ++bj) { const f32x4 v0 = acc[ai][bj][m][0], v1 = acc[ai][bj][m][1];
                    u32x4 w; w.x = pk2(v0[0], v0[1]); w.y = pk2(v0[2], v0[3]); w.z = pk2(v1[0], v1[1]); w.w = pk2(v1[2], v1[3]);
                    *(u32x4*)(rowp + bj * HALF) = w; } }
    }
};
template <class Epi, class Sched, bool ALIGN_EPI = false, bool SP2 = false>
__device__ __forceinline__ void gemm_phase(PG8_LAS unsigned char* lds, const Gemm g, const Sched& S, const Epi& E) {
    const int tid = tidx(), wid = __builtin_amdgcn_readfirstlane(tid >> 6), lane = tid & 63, wr = wid >> 2, wc = wid & 3, fr = lane & 15, fq = lane >> 4;
    const int K = g.K, nt = K / BK;
    unsigned voffA[2], voffB[2];
#pragma unroll
    for (int i = 0; i < 2; ++i) { int R, C; stage_rc(tid * 16 + i * 8192, R, C); const int Rb = Epi::PERM ? ((R & ~31) + perm32(R & 31)) : R;
        voffA[i] = (unsigned)(R * K + C) * 2u; voffB[i] = (unsigned)(Rb * K + C) * 2u; }
    const size_t kstep = (size_t)(BK * 2);
    const size_t hstep = (size_t)HALF * K * 2;
    const size_t tstep = 2 * hstep;
    const unsigned ldsw = (unsigned)wid * 1024u;
    const int aoff = lds_byte(wr * 64 + fr, fq * 8), boff = lds_byte(wc * 32 + fr, fq * 8);
#define PG8_SA(b, h) (((b) * 2 + (h)) * HTB)
#define PG8_SB(b, h) ((4 + (b) * 2 + (h)) * HTB)
#define PG8_STAGE(bufoff, gbase, voff) do { _Pragma("unroll") for (int _i = 0; _i < 2; ++_i) \
        __builtin_amdgcn_global_load_lds((const unsigned*)((const char*)(gbase) + (voff)[_i]), (PG8_LAS unsigned*)(lds + (bufoff) + ldsw + _i * 8192), 16, 0, 0); } while (0)
#define PG8_LDA(dst, b, h) do { _Pragma("unroll") for (int m = 0; m < 4; ++m) _Pragma("unroll") for (int k = 0; k < 2; ++k) dst[m][k] = *(const PG8_LAS bf16x8*)(lds + PG8_SA(b, h) + aoff + m * 2048 + k * 1024); } while (0)
#define PG8_LDB(dst, b, h) do { _Pragma("unroll") for (int n = 0; n < 2; ++n) _Pragma("unroll") for (int k = 0; k < 2; ++k) dst[n][k] = *(const PG8_LAS bf16x8*)(lds + PG8_SB(b, h) + boff + n * 2048 + k * 1024); } while (0)
#define PG8_MMA(ai, bj, At, Bt) do { __builtin_amdgcn_s_setprio(1); _Pragma("unroll") for (int m = 0; m < 4; ++m) _Pragma("unroll") for (int n = 0; n < 2; ++n) _Pragma("unroll") for (int k = 0; k < 2; ++k) \
        acc[ai][bj][m][n] = __builtin_amdgcn_mfma_f32_16x16x32_bf16(Bt[n][k], At[m][k], acc[ai][bj][m][n], 0, 0, 0); __builtin_amdgcn_s_setprio(0); } while (0)
#define PG8_WAIT_V(n) asm volatile("s_waitcnt vmcnt(" #n ")" ::: "memory")
#define PG8_WAIT_L(n) asm volatile("s_waitcnt lgkmcnt(" #n ")" ::: "memory")
#define PG8_BAR __builtin_amdgcn_s_barrier()
#define PG8_SCHED __builtin_amdgcn_sched_barrier(0)
    Unit cur, nxt; int ui = 0;
    if (!S.next(0, cur)) return;
    f32x4 acc[2][2][4][2];
#pragma unroll
    for (int a = 0; a < 2; ++a)
#pragma unroll
        for (int b = 0; b < 2; ++b)
#pragma unroll
            for (int m = 0; m < 4; ++m)
#pragma unroll
                for (int n = 0; n < 2; ++n) acc[a][b][m][n] = (f32x4){0.f, 0.f, 0.f, 0.f};
    bf16x8 At[4][2], B0[2][2], B1[2][2];
    const char* cA = (const char*)g.A + (size_t)cur.pm * tstep; const char* cB = (const char*)g.Bt + (size_t)cur.pn * tstep;
    S.a_ready(cur);
    if constexpr (SP2) {
        PG8_STAGE(PG8_SB(0, 0), cB, voffB); PG8_STAGE(PG8_SB(0, 1), cB + hstep, voffB); PG8_STAGE(PG8_SA(0, 0), cA, voffA); PG8_STAGE(PG8_SA(0, 1), cA + hstep, voffA);
        if (wr == 1) PG8_BAR;
        PG8_WAIT_V(2); PG8_BAR;
        PG8_STAGE(PG8_SB(1, 0), cB + kstep, voffB); PG8_STAGE(PG8_SA(1, 0), cA + kstep, voffA); PG8_STAGE(PG8_SB(1, 1), cB + hstep + kstep, voffB);
        PG8_WAIT_V(6); PG8_BAR;
    } else {
        PG8_STAGE(PG8_SB(0, 0), cB, voffB); PG8_STAGE(PG8_SA(0, 0), cA, voffA); PG8_STAGE(PG8_SB(0, 1), cB + hstep, voffB); PG8_STAGE(PG8_SA(0, 1), cA + hstep, voffA);
        if (wr == 1) PG8_BAR;
        PG8_WAIT_V(4); PG8_BAR;
        PG8_STAGE(PG8_SB(1, 0), cB + kstep, voffB); PG8_STAGE(PG8_SA(1, 0), cA + kstep, voffA); PG8_STAGE(PG8_SB(1, 1), cB + hstep + kstep, voffB);
        PG8_WAIT_V(6); PG8_BAR;
    }
    for (;;) {
        const bool has_next = S.next(ui + 1, nxt);
        const char* nA = has_next ? (const char*)g.A + (size_t)nxt.pm * tstep : cA; const char* nB = has_next ? (const char*)g.Bt + (size_t)nxt.pn * tstep : cB;
        for (int t = 0; t < nt; t += 2) {
            const bool last = (t == nt - 2);
            const char* a1 = cA + (size_t)(t + 1) * kstep;
            const char* a2 = last ? nA : cA + (size_t)(t + 2) * kstep; const char* b2 = last ? nB : cB + (size_t)(t + 2) * kstep;
            const char* a3 = a2 + kstep; const char* b3 = b2 + kstep;
            if (last && has_next) S.a_ready(nxt);
            if constexpr (SP2) {
            PG8_LDB(B0, 0, 0); PG8_LDB(B1, 0, 1); PG8_SCHED; PG8_LDA(At, 0, 0); PG8_STAGE(PG8_SA(1, 1), a1 + hstep, voffA);
            PG8_WAIT_V(8); PG8_WAIT_L(0); PG8_BAR; PG8_MMA(0, 0, At, B0); PG8_MMA(0, 1, At, B1); PG8_BAR; PG8_SCHED;
            PG8_LDA(At, 0, 1); PG8_STAGE(PG8_SB(0, 0), b2, voffB); PG8_STAGE(PG8_SB(0, 1), b2 + hstep, voffB); PG8_STAGE(PG8_SA(0, 0), a2, voffA);
            PG8_WAIT_V(8); PG8_WAIT_L(0); PG8_BAR; PG8_MMA(1, 0, At, B0); PG8_MMA(1, 1, At, B1); PG8_BAR; PG8_SCHED;
            PG8_LDB(B0, 1, 0); PG8_LDB(B1, 1, 1); PG8_SCHED; PG8_LDA(At, 1, 0); PG8_STAGE(PG8_SA(0, 1), a2 + hstep, voffA);
            PG8_WAIT_V(8); PG8_WAIT_L(0); PG8_BAR; PG8_MMA(0, 0, At, B0); PG8_MMA(0, 1, At, B1); PG8_BAR; PG8_SCHED;
            PG8_LDA(At, 1, 1); PG8_STAGE(PG8_SB(1, 0), b3, voffB); PG8_STAGE(PG8_SB(1, 1), b3 + hstep, voffB); PG8_STAGE(PG8_SA(1, 0), a3, voffA);
            PG8_WAIT_V(8); PG8_WAIT_L(0); PG8_BAR; PG8_MMA(1, 0, At, B0); PG8_MMA(1, 1, At, B1); PG8_BAR; PG8_SCHED;
            } else {
            PG8_LDB(B0, 0, 0); PG8_SCHED; PG8_LDA(At, 0, 0); PG8_STAGE(PG8_SA(1, 1), a1 + hstep, voffA);
            PG8_WAIT_L(8); PG8_BAR; PG8_WAIT_L(0); PG8_MMA(0, 0, At, B0); PG8_BAR; PG8_SCHED;
            PG8_LDB(B1, 0, 1); PG8_STAGE(PG8_SB(0, 0), b2, voffB);
            PG8_BAR; PG8_WAIT_L(0); PG8_MMA(0, 1, At, B1); PG8_BAR;
            PG8_LDA(At, 0, 1); PG8_STAGE(PG8_SA(0, 0), a2, voffA);
            PG8_BAR; PG8_WAIT_L(0); PG8_MMA(1, 0, At, B0); PG8_BAR; PG8_SCHED;
            PG8_STAGE(PG8_SB(0, 1), b2 + hstep, voffB);
            PG8_WAIT_V(6); PG8_BAR; PG8_MMA(1, 1, At, B1); PG8_BAR;
            PG8_LDB(B0, 1, 0); PG8_SCHED; PG8_LDA(At, 1, 0); PG8_STAGE(PG8_SA(0, 1), a2 + hstep, voffA);
            PG8_WAIT_L(8); PG8_BAR; PG8_WAIT_L(0); PG8_MMA(0, 0, At, B0); PG8_BAR; PG8_SCHED;
            PG8_LDB(B1, 1, 1); PG8_STAGE(PG8_SB(1, 0), b3, voffB);
            PG8_BAR; PG8_WAIT_L(0); PG8_MMA(0, 1, At, B1); PG8_BAR;
            PG8_LDA(At, 1, 1); PG8_STAGE(PG8_SA(1, 0), a3, voffA);
            PG8_BAR; PG8_WAIT_L(0); PG8_MMA(1, 0, At, B0); PG8_BAR; PG8_SCHED;
            PG8_STAGE(PG8_SB(1, 1), b3 + hstep, voffB);
            PG8_WAIT_V(6); PG8_BAR; PG8_MMA(1, 1, At, B1); PG8_BAR;
            }
        }
        if constexpr (ALIGN_EPI) { if (wr == 0) PG8_BAR; }
        if constexpr (!Epi::AFTER_DRAIN) { E(acc, cur, wr, wc, fr, fq); S.done(cur); }
        if (!has_next) break;
#pragma unroll
        for (int a = 0; a < 2; ++a)
#pragma unroll
            for (int b = 0; b < 2; ++b)
#pragma unroll
                for (int m = 0; m < 4; ++m)
#pragma unroll
                    for (int n = 0; n < 2; ++n) acc[a][b][m][n] = (f32x4){0.f, 0.f, 0.f, 0.f};
        cur = nxt; cA = nA; cB = nB; ++ui;
        if constexpr (ALIGN_EPI) { if (wr == 1) PG8_BAR; }
    }
    PG8_WAIT_V(0);
    if constexpr (!ALIGN_EPI) { if (wr == 0) PG8_BAR; }
    PG8_BAR;
    if constexpr (Epi::AFTER_DRAIN) { E.fused(acc, cur, wr, wc, fr, fq, lds, wid, lane); S.done(cur); }
#undef PG8_SA
#undef PG8_SB
#undef PG8_STAGE
#undef PG8_LDA
#undef PG8_LDB
#undef PG8_MMA
#undef PG8_WAIT_V
#undef PG8_WAIT_L
#undef PG8_BAR
#undef PG8_SCHED
}
}


template <class ColFn, class GainFn>
__device__ __forceinline__ void transpose_item(const float* src, int ldsrc, int Kreal, ColFn colfn, GainFn gain, bf16* dst, int K, int k0, int n0, float* scr, int lane) {
    const int n = n0 + (lane & 31); const int c = colfn(n);
#pragma unroll 8
    for (int i = 0; i < 32; ++i) { const int kk = 2 * i + (lane >> 5), k = k0 + kk;
        float v = 0.f; if (c >= 0 && k < Kreal) v = src[(size_t)k * ldsrc + c] * gain(k);
        scr[kk * 33 + (lane & 31)] = v; }
    asm volatile("s_waitcnt lgkmcnt(0)" ::: "memory");
    const int c8 = lane & 7;
#pragma unroll
    for (int j = 0; j < 4; ++j) { const int nn = (lane >> 3) + 8 * j; const float* s = scr + (8 * c8) * 33 + nn;
        v4u o; o.x = pk2(s[0 * 33], s[1 * 33]); o.y = pk2(s[2 * 33], s[3 * 33]); o.z = pk2(s[4 * 33], s[5 * 33]); o.w = pk2(s[6 * 33], s[7 * 33]);
        *(v4u*)(dst + (size_t)(n0 + nn) * K + k0 + 8 * c8) = o; }
    asm volatile("s_waitcnt lgkmcnt(0)" ::: "memory");
}
__device__ __forceinline__ int win_col(int n) {
    if (n < 1536) return n;
    if (n < 1792) return n - 1536 + 1544;
    if (n < 1920) return n - 1792 + 1800;
    if (n < 1952) return n - 1920 + 1928;
    if (n < 1960) return n - 1952 + 1536;
    return -1;
}
__device__ void ph_prep(float* lds, float* mod, bf16* WIN_T, bf16* WOUT_T, bf16* WUQ_T, bf16* WUKV_T, bf16* WGU_T, bf16* WD_T, bf16* WRF, int* CNT) {
    const int tid = tidx(), lane = tid & 63, wave = tid >> 6;
    if (blockIdx.x < 6 * D / 64) {
        float* sc = lds;
        float* part = lds + 8 * D;
        const float* c = IN(1); const float* ada_w = IN(3); const float* ada_b = IN(4);
        for (int i = tid; i < NB * D; i += NT) sc[i] = silu_f(c[i]);
        __syncthreads();
        const int j = blockIdx.x * 64 + lane;
        float acc[NB];
#pragma unroll
        for (int b = 0; b < NB; ++b) acc[b] = 0.f;
        for (int k = wave * 128; k < wave * 128 + 128; ++k) {
            const float w = ada_w[(size_t)k * 6 * D + j];
#pragma unroll
            for (int b = 0; b < NB; ++b) acc[b] += sc[b * D + k] * w;
        }
#pragma unroll
        for (int b = 0; b < NB; ++b) part[(wave * NB + b) * 64 + lane] = acc[b];
        __syncthreads();
        { const int b = tid >> 6;
          float s = ada_b[j];
#pragma unroll
          for (int w = 0; w < 8; ++w) s += part[(w * NB + b) * 64 + lane];
          mod[b * 6 * D + j] = s; }
        __syncthreads();
    }
    float* scr = lds + wave * (64 * 33);
    const int gw = (gridDim.x - 1 - blockIdx.x) * (NT / 64) + wave, ngw = gridDim.x * (NT / 64);
    constexpr int I_IN = (D / 64) * (NU / 32), I_OUT = (D / 64) * (D / 32), I_UQ = (QR / 64) * (768 / 32), I_UKV = (256 / 64) * (1024 / 32);
    const float* ssd_norm = IN(15); const float* q_norm = IN(16); const float* kv_norm = IN(18); const float* mla_norm = IN(20);
    if (blockIdx.x == 0 && tid < 64) CNT[tid] = 0;
    for (int ch = blockIdx.x * NT + tid; ch < 32 * 3 * 64; ch += gridDim.x * NT) {
        const int ln = ch & 63, cb = (ch >> 6) % 3, sk = ch / 192; const int col = 16 * cb + (ln & 15);
        const float* wgr = IN(22); const float* wer = IN(24);
        unsigned hi4[4], lo4[4];
#pragma unroll
        for (int j = 0; j < 8; j += 2) { float v[2];
#pragma unroll
            for (int q = 0; q < 2; ++q) { const int k = 32 * sk + 8 * (ln >> 4) + j + q; v[q] = (col < 4) ? wgr[k * 4 + col] : (col < 36 ? wer[k * 32 + col - 4] : 0.f); }
            const unsigned h0 = f2bf(v[0]), h1 = f2bf(v[1]);
            hi4[j >> 1] = h0 | (h1 << 16); lo4[j >> 1] = pk2(v[0] - __uint_as_float(h0 << 16), v[1] - __uint_as_float(h1 << 16)); }
        v4u* dst = (v4u*)(WRF + ((size_t)(sk * 3 + cb) * 2) * 512 + ln * 8);
        dst[0] = (v4u){hi4[0], hi4[1], hi4[2], hi4[3]}; dst[64] = (v4u){lo4[0], lo4[1], lo4[2], lo4[3]};
    }
    constexpr int I_GU = NEXP * (D / 64) * (512 / 32), I_DN = NEXP * (FF / 64) * (D / 32);
    for (int it = gw; it < I_IN + I_OUT + I_UQ + I_UKV + I_GU + I_DN; it += ngw) {
        int r = it;
        if (r < I_IN) { const int nb = NU / 32; transpose_item(IN(9), NIN, D, [](int n) { return win_col(n); }, [](int) { return 1.f; }, WIN_T, D, (r / nb) * 64, (r % nb) * 32, scr, lane); continue; }
        r -= I_IN;
        if (r < I_OUT) { const int nb = D / 32; transpose_item(IN(21), D, D, [](int n) { return n; }, [=](int k) { return k < 512 ? ssd_norm[k] : mla_norm[k - 512]; }, WOUT_T, D, (r / nb) * 64, (r % nb) * 32, scr, lane); continue; }
        r -= I_OUT;
        if (r < I_UQ) { const int nb = 768 / 32; transpose_item(IN(17), 768, QR, [](int n) { return n; }, [=](int k) { return q_norm[k] * 0.14724444f; }, WUQ_T, QR, (r / nb) * 64, (r % nb) * 32, scr, lane); continue; }
        r -= I_UQ;
        if (r >= I_UQ + I_UKV - I_UQ) {
            r -= I_UKV;
            if (r < I_GU) { const int e = r / 256, q = r % 256, kb = q / 16, nb = q % 16;
                const int ct = nb >> 3, rr = (nb & 7) * 32; const float* src = (rr < 128 ? IN(26) : IN(27)) + (size_t)e * D * FF; const int cbase = 128 * ct + (rr & 127) - 32 * nb;
                transpose_item(src, FF, D, [=](int n) { return n + cbase; }, [](int) { return 1.f; }, WGU_T + (size_t)e * 512 * D, D, kb * 64, nb * 32, scr, lane); continue; }
            r -= I_GU;
            { const int e = r / 128, q = r % 128, kb = q / 32, nb = q % 32;
              transpose_item(IN(28) + (size_t)e * FF * D, D, FF, [](int n) { return n; }, [](int) { return 1.f; }, WD_T + (size_t)e * D * FF, FF, kb * 64, nb * 32, scr, lane); continue; }
        }
        { const int nb = 1024 / 32; transpose_item(IN(19), 1024, KVR, [](int n) { return n; }, [=](int k) { return k < KVR ? kv_norm[k] : 0.f; }, WUKV_T, 256, (r / nb) * 64, (r % nb) * 32, scr, lane); }
    }
}

__device__ void ph_prenorm_bf16(const float* in, const float* g, const float* mod, int sh_off, int sc_off, bf16* out) {
    const int lane = tidx() & 63, gw = blockIdx.x * (NT / 64) + (tidx() >> 6), ngw = gridDim.x * (NT / 64);
    for (int t = gw; t < M; t += ngw) {
        const int b = t / SEQ; const f32x4v* r = (const f32x4v*)(in + (size_t)t * D) + lane;
        f32x4v v[4]; float s = 0.f;
#pragma unroll
        for (int j = 0; j < 4; ++j) { v[j] = r[64 * j]; s += (v[j].x * v[j].x + v[j].y * v[j].y) + (v[j].z * v[j].z + v[j].w * v[j].w); }
        const float inv = rsqrtf(wave_sum(s) / D + EPS);
        const f32x4v* gp = (const f32x4v*)g + lane; const f32x4v* scp = (const f32x4v*)(mod + b * 6 * D + sc_off) + lane; const f32x4v* shp = (const f32x4v*)(mod + b * 6 * D + sh_off) + lane;
        unsigned long long* o8 = (unsigned long long*)(out + (size_t)t * D) + lane;
#pragma unroll
        for (int j = 0; j < 4; ++j) { const f32x4v gg = gp[64 * j], sc = scp[64 * j], sh = shp[64 * j];
            const f32x4v h = v[j] * inv * gg * (sc + 1.f) + sh;
            o8[64 * j] = (unsigned long long)pk2(h.x, h.y) | ((unsigned long long)pk2(h.z, h.w) << 32); }
    }
}


__device__ void ph_prep2(const bf16* U, const int* pos, const float* conv_w, const float* conv_b, const float* dt_bias,
                         bf16* CQN, bf16* CKVN, bf16* KF, float* COS, float* SIN, float* DT, bf16* XC) {
    const int lane = tidx() & 63, gw = blockIdx.x * (NT / 64) + (tidx() >> 6), ngw = gridDim.x * (NT / 64);
    const int rows_per = (M + ngw - 1) / ngw;
    for (int t = gw * rows_per; t < (gw + 1) * rows_per && t < M; ++t) {
        const int sq = t & (SEQ - 1), b = t >> 11;
        const bf16* ur = U + (size_t)t * NU;
        { const uint2 w = *(const uint2*)(ur + OFF_CQ + lane * 4);
          const float a0 = __uint_as_float(w.x << 16), a1 = __uint_as_float(w.x & 0xffff0000u), a2 = __uint_as_float(w.y << 16), a3 = __uint_as_float(w.y & 0xffff0000u);
          const float inv = rsqrtf(wave_sum(a0 * a0 + a1 * a1 + a2 * a2 + a3 * a3) * (1.f / QR) + EPS);
          uint2 o; o.x = pk2(a0 * inv, a1 * inv); o.y = pk2(a2 * inv, a3 * inv);
          *(uint2*)(CQN + (size_t)t * QR + lane * 4) = o; }
        { const unsigned w = *(const unsigned*)(ur + OFF_CKV + lane * 2);
          const float a0 = __uint_as_float(w << 16), a1 = __uint_as_float(w & 0xffff0000u);
          const float inv = rsqrtf(wave_sum(a0 * a0 + a1 * a1) * (1.f / KVR) + EPS);
          *(unsigned*)(CKVN + (size_t)t * 256 + lane * 2) = pk2(a0 * inv, a1 * inv);
          *(unsigned*)(CKVN + (size_t)t * 256 + 128 + lane * 2) = 0u; }
        { const int i = lane & 15;
          const float x1 = bf2f(ur[OFF_KR + i]), x2 = bf2f(ur[OFF_KR + 16 + i]);
          const float inv = exp2f(-(float)i * (13.287712379549449f / 16.0f));
          const float ang = (float)pos[t] * inv;
          float sn, cs; sincosf(ang, &sn, &cs);
          if (lane < 16) { COS[(size_t)t * 16 + i] = cs; SIN[(size_t)t * 16 + i] = sn; }
          const float r1 = x1 * cs - x2 * sn, r2 = x2 * cs + x1 * sn;
          const int cc = lane & 3, hh = (lane >> 2) & 7;
          float e[8];
#pragma unroll
          for (int j = 0; j < 8; ++j) { const float p1 = __shfl(r1, (cc & 1) * 8 + j), p2 = __shfl(r2, (cc & 1) * 8 + j); e[j] = (cc >> 1) ? p2 : p1; }
          if (lane < 32) { v4u o; o.x = pk2(e[0], e[1]); o.y = pk2(e[2], e[3]); o.z = pk2(e[4], e[5]); o.w = pk2(e[6], e[7]);
            *(v4u*)(KF + (size_t)((b * 8 + hh) * 32 + (sq >> 6)) * 6144 + (8 + cc) * 512 + (sq & 63) * 8) = o; } }
        if (lane < 8) { const float raw = bf2f(ur[OFF_DT + lane]) + dt_bias[lane]; DT[(size_t)t * 8 + lane] = raw > 20.f ? raw : log1pf(expf(raw)); }
        { const int ch = lane * 16;
          float acc[16];
          { const f32x4v* bp = (const f32x4v*)(conv_b + ch);
#pragma unroll
            for (int q4 = 0; q4 < 4; ++q4) { const f32x4v bb = bp[q4]; acc[4 * q4] = bb.x; acc[4 * q4 + 1] = bb.y; acc[4 * q4 + 2] = bb.z; acc[4 * q4 + 3] = bb.w; } }
#pragma unroll
          for (int k = 0; k < 4; ++k) {
              if (sq - 3 + k >= 0) {
                  const v4u* xp = (const v4u*)(U + (size_t)(t - 3 + k) * NU + OFF_XBC + ch);
                  const v4u xa = xp[0], xb = xp[1];
                  const f32x4v* wp = (const f32x4v*)(conv_w + k * SSD_XBC + ch);
                  const unsigned xw[8] = {xa.x, xa.y, xa.z, xa.w, xb.x, xb.y, xb.z, xb.w};
#pragma unroll
                  for (int q4 = 0; q4 < 4; ++q4) { const f32x4v ww = wp[q4];
                      acc[4 * q4] += ww.x * __uint_as_float(xw[2 * q4] << 16); acc[4 * q4 + 1] += ww.y * __uint_as_float(xw[2 * q4] & 0xffff0000u);
                      acc[4 * q4 + 2] += ww.z * __uint_as_float(xw[2 * q4 + 1] << 16); acc[4 * q4 + 3] += ww.w * __uint_as_float(xw[2 * q4 + 1] & 0xffff0000u); }
              }
          }
          v4u o0, o1;
          o0.x = pk2(silu_f(acc[0]), silu_f(acc[1])); o0.y = pk2(silu_f(acc[2]), silu_f(acc[3])); o0.z = pk2(silu_f(acc[4]), silu_f(acc[5])); o0.w = pk2(silu_f(acc[6]), silu_f(acc[7]));
          o1.x = pk2(silu_f(acc[8]), silu_f(acc[9])); o1.y = pk2(silu_f(acc[10]), silu_f(acc[11])); o1.z = pk2(silu_f(acc[12]), silu_f(acc[13])); o1.w = pk2(silu_f(acc[14]), silu_f(acc[15]));
          { bf16* base = XC + (size_t)(t >> 7) * 131072; const int l = t & 127;
            if (ch < 512) { v4u* op = (v4u*)(base + (ch >> 6) * 8192 + ((ch & 63) >> 5) * 4096 + l * 32 + (ch & 31)); op[0] = o0; op[1] = o1; }
            else { const int c2 = ch - 512; bf16* q = base + 65536 + (c2 >> 7) * 16384 + ((c2 & 127) >> 3) * 1024 + l * 8; *(v4u*)q = o0; *(v4u*)(q + 1024) = o1; } } }
    }
}


typedef short bf16x8v __attribute__((ext_vector_type(8)));
__device__ void ph_rowrouter(float* ldsf, const bf16* Yb, const float* x, const float* post_gain, const float* pre_gain, const float* mod, const bf16* WRF,
                             const float* bgr, const float* ber, float* out, bf16* H2, int* CNT, int* RT_E, int* RT_S, float* RT_W) {
    const int tid = tidx(), lane = tid & 63, wave = tid >> 6, row = lane & 15, kg = lane >> 4;
    const int gw = blockIdx.x * (NT / 64) + wave, ngw = gridDim.x * (NT / 64);
    float* L = ldsf + wave * (16 * 48);
    for (int item = gw; item < M / 16; item += ngw) {
        const int t = item * 16 + row, b = t >> 11;
        const bf16* yr = Yb + (size_t)t * D + 8 * kg; const float* xr = x + (size_t)t * D + 8 * kg; float* orow = out + (size_t)t * D + 8 * kg;
        const float* g1 = mod + b * 6 * D + 2 * D + 8 * kg; const float* sc2 = mod + b * 6 * D + 4 * D + 8 * kg; const float* sh2 = mod + b * 6 * D + 3 * D + 8 * kg;
        float ssy = 0.f;
#pragma unroll 4
        for (int sk = 0; sk < 32; ++sk) { const v4u w = *(const v4u*)(yr + 32 * sk);
#pragma unroll
            for (int e = 0; e < 4; ++e) { const float a = __uint_as_float(w[e] << 16), c = __uint_as_float(w[e] & 0xffff0000u); ssy += a * a + c * c; } }
        ssy += __shfl_xor(ssy, 16); ssy += __shfl_xor(ssy, 32);
        const float invy = rsqrtf(ssy * (1.f / D) + EPS);
        float ss1 = 0.f;
#pragma unroll 2
        for (int sk = 0; sk < 32; ++sk) { const v4u w = *(const v4u*)(yr + 32 * sk);
            const f32x4v xa = *(const f32x4v*)(xr + 32 * sk), xb = *(const f32x4v*)(xr + 32 * sk + 4);
            const f32x4v ga = *(const f32x4v*)(g1 + 32 * sk), gb = *(const f32x4v*)(g1 + 32 * sk + 4);
            const f32x4v pa = *(const f32x4v*)(post_gain + 8 * kg + 32 * sk), pb = *(const f32x4v*)(post_gain + 8 * kg + 32 * sk + 4);
            f32x4v ya, yb; ya.x = __uint_as_float(w.x << 16); ya.y = __uint_as_float(w.x & 0xffff0000u); ya.z = __uint_as_float(w.y << 16); ya.w = __uint_as_float(w.y & 0xffff0000u);
            yb.x = __uint_as_float(w.z << 16); yb.y = __uint_as_float(w.z & 0xffff0000u); yb.z = __uint_as_float(w.w << 16); yb.w = __uint_as_float(w.w & 0xffff0000u);
            const f32x4v oa = xa + ga * (ya * invy * pa), ob = xb + gb * (yb * invy * pb);
            *(f32x4v*)(orow + 32 * sk) = oa; *(f32x4v*)(orow + 32 * sk + 4) = ob;
            ss1 += (oa.x * oa.x + oa.y * oa.y) + (oa.z * oa.z + oa.w * oa.w) + (ob.x * ob.x + ob.y * ob.y) + (ob.z * ob.z + ob.w * ob.w); }
        ss1 += __shfl_xor(ss1, 16); ss1 += __shfl_xor(ss1, 32);
        const float inv1 = rsqrtf(ss1 * (1.f / D) + EPS);
        f32x4v acc0 = {0.f, 0.f, 0.f, 0.f}, acc1 = acc0, acc2 = acc0;
        bf16* hrow = H2 + (size_t)t * D + 8 * kg;
#pragma unroll 2
        for (int sk = 0; sk < 32; ++sk) {
            const f32x4v xa = *(const f32x4v*)(orow + 32 * sk), xb = *(const f32x4v*)(orow + 32 * sk + 4);
            const f32x4v pa = *(const f32x4v*)(pre_gain + 8 * kg + 32 * sk), pb = *(const f32x4v*)(pre_gain + 8 * kg + 32 * sk + 4);
            const f32x4v ca = *(const f32x4v*)(sc2 + 32 * sk), cb = *(const f32x4v*)(sc2 + 32 * sk + 4);
            const f32x4v sa = *(const f32x4v*)(sh2 + 32 * sk), sb = *(const f32x4v*)(sh2 + 32 * sk + 4);
            const f32x4v ha = xa * inv1 * pa * (ca + 1.f) + sa, hb = xb * inv1 * pb * (cb + 1.f) + sb;
            const float hv[8] = {ha.x, ha.y, ha.z, ha.w, hb.x, hb.y, hb.z, hb.w};
            unsigned hw[4], lw[4];
#pragma unroll
            for (int e = 0; e < 4; ++e) { const unsigned h0 = f2bf(hv[2 * e]), h1 = f2bf(hv[2 * e + 1]); hw[e] = h0 | (h1 << 16);
                lw[e] = pk2(hv[2 * e] - __uint_as_float(h0 << 16), hv[2 * e + 1] - __uint_as_float(h1 << 16)); }
            const v4u hq = {hw[0], hw[1], hw[2], hw[3]}, lq = {lw[0], lw[1], lw[2], lw[3]};
            *(v4u*)(hrow + 32 * sk) = hq;
            const bf16x8v a_hi = __builtin_bit_cast(bf16x8v, hq), a_lo = __builtin_bit_cast(bf16x8v, lq);
            const v4u* bp = (const v4u*)(WRF + (size_t)(sk * 3) * 2 * 512 + lane * 8);
#define RSTEP(ACC, cb_) do { const bf16x8v bh_ = __builtin_bit_cast(bf16x8v, bp[(cb_) * 128]), bl_ = __builtin_bit_cast(bf16x8v, bp[(cb_) * 128 + 64]); \
                ACC = __builtin_amdgcn_mfma_f32_16x16x32_bf16(a_hi, bh_, ACC, 0, 0, 0); ACC = __builtin_amdgcn_mfma_f32_16x16x32_bf16(a_lo, bh_, ACC, 0, 0, 0); \
                ACC = __builtin_amdgcn_mfma_f32_16x16x32_bf16(a_hi, bl_, ACC, 0, 0, 0); } while (0)
            RSTEP(acc0, 0); RSTEP(acc1, 1); RSTEP(acc2, 2);
#undef RSTEP
        }
#pragma unroll
        for (int j = 0; j < 4; ++j) { L[(4 * kg + j) * 48 + row] = acc0[j]; L[(4 * kg + j) * 48 + 16 + row] = acc1[j]; L[(4 * kg + j) * 48 + 32 + row] = acc2[j]; }
        asm volatile("s_waitcnt lgkmcnt(0)" ::: "memory");
        if (lane < 16) {
            const float* lr = L + lane * 48;
            float mxv = -INFINITY; int gi = 0;
            for (int i = 0; i < 4; ++i) { const float v = lr[i] + bgr[i]; if (v > mxv) { mxv = v; gi = i; } }
            float den = 0.f; for (int i = 0; i < 4; ++i) den += expf(lr[i] + bgr[i] - mxv);
            const float gwt = 1.f / den;
            float v1 = -INFINITY, v2 = -INFINITY; int i1 = 0, i2 = 0;
            for (int i = 0; i < 8; ++i) { const float v = lr[4 + gi * 8 + i] + ber[gi * 8 + i];
                if (v > v1) { v2 = v1; i2 = i1; v1 = v; i1 = i; } else if (v > v2) { v2 = v; i2 = i; } }
            const float p2 = expf(v2 - v1);
            const int e1 = gi * 8 + i1, e2 = gi * 8 + i2, tt = item * 16 + lane;
            const int s1 = atomicAdd(&CNT[e1], 1), s2 = atomicAdd(&CNT[e2], 1);
            RT_E[tt] = e1 | (e2 << 8); RT_S[2 * tt] = s1; RT_S[2 * tt + 1] = s2; RT_W[2 * tt] = gwt / (1.f + p2); RT_W[2 * tt + 1] = gwt * p2 / (1.f + p2);
        }
        asm volatile("s_waitcnt lgkmcnt(0)" ::: "memory");
    }
}
__device__ __forceinline__ void moe_table(int* tp, const int* CNT) {
    const int tid = tidx();
    __syncthreads();
    if (tid < 64) { const int c = (tid < 32) ? __hip_atomic_load(CNT + tid, __ATOMIC_RELAXED, __HIP_MEMORY_SCOPE_AGENT) : 0; int v = (c + 255) >> 8;
        int inc = v;
#pragma unroll
        for (int o = 1; o < 64; o <<= 1) { const int n = __shfl_up(inc, o); if ((tid & 63) >= o) inc += n; }
        if (tid <= 32) tp[tid] = inc - v; }
    __syncthreads();
}
__device__ void ph_gather(int* tp, const bf16* H2, const int* RT_E, const int* RT_S, const float* RT_W, bf16* HG, float* ROWW, int* TOKROW) {
    const int lane = tidx() & 63, gw = blockIdx.x * (NT / 64) + (tidx() >> 6), ngw = gridDim.x * (NT / 64);
    for (int p = gw; p < 2 * M; p += ngw) { const int t = p >> 1, k = p & 1;
        const int e = (RT_E[t] >> (8 * k)) & 255; const int rowd = tp[e] * 256 + RT_S[p];
        const v4u* src = (const v4u*)(H2 + (size_t)t * D) + lane; v4u* dst = (v4u*)(HG + (size_t)rowd * D) + lane;
        dst[0] = src[0]; dst[64] = src[64];
        if (lane == 0) { ROWW[rowd] = RT_W[p]; TOKROW[p] = rowd; } }
}
__device__ void ph_moe_final(const bf16* YP, const int* TOKROW, const float* gain, const float* mod, float* out) {
    const int lane = tidx() & 63, gw = blockIdx.x * (NT / 64) + (tidx() >> 6), ngw = gridDim.x * (NT / 64);
    for (int t = gw; t < M; t += ngw) { const int b = t >> 11; const int r1 = TOKROW[2 * t], r2 = TOKROW[2 * t + 1];
        const v4u* p1 = (const v4u*)(YP + (size_t)r1 * D) + lane; const v4u* p2 = (const v4u*)(YP + (size_t)r2 * D) + lane;
        float y[16]; float ss = 0.f;
#pragma unroll
        for (int j = 0; j < 2; ++j) { const v4u a = p1[64 * j], c = p2[64 * j];
#pragma unroll
            for (int e = 0; e < 4; ++e) { const float v0 = __uint_as_float(a[e] << 16) + __uint_as_float(c[e] << 16), v1 = __uint_as_float(a[e] & 0xffff0000u) + __uint_as_float(c[e] & 0xffff0000u);
                y[8 * j + 2 * e] = v0; y[8 * j + 2 * e + 1] = v1; ss += v0 * v0 + v1 * v1; } }
        const float inv = rsqrtf(wave_sum(ss) * (1.f / D) + EPS);
#pragma unroll
        for (int j = 0; j < 2; ++j) { const int col = 512 * j + lane * 8; float* op = out + (size_t)t * D + col;
            const f32x4v g2a = *(const f32x4v*)(mod + b * 6 * D + 5 * D + col), g2b = *(const f32x4v*)(mod + b * 6 * D + 5 * D + col + 4);
            const f32x4v ga = *(const f32x4v*)(gain + col), gb = *(const f32x4v*)(gain + col + 4);
            f32x4v xa = *(f32x4v*)op, xb = *(f32x4v*)(op + 4);
            xa.x += g2a.x * (y[8 * j + 0] * inv * ga.x); xa.y += g2a.y * (y[8 * j + 1] * inv * ga.y); xa.z += g2a.z * (y[8 * j + 2] * inv * ga.z); xa.w += g2a.w * (y[8 * j + 3] * inv * ga.w);
            xb.x += g2b.x * (y[8 * j + 4] * inv * gb.x); xb.y += g2b.y * (y[8 * j + 5] * inv * gb.y); xb.z += g2b.z * (y[8 * j + 6] * inv * gb.z); xb.w += g2b.w * (y[8 * j + 7] * inv * gb.w);
            *(f32x4v*)op = xa; *(f32x4v*)(op + 4) = xb; }
    }
}
__device__ void ph_attn_ref(const bf16* Q, const bf16* KF, const bf16* VT, float* o) {
    const int lane = tidx() & 63, gw = blockIdx.x * (NT / 64) + (tidx() >> 6), ngw = gridDim.x * (NT / 64);
    for (int item = gw; item < NB * MLA_H * (SEQ / 64); item += ngw) {
        const int qb = (SEQ / 64 - 1) - item / (NB * MLA_H), bh = item % (NB * MLA_H), b = bh / MLA_H, h = bh % MLA_H;
        const int qi = qb * 64 + lane;
        const size_t t = (size_t)b * SEQ + qi;
        float qr[QK];
#pragma unroll
        for (int d = 0; d < QK; ++d) qr[d] = bf2f(Q[t * 768 + h * QK + d]);
        float acc[VD];
#pragma unroll
        for (int d = 0; d < VD; ++d) acc[d] = 0.f;
        float mx = -INFINITY, l = 0.f;
        const int kmax = qb * 64 + 63;
        for (int k = 0; k <= kmax; ++k) {
            const bf16* kt = KF + (size_t)(bh * 32 + (k >> 6)) * 6144 + (k & 63) * 8;
            const bf16* vt = VT + (size_t)(bh * 32 + (k >> 6)) * 4096 + (k & 63) * 32;
            float s = 0.f;
#pragma unroll
            for (int d = 0; d < QK; ++d) s += qr[d] * bf2f(kt[(d >> 3) * 512 + (d & 7)]);
            if (k <= qi) {
                const float mn = fmaxf(mx, s);
                const float f = exp2f(mx - mn), pv = exp2f(s - mn);
                l = l * f + pv;
#pragma unroll
                for (int d = 0; d < VD; ++d) acc[d] = acc[d] * f + pv * bf2f(vt[(d >> 5) * 2048 + (d & 31)]);
                mx = mn;
            }
        }
        const float il = 1.f / l;
#pragma unroll
        for (int d = 0; d < VD; ++d) o[t * (MLA_H * VD) + h * VD + d] = acc[d] * il;
    }
}

namespace att {
typedef short bf16x8 __attribute__((ext_vector_type(8)));
typedef short s16x4 __attribute__((ext_vector_type(4)));
typedef float f32x16 __attribute__((ext_vector_type(16)));
typedef unsigned u32x4 __attribute__((ext_vector_type(4)));
#define ALAS __attribute__((address_space(3)))
constexpr int KSLOT = 12288, VSLOT = 8192, NSLOT = 3;
constexpr int LDS_K = 0, LDS_V = NSLOT * KSLOT, LDS_WS = LDS_V + NSLOT * VSLOT, LDS_OST = LDS_WS + 8 * 256, LDS_END = LDS_OST + 8 * 4096;
constexpr float THR = 8.0f;
__device__ __forceinline__ int crow(int r, int hi) { return (r & 3) + 8 * (r >> 2) + 4 * hi; }
__device__ __forceinline__ unsigned cvtpk(float lo, float hi) { typedef float f2 __attribute__((ext_vector_type(2))); typedef __bf16 b2 __attribute__((ext_vector_type(2)));
    f2 v = {lo, hi}; b2 b = __builtin_convertvector(v, b2); return __builtin_bit_cast(unsigned, b); }
__device__ __forceinline__ s16x4 vtr(const ALAS char* p) { typedef short v4 __attribute__((ext_vector_type(4))); return __builtin_bit_cast(s16x4, __builtin_amdgcn_ds_read_tr16_b64_v4i16((ALAS v4*)p)); }
#define AWAIT_BAR(N) asm volatile("s_waitcnt vmcnt(" #N ") lgkmcnt(0)\n\ts_barrier" ::: "memory")

__device__ __forceinline__ void attn_unit(ALAS char* lds, int bh, int qb, const bf16* Q, const bf16* KF, const bf16* VT, bf16* YC, float* SSQ) {
    const int tid = tidx(), lane = tid & 63, r32 = lane & 31, hi = lane >> 5; const int wid = __builtin_amdgcn_readfirstlane(tid >> 6);
    const int b = bh >> 3, h = bh & 7;
    const char* Kt = (const char*)(KF + (size_t)bh * 32 * 6144); const char* Vt = (const char*)(VT + (size_t)bh * 32 * 4096);
    const int NTL = 4 * (qb + 1);
    bf16x8 qf[6];
    { const bf16* qp = Q + (size_t)(b * SEQ + qb * 256 + wid * 32 + r32) * 768 + h * QK + hi * 8;
#pragma unroll
      for (int d0 = 0; d0 < 6; ++d0) qf[d0] = *(const bf16x8*)(qp + d0 * 16); }
    const unsigned koff0 = wid * 1024 + lane * 16, koff1 = (8 + (wid & 3)) * 1024 + lane * 16, voff = wid * 1024 + lane * 16;
#define ADMA(t, slot) do { const char* kb_ = Kt + (size_t)(t) * KSLOT; const char* vb_ = Vt + (size_t)(t) * VSLOT; \
        __builtin_amdgcn_global_load_lds((const unsigned*)(kb_ + koff0), (ALAS unsigned*)(lds + LDS_K + (slot) * KSLOT + wid * 1024), 16, 0, 0); \
        __builtin_amdgcn_global_load_lds((const unsigned*)(kb_ + koff1), (ALAS unsigned*)(lds + LDS_K + (slot) * KSLOT + (8 + (wid & 3)) * 1024), 16, 0, 0); \
        __builtin_amdgcn_global_load_lds((const unsigned*)(vb_ + voff), (ALAS unsigned*)(lds + LDS_V + (slot) * VSLOT + wid * 1024), 16, 0, 0); } while (0)
    ADMA(0, 0); ADMA(1, 1);
    ALAS float* wsf = (ALAS float*)(lds + LDS_WS) + wid * 64;
    float mref = 0.f, l = 0.f;
    f32x16 o0 = {}, o1 = {}, negm = {};
    const int qrel = wid * 32 + r32;
    const int vlane = (4 * hi + ((lane & 15) >> 2)) * 64 + ((lane >> 4) & 1) * 32 + (lane & 3) * 8;
    int slot = 0;
    for (int t = 0; t < NTL; ++t) {
        if (t + 1 < NTL) { AWAIT_BAR(3); } else { AWAIT_BAR(0); }
        if (t + 2 < NTL) { const int s2 = (slot == 0) ? 2 : slot - 1; ADMA(t + 2, s2); }
        const ALAS char* Ks = lds + LDS_K + slot * KSLOT + hi * 1024 + r32 * 16;
        const ALAS char* Vs = lds + LDS_V + slot * VSLOT + vlane;
        f32x16 p0 = negm, p1 = negm;
#pragma unroll
        for (int d0 = 0; d0 < 6; ++d0) {
            const bf16x8 ka0 = *(const ALAS bf16x8*)(Ks + d0 * 2048), ka1 = *(const ALAS bf16x8*)(Ks + d0 * 2048 + 512);
            p0 = __builtin_amdgcn_mfma_f32_32x32x16_bf16(ka0, qf[d0], p0, 0, 0, 0);
            p1 = __builtin_amdgcn_mfma_f32_32x32x16_bf16(ka1, qf[d0], p1, 0, 0, 0);
        }
        const int jb = t - (NTL - 4);
        if (jb >= 0) {
#pragma unroll
            for (int r = 0; r < 16; ++r) { const int kv = 64 * jb + crow(r, hi); if (kv > qrel) p0[r] = -INFINITY; if (kv + 32 > qrel) p1[r] = -INFINITY; }
        }
        float rm = fmaxf(p0[0], p1[0]);
#pragma unroll
        for (int r = 1; r < 16; ++r) rm = fmaxf(rm, fmaxf(p0[r], p1[r]));
        { auto rr = __builtin_amdgcn_permlane32_swap(__float_as_uint(rm), __float_as_uint(rm), false, false); rm = fmaxf(__uint_as_float(rr[0]), __uint_as_float(rr[1])); }
        if (t == 0 || __any(rm > THR)) {
            const float dl = (t == 0) ? rm : fmaxf(rm, 0.f);
            mref += dl;
#pragma unroll
            for (int r = 0; r < 16; ++r) { p0[r] -= dl; p1[r] -= dl; }
#pragma unroll
            for (int r = 0; r < 16; ++r) negm[r] = -mref;
            const float f = exp2f(-dl); l *= f;
            if (t > 0) {
                if (hi == 0) wsf[r32] = f;
                asm volatile("s_waitcnt lgkmcnt(0)" ::: "memory");
#pragma unroll
                for (int r = 0; r < 16; ++r) { const float fr_ = wsf[crow(r, hi)]; o0[r] *= fr_; o1[r] *= fr_; }
            }
        }
        float ls = 0.f;
#pragma unroll
        for (int r = 0; r < 16; ++r) { p0[r] = exp2f(p0[r]); p1[r] = exp2f(p1[r]); ls += p0[r] + p1[r]; }
        l += ls;
        u32x4 pw0 = {cvtpk(p0[0], p0[1]), cvtpk(p0[2], p0[3]), cvtpk(p0[4], p0[5]), cvtpk(p0[6], p0[7])};
        u32x4 pw1 = {cvtpk(p0[8], p0[9]), cvtpk(p0[10], p0[11]), cvtpk(p0[12], p0[13]), cvtpk(p0[14], p0[15])};
        u32x4 pw2 = {cvtpk(p1[0], p1[1]), cvtpk(p1[2], p1[3]), cvtpk(p1[4], p1[5]), cvtpk(p1[6], p1[7])};
        u32x4 pw3 = {cvtpk(p1[8], p1[9]), cvtpk(p1[10], p1[11]), cvtpk(p1[12], p1[13]), cvtpk(p1[14], p1[15])};
#define PV_STEP(PW, ks) do { const bf16x8 pa_ = __builtin_bit_cast(bf16x8, PW); \
            { const s16x4 a_ = vtr(Vs + (ks) * 1024), b_ = vtr(Vs + (ks) * 1024 + 512); const bf16x8 vf_ = {a_[0], a_[1], a_[2], a_[3], b_[0], b_[1], b_[2], b_[3]}; \
              o0 = __builtin_amdgcn_mfma_f32_32x32x16_bf16(pa_, vf_, o0, 0, 0, 0); } \
            { const s16x4 a_ = vtr(Vs + 4096 + (ks) * 1024), b_ = vtr(Vs + 4096 + (ks) * 1024 + 512); const bf16x8 vf_ = {a_[0], a_[1], a_[2], a_[3], b_[0], b_[1], b_[2], b_[3]}; \
              o1 = __builtin_amdgcn_mfma_f32_32x32x16_bf16(pa_, vf_, o1, 0, 0, 0); } } while (0)
        PV_STEP(pw0, 0); PV_STEP(pw1, 1); PV_STEP(pw2, 2); PV_STEP(pw3, 3);
#undef PV_STEP
        slot = (slot == 2) ? 0 : slot + 1;
    }
    { auto rr = __builtin_amdgcn_permlane32_swap(__float_as_uint(l), __float_as_uint(l), false, false); l = __uint_as_float(rr[0]) + __uint_as_float(rr[1]); }
    if (hi == 0) wsf[32 + r32] = l;
    asm volatile("s_waitcnt lgkmcnt(0)" ::: "memory");
    ALAS bf16* stg = (ALAS bf16*)(lds + LDS_OST) + wid * 2048;
#pragma unroll
    for (int r = 0; r < 16; ++r) { const int orow = crow(r, hi); const float rl = 1.f / wsf[32 + orow];
        stg[orow * 64 + r32] = (bf16)f2bf(o0[r] * rl); stg[orow * 64 + 32 + r32] = (bf16)f2bf(o1[r] * rl); }
    asm volatile("s_waitcnt lgkmcnt(0)" ::: "memory");
    const size_t trow0 = (size_t)b * SEQ + qb * 256 + wid * 32;
#pragma unroll
    for (int i = 0; i < 4; ++i) { const int row = i * 8 + (lane >> 3), ch = lane & 7;
        const u32x4 v = *(const ALAS u32x4*)(stg + row * 64 + ch * 8);
        *(u32x4*)(YC + (trow0 + row) * 1024 + 512 + h * 64 + ch * 8) = v;
        float sq = 0.f;
#pragma unroll
        for (int e = 0; e < 4; ++e) { const float a = __uint_as_float(v[e] << 16), c = __uint_as_float(v[e] & 0xffff0000u); sq += a * a + c * c; }
        sq += __shfl_xor(sq, 1); sq += __shfl_xor(sq, 2); sq += __shfl_xor(sq, 4);
        if (ch == 0) SSQ[(trow0 + row) * 16 + 8 + h] = sq; }
    asm volatile("s_waitcnt lgkmcnt(0)\n\ts_barrier" ::: "memory");
#undef ADMA
}
__device__ __forceinline__ void attn_phase(ALAS char* lds, const bf16* Q, const bf16* KF, const bf16* VT, bf16* YC, float* SSQ) {
    const int G = gridDim.x, bid = blockIdx.x; const int vcu = (G % 8 == 0) ? (bid % 8) * (G / 8) + bid / 8 : bid;
    for (int p = vcu; p < 256; p += G) { const int bh = p >> 2, s = p & 3;
        attn_unit(lds, bh, 7 - s, Q, KF, VT, YC, SSQ);
        attn_unit(lds, bh, s, Q, KF, VT, YC, SSQ); }
}
#undef AWAIT_BAR
}
__device__ void ph_prenorm(const float* in, const float* g, const float* mod, int sh_off, int sc_off, float* out) {
    const int lane = tidx() & 63, gw = blockIdx.x * (NT / 64) + (tidx() >> 6), ngw = gridDim.x * (NT / 64);
    for (int t = gw; t < M; t += ngw) {
        const int b = t / SEQ; const float* r = in + (size_t)t * D;
        float s = 0.f;
        for (int i = lane; i < D; i += 64) s += r[i] * r[i];
        const float inv = rsqrtf(wave_sum(s) / D + EPS);
        for (int i = lane; i < D; i += 64)
            out[(size_t)t * D + i] = r[i] * inv * g[i] * (1.f + mod[b * 6 * D + sc_off + i]) + mod[b * 6 * D + sh_off + i];
    }
}
template <class TY> __device__ void ph_post(const float* base, const TY* y, const float* g, const float* mod, int gate_off, float* out) {
    const int lane = tidx() & 63, gw = blockIdx.x * (NT / 64) + (tidx() >> 6), ngw = gridDim.x * (NT / 64);
    for (int t = gw; t < M; t += ngw) {
        const int b = t / SEQ; const TY* r = y + (size_t)t * D;
        float s = 0.f;
        for (int i = lane; i < D; i += 64) { const float v = ldf(r + i); s += v * v; }
        const float inv = rsqrtf(wave_sum(s) / D + EPS);
        for (int i = lane; i < D; i += 64)
            out[(size_t)t * D + i] = base[(size_t)t * D + i] + mod[b * 6 * D + gate_off + i] * (ldf(r + i) * inv * g[i]);
    }
}
template <class TI> __device__ void ph_rms_slice(const TI* in, int ldi, int off, int n, const float* g, float* out, int ldo, int ooff) {
    const int lane = tidx() & 63, gw = blockIdx.x * (NT / 64) + (tidx() >> 6), ngw = gridDim.x * (NT / 64);
    for (int t = gw; t < M; t += ngw) {
        const TI* r = in + (size_t)t * ldi + off;
        float s = 0.f;
        for (int i = lane; i < n; i += 64) { const float v = ldf(r + i); s += v * v; }
        const float inv = rsqrtf(wave_sum(s) / n + EPS);
        for (int i = lane; i < n; i += 64) out[(size_t)t * ldo + ooff + i] = ldf(r + i) * inv * g[i];
    }
}

namespace ssd {
typedef short bf16x8 __attribute__((ext_vector_type(8)));
typedef short s16x4 __attribute__((ext_vector_type(4)));
typedef float f32x16 __attribute__((ext_vector_type(16)));
typedef unsigned u32x4 __attribute__((ext_vector_type(4)));
#define SLAS __attribute__((address_space(3)))
constexpr float LOG2E = 1.4426950408889634f;
__device__ __forceinline__ int crow(int r, int hi) { return (r & 3) + 8 * (r >> 2) + 4 * hi; }
__device__ __forceinline__ s16x4 vtr(const SLAS char* p) { typedef short v4 __attribute__((ext_vector_type(4))); return __builtin_bit_cast(s16x4, __builtin_amdgcn_ds_read_tr16_b64_v4i16((SLAS v4*)p)); }
__device__ __forceinline__ unsigned cvtpk(float lo, float hi) { typedef float f2 __attribute__((ext_vector_type(2))); typedef __bf16 b2 __attribute__((ext_vector_type(2)));
    f2 v = {lo, hi}; b2 b = __builtin_convertvector(v, b2); return __builtin_bit_cast(unsigned, b); }
#define SWAIT_BAR(N) asm volatile("s_waitcnt vmcnt(" #N ") lgkmcnt(0)\n\ts_barrier" ::: "memory")
#define SDMA(gsrc, ldst) __builtin_amdgcn_global_load_lds((const unsigned*)(gsrc), (SLAS unsigned*)(ldst), 16, 0, 0)

constexpr int SW_BUF = 49152, SW_TAB = 2 * SW_BUF;
__device__ __forceinline__ void state_sweep(SLAS char* lds, int b, int h, const bf16* XT, const float* DT, const float* a_log, float* ACS2, bf16* PREV) {
    const int tid = tidx(), lane = tid & 63, r32 = lane & 31, hi = lane >> 5; const int wid = __builtin_amdgcn_readfirstlane(tid >> 6);
    const int g = h >> 2, pt = wid & 1, nt = wid >> 1;
    const float a = -expf(a_log[h]);
    SLAS float* tab = (SLAS float*)(lds + SW_TAB);
    f32x16 st = {};
    const int trl = (4 * hi + ((lane & 15) >> 2));
    const int trc = 16 * ((lane >> 4) & 1) + 4 * (lane & 3);
#define SW_ISSUE(c_, buf_) do { const char* xs_ = (const char*)(XT + (size_t)(b * 16 + (c_)) * 131072 + h * 8192); const char* bs_ = (const char*)(XT + (size_t)(b * 16 + (c_)) * 131072 + 65536 + g * 16384); \
        _Pragma("unroll") for (int i_ = 0; i_ < 2; ++i_) SDMA(xs_ + (wid * 2 + i_) * 1024 + lane * 16, lds + (buf_) * SW_BUF + (wid * 2 + i_) * 1024); \
        _Pragma("unroll") for (int i_ = 0; i_ < 4; ++i_) SDMA(bs_ + (wid * 4 + i_) * 1024 + lane * 16, lds + (buf_) * SW_BUF + 16384 + (wid * 4 + i_) * 1024); } while (0)
    SW_ISSUE(0, 0);
    for (int c = 0; c < 16; ++c) {
        const int buf = c & 1;
        float cdec = 0.f, d0 = 0.f, d1 = 0.f;
        const size_t t0 = (size_t)(b * 16 + c) * 128;
        if (wid == 0) { d0 = DT[(t0 + 2 * lane) * 8 + h]; d1 = DT[(t0 + 2 * lane + 1) * 8 + h]; }
        if (c + 1 < 16) SW_ISSUE(c + 1, buf ^ 1);
        float cs0 = 0.f, cs1 = 0.f;
        if (wid == 0) {
            const float a0 = d0 * a, a1 = d1 * a; float inc = a0 + a1;
#pragma unroll
            for (int o = 1; o < 64; o <<= 1) { const float n = __shfl_up(inc, o); if (lane >= o) inc += n; }
            const float tot = __shfl(inc, 63); cs1 = inc; cs0 = inc - a1;
            tab[2 * lane] = cs0 * LOG2E; tab[2 * lane + 1] = cs1 * LOG2E;
            tab[128 + 2 * lane] = d0 * expf(tot - cs0); tab[128 + 2 * lane + 1] = d1 * expf(tot - cs1);
            if (lane == 0) tab[256] = expf(tot);
        }
        if (c + 1 < 16) { SWAIT_BAR(6); } else { SWAIT_BAR(0); }
        if (wid == 0) { ACS2[(t0 + 2 * lane) * 8 + h] = cs0 * LOG2E; ACS2[(t0 + 2 * lane + 1) * 8 + h] = cs1 * LOG2E; }
        cdec = tab[256];
        { SLAS char* xp = lds + buf * SW_BUF + tid * 32; const int l = (tid >> 1) & 127; const float w = tab[128 + l];
          u32x4 q0 = *(SLAS u32x4*)xp, q1 = *(SLAS u32x4*)(xp + 16);
#pragma unroll
          for (int e = 0; e < 4; ++e) { q0[e] = cvtpk(__uint_as_float(q0[e] << 16) * w, __uint_as_float(q0[e] & 0xffff0000u) * w); q1[e] = cvtpk(__uint_as_float(q1[e] << 16) * w, __uint_as_float(q1[e] & 0xffff0000u) * w); }
          *(SLAS u32x4*)xp = q0; *(SLAS u32x4*)(xp + 16) = q1; }
        asm volatile("s_waitcnt lgkmcnt(0)\n\ts_barrier" ::: "memory");
        f32x16 acc = {};
        { const SLAS char* bb = lds + buf * SW_BUF + 16384 + ((32 * nt + trc) >> 3) * 2048 + ((32 * nt + trc) & 7) * 2 + trl * 16;
          const SLAS char* xb = lds + buf * SW_BUF + pt * 8192 + trl * 64 + trc * 2;
#pragma unroll
          for (int ks = 0; ks < 8; ++ks) {
              const s16x4 a0 = vtr(bb + ks * 256), a1 = vtr(bb + ks * 256 + 128); const s16x4 x0 = vtr(xb + ks * 1024), x1 = vtr(xb + ks * 1024 + 512);
              const bf16x8 af = {a0[0], a0[1], a0[2], a0[3], a1[0], a1[1], a1[2], a1[3]}, xf = {x0[0], x0[1], x0[2], x0[3], x1[0], x1[1], x1[2], x1[3]};
              acc = __builtin_amdgcn_mfma_f32_32x32x16_bf16(af, xf, acc, 0, 0, 0); } }
        { bf16* pv = PREV + (size_t)((b * 16 + c) * 8 + h) * 8192 + (32 * pt + r32) * 8 + 4 * hi;
#pragma unroll
          for (int rg = 0; rg < 4; ++rg) { uint2 o; o.x = cvtpk(st[4 * rg], st[4 * rg + 1]); o.y = cvtpk(st[4 * rg + 2], st[4 * rg + 3]); *(uint2*)(pv + (4 * nt + rg) * 512) = o; } }
#pragma unroll
        for (int r = 0; r < 16; ++r) st[r] = st[r] * cdec + acc[r];
        asm volatile("s_waitcnt lgkmcnt(0)\n\ts_barrier" ::: "memory");
    }
#undef SW_ISSUE
}

constexpr int P2_C = 0, P2_B = 32768, P2_XP = 65536, P2_TAB = 131072, P2_STG = 135168, P2_END = 151552;
__device__ __forceinline__ void chunk_unit(SLAS char* lds, int b, int c, int g, const bf16* XT, const bf16* PREV, const float* DT, const float* ACS2, const float* d_skip,
                                           const bf16* U, bf16* YC, float* SSQS) {
    const int tid = tidx(), lane = tid & 63, r32 = lane & 31, hi = lane >> 5; const int wid = __builtin_amdgcn_readfirstlane(tid >> 6);
    const int lb = wid >> 1, ph = wid & 1;
    const char* xt = (const char*)(XT + (size_t)(b * 16 + c) * 131072);
    const size_t t0 = (size_t)(b * 16 + c) * 128;
#pragma unroll
    for (int i = 0; i < 4; ++i) { SDMA(xt + (98304 + g * 16384) * 2 + (wid * 4 + i) * 1024 + lane * 16, lds + P2_C + (wid * 4 + i) * 1024);
                                  SDMA(xt + (65536 + g * 16384) * 2 + (wid * 4 + i) * 1024 + lane * 16, lds + P2_B + (wid * 4 + i) * 1024); }
#define P2_ISSUE(hh_) do { const int h_ = 4 * g + (hh_); const char* xs_ = xt + h_ * 16384; const char* ps_ = (const char*)(PREV + (size_t)((b * 16 + c) * 8 + h_) * 8192); \
        SLAS char* d_ = lds + P2_XP + ((hh_) & 1) * 32768; \
        _Pragma("unroll") for (int i_ = 0; i_ < 2; ++i_) { SDMA(xs_ + (wid * 2 + i_) * 1024 + lane * 16, d_ + (wid * 2 + i_) * 1024); SDMA(ps_ + (wid * 2 + i_) * 1024 + lane * 16, d_ + 16384 + (wid * 2 + i_) * 1024); } } while (0)
    P2_ISSUE(0);
    { SLAS float* tab = (SLAS float*)(lds + P2_TAB); const int hh = tid >> 7, l = tid & 127;
      tab[hh * 256 + l] = ACS2[(t0 + l) * 8 + 4 * g + hh]; tab[hh * 256 + 128 + l] = DT[(t0 + l) * 8 + 4 * g + hh]; }
    P2_ISSUE(1);
    SWAIT_BAR(4);
    bf16x8 cf[8];
#pragma unroll
    for (int ks = 0; ks < 8; ++ks) cf[ks] = *(const SLAS bf16x8*)(lds + P2_C + (2 * ks + hi) * 2048 + (32 * lb + r32) * 16);
    f32x16 cbt[4];
#pragma unroll
    for (int sb = 0; sb < 4; ++sb) { cbt[sb] = f32x16{};
        if (sb <= lb) {
#pragma unroll
            for (int ks = 0; ks < 8; ++ks) { const bf16x8 bfr = *(const SLAS bf16x8*)(lds + P2_B + (2 * ks + hi) * 2048 + (32 * sb + r32) * 16);
                cbt[sb] = __builtin_amdgcn_mfma_f32_32x32x16_bf16(bfr, cf[ks], cbt[sb], 0, 0, 0); } } }
    const int vlane = (4 * hi + ((lane & 15) >> 2)) * 64 + ((lane >> 4) & 1) * 32 + (lane & 3) * 8;
    const int lrow = 32 * lb + r32;
    for (int hh = 0; hh < 4; ++hh) {
        const int h = 4 * g + hh;
        const SLAS char* xb = lds + P2_XP + (hh & 1) * 32768; const SLAS char* pb = xb + 16384;
        const SLAS float* tab = (const SLAS float*)(lds + P2_TAB) + hh * 256;
        const float dsk = d_skip[h];
        f32x16 o = {};
#pragma unroll
        for (int ks = 0; ks < 8; ++ks) { const bf16x8 pf = *(const SLAS bf16x8*)(pb + (2 * ks + hi) * 1024 + (32 * ph + r32) * 16);
            o = __builtin_amdgcn_mfma_f32_32x32x16_bf16(cf[ks], pf, o, 0, 0, 0); }
#pragma unroll
        for (int r = 0; r < 16; ++r) o[r] *= exp2f(tab[32 * lb + crow(r, hi)]);
        const float al = tab[lrow];
#pragma unroll
        for (int sb = 0; sb < 4; ++sb) {
            if (sb <= lb) {
                float pr[16];
#pragma unroll
                for (int r = 0; r < 16; ++r) { const int sidx = 32 * sb + crow(r, hi);
                    float v = cbt[sb][r] * exp2f(al - tab[sidx]) * tab[128 + sidx];
                    if (sb == lb) { v = (sidx <= lrow) ? v : 0.f; v += (sidx == lrow) ? dsk : 0.f; }
                    pr[r] = v; }
                const u32x4 pw0 = {cvtpk(pr[0], pr[1]), cvtpk(pr[2], pr[3]), cvtpk(pr[4], pr[5]), cvtpk(pr[6], pr[7])};
                const u32x4 pw1 = {cvtpk(pr[8], pr[9]), cvtpk(pr[10], pr[11]), cvtpk(pr[12], pr[13]), cvtpk(pr[14], pr[15])};
                const SLAS char* xv = xb + ph * 8192 + vlane + (2 * sb) * 1024;
                { const s16x4 a_ = vtr(xv), b_ = vtr(xv + 512); const bf16x8 vf = {a_[0], a_[1], a_[2], a_[3], b_[0], b_[1], b_[2], b_[3]};
                  o = __builtin_amdgcn_mfma_f32_32x32x16_bf16(__builtin_bit_cast(bf16x8, pw0), vf, o, 0, 0, 0); }
                { const s16x4 a_ = vtr(xv + 1024), b_ = vtr(xv + 1024 + 512); const bf16x8 vf = {a_[0], a_[1], a_[2], a_[3], b_[0], b_[1], b_[2], b_[3]};
                  o = __builtin_amdgcn_mfma_f32_32x32x16_bf16(__builtin_bit_cast(bf16x8, pw1), vf, o, 0, 0, 0); }
            }
        }
        SLAS bf16* stg = (SLAS bf16*)(lds + P2_STG) + wid * 1024;
#pragma unroll
        for (int r = 0; r < 16; ++r) stg[crow(r, hi) * 32 + r32] = (bf16)f2bf(o[r]);
        asm volatile("s_waitcnt lgkmcnt(0)" ::: "memory");
#pragma unroll
        for (int i = 0; i < 2; ++i) { const int row = i * 16 + (lane >> 2), ch = lane & 3; const size_t t = t0 + 32 * lb + row;
            const u32x4 ov = *(const SLAS u32x4*)(stg + row * 32 + ch * 8);
            const u32x4 zv = *(const u32x4*)(U + t * NU + OFF_Z + h * 64 + 32 * ph + 8 * ch);
            u32x4 w; float sq = 0.f;
#pragma unroll
            for (int e = 0; e < 4; ++e) { const float z0 = __uint_as_float(zv[e] << 16), z1 = __uint_as_float(zv[e] & 0xffff0000u);
                const float v0 = __uint_as_float(ov[e] << 16) * (z0 * __builtin_amdgcn_rcpf(1.f + __expf(-z0))), v1 = __uint_as_float(ov[e] & 0xffff0000u) * (z1 * __builtin_amdgcn_rcpf(1.f + __expf(-z1)));
                w[e] = cvtpk(v0, v1); const float r0 = __uint_as_float(w[e] << 16), r1 = __uint_as_float(w[e] & 0xffff0000u); sq += r0 * r0 + r1 * r1; }
            *(u32x4*)(YC + t * 1024 + h * 64 + 32 * ph + 8 * ch) = w;
            sq += __shfl_xor(sq, 1); sq += __shfl_xor(sq, 2);
            if (ch == 0) SSQS[t * 16 + h * 2 + ph] = sq; }
        if (hh < 3) {
            if (hh + 2 < 4) { asm volatile("s_waitcnt lgkmcnt(0)\n\ts_barrier" ::: "memory"); P2_ISSUE(hh + 2); SWAIT_BAR(4); }
            else { SWAIT_BAR(0); }
        }
    }
    asm volatile("s_waitcnt vmcnt(0) lgkmcnt(0)\n\ts_barrier" ::: "memory");
#undef P2_ISSUE
}
#undef SWAIT_BAR
#undef SDMA
}
__device__ void ph_gate_norm(const float* y, const bf16* u, bf16* YC) {
    const int lane = tidx() & 63, gw = blockIdx.x * (NT / 64) + (tidx() >> 6), ngw = gridDim.x * (NT / 64);
    for (int t = gw; t < M; t += ngw) {
        float v[8]; float s = 0.f;
#pragma unroll
        for (int j = 0; j < 8; ++j) { const int i = lane + 64 * j; v[j] = y[(size_t)t * SSD_INNER + i] * silu_f(bf2f(u[(size_t)t * NU + OFF_Z + i])); s += v[j] * v[j]; }
        const float inv = rsqrtf(wave_sum(s) / SSD_INNER + EPS);
#pragma unroll
        for (int j = 0; j < 8; ++j) YC[(size_t)t * 1024 + lane + 64 * j] = (bf16)f2bf(v[j] * inv);
    }
}
__device__ void ph_yc_norm(bf16* YC, const float* SSQS, const float* SSQ) {
    const int lane = tidx() & 63, gw = blockIdx.x * (NT / 64) + (tidx() >> 6), ngw = gridDim.x * (NT / 64);
    for (int t = gw; t < M; t += ngw) {
        float ss = 0.f, sm = 0.f;
#pragma unroll
        for (int q = 0; q < 4; ++q) { const f32x4v a = *(const f32x4v*)(SSQS + (size_t)t * 16 + 4 * q); ss += (a.x + a.y) + (a.z + a.w); }
        { const f32x4v a = *(const f32x4v*)(SSQ + (size_t)t * 16 + 8), b = *(const f32x4v*)(SSQ + (size_t)t * 16 + 12); sm = (a.x + a.y) + (a.z + a.w) + (b.x + b.y) + (b.z + b.w); }
        const float invs = rsqrtf(ss * (1.f / 512.f) + EPS), invm = rsqrtf(sm * (1.f / 512.f) + EPS);
#pragma unroll
        for (int hlf = 0; hlf < 2; ++hlf) { const float inv = hlf ? invm : invs;
            v4u* p = (v4u*)(YC + (size_t)t * 1024 + 512 * hlf) + lane; v4u w = *p;
            w.x = pk2(__uint_as_float(w.x << 16) * inv, __uint_as_float(w.x & 0xffff0000u) * inv); w.y = pk2(__uint_as_float(w.y << 16) * inv, __uint_as_float(w.y & 0xffff0000u) * inv);
            w.z = pk2(__uint_as_float(w.z << 16) * inv, __uint_as_float(w.z & 0xffff0000u) * inv); w.w = pk2(__uint_as_float(w.w << 16) * inv, __uint_as_float(w.w & 0xffff0000u) * inv);
            *p = w; }
    }
}
__device__ void ph_gemm(float* lds, const float* A, int lda, const float* B, int ldb, float* C, int ldc, int Mr, int N, int K) {
    float (*As)[129] = (float (*)[129])lds;
    float (*Bs)[65] = (float (*)[65])(lds + 16 * 129);
    const int tx = tidx() & 15, ty = tidx() >> 4;
    const int ntn = (N + 63) / 64, ntm = Mr / 128;
    for (int tile = blockIdx.x; tile < ntn * ntm; tile += gridDim.x) {
        const int m0 = (tile / ntn) * 128, n0 = (tile % ntn) * 64;
        float acc[4][4] = {};
        for (int k0 = 0; k0 < K; k0 += 16) {
            for (int i = tidx(); i < 128 * 16; i += NT) { const int r = i >> 4, kk = i & 15; As[kk][r] = A[(size_t)(m0 + r) * lda + k0 + kk]; }
            for (int i = tidx(); i < 64 * 16; i += NT) { const int kk = i >> 6, cc = i & 63; Bs[kk][cc] = (n0 + cc < N) ? B[(size_t)(k0 + kk) * ldb + n0 + cc] : 0.f; }
            __syncthreads();
#pragma unroll
            for (int kk = 0; kk < 16; ++kk) {
                float a[4], b[4];
#pragma unroll
                for (int i = 0; i < 4; ++i) { a[i] = As[kk][ty * 4 + i]; b[i] = Bs[kk][tx * 4 + i]; }
#pragma unroll
                for (int i = 0; i < 4; ++i)
#pragma unroll
                    for (int j = 0; j < 4; ++j) acc[i][j] += a[i] * b[j];
            }
            __syncthreads();
        }
#pragma unroll
        for (int i = 0; i < 4; ++i)
#pragma unroll
            for (int j = 0; j < 4; ++j) { const int n = n0 + tx * 4 + j; if (n < N) C[(size_t)(m0 + ty * 4 + i) * ldc + n] = acc[i][j]; }
    }
}
__device__ void ph_conv(const bf16* u, const float* cw, const float* cb, float* xc) {
    for (size_t idx = (size_t)blockIdx.x * NT + tidx(); idx < (size_t)M * SSD_XBC; idx += (size_t)gridDim.x * NT) {
        const int ch = (int)(idx % SSD_XBC), t = (int)(idx / SSD_XBC), s = t % SEQ;
        float acc = cb[ch];
        for (int k = 0; k < 4; ++k) { const int ss = s - 3 + k; if (ss >= 0) acc += cw[k * SSD_XBC + ch] * bf2f(u[(size_t)(t - 3 + k) * NU + OFF_XBC + ch]); }
        xc[idx] = silu_f(acc);
    }
}
__device__ void ph_ssd_seq(const float* DT, const bf16* xc, const float* dt_bias, const float* a_log, const float* d_skip, float* y) {
    for (int item = blockIdx.x; item < NB * SSD_H; item += gridDim.x) {
        const int b = item / SSD_H, h = item % SSD_H, g = h / (SSD_H / SSD_G);
        const int p = tidx() >> 3, nq = tidx() & 7;
        const float a = -expf(a_log[h]), dsk = d_skip[h];
        float st[16];
#pragma unroll
        for (int i = 0; i < 16; ++i) st[i] = 0.f;
        for (int s = 0; s < SEQ; ++s) {
            const size_t t = (size_t)b * SEQ + s;
            const float dt = DT[t * 8 + h];
            const float da = expf(dt * a);
            const float xv = bf2f(xc[t * SSD_XBC + h * SSD_P + p]);
            const float xd = xv * dt;
            const bf16* Bp = xc + t * SSD_XBC + SSD_INNER + g * SSD_N + nq * 16;
            const bf16* Cp = xc + t * SSD_XBC + SSD_INNER + SSD_G * SSD_N + g * SSD_N + nq * 16;
            float acc = 0.f;
#pragma unroll
            for (int i = 0; i < 16; ++i) { st[i] = st[i] * da + xd * bf2f(Bp[i]); acc += bf2f(Cp[i]) * st[i]; }
            acc += __shfl_xor(acc, 1); acc += __shfl_xor(acc, 2); acc += __shfl_xor(acc, 4);
            if (nq == 0) y[t * SSD_INNER + h * SSD_P + p] = acc + dsk * xv;
        }
    }
}
__device__ void ph_rope(float* q, const bf16* u, const int* pos, float* kpe) {
    for (int idx = blockIdx.x * NT + tidx(); idx < M * 9 * 16; idx += gridDim.x * NT) {
        const int i = idx % 16, hh = (idx / 16) % 9, t = idx / (16 * 9);
        const float inv = 1.0f / powf(10000.0f, (float)(2 * i) / 32.0f);
        const float ang = (float)pos[t] * inv;
        float sn, cs; sincosf(ang, &sn, &cs);
        if (hh < 8) {
            float* p = q + (size_t)t * (MLA_H * QK) + hh * QK + NOPE;
            const float x1 = p[i], x2 = p[16 + i];
            p[i] = x1 * cs - x2 * sn; p[16 + i] = x2 * cs + x1 * sn;
        } else {
            const bf16* p = u + (size_t)t * NU + OFF_KR;
            const float x1 = bf2f(p[i]), x2 = bf2f(p[16 + i]);
            kpe[(size_t)t * ROPE + i] = x1 * cs - x2 * sn; kpe[(size_t)t * ROPE + 16 + i] = x2 * cs + x1 * sn;
        }
    }
}
__device__ void ph_attn(const float* q, const float* kv, const float* kpe, float* o) {
    const int lane = tidx() & 63, gw = blockIdx.x * (NT / 64) + (tidx() >> 6), ngw = gridDim.x * (NT / 64);
    for (int item = gw; item < NB * MLA_H * (SEQ / 64); item += ngw) {
        const int qb = (SEQ / 64 - 1) - item / (NB * MLA_H), bh = item % (NB * MLA_H), b = bh / MLA_H, h = bh % MLA_H;
        const int qi = qb * 64 + lane;
        const size_t t = (size_t)b * SEQ + qi;
        float qr[QK];
#pragma unroll
        for (int d = 0; d < QK; ++d) qr[d] = q[t * (MLA_H * QK) + h * QK + d] * 0.10206207261596575f;
        float acc[VD];
#pragma unroll
        for (int d = 0; d < VD; ++d) acc[d] = 0.f;
        float mx = -INFINITY, l = 0.f;
        const int kmax = qb * 64 + 63;
        for (int k = 0; k <= kmax; ++k) {
            const size_t tk = (size_t)b * SEQ + k;
            const float* kn = kv + tk * (MLA_H * 128) + h * 128;
            const float* kp = kpe + tk * ROPE;
            float s = 0.f;
#pragma unroll
            for (int d = 0; d < NOPE; ++d) s += qr[d] * kn[d];
#pragma unroll
            for (int d = 0; d < ROPE; ++d) s += qr[NOPE + d] * kp[d];
            if (k <= qi) {
                const float mn = fmaxf(mx, s);
                const float f = expf(mx - mn), pv = expf(s - mn);
                l = l * f + pv;
#pragma unroll
                for (int d = 0; d < VD; ++d) acc[d] = acc[d] * f + pv * kn[64 + d];
                mx = mn;
            }
        }
        const float il = 1.f / l;
#pragma unroll
        for (int d = 0; d < VD; ++d) o[t * (MLA_H * VD) + h * VD + d] = acc[d] * il;
    }
}
__device__ void ph_moe(float* lds, const float* h2, const float* wgr, const float* bgr, const float* wer, const float* ber,
                       const float* wg, const float* wu, const float* wd, float* y2) {
    const int sb = tidx() >> 8, tid = tidx() & 255;
    float* xs = lds + sb * 2048;
    float* logit = xs + 1024;
    float* hid = xs + 1088;
    int* sel_e = (int*)(xs + 1600);
    float* sel_w = xs + 1604;
    for (int it = blockIdx.x; it < M / 2; it += gridDim.x) {
        const int t = it * 2 + sb;
        __syncthreads();
        for (int i = tid; i < D; i += 256) xs[i] = h2[(size_t)t * D + i];
        __syncthreads();
        {
            const int w = tid >> 6, lane = tid & 63;
            for (int cidx = w * 9; cidx < w * 9 + 9; ++cidx) {
                float s = 0.f;
                for (int k = lane; k < D; k += 64) s += xs[k] * (cidx < 4 ? wgr[k * 4 + cidx] : wer[k * 32 + (cidx - 4)]);
                s = wave_sum(s);
                if (lane == 0) logit[cidx] = s;
            }
        }
        __syncthreads();
        if (tid == 0) {
            float mxv = -INFINITY; int gi = 0;
            for (int i = 0; i < 4; ++i) { const float v = logit[i] + bgr[i]; logit[i] = v; if (v > mxv) { mxv = v; gi = i; } }
            float den = 0.f; for (int i = 0; i < 4; ++i) den += expf(logit[i] - mxv);
            const float gw = 1.f / den;
            float emx = -INFINITY; int i1 = 0;
            for (int i = 0; i < 8; ++i) { const float v = logit[4 + gi * 8 + i] + ber[gi * 8 + i]; logit[4 + gi * 8 + i] = v; if (v > emx) { emx = v; i1 = i; } }
            float e2 = -INFINITY; int i2 = 0;
            for (int i = 0; i < 8; ++i) { const float v = logit[4 + gi * 8 + i]; if (i != i1 && v > e2) { e2 = v; i2 = i; } }
            const float p2 = expf(e2 - emx);
            sel_e[0] = gi * 8 + i1; sel_e[1] = gi * 8 + i2;
            sel_w[0] = gw / (1.f + p2); sel_w[1] = gw * p2 / (1.f + p2);
        }
        __syncthreads();
        for (int k2 = 0; k2 < 2; ++k2) {
            const int e = sel_e[k2];
            const float* G = wg + (size_t)e * D * FF; const float* U = wu + (size_t)e * D * FF;
            float ga = 0.f, ua = 0.f;
            for (int k = 0; k < D; ++k) { ga += xs[k] * G[(size_t)k * FF + tid]; ua += xs[k] * U[(size_t)k * FF + tid]; }
            hid[k2 * FF + tid] = silu_f(ga) * ua * sel_w[k2];
        }
        __syncthreads();
        for (int d = tid; d < D; d += 256) {
            float acc = 0.f;
            for (int k2 = 0; k2 < 2; ++k2) {
                const float* Wd = wd + (size_t)sel_e[k2] * FF * D;
                for (int f = 0; f < FF; ++f) acc += hid[k2 * FF + f] * Wd[(size_t)f * D + d];
            }
            y2[(size_t)t * D + d] = acc;
        }
    }
}


#define LAS __attribute__((address_space(3)))
#define XB_TMO      128
#define XB_XCNT(j)  (256  + 64 * (j))
#define XB_XSUB(j)  (1280 + 64 * (j))
#define XB_XGEN(j)  (2304 + 64 * (j))
#define XB_TOP      3328
#define XB_TOPGEN   3392
#define XCD_BAR_WORDS 3456
#define XB_SPIN_CAP (1u << 18)

__device__ __forceinline__ unsigned xb_ld(unsigned* p)              { return __hip_atomic_load(p, __ATOMIC_RELAXED, __HIP_MEMORY_SCOPE_AGENT); }
__device__ __forceinline__ unsigned xb_add(unsigned* p, unsigned v) { return __hip_atomic_fetch_add(p, v, __ATOMIC_RELAXED, __HIP_MEMORY_SCOPE_AGENT); }
__device__ __forceinline__ unsigned xb_xcc_id() { return (unsigned)__builtin_amdgcn_s_getreg((3 << 11) | 20) & 0xFu; }
#define XB_SPIN(cond, bar) do { unsigned _sp = 0; while (cond) { __builtin_amdgcn_s_sleep(1); \
    if ((++_sp & 255u) == 0u) { if (xb_ld(&(bar)[XB_TMO])) break; if (_sp > XB_SPIN_CAP) { atomicAdd(&(bar)[XB_TMO], 1u); break; } } } } while (0)

struct XcdBarrier {
    unsigned* bar; unsigned x;
    volatile LAS unsigned* st;
};

__device__ __forceinline__ XcdBarrier xcd_barrier_post(unsigned* bar, volatile LAS unsigned* st) {
    XcdBarrier b; b.bar = bar; b.x = xb_xcc_id(); b.st = st;
    if (tidx() == 0) (void)xb_add(&bar[XB_XCNT(b.x)], 1u);
    return b;
}
__device__ __forceinline__ void xcd_barrier_complete(unsigned* bar, unsigned x, unsigned& nloc, unsigned& nx) {
    const unsigned G = gridDim.x * gridDim.y * gridDim.z;
    unsigned sum, cnt, mine, sp = 0u;
    for (;;) {
        sum = 0u; cnt = 0u; mine = 0u;
#pragma unroll
        for (unsigned j = 0; j < 16; ++j) { const unsigned c = xb_ld(&bar[XB_XCNT(j)]); sum += c; cnt += (c > 0u) ? 1u : 0u; mine = (j == x) ? c : mine; }
        if (sum == G) break;
        __builtin_amdgcn_s_sleep(1);
        if ((++sp & 255u) == 0u) { if (xb_ld(&bar[XB_TMO])) break; if (sp > XB_SPIN_CAP) { atomicAdd(&bar[XB_TMO], 1u); break; } }
    }
    nloc = mine > 0u ? mine : 1u; nx = cnt > 0u ? cnt : 1u;
}

__device__ __forceinline__ void xcd_barrier(const XcdBarrier& b) {
    asm volatile("s_waitcnt vmcnt(0)" ::: "memory");
    __syncthreads();
    if (tidx() == 0) {
        unsigned* bar = b.bar;
        __builtin_amdgcn_s_waitcnt(0);
        unsigned nloc = b.st[0], nx = b.st[1];
        if (nloc == 0u) { xcd_barrier_complete(bar, b.x, nloc, nx); b.st[0] = nloc; b.st[1] = nx; }
        const unsigned old = xb_add(&bar[XB_XSUB(b.x)], 1u);
        const unsigned gen = old / nloc;
        if (old + 1u == (gen + 1u) * nloc) {
            __builtin_amdgcn_fence(__ATOMIC_RELEASE, "agent");
            asm volatile("s_waitcnt vmcnt(0)" ::: "memory");
            const unsigned og = xb_add(&bar[XB_TOP], 1u);
            const unsigned tg = og / nx;
            if (og + 1u == (tg + 1u) * nx) xb_add(&bar[XB_TOPGEN], 1u);
            else XB_SPIN(xb_ld(&bar[XB_TOPGEN]) == tg, bar);
            __builtin_amdgcn_fence(__ATOMIC_ACQUIRE, "agent");
            xb_add(&bar[XB_XGEN(b.x)], 1u);
            asm volatile("s_waitcnt vmcnt(0)" ::: "memory");
        } else {
            XB_SPIN(xb_ld(&bar[XB_XGEN(b.x)]) == gen, bar);
            __builtin_amdgcn_fence(__ATOMIC_ACQUIRE, "agent");
            asm volatile("s_waitcnt vmcnt(0)" ::: "memory");
        }
    }
    __syncthreads();
}


constexpr size_t MiB = 1u << 20;
#define WSB(T, off) ((T*)(kargs()->ws + (size_t)(off)))
#define OUTB(T, off) ((T*)((char*)kargs()->out + (size_t)(off)))
#define B_CNT    WSB(int, 4096)
#define B_MOD    WSB(float, 1 * MiB)
#define B_DT     WSB(float, 1 * MiB + 256 * 1024)
#define B_ACS2   WSB(float, 1 * MiB + 768 * 1024)
#define B_WIN    WSB(bf16, 2 * MiB)
#define B_WOUT   WSB(bf16, 6 * MiB)
#define B_WUQ    WSB(bf16, 8 * MiB)
#define B_WUKV   WSB(bf16, 9 * MiB)
#define B_WRF    WSB(bf16, 9 * MiB + 512 * 1024)
#define B_WGU    WSB(bf16, 10 * MiB)
#define B_WD     WSB(bf16, 42 * MiB)
#define B_HB     WSB(bf16, 58 * MiB)
#define B_YC     WSB(bf16, 58 * MiB)
#define B_H2     WSB(bf16, 58 * MiB)
#define B_U      WSB(bf16, 90 * MiB)
#define B_HG     WSB(bf16, 90 * MiB)
#define B_YP     WSB(bf16, 90 * MiB)
#define B_XT     WSB(bf16, 154 * MiB)
#define B_YB     WSB(bf16, 154 * MiB)
#define B_HID    WSB(bf16, 170 * MiB)
#define B_Q      WSB(bf16, 186 * MiB)
#define B_KF     WSB(bf16, 210 * MiB)
#define B_VT     WSB(bf16, 234 * MiB)
#define B_COS    WSB(float, 250 * MiB)
#define B_SIN    WSB(float, 251 * MiB)
#define B_RTE    WSB(int, 250 * MiB)
#define B_RTS    WSB(int, 250 * MiB + 256 * 1024)
#define B_RTW    WSB(float, 250 * MiB + 512 * 1024)
#define B_TOKROW WSB(int, 250 * MiB + 768 * 1024)
#define B_ROWW   WSB(float, 251 * MiB)
#define B_SSQ    WSB(float, 252 * MiB)
#define B_SSQS   WSB(float, 253 * MiB)
#define B_PREV   OUTB(bf16, 0)
#define B_CQN    OUTB(bf16, 32 * MiB)
#define B_CKVN   OUTB(bf16, 40 * MiB)
#define LDS_TP   ((int*)(lds_raw + 131072 + 1024))

__global__ void __launch_bounds__(NT, 2) mega_fwd(Params P) {
    if (threadIdx.x < 2) ((volatile LAS unsigned*)(lds_raw + WTAB_OFF - 16))[threadIdx.x] = 0u;
    tidx_init();
    float* lds = (float*)lds_raw;
    cg::grid_group grid = cg::this_grid();
    const XcdBarrier bar = xcd_barrier_post((unsigned*)(kargs()->ws + 16384), (volatile LAS unsigned*)(lds_raw + WTAB_OFF - 16));
#define GSYNC() xcd_barrier(bar)
    ph_prep(lds, B_MOD, B_WIN, B_WOUT, B_WUQ, B_WUKV, B_WGU, B_WD, B_WRF, B_CNT);
    grid.sync();
    ph_prenorm_bf16(IN(0), IN(5), B_MOD, 0 * D, 1 * D, B_HB);
    GSYNC();
    { pg8::Gemm g{B_HB, B_WIN, M, NU, D}; pg8::StaticOrder S; S.init(M, NU, gridDim.x, (int)blockIdx.x);
      pg8::EpiBf16<0> E{B_U, NU};
      pg8::gemm_phase<pg8::EpiBf16<0>, pg8::StaticOrder, true, true>((PG8_LAS unsigned char*)lds_raw, g, S, E); }
    GSYNC();
    ph_prep2(B_U, kargs()->pos, IN(10), IN(11), IN(12), B_CQN, B_CKVN, B_KF, B_COS, B_SIN, B_DT, B_XT);
    GSYNC();
    {
      const int G = gridDim.x, bid = blockIdx.x; const bool split = G >= 128;
      if (!split || bid < 64) { for (int it = bid; it < 64; it += (split ? 64 : G)) ssd::state_sweep((SLAS char*)lds_raw, it >> 3, it & 7, B_XT, B_DT, IN(13), B_ACS2, B_PREV); }
      if (!split || bid >= 64) { const int Gg = split ? G - 64 : G, cg_ = split ? bid - 64 : bid;
        { pg8::Gemm g{B_CQN, B_WUQ, M, 768, QR}; pg8::StaticOrder S; S.init(M, 768, Gg, cg_);
          pg8::EpiQ E{B_Q, B_COS, B_SIN};
          pg8::gemm_phase<pg8::EpiQ, pg8::StaticOrder, true, false>((PG8_LAS unsigned char*)lds_raw, g, S, E); }
        { pg8::Gemm g{B_CKVN, B_WUKV, M, 1024, 256}; pg8::StaticOrder S; S.init(M, 1024, Gg, cg_);
          pg8::EpiKV E{B_KF, B_VT};
          pg8::gemm_phase<pg8::EpiKV, pg8::StaticOrder, true, false>((PG8_LAS unsigned char*)lds_raw, g, S, E); } } }
    GSYNC();
    att::attn_phase((ALAS char*)lds_raw, B_Q, B_KF, B_VT, B_YC, B_SSQ);
    { const int G = gridDim.x, bid = blockIdx.x; const int vcu = (G % 8 == 0) ? (bid % 8) * (G / 8) + bid / 8 : bid;
      for (int u = vcu; u < 256; u += G) ssd::chunk_unit((SLAS char*)lds_raw, u >> 5, (u >> 1) & 15, u & 1, B_XT, B_PREV, B_DT, B_ACS2, IN(14), B_U, B_YC, B_SSQS); }
    GSYNC();
    ph_yc_norm(B_YC, B_SSQS, B_SSQ);
    GSYNC();
    { pg8::Gemm g{B_YC, B_WOUT, M, D, D}; pg8::StaticOrder S; S.init(M, D, gridDim.x, (int)blockIdx.x);
      pg8::EpiBf16<0> E{B_YB, D};
      pg8::gemm_phase<pg8::EpiBf16<0>, pg8::StaticOrder, true, true>((PG8_LAS unsigned char*)lds_raw, g, S, E); }
    GSYNC();
    ph_rowrouter(lds, B_YB, IN(0), IN(6), IN(7), B_MOD, B_WRF, IN(23), IN(25), kargs()->out, B_H2, B_CNT, B_RTE, B_RTS, B_RTW);
    GSYNC();
    moe_table(LDS_TP, B_CNT);
    ph_gather(LDS_TP, B_H2, B_RTE, B_RTS, B_RTW, B_HG, B_ROWW, B_TOKROW);
    GSYNC();
    { pg8::Gemm g{B_HG, B_WGU, 0, 0, D}; pg8::GroupedOrder S{(const PG8_LAS int*)LDS_TP, 2, (int)gridDim.x, (int)blockIdx.x};
      pg8::EpiGU E{B_HID, B_ROWW};
      pg8::gemm_phase<pg8::EpiGU, pg8::GroupedOrder, true, true>((PG8_LAS unsigned char*)lds_raw, g, S, E); }
    GSYNC();
    { pg8::Gemm g{B_HID, B_WD, 0, 0, FF}; pg8::GroupedOrder S{(const PG8_LAS int*)LDS_TP, 4, (int)gridDim.x, (int)blockIdx.x};
      pg8::EpiDown E{B_YP};
      pg8::gemm_phase<pg8::EpiDown, pg8::GroupedOrder, true, true>((PG8_LAS unsigned char*)lds_raw, g, S, E); }
    GSYNC();
    ph_moe_final(B_YP, B_TOKROW, IN(8), B_MOD, kargs()->out);
}

extern "C" void kernel_launch(void* const* d_in, const int* in_sizes, int n_in, void* d_out, int out_size, void* d_ws, size_t ws_size,
                              hipStream_t stream) {
    static int grid_blocks = 0;
    if (!grid_blocks) {
        int dev = 0, cus = 0, per_cu = 0;
        (void)hipGetDevice(&dev);
        (void)hipDeviceGetAttribute(&cus, hipDeviceAttributeMultiprocessorCount, dev);
        (void)hipFuncSetAttribute((const void*)mega_fwd, hipFuncAttributeMaxDynamicSharedMemorySize, LDS_BYTES);
        (void)hipOccupancyMaxActiveBlocksPerMultiprocessor(&per_cu, (const void*)mega_fwd, NT, LDS_BYTES);
        if (per_cu < 1) { fprintf(stderr, "occupancy query returned %d\n", per_cu); per_cu = 1; }
        grid_blocks = cus * per_cu;
    }
    (void)hipMemsetAsync(d_ws, 0, 65536, stream);
    Params p{};
    for (int i = 0; i < 29; ++i) p.in[i] = (const float*)d_in[i];
    p.pos = (const int*)d_in[2];
    p.out = (float*)d_out;
    p.ws = (char*)d_ws;
    void* args[] = {&p};
    hipError_t e = hipLaunchCooperativeKernel((void*)mega_fwd, dim3(grid_blocks), dim3(NT), args, LDS_BYTES, stream);
    if (e != hipSuccess) fprintf(stderr, "cooperative launch failed: %s (grid %d)\n", hipGetErrorString(e), grid_blocks);
}
```

```cpp
#include <hip/hip_runtime.h>
#include <hip/hip_cooperative_groups.h>
#include <stdint.h>
#include <math.h>
#include <cstdio>
namespace cg = cooperative_groups;

constexpr int D = 1024, NB = 8, SEQ = 2048, M = NB * SEQ;
constexpr int SSD_H = 8, SSD_P = 64, SSD_INNER = 512, SSD_G = 2, SSD_N = 128, SSD_XBC = 1024;
constexpr int MLA_H = 8, NOPE = 64, ROPE = 32, QK = 96, VD = 64, QR = 256, KVR = 128;
constexpr int NIN = 1960;
constexpr int NU = 2048;
constexpr int OFF_Z = 0, OFF_XBC = 512, OFF_CQ = 1536, OFF_CKV = 1792, OFF_KR = 1920, OFF_DT = 1952;
constexpr int NEXP = 32, FF = 256;
constexpr float EPS = 1e-6f;
constexpr int NT = 512;
constexpr int LDS_BYTES = 160 * 1024;

typedef unsigned short bf16;
__device__ __forceinline__ float bf2f(bf16 v) { return __uint_as_float((unsigned)v << 16); }
__device__ __forceinline__ unsigned f2bf(float f) { unsigned u = __float_as_uint(f); return (u + 0x7fffu + ((u >> 16) & 1u)) >> 16; }
__device__ __forceinline__ unsigned pk2(float lo, float hi) { return f2bf(lo) | (f2bf(hi) << 16); }
typedef unsigned v4u __attribute__((ext_vector_type(4)));
typedef float f32x4v __attribute__((ext_vector_type(4)));

struct Params {
    const float* in[29];
    const int* pos;
    float* out;
    char* ws;
};

__device__ __forceinline__ float ldf(const float* p) { return *p; }
__device__ __forceinline__ float ldf(const bf16* p) { return bf2f(*p); }
extern __shared__ __attribute__((aligned(16))) unsigned char lds_raw[];
constexpr int WTAB_OFF = 160 * 1024 - 256;
__device__ __forceinline__ int hw_wave_key() { int k; asm volatile("s_getreg_b32 %0, hwreg(HW_REG_HW_ID, 0, 6)" : "=s"(k)); return k; }
__device__ __forceinline__ void tidx_init() { const int key = hw_wave_key(); ((volatile __attribute__((address_space(3))) int*)(lds_raw + WTAB_OFF))[key] = (int)(threadIdx.x >> 6); __syncthreads(); }
__device__ __forceinline__ int tidx() {
    const int key = hw_wave_key();
    int w = ((volatile __attribute__((address_space(3))) int*)(lds_raw + WTAB_OFF))[key];
    w = __builtin_amdgcn_readfirstlane(w);
    unsigned ones = ~0u; asm volatile("" : "+s"(ones));
    int t = w * 64 + (int)__builtin_amdgcn_mbcnt_hi(ones, __builtin_amdgcn_mbcnt_lo(ones, 0u));
    asm volatile("" : "+v"(t)); return t; }
typedef const __attribute__((address_space(4))) Params* KArgs;
__device__ __forceinline__ KArgs kargs() { KArgs p = (KArgs)__builtin_amdgcn_kernarg_segment_ptr(); asm volatile("" : "+s"(p)); return p; }
#define IN(i) (kargs()->in[i])
__device__ __forceinline__ float silu_f(float v) { return v / (1.f + expf(-v)); }
__device__ __forceinline__ float wave_sum(float v) {
#pragma unroll
    for (int o = 32; o > 0; o >>= 1) v += __shfl_xor(v, o);
    return v;
}

namespace pg8 {
#define PG8_LAS __attribute__((address_space(3)))
typedef unsigned short bf16_t;
typedef short bf16x8 __attribute__((ext_vector_type(8)));
typedef float f32x4 __attribute__((ext_vector_type(4)));
typedef unsigned u32x4 __attribute__((ext_vector_type(4)));
constexpr int BM = 256, BK = 64, HALF = 128, HTB = HALF * BK * 2  , STAGE_BYTES = 8 * HTB, NXCD = 8, WGM = 8;

__host__ __device__ __forceinline__ int lds_byte(int r, int c) { const int st = (r >> 4) * 2 + (c >> 5), rr = r & 15, cc = c & 31, ob = rr * 64 + cc * 2; return st * 1024 + (ob ^ (((ob >> 9) & 1) << 5)); }
__host__ __device__ __forceinline__ void stage_rc(int b, int& R, int& C) { const int st = b / 1024, sb = b % 1024, swz = sb ^ (((sb >> 9) & 1) << 5); R = (st >> 1) * 16 + swz / 64; C = (st & 1) * 32 + (swz % 64) / 2; }
__host__ __device__ __forceinline__ int perm32(int rho) { const int n = rho >> 4, i = rho & 15; return 8 * (i >> 2) + 4 * n + (i & 3); }

struct Unit { int pm, pn; };
struct Gemm { const bf16_t* A; const bf16_t* Bt; int M, N, K; };

struct StaticOrder {
    int nM, nN, nwg, G, c;
    __host__ __device__ void init(int M, int N, int G_, int c_) { nM = M / BM; nN = N / BM; nwg = nM * nN; G = G_; c = c_; }
    __host__ __device__ bool next(int i, Unit& u) const {
        const long L = (long)i * G + c; if (L >= nwg) return false;
        int wgid = (int)L; { const int q = nwg / NXCD, r = nwg % NXCD, xcd = wgid % NXCD, off = wgid / NXCD; wgid = (xcd < r ? xcd * (q + 1) : r * (q + 1) + (xcd - r) * q) + off; }
        const int nig = WGM * nN, gid = wgid / nig, fm = gid * WGM, gsz = (nM - fm) < WGM ? (nM - fm) : WGM;
        u.pm = fm + ((wgid % nig) % gsz); u.pn = (wgid % nig) / gsz; return true;
    }
    __device__ __forceinline__ void a_ready(const Unit&) const {}
    __device__ __forceinline__ void done(const Unit&) const {}
};


template <int ACT> struct EpiBf16 {
    static constexpr bool PERM = true, AFTER_DRAIN = false;
    bf16_t* O; int ldc;
    __device__ __forceinline__ void operator()(const f32x4 (&acc)[2][2][4][2], const Unit& u, int wr, int wc, int fr, int fq) const {
        { const int l_ = tidx() & 63; fr = l_ & 15; fq = l_ >> 4; }
        const int row0 = u.pm * BM + wr * 64 + fr; const int col0 = u.pn * BM + wc * 32 + 8 * fq;
#pragma unroll
        for (int ai = 0; ai < 2; ++ai)
#pragma unroll
            for (int m = 0; m < 4; ++m) { bf16_t* rowp = O + (size_t)(row0 + ai * HALF + m * 16) * ldc + col0;
#pragma unroll
                for (int bj = 0; bj < 2; ++bj) { const f32x4 v0 = acc[ai][bj][m][0], v1 = acc[ai][bj][m][1];
                    u32x4 w; w.x = pk2(v0[0], v0[1]); w.y = pk2(v0[2], v0[3]); w.z = pk2(v1[0], v1[1]); w.w = pk2(v1[2], v1[3]);
                    *(u32x4*)(rowp + bj * HALF) = w; } }
    }
};

struct EpiQ {
    static constexpr bool PERM = true, AFTER_DRAIN = false;
    bf16_t* Q; const float* COS; const float* SIN;
    __device__ __forceinline__ void operator()(const f32x4 (&acc)[2][2][4][2], const Unit& u, int wr, int wc, int fr, int fq) const {
        { const int l_ = tidx() & 63; fr = l_ & 15; fq = l_ >> 4; }
        const int row0 = u.pm * BM + wr * 64 + fr;
#pragma unroll
        for (int bj = 0; bj < 2; ++bj) {
            const int colg = u.pn * BM + bj * HALF + wc * 32;
            const bool pe = ((colg >> 5) % 3) == 2;
#pragma unroll
            for (int ai = 0; ai < 2; ++ai)
#pragma unroll
                for (int m = 0; m < 4; ++m) {
                    const int row = row0 + ai * HALF + m * 16;
                    f32x4 v0 = acc[ai][bj][m][0], v1 = acc[ai][bj][m][1];
                    if (pe) {
                        f32x4 w0, w1;
#pragma unroll
                        for (int e = 0; e < 4; ++e) { w0[e] = __shfl_xor(v0[e], 32); w1[e] = __shfl_xor(v1[e], 32); }
                        const f32x4* cp = (const f32x4*)(COS + (size_t)row * 16 + (fq & 1) * 8); const f32x4* sp = (const f32x4*)(SIN + (size_t)row * 16 + (fq & 1) * 8);
                        const f32x4 c0 = cp[0], c1 = cp[1], s0 = sp[0], s1 = sp[1];
                        const float sg = (fq < 2) ? -1.f : 1.f;
                        v0 = v0 * c0 + w0 * s0 * sg; v1 = v1 * c1 + w1 * s1 * sg;
                    }
                    u32x4 w; w.x = pk2(v0[0], v0[1]); w.y = pk2(v0[2], v0[3]); w.z = pk2(v1[0], v1[1]); w.w = pk2(v1[2], v1[3]);
                    *(u32x4*)(Q + (size_t)row * 768 + colg + 8 * fq) = w;
                    if (pe) asm volatile("" ::: "memory");
                }
        }
    }
};
struct EpiKV {
    static constexpr bool PERM = true, AFTER_DRAIN = false;
    bf16_t* KF; bf16_t* VT;
    __device__ __forceinline__ void operator()(const f32x4 (&acc)[2][2][4][2], const Unit& u, int wr, int wc, int fr, int fq) const {
        { const int l_ = tidx() & 63; fr = l_ & 15; fq = l_ >> 4; }
        const int row0 = u.pm * BM + wr * 64 + fr;
#pragma unroll
        for (int bj = 0; bj < 2; ++bj) {
            const int colg = u.pn * BM + bj * HALF + wc * 32; const int h = colg >> 7, j0 = (colg & 127) + 8 * fq;
#pragma unroll
            for (int ai = 0; ai < 2; ++ai)
#pragma unroll
                for (int m = 0; m < 4; ++m) {
                    const int t = row0 + ai * HALF + m * 16; const int b = t >> 11, sq = t & 2047, tile = sq >> 6, key = sq & 63;
                    const size_t base = (size_t)((b * 8 + h) * 32 + tile);
                    bf16_t* dst = (j0 < 64) ? KF + base * 6144 + (j0 >> 3) * 512 + key * 8 : VT + base * 4096 + ((j0 - 64) >> 5) * 2048 + key * 32 + ((j0 - 64) & 31);
                    const f32x4 v0 = acc[ai][bj][m][0], v1 = acc[ai][bj][m][1];
                    u32x4 w; w.x = pk2(v0[0], v0[1]); w.y = pk2(v0[2], v0[3]); w.z = pk2(v1[0], v1[1]); w.w = pk2(v1[2], v1[3]);
                    *(u32x4*)dst = w;
                }
        }
    }
};

struct GroupedOrder {
    const PG8_LAS int* tp; int NCT, G, c;
    __device__ __forceinline__ bool next(int i, Unit& u) const {
        const int L = i * G + c, total = tp[32] * NCT; if (L >= total) return false;
        const int rtg = L / NCT, ct = L - rtg * NCT; int e = 0;
        for (int j = 1; j < 32; ++j) e += (tp[j] <= rtg) ? 1 : 0;
        u.pm = rtg; u.pn = e * NCT + ct; return true;
    }
    __device__ __forceinline__ void a_ready(const Unit&) const {}
    __device__ __forceinline__ void done(const Unit&) const {}
};
struct EpiGU {
    static constexpr bool PERM = true, AFTER_DRAIN = false;
    bf16_t* HID; const float* ROWW;
    __device__ __forceinline__ void operator()(const f32x4 (&acc)[2][2][4][2], const Unit& u, int wr, int wc, int fr, int fq) const {
        { const int l_ = tidx() & 63; fr = l_ & 15; fq = l_ >> 4; }
        const int row0 = u.pm * BM + wr * 64 + fr; const int col0 = (u.pn & 1) * 128 + wc * 32 + 8 * fq;
#pragma unroll
        for (int ai = 0; ai < 2; ++ai)
#pragma unroll
            for (int m = 0; m < 4; ++m) { const int row = row0 + ai * HALF + m * 16; const float w = ROWW[row];
                float hv[8];
#pragma unroll
                for (int n = 0; n < 2; ++n)
#pragma unroll
                    for (int e = 0; e < 4; ++e) { const float g = acc[ai][0][m][n][e], up = acc[ai][1][m][n][e]; hv[4 * n + e] = g * __builtin_amdgcn_rcpf(1.f + __expf(-g)) * up * w; }
                u32x4 o; o.x = pk2(hv[0], hv[1]); o.y = pk2(hv[2], hv[3]); o.z = pk2(hv[4], hv[5]); o.w = pk2(hv[6], hv[7]);
                *(u32x4*)(HID + (size_t)row * 256 + col0) = o; }
    }
};
struct EpiDown {
    static constexpr bool PERM = true, AFTER_DRAIN = false;
    bf16_t* YP;
    __device__ __forceinline__ void operator()(const f32x4 (&acc)[2][2][4][2], const Unit& u, int wr, int wc, int fr, int fq) const {
        { const int l_ = tidx() & 63; fr = l_ & 15; fq = l_ >> 4; }
        const int row0 = u.pm * BM + wr * 64 + fr; const int col0 = (u.pn & 3) * BM + wc * 32 + 8 * fq;
#pragma unroll
        for (int ai = 0; ai < 2; ++ai)
#pragma unroll
            for (int m = 0; m < 4; ++m) { bf16_t* rowp = YP + (size_t)(row0 + ai * HALF + m * 16) * 1024 + col0;
#pragma unroll
                for (int bj = 0; bj < 2; ++bj) { const f32x4 v0 = acc[ai][bj][m][0], v1 = acc[ai][bj][m][1];
                    u32x4 w; w.x = pk2(v0[0], v0[1]); w.y = pk2(v0[2], v0[3]); w.z = pk2(v1[0], v1[1]); w.w = pk2(v1[2], v1[3]);
                    *(u32x4*)(rowp + bj * HALF) = w; } }
    }
};
template <class Epi, class Sched, bool ALIGN_EPI = false, bool SP2 = false>
__device__ __forceinline__ void gemm_phase(PG8_LAS unsigned char* lds, const Gemm g, const Sched& S, const Epi& E) {
    const int tid = tidx(), wid = __builtin_amdgcn_readfirstlane(tid >> 6), lane = tid & 63, wr = wid >> 2, wc = wid & 3, fr = lane & 15, fq = lane >> 4;
    const int K = g.K, nt = K / BK;
    unsigned voffA[2], voffB[2];
#pragma unroll
    for (int i = 0; i < 2; ++i) { int R, C; stage_rc(tid * 16 + i * 8192, R, C); const int Rb = Epi::PERM ? ((R & ~31) + perm32(R & 31)) : R;
        voffA[i] = (unsigned)(R * K + C) * 2u; voffB[i] = (unsigned)(Rb * K + C) * 2u; }
    const size_t kstep = (size_t)(BK * 2);
    const size_t hstep = (size_t)HALF * K * 2;
    const size_t tstep = 2 * hstep;
    const unsigned ldsw = (unsigned)wid * 1024u;
    const int aoff = lds_byte(wr * 64 + fr, fq * 8), boff = lds_byte(wc * 32 + fr, fq * 8);
#define PG8_SA(b, h) (((b) * 2 + (h)) * HTB)
#define PG8_SB(b, h) ((4 + (b) * 2 + (h)) * HTB)
#define PG8_STAGE(bufoff, gbase, voff) do { _Pragma("unroll") for (int _i = 0; _i < 2; ++_i) \
        __builtin_amdgcn_global_load_lds((const unsigned*)((const char*)(gbase) + (voff)[_i]), (PG8_LAS unsigned*)(lds + (bufoff) + ldsw + _i * 8192), 16, 0, 0); } while (0)
#define PG8_LDA(dst, b, h) do { _Pragma("unroll") for (int m = 0; m < 4; ++m) _Pragma("unroll") for (int k = 0; k < 2; ++k) dst[m][k] = *(const PG8_LAS bf16x8*)(lds + PG8_SA(b, h) + aoff + m * 2048 + k * 1024); } while (0)
#define PG8_LDB(dst, b, h) do { _Pragma("unroll") for (int n = 0; n < 2; ++n) _Pragma("unroll") for (int k = 0; k < 2; ++k) dst[n][k] = *(const PG8_LAS bf16x8*)(lds + PG8_SB(b, h) + boff + n * 2048 + k * 1024); } while (0)
#define PG8_MMA(ai, bj, At, Bt) do { __builtin_amdgcn_s_setprio(1); _Pragma("unroll") for (int m = 0; m < 4; ++m) _Pragma("unroll") for (int n = 0; n < 2; ++n) _Pragma("unroll") for (int k = 0; k < 2; ++k) \
        acc[ai][bj][m][n] = __builtin_amdgcn_mfma_f32_16x16x32_bf16(Bt[n][k], At[m][k], acc[ai][bj][m][n], 0, 0, 0); __builtin_amdgcn_s_setprio(0); } while (0)
#define PG8_WAIT_V(n) asm volatile("s_waitcnt vmcnt(" #n ")" ::: "memory")
#define PG8_WAIT_L(n) asm volatile("s_waitcnt lgkmcnt(" #n ")" ::: "memory")
#define PG8_BAR __builtin_amdgcn_s_barrier()
#define PG8_SCHED __builtin_amdgcn_sched_barrier(0)
    Unit cur, nxt; int ui = 0;
    if (!S.next(0, cur)) return;
    f32x4 acc[2][2][4][2];
#pragma unroll
    for (int a = 0; a < 2; ++a)
#pragma unroll
        for (int b = 0; b < 2; ++b)
#pragma unroll
            for (int m = 0; m < 4; ++m)
#pragma unroll
                for (int n = 0; n < 2; ++n) acc[a][b][m][n] = (f32x4){0.f, 0.f, 0.f, 0.f};
    bf16x8 At[4][2], B0[2][2], B1[2][2];
    const char* cA = (const char*)g.A + (size_t)cur.pm * tstep; const char* cB = (const char*)g.Bt + (size_t)cur.pn * tstep;
    S.a_ready(cur);
    if constexpr (SP2) {
        PG8_STAGE(PG8_SB(0, 0), cB, voffB); PG8_STAGE(PG8_SB(0, 1), cB + hstep, voffB); PG8_STAGE(PG8_SA(0, 0), cA, voffA); PG8_STAGE(PG8_SA(0, 1), cA + hstep, voffA);
        if (wr == 1) PG8_BAR;
        PG8_WAIT_V(2); PG8_BAR;
        PG8_STAGE(PG8_SB(1, 0), cB + kstep, voffB); PG8_STAGE(PG8_SA(1, 0), cA + kstep, voffA); PG8_STAGE(PG8_SB(1, 1), cB + hstep + kstep, voffB);
        PG8_WAIT_V(6); PG8_BAR;
    } else {
        PG8_STAGE(PG8_SB(0, 0), cB, voffB); PG8_STAGE(PG8_SA(0, 0), cA, voffA); PG8_STAGE(PG8_SB(0, 1), cB + hstep, voffB); PG8_STAGE(PG8_SA(0, 1), cA + hstep, voffA);
        if (wr == 1) PG8_BAR;
        PG8_WAIT_V(4); PG8_BAR;
        PG8_STAGE(PG8_SB(1, 0), cB + kstep, voffB); PG8_STAGE(PG8_SA(1, 0), cA + kstep, voffA); PG8_STAGE(PG8_SB(1, 1), cB + hstep + kstep, voffB);
        PG8_WAIT_V(6); PG8_BAR;
    }
    for (;;) {
        const bool has_next = S.next(ui + 1, nxt);
        const char* nA = has_next ? (const char*)g.A + (size_t)nxt.pm * tstep : cA; const char* nB = has_next ? (const char*)g.Bt + (size_t)nxt.pn * tstep : cB;
        for (int t = 0; t < nt; t += 2) {
            const bool last = (t == nt - 2);
            const char* a1 = cA + (size_t)(t + 1) * kstep;
            const char* a2 = last ? nA : cA + (size_t)(t + 2) * kstep; const char* b2 = last ? nB : cB + (size_t)(t + 2) * kstep;
            const char* a3 = a2 + kstep; const char* b3 = b2 + kstep;
            if (last && has_next) S.a_ready(nxt);
            if constexpr (SP2) {
            PG8_LDB(B0, 0, 0); PG8_LDB(B1, 0, 1); PG8_SCHED; PG8_LDA(At, 0, 0); PG8_STAGE(PG8_SA(1, 1), a1 + hstep, voffA);
            PG8_WAIT_V(8); PG8_WAIT_L(0); PG8_BAR; PG8_MMA(0, 0, At, B0); PG8_MMA(0, 1, At, B1); PG8_BAR; PG8_SCHED;
            PG8_LDA(At, 0, 1); PG8_STAGE(PG8_SB(0, 0), b2, voffB); PG8_STAGE(PG8_SB(0, 1), b2 + hstep, voffB); PG8_STAGE(PG8_SA(0, 0), a2, voffA);
            PG8_WAIT_V(8); PG8_WAIT_L(0); PG8_BAR; PG8_MMA(1, 0, At, B0); PG8_MMA(1, 1, At, B1); PG8_BAR; PG8_SCHED;
            PG8_LDB(B0, 1, 0); PG8_LDB(B1, 1, 1); PG8_SCHED; PG8_LDA(At, 1, 0); PG8_STAGE(PG8_SA(0, 1), a2 + hstep, voffA);
            PG8_WAIT_V(8); PG8_WAIT_L(0); PG8_BAR; PG8_MMA(0, 0, At, B0); PG8_MMA(0, 1, At, B1); PG8_BAR; PG8_SCHED;
            PG8_LDA(At, 1, 1); PG8_STAGE(PG8_SB(1, 0), b3, voffB); PG8_STAGE(PG8_SB(1, 1), b3 + hstep, voffB); PG8_STAGE(PG8_SA(1, 0), a3, voffA);
            PG8_WAIT_V(8); PG8_WAIT_L(0); PG8_BAR; PG8_MMA(1, 0, At, B0); PG8_MMA(1, 1, At, B1); PG8_BAR; PG8_SCHED;
            } else {
            PG8_LDB(B0, 0, 0); PG8_SCHED; PG8_LDA(At, 0, 0); PG8_STAGE(PG8_SA(1, 1), a1 + hstep, voffA);
            PG8_WAIT_L(8); PG8_BAR; PG8_WAIT_L(0); PG8_MMA(0, 0, At, B0); PG8_BAR; PG8_SCHED;
            PG8_LDB(B1, 0, 1); PG8_STAGE(PG8_SB(0, 0), b2, voffB);
            PG8_BAR; PG8_WAIT_L(0); PG8_MMA(0, 1, At, B1); PG8_BAR;
            PG8_LDA(At, 0, 1); PG8_STAGE(PG8_SA(0, 0), a2, voffA);
            PG8_BAR; PG8_WAIT_L(0); PG8_MMA(1, 0, At, B0); PG8_BAR; PG8_SCHED;
            PG8_STAGE(PG8_SB(0, 1), b2 + hstep, voffB);
            PG8_WAIT_V(6); PG8_BAR; PG8_MMA(1, 1, At, B1); PG8_BAR;
            PG8_LDB(B0, 1, 0); PG8_SCHED; PG8_LDA(At, 1, 0); PG8_STAGE(PG8_SA(0, 1), a2 + hstep, voffA);
            PG8_WAIT_L(8); PG8_BAR; PG8_WAIT_L(0); PG8_MMA(0, 0, At, B0); PG8_BAR; PG8_SCHED;
            PG8_LDB(B1, 1, 1); PG8_STAGE(PG8_SB(1, 0), b3, voffB);
            PG8_BAR; PG8_WAIT_L(0); PG8_MMA(0, 1, At, B1); PG8_BAR;
            PG8_LDA(At, 1, 1); PG8_STAGE(PG8_SA(1, 0), a3, voffA);
            PG8_BAR; PG8_WAIT_L(0); PG8_MMA(1, 0, At, B0); PG8_BAR; PG8_SCHED;
            PG8_STAGE(PG8_SB(1, 1), b3 + hstep, voffB);
            PG8_WAIT_V(6); PG8_BAR; PG8_MMA(1, 1, At, B1); PG8_BAR;
            }
        }
        if constexpr (ALIGN_EPI) { if (wr == 0) PG8_BAR; }
        if constexpr (!Epi::AFTER_DRAIN) { E(acc, cur, wr, wc, fr, fq); S.done(cur); }
        if (!has_next) break;
#pragma unroll
        for (int a = 0; a < 2; ++a)
#pragma unroll
            for (int b = 0; b < 2; ++b)
#pragma unroll
                for (int m = 0; m < 4; ++m)
#pragma unroll
                    for (int n = 0; n < 2; ++n) acc[a][b][m][n] = (f32x4){0.f, 0.f, 0.f, 0.f};
        cur = nxt; cA = nA; cB = nB; ++ui;
        if constexpr (ALIGN_EPI) { if (wr == 1) PG8_BAR; }
    }
    PG8_WAIT_V(0);
    if constexpr (!ALIGN_EPI) { if (wr == 0) PG8_BAR; }
    PG8_BAR;
    if constexpr (Epi::AFTER_DRAIN) { E.fused(acc, cur, wr, wc, fr, fq, lds, wid, lane); S.done(cur); }
#undef PG8_SA
#undef PG8_SB
#undef PG8_STAGE
#undef PG8_LDA
#undef PG8_LDB
#undef PG8_MMA
#undef PG8_WAIT_V
#undef PG8_WAIT_L
#undef PG8_BAR
#undef PG8_SCHED
}
}


template <class ColFn, class GainFn>
__device__ __forceinline__ void transpose_item(const float* src, int ldsrc, int Kreal, ColFn colfn, GainFn gain, bf16* dst, int K, int k0, int n0, float* scr, int lane) {
    const int n = n0 + (lane & 31); const int c = colfn(n);
#pragma unroll 8
    for (int i = 0; i < 32; ++i) { const int kk = 2 * i + (lane >> 5), k = k0 + kk;
        float v = 0.f; if (c >= 0 && k < Kreal) v = src[(size_t)k * ldsrc + c] * gain(k);
        scr[kk * 33 + (lane & 31)] = v; }
    asm volatile("s_waitcnt lgkmcnt(0)" ::: "memory");
    const int c8 = lane & 7;
#pragma unroll
    for (int j = 0; j < 4; ++j) { const int nn = (lane >> 3) + 8 * j; const float* s = scr + (8 * c8) * 33 + nn;
        v4u o; o.x = pk2(s[0 * 33], s[1 * 33]); o.y = pk2(s[2 * 33], s[3 * 33]); o.z = pk2(s[4 * 33], s[5 * 33]); o.w = pk2(s[6 * 33], s[7 * 33]);
        *(v4u*)(dst + (size_t)(n0 + nn) * K + k0 + 8 * c8) = o; }
    asm volatile("s_waitcnt lgkmcnt(0)" ::: "memory");
}
__device__ __forceinline__ int win_col(int n) {
    if (n < 1536) return n;
    if (n < 1792) return n - 1536 + 1544;
    if (n < 1920) return n - 1792 + 1800;
    if (n < 1952) return n - 1920 + 1928;
    if (n < 1960) return n - 1952 + 1536;
    return -1;
}
__device__ void ph_prep(float* lds, float* mod, bf16* WIN_T, bf16* WOUT_T, bf16* WUQ_T, bf16* WUKV_T, bf16* WGU_T, bf16* WD_T, float* WRT, int* CNT) {
    const int tid = tidx(), lane = tid & 63, wave = tid >> 6;
    if (blockIdx.x < 6 * D / 64) {
        float* sc = lds;
        float* part = lds + 8 * D;
        const float* c = IN(1); const float* ada_w = IN(3); const float* ada_b = IN(4);
        for (int i = tid; i < NB * D; i += NT) sc[i] = silu_f(c[i]);
        __syncthreads();
        const int j = blockIdx.x * 64 + lane;
        float acc[NB];
#pragma unroll
        for (int b = 0; b < NB; ++b) acc[b] = 0.f;
        for (int k = wave * 128; k < wave * 128 + 128; ++k) {
            const float w = ada_w[(size_t)k * 6 * D + j];
#pragma unroll
            for (int b = 0; b < NB; ++b) acc[b] += sc[b * D + k] * w;
        }
#pragma unroll
        for (int b = 0; b < NB; ++b) part[(wave * NB + b) * 64 + lane] = acc[b];
        __syncthreads();
        { const int b = tid >> 6;
          float s = ada_b[j];
#pragma unroll
          for (int w = 0; w < 8; ++w) s += part[(w * NB + b) * 64 + lane];
          mod[b * 6 * D + j] = s; }
        __syncthreads();
    }
    float* scr = lds + wave * (64 * 33);
    const int gw = (gridDim.x - 1 - blockIdx.x) * (NT / 64) + wave, ngw = gridDim.x * (NT / 64);
    constexpr int I_IN = (D / 64) * (NU / 32), I_OUT = (D / 64) * (D / 32), I_UQ = (QR / 64) * (768 / 32), I_UKV = (256 / 64) * (1024 / 32);
    const float* ssd_norm = IN(15); const float* q_norm = IN(16); const float* kv_norm = IN(18); const float* mla_norm = IN(20);
    for (int i = blockIdx.x * NT + tid; i < 36 * D; i += gridDim.x * NT) { const int c = i >> 10, k = i & 1023;
        WRT[i] = (c < 4) ? IN(22)[k * 4 + c] : IN(24)[k * 32 + c - 4]; }
    constexpr int I_GU = NEXP * (D / 64) * (512 / 32), I_DN = NEXP * (FF / 64) * (D / 32);
    for (int it = gw; it < I_IN + I_OUT + I_UQ + I_UKV + I_GU + I_DN; it += ngw) {
        int r = it;
        if (r < I_IN) { const int nb = NU / 32; transpose_item(IN(9), NIN, D, [](int n) { return win_col(n); }, [](int) { return 1.f; }, WIN_T, D, (r / nb) * 64, (r % nb) * 32, scr, lane); continue; }
        r -= I_IN;
        if (r < I_OUT) { const int nb = D / 32; transpose_item(IN(21), D, D, [](int n) { return n; }, [=](int k) { return k < 512 ? ssd_norm[k] : mla_norm[k - 512]; }, WOUT_T, D, (r / nb) * 64, (r % nb) * 32, scr, lane); continue; }
        r -= I_OUT;
        if (r < I_UQ) { const int nb = 768 / 32; transpose_item(IN(17), 768, QR, [](int n) { return n; }, [=](int k) { return q_norm[k] * 0.14724444f; }, WUQ_T, QR, (r / nb) * 64, (r % nb) * 32, scr, lane); continue; }
        r -= I_UQ;
        if (r >= I_UQ + I_UKV - I_UQ) {
            r -= I_UKV;
            if (r < I_GU) { const int e = r / 256, q = r % 256, kb = q / 16, nb = q % 16;
                const int ct = nb >> 3, rr = (nb & 7) * 32; const float* src = (rr < 128 ? IN(26) : IN(27)) + (size_t)e * D * FF; const int cbase = 128 * ct + (rr & 127) - 32 * nb;
                transpose_item(src, FF, D, [=](int n) { return n + cbase; }, [](int) { return 1.f; }, WGU_T + (size_t)e * 512 * D, D, kb * 64, nb * 32, scr, lane); continue; }
            r -= I_GU;
            { const int e = r / 128, q = r % 128, kb = q / 32, nb = q % 32;
              transpose_item(IN(28) + (size_t)e * FF * D, D, FF, [](int n) { return n; }, [](int) { return 1.f; }, WD_T + (size_t)e * D * FF, FF, kb * 64, nb * 32, scr, lane); continue; }
        }
        { const int nb = 1024 / 32; transpose_item(IN(19), 1024, KVR, [](int n) { return n; }, [=](int k) { return k < KVR ? kv_norm[k] : 0.f; }, WUKV_T, 256, (r / nb) * 64, (r % nb) * 32, scr, lane); }
    }
}

__device__ void ph_prenorm_bf16(const float* in, const float* g, const float* mod, int sh_off, int sc_off, bf16* out) {
    const int lane = tidx() & 63, gw = blockIdx.x * (NT / 64) + (tidx() >> 6), ngw = gridDim.x * (NT / 64);
    for (int t = gw; t < M; t += ngw) {
        const int b = t / SEQ; const f32x4v* r = (const f32x4v*)(in + (size_t)t * D) + lane;
        f32x4v v[4]; float s = 0.f;
#pragma unroll
        for (int j = 0; j < 4; ++j) { v[j] = r[64 * j]; s += (v[j].x * v[j].x + v[j].y * v[j].y) + (v[j].z * v[j].z + v[j].w * v[j].w); }
        const float inv = rsqrtf(wave_sum(s) / D + EPS);
        const f32x4v* gp = (const f32x4v*)g + lane; const f32x4v* scp = (const f32x4v*)(mod + b * 6 * D + sc_off) + lane; const f32x4v* shp = (const f32x4v*)(mod + b * 6 * D + sh_off) + lane;
        unsigned long long* o8 = (unsigned long long*)(out + (size_t)t * D) + lane;
#pragma unroll
        for (int j = 0; j < 4; ++j) { const f32x4v gg = gp[64 * j], sc = scp[64 * j], sh = shp[64 * j];
            const f32x4v h = v[j] * inv * gg * (sc + 1.f) + sh;
            o8[64 * j] = (unsigned long long)pk2(h.x, h.y) | ((unsigned long long)pk2(h.z, h.w) << 32); }
    }
}


__device__ void ph_prep2(const bf16* U, const int* pos, const float* conv_w, const float* conv_b, const float* dt_bias,
                         bf16* CQN, bf16* CKVN, bf16* KF, float* COS, float* SIN, float* DT, bf16* XC) {
    const int lane = tidx() & 63, gw = blockIdx.x * (NT / 64) + (tidx() >> 6), ngw = gridDim.x * (NT / 64);
    const int rows_per = (M + ngw - 1) / ngw;
    for (int t = gw * rows_per; t < (gw + 1) * rows_per && t < M; ++t) {
        const int sq = t & (SEQ - 1), b = t >> 11;
        const bf16* ur = U + (size_t)t * NU;
        { const uint2 w = *(const uint2*)(ur + OFF_CQ + lane * 4);
          const float a0 = __uint_as_float(w.x << 16), a1 = __uint_as_float(w.x & 0xffff0000u), a2 = __uint_as_float(w.y << 16), a3 = __uint_as_float(w.y & 0xffff0000u);
          const float inv = rsqrtf(wave_sum(a0 * a0 + a1 * a1 + a2 * a2 + a3 * a3) * (1.f / QR) + EPS);
          uint2 o; o.x = pk2(a0 * inv, a1 * inv); o.y = pk2(a2 * inv, a3 * inv);
          *(uint2*)(CQN + (size_t)t * QR + lane * 4) = o; }
        { const unsigned w = *(const unsigned*)(ur + OFF_CKV + lane * 2);
          const float a0 = __uint_as_float(w << 16), a1 = __uint_as_float(w & 0xffff0000u);
          const float inv = rsqrtf(wave_sum(a0 * a0 + a1 * a1) * (1.f / KVR) + EPS);
          *(unsigned*)(CKVN + (size_t)t * 256 + lane * 2) = pk2(a0 * inv, a1 * inv);
          *(unsigned*)(CKVN + (size_t)t * 256 + 128 + lane * 2) = 0u; }
        { const int i = lane & 15;
          const float x1 = bf2f(ur[OFF_KR + i]), x2 = bf2f(ur[OFF_KR + 16 + i]);
          const float inv = exp2f(-(float)i * (13.287712379549449f / 16.0f));
          const float ang = (float)pos[t] * inv;
          float sn, cs; sincosf(ang, &sn, &cs);
          if (lane < 16) { COS[(size_t)t * 16 + i] = cs; SIN[(size_t)t * 16 + i] = sn; }
          const float r1 = x1 * cs - x2 * sn, r2 = x2 * cs + x1 * sn;
          const int cc = lane & 3, hh = (lane >> 2) & 7;
          float e[8];
#pragma unroll
          for (int j = 0; j < 8; ++j) { const float p1 = __shfl(r1, (cc & 1) * 8 + j), p2 = __shfl(r2, (cc & 1) * 8 + j); e[j] = (cc >> 1) ? p2 : p1; }
          if (lane < 32) { v4u o; o.x = pk2(e[0], e[1]); o.y = pk2(e[2], e[3]); o.z = pk2(e[4], e[5]); o.w = pk2(e[6], e[7]);
            *(v4u*)(KF + (size_t)((b * 8 + hh) * 32 + (sq >> 6)) * 6144 + (8 + cc) * 512 + (sq & 63) * 8) = o; } }
        if (lane < 8) { const float raw = bf2f(ur[OFF_DT + lane]) + dt_bias[lane]; DT[(size_t)t * 8 + lane] = raw > 20.f ? raw : log1pf(expf(raw)); }
        { const int ch = lane * 16;
          float acc[16];
          { const f32x4v* bp = (const f32x4v*)(conv_b + ch);
#pragma unroll
            for (int q4 = 0; q4 < 4; ++q4) { const f32x4v bb = bp[q4]; acc[4 * q4] = bb.x; acc[4 * q4 + 1] = bb.y; acc[4 * q4 + 2] = bb.z; acc[4 * q4 + 3] = bb.w; } }
#pragma unroll
          for (int k = 0; k < 4; ++k) {
              if (sq - 3 + k >= 0) {
                  const v4u* xp = (const v4u*)(U + (size_t)(t - 3 + k) * NU + OFF_XBC + ch);
                  const v4u xa = xp[0], xb = xp[1];
                  const f32x4v* wp = (const f32x4v*)(conv_w + k * SSD_XBC + ch);
                  const unsigned xw[8] = {xa.x, xa.y, xa.z, xa.w, xb.x, xb.y, xb.z, xb.w};
#pragma unroll
                  for (int q4 = 0; q4 < 4; ++q4) { const f32x4v ww = wp[q4];
                      acc[4 * q4] += ww.x * __uint_as_float(xw[2 * q4] << 16); acc[4 * q4 + 1] += ww.y * __uint_as_float(xw[2 * q4] & 0xffff0000u);
                      acc[4 * q4 + 2] += ww.z * __uint_as_float(xw[2 * q4 + 1] << 16); acc[4 * q4 + 3] += ww.w * __uint_as_float(xw[2 * q4 + 1] & 0xffff0000u); }
              }
          }
          v4u o0, o1;
          o0.x = pk2(silu_f(acc[0]), silu_f(acc[1])); o0.y = pk2(silu_f(acc[2]), silu_f(acc[3])); o0.z = pk2(silu_f(acc[4]), silu_f(acc[5])); o0.w = pk2(silu_f(acc[6]), silu_f(acc[7]));
          o1.x = pk2(silu_f(acc[8]), silu_f(acc[9])); o1.y = pk2(silu_f(acc[10]), silu_f(acc[11])); o1.z = pk2(silu_f(acc[12]), silu_f(acc[13])); o1.w = pk2(silu_f(acc[14]), silu_f(acc[15]));
          { bf16* base = XC + (size_t)(t >> 7) * 131072; const int l = t & 127;
            if (ch < 512) { v4u* op = (v4u*)(base + (ch >> 6) * 8192 + ((ch & 63) >> 5) * 4096 + l * 32 + (ch & 31)); op[0] = o0; op[1] = o1; }
            else { const int c2 = ch - 512; bf16* q = base + 65536 + (c2 >> 7) * 16384 + ((c2 & 127) >> 3) * 1024 + l * 8; *(v4u*)q = o0; *(v4u*)(q + 1024) = o1; } } }
    }
}


#define RLAS __attribute__((address_space(3)))
__device__ __forceinline__ float dpp_f(float v, int ctrl_sel) {
    const int x = __float_as_int(v); int r;
    if (ctrl_sel == 0) r = __builtin_amdgcn_update_dpp(0, x, 0xB1, 0xF, 0xF, true);
    else if (ctrl_sel == 1) r = __builtin_amdgcn_update_dpp(0, x, 0x1B, 0xF, 0xF, true);
    else if (ctrl_sel == 2) r = __builtin_amdgcn_update_dpp(0, x, 0x141, 0xF, 0xF, true);
    else r = __builtin_amdgcn_update_dpp(0, x, 0x140, 0xF, 0xF, true);
    return __int_as_float(r);
}
__device__ __forceinline__ float wave_sum_valu(float v) {
    v += dpp_f(v, 0); v += dpp_f(v, 1); v += dpp_f(v, 2); v += dpp_f(v, 3);
    { auto rr = __builtin_amdgcn_permlane16_swap(__float_as_uint(v), __float_as_uint(v), false, false); v = __uint_as_float(rr[0]) + __uint_as_float(rr[1]); }
    { auto rr = __builtin_amdgcn_permlane32_swap(__float_as_uint(v), __float_as_uint(v), false, false); v = __uint_as_float(rr[0]) + __uint_as_float(rr[1]); }
    return v;
}
__device__ void ph_rowrouter(RLAS float* ldsf, const bf16* Yb, const float* x, const float* post_gain, const float* pre_gain, const float* mod, const float* WRT,
                             const float* bgr, const float* ber, float* out, bf16* H2, int* CNT, int* RT_E, int* RT_S, float* RT_W) {
    const int tid = tidx(), lane = tid & 63, wave = tid >> 6;
    const int gw = blockIdx.x * (NT / 64) + wave, ngw = gridDim.x * (NT / 64);
    { const f32x4v* src = (const f32x4v*)WRT; RLAS f32x4v* dst = (RLAS f32x4v*)ldsf;
      for (int i = tid; i < 36 * 1024 / 4; i += NT) dst[i] = src[i]; }
    RLAS float* Lg = ldsf + 36 * 1024 + wave * 320;
    __syncthreads();
    const int b0 = lane & 1, b1 = (lane >> 1) & 1, b2 = (lane >> 2) & 1, b3 = (lane >> 3) & 1, b4 = (lane >> 4) & 1, b5 = lane >> 5;
    const int i4 = b0 + 2 * b1, i3 = i4 + 3 * b2, i2 = i3 + 5 * b3;
    const bool colok = (i4 <= 2) && (i3 <= 4) && (i2 <= 8); const int mycol = i2 + 9 * b4 + 18 * b5;
    const int rows_per = (M + ngw - 1) / ngw;
    for (int bi = 0; bi < (rows_per + 7) / 8; ++bi) {
        const int tb = gw * rows_per + 8 * bi; const int nr = max(0, min(8, min((gw + 1) * rows_per, M) - tb));
        uint2 ynx[4]; f32x4v xnx[4];
        if (nr > 0) { const uint2* yp0 = (const uint2*)(Yb + (size_t)tb * D) + lane; const f32x4v* xp0 = (const f32x4v*)(x + (size_t)tb * D) + lane;
#pragma unroll
            for (int j = 0; j < 4; ++j) { ynx[j] = yp0[64 * j]; xnx[j] = xp0[64 * j]; } }
        for (int ri = 0; ri < nr; ++ri) {
            const int t = tb + ri, b = t >> 11;
            f32x4v* op = (f32x4v*)(out + (size_t)t * D) + lane;
            f32x4v y[4], xv[4]; float ssy = 0.f;
#pragma unroll
            for (int j = 0; j < 4; ++j) { const uint2 w = ynx[j]; xv[j] = xnx[j];
                y[j].x = __uint_as_float(w.x << 16); y[j].y = __uint_as_float(w.x & 0xffff0000u); y[j].z = __uint_as_float(w.y << 16); y[j].w = __uint_as_float(w.y & 0xffff0000u);
                ssy += (y[j].x * y[j].x + y[j].y * y[j].y) + (y[j].z * y[j].z + y[j].w * y[j].w); }
            if (ri + 1 < nr) { const uint2* yp1 = (const uint2*)(Yb + (size_t)(t + 1) * D) + lane; const f32x4v* xp1 = (const f32x4v*)(x + (size_t)(t + 1) * D) + lane;
#pragma unroll
                for (int j = 0; j < 4; ++j) { ynx[j] = yp1[64 * j]; xnx[j] = xp1[64 * j]; } }
            const float invy = rsqrtf(wave_sum_valu(ssy) * (1.f / D) + EPS);
            const f32x4v* g1p = (const f32x4v*)(mod + b * 6 * D + 2 * D) + lane; const f32x4v* pgp = (const f32x4v*)post_gain + lane;
            float ss1 = 0.f;
#pragma unroll
            for (int j = 0; j < 4; ++j) { xv[j] = xv[j] + g1p[64 * j] * (y[j] * invy * pgp[64 * j]); op[64 * j] = xv[j];
                ss1 += (xv[j].x * xv[j].x + xv[j].y * xv[j].y) + (xv[j].z * xv[j].z + xv[j].w * xv[j].w); }
            const float inv1 = rsqrtf(wave_sum_valu(ss1) * (1.f / D) + EPS);
            const f32x4v* prp = (const f32x4v*)pre_gain + lane; const f32x4v* scp = (const f32x4v*)(mod + b * 6 * D + 4 * D) + lane; const f32x4v* shp = (const f32x4v*)(mod + b * 6 * D + 3 * D) + lane;
            uint2* hp = (uint2*)(H2 + (size_t)t * D) + lane;
#pragma unroll
            for (int j = 0; j < 4; ++j) { xv[j] = xv[j] * inv1 * prp[64 * j] * (scp[64 * j] + 1.f) + shp[64 * j];
                uint2 o; o.x = pk2(xv[j].x, xv[j].y); o.y = pk2(xv[j].z, xv[j].w); hp[64 * j] = o; }
            const RLAS f32x4v* wl = (const RLAS f32x4v*)ldsf + lane;
#define RDOT(c_) ({ const RLAS f32x4v* wc_ = wl + (c_) * 256; float a_ = 0.f; _Pragma("unroll") for (int j = 0; j < 4; ++j) { const f32x4v w_ = wc_[64 * j]; \
                a_ += (xv[j].x * w_.x + xv[j].y * w_.y) + (xv[j].z * w_.z + xv[j].w * w_.w); } a_; })
            float v1[18];
#pragma unroll
            for (int i = 0; i < 18; ++i) { const float a = RDOT(i), c = RDOT(i + 18);
                auto rr = __builtin_amdgcn_permlane32_swap(__float_as_uint(a), __float_as_uint(c), false, false); v1[i] = __uint_as_float(rr[0]) + __uint_as_float(rr[1]); }
#undef RDOT
            float v2[10];
#pragma unroll
            for (int i = 0; i < 9; ++i) { auto rr = __builtin_amdgcn_permlane16_swap(__float_as_uint(v1[i]), __float_as_uint(v1[i + 9]), false, false); v2[i] = __uint_as_float(rr[0]) + __uint_as_float(rr[1]); }
            v2[9] = 0.f;
            float v3[6];
#pragma unroll
            for (int i = 0; i < 5; ++i) { const float keep = b3 ? v2[i + 5] : v2[i], send = b3 ? v2[i] : v2[i + 5]; v3[i] = keep + dpp_f(send, 3); }
            v3[5] = 0.f;
            float v4[4];
#pragma unroll
            for (int i = 0; i < 3; ++i) { const float keep = b2 ? v3[i + 3] : v3[i], send = b2 ? v3[i] : v3[i + 3]; v4[i] = keep + dpp_f(send, 2); }
            v4[3] = 0.f;
            float v5[2];
#pragma unroll
            for (int i = 0; i < 2; ++i) { const float keep = b1 ? v4[i + 2] : v4[i], send = b1 ? v4[i] : v4[i + 2]; v5[i] = keep + dpp_f(send, 1); }
            const float keep6 = b0 ? v5[1] : v5[0], send6 = b0 ? v5[0] : v5[1];
            const float tot = keep6 + dpp_f(send6, 0);
            if (colok) Lg[ri * 40 + mycol] = tot;
        }
        asm volatile("s_waitcnt lgkmcnt(0)" ::: "memory");
        RLAS int* agg = (RLAS int*)(ldsf + 36 * 1024 + 8 * 320);
        if (tid < 32) agg[tid] = 0;
        __syncthreads();
        int e1 = 0, e2 = 0, r1 = 0, r2 = 0; float w1 = 0.f, w2 = 0.f;
        if (lane < nr) {
            const RLAS float* lr = Lg + lane * 40;
            float mxv = -INFINITY; int gi = 0;
            for (int i = 0; i < 4; ++i) { const float v = lr[i] + bgr[i]; if (v > mxv) { mxv = v; gi = i; } }
            float den = 0.f; for (int i = 0; i < 4; ++i) den += expf(lr[i] + bgr[i] - mxv);
            const float gwt = 1.f / den;
            float v1 = -INFINITY, v2 = -INFINITY; int i1 = 0, i2 = 0;
            for (int i = 0; i < 8; ++i) { const float v = lr[4 + gi * 8 + i] + ber[gi * 8 + i];
                if (v > v1) { v2 = v1; i2 = i1; v1 = v; i1 = i; } else if (v > v2) { v2 = v; i2 = i; } }
            const float p2 = expf(v2 - v1);
            e1 = gi * 8 + i1; e2 = gi * 8 + i2; w1 = gwt / (1.f + p2); w2 = gwt * p2 / (1.f + p2);
            r1 = __hip_atomic_fetch_add(agg + e1, 1, __ATOMIC_RELAXED, __HIP_MEMORY_SCOPE_WORKGROUP);
            r2 = __hip_atomic_fetch_add(agg + e2, 1, __ATOMIC_RELAXED, __HIP_MEMORY_SCOPE_WORKGROUP);
        }
        __syncthreads();
        if (tid < 32) { const int c = agg[tid]; agg[32 + tid] = c ? atomicAdd(&CNT[tid * 64], c) : 0; }
        __syncthreads();
        if (lane < nr) { const int t = tb + lane;
            RT_E[t] = e1 | (e2 << 8); RT_S[2 * t] = agg[32 + e1] + r1; RT_S[2 * t + 1] = agg[32 + e2] + r2; RT_W[2 * t] = w1; RT_W[2 * t + 1] = w2; }
        __syncthreads();
    }
    __syncthreads();
}
__device__ __forceinline__ void moe_table(int* tp, const int* CNT) {
    const int tid = tidx();
    __syncthreads();
    if (tid < 64) { const int c = (tid < 32) ? __hip_atomic_load(CNT + tid * 64, __ATOMIC_RELAXED, __HIP_MEMORY_SCOPE_AGENT) : 0; int v = (c + 255) >> 8;
        int inc = v;
#pragma unroll
        for (int o = 1; o < 64; o <<= 1) { const int n = __shfl_up(inc, o); if ((tid & 63) >= o) inc += n; }
        if (tid <= 32) tp[tid] = inc - v; }
    __syncthreads();
}
__device__ void ph_gather(int* tp, const bf16* H2, const int* RT_E, const int* RT_S, const float* RT_W, bf16* HG, float* ROWW, int* TOKROW) {
    const int lane = tidx() & 63, gw = blockIdx.x * (NT / 64) + (tidx() >> 6), ngw = gridDim.x * (NT / 64);
    for (int p = gw; p < 2 * M; p += ngw) { const int t = p >> 1, k = p & 1;
        const int e = (RT_E[t] >> (8 * k)) & 255; const int rowd = tp[e] * 256 + RT_S[p];
        const v4u* src = (const v4u*)(H2 + (size_t)t * D) + lane; v4u* dst = (v4u*)(HG + (size_t)rowd * D) + lane;
        dst[0] = src[0]; dst[64] = src[64];
        if (lane == 0) { ROWW[rowd] = RT_W[p]; TOKROW[p] = rowd; } }
}
__device__ void ph_moe_final(const bf16* YP, const int* TOKROW, const float* gain, const float* mod, float* out) {
    const int lane = tidx() & 63, gw = blockIdx.x * (NT / 64) + (tidx() >> 6), ngw = gridDim.x * (NT / 64);
    for (int t = gw; t < M; t += ngw) { const int b = t >> 11; const int r1 = TOKROW[2 * t], r2 = TOKROW[2 * t + 1];
        const v4u* p1 = (const v4u*)(YP + (size_t)r1 * D) + lane; const v4u* p2 = (const v4u*)(YP + (size_t)r2 * D) + lane;
        float y[16]; float ss = 0.f;
#pragma unroll
        for (int j = 0; j < 2; ++j) { const v4u a = p1[64 * j], c = p2[64 * j];
#pragma unroll
            for (int e = 0; e < 4; ++e) { const float v0 = __uint_as_float(a[e] << 16) + __uint_as_float(c[e] << 16), v1 = __uint_as_float(a[e] & 0xffff0000u) + __uint_as_float(c[e] & 0xffff0000u);
                y[8 * j + 2 * e] = v0; y[8 * j + 2 * e + 1] = v1; ss += v0 * v0 + v1 * v1; } }
        const float inv = rsqrtf(wave_sum(ss) * (1.f / D) + EPS);
#pragma unroll
        for (int j = 0; j < 2; ++j) { const int col = 512 * j + lane * 8; float* op = out + (size_t)t * D + col;
            const f32x4v g2a = *(const f32x4v*)(mod + b * 6 * D + 5 * D + col), g2b = *(const f32x4v*)(mod + b * 6 * D + 5 * D + col + 4);
            const f32x4v ga = *(const f32x4v*)(gain + col), gb = *(const f32x4v*)(gain + col + 4);
            f32x4v xa = *(f32x4v*)op, xb = *(f32x4v*)(op + 4);
            xa.x += g2a.x * (y[8 * j + 0] * inv * ga.x); xa.y += g2a.y * (y[8 * j + 1] * inv * ga.y); xa.z += g2a.z * (y[8 * j + 2] * inv * ga.z); xa.w += g2a.w * (y[8 * j + 3] * inv * ga.w);
            xb.x += g2b.x * (y[8 * j + 4] * inv * gb.x); xb.y += g2b.y * (y[8 * j + 5] * inv * gb.y); xb.z += g2b.z * (y[8 * j + 6] * inv * gb.z); xb.w += g2b.w * (y[8 * j + 7] * inv * gb.w);
            *(f32x4v*)op = xa; *(f32x4v*)(op + 4) = xb; }
    }
}
__device__ void ph_attn_ref(const bf16* Q, const bf16* KF, const bf16* VT, float* o) {
    const int lane = tidx() & 63, gw = blockIdx.x * (NT / 64) + (tidx() >> 6), ngw = gridDim.x * (NT / 64);
    for (int item = gw; item < NB * MLA_H * (SEQ / 64); item += ngw) {
        const int qb = (SEQ / 64 - 1) - item / (NB * MLA_H), bh = item % (NB * MLA_H), b = bh / MLA_H, h = bh % MLA_H;
        const int qi = qb * 64 + lane;
        const size_t t = (size_t)b * SEQ + qi;
        float qr[QK];
#pragma unroll
        for (int d = 0; d < QK; ++d) qr[d] = bf2f(Q[t * 768 + h * QK + d]);
        float acc[VD];
#pragma unroll
        for (int d = 0; d < VD; ++d) acc[d] = 0.f;
        float mx = -INFINITY, l = 0.f;
        const int kmax = qb * 64 + 63;
        for (int k = 0; k <= kmax; ++k) {
            const bf16* kt = KF + (size_t)(bh * 32 + (k >> 6)) * 6144 + (k & 63) * 8;
            const bf16* vt = VT + (size_t)(bh * 32 + (k >> 6)) * 4096 + (k & 63) * 32;
            float s = 0.f;
#pragma unroll
            for (int d = 0; d < QK; ++d) s += qr[d] * bf2f(kt[(d >> 3) * 512 + (d & 7)]);
            if (k <= qi) {
                const float mn = fmaxf(mx, s);
                const float f = exp2f(mx - mn), pv = exp2f(s - mn);
                l = l * f + pv;
#pragma unroll
                for (int d = 0; d < VD; ++d) acc[d] = acc[d] * f + pv * bf2f(vt[(d >> 5) * 2048 + (d & 31)]);
                mx = mn;
            }
        }
        const float il = 1.f / l;
#pragma unroll
        for (int d = 0; d < VD; ++d) o[t * (MLA_H * VD) + h * VD + d] = acc[d] * il;
    }
}

namespace att {
typedef short bf16x8 __attribute__((ext_vector_type(8)));
typedef short s16x4 __attribute__((ext_vector_type(4)));
typedef float f32x16 __attribute__((ext_vector_type(16)));
typedef unsigned u32x4 __attribute__((ext_vector_type(4)));
#define ALAS __attribute__((address_space(3)))
constexpr int KSLOT = 12288, VSLOT = 8192, NSLOT = 3;
constexpr int LDS_K = 0, LDS_V = NSLOT * KSLOT, LDS_WS = LDS_V + NSLOT * VSLOT, LDS_OST = LDS_WS + 8 * 256, LDS_END = LDS_OST + 8 * 4096;
constexpr float THR = 8.0f;
__device__ __forceinline__ int crow(int r, int hi) { return (r & 3) + 8 * (r >> 2) + 4 * hi; }
__device__ __forceinline__ unsigned cvtpk(float lo, float hi) { typedef float f2 __attribute__((ext_vector_type(2))); typedef __bf16 b2 __attribute__((ext_vector_type(2)));
    f2 v = {lo, hi}; b2 b = __builtin_convertvector(v, b2); return __builtin_bit_cast(unsigned, b); }
__device__ __forceinline__ s16x4 vtr(const ALAS char* p) { typedef short v4 __attribute__((ext_vector_type(4))); return __builtin_bit_cast(s16x4, __builtin_amdgcn_ds_read_tr16_b64_v4i16((ALAS v4*)p)); }
#define AWAIT_BAR(N) asm volatile("s_waitcnt vmcnt(" #N ") lgkmcnt(0)\n\ts_barrier" ::: "memory")

__device__ __forceinline__ void attn_unit(ALAS char* lds, int bh, int qb, const bf16* Q, const bf16* KF, const bf16* VT, bf16* YC, float* SSQ) {
    const int tid = tidx(), lane = tid & 63, r32 = lane & 31, hi = lane >> 5; const int wid = __builtin_amdgcn_readfirstlane(tid >> 6);
    const int b = bh >> 3, h = bh & 7;
    const char* Kt = (const char*)(KF + (size_t)bh * 32 * 6144); const char* Vt = (const char*)(VT + (size_t)bh * 32 * 4096);
    const int NTL = 4 * (qb + 1);
    bf16x8 qf[6];
    { const bf16* qp = Q + (size_t)(b * SEQ + qb * 256 + wid * 32 + r32) * 768 + h * QK + hi * 8;
#pragma unroll
      for (int d0 = 0; d0 < 6; ++d0) qf[d0] = *(const bf16x8*)(qp + d0 * 16); }
    const unsigned koff0 = wid * 1024 + lane * 16, koff1 = (8 + (wid & 3)) * 1024 + lane * 16, voff = wid * 1024 + lane * 16;
#define ADMA(t, slot) do { const char* kb_ = Kt + (size_t)(t) * KSLOT; const char* vb_ = Vt + (size_t)(t) * VSLOT; \
        __builtin_amdgcn_global_load_lds((const unsigned*)(kb_ + koff0), (ALAS unsigned*)(lds + LDS_K + (slot) * KSLOT + wid * 1024), 16, 0, 0); \
        __builtin_amdgcn_global_load_lds((const unsigned*)(kb_ + koff1), (ALAS unsigned*)(lds + LDS_K + (slot) * KSLOT + (8 + (wid & 3)) * 1024), 16, 0, 0); \
        __builtin_amdgcn_global_load_lds((const unsigned*)(vb_ + voff), (ALAS unsigned*)(lds + LDS_V + (slot) * VSLOT + wid * 1024), 16, 0, 0); } while (0)
    ADMA(0, 0); ADMA(1, 1);
    ALAS float* wsf = (ALAS float*)(lds + LDS_WS) + wid * 64;
    float mref = 0.f, l = 0.f;
    f32x16 o0 = {}, o1 = {}, negm = {};
    const int qrel = wid * 32 + r32;
    const int vlane = (4 * hi + ((lane & 15) >> 2)) * 64 + ((lane >> 4) & 1) * 32 + (lane & 3) * 8;
    int slot = 0;
    for (int t = 0; t < NTL; ++t) {
        if (t + 1 < NTL) { AWAIT_BAR(3); } else { AWAIT_BAR(0); }
        if (t + 2 < NTL) { const int s2 = (slot == 0) ? 2 : slot - 1; ADMA(t + 2, s2); }
        const ALAS char* Ks = lds + LDS_K + slot * KSLOT + hi * 1024 + r32 * 16;
        const ALAS char* Vs = lds + LDS_V + slot * VSLOT + vlane;
        f32x16 p0 = negm, p1 = negm;
#pragma unroll
        for (int d0 = 0; d0 < 6; ++d0) {
            const bf16x8 ka0 = *(const ALAS bf16x8*)(Ks + d0 * 2048), ka1 = *(const ALAS bf16x8*)(Ks + d0 * 2048 + 512);
            p0 = __builtin_amdgcn_mfma_f32_32x32x16_bf16(ka0, qf[d0], p0, 0, 0, 0);
            p1 = __builtin_amdgcn_mfma_f32_32x32x16_bf16(ka1, qf[d0], p1, 0, 0, 0);
        }
        const int jb = t - (NTL - 4);
        if (jb >= 0) {
#pragma unroll
            for (int r = 0; r < 16; ++r) { const int kv = 64 * jb + crow(r, hi); if (kv > qrel) p0[r] = -INFINITY; if (kv + 32 > qrel) p1[r] = -INFINITY; }
        }
        float rm = fmaxf(p0[0], p1[0]);
#pragma unroll
        for (int r = 1; r < 16; ++r) rm = fmaxf(rm, fmaxf(p0[r], p1[r]));
        { auto rr = __builtin_amdgcn_permlane32_swap(__float_as_uint(rm), __float_as_uint(rm), false, false); rm = fmaxf(__uint_as_float(rr[0]), __uint_as_float(rr[1])); }
        if (t == 0 || __any(rm > THR)) {
            const float dl = (t == 0) ? rm : fmaxf(rm, 0.f);
            mref += dl;
#pragma unroll
            for (int r = 0; r < 16; ++r) { p0[r] -= dl; p1[r] -= dl; }
#pragma unroll
            for (int r = 0; r < 16; ++r) negm[r] = -mref;
            const float f = exp2f(-dl); l *= f;
            if (t > 0) {
                if (hi == 0) wsf[r32] = f;
                asm volatile("s_waitcnt lgkmcnt(0)" ::: "memory");
#pragma unroll
                for (int r = 0; r < 16; ++r) { const float fr_ = wsf[crow(r, hi)]; o0[r] *= fr_; o1[r] *= fr_; }
            }
        }
        float ls = 0.f;
#pragma unroll
        for (int r = 0; r < 16; ++r) { p0[r] = exp2f(p0[r]); p1[r] = exp2f(p1[r]); ls += p0[r] + p1[r]; }
        l += ls;
        u32x4 pw0 = {cvtpk(p0[0], p0[1]), cvtpk(p0[2], p0[3]), cvtpk(p0[4], p0[5]), cvtpk(p0[6], p0[7])};
        u32x4 pw1 = {cvtpk(p0[8], p0[9]), cvtpk(p0[10], p0[11]), cvtpk(p0[12], p0[13]), cvtpk(p0[14], p0[15])};
        u32x4 pw2 = {cvtpk(p1[0], p1[1]), cvtpk(p1[2], p1[3]), cvtpk(p1[4], p1[5]), cvtpk(p1[6], p1[7])};
        u32x4 pw3 = {cvtpk(p1[8], p1[9]), cvtpk(p1[10], p1[11]), cvtpk(p1[12], p1[13]), cvtpk(p1[14], p1[15])};
#define PV_STEP(PW, ks) do { const bf16x8 pa_ = __builtin_bit_cast(bf16x8, PW); \
            { const s16x4 a_ = vtr(Vs + (ks) * 1024), b_ = vtr(Vs + (ks) * 1024 + 512); const bf16x8 vf_ = {a_[0], a_[1], a_[2], a_[3], b_[0], b_[1], b_[2], b_[3]}; \
              o0 = __builtin_amdgcn_mfma_f32_32x32x16_bf16(pa_, vf_, o0, 0, 0, 0); } \
            { const s16x4 a_ = vtr(Vs + 4096 + (ks) * 1024), b_ = vtr(Vs + 4096 + (ks) * 1024 + 512); const bf16x8 vf_ = {a_[0], a_[1], a_[2], a_[3], b_[0], b_[1], b_[2], b_[3]}; \
              o1 = __builtin_amdgcn_mfma_f32_32x32x16_bf16(pa_, vf_, o1, 0, 0, 0); } } while (0)
        PV_STEP(pw0, 0); PV_STEP(pw1, 1); PV_STEP(pw2, 2); PV_STEP(pw3, 3);
#undef PV_STEP
        slot = (slot == 2) ? 0 : slot + 1;
    }
    { auto rr = __builtin_amdgcn_permlane32_swap(__float_as_uint(l), __float_as_uint(l), false, false); l = __uint_as_float(rr[0]) + __uint_as_float(rr[1]); }
    if (hi == 0) wsf[32 + r32] = l;
    asm volatile("s_waitcnt lgkmcnt(0)" ::: "memory");
    ALAS bf16* stg = (ALAS bf16*)(lds + LDS_OST) + wid * 2048;
#pragma unroll
    for (int r = 0; r < 16; ++r) { const int orow = crow(r, hi); const float rl = 1.f / wsf[32 + orow];
        stg[orow * 64 + r32] = (bf16)f2bf(o0[r] * rl); stg[orow * 64 + 32 + r32] = (bf16)f2bf(o1[r] * rl); }
    asm volatile("s_waitcnt lgkmcnt(0)" ::: "memory");
    const size_t trow0 = (size_t)b * SEQ + qb * 256 + wid * 32;
#pragma unroll
    for (int i = 0; i < 4; ++i) { const int row = i * 8 + (lane >> 3), ch = lane & 7;
        const u32x4 v = *(const ALAS u32x4*)(stg + row * 64 + ch * 8);
        *(u32x4*)(YC + (trow0 + row) * 1024 + 512 + h * 64 + ch * 8) = v;
        float sq = 0.f;
#pragma unroll
        for (int e = 0; e < 4; ++e) { const float a = __uint_as_float(v[e] << 16), c = __uint_as_float(v[e] & 0xffff0000u); sq += a * a + c * c; }
        sq += __shfl_xor(sq, 1); sq += __shfl_xor(sq, 2); sq += __shfl_xor(sq, 4);
        if (ch == 0) SSQ[(trow0 + row) * 16 + 8 + h] = sq; }
    asm volatile("s_waitcnt lgkmcnt(0)\n\ts_barrier" ::: "memory");
#undef ADMA
}
__device__ __forceinline__ void attn_phase(ALAS char* lds, const bf16* Q, const bf16* KF, const bf16* VT, bf16* YC, float* SSQ) {
    const int G = gridDim.x, bid = blockIdx.x; const int vcu = (G % 8 == 0) ? (bid % 8) * (G / 8) + bid / 8 : bid;
    for (int p = vcu; p < 256; p += G) { const int bh = p >> 2, s = p & 3;
        attn_unit(lds, bh, 7 - s, Q, KF, VT, YC, SSQ);
        attn_unit(lds, bh, s, Q, KF, VT, YC, SSQ); }
}
#undef AWAIT_BAR
}
__device__ void ph_prenorm(const float* in, const float* g, const float* mod, int sh_off, int sc_off, float* out) {
    const int lane = tidx() & 63, gw = blockIdx.x * (NT / 64) + (tidx() >> 6), ngw = gridDim.x * (NT / 64);
    for (int t = gw; t < M; t += ngw) {
        const int b = t / SEQ; const float* r = in + (size_t)t * D;
        float s = 0.f;
        for (int i = lane; i < D; i += 64) s += r[i] * r[i];
        const float inv = rsqrtf(wave_sum(s) / D + EPS);
        for (int i = lane; i < D; i += 64)
            out[(size_t)t * D + i] = r[i] * inv * g[i] * (1.f + mod[b * 6 * D + sc_off + i]) + mod[b * 6 * D + sh_off + i];
    }
}
template <class TY> __device__ void ph_post(const float* base, const TY* y, const float* g, const float* mod, int gate_off, float* out) {
    const int lane = tidx() & 63, gw = blockIdx.x * (NT / 64) + (tidx() >> 6), ngw = gridDim.x * (NT / 64);
    for (int t = gw; t < M; t += ngw) {
        const int b = t / SEQ; const TY* r = y + (size_t)t * D;
        float s = 0.f;
        for (int i = lane; i < D; i += 64) { const float v = ldf(r + i); s += v * v; }
        const float inv = rsqrtf(wave_sum(s) / D + EPS);
        for (int i = lane; i < D; i += 64)
            out[(size_t)t * D + i] = base[(size_t)t * D + i] + mod[b * 6 * D + gate_off + i] * (ldf(r + i) * inv * g[i]);
    }
}
template <class TI> __device__ void ph_rms_slice(const TI* in, int ldi, int off, int n, const float* g, float* out, int ldo, int ooff) {
    const int lane = tidx() & 63, gw = blockIdx.x * (NT / 64) + (tidx() >> 6), ngw = gridDim.x * (NT / 64);
    for (int t = gw; t < M; t += ngw) {
        const TI* r = in + (size_t)t * ldi + off;
        float s = 0.f;
        for (int i = lane; i < n; i += 64) { const float v = ldf(r + i); s += v * v; }
        const float inv = rsqrtf(wave_sum(s) / n + EPS);
        for (int i = lane; i < n; i += 64) out[(size_t)t * ldo + ooff + i] = ldf(r + i) * inv * g[i];
    }
}

namespace ssd {
typedef short bf16x8 __attribute__((ext_vector_type(8)));
typedef short s16x4 __attribute__((ext_vector_type(4)));
typedef float f32x16 __attribute__((ext_vector_type(16)));
typedef unsigned u32x4 __attribute__((ext_vector_type(4)));
#define SLAS __attribute__((address_space(3)))
constexpr float LOG2E = 1.4426950408889634f;
__device__ __forceinline__ int crow(int r, int hi) { return (r & 3) + 8 * (r >> 2) + 4 * hi; }
__device__ __forceinline__ s16x4 vtr(const SLAS char* p) { typedef short v4 __attribute__((ext_vector_type(4))); return __builtin_bit_cast(s16x4, __builtin_amdgcn_ds_read_tr16_b64_v4i16((SLAS v4*)p)); }
__device__ __forceinline__ unsigned cvtpk(float lo, float hi) { typedef float f2 __attribute__((ext_vector_type(2))); typedef __bf16 b2 __attribute__((ext_vector_type(2)));
    f2 v = {lo, hi}; b2 b = __builtin_convertvector(v, b2); return __builtin_bit_cast(unsigned, b); }
#define SWAIT_BAR(N) asm volatile("s_waitcnt vmcnt(" #N ") lgkmcnt(0)\n\ts_barrier" ::: "memory")
#define SDMA(gsrc, ldst) __builtin_amdgcn_global_load_lds((const unsigned*)(gsrc), (SLAS unsigned*)(ldst), 16, 0, 0)

constexpr int SW_BUF = 49152, SW_TAB = 2 * SW_BUF;
__device__ __forceinline__ void state_sweep(SLAS char* lds, int b, int h, const bf16* XT, const float* DT, const float* a_log, float* ACS2, bf16* PREV) {
    const int tid = tidx(), lane = tid & 63, r32 = lane & 31, hi = lane >> 5; const int wid = __builtin_amdgcn_readfirstlane(tid >> 6);
    const int g = h >> 2, pt = wid & 1, nt = wid >> 1;
    const float a = -expf(a_log[h]);
    SLAS float* tab = (SLAS float*)(lds + SW_TAB);
    f32x16 st = {};
    const int trl = (4 * hi + ((lane & 15) >> 2));
    const int trc = 16 * ((lane >> 4) & 1) + 4 * (lane & 3);
#define SW_ISSUE(c_, buf_) do { const char* xs_ = (const char*)(XT + (size_t)(b * 16 + (c_)) * 131072 + h * 8192); const char* bs_ = (const char*)(XT + (size_t)(b * 16 + (c_)) * 131072 + 65536 + g * 16384); \
        _Pragma("unroll") for (int i_ = 0; i_ < 2; ++i_) SDMA(xs_ + (wid * 2 + i_) * 1024 + lane * 16, lds + (buf_) * SW_BUF + (wid * 2 + i_) * 1024); \
        _Pragma("unroll") for (int i_ = 0; i_ < 4; ++i_) SDMA(bs_ + (wid * 4 + i_) * 1024 + lane * 16, lds + (buf_) * SW_BUF + 16384 + (wid * 4 + i_) * 1024); } while (0)
    SW_ISSUE(0, 0);
    for (int c = 0; c < 16; ++c) {
        const int buf = c & 1;
        float cdec = 0.f, d0 = 0.f, d1 = 0.f;
        const size_t t0 = (size_t)(b * 16 + c) * 128;
        if (wid == 0) { d0 = DT[(t0 + 2 * lane) * 8 + h]; d1 = DT[(t0 + 2 * lane + 1) * 8 + h]; }
        if (c + 1 < 16) SW_ISSUE(c + 1, buf ^ 1);
        float cs0 = 0.f, cs1 = 0.f;
        if (wid == 0) {
            const float a0 = d0 * a, a1 = d1 * a; float inc = a0 + a1;
#pragma unroll
            for (int o = 1; o < 64; o <<= 1) { const float n = __shfl_up(inc, o); if (lane >= o) inc += n; }
            const float tot = __shfl(inc, 63); cs1 = inc; cs0 = inc - a1;
            tab[2 * lane] = cs0 * LOG2E; tab[2 * lane + 1] = cs1 * LOG2E;
            tab[128 + 2 * lane] = d0 * expf(tot - cs0); tab[128 + 2 * lane + 1] = d1 * expf(tot - cs1);
            if (lane == 0) tab[256] = expf(tot);
        }
        if (c + 1 < 16) { SWAIT_BAR(6); } else { SWAIT_BAR(0); }
        if (wid == 0) { ACS2[(t0 + 2 * lane) * 8 + h] = cs0 * LOG2E; ACS2[(t0 + 2 * lane + 1) * 8 + h] = cs1 * LOG2E; }
        cdec = tab[256];
        { SLAS char* xp = lds + buf * SW_BUF + tid * 32; const int l = (tid >> 1) & 127; const float w = tab[128 + l];
          u32x4 q0 = *(SLAS u32x4*)xp, q1 = *(SLAS u32x4*)(xp + 16);
#pragma unroll
          for (int e = 0; e < 4; ++e) { q0[e] = cvtpk(__uint_as_float(q0[e] << 16) * w, __uint_as_float(q0[e] & 0xffff0000u) * w); q1[e] = cvtpk(__uint_as_float(q1[e] << 16) * w, __uint_as_float(q1[e] & 0xffff0000u) * w); }
          *(SLAS u32x4*)xp = q0; *(SLAS u32x4*)(xp + 16) = q1; }
        asm volatile("s_waitcnt lgkmcnt(0)\n\ts_barrier" ::: "memory");
        f32x16 acc = {};
        { const SLAS char* bb = lds + buf * SW_BUF + 16384 + ((32 * nt + trc) >> 3) * 2048 + ((32 * nt + trc) & 7) * 2 + trl * 16;
          const SLAS char* xb = lds + buf * SW_BUF + pt * 8192 + trl * 64 + trc * 2;
#pragma unroll
          for (int ks = 0; ks < 8; ++ks) {
              const s16x4 a0 = vtr(bb + ks * 256), a1 = vtr(bb + ks * 256 + 128); const s16x4 x0 = vtr(xb + ks * 1024), x1 = vtr(xb + ks * 1024 + 512);
              const bf16x8 af = {a0[0], a0[1], a0[2], a0[3], a1[0], a1[1], a1[2], a1[3]}, xf = {x0[0], x0[1], x0[2], x0[3], x1[0], x1[1], x1[2], x1[3]};
              acc = __builtin_amdgcn_mfma_f32_32x32x16_bf16(af, xf, acc, 0, 0, 0); } }
        { bf16* pv = PREV + (size_t)((b * 16 + c) * 8 + h) * 8192 + (32 * pt + r32) * 8 + 4 * hi;
#pragma unroll
          for (int rg = 0; rg < 4; ++rg) { uint2 o; o.x = cvtpk(st[4 * rg], st[4 * rg + 1]); o.y = cvtpk(st[4 * rg + 2], st[4 * rg + 3]); *(uint2*)(pv + (4 * nt + rg) * 512) = o; } }
#pragma unroll
        for (int r = 0; r < 16; ++r) st[r] = st[r] * cdec + acc[r];
        asm volatile("s_waitcnt lgkmcnt(0)\n\ts_barrier" ::: "memory");
    }
#undef SW_ISSUE
}

constexpr int P2_C = 0, P2_B = 32768, P2_XP = 65536, P2_TAB = 131072, P2_STG = 135168, P2_END = 151552;
__device__ __forceinline__ void chunk_unit(SLAS char* lds, int b, int c, int g, const bf16* XT, const bf16* PREV, const float* DT, const float* ACS2, const float* d_skip,
                                           const bf16* U, bf16* YC, float* SSQS) {
    const int tid = tidx(), lane = tid & 63, r32 = lane & 31, hi = lane >> 5; const int wid = __builtin_amdgcn_readfirstlane(tid >> 6);
    const int lb = wid >> 1, ph = wid & 1;
    const char* xt = (const char*)(XT + (size_t)(b * 16 + c) * 131072);
    const size_t t0 = (size_t)(b * 16 + c) * 128;
#pragma unroll
    for (int i = 0; i < 4; ++i) { SDMA(xt + (98304 + g * 16384) * 2 + (wid * 4 + i) * 1024 + lane * 16, lds + P2_C + (wid * 4 + i) * 1024);
                                  SDMA(xt + (65536 + g * 16384) * 2 + (wid * 4 + i) * 1024 + lane * 16, lds + P2_B + (wid * 4 + i) * 1024); }
#define P2_ISSUE(hh_) do { const int h_ = 4 * g + (hh_); const char* xs_ = xt + h_ * 16384; const char* ps_ = (const char*)(PREV + (size_t)((b * 16 + c) * 8 + h_) * 8192); \
        SLAS char* d_ = lds + P2_XP + ((hh_) & 1) * 32768; \
        _Pragma("unroll") for (int i_ = 0; i_ < 2; ++i_) { SDMA(xs_ + (wid * 2 + i_) * 1024 + lane * 16, d_ + (wid * 2 + i_) * 1024); SDMA(ps_ + (wid * 2 + i_) * 1024 + lane * 16, d_ + 16384 + (wid * 2 + i_) * 1024); } } while (0)
    P2_ISSUE(0);
    { SLAS float* tab = (SLAS float*)(lds + P2_TAB); const int hh = tid >> 7, l = tid & 127;
      tab[hh * 256 + l] = ACS2[(t0 + l) * 8 + 4 * g + hh]; tab[hh * 256 + 128 + l] = DT[(t0 + l) * 8 + 4 * g + hh]; }
    P2_ISSUE(1);
    SWAIT_BAR(4);
    bf16x8 cf[8];
#pragma unroll
    for (int ks = 0; ks < 8; ++ks) cf[ks] = *(const SLAS bf16x8*)(lds + P2_C + (2 * ks + hi) * 2048 + (32 * lb + r32) * 16);
    f32x16 cbt[4];
#pragma unroll
    for (int sb = 0; sb < 4; ++sb) { cbt[sb] = f32x16{};
        if (sb <= lb) {
#pragma unroll
            for (int ks = 0; ks < 8; ++ks) { const bf16x8 bfr = *(const SLAS bf16x8*)(lds + P2_B + (2 * ks + hi) * 2048 + (32 * sb + r32) * 16);
                cbt[sb] = __builtin_amdgcn_mfma_f32_32x32x16_bf16(bfr, cf[ks], cbt[sb], 0, 0, 0); } } }
    const int vlane = (4 * hi + ((lane & 15) >> 2)) * 64 + ((lane >> 4) & 1) * 32 + (lane & 3) * 8;
    const int lrow = 32 * lb + r32;
    for (int hh = 0; hh < 4; ++hh) {
        const int h = 4 * g + hh;
        const SLAS char* xb = lds + P2_XP + (hh & 1) * 32768; const SLAS char* pb = xb + 16384;
        const SLAS float* tab = (const SLAS float*)(lds + P2_TAB) + hh * 256;
        const float dsk = d_skip[h];
        f32x16 o = {};
#pragma unroll
        for (int ks = 0; ks < 8; ++ks) { const bf16x8 pf = *(const SLAS bf16x8*)(pb + (2 * ks + hi) * 1024 + (32 * ph + r32) * 16);
            o = __builtin_amdgcn_mfma_f32_32x32x16_bf16(cf[ks], pf, o, 0, 0, 0); }
#pragma unroll
        for (int r = 0; r < 16; ++r) o[r] *= exp2f(tab[32 * lb + crow(r, hi)]);
        const float al = tab[lrow];
#pragma unroll
        for (int sb = 0; sb < 4; ++sb) {
            if (sb <= lb) {
                float pr[16];
#pragma unroll
                for (int r = 0; r < 16; ++r) { const int sidx = 32 * sb + crow(r, hi);
                    float v = cbt[sb][r] * exp2f(al - tab[sidx]) * tab[128 + sidx];
                    if (sb == lb) { v = (sidx <= lrow) ? v : 0.f; v += (sidx == lrow) ? dsk : 0.f; }
                    pr[r] = v; }
                const u32x4 pw0 = {cvtpk(pr[0], pr[1]), cvtpk(pr[2], pr[3]), cvtpk(pr[4], pr[5]), cvtpk(pr[6], pr[7])};
                const u32x4 pw1 = {cvtpk(pr[8], pr[9]), cvtpk(pr[10], pr[11]), cvtpk(pr[12], pr[13]), cvtpk(pr[14], pr[15])};
                const SLAS char* xv = xb + ph * 8192 + vlane + (2 * sb) * 1024;
                { const s16x4 a_ = vtr(xv), b_ = vtr(xv + 512); const bf16x8 vf = {a_[0], a_[1], a_[2], a_[3], b_[0], b_[1], b_[2], b_[3]};
                  o = __builtin_amdgcn_mfma_f32_32x32x16_bf16(__builtin_bit_cast(bf16x8, pw0), vf, o, 0, 0, 0); }
                { const s16x4 a_ = vtr(xv + 1024), b_ = vtr(xv + 1024 + 512); const bf16x8 vf = {a_[0], a_[1], a_[2], a_[3], b_[0], b_[1], b_[2], b_[3]};
                  o = __builtin_amdgcn_mfma_f32_32x32x16_bf16(__builtin_bit_cast(bf16x8, pw1), vf, o, 0, 0, 0); }
            }
        }
        SLAS bf16* stg = (SLAS bf16*)(lds + P2_STG) + wid * 1024;
#pragma unroll
        for (int r = 0; r < 16; ++r) stg[crow(r, hi) * 32 + r32] = (bf16)f2bf(o[r]);
        asm volatile("s_waitcnt lgkmcnt(0)" ::: "memory");
#pragma unroll
        for (int i = 0; i < 2; ++i) { const int row = i * 16 + (lane >> 2), ch = lane & 3; const size_t t = t0 + 32 * lb + row;
            const u32x4 ov = *(const SLAS u32x4*)(stg + row * 32 + ch * 8);
            const u32x4 zv = *(const u32x4*)(U + t * NU + OFF_Z + h * 64 + 32 * ph + 8 * ch);
            u32x4 w; float sq = 0.f;
#pragma unroll
            for (int e = 0; e < 4; ++e) { const float z0 = __uint_as_float(zv[e] << 16), z1 = __uint_as_float(zv[e] & 0xffff0000u);
                const float v0 = __uint_as_float(ov[e] << 16) * (z0 * __builtin_amdgcn_rcpf(1.f + __expf(-z0))), v1 = __uint_as_float(ov[e] & 0xffff0000u) * (z1 * __builtin_amdgcn_rcpf(1.f + __expf(-z1)));
                w[e] = cvtpk(v0, v1); const float r0 = __uint_as_float(w[e] << 16), r1 = __uint_as_float(w[e] & 0xffff0000u); sq += r0 * r0 + r1 * r1; }
            *(u32x4*)(YC + t * 1024 + h * 64 + 32 * ph + 8 * ch) = w;
            sq += __shfl_xor(sq, 1); sq += __shfl_xor(sq, 2);
            if (ch == 0) SSQS[t * 16 + h * 2 + ph] = sq; }
        if (hh < 3) {
            if (hh + 2 < 4) { asm volatile("s_waitcnt lgkmcnt(0)\n\ts_barrier" ::: "memory"); P2_ISSUE(hh + 2); SWAIT_BAR(4); }
            else { SWAIT_BAR(0); }
        }
    }
    asm volatile("s_waitcnt vmcnt(0) lgkmcnt(0)\n\ts_barrier" ::: "memory");
#undef P2_ISSUE
}
#undef SWAIT_BAR
#undef SDMA
}
__device__ void ph_gate_norm(const float* y, const bf16* u, bf16* YC) {
    const int lane = tidx() & 63, gw = blockIdx.x * (NT / 64) + (tidx() >> 6), ngw = gridDim.x * (NT / 64);
    for (int t = gw; t < M; t += ngw) {
        float v[8]; float s = 0.f;
#pragma unroll
        for (int j = 0; j < 8; ++j) { const int i = lane + 64 * j; v[j] = y[(size_t)t * SSD_INNER + i] * silu_f(bf2f(u[(size_t)t * NU + OFF_Z + i])); s += v[j] * v[j]; }
        const float inv = rsqrtf(wave_sum(s) / SSD_INNER + EPS);
#pragma unroll
        for (int j = 0; j < 8; ++j) YC[(size_t)t * 1024 + lane + 64 * j] = (bf16)f2bf(v[j] * inv);
    }
}
__device__ void ph_yc_norm(bf16* YC, const float* SSQS, const float* SSQ) {
    const int lane = tidx() & 63, gw = blockIdx.x * (NT / 64) + (tidx() >> 6), ngw = gridDim.x * (NT / 64);
    for (int t = gw; t < M; t += ngw) {
        float ss = 0.f, sm = 0.f;
#pragma unroll
        for (int q = 0; q < 4; ++q) { const f32x4v a = *(const f32x4v*)(SSQS + (size_t)t * 16 + 4 * q); ss += (a.x + a.y) + (a.z + a.w); }
        { const f32x4v a = *(const f32x4v*)(SSQ + (size_t)t * 16 + 8), b = *(const f32x4v*)(SSQ + (size_t)t * 16 + 12); sm = (a.x + a.y) + (a.z + a.w) + (b.x + b.y) + (b.z + b.w); }
        const float invs = rsqrtf(ss * (1.f / 512.f) + EPS), invm = rsqrtf(sm * (1.f / 512.f) + EPS);
#pragma unroll
        for (int hlf = 0; hlf < 2; ++hlf) { const float inv = hlf ? invm : invs;
            v4u* p = (v4u*)(YC + (size_t)t * 1024 + 512 * hlf) + lane; v4u w = *p;
            w.x = pk2(__uint_as_float(w.x << 16) * inv, __uint_as_float(w.x & 0xffff0000u) * inv); w.y = pk2(__uint_as_float(w.y << 16) * inv, __uint_as_float(w.y & 0xffff0000u) * inv);
            w.z = pk2(__uint_as_float(w.z << 16) * inv, __uint_as_float(w.z & 0xffff0000u) * inv); w.w = pk2(__uint_as_float(w.w << 16) * inv, __uint_as_float(w.w & 0xffff0000u) * inv);
            *p = w; }
    }
}
__device__ void ph_gemm(float* lds, const float* A, int lda, const float* B, int ldb, float* C, int ldc, int Mr, int N, int K) {
    float (*As)[129] = (float (*)[129])lds;
    float (*Bs)[65] = (float (*)[65])(lds + 16 * 129);
    const int tx = tidx() & 15, ty = tidx() >> 4;
    const int ntn = (N + 63) / 64, ntm = Mr / 128;
    for (int tile = blockIdx.x; tile < ntn * ntm; tile += gridDim.x) {
        const int m0 = (tile / ntn) * 128, n0 = (tile % ntn) * 64;
        float acc[4][4] = {};
        for (int k0 = 0; k0 < K; k0 += 16) {
            for (int i = tidx(); i < 128 * 16; i += NT) { const int r = i >> 4, kk = i & 15; As[kk][r] = A[(size_t)(m0 + r) * lda + k0 + kk]; }
            for (int i = tidx(); i < 64 * 16; i += NT) { const int kk = i >> 6, cc = i & 63; Bs[kk][cc] = (n0 + cc < N) ? B[(size_t)(k0 + kk) * ldb + n0 + cc] : 0.f; }
            __syncthreads();
#pragma unroll
            for (int kk = 0; kk < 16; ++kk) {
                float a[4], b[4];
#pragma unroll
                for (int i = 0; i < 4; ++i) { a[i] = As[kk][ty * 4 + i]; b[i] = Bs[kk][tx * 4 + i]; }
#pragma unroll
                for (int i = 0; i < 4; ++i)
#pragma unroll
                    for (int j = 0; j < 4; ++j) acc[i][j] += a[i] * b[j];
            }
            __syncthreads();
        }
#pragma unroll
        for (int i = 0; i < 4; ++i)
#pragma unroll
            for (int j = 0; j < 4; ++j) { const int n = n0 + tx * 4 + j; if (n < N) C[(size_t)(m0 + ty * 4 + i) * ldc + n] = acc[i][j]; }
    }
}
__device__ void ph_conv(const bf16* u, const float* cw, const float* cb, float* xc) {
    for (size_t idx = (size_t)blockIdx.x * NT + tidx(); idx < (size_t)M * SSD_XBC; idx += (size_t)gridDim.x * NT) {
        const int ch = (int)(idx % SSD_XBC), t = (int)(idx / SSD_XBC), s = t % SEQ;
        float acc = cb[ch];
        for (int k = 0; k < 4; ++k) { const int ss = s - 3 + k; if (ss >= 0) acc += cw[k * SSD_XBC + ch] * bf2f(u[(size_t)(t - 3 + k) * NU + OFF_XBC + ch]); }
        xc[idx] = silu_f(acc);
    }
}
__device__ void ph_ssd_seq(const float* DT, const bf16* xc, const float* dt_bias, const float* a_log, const float* d_skip, float* y) {
    for (int item = blockIdx.x; item < NB * SSD_H; item += gridDim.x) {
        const int b = item / SSD_H, h = item % SSD_H, g = h / (SSD_H / SSD_G);
        const int p = tidx() >> 3, nq = tidx() & 7;
        const float a = -expf(a_log[h]), dsk = d_skip[h];
        float st[16];
#pragma unroll
        for (int i = 0; i < 16; ++i) st[i] = 0.f;
        for (int s = 0; s < SEQ; ++s) {
            const size_t t = (size_t)b * SEQ + s;
            const float dt = DT[t * 8 + h];
            const float da = expf(dt * a);
            const float xv = bf2f(xc[t * SSD_XBC + h * SSD_P + p]);
            const float xd = xv * dt;
            const bf16* Bp = xc + t * SSD_XBC + SSD_INNER + g * SSD_N + nq * 16;
            const bf16* Cp = xc + t * SSD_XBC + SSD_INNER + SSD_G * SSD_N + g * SSD_N + nq * 16;
            float acc = 0.f;
#pragma unroll
            for (int i = 0; i < 16; ++i) { st[i] = st[i] * da + xd * bf2f(Bp[i]); acc += bf2f(Cp[i]) * st[i]; }
            acc += __shfl_xor(acc, 1); acc += __shfl_xor(acc, 2); acc += __shfl_xor(acc, 4);
            if (nq == 0) y[t * SSD_INNER + h * SSD_P + p] = acc + dsk * xv;
        }
    }
}
__device__ void ph_rope(float* q, const bf16* u, const int* pos, float* kpe) {
    for (int idx = blockIdx.x * NT + tidx(); idx < M * 9 * 16; idx += gridDim.x * NT) {
        const int i = idx % 16, hh = (idx / 16) % 9, t = idx / (16 * 9);
        const float inv = 1.0f / powf(10000.0f, (float)(2 * i) / 32.0f);
        const float ang = (float)pos[t] * inv;
        float sn, cs; sincosf(ang, &sn, &cs);
        if (hh < 8) {
            float* p = q + (size_t)t * (MLA_H * QK) + hh * QK + NOPE;
            const float x1 = p[i], x2 = p[16 + i];
            p[i] = x1 * cs - x2 * sn; p[16 + i] = x2 * cs + x1 * sn;
        } else {
            const bf16* p = u + (size_t)t * NU + OFF_KR;
            const float x1 = bf2f(p[i]), x2 = bf2f(p[16 + i]);
            kpe[(size_t)t * ROPE + i] = x1 * cs - x2 * sn; kpe[(size_t)t * ROPE + 16 + i] = x2 * cs + x1 * sn;
        }
    }
}
__device__ void ph_attn(const float* q, const float* kv, const float* kpe, float* o) {
    const int lane = tidx() & 63, gw = blockIdx.x * (NT / 64) + (tidx() >> 6), ngw = gridDim.x * (NT / 64);
    for (int item = gw; item < NB * MLA_H * (SEQ / 64); item += ngw) {
        const int qb = (SEQ / 64 - 1) - item / (NB * MLA_H), bh = item % (NB * MLA_H), b = bh / MLA_H, h = bh % MLA_H;
        const int qi = qb * 64 + lane;
        const size_t t = (size_t)b * SEQ + qi;
        float qr[QK];
#pragma unroll
        for (int d = 0; d < QK; ++d) qr[d] = q[t * (MLA_H * QK) + h * QK + d] * 0.10206207261596575f;
        float acc[VD];
#pragma unroll
        for (int d = 0; d < VD; ++d) acc[d] = 0.f;
        float mx = -INFINITY, l = 0.f;
        const int kmax = qb * 64 + 63;
        for (int k = 0; k <= kmax; ++k) {
            const size_t tk = (size_t)b * SEQ + k;
            const float* kn = kv + tk * (MLA_H * 128) + h * 128;
            const float* kp = kpe + tk * ROPE;
            float s = 0.f;
#pragma unroll
            for (int d = 0; d < NOPE; ++d) s += qr[d] * kn[d];
#pragma unroll
            for (int d = 0; d < ROPE; ++d) s += qr[NOPE + d] * kp[d];
            if (k <= qi) {
                const float mn = fmaxf(mx, s);
                const float f = expf(mx - mn), pv = expf(s - mn);
                l = l * f + pv;
#pragma unroll
                for (int d = 0; d < VD; ++d) acc[d] = acc[d] * f + pv * kn[64 + d];
                mx = mn;
            }
        }
        const float il = 1.f / l;
#pragma unroll
        for (int d = 0; d < VD; ++d) o[t * (MLA_H * VD) + h * VD + d] = acc[d] * il;
    }
}
__device__ void ph_moe(float* lds, const float* h2, const float* wgr, const float* bgr, const float* wer, const float* ber,
                       const float* wg, const float* wu, const float* wd, float* y2) {
    const int sb = tidx() >> 8, tid = tidx() & 255;
    float* xs = lds + sb * 2048;
    float* logit = xs + 1024;
    float* hid = xs + 1088;
    int* sel_e = (int*)(xs + 1600);
    float* sel_w = xs + 1604;
    for (int it = blockIdx.x; it < M / 2; it += gridDim.x) {
        const int t = it * 2 + sb;
        __syncthreads();
        for (int i = tid; i < D; i += 256) xs[i] = h2[(size_t)t * D + i];
        __syncthreads();
        {
            const int w = tid >> 6, lane = tid & 63;
            for (int cidx = w * 9; cidx < w * 9 + 9; ++cidx) {
                float s = 0.f;
                for (int k = lane; k < D; k += 64) s += xs[k] * (cidx < 4 ? wgr[k * 4 + cidx] : wer[k * 32 + (cidx - 4)]);
                s = wave_sum(s);
                if (lane == 0) logit[cidx] = s;
            }
        }
        __syncthreads();
        if (tid == 0) {
            float mxv = -INFINITY; int gi = 0;
            for (int i = 0; i < 4; ++i) { const float v = logit[i] + bgr[i]; logit[i] = v; if (v > mxv) { mxv = v; gi = i; } }
            float den = 0.f; for (int i = 0; i < 4; ++i) den += expf(logit[i] - mxv);
            const float gw = 1.f / den;
            float emx = -INFINITY; int i1 = 0;
            for (int i = 0; i < 8; ++i) { const float v = logit[4 + gi * 8 + i] + ber[gi * 8 + i]; logit[4 + gi * 8 + i] = v; if (v > emx) { emx = v; i1 = i; } }
            float e2 = -INFINITY; int i2 = 0;
            for (int i = 0; i < 8; ++i) { const float v = logit[4 + gi * 8 + i]; if (i != i1 && v > e2) { e2 = v; i2 = i; } }
            const float p2 = expf(e2 - emx);
            sel_e[0] = gi * 8 + i1; sel_e[1] = gi * 8 + i2;
            sel_w[0] = gw / (1.f + p2); sel_w[1] = gw * p2 / (1.f + p2);
        }
        __syncthreads();
        for (int k2 = 0; k2 < 2; ++k2) {
            const int e = sel_e[k2];
            const float* G = wg + (size_t)e * D * FF; const float* U = wu + (size_t)e * D * FF;
            float ga = 0.f, ua = 0.f;
            for (int k = 0; k < D; ++k) { ga += xs[k] * G[(size_t)k * FF + tid]; ua += xs[k] * U[(size_t)k * FF + tid]; }
            hid[k2 * FF + tid] = silu_f(ga) * ua * sel_w[k2];
        }
        __syncthreads();
        for (int d = tid; d < D; d += 256) {
            float acc = 0.f;
            for (int k2 = 0; k2 < 2; ++k2) {
                const float* Wd = wd + (size_t)sel_e[k2] * FF * D;
                for (int f = 0; f < FF; ++f) acc += hid[k2 * FF + f] * Wd[(size_t)f * D + d];
            }
            y2[(size_t)t * D + d] = acc;
        }
    }
}


#define LAS __attribute__((address_space(3)))
#define XB_TMO      128
#define XB_XCNT(j)  (256  + 64 * (j))
#define XB_XSUB(j)  (1280 + 64 * (j))
#define XB_XGEN(j)  (2304 + 64 * (j))
#define XB_TOP      3328
#define XB_TOPGEN   3392
#define XCD_BAR_WORDS 3456
#define XB_SPIN_CAP (1u << 18)

__device__ __forceinline__ unsigned xb_ld(unsigned* p)              { return __hip_atomic_load(p, __ATOMIC_RELAXED, __HIP_MEMORY_SCOPE_AGENT); }
__device__ __forceinline__ unsigned xb_add(unsigned* p, unsigned v) { return __hip_atomic_fetch_add(p, v, __ATOMIC_RELAXED, __HIP_MEMORY_SCOPE_AGENT); }
__device__ __forceinline__ unsigned xb_xcc_id() { return (unsigned)__builtin_amdgcn_s_getreg((3 << 11) | 20) & 0xFu; }
#define XB_SPIN(cond, bar) do { unsigned _sp = 0; while (cond) { __builtin_amdgcn_s_sleep(1); \
    if ((++_sp & 255u) == 0u) { if (xb_ld(&(bar)[XB_TMO])) break; if (_sp > XB_SPIN_CAP) { atomicAdd(&(bar)[XB_TMO], 1u); break; } } } } while (0)

struct XcdBarrier {
    unsigned* bar; unsigned x;
    volatile LAS unsigned* st;
};

__device__ __forceinline__ XcdBarrier xcd_barrier_post(unsigned* bar, volatile LAS unsigned* st) {
    XcdBarrier b; b.bar = bar; b.x = xb_xcc_id(); b.st = st;
    if (tidx() == 0) (void)xb_add(&bar[XB_XCNT(b.x)], 1u);
    return b;
}
__device__ __forceinline__ void xcd_barrier_complete(unsigned* bar, unsigned x, unsigned& nloc, unsigned& nx) {
    const unsigned G = gridDim.x * gridDim.y * gridDim.z;
    unsigned sum, cnt, mine, sp = 0u;
    for (;;) {
        sum = 0u; cnt = 0u; mine = 0u;
#pragma unroll
        for (unsigned j = 0; j < 16; ++j) { const unsigned c = xb_ld(&bar[XB_XCNT(j)]); sum += c; cnt += (c > 0u) ? 1u : 0u; mine = (j == x) ? c : mine; }
        if (sum == G) break;
        __builtin_amdgcn_s_sleep(1);
        if ((++sp & 255u) == 0u) { if (xb_ld(&bar[XB_TMO])) break; if (sp > XB_SPIN_CAP) { atomicAdd(&bar[XB_TMO], 1u); break; } }
    }
    nloc = mine > 0u ? mine : 1u; nx = cnt > 0u ? cnt : 1u;
}

__device__ __forceinline__ void xcd_barrier(const XcdBarrier& b) {
    asm volatile("s_waitcnt vmcnt(0)" ::: "memory");
    __syncthreads();
    if (tidx() == 0) {
        unsigned* bar = b.bar;
        __builtin_amdgcn_s_waitcnt(0);
        unsigned nloc = b.st[0], nx = b.st[1];
        if (nloc == 0u) { xcd_barrier_complete(bar, b.x, nloc, nx); b.st[0] = nloc; b.st[1] = nx; }
        const unsigned old = xb_add(&bar[XB_XSUB(b.x)], 1u);
        const unsigned gen = old / nloc;
        if (old + 1u == (gen + 1u) * nloc) {
            __builtin_amdgcn_fence(__ATOMIC_RELEASE, "agent");
            asm volatile("s_waitcnt vmcnt(0)" ::: "memory");
            const unsigned og = xb_add(&bar[XB_TOP], 1u);
            const unsigned tg = og / nx;
            if (og + 1u == (tg + 1u) * nx) xb_add(&bar[XB_TOPGEN], 1u);
            else XB_SPIN(xb_ld(&bar[XB_TOPGEN]) == tg, bar);
            __builtin_amdgcn_fence(__ATOMIC_ACQUIRE, "agent");
            xb_add(&bar[XB_XGEN(b.x)], 1u);
            asm volatile("s_waitcnt vmcnt(0)" ::: "memory");
        } else {
            XB_SPIN(xb_ld(&bar[XB_XGEN(b.x)]) == gen, bar);
            __builtin_amdgcn_fence(__ATOMIC_ACQUIRE, "agent");
            asm volatile("s_waitcnt vmcnt(0)" ::: "memory");
        }
    }
    __syncthreads();
}


constexpr size_t MiB = 1u << 20;
#define WSB(T, off) ((T*)(kargs()->ws + (size_t)(off)))
#define OUTB(T, off) ((T*)((char*)kargs()->out + (size_t)(off)))
#define B_CNT    WSB(int, 4096)
#define B_MOD    WSB(float, 1 * MiB)
#define B_DT     WSB(float, 1 * MiB + 256 * 1024)
#define B_ACS2   WSB(float, 1 * MiB + 768 * 1024)
#define B_WIN    WSB(bf16, 2 * MiB)
#define B_WOUT   WSB(bf16, 6 * MiB)
#define B_WUQ    WSB(bf16, 8 * MiB)
#define B_WUKV   WSB(bf16, 9 * MiB)
#define B_WRT    WSB(float, 9 * MiB + 512 * 1024)
#define B_WGU    WSB(bf16, 10 * MiB)
#define B_WD     WSB(bf16, 42 * MiB)
#define B_HB     WSB(bf16, 58 * MiB)
#define B_YC     WSB(bf16, 58 * MiB)
#define B_H2     WSB(bf16, 58 * MiB)
#define B_U      WSB(bf16, 90 * MiB)
#define B_HG     WSB(bf16, 90 * MiB)
#define B_YP     WSB(bf16, 90 * MiB)
#define B_XT     WSB(bf16, 154 * MiB)
#define B_YB     WSB(bf16, 154 * MiB)
#define B_HID    WSB(bf16, 170 * MiB)
#define B_Q      WSB(bf16, 186 * MiB)
#define B_KF     WSB(bf16, 210 * MiB)
#define B_VT     WSB(bf16, 234 * MiB)
#define B_COS    WSB(float, 250 * MiB)
#define B_SIN    WSB(float, 251 * MiB)
#define B_RTE    WSB(int, 250 * MiB)
#define B_RTS    WSB(int, 250 * MiB + 256 * 1024)
#define B_RTW    WSB(float, 250 * MiB + 512 * 1024)
#define B_TOKROW WSB(int, 250 * MiB + 768 * 1024)
#define B_ROWW   WSB(float, 251 * MiB)
#define B_SSQ    WSB(float, 252 * MiB)
#define B_SSQS   WSB(float, 253 * MiB)
#define B_PREV   OUTB(bf16, 0)
#define B_CQN    OUTB(bf16, 32 * MiB)
#define B_CKVN   OUTB(bf16, 40 * MiB)
#define LDS_TP   ((int*)(lds_raw + 131072 + 1024))

__global__ void __launch_bounds__(NT, 2) mega_fwd(Params P) {
    if (threadIdx.x < 2) ((volatile LAS unsigned*)(lds_raw + WTAB_OFF - 16))[threadIdx.x] = 0u;
    tidx_init();
    float* lds = (float*)lds_raw;
    cg::grid_group grid = cg::this_grid();
    const XcdBarrier bar = xcd_barrier_post((unsigned*)(kargs()->ws + 16384), (volatile LAS unsigned*)(lds_raw + WTAB_OFF - 16));
#define GSYNC() xcd_barrier(bar)
    ph_prep(lds, B_MOD, B_WIN, B_WOUT, B_WUQ, B_WUKV, B_WGU, B_WD, B_WRT, B_CNT);
    grid.sync();
    ph_prenorm_bf16(IN(0), IN(5), B_MOD, 0 * D, 1 * D, B_HB);
    GSYNC();
    { pg8::Gemm g{B_HB, B_WIN, M, NU, D}; pg8::StaticOrder S; S.init(M, NU, gridDim.x, (int)blockIdx.x);
      pg8::EpiBf16<0> E{B_U, NU};
      pg8::gemm_phase<pg8::EpiBf16<0>, pg8::StaticOrder, true, true>((PG8_LAS unsigned char*)lds_raw, g, S, E); }
    GSYNC();
    ph_prep2(B_U, kargs()->pos, IN(10), IN(11), IN(12), B_CQN, B_CKVN, B_KF, B_COS, B_SIN, B_DT, B_XT);
    GSYNC();
    {
      const int G = gridDim.x, bid = blockIdx.x; const bool split = G >= 128;
      if (!split || bid < 64) { for (int it = bid; it < 64; it += (split ? 64 : G)) ssd::state_sweep((SLAS char*)lds_raw, it >> 3, it & 7, B_XT, B_DT, IN(13), B_ACS2, B_PREV); }
      if (!split || bid >= 64) { const int Gg = split ? G - 64 : G, cg_ = split ? bid - 64 : bid;
        { pg8::Gemm g{B_CQN, B_WUQ, M, 768, QR}; pg8::StaticOrder S; S.init(M, 768, Gg, cg_);
          pg8::EpiQ E{B_Q, B_COS, B_SIN};
          pg8::gemm_phase<pg8::EpiQ, pg8::StaticOrder, true, false>((PG8_LAS unsigned char*)lds_raw, g, S, E); }
        { pg8::Gemm g{B_CKVN, B_WUKV, M, 1024, 256}; pg8::StaticOrder S; S.init(M, 1024, Gg, cg_);
          pg8::EpiKV E{B_KF, B_VT};
          pg8::gemm_phase<pg8::EpiKV, pg8::StaticOrder, true, false>((PG8_LAS unsigned char*)lds_raw, g, S, E); } } }
    GSYNC();
    att::attn_phase((ALAS char*)lds_raw, B_Q, B_KF, B_VT, B_YC, B_SSQ);
    { const int G = gridDim.x, bid = blockIdx.x; const int vcu = (G % 8 == 0) ? (bid % 8) * (G / 8) + bid / 8 : bid;
      for (int u = vcu; u < 256; u += G) ssd::chunk_unit((SLAS char*)lds_raw, u >> 5, (u >> 1) & 15, u & 1, B_XT, B_PREV, B_DT, B_ACS2, IN(14), B_U, B_YC, B_SSQS); }
    GSYNC();
    ph_yc_norm(B_YC, B_SSQS, B_SSQ);
    GSYNC();
    { pg8::Gemm g{B_YC, B_WOUT, M, D, D}; pg8::StaticOrder S; S.init(M, D, gridDim.x, (int)blockIdx.x);
      pg8::EpiBf16<0> E{B_YB, D};
      pg8::gemm_phase<pg8::EpiBf16<0>, pg8::StaticOrder, true, true>((PG8_LAS unsigned char*)lds_raw, g, S, E); }
    GSYNC();
    ph_rowrouter((__attribute__((address_space(3))) float*)lds_raw, B_YB, IN(0), IN(6), IN(7), B_MOD, B_WRT, IN(23), IN(25), kargs()->out, B_H2, B_CNT, B_RTE, B_RTS, B_RTW);
    GSYNC();
    moe_table(LDS_TP, B_CNT);
    ph_gather(LDS_TP, B_H2, B_RTE, B_RTS, B_RTW, B_HG, B_ROWW, B_TOKROW);
    GSYNC();
    { pg8::Gemm g{B_HG, B_WGU, 0, 0, D}; pg8::GroupedOrder S{(const PG8_LAS int*)LDS_TP, 2, (int)gridDim.x, (int)blockIdx.x};
      pg8::EpiGU E{B_HID, B_ROWW};
      pg8::gemm_phase<pg8::EpiGU, pg8::GroupedOrder, true, true>((PG8_LAS unsigned char*)lds_raw, g, S, E); }
    GSYNC();
    { pg8::Gemm g{B_HID, B_WD, 0, 0, FF}; pg8::GroupedOrder S{(const PG8_LAS int*)LDS_TP, 4, (int)gridDim.x, (int)blockIdx.x};
      pg8::EpiDown E{B_YP};
      pg8::gemm_phase<pg8::EpiDown, pg8::GroupedOrder, true, true>((PG8_LAS unsigned char*)lds_raw, g, S, E); }
    GSYNC();
    ph_moe_final(B_YP, B_TOKROW, IN(8), B_MOD, kargs()->out);
}

extern "C" void kernel_launch(void* const* d_in, const int* in_sizes, int n_in, void* d_out, int out_size, void* d_ws, size_t ws_size,
                              hipStream_t stream) {
    static int grid_blocks = 0;
    if (!grid_blocks) {
        int dev = 0, cus = 0, per_cu = 0;
        (void)hipGetDevice(&dev);
        (void)hipDeviceGetAttribute(&cus, hipDeviceAttributeMultiprocessorCount, dev);
        (void)hipFuncSetAttribute((const void*)mega_fwd, hipFuncAttributeMaxDynamicSharedMemorySize, LDS_BYTES);
        (void)hipOccupancyMaxActiveBlocksPerMultiprocessor(&per_cu, (const void*)mega_fwd, NT, LDS_BYTES);
        if (per_cu < 1) { fprintf(stderr, "occupancy query returned %d\n", per_cu); per_cu = 1; }
        grid_blocks = cus * per_cu;
    }
    (void)hipMemsetAsync(d_ws, 0, 65536, stream);
    Params p{};
    for (int i = 0; i < 29; ++i) p.in[i] = (const float*)d_in[i];
    p.pos = (const int*)d_in[2];
    p.out = (float*)d_out;
    p.ws = (char*)d_ws;
    void* args[] = {&p};
    hipError_t e = hipLaunchCooperativeKernel((void*)mega_fwd, dim3(grid_blocks), dim3(NT), args, LDS_BYTES, stream);
    if (e != hipSuccess) fprintf(stderr, "cooperative launch failed: %s (grid %d)\n", hipGetErrorString(e), grid_blocks);
}
```

```cpp
#include <hip/hip_runtime.h>
#include <hip/hip_cooperative_groups.h>
#include <stdint.h>
#include <math.h>
#include <cstdio>
namespace cg = cooperative_groups;

constexpr int D = 1024, NB = 8, SEQ = 2048, M = NB * SEQ;
constexpr int SSD_H = 8, SSD_P = 64, SSD_INNER = 512, SSD_G = 2, SSD_N = 128, SSD_XBC = 1024;
constexpr int MLA_H = 8, NOPE = 64, ROPE = 32, QK = 96, VD = 64, QR = 256, KVR = 128;
constexpr int NIN = 1960;
constexpr int NU = 2048;
constexpr int OFF_Z = 0, OFF_XBC = 512, OFF_CQ = 1536, OFF_CKV = 1792, OFF_KR = 1920, OFF_DT = 1952;
constexpr int NEXP = 32, FF = 256;
constexpr float EPS = 1e-6f;
constexpr int NT = 512;
constexpr int LDS_BYTES = 160 * 1024;

typedef unsigned short bf16;
__device__ __forceinline__ float bf2f(bf16 v) { return __uint_as_float((unsigned)v << 16); }
__device__ __forceinline__ unsigned f2bf(float f) { unsigned u = __float_as_uint(f); return (u + 0x7fffu + ((u >> 16) & 1u)) >> 16; }
__device__ __forceinline__ unsigned pk2(float lo, float hi) { return f2bf(lo) | (f2bf(hi) << 16); }
typedef unsigned v4u __attribute__((ext_vector_type(4)));
typedef float f32x4v __attribute__((ext_vector_type(4)));

struct Params {
    const float* in[29];
    const int* pos;
    float* out;
    char* ws;
};

__device__ __forceinline__ float ldf(const float* p) { return *p; }
__device__ __forceinline__ float ldf(const bf16* p) { return bf2f(*p); }
extern __shared__ __attribute__((aligned(16))) unsigned char lds_raw[];
constexpr int WTAB_OFF = 160 * 1024 - 256;
__device__ __forceinline__ int hw_wave_key() { int k; asm volatile("s_getreg_b32 %0, hwreg(HW_REG_HW_ID, 0, 6)" : "=s"(k)); return k; }
__device__ __forceinline__ void tidx_init() { const int key = hw_wave_key(); ((volatile __attribute__((address_space(3))) int*)(lds_raw + WTAB_OFF))[key] = (int)(threadIdx.x >> 6); __syncthreads(); }
__device__ __forceinline__ int tidx() {
    const int key = hw_wave_key();
    int w = ((volatile __attribute__((address_space(3))) int*)(lds_raw + WTAB_OFF))[key];
    w = __builtin_amdgcn_readfirstlane(w);
    unsigned ones = ~0u; asm volatile("" : "+s"(ones));
    int t = w * 64 + (int)__builtin_amdgcn_mbcnt_hi(ones, __builtin_amdgcn_mbcnt_lo(ones, 0u));
    asm volatile("" : "+v"(t)); return t; }
typedef const __attribute__((address_space(4))) Params* KArgs;
__device__ __forceinline__ KArgs kargs() { KArgs p = (KArgs)__builtin_amdgcn_kernarg_segment_ptr(); asm volatile("" : "+s"(p)); return p; }
#define IN(i) (kargs()->in[i])
__device__ __forceinline__ float silu_f(float v) { return v / (1.f + expf(-v)); }
__device__ __forceinline__ float wave_sum(float v) {
#pragma unroll
    for (int o = 32; o > 0; o >>= 1) v += __shfl_xor(v, o);
    return v;
}

namespace pg8 {
#define PG8_LAS __attribute__((address_space(3)))
typedef unsigned short bf16_t;
typedef short bf16x8 __attribute__((ext_vector_type(8)));
typedef float f32x4 __attribute__((ext_vector_type(4)));
typedef unsigned u32x4 __attribute__((ext_vector_type(4)));
constexpr int BM = 256, BK = 64, HALF = 128, HTB = HALF * BK * 2  , STAGE_BYTES = 8 * HTB, NXCD = 8, WGM = 8;

__host__ __device__ __forceinline__ int lds_byte(int r, int c) { const int st = (r >> 4) * 2 + (c >> 5), rr = r & 15, cc = c & 31, ob = rr * 64 + cc * 2; return st * 1024 + (ob ^ (((ob >> 9) & 1) << 5)); }
__host__ __device__ __forceinline__ void stage_rc(int b, int& R, int& C) { const int st = b / 1024, sb = b % 1024, swz = sb ^ (((sb >> 9) & 1) << 5); R = (st >> 1) * 16 + swz / 64; C = (st & 1) * 32 + (swz % 64) / 2; }
__host__ __device__ __forceinline__ int perm32(int rho) { const int n = rho >> 4, i = rho & 15; return 8 * (i >> 2) + 4 * n + (i & 3); }

struct Unit { int pm, pn; };
struct Gemm { const bf16_t* A; const bf16_t* Bt; int M, N, K; };

struct StaticOrder {
    int nM, nN, nwg, G, c;
    __host__ __device__ void init(int M, int N, int G_, int c_) { nM = M / BM; nN = N / BM; nwg = nM * nN; G = G_; c = c_; }
    __host__ __device__ bool next(int i, Unit& u) const {
        const long L = (long)i * G + c; if (L >= nwg) return false;
        int wgid = (int)L; { const int q = nwg / NXCD, r = nwg % NXCD, xcd = wgid % NXCD, off = wgid / NXCD; wgid = (xcd < r ? xcd * (q + 1) : r * (q + 1) + (xcd - r) * q) + off; }
        const int nig = WGM * nN, gid = wgid / nig, fm = gid * WGM, gsz = (nM - fm) < WGM ? (nM - fm) : WGM;
        u.pm = fm + ((wgid % nig) % gsz); u.pn = (wgid % nig) / gsz; return true;
    }
    __device__ __forceinline__ void a_ready(const Unit&) const {}
    __device__ __forceinline__ void done(const Unit&) const {}
};


template <int ACT> struct EpiBf16 {
    static constexpr bool PERM = true, AFTER_DRAIN = false;
    bf16_t* O; int ldc;
    __device__ __forceinline__ void operator()(const f32x4 (&acc)[2][2][4][2], const Unit& u, int wr, int wc, int fr, int fq) const {
        { const int l_ = tidx() & 63; fr = l_ & 15; fq = l_ >> 4; }
        const int row0 = u.pm * BM + wr * 64 + fr; const int col0 = u.pn * BM + wc * 32 + 8 * fq;
#pragma unroll
        for (int ai = 0; ai < 2; ++ai)
#pragma unroll
            for (int m = 0; m < 4; ++m) { bf16_t* rowp = O + (size_t)(row0 + ai * HALF + m * 16) * ldc + col0;
#pragma unroll
                for (int bj = 0; bj < 2; ++bj) { const f32x4 v0 = acc[ai][bj][m][0], v1 = acc[ai][bj][m][1];
                    u32x4 w; w.x = pk2(v0[0], v0[1]); w.y = pk2(v0[2], v0[3]); w.z = pk2(v1[0], v1[1]); w.w = pk2(v1[2], v1[3]);
                    *(u32x4*)(rowp + bj * HALF) = w; } }
    }
};

struct EpiQ {
    static constexpr bool PERM = true, AFTER_DRAIN = false;
    bf16_t* Q; const float* COS; const float* SIN;
    __device__ __forceinline__ void operator()(const f32x4 (&acc)[2][2][4][2], const Unit& u, int wr, int wc, int fr, int fq) const {
        { const int l_ = tidx() & 63; fr = l_ & 15; fq = l_ >> 4; }
        const int row0 = u.pm * BM + wr * 64 + fr;
#pragma unroll
        for (int bj = 0; bj < 2; ++bj) {
            const int colg = u.pn * BM + bj * HALF + wc * 32;
            const bool pe = ((colg >> 5) % 3) == 2;
#pragma unroll
            for (int ai = 0; ai < 2; ++ai)
#pragma unroll
                for (int m = 0; m < 4; ++m) {
                    const int row = row0 + ai * HALF + m * 16;
                    f32x4 v0 = acc[ai][bj][m][0], v1 = acc[ai][bj][m][1];
                    if (pe) {
                        f32x4 w0, w1;
#pragma unroll
                        for (int e = 0; e < 4; ++e) { w0[e] = __shfl_xor(v0[e], 32); w1[e] = __shfl_xor(v1[e], 32); }
                        const f32x4* cp = (const f32x4*)(COS + (size_t)row * 16 + (fq & 1) * 8); const f32x4* sp = (const f32x4*)(SIN + (size_t)row * 16 + (fq & 1) * 8);
                        const f32x4 c0 = cp[0], c1 = cp[1], s0 = sp[0], s1 = sp[1];
                        const float sg = (fq < 2) ? -1.f : 1.f;
                        v0 = v0 * c0 + w0 * s0 * sg; v1 = v1 * c1 + w1 * s1 * sg;
                    }
                    u32x4 w; w.x = pk2(v0[0], v0[1]); w.y = pk2(v0[2], v0[3]); w.z = pk2(v1[0], v1[1]); w.w = pk2(v1[2], v1[3]);
                    *(u32x4*)(Q + (size_t)row * 768 + colg + 8 * fq) = w;
                    if (pe) asm volatile("" ::: "memory");
                }
        }
    }
};
struct EpiKV {
    static constexpr bool PERM = true, AFTER_DRAIN = false;
    bf16_t* KF; bf16_t* VT;
    __device__ __forceinline__ void operator()(const f32x4 (&acc)[2][2][4][2], const Unit& u, int wr, int wc, int fr, int fq) const {
        { const int l_ = tidx() & 63; fr = l_ & 15; fq = l_ >> 4; }
        const int row0 = u.pm * BM + wr * 64 + fr;
#pragma unroll
        for (int bj = 0; bj < 2; ++bj) {
            const int colg = u.pn * BM + bj * HALF + wc * 32; const int h = colg >> 7, j0 = (colg & 127) + 8 * fq;
#pragma unroll
            for (int ai = 0; ai < 2; ++ai)
#pragma unroll
                for (int m = 0; m < 4; ++m) {
                    const int t = row0 + ai * HALF + m * 16; const int b = t >> 11, sq = t & 2047, tile = sq >> 6, key = sq & 63;
                    const size_t base = (size_t)((b * 8 + h) * 32 + tile);
                    bf16_t* dst = (j0 < 64) ? KF + base * 6144 + (j0 >> 3) * 512 + key * 8 : VT + base * 4096 + ((j0 - 64) >> 5) * 2048 + key * 32 + ((j0 - 64) & 31);
                    const f32x4 v0 = acc[ai][bj][m][0], v1 = acc[ai][bj][m][1];
                    u32x4 w; w.x = pk2(v0[0], v0[1]); w.y = pk2(v0[2], v0[3]); w.z = pk2(v1[0], v1[1]); w.w = pk2(v1[2], v1[3]);
                    *(u32x4*)dst = w;
                }
        }
    }
};

struct GroupedOrder {
    const PG8_LAS int* tp; int NCT, G, c;
    __device__ __forceinline__ bool next(int i, Unit& u) const {
        const int L = i * G + c, total = tp[32] * NCT; if (L >= total) return false;
        const int rtg = L / NCT, ct = L - rtg * NCT; int e = 0;
        for (int j = 1; j < 32; ++j) e += (tp[j] <= rtg) ? 1 : 0;
        u.pm = rtg; u.pn = e * NCT + ct; return true;
    }
    __device__ __forceinline__ void a_ready(const Unit&) const {}
    __device__ __forceinline__ void done(const Unit&) const {}
};
struct EpiGU {
    static constexpr bool PERM = true, AFTER_DRAIN = false;
    bf16_t* HID; const float* ROWW;
    __device__ __forceinline__ void operator()(const f32x4 (&acc)[2][2][4][2], const Unit& u, int wr, int wc, int fr, int fq) const {
        { const int l_ = tidx() & 63; fr = l_ & 15; fq = l_ >> 4; }
        const int row0 = u.pm * BM + wr * 64 + fr; const int col0 = (u.pn & 1) * 128 + wc * 32 + 8 * fq;
#pragma unroll
        for (int ai = 0; ai < 2; ++ai)
#pragma unroll
            for (int m = 0; m < 4; ++m) { const int row = row0 + ai * HALF + m * 16; const float w = ROWW[row];
                float hv[8];
#pragma unroll
                for (int n = 0; n < 2; ++n)
#pragma unroll
                    for (int e = 0; e < 4; ++e) { const float g = acc[ai][0][m][n][e], up = acc[ai][1][m][n][e]; hv[4 * n + e] = g * __builtin_amdgcn_rcpf(1.f + __expf(-g)) * up * w; }
                u32x4 o; o.x = pk2(hv[0], hv[1]); o.y = pk2(hv[2], hv[3]); o.z = pk2(hv[4], hv[5]); o.w = pk2(hv[6], hv[7]);
                *(u32x4*)(HID + (size_t)row * 256 + col0) = o; }
    }
};
struct EpiDown {
    static constexpr bool PERM = true, AFTER_DRAIN = false;
    bf16_t* YP;
    __device__ __forceinline__ void operator()(const f32x4 (&acc)[2][2][4][2], const Unit& u, int wr, int wc, int fr, int fq) const {
        { const int l_ = tidx() & 63; fr = l_ & 15; fq = l_ >> 4; }
        const int row0 = u.pm * BM + wr * 64 + fr; const int col0 = (u.pn & 3) * BM + wc * 32 + 8 * fq;
#pragma unroll
        for (int ai = 0; ai < 2; ++ai)
#pragma unroll
            for (int m = 0; m < 4; ++m) { bf16_t* rowp = YP + (size_t)(row0 + ai * HALF + m * 16) * 1024 + col0;
#pragma unroll
                for (int bj = 0; bj < 2; ++bj) { const f32x4 v0 = acc[ai][bj][m][0], v1 = acc[ai][bj][m][1];
                    u32x4 w; w.x = pk2(v0[0], v0[1]); w.y = pk2(v0[2], v0[3]); w.z = pk2(v1[0], v1[1]); w.w = pk2(v1[2], v1[3]);
                    *(u32x4*)(rowp + bj * HALF) = w; } }
    }
};
template <class Epi, class Sched, bool ALIGN_EPI = false, bool SP2 = false>
__device__ __forceinline__ void gemm_phase(PG8_LAS unsigned char* lds, const Gemm g, const Sched& S, const Epi& E) {
    const int tid = tidx(), wid = __builtin_amdgcn_readfirstlane(tid >> 6), lane = tid & 63, wr = wid >> 2, wc = wid & 3, fr = lane & 15, fq = lane >> 4;
    const int K = g.K, nt = K / BK;
    unsigned voffA[2], voffB[2];
#pragma unroll
    for (int i = 0; i < 2; ++i) { int R, C; stage_rc(tid * 16 + i * 8192, R, C); const int Rb = Epi::PERM ? ((R & ~31) + perm32(R & 31)) : R;
        voffA[i] = (unsigned)(R * K + C) * 2u; voffB[i] = (unsigned)(Rb * K + C) * 2u; }
    const size_t kstep = (size_t)(BK * 2);
    const size_t hstep = (size_t)HALF * K * 2;
    const size_t tstep = 2 * hstep;
    const unsigned ldsw = (unsigned)wid * 1024u;
    const int aoff = lds_byte(wr * 64 + fr, fq * 8), boff = lds_byte(wc * 32 + fr, fq * 8);
#define PG8_SA(b, h) (((b) * 2 + (h)) * HTB)
#define PG8_SB(b, h) ((4 + (b) * 2 + (h)) * HTB)
#define PG8_STAGE(bufoff, gbase, voff) do { _Pragma("unroll") for (int _i = 0; _i < 2; ++_i) \
        __builtin_amdgcn_global_load_lds((const unsigned*)((const char*)(gbase) + (voff)[_i]), (PG8_LAS unsigned*)(lds + (bufoff) + ldsw + _i * 8192), 16, 0, 0); } while (0)
#define PG8_LDA(dst, b, h) do { _Pragma("unroll") for (int m = 0; m < 4; ++m) _Pragma("unroll") for (int k = 0; k < 2; ++k) dst[m][k] = *(const PG8_LAS bf16x8*)(lds + PG8_SA(b, h) + aoff + m * 2048 + k * 1024); } while (0)
#define PG8_LDB(dst, b, h) do { _Pragma("unroll") for (int n = 0; n < 2; ++n) _Pragma("unroll") for (int k = 0; k < 2; ++k) dst[n][k] = *(const PG8_LAS bf16x8*)(lds + PG8_SB(b, h) + boff + n * 2048 + k * 1024); } while (0)
#define PG8_MMA(ai, bj, At, Bt) do { __builtin_amdgcn_s_setprio(1); _Pragma("unroll") for (int m = 0; m < 4; ++m) _Pragma("unroll") for (int n = 0; n < 2; ++n) _Pragma("unroll") for (int k = 0; k < 2; ++k) \
        acc[ai][bj][m][n] = __builtin_amdgcn_mfma_f32_16x16x32_bf16(Bt[n][k], At[m][k], acc[ai][bj][m][n], 0, 0, 0); __builtin_amdgcn_s_setprio(0); } while (0)
#define PG8_WAIT_V(n) asm volatile("s_waitcnt vmcnt(" #n ")" ::: "memory")
#define PG8_WAIT_L(n) asm volatile("s_waitcnt lgkmcnt(" #n ")" ::: "memory")
#define PG8_BAR __builtin_amdgcn_s_barrier()
#define PG8_SCHED __builtin_amdgcn_sched_barrier(0)
    Unit cur, nxt; int ui = 0;
    if (!S.next(0, cur)) return;
    f32x4 acc[2][2][4][2];
#pragma unroll
    for (int a = 0; a < 2; ++a)
#pragma unroll
        for (int b = 0; b < 2; ++b)
#pragma unroll
            for (int m = 0; m < 4; ++m)
#pragma unroll
                for (int n = 0; n < 2; ++n) acc[a][b][m][n] = (f32x4){0.f, 0.f, 0.f, 0.f};
    bf16x8 At[4][2], B0[2][2], B1[2][2];
    const char* cA = (const char*)g.A + (size_t)cur.pm * tstep; const char* cB = (const char*)g.Bt + (size_t)cur.pn * tstep;
    S.a_ready(cur);
    if constexpr (SP2) {
        PG8_STAGE(PG8_SB(0, 0), cB, voffB); PG8_STAGE(PG8_SB(0, 1), cB + hstep, voffB); PG8_STAGE(PG8_SA(0, 0), cA, voffA); PG8_STAGE(PG8_SA(0, 1), cA + hstep, voffA);
        if (wr == 1) PG8_BAR;
        PG8_WAIT_V(2); PG8_BAR;
        PG8_STAGE(PG8_SB(1, 0), cB + kstep, voffB); PG8_STAGE(PG8_SA(1, 0), cA + kstep, voffA); PG8_STAGE(PG8_SB(1, 1), cB + hstep + kstep, voffB);
        PG8_WAIT_V(6); PG8_BAR;
    } else {
        PG8_STAGE(PG8_SB(0, 0), cB, voffB); PG8_STAGE(PG8_SA(0, 0), cA, voffA); PG8_STAGE(PG8_SB(0, 1), cB + hstep, voffB); PG8_STAGE(PG8_SA(0, 1), cA + hstep, voffA);
        if (wr == 1) PG8_BAR;
        PG8_WAIT_V(4); PG8_BAR;
        PG8_STAGE(PG8_SB(1, 0), cB + kstep, voffB); PG8_STAGE(PG8_SA(1, 0), cA + kstep, voffA); PG8_STAGE(PG8_SB(1, 1), cB + hstep + kstep, voffB);
        PG8_WAIT_V(6); PG8_BAR;
    }
    for (;;) {
        const bool has_next = S.next(ui + 1, nxt);
        const char* nA = has_next ? (const char*)g.A + (size_t)nxt.pm * tstep : cA; const char* nB = has_next ? (const char*)g.Bt + (size_t)nxt.pn * tstep : cB;
        for (int t = 0; t < nt; t += 2) {
            const bool last = (t == nt - 2);
            const char* a1 = cA + (size_t)(t + 1) * kstep;
            const char* a2 = last ? nA : cA + (size_t)(t + 2) * kstep; const char* b2 = last ? nB : cB + (size_t)(t + 2) * kstep;
            const char* a3 = a2 + kstep; const char* b3 = b2 + kstep;
            if (last && has_next) S.a_ready(nxt);
            if constexpr (SP2) {
            PG8_LDB(B0, 0, 0); PG8_LDB(B1, 0, 1); PG8_SCHED; PG8_LDA(At, 0, 0); PG8_STAGE(PG8_SA(1, 1), a1 + hstep, voffA);
            PG8_WAIT_V(8); PG8_WAIT_L(0); PG8_BAR; PG8_MMA(0, 0, At, B0); PG8_MMA(0, 1, At, B1); PG8_BAR; PG8_SCHED;
            PG8_LDA(At, 0, 1); PG8_STAGE(PG8_SB(0, 0), b2, voffB); PG8_STAGE(PG8_SB(0, 1), b2 + hstep, voffB); PG8_STAGE(PG8_SA(0, 0), a2, voffA);
            PG8_WAIT_V(8); PG8_WAIT_L(0); PG8_BAR; PG8_MMA(1, 0, At, B0); PG8_MMA(1, 1, At, B1); PG8_BAR; PG8_SCHED;
            PG8_LDB(B0, 1, 0); PG8_LDB(B1, 1, 1); PG8_SCHED; PG8_LDA(At, 1, 0); PG8_STAGE(PG8_SA(0, 1), a2 + hstep, voffA);
            PG8_WAIT_V(8); PG8_WAIT_L(0); PG8_BAR; PG8_MMA(0, 0, At, B0); PG8_MMA(0, 1, At, B1); PG8_BAR; PG8_SCHED;
            PG8_LDA(At, 1, 1); PG8_STAGE(PG8_SB(1, 0), b3, voffB); PG8_STAGE(PG8_SB(1, 1), b3 + hstep, voffB); PG8_STAGE(PG8_SA(1, 0), a3, voffA);
            PG8_WAIT_V(8); PG8_WAIT_L(0); PG8_BAR; PG8_MMA(1, 0, At, B0); PG8_MMA(1, 1, At, B1); PG8_BAR; PG8_SCHED;
            } else {
            PG8_LDB(B0, 0, 0); PG8_SCHED; PG8_LDA(At, 0, 0); PG8_STAGE(PG8_SA(1, 1), a1 + hstep, voffA);
            PG8_WAIT_L(8); PG8_BAR; PG8_WAIT_L(0); PG8_MMA(0, 0, At, B0); PG8_BAR; PG8_SCHED;
            PG8_LDB(B1, 0, 1); PG8_STAGE(PG8_SB(0, 0), b2, voffB);
            PG8_BAR; PG8_WAIT_L(0); PG8_MMA(0, 1, At, B1); PG8_BAR;
            PG8_LDA(At, 0, 1); PG8_STAGE(PG8_SA(0, 0), a2, voffA);
            PG8_BAR; PG8_WAIT_L(0); PG8_MMA(1, 0, At, B0); PG8_BAR; PG8_SCHED;
            PG8_STAGE(PG8_SB(0, 1), b2 + hstep, voffB);
            PG8_WAIT_V(6); PG8_BAR; PG8_MMA(1, 1, At, B1); PG8_BAR;
            PG8_LDB(B0, 1, 0); PG8_SCHED; PG8_LDA(At, 1, 0); PG8_STAGE(PG8_SA(0, 1), a2 + hstep, voffA);
            PG8_WAIT_L(8); PG8_BAR; PG8_WAIT_L(0); PG8_MMA(0, 0, At, B0); PG8_BAR; PG8_SCHED;
            PG8_LDB(B1, 1, 1); PG8_STAGE(PG8_SB(1, 0), b3, voffB);
            PG8_BAR; PG8_WAIT_L(0); PG8_MMA(0, 1, At, B1); PG8_BAR;
            PG8_LDA(At, 1, 1); PG8_STAGE(PG8_SA(1, 0), a3, voffA);
            PG8_BAR; PG8_WAIT_L(0); PG8_MMA(1, 0, At, B0); PG8_BAR; PG8_SCHED;
            PG8_STAGE(PG8_SB(1, 1), b3 + hstep, voffB);
            PG8_WAIT_V(6); PG8_BAR; PG8_MMA(1, 1, At, B1); PG8_BAR;
            }
        }
        if constexpr (ALIGN_EPI) { if (wr == 0) PG8_BAR; }
        if constexpr (!Epi::AFTER_DRAIN) { E(acc, cur, wr, wc, fr, fq); S.done(cur); }
        if (!has_next) break;
#pragma unroll
        for (int a = 0; a < 2; ++a)
#pragma unroll
            for (int b = 0; b < 2; ++b)
#pragma unroll
                for (int m = 0; m < 4; ++m)
#pragma unroll
                    for (int n = 0; n < 2; ++n) acc[a][b][m][n] = (f32x4){0.f, 0.f, 0.f, 0.f};
        cur = nxt; cA = nA; cB = nB; ++ui;
        if constexpr (ALIGN_EPI) { if (wr == 1) PG8_BAR; }
    }
    PG8_WAIT_V(0);
    if constexpr (!ALIGN_EPI) { if (wr == 0) PG8_BAR; }
    PG8_BAR;
    if constexpr (Epi::AFTER_DRAIN) { E.fused(acc, cur, wr, wc, fr, fq, lds, wid, lane); S.done(cur); }
#undef PG8_SA
#undef PG8_SB
#undef PG8_STAGE
#undef PG8_LDA
#undef PG8_LDB
#undef PG8_MMA
#undef PG8_WAIT_V
#undef PG8_WAIT_L
#undef PG8_BAR
#undef PG8_SCHED
}
}


template <class GainFn>
__device__ __forceinline__ void transpose_tile(const float* src, int ldsrc, int srccol0  , GainFn gain, bf16* dst, int K, int k0, int n0, int lane) {
    const int r = lane >> 4, c = lane & 15;
    f32x4v v[16];
    if (srccol0 >= 0) {
#pragma unroll
        for (int i = 0; i < 16; ++i) v[i] = *(const f32x4v*)(src + (size_t)(k0 + 4 * i + r) * ldsrc + srccol0 + 4 * c);
    } else {
#pragma unroll
        for (int i = 0; i < 16; ++i) v[i] = (f32x4v){0.f, 0.f, 0.f, 0.f};
    }
    unsigned pk[16][2];
#pragma unroll
    for (int i = 0; i < 16; ++i) {
        unsigned a0 = __float_as_uint(v[i].x), a1 = __float_as_uint(v[i].y), a2 = __float_as_uint(v[i].z), a3 = __float_as_uint(v[i].w);
        { auto t = __builtin_amdgcn_permlane32_swap(a0, a2, false, false); a0 = t[0]; a2 = t[1]; }
        { auto t = __builtin_amdgcn_permlane32_swap(a1, a3, false, false); a1 = t[0]; a3 = t[1]; }
        { auto t = __builtin_amdgcn_permlane16_swap(a0, a1, false, false); a0 = t[0]; a1 = t[1]; }
        { auto t = __builtin_amdgcn_permlane16_swap(a2, a3, false, false); a2 = t[0]; a3 = t[1]; }
        const f32x4v g = gain(k0 + 4 * i);
        pk[i][0] = pk2(__uint_as_float(a0) * g.x, __uint_as_float(a1) * g.y); pk[i][1] = pk2(__uint_as_float(a2) * g.z, __uint_as_float(a3) * g.w);
    }
    bf16* drow = dst + (size_t)(n0 + 4 * c + r) * K + k0;
#pragma unroll
    for (int i = 0; i < 8; ++i) *(v4u*)(drow + 8 * i) = (v4u){pk[2 * i][0], pk[2 * i][1], pk[2 * i + 1][0], pk[2 * i + 1][1]};
}
__device__ __forceinline__ int win_col(int n) {
    if (n < 1536) return n;
    if (n < 1792) return n - 1536 + 1544;
    if (n < 1920) return n - 1792 + 1800;
    if (n < 1952) return n - 1920 + 1928;
    if (n < 1960) return n - 1952 + 1536;
    return -1;
}
template <class GainFn>
__device__ __forceinline__ void transpose_tile_win(const float* src, GainFn gain, bf16* dst, int k0, int n0, int lane) {
    const int r = lane >> 4, c = lane & 15; const int sc = win_col(n0 + 4 * c);
    f32x4v v[16];
#pragma unroll
    for (int i = 0; i < 16; ++i) v[i] = (sc >= 0) ? *(const f32x4v*)(src + (size_t)(k0 + 4 * i + r) * NIN + sc) : (f32x4v){0.f, 0.f, 0.f, 0.f};
    unsigned pk[16][2];
#pragma unroll
    for (int i = 0; i < 16; ++i) {
        unsigned a0 = __float_as_uint(v[i].x), a1 = __float_as_uint(v[i].y), a2 = __float_as_uint(v[i].z), a3 = __float_as_uint(v[i].w);
        { auto t = __builtin_amdgcn_permlane32_swap(a0, a2, false, false); a0 = t[0]; a2 = t[1]; }
        { auto t = __builtin_amdgcn_permlane32_swap(a1, a3, false, false); a1 = t[0]; a3 = t[1]; }
        { auto t = __builtin_amdgcn_permlane16_swap(a0, a1, false, false); a0 = t[0]; a1 = t[1]; }
        { auto t = __builtin_amdgcn_permlane16_swap(a2, a3, false, false); a2 = t[0]; a3 = t[1]; }
        pk[i][0] = pk2(__uint_as_float(a0), __uint_as_float(a1)); pk[i][1] = pk2(__uint_as_float(a2), __uint_as_float(a3));
    }
    bf16* drow = dst + (size_t)(n0 + 4 * c + r) * D + k0;
#pragma unroll
    for (int i = 0; i < 8; ++i) *(v4u*)(drow + 8 * i) = (v4u){pk[2 * i][0], pk[2 * i][1], pk[2 * i + 1][0], pk[2 * i + 1][1]};
}
__device__ void ph_prep(float* lds, float* mod, bf16* WIN_T, bf16* WOUT_T, bf16* WUQ_T, bf16* WUKV_T, bf16* WGU_T, bf16* WD_T, float* WRT, int* CNT) {
    const int tid = tidx(), lane = tid & 63, wave = tid >> 6;
    for (int item = blockIdx.x; item < 6 * D / 32; item += gridDim.x) {
        float* sc = lds;
        float* part = lds + 8 * D;
        const float* c = IN(1); const float* ada_w = IN(3); const float* ada_b = IN(4);
        __syncthreads();
        for (int i = tid; i < NB * D; i += NT) sc[i] = silu_f(c[i]);
        __syncthreads();
        const int kr = lane >> 3, cq = lane & 7; const int j0 = item * 32 + 4 * cq;
        f32x4v acc[NB];
#pragma unroll
        for (int b = 0; b < NB; ++b) acc[b] = (f32x4v){0.f, 0.f, 0.f, 0.f};
#pragma unroll 4
        for (int i = 0; i < 16; ++i) { const int k = wave * 128 + 8 * i + kr;
            const f32x4v w = *(const f32x4v*)(ada_w + (size_t)k * 6 * D + j0);
#pragma unroll
            for (int b = 0; b < NB; ++b) acc[b] += w * sc[b * D + k]; }
#pragma unroll
        for (int b = 0; b < NB; ++b) {
#pragma unroll
            for (int e = 0; e < 4; ++e) { float v = acc[b][e]; v += __shfl_xor(v, 8); v += __shfl_xor(v, 16); v += __shfl_xor(v, 32); acc[b][e] = v; } }
        if (lane < 8) {
#pragma unroll
            for (int b = 0; b < NB; ++b) *(f32x4v*)(part + (wave * NB + b) * 32 + 4 * lane) = acc[b]; }
        __syncthreads();
        if (tid < NB * 32) { const int b = tid >> 5, jj = tid & 31;
            float sm = ada_b[item * 32 + jj];
#pragma unroll
            for (int w = 0; w < 8; ++w) sm += part[(w * NB + b) * 32 + jj];
            mod[b * 6 * D + item * 32 + jj] = sm; }
    }
    __syncthreads();
    for (int i = blockIdx.x * NT + tid; i < 36 * D; i += gridDim.x * NT) { const int c = i >> 10, k = i & 1023;
        WRT[i] = (c < 4) ? IN(22)[k * 4 + c] : IN(24)[k * 32 + c - 4]; }
    const int gw = (gridDim.x - 1 - blockIdx.x) * (NT / 64) + wave, ngw = gridDim.x * (NT / 64);
    constexpr int I_IN = (D / 64) * (NU / 64), I_OUT = (D / 64) * (D / 64), I_UQ = (QR / 64) * (768 / 64), I_UKV = (256 / 64) * (1024 / 64);
    constexpr int I_GU = NEXP * (D / 64) * (512 / 64), I_DN = NEXP * (FF / 64) * (D / 64);
    const float* ssd_norm = IN(15); const float* q_norm = IN(16); const float* kv_norm = IN(18); const float* mla_norm = IN(20);
    const auto one4 = [](int) { return (f32x4v){1.f, 1.f, 1.f, 1.f}; };
    for (int it = gw; it < I_GU + I_DN + I_IN + I_OUT + I_UQ + I_UKV; it += ngw) {
        int r = it;
        if (r < I_GU) { const int e = r >> 7, q = r & 127, kb = q >> 3, nb = q & 7;
            const int ct = nb >> 2, rr = (nb & 3) * 64; const float* src = (rr < 128 ? IN(26) : IN(27)) + (size_t)e * D * FF;
            transpose_tile(src, FF, 128 * ct + (rr & 127), one4, WGU_T + (size_t)e * 512 * D, D, kb * 64, nb * 64, lane); continue; }
        r -= I_GU;
        if (r < I_DN) { const int e = r >> 6, q = r & 63, kb = q >> 4, nb = q & 15;
            transpose_tile(IN(28) + (size_t)e * FF * D, D, nb * 64, one4, WD_T + (size_t)e * D * FF, FF, kb * 64, nb * 64, lane); continue; }
        r -= I_DN;
        if (r < I_IN) { const int nb = NU / 64; transpose_tile_win(IN(9), one4, WIN_T, (r / nb) * 64, (r % nb) * 64, lane); continue; }
        r -= I_IN;
        if (r < I_OUT) { const int nb = D / 64; transpose_tile(IN(21), D, (r % nb) * 64, [=](int k) { return k < 512 ? *(const f32x4v*)(ssd_norm + k) : *(const f32x4v*)(mla_norm + k - 512); }, WOUT_T, D, (r / nb) * 64, (r % nb) * 64, lane); continue; }
        r -= I_OUT;
        if (r < I_UQ) { const int nb = 768 / 64; transpose_tile(IN(17), 768, (r % nb) * 64, [=](int k) { return *(const f32x4v*)(q_norm + k) * 0.14724444f; }, WUQ_T, QR, (r / nb) * 64, (r % nb) * 64, lane); continue; }
        r -= I_UQ;
        { const int nb = 1024 / 64, kb = r / nb; transpose_tile(IN(19), 1024, kb < 2 ? (r % nb) * 64 : -1, [=](int k) { return k < KVR ? *(const f32x4v*)(kv_norm + k) : (f32x4v){0.f, 0.f, 0.f, 0.f}; }, WUKV_T, 256, kb * 64, (r % nb) * 64, lane); }
    }
}

__device__ void ph_prenorm_bf16(const float* in, const float* g, const float* mod, int sh_off, int sc_off, bf16* out) {
    const int lane = tidx() & 63, gw = blockIdx.x * (NT / 64) + (tidx() >> 6), ngw = gridDim.x * (NT / 64);
    for (int t = gw; t < M; t += ngw) {
        const int b = t / SEQ; const f32x4v* r = (const f32x4v*)(in + (size_t)t * D) + lane;
        f32x4v v[4]; float s = 0.f;
#pragma unroll
        for (int j = 0; j < 4; ++j) { v[j] = r[64 * j]; s += (v[j].x * v[j].x + v[j].y * v[j].y) + (v[j].z * v[j].z + v[j].w * v[j].w); }
        const float inv = rsqrtf(wave_sum(s) / D + EPS);
        const f32x4v* gp = (const f32x4v*)g + lane; const f32x4v* scp = (const f32x4v*)(mod + b * 6 * D + sc_off) + lane; const f32x4v* shp = (const f32x4v*)(mod + b * 6 * D + sh_off) + lane;
        unsigned long long* o8 = (unsigned long long*)(out + (size_t)t * D) + lane;
#pragma unroll
        for (int j = 0; j < 4; ++j) { const f32x4v gg = gp[64 * j], sc = scp[64 * j], sh = shp[64 * j];
            const f32x4v h = v[j] * inv * gg * (sc + 1.f) + sh;
            o8[64 * j] = (unsigned long long)pk2(h.x, h.y) | ((unsigned long long)pk2(h.z, h.w) << 32); }
    }
}


__device__ void ph_prep2(const bf16* U, const int* pos, const float* conv_w, const float* conv_b, const float* dt_bias,
                         bf16* CQN, bf16* CKVN, bf16* KF, float* COS, float* SIN, float* DT, bf16* XC) {
    const int lane = tidx() & 63, gw = blockIdx.x * (NT / 64) + (tidx() >> 6), ngw = gridDim.x * (NT / 64);
    const int rows_per = (M + ngw - 1) / ngw;
    for (int t = gw * rows_per; t < (gw + 1) * rows_per && t < M; ++t) {
        const int sq = t & (SEQ - 1), b = t >> 11;
        const bf16* ur = U + (size_t)t * NU;
        { const uint2 w = *(const uint2*)(ur + OFF_CQ + lane * 4);
          const float a0 = __uint_as_float(w.x << 16), a1 = __uint_as_float(w.x & 0xffff0000u), a2 = __uint_as_float(w.y << 16), a3 = __uint_as_float(w.y & 0xffff0000u);
          const float inv = rsqrtf(wave_sum(a0 * a0 + a1 * a1 + a2 * a2 + a3 * a3) * (1.f / QR) + EPS);
          uint2 o; o.x = pk2(a0 * inv, a1 * inv); o.y = pk2(a2 * inv, a3 * inv);
          *(uint2*)(CQN + (size_t)t * QR + lane * 4) = o; }
        { const unsigned w = *(const unsigned*)(ur + OFF_CKV + lane * 2);
          const float a0 = __uint_as_float(w << 16), a1 = __uint_as_float(w & 0xffff0000u);
          const float inv = rsqrtf(wave_sum(a0 * a0 + a1 * a1) * (1.f / KVR) + EPS);
          *(unsigned*)(CKVN + (size_t)t * 256 + lane * 2) = pk2(a0 * inv, a1 * inv);
          *(unsigned*)(CKVN + (size_t)t * 256 + 128 + lane * 2) = 0u; }
        { const int i = lane & 15;
          const float x1 = bf2f(ur[OFF_KR + i]), x2 = bf2f(ur[OFF_KR + 16 + i]);
          const float inv = exp2f(-(float)i * (13.287712379549449f / 16.0f));
          const float ang = (float)pos[t] * inv;
          float sn, cs; sincosf(ang, &sn, &cs);
          if (lane < 16) { COS[(size_t)t * 16 + i] = cs; SIN[(size_t)t * 16 + i] = sn; }
          const float r1 = x1 * cs - x2 * sn, r2 = x2 * cs + x1 * sn;
          const int cc = lane & 3, hh = (lane >> 2) & 7;
          float e[8];
#pragma unroll
          for (int j = 0; j < 8; ++j) { const float p1 = __shfl(r1, (cc & 1) * 8 + j), p2 = __shfl(r2, (cc & 1) * 8 + j); e[j] = (cc >> 1) ? p2 : p1; }
          if (lane < 32) { v4u o; o.x = pk2(e[0], e[1]); o.y = pk2(e[2], e[3]); o.z = pk2(e[4], e[5]); o.w = pk2(e[6], e[7]);
            *(v4u*)(KF + (size_t)((b * 8 + hh) * 32 + (sq >> 6)) * 6144 + (8 + cc) * 512 + (sq & 63) * 8) = o; } }
        if (lane < 8) { const float raw = bf2f(ur[OFF_DT + lane]) + dt_bias[lane]; DT[(size_t)t * 8 + lane] = raw > 20.f ? raw : log1pf(expf(raw)); }
        { const int ch = lane * 16;
          float acc[16];
          { const f32x4v* bp = (const f32x4v*)(conv_b + ch);
#pragma unroll
            for (int q4 = 0; q4 < 4; ++q4) { const f32x4v bb = bp[q4]; acc[4 * q4] = bb.x; acc[4 * q4 + 1] = bb.y; acc[4 * q4 + 2] = bb.z; acc[4 * q4 + 3] = bb.w; } }
#pragma unroll
          for (int k = 0; k < 4; ++k) {
              if (sq - 3 + k >= 0) {
                  const v4u* xp = (const v4u*)(U + (size_t)(t - 3 + k) * NU + OFF_XBC + ch);
                  const v4u xa = xp[0], xb = xp[1];
                  const f32x4v* wp = (const f32x4v*)(conv_w + k * SSD_XBC + ch);
                  const unsigned xw[8] = {xa.x, xa.y, xa.z, xa.w, xb.x, xb.y, xb.z, xb.w};
#pragma unroll
                  for (int q4 = 0; q4 < 4; ++q4) { const f32x4v ww = wp[q4];
                      acc[4 * q4] += ww.x * __uint_as_float(xw[2 * q4] << 16); acc[4 * q4 + 1] += ww.y * __uint_as_float(xw[2 * q4] & 0xffff0000u);
                      acc[4 * q4 + 2] += ww.z * __uint_as_float(xw[2 * q4 + 1] << 16); acc[4 * q4 + 3] += ww.w * __uint_as_float(xw[2 * q4 + 1] & 0xffff0000u); }
              }
          }
          v4u o0, o1;
          o0.x = pk2(silu_f(acc[0]), silu_f(acc[1])); o0.y = pk2(silu_f(acc[2]), silu_f(acc[3])); o0.z = pk2(silu_f(acc[4]), silu_f(acc[5])); o0.w = pk2(silu_f(acc[6]), silu_f(acc[7]));
          o1.x = pk2(silu_f(acc[8]), silu_f(acc[9])); o1.y = pk2(silu_f(acc[10]), silu_f(acc[11])); o1.z = pk2(silu_f(acc[12]), silu_f(acc[13])); o1.w = pk2(silu_f(acc[14]), silu_f(acc[15]));
          { bf16* base = XC + (size_t)(t >> 7) * 131072; const int l = t & 127;
            if (ch < 512) { v4u* op = (v4u*)(base + (ch >> 6) * 8192 + ((ch & 63) >> 5) * 4096 + l * 32 + (ch & 31)); op[0] = o0; op[1] = o1; }
            else { const int c2 = ch - 512; bf16* q = base + 65536 + (c2 >> 7) * 16384 + ((c2 & 127) >> 3) * 1024 + l * 8; *(v4u*)q = o0; *(v4u*)(q + 1024) = o1; } } }
    }
}


#define RLAS __attribute__((address_space(3)))
__device__ __forceinline__ float dpp_f(float v, int ctrl_sel) {
    const int x = __float_as_int(v); int r;
    if (ctrl_sel == 0) r = __builtin_amdgcn_update_dpp(0, x, 0xB1, 0xF, 0xF, true);
    else if (ctrl_sel == 1) r = __builtin_amdgcn_update_dpp(0, x, 0x1B, 0xF, 0xF, true);
    else if (ctrl_sel == 2) r = __builtin_amdgcn_update_dpp(0, x, 0x141, 0xF, 0xF, true);
    else r = __builtin_amdgcn_update_dpp(0, x, 0x140, 0xF, 0xF, true);
    return __int_as_float(r);
}
__device__ __forceinline__ float wave_sum_valu(float v) {
    v += dpp_f(v, 0); v += dpp_f(v, 1); v += dpp_f(v, 2); v += dpp_f(v, 3);
    { auto rr = __builtin_amdgcn_permlane16_swap(__float_as_uint(v), __float_as_uint(v), false, false); v = __uint_as_float(rr[0]) + __uint_as_float(rr[1]); }
    { auto rr = __builtin_amdgcn_permlane32_swap(__float_as_uint(v), __float_as_uint(v), false, false); v = __uint_as_float(rr[0]) + __uint_as_float(rr[1]); }
    return v;
}
__device__ void ph_rowrouter(RLAS float* ldsf, const bf16* Yb, const float* x, const float* post_gain, const float* pre_gain, const float* mod, const float* WRT,
                             const float* bgr, const float* ber, float* out, bf16* H2, int* CNT, int* RT_E, int* RT_S, float* RT_W) {
    const int tid = tidx(), lane = tid & 63, wave = tid >> 6;
    const int gw = blockIdx.x * (NT / 64) + wave, ngw = gridDim.x * (NT / 64);
    { const f32x4v* src = (const f32x4v*)WRT; RLAS f32x4v* dst = (RLAS f32x4v*)ldsf;
      for (int i = tid; i < 36 * 1024 / 4; i += NT) dst[i] = src[i]; }
    RLAS float* Lg = ldsf + 36 * 1024 + wave * 320;
    __syncthreads();
    const int b0 = lane & 1, b1 = (lane >> 1) & 1, b2 = (lane >> 2) & 1, b3 = (lane >> 3) & 1, b4 = (lane >> 4) & 1, b5 = lane >> 5;
    const int i4 = b0 + 2 * b1, i3 = i4 + 3 * b2, i2 = i3 + 5 * b3;
    const bool colok = (i4 <= 2) && (i3 <= 4) && (i2 <= 8); const int mycol = i2 + 9 * b4 + 18 * b5;
    const int rows_per = (M + ngw - 1) / ngw;
    for (int bi = 0; bi < (rows_per + 7) / 8; ++bi) {
        const int tb = gw * rows_per + 8 * bi; const int nr = max(0, min(8, min((gw + 1) * rows_per, M) - tb));
        uint2 ynx[4]; f32x4v xnx[4];
        if (nr > 0) { const uint2* yp0 = (const uint2*)(Yb + (size_t)tb * D) + lane; const f32x4v* xp0 = (const f32x4v*)(x + (size_t)tb * D) + lane;
#pragma unroll
            for (int j = 0; j < 4; ++j) { ynx[j] = yp0[64 * j]; xnx[j] = xp0[64 * j]; } }
        for (int ri = 0; ri < nr; ++ri) {
            const int t = tb + ri, b = t >> 11;
            f32x4v* op = (f32x4v*)(out + (size_t)t * D) + lane;
            f32x4v y[4], xv[4]; float ssy = 0.f;
#pragma unroll
            for (int j = 0; j < 4; ++j) { const uint2 w = ynx[j]; xv[j] = xnx[j];
                y[j].x = __uint_as_float(w.x << 16); y[j].y = __uint_as_float(w.x & 0xffff0000u); y[j].z = __uint_as_float(w.y << 16); y[j].w = __uint_as_float(w.y & 0xffff0000u);
                ssy += (y[j].x * y[j].x + y[j].y * y[j].y) + (y[j].z * y[j].z + y[j].w * y[j].w); }
            if (ri + 1 < nr) { const uint2* yp1 = (const uint2*)(Yb + (size_t)(t + 1) * D) + lane; const f32x4v* xp1 = (const f32x4v*)(x + (size_t)(t + 1) * D) + lane;
#pragma unroll
                for (int j = 0; j < 4; ++j) { ynx[j] = yp1[64 * j]; xnx[j] = xp1[64 * j]; } }
            const float invy = rsqrtf(wave_sum_valu(ssy) * (1.f / D) + EPS);
            const f32x4v* g1p = (const f32x4v*)(mod + b * 6 * D + 2 * D) + lane; const f32x4v* pgp = (const f32x4v*)post_gain + lane;
            float ss1 = 0.f;
#pragma unroll
            for (int j = 0; j < 4; ++j) { xv[j] = xv[j] + g1p[64 * j] * (y[j] * invy * pgp[64 * j]); op[64 * j] = xv[j];
                ss1 += (xv[j].x * xv[j].x + xv[j].y * xv[j].y) + (xv[j].z * xv[j].z + xv[j].w * xv[j].w); }
            const float inv1 = rsqrtf(wave_sum_valu(ss1) * (1.f / D) + EPS);
            const f32x4v* prp = (const f32x4v*)pre_gain + lane; const f32x4v* scp = (const f32x4v*)(mod + b * 6 * D + 4 * D) + lane; const f32x4v* shp = (const f32x4v*)(mod + b * 6 * D + 3 * D) + lane;
            uint2* hp = (uint2*)(H2 + (size_t)t * D) + lane;
#pragma unroll
            for (int j = 0; j < 4; ++j) { xv[j] = xv[j] * inv1 * prp[64 * j] * (scp[64 * j] + 1.f) + shp[64 * j];
                uint2 o; o.x = pk2(xv[j].x, xv[j].y); o.y = pk2(xv[j].z, xv[j].w); hp[64 * j] = o; }
            const RLAS f32x4v* wl = (const RLAS f32x4v*)ldsf + lane;
#define RDOT(c_) ({ const RLAS f32x4v* wc_ = wl + (c_) * 256; float a_ = 0.f; _Pragma("unroll") for (int j = 0; j < 4; ++j) { const f32x4v w_ = wc_[64 * j]; \
                a_ += (xv[j].x * w_.x + xv[j].y * w_.y) + (xv[j].z * w_.z + xv[j].w * w_.w); } a_; })
            float v1[18];
#pragma unroll
            for (int i = 0; i < 18; ++i) { const float a = RDOT(i), c = RDOT(i + 18);
                auto rr = __builtin_amdgcn_permlane32_swap(__float_as_uint(a), __float_as_uint(c), false, false); v1[i] = __uint_as_float(rr[0]) + __uint_as_float(rr[1]); }
#undef RDOT
            float v2[10];
#pragma unroll
            for (int i = 0; i < 9; ++i) { auto rr = __builtin_amdgcn_permlane16_swap(__float_as_uint(v1[i]), __float_as_uint(v1[i + 9]), false, false); v2[i] = __uint_as_float(rr[0]) + __uint_as_float(rr[1]); }
            v2[9] = 0.f;
            float v3[6];
#pragma unroll
            for (int i = 0; i < 5; ++i) { const float keep = b3 ? v2[i + 5] : v2[i], send = b3 ? v2[i] : v2[i + 5]; v3[i] = keep + dpp_f(send, 3); }
            v3[5] = 0.f;
            float v4[4];
#pragma unroll
            for (int i = 0; i < 3; ++i) { const float keep = b2 ? v3[i + 3] : v3[i], send = b2 ? v3[i] : v3[i + 3]; v4[i] = keep + dpp_f(send, 2); }
            v4[3] = 0.f;
            float v5[2];
#pragma unroll
            for (int i = 0; i < 2; ++i) { const float keep = b1 ? v4[i + 2] : v4[i], send = b1 ? v4[i] : v4[i + 2]; v5[i] = keep + dpp_f(send, 1); }
            const float keep6 = b0 ? v5[1] : v5[0], send6 = b0 ? v5[0] : v5[1];
            const float tot = keep6 + dpp_f(send6, 0);
            if (colok) Lg[ri * 40 + mycol] = tot;
        }
        asm volatile("s_waitcnt lgkmcnt(0)" ::: "memory");
        RLAS int* agg = (RLAS int*)(ldsf + 36 * 1024 + 8 * 320);
        if (tid < 32) agg[tid] = 0;
        __syncthreads();
        int e1 = 0, e2 = 0, r1 = 0, r2 = 0; float w1 = 0.f, w2 = 0.f;
        if (lane < nr) {
            const RLAS float* lr = Lg + lane * 40;
            float mxv = -INFINITY; int gi = 0;
            for (int i = 0; i < 4; ++i) { const float v = lr[i] + bgr[i]; if (v > mxv) { mxv = v; gi = i; } }
            float den = 0.f; for (int i = 0; i < 4; ++i) den += expf(lr[i] + bgr[i] - mxv);
            const float gwt = 1.f / den;
            float v1 = -INFINITY, v2 = -INFINITY; int i1 = 0, i2 = 0;
            for (int i = 0; i < 8; ++i) { const float v = lr[4 + gi * 8 + i] + ber[gi * 8 + i];
                if (v > v1) { v2 = v1; i2 = i1; v1 = v; i1 = i; } else if (v > v2) { v2 = v; i2 = i; } }
            const float p2 = expf(v2 - v1);
            e1 = gi * 8 + i1; e2 = gi * 8 + i2; w1 = gwt / (1.f + p2); w2 = gwt * p2 / (1.f + p2);
            r1 = __hip_atomic_fetch_add(agg + e1, 1, __ATOMIC_RELAXED, __HIP_MEMORY_SCOPE_WORKGROUP);
            r2 = __hip_atomic_fetch_add(agg + e2, 1, __ATOMIC_RELAXED, __HIP_MEMORY_SCOPE_WORKGROUP);
        }
        __syncthreads();
        if (tid < 32) { const int c = agg[tid]; agg[32 + tid] = c ? atomicAdd(&CNT[tid * 64], c) : 0; }
        __syncthreads();
        if (lane < nr) { const int t = tb + lane;
            RT_E[t] = e1 | (e2 << 8); RT_S[2 * t] = agg[32 + e1] + r1; RT_S[2 * t + 1] = agg[32 + e2] + r2; RT_W[2 * t] = w1; RT_W[2 * t + 1] = w2; }
        __syncthreads();
    }
    __syncthreads();
}
__device__ __forceinline__ void moe_table(int* tp, const int* CNT) {
    const int tid = tidx();
    __syncthreads();
    if (tid < 64) { const int c = (tid < 32) ? __hip_atomic_load(CNT + tid * 64, __ATOMIC_RELAXED, __HIP_MEMORY_SCOPE_AGENT) : 0; int v = (c + 255) >> 8;
        int inc = v;
#pragma unroll
        for (int o = 1; o < 64; o <<= 1) { const int n = __shfl_up(inc, o); if ((tid & 63) >= o) inc += n; }
        if (tid <= 32) tp[tid] = inc - v; }
    __syncthreads();
}
__device__ void ph_gather(int* tp, const bf16* H2, const int* RT_E, const int* RT_S, const float* RT_W, bf16* HG, float* ROWW, int* TOKROW) {
    const int lane = tidx() & 63, gw = blockIdx.x * (NT / 64) + (tidx() >> 6), ngw = gridDim.x * (NT / 64);
    for (int p = gw; p < 2 * M; p += ngw) { const int t = p >> 1, k = p & 1;
        const int e = (RT_E[t] >> (8 * k)) & 255; const int rowd = tp[e] * 256 + RT_S[p];
        const v4u* src = (const v4u*)(H2 + (size_t)t * D) + lane; v4u* dst = (v4u*)(HG + (size_t)rowd * D) + lane;
        dst[0] = src[0]; dst[64] = src[64];
        if (lane == 0) { ROWW[rowd] = RT_W[p]; TOKROW[p] = rowd; } }
}
__device__ void ph_moe_final(const bf16* YP, const int* TOKROW, const float* gain, const float* mod, float* out) {
    const int lane = tidx() & 63, gw = blockIdx.x * (NT / 64) + (tidx() >> 6), ngw = gridDim.x * (NT / 64);
    for (int t = gw; t < M; t += ngw) { const int b = t >> 11; const int r1 = TOKROW[2 * t], r2 = TOKROW[2 * t + 1];
        const v4u* p1 = (const v4u*)(YP + (size_t)r1 * D) + lane; const v4u* p2 = (const v4u*)(YP + (size_t)r2 * D) + lane;
        float y[16]; float ss = 0.f;
#pragma unroll
        for (int j = 0; j < 2; ++j) { const v4u a = p1[64 * j], c = p2[64 * j];
#pragma unroll
            for (int e = 0; e < 4; ++e) { const float v0 = __uint_as_float(a[e] << 16) + __uint_as_float(c[e] << 16), v1 = __uint_as_float(a[e] & 0xffff0000u) + __uint_as_float(c[e] & 0xffff0000u);
                y[8 * j + 2 * e] = v0; y[8 * j + 2 * e + 1] = v1; ss += v0 * v0 + v1 * v1; } }
        const float inv = rsqrtf(wave_sum(ss) * (1.f / D) + EPS);
#pragma unroll
        for (int j = 0; j < 2; ++j) { const int col = 512 * j + lane * 8; float* op = out + (size_t)t * D + col;
            const f32x4v g2a = *(const f32x4v*)(mod + b * 6 * D + 5 * D + col), g2b = *(const f32x4v*)(mod + b * 6 * D + 5 * D + col + 4);
            const f32x4v ga = *(const f32x4v*)(gain + col), gb = *(const f32x4v*)(gain + col + 4);
            f32x4v xa = *(f32x4v*)op, xb = *(f32x4v*)(op + 4);
            xa.x += g2a.x * (y[8 * j + 0] * inv * ga.x); xa.y += g2a.y * (y[8 * j + 1] * inv * ga.y); xa.z += g2a.z * (y[8 * j + 2] * inv * ga.z); xa.w += g2a.w * (y[8 * j + 3] * inv * ga.w);
            xb.x += g2b.x * (y[8 * j + 4] * inv * gb.x); xb.y += g2b.y * (y[8 * j + 5] * inv * gb.y); xb.z += g2b.z * (y[8 * j + 6] * inv * gb.z); xb.w += g2b.w * (y[8 * j + 7] * inv * gb.w);
            *(f32x4v*)op = xa; *(f32x4v*)(op + 4) = xb; }
    }
}
__device__ void ph_attn_ref(const bf16* Q, const bf16* KF, const bf16* VT, float* o) {
    const int lane = tidx() & 63, gw = blockIdx.x * (NT / 64) + (tidx() >> 6), ngw = gridDim.x * (NT / 64);
    for (int item = gw; item < NB * MLA_H * (SEQ / 64); item += ngw) {
        const int qb = (SEQ / 64 - 1) - item / (NB * MLA_H), bh = item % (NB * MLA_H), b = bh / MLA_H, h = bh % MLA_H;
        const int qi = qb * 64 + lane;
        const size_t t = (size_t)b * SEQ + qi;
        float qr[QK];
#pragma unroll
        for (int d = 0; d < QK; ++d) qr[d] = bf2f(Q[t * 768 + h * QK + d]);
        float acc[VD];
#pragma unroll
        for (int d = 0; d < VD; ++d) acc[d] = 0.f;
        float mx = -INFINITY, l = 0.f;
        const int kmax = qb * 64 + 63;
        for (int k = 0; k <= kmax; ++k) {
            const bf16* kt = KF + (size_t)(bh * 32 + (k >> 6)) * 6144 + (k & 63) * 8;
            const bf16* vt = VT + (size_t)(bh * 32 + (k >> 6)) * 4096 + (k & 63) * 32;
            float s = 0.f;
#pragma unroll
            for (int d = 0; d < QK; ++d) s += qr[d] * bf2f(kt[(d >> 3) * 512 + (d & 7)]);
            if (k <= qi) {
                const float mn = fmaxf(mx, s);
                const float f = exp2f(mx - mn), pv = exp2f(s - mn);
                l = l * f + pv;
#pragma unroll
                for (int d = 0; d < VD; ++d) acc[d] = acc[d] * f + pv * bf2f(vt[(d >> 5) * 2048 + (d & 31)]);
                mx = mn;
            }
        }
        const float il = 1.f / l;
#pragma unroll
        for (int d = 0; d < VD; ++d) o[t * (MLA_H * VD) + h * VD + d] = acc[d] * il;
    }
}

namespace att {
typedef short bf16x8 __attribute__((ext_vector_type(8)));
typedef short s16x4 __attribute__((ext_vector_type(4)));
typedef float f32x16 __attribute__((ext_vector_type(16)));
typedef unsigned u32x4 __attribute__((ext_vector_type(4)));
#define ALAS __attribute__((address_space(3)))
constexpr int KSLOT = 12288, VSLOT = 8192, NSLOT = 3;
constexpr int LDS_K = 0, LDS_V = NSLOT * KSLOT, LDS_WS = LDS_V + NSLOT * VSLOT, LDS_OST = LDS_WS + 8 * 256, LDS_END = LDS_OST + 8 * 4096;
constexpr float THR = 8.0f;
__device__ __forceinline__ int crow(int r, int hi) { return (r & 3) + 8 * (r >> 2) + 4 * hi; }
__device__ __forceinline__ unsigned cvtpk(float lo, float hi) { typedef float f2 __attribute__((ext_vector_type(2))); typedef __bf16 b2 __attribute__((ext_vector_type(2)));
    f2 v = {lo, hi}; b2 b = __builtin_convertvector(v, b2); return __builtin_bit_cast(unsigned, b); }
__device__ __forceinline__ s16x4 vtr(const ALAS char* p) { typedef short v4 __attribute__((ext_vector_type(4))); return __builtin_bit_cast(s16x4, __builtin_amdgcn_ds_read_tr16_b64_v4i16((ALAS v4*)p)); }
#define AWAIT_BAR(N) asm volatile("s_waitcnt vmcnt(" #N ") lgkmcnt(0)\n\ts_barrier" ::: "memory")

__device__ __forceinline__ void attn_unit(ALAS char* lds, int bh, int qb, const bf16* Q, const bf16* KF, const bf16* VT, bf16* YC, float* SSQ) {
    const int tid = tidx(), lane = tid & 63, r32 = lane & 31, hi = lane >> 5; const int wid = __builtin_amdgcn_readfirstlane(tid >> 6);
    const int b = bh >> 3, h = bh & 7;
    const char* Kt = (const char*)(KF + (size_t)bh * 32 * 6144); const char* Vt = (const char*)(VT + (size_t)bh * 32 * 4096);
    const int NTL = 4 * (qb + 1);
    bf16x8 qf[6];
    { const bf16* qp = Q + (size_t)(b * SEQ + qb * 256 + wid * 32 + r32) * 768 + h * QK + hi * 8;
#pragma unroll
      for (int d0 = 0; d0 < 6; ++d0) qf[d0] = *(const bf16x8*)(qp + d0 * 16); }
    const unsigned koff0 = wid * 1024 + lane * 16, koff1 = (8 + (wid & 3)) * 1024 + lane * 16, voff = wid * 1024 + lane * 16;
#define ADMA(t, slot) do { const char* kb_ = Kt + (size_t)(t) * KSLOT; const char* vb_ = Vt + (size_t)(t) * VSLOT; \
        __builtin_amdgcn_global_load_lds((const unsigned*)(kb_ + koff0), (ALAS unsigned*)(lds + LDS_K + (slot) * KSLOT + wid * 1024), 16, 0, 0); \
        __builtin_amdgcn_global_load_lds((const unsigned*)(kb_ + koff1), (ALAS unsigned*)(lds + LDS_K + (slot) * KSLOT + (8 + (wid & 3)) * 1024), 16, 0, 0); \
        __builtin_amdgcn_global_load_lds((const unsigned*)(vb_ + voff), (ALAS unsigned*)(lds + LDS_V + (slot) * VSLOT + wid * 1024), 16, 0, 0); } while (0)
    ADMA(0, 0); ADMA(1, 1);
    ALAS float* wsf = (ALAS float*)(lds + LDS_WS) + wid * 64;
    float mref = 0.f, l = 0.f;
    f32x16 o0 = {}, o1 = {}, negm = {};
    const int qrel = wid * 32 + r32;
    const int vlane = (4 * hi + ((lane & 15) >> 2)) * 64 + ((lane >> 4) & 1) * 32 + (lane & 3) * 8;
    int slot = 0;
    for (int t = 0; t < NTL; ++t) {
        if (t + 1 < NTL) { AWAIT_BAR(3); } else { AWAIT_BAR(0); }
        if (t + 2 < NTL) { const int s2 = (slot == 0) ? 2 : slot - 1; ADMA(t + 2, s2); }
        const ALAS char* Ks = lds + LDS_K + slot * KSLOT + hi * 1024 + r32 * 16;
        const ALAS char* Vs = lds + LDS_V + slot * VSLOT + vlane;
        f32x16 p0 = negm, p1 = negm;
#pragma unroll
        for (int d0 = 0; d0 < 6; ++d0) {
            const bf16x8 ka0 = *(const ALAS bf16x8*)(Ks + d0 * 2048), ka1 = *(const ALAS bf16x8*)(Ks + d0 * 2048 + 512);
            p0 = __builtin_amdgcn_mfma_f32_32x32x16_bf16(ka0, qf[d0], p0, 0, 0, 0);
            p1 = __builtin_amdgcn_mfma_f32_32x32x16_bf16(ka1, qf[d0], p1, 0, 0, 0);
        }
        const int jb = t - (NTL - 4);
        if (jb >= 0) {
#pragma unroll
            for (int r = 0; r < 16; ++r) { const int kv = 64 * jb + crow(r, hi); if (kv > qrel) p0[r] = -INFINITY; if (kv + 32 > qrel) p1[r] = -INFINITY; }
        }
        float rm = fmaxf(p0[0], p1[0]);
#pragma unroll
        for (int r = 1; r < 16; ++r) rm = fmaxf(rm, fmaxf(p0[r], p1[r]));
        { auto rr = __builtin_amdgcn_permlane32_swap(__float_as_uint(rm), __float_as_uint(rm), false, false); rm = fmaxf(__uint_as_float(rr[0]), __uint_as_float(rr[1])); }
        if (t == 0 || __any(rm > THR)) {
            const float dl = (t == 0) ? rm : fmaxf(rm, 0.f);
            mref += dl;
#pragma unroll
            for (int r = 0; r < 16; ++r) { p0[r] -= dl; p1[r] -= dl; }
#pragma unroll
            for (int r = 0; r < 16; ++r) negm[r] = -mref;
            const float f = exp2f(-dl); l *= f;
            if (t > 0) {
                if (hi == 0) wsf[r32] = f;
                asm volatile("s_waitcnt lgkmcnt(0)" ::: "memory");
#pragma unroll
                for (int r = 0; r < 16; ++r) { const float fr_ = wsf[crow(r, hi)]; o0[r] *= fr_; o1[r] *= fr_; }
            }
        }
        float ls = 0.f;
#pragma unroll
        for (int r = 0; r < 16; ++r) { p0[r] = exp2f(p0[r]); p1[r] = exp2f(p1[r]); ls += p0[r] + p1[r]; }
        l += ls;
        u32x4 pw0 = {cvtpk(p0[0], p0[1]), cvtpk(p0[2], p0[3]), cvtpk(p0[4], p0[5]), cvtpk(p0[6], p0[7])};
        u32x4 pw1 = {cvtpk(p0[8], p0[9]), cvtpk(p0[10], p0[11]), cvtpk(p0[12], p0[13]), cvtpk(p0[14], p0[15])};
        u32x4 pw2 = {cvtpk(p1[0], p1[1]), cvtpk(p1[2], p1[3]), cvtpk(p1[4], p1[5]), cvtpk(p1[6], p1[7])};
        u32x4 pw3 = {cvtpk(p1[8], p1[9]), cvtpk(p1[10], p1[11]), cvtpk(p1[12], p1[13]), cvtpk(p1[14], p1[15])};
#define PV_STEP(PW, ks) do { const bf16x8 pa_ = __builtin_bit_cast(bf16x8, PW); \
            { const s16x4 a_ = vtr(Vs + (ks) * 1024), b_ = vtr(Vs + (ks) * 1024 + 512); const bf16x8 vf_ = {a_[0], a_[1], a_[2], a_[3], b_[0], b_[1], b_[2], b_[3]}; \
              o0 = __builtin_amdgcn_mfma_f32_32x32x16_bf16(pa_, vf_, o0, 0, 0, 0); } \
            { const s16x4 a_ = vtr(Vs + 4096 + (ks) * 1024), b_ = vtr(Vs + 4096 + (ks) * 1024 + 512); const bf16x8 vf_ = {a_[0], a_[1], a_[2], a_[3], b_[0], b_[1], b_[2], b_[3]}; \
              o1 = __builtin_amdgcn_mfma_f32_32x32x16_bf16(pa_, vf_, o1, 0, 0, 0); } } while (0)
        PV_STEP(pw0, 0); PV_STEP(pw1, 1); PV_STEP(pw2, 2); PV_STEP(pw3, 3);
#undef PV_STEP
        slot = (slot == 2) ? 0 : slot + 1;
    }
    { auto rr = __builtin_amdgcn_permlane32_swap(__float_as_uint(l), __float_as_uint(l), false, false); l = __uint_as_float(rr[0]) + __uint_as_float(rr[1]); }
    if (hi == 0) wsf[32 + r32] = l;
    asm volatile("s_waitcnt lgkmcnt(0)" ::: "memory");
    ALAS bf16* stg = (ALAS bf16*)(lds + LDS_OST) + wid * 2048;
#pragma unroll
    for (int r = 0; r < 16; ++r) { const int orow = crow(r, hi); const float rl = 1.f / wsf[32 + orow];
        stg[orow * 64 + r32] = (bf16)f2bf(o0[r] * rl); stg[orow * 64 + 32 + r32] = (bf16)f2bf(o1[r] * rl); }
    asm volatile("s_waitcnt lgkmcnt(0)" ::: "memory");
    const size_t trow0 = (size_t)b * SEQ + qb * 256 + wid * 32;
#pragma unroll
    for (int i = 0; i < 4; ++i) { const int row = i * 8 + (lane >> 3), ch = lane & 7;
        const u32x4 v = *(const ALAS u32x4*)(stg + row * 64 + ch * 8);
        *(u32x4*)(YC + (trow0 + row) * 1024 + 512 + h * 64 + ch * 8) = v;
        float sq = 0.f;
#pragma unroll
        for (int e = 0; e < 4; ++e) { const float a = __uint_as_float(v[e] << 16), c = __uint_as_float(v[e] & 0xffff0000u); sq += a * a + c * c; }
        sq += __shfl_xor(sq, 1); sq += __shfl_xor(sq, 2); sq += __shfl_xor(sq, 4);
        if (ch == 0) SSQ[(trow0 + row) * 16 + 8 + h] = sq; }
    asm volatile("s_waitcnt lgkmcnt(0)\n\ts_barrier" ::: "memory");
#undef ADMA
}
__device__ __forceinline__ void attn_phase(ALAS char* lds, const bf16* Q, const bf16* KF, const bf16* VT, bf16* YC, float* SSQ) {
    const int G = gridDim.x, bid = blockIdx.x; const int vcu = (G % 8 == 0) ? (bid % 8) * (G / 8) + bid / 8 : bid;
    for (int p = vcu; p < 256; p += G) { const int bh = p >> 2, s = p & 3;
        attn_unit(lds, bh, 7 - s, Q, KF, VT, YC, SSQ);
        attn_unit(lds, bh, s, Q, KF, VT, YC, SSQ); }
}
#undef AWAIT_BAR
}
__device__ void ph_prenorm(const float* in, const float* g, const float* mod, int sh_off, int sc_off, float* out) {
    const int lane = tidx() & 63, gw = blockIdx.x * (NT / 64) + (tidx() >> 6), ngw = gridDim.x * (NT / 64);
    for (int t = gw; t < M; t += ngw) {
        const int b = t / SEQ; const float* r = in + (size_t)t * D;
        float s = 0.f;
        for (int i = lane; i < D; i += 64) s += r[i] * r[i];
        const float inv = rsqrtf(wave_sum(s) / D + EPS);
        for (int i = lane; i < D; i += 64)
            out[(size_t)t * D + i] = r[i] * inv * g[i] * (1.f + mod[b * 6 * D + sc_off + i]) + mod[b * 6 * D + sh_off + i];
    }
}
template <class TY> __device__ void ph_post(const float* base, const TY* y, const float* g, const float* mod, int gate_off, float* out) {
    const int lane = tidx() & 63, gw = blockIdx.x * (NT / 64) + (tidx() >> 6), ngw = gridDim.x * (NT / 64);
    for (int t = gw; t < M; t += ngw) {
        const int b = t / SEQ; const TY* r = y + (size_t)t * D;
        float s = 0.f;
        for (int i = lane; i < D; i += 64) { const float v = ldf(r + i); s += v * v; }
        const float inv = rsqrtf(wave_sum(s) / D + EPS);
        for (int i = lane; i < D; i += 64)
            out[(size_t)t * D + i] = base[(size_t)t * D + i] + mod[b * 6 * D + gate_off + i] * (ldf(r + i) * inv * g[i]);
    }
}
template <class TI> __device__ void ph_rms_slice(const TI* in, int ldi, int off, int n, const float* g, float* out, int ldo, int ooff) {
    const int lane = tidx() & 63, gw = blockIdx.x * (NT / 64) + (tidx() >> 6), ngw = gridDim.x * (NT / 64);
    for (int t = gw; t < M; t += ngw) {
        const TI* r = in + (size_t)t * ldi + off;
        float s = 0.f;
        for (int i = lane; i < n; i += 64) { const float v = ldf(r + i); s += v * v; }
        const float inv = rsqrtf(wave_sum(s) / n + EPS);
        for (int i = lane; i < n; i += 64) out[(size_t)t * ldo + ooff + i] = ldf(r + i) * inv * g[i];
    }
}

namespace ssd {
typedef short bf16x8 __attribute__((ext_vector_type(8)));
typedef short s16x4 __attribute__((ext_vector_type(4)));
typedef float f32x16 __attribute__((ext_vector_type(16)));
typedef unsigned u32x4 __attribute__((ext_vector_type(4)));
#define SLAS __attribute__((address_space(3)))
constexpr float LOG2E = 1.4426950408889634f;
__device__ __forceinline__ int crow(int r, int hi) { return (r & 3) + 8 * (r >> 2) + 4 * hi; }
__device__ __forceinline__ s16x4 vtr(const SLAS char* p) { typedef short v4 __attribute__((ext_vector_type(4))); return __builtin_bit_cast(s16x4, __builtin_amdgcn_ds_read_tr16_b64_v4i16((SLAS v4*)p)); }
__device__ __forceinline__ unsigned cvtpk(float lo, float hi) { typedef float f2 __attribute__((ext_vector_type(2))); typedef __bf16 b2 __attribute__((ext_vector_type(2)));
    f2 v = {lo, hi}; b2 b = __builtin_convertvector(v, b2); return __builtin_bit_cast(unsigned, b); }
#define SWAIT_BAR(N) asm volatile("s_waitcnt vmcnt(" #N ") lgkmcnt(0)\n\ts_barrier" ::: "memory")
#define SDMA(gsrc, ldst) __builtin_amdgcn_global_load_lds((const unsigned*)(gsrc), (SLAS unsigned*)(ldst), 16, 0, 0)

constexpr int SW_BUF = 49152, SW_TAB = 2 * SW_BUF;
__device__ __forceinline__ void state_sweep(SLAS char* lds, int b, int h, const bf16* XT, const float* DT, const float* a_log, float* ACS2, bf16* PREV) {
    const int tid = tidx(), lane = tid & 63, r32 = lane & 31, hi = lane >> 5; const int wid = __builtin_amdgcn_readfirstlane(tid >> 6);
    const int g = h >> 2, pt = wid & 1, nt = wid >> 1;
    const float a = -expf(a_log[h]);
    SLAS float* tab = (SLAS float*)(lds + SW_TAB);
    f32x16 st = {};
    const int trl = (4 * hi + ((lane & 15) >> 2));
    const int trc = 16 * ((lane >> 4) & 1) + 4 * (lane & 3);
#define SW_ISSUE(c_, buf_) do { const char* xs_ = (const char*)(XT + (size_t)(b * 16 + (c_)) * 131072 + h * 8192); const char* bs_ = (const char*)(XT + (size_t)(b * 16 + (c_)) * 131072 + 65536 + g * 16384); \
        _Pragma("unroll") for (int i_ = 0; i_ < 2; ++i_) SDMA(xs_ + (wid * 2 + i_) * 1024 + lane * 16, lds + (buf_) * SW_BUF + (wid * 2 + i_) * 1024); \
        _Pragma("unroll") for (int i_ = 0; i_ < 4; ++i_) SDMA(bs_ + (wid * 4 + i_) * 1024 + lane * 16, lds + (buf_) * SW_BUF + 16384 + (wid * 4 + i_) * 1024); } while (0)
    SW_ISSUE(0, 0);
    for (int c = 0; c < 16; ++c) {
        const int buf = c & 1;
        float cdec = 0.f, d0 = 0.f, d1 = 0.f;
        const size_t t0 = (size_t)(b * 16 + c) * 128;
        if (wid == 0) { d0 = DT[(t0 + 2 * lane) * 8 + h]; d1 = DT[(t0 + 2 * lane + 1) * 8 + h]; }
        if (c + 1 < 16) SW_ISSUE(c + 1, buf ^ 1);
        float cs0 = 0.f, cs1 = 0.f;
        if (wid == 0) {
            const float a0 = d0 * a, a1 = d1 * a; float inc = a0 + a1;
#pragma unroll
            for (int o = 1; o < 64; o <<= 1) { const float n = __shfl_up(inc, o); if (lane >= o) inc += n; }
            const float tot = __shfl(inc, 63); cs1 = inc; cs0 = inc - a1;
            tab[2 * lane] = cs0 * LOG2E; tab[2 * lane + 1] = cs1 * LOG2E;
            tab[128 + 2 * lane] = d0 * expf(tot - cs0); tab[128 + 2 * lane + 1] = d1 * expf(tot - cs1);
            if (lane == 0) tab[256] = expf(tot);
        }
        if (c + 1 < 16) { SWAIT_BAR(6); } else { SWAIT_BAR(0); }
        if (wid == 0) { ACS2[(t0 + 2 * lane) * 8 + h] = cs0 * LOG2E; ACS2[(t0 + 2 * lane + 1) * 8 + h] = cs1 * LOG2E; }
        cdec = tab[256];
        { SLAS char* xp = lds + buf * SW_BUF + tid * 32; const int l = (tid >> 1) & 127; const float w = tab[128 + l];
          u32x4 q0 = *(SLAS u32x4*)xp, q1 = *(SLAS u32x4*)(xp + 16);
#pragma unroll
          for (int e = 0; e < 4; ++e) { q0[e] = cvtpk(__uint_as_float(q0[e] << 16) * w, __uint_as_float(q0[e] & 0xffff0000u) * w); q1[e] = cvtpk(__uint_as_float(q1[e] << 16) * w, __uint_as_float(q1[e] & 0xffff0000u) * w); }
          *(SLAS u32x4*)xp = q0; *(SLAS u32x4*)(xp + 16) = q1; }
        asm volatile("s_waitcnt lgkmcnt(0)\n\ts_barrier" ::: "memory");
        f32x16 acc = {};
        { const SLAS char* bb = lds + buf * SW_BUF + 16384 + ((32 * nt + trc) >> 3) * 2048 + ((32 * nt + trc) & 7) * 2 + trl * 16;
          const SLAS char* xb = lds + buf * SW_BUF + pt * 8192 + trl * 64 + trc * 2;
#pragma unroll
          for (int ks = 0; ks < 8; ++ks) {
              const s16x4 a0 = vtr(bb + ks * 256), a1 = vtr(bb + ks * 256 + 128); const s16x4 x0 = vtr(xb + ks * 1024), x1 = vtr(xb + ks * 1024 + 512);
              const bf16x8 af = {a0[0], a0[1], a0[2], a0[3], a1[0], a1[1], a1[2], a1[3]}, xf = {x0[0], x0[1], x0[2], x0[3], x1[0], x1[1], x1[2], x1[3]};
              acc = __builtin_amdgcn_mfma_f32_32x32x16_bf16(af, xf, acc, 0, 0, 0); } }
        { bf16* pv = PREV + (size_t)((b * 16 + c) * 8 + h) * 8192 + (32 * pt + r32) * 8 + 4 * hi;
#pragma unroll
          for (int rg = 0; rg < 4; ++rg) { uint2 o; o.x = cvtpk(st[4 * rg], st[4 * rg + 1]); o.y = cvtpk(st[4 * rg + 2], st[4 * rg + 3]); *(uint2*)(pv + (4 * nt + rg) * 512) = o; } }
#pragma unroll
        for (int r = 0; r < 16; ++r) st[r] = st[r] * cdec + acc[r];
        asm volatile("s_waitcnt lgkmcnt(0)\n\ts_barrier" ::: "memory");
    }
#undef SW_ISSUE
}

constexpr int P2_C = 0, P2_B = 32768, P2_XP = 65536, P2_TAB = 131072, P2_STG = 135168, P2_END = 151552;
__device__ __forceinline__ void chunk_unit(SLAS char* lds, int b, int c, int g, const bf16* XT, const bf16* PREV, const float* DT, const float* ACS2, const float* d_skip,
                                           const bf16* U, bf16* YC, float* SSQS) {
    const int tid = tidx(), lane = tid & 63, r32 = lane & 31, hi = lane >> 5; const int wid = __builtin_amdgcn_readfirstlane(tid >> 6);
    const int lb = wid >> 1, ph = wid & 1;
    const char* xt = (const char*)(XT + (size_t)(b * 16 + c) * 131072);
    const size_t t0 = (size_t)(b * 16 + c) * 128;
#pragma unroll
    for (int i = 0; i < 4; ++i) { SDMA(xt + (98304 + g * 16384) * 2 + (wid * 4 + i) * 1024 + lane * 16, lds + P2_C + (wid * 4 + i) * 1024);
                                  SDMA(xt + (65536 + g * 16384) * 2 + (wid * 4 + i) * 1024 + lane * 16, lds + P2_B + (wid * 4 + i) * 1024); }
#define P2_ISSUE(hh_) do { const int h_ = 4 * g + (hh_); const char* xs_ = xt + h_ * 16384; const char* ps_ = (const char*)(PREV + (size_t)((b * 16 + c) * 8 + h_) * 8192); \
        SLAS char* d_ = lds + P2_XP + ((hh_) & 1) * 32768; \
        _Pragma("unroll") for (int i_ = 0; i_ < 2; ++i_) { SDMA(xs_ + (wid * 2 + i_) * 1024 + lane * 16, d_ + (wid * 2 + i_) * 1024); SDMA(ps_ + (wid * 2 + i_) * 1024 + lane * 16, d_ + 16384 + (wid * 2 + i_) * 1024); } } while (0)
    P2_ISSUE(0);
    { SLAS float* tab = (SLAS float*)(lds + P2_TAB); const int hh = tid >> 7, l = tid & 127;
      tab[hh * 256 + l] = ACS2[(t0 + l) * 8 + 4 * g + hh]; tab[hh * 256 + 128 + l] = DT[(t0 + l) * 8 + 4 * g + hh]; }
    P2_ISSUE(1);
    SWAIT_BAR(4);
    bf16x8 cf[8];
#pragma unroll
    for (int ks = 0; ks < 8; ++ks) cf[ks] = *(const SLAS bf16x8*)(lds + P2_C + (2 * ks + hi) * 2048 + (32 * lb + r32) * 16);
    f32x16 cbt[4];
#pragma unroll
    for (int sb = 0; sb < 4; ++sb) { cbt[sb] = f32x16{};
        if (sb <= lb) {
#pragma unroll
            for (int ks = 0; ks < 8; ++ks) { const bf16x8 bfr = *(const SLAS bf16x8*)(lds + P2_B + (2 * ks + hi) * 2048 + (32 * sb + r32) * 16);
                cbt[sb] = __builtin_amdgcn_mfma_f32_32x32x16_bf16(bfr, cf[ks], cbt[sb], 0, 0, 0); } } }
    const int vlane = (4 * hi + ((lane & 15) >> 2)) * 64 + ((lane >> 4) & 1) * 32 + (lane & 3) * 8;
    const int lrow = 32 * lb + r32;
    for (int hh = 0; hh < 4; ++hh) {
        const int h = 4 * g + hh;
        const SLAS char* xb = lds + P2_XP + (hh & 1) * 32768; const SLAS char* pb = xb + 16384;
        const SLAS float* tab = (const SLAS float*)(lds + P2_TAB) + hh * 256;
        const float dsk = d_skip[h];
        f32x16 o = {};
#pragma unroll
        for (int ks = 0; ks < 8; ++ks) { const bf16x8 pf = *(const SLAS bf16x8*)(pb + (2 * ks + hi) * 1024 + (32 * ph + r32) * 16);
            o = __builtin_amdgcn_mfma_f32_32x32x16_bf16(cf[ks], pf, o, 0, 0, 0); }
#pragma unroll
        for (int r = 0; r < 16; ++r) o[r] *= exp2f(tab[32 * lb + crow(r, hi)]);
        const float al = tab[lrow];
#pragma unroll
        for (int sb = 0; sb < 4; ++sb) {
            if (sb <= lb) {
                float pr[16];
#pragma unroll
                for (int r = 0; r < 16; ++r) { const int sidx = 32 * sb + crow(r, hi);
                    float v = cbt[sb][r] * exp2f(al - tab[sidx]) * tab[128 + sidx];
                    if (sb == lb) { v = (sidx <= lrow) ? v : 0.f; v += (sidx == lrow) ? dsk : 0.f; }
                    pr[r] = v; }
                const u32x4 pw0 = {cvtpk(pr[0], pr[1]), cvtpk(pr[2], pr[3]), cvtpk(pr[4], pr[5]), cvtpk(pr[6], pr[7])};
                const u32x4 pw1 = {cvtpk(pr[8], pr[9]), cvtpk(pr[10], pr[11]), cvtpk(pr[12], pr[13]), cvtpk(pr[14], pr[15])};
                const SLAS char* xv = xb + ph * 8192 + vlane + (2 * sb) * 1024;
                { const s16x4 a_ = vtr(xv), b_ = vtr(xv + 512); const bf16x8 vf = {a_[0], a_[1], a_[2], a_[3], b_[0], b_[1], b_[2], b_[3]};
                  o = __builtin_amdgcn_mfma_f32_32x32x16_bf16(__builtin_bit_cast(bf16x8, pw0), vf, o, 0, 0, 0); }
                { const s16x4 a_ = vtr(xv + 1024), b_ = vtr(xv + 1024 + 512); const bf16x8 vf = {a_[0], a_[1], a_[2], a_[3], b_[0], b_[1], b_[2], b_[3]};
                  o = __builtin_amdgcn_mfma_f32_32x32x16_bf16(__builtin_bit_cast(bf16x8, pw1), vf, o, 0, 0, 0); }
            }
        }
        SLAS bf16* stg = (SLAS bf16*)(lds + P2_STG) + wid * 1024;
#pragma unroll
        for (int r = 0; r < 16; ++r) stg[crow(r, hi) * 32 + r32] = (bf16)f2bf(o[r]);
        asm volatile("s_waitcnt lgkmcnt(0)" ::: "memory");
#pragma unroll
        for (int i = 0; i < 2; ++i) { const int row = i * 16 + (lane >> 2), ch = lane & 3; const size_t t = t0 + 32 * lb + row;
            const u32x4 ov = *(const SLAS u32x4*)(stg + row * 32 + ch * 8);
            const u32x4 zv = *(const u32x4*)(U + t * NU + OFF_Z + h * 64 + 32 * ph + 8 * ch);
            u32x4 w; float sq = 0.f;
#pragma unroll
            for (int e = 0; e < 4; ++e) { const float z0 = __uint_as_float(zv[e] << 16), z1 = __uint_as_float(zv[e] & 0xffff0000u);
                const float v0 = __uint_as_float(ov[e] << 16) * (z0 * __builtin_amdgcn_rcpf(1.f + __expf(-z0))), v1 = __uint_as_float(ov[e] & 0xffff0000u) * (z1 * __builtin_amdgcn_rcpf(1.f + __expf(-z1)));
                w[e] = cvtpk(v0, v1); const float r0 = __uint_as_float(w[e] << 16), r1 = __uint_as_float(w[e] & 0xffff0000u); sq += r0 * r0 + r1 * r1; }
            *(u32x4*)(YC + t * 1024 + h * 64 + 32 * ph + 8 * ch) = w;
            sq += __shfl_xor(sq, 1); sq += __shfl_xor(sq, 2);
            if (ch == 0) SSQS[t * 16 + h * 2 + ph] = sq; }
        if (hh < 3) {
            if (hh + 2 < 4) { asm volatile("s_waitcnt lgkmcnt(0)\n\ts_barrier" ::: "memory"); P2_ISSUE(hh + 2); SWAIT_BAR(4); }
            else { SWAIT_BAR(0); }
        }
    }
    asm volatile("s_waitcnt vmcnt(0) lgkmcnt(0)\n\ts_barrier" ::: "memory");
#undef P2_ISSUE
}
#undef SWAIT_BAR
#undef SDMA
}
__device__ void ph_gate_norm(const float* y, const bf16* u, bf16* YC) {
    const int lane = tidx() & 63, gw = blockIdx.x * (NT / 64) + (tidx() >> 6), ngw = gridDim.x * (NT / 64);
    for (int t = gw; t < M; t += ngw) {
        float v[8]; float s = 0.f;
#pragma unroll
        for (int j = 0; j < 8; ++j) { const int i = lane + 64 * j; v[j] = y[(size_t)t * SSD_INNER + i] * silu_f(bf2f(u[(size_t)t * NU + OFF_Z + i])); s += v[j] * v[j]; }
        const float inv = rsqrtf(wave_sum(s) / SSD_INNER + EPS);
#pragma unroll
        for (int j = 0; j < 8; ++j) YC[(size_t)t * 1024 + lane + 64 * j] = (bf16)f2bf(v[j] * inv);
    }
}
__device__ void ph_yc_norm(bf16* YC, const float* SSQS, const float* SSQ) {
    const int lane = tidx() & 63, gw = blockIdx.x * (NT / 64) + (tidx() >> 6), ngw = gridDim.x * (NT / 64);
    for (int t = gw; t < M; t += ngw) {
        float ss = 0.f, sm = 0.f;
#pragma unroll
        for (int q = 0; q < 4; ++q) { const f32x4v a = *(const f32x4v*)(SSQS + (size_t)t * 16 + 4 * q); ss += (a.x + a.y) + (a.z + a.w); }
        { const f32x4v a = *(const f32x4v*)(SSQ + (size_t)t * 16 + 8), b = *(const f32x4v*)(SSQ + (size_t)t * 16 + 12); sm = (a.x + a.y) + (a.z + a.w) + (b.x + b.y) + (b.z + b.w); }
        const float invs = rsqrtf(ss * (1.f / 512.f) + EPS), invm = rsqrtf(sm * (1.f / 512.f) + EPS);
#pragma unroll
        for (int hlf = 0; hlf < 2; ++hlf) { const float inv = hlf ? invm : invs;
            v4u* p = (v4u*)(YC + (size_t)t * 1024 + 512 * hlf) + lane; v4u w = *p;
            w.x = pk2(__uint_as_float(w.x << 16) * inv, __uint_as_float(w.x & 0xffff0000u) * inv); w.y = pk2(__uint_as_float(w.y << 16) * inv, __uint_as_float(w.y & 0xffff0000u) * inv);
            w.z = pk2(__uint_as_float(w.z << 16) * inv, __uint_as_float(w.z & 0xffff0000u) * inv); w.w = pk2(__uint_as_float(w.w << 16) * inv, __uint_as_float(w.w & 0xffff0000u) * inv);
            *p = w; }
    }
}
__device__ void ph_gemm(float* lds, const float* A, int lda, const float* B, int ldb, float* C, int ldc, int Mr, int N, int K) {
    float (*As)[129] = (float (*)[129])lds;
    float (*Bs)[65] = (float (*)[65])(lds + 16 * 129);
    const int tx = tidx() & 15, ty = tidx() >> 4;
    const int ntn = (N + 63) / 64, ntm = Mr / 128;
    for (int tile = blockIdx.x; tile < ntn * ntm; tile += gridDim.x) {
        const int m0 = (tile / ntn) * 128, n0 = (tile % ntn) * 64;
        float acc[4][4] = {};
        for (int k0 = 0; k0 < K; k0 += 16) {
            for (int i = tidx(); i < 128 * 16; i += NT) { const int r = i >> 4, kk = i & 15; As[kk][r] = A[(size_t)(m0 + r) * lda + k0 + kk]; }
            for (int i = tidx(); i < 64 * 16; i += NT) { const int kk = i >> 6, cc = i & 63; Bs[kk][cc] = (n0 + cc < N) ? B[(size_t)(k0 + kk) * ldb + n0 + cc] : 0.f; }
            __syncthreads();
#pragma unroll
            for (int kk = 0; kk < 16; ++kk) {
                float a[4], b[4];
#pragma unroll
                for (int i = 0; i < 4; ++i) { a[i] = As[kk][ty * 4 + i]; b[i] = Bs[kk][tx * 4 + i]; }
#pragma unroll
                for (int i = 0; i < 4; ++i)
#pragma unroll
                    for (int j = 0; j < 4; ++j) acc[i][j] += a[i] * b[j];
            }
            __syncthreads();
        }
#pragma unroll
        for (int i = 0; i < 4; ++i)
#pragma unroll
            for (int j = 0; j < 4; ++j) { const int n = n0 + tx * 4 + j; if (n < N) C[(size_t)(m0 + ty * 4 + i) * ldc + n] = acc[i][j]; }
    }
}
__device__ void ph_conv(const bf16* u, const float* cw, const float* cb, float* xc) {
    for (size_t idx = (size_t)blockIdx.x * NT + tidx(); idx < (size_t)M * SSD_XBC; idx += (size_t)gridDim.x * NT) {
        const int ch = (int)(idx % SSD_XBC), t = (int)(idx / SSD_XBC), s = t % SEQ;
        float acc = cb[ch];
        for (int k = 0; k < 4; ++k) { const int ss = s - 3 + k; if (ss >= 0) acc += cw[k * SSD_XBC + ch] * bf2f(u[(size_t)(t - 3 + k) * NU + OFF_XBC + ch]); }
        xc[idx] = silu_f(acc);
    }
}
__device__ void ph_ssd_seq(const float* DT, const bf16* xc, const float* dt_bias, const float* a_log, const float* d_skip, float* y) {
    for (int item = blockIdx.x; item < NB * SSD_H; item += gridDim.x) {
        const int b = item / SSD_H, h = item % SSD_H, g = h / (SSD_H / SSD_G);
        const int p = tidx() >> 3, nq = tidx() & 7;
        const float a = -expf(a_log[h]), dsk = d_skip[h];
        float st[16];
#pragma unroll
        for (int i = 0; i < 16; ++i) st[i] = 0.f;
        for (int s = 0; s < SEQ; ++s) {
            const size_t t = (size_t)b * SEQ + s;
            const float dt = DT[t * 8 + h];
            const float da = expf(dt * a);
            const float xv = bf2f(xc[t * SSD_XBC + h * SSD_P + p]);
            const float xd = xv * dt;
            const bf16* Bp = xc + t * SSD_XBC + SSD_INNER + g * SSD_N + nq * 16;
            const bf16* Cp = xc + t * SSD_XBC + SSD_INNER + SSD_G * SSD_N + g * SSD_N + nq * 16;
            float acc = 0.f;
#pragma unroll
            for (int i = 0; i < 16; ++i) { st[i] = st[i] * da + xd * bf2f(Bp[i]); acc += bf2f(Cp[i]) * st[i]; }
            acc += __shfl_xor(acc, 1); acc += __shfl_xor(acc, 2); acc += __shfl_xor(acc, 4);
            if (nq == 0) y[t * SSD_INNER + h * SSD_P + p] = acc + dsk * xv;
        }
    }
}
__device__ void ph_rope(float* q, const bf16* u, const int* pos, float* kpe) {
    for (int idx = blockIdx.x * NT + tidx(); idx < M * 9 * 16; idx += gridDim.x * NT) {
        const int i = idx % 16, hh = (idx / 16) % 9, t = idx / (16 * 9);
        const float inv = 1.0f / powf(10000.0f, (float)(2 * i) / 32.0f);
        const float ang = (float)pos[t] * inv;
        float sn, cs; sincosf(ang, &sn, &cs);
        if (hh < 8) {
            float* p = q + (size_t)t * (MLA_H * QK) + hh * QK + NOPE;
            const float x1 = p[i], x2 = p[16 + i];
            p[i] = x1 * cs - x2 * sn; p[16 + i] = x2 * cs + x1 * sn;
        } else {
            const bf16* p = u + (size_t)t * NU + OFF_KR;
            const float x1 = bf2f(p[i]), x2 = bf2f(p[16 + i]);
            kpe[(size_t)t * ROPE + i] = x1 * cs - x2 * sn; kpe[(size_t)t * ROPE + 16 + i] = x2 * cs + x1 * sn;
        }
    }
}
__device__ void ph_attn(const float* q, const float* kv, const float* kpe, float* o) {
    const int lane = tidx() & 63, gw = blockIdx.x * (NT / 64) + (tidx() >> 6), ngw = gridDim.x * (NT / 64);
    for (int item = gw; item < NB * MLA_H * (SEQ / 64); item += ngw) {
        const int qb = (SEQ / 64 - 1) - item / (NB * MLA_H), bh = item % (NB * MLA_H), b = bh / MLA_H, h = bh % MLA_H;
        const int qi = qb * 64 + lane;
        const size_t t = (size_t)b * SEQ + qi;
        float qr[QK];
#pragma unroll
        for (int d = 0; d < QK; ++d) qr[d] = q[t * (MLA_H * QK) + h * QK + d] * 0.10206207261596575f;
        float acc[VD];
#pragma unroll
        for (int d = 0; d < VD; ++d) acc[d] = 0.f;
        float mx = -INFINITY, l = 0.f;
        const int kmax = qb * 64 + 63;
        for (int k = 0; k <= kmax; ++k) {
            const size_t tk = (size_t)b * SEQ + k;
            const float* kn = kv + tk * (MLA_H * 128) + h * 128;
            const float* kp = kpe + tk * ROPE;
            float s = 0.f;
#pragma unroll
            for (int d = 0; d < NOPE; ++d) s += qr[d] * kn[d];
#pragma unroll
            for (int d = 0; d < ROPE; ++d) s += qr[NOPE + d] * kp[d];
            if (k <= qi) {
                const float mn = fmaxf(mx, s);
                const float f = expf(mx - mn), pv = expf(s - mn);
                l = l * f + pv;
#pragma unroll
                for (int d = 0; d < VD; ++d) acc[d] = acc[d] * f + pv * kn[64 + d];
                mx = mn;
            }
        }
        const float il = 1.f / l;
#pragma unroll
        for (int d = 0; d < VD; ++d) o[t * (MLA_H * VD) + h * VD + d] = acc[d] * il;
    }
}
__device__ void ph_moe(float* lds, const float* h2, const float* wgr, const float* bgr, const float* wer, const float* ber,
                       const float* wg, const float* wu, const float* wd, float* y2) {
    const int sb = tidx() >> 8, tid = tidx() & 255;
    float* xs = lds + sb * 2048;
    float* logit = xs + 1024;
    float* hid = xs + 1088;
    int* sel_e = (int*)(xs + 1600);
    float* sel_w = xs + 1604;
    for (int it = blockIdx.x; it < M / 2; it += gridDim.x) {
        const int t = it * 2 + sb;
        __syncthreads();
        for (int i = tid; i < D; i += 256) xs[i] = h2[(size_t)t * D + i];
        __syncthreads();
        {
            const int w = tid >> 6, lane = tid & 63;
            for (int cidx = w * 9; cidx < w * 9 + 9; ++cidx) {
                float s = 0.f;
                for (int k = lane; k < D; k += 64) s += xs[k] * (cidx < 4 ? wgr[k * 4 + cidx] : wer[k * 32 + (cidx - 4)]);
                s = wave_sum(s);
                if (lane == 0) logit[cidx] = s;
            }
        }
        __syncthreads();
        if (tid == 0) {
            float mxv = -INFINITY; int gi = 0;
            for (int i = 0; i < 4; ++i) { const float v = logit[i] + bgr[i]; logit[i] = v; if (v > mxv) { mxv = v; gi = i; } }
            float den = 0.f; for (int i = 0; i < 4; ++i) den += expf(logit[i] - mxv);
            const float gw = 1.f / den;
            float emx = -INFINITY; int i1 = 0;
            for (int i = 0; i < 8; ++i) { const float v = logit[4 + gi * 8 + i] + ber[gi * 8 + i]; logit[4 + gi * 8 + i] = v; if (v > emx) { emx = v; i1 = i; } }
            float e2 = -INFINITY; int i2 = 0;
            for (int i = 0; i < 8; ++i) { const float v = logit[4 + gi * 8 + i]; if (i != i1 && v > e2) { e2 = v; i2 = i; } }
            const float p2 = expf(e2 - emx);
            sel_e[0] = gi * 8 + i1; sel_e[1] = gi * 8 + i2;
            sel_w[0] = gw / (1.f + p2); sel_w[1] = gw * p2 / (1.f + p2);
        }
        __syncthreads();
        for (int k2 = 0; k2 < 2; ++k2) {
            const int e = sel_e[k2];
            const float* G = wg + (size_t)e * D * FF; const float* U = wu + (size_t)e * D * FF;
            float ga = 0.f, ua = 0.f;
            for (int k = 0; k < D; ++k) { ga += xs[k] * G[(size_t)k * FF + tid]; ua += xs[k] * U[(size_t)k * FF + tid]; }
            hid[k2 * FF + tid] = silu_f(ga) * ua * sel_w[k2];
        }
        __syncthreads();
        for (int d = tid; d < D; d += 256) {
            float acc = 0.f;
            for (int k2 = 0; k2 < 2; ++k2) {
                const float* Wd = wd + (size_t)sel_e[k2] * FF * D;
                for (int f = 0; f < FF; ++f) acc += hid[k2 * FF + f] * Wd[(size_t)f * D + d];
            }
            y2[(size_t)t * D + d] = acc;
        }
    }
}


#define LAS __attribute__((address_space(3)))
#define XB_TMO      128
#define XB_XCNT(j)  (256  + 64 * (j))
#define XB_XSUB(j)  (1280 + 64 * (j))
#define XB_XGEN(j)  (2304 + 64 * (j))
#define XB_TOP      3328
#define XB_TOPGEN   3392
#define XCD_BAR_WORDS 3456
#define XB_SPIN_CAP (1u << 18)

__device__ __forceinline__ unsigned xb_ld(unsigned* p)              { return __hip_atomic_load(p, __ATOMIC_RELAXED, __HIP_MEMORY_SCOPE_AGENT); }
__device__ __forceinline__ unsigned xb_add(unsigned* p, unsigned v) { return __hip_atomic_fetch_add(p, v, __ATOMIC_RELAXED, __HIP_MEMORY_SCOPE_AGENT); }
__device__ __forceinline__ unsigned xb_xcc_id() { return (unsigned)__builtin_amdgcn_s_getreg((3 << 11) | 20) & 0xFu; }
#define XB_SPIN(cond, bar) do { unsigned _sp = 0; while (cond) { __builtin_amdgcn_s_sleep(1); \
    if ((++_sp & 255u) == 0u) { if (xb_ld(&(bar)[XB_TMO])) break; if (_sp > XB_SPIN_CAP) { atomicAdd(&(bar)[XB_TMO], 1u); break; } } } } while (0)

struct XcdBarrier {
    unsigned* bar; unsigned x;
    volatile LAS unsigned* st;
};

__device__ __forceinline__ XcdBarrier xcd_barrier_post(unsigned* bar, volatile LAS unsigned* st) {
    XcdBarrier b; b.bar = bar; b.x = xb_xcc_id(); b.st = st;
    if (tidx() == 0) (void)xb_add(&bar[XB_XCNT(b.x)], 1u);
    return b;
}
__device__ __forceinline__ void xcd_barrier_complete(unsigned* bar, unsigned x, unsigned& nloc, unsigned& nx) {
    const unsigned G = gridDim.x * gridDim.y * gridDim.z;
    unsigned sum, cnt, mine, sp = 0u;
    for (;;) {
        sum = 0u; cnt = 0u; mine = 0u;
#pragma unroll
        for (unsigned j = 0; j < 16; ++j) { const unsigned c = xb_ld(&bar[XB_XCNT(j)]); sum += c; cnt += (c > 0u) ? 1u : 0u; mine = (j == x) ? c : mine; }
        if (sum == G) break;
        __builtin_amdgcn_s_sleep(1);
        if ((++sp & 255u) == 0u) { if (xb_ld(&bar[XB_TMO])) break; if (sp > XB_SPIN_CAP) { atomicAdd(&bar[XB_TMO], 1u); break; } }
    }
    nloc = mine > 0u ? mine : 1u; nx = cnt > 0u ? cnt : 1u;
}

__device__ __forceinline__ void xcd_barrier(const XcdBarrier& b) {
    asm volatile("s_waitcnt vmcnt(0)" ::: "memory");
    __syncthreads();
    if (tidx() == 0) {
        unsigned* bar = b.bar;
        __builtin_amdgcn_s_waitcnt(0);
        unsigned nloc = b.st[0], nx = b.st[1];
        if (nloc == 0u) { xcd_barrier_complete(bar, b.x, nloc, nx); b.st[0] = nloc; b.st[1] = nx; }
        const unsigned old = xb_add(&bar[XB_XSUB(b.x)], 1u);
        const unsigned gen = old / nloc;
        if (old + 1u == (gen + 1u) * nloc) {
            __builtin_amdgcn_fence(__ATOMIC_RELEASE, "agent");
            asm volatile("s_waitcnt vmcnt(0)" ::: "memory");
            const unsigned og = xb_add(&bar[XB_TOP], 1u);
            const unsigned tg = og / nx;
            if (og + 1u == (tg + 1u) * nx) xb_add(&bar[XB_TOPGEN], 1u);
            else XB_SPIN(xb_ld(&bar[XB_TOPGEN]) == tg, bar);
            __builtin_amdgcn_fence(__ATOMIC_ACQUIRE, "agent");
            xb_add(&bar[XB_XGEN(b.x)], 1u);
            asm volatile("s_waitcnt vmcnt(0)" ::: "memory");
        } else {
            XB_SPIN(xb_ld(&bar[XB_XGEN(b.x)]) == gen, bar);
            __builtin_amdgcn_fence(__ATOMIC_ACQUIRE, "agent");
            asm volatile("s_waitcnt vmcnt(0)" ::: "memory");
        }
    }
    __syncthreads();
}


constexpr size_t MiB = 1u << 20;
#define WSB(T, off) ((T*)(kargs()->ws + (size_t)(off)))
#define OUTB(T, off) ((T*)((char*)kargs()->out + (size_t)(off)))
#define B_CNT    WSB(int, 4096)
#define B_MOD    WSB(float, 1 * MiB)
#define B_DT     WSB(float, 1 * MiB + 256 * 1024)
#define B_ACS2   WSB(float, 1 * MiB + 768 * 1024)
#define B_WIN    WSB(bf16, 2 * MiB)
#define B_WOUT   WSB(bf16, 6 * MiB)
#define B_WUQ    WSB(bf16, 8 * MiB)
#define B_WUKV   WSB(bf16, 9 * MiB)
#define B_WRT    WSB(float, 9 * MiB + 512 * 1024)
#define B_WGU    WSB(bf16, 10 * MiB)
#define B_WD     WSB(bf16, 42 * MiB)
#define B_HB     WSB(bf16, 58 * MiB)
#define B_YC     WSB(bf16, 58 * MiB)
#define B_H2     WSB(bf16, 58 * MiB)
#define B_U      WSB(bf16, 90 * MiB)
#define B_HG     WSB(bf16, 90 * MiB)
#define B_YP     WSB(bf16, 90 * MiB)
#define B_XT     WSB(bf16, 154 * MiB)
#define B_YB     WSB(bf16, 154 * MiB)
#define B_HID    WSB(bf16, 170 * MiB)
#define B_Q      WSB(bf16, 186 * MiB)
#define B_KF     WSB(bf16, 210 * MiB)
#define B_VT     WSB(bf16, 234 * MiB)
#define B_COS    WSB(float, 250 * MiB)
#define B_SIN    WSB(float, 251 * MiB)
#define B_RTE    WSB(int, 250 * MiB)
#define B_RTS    WSB(int, 250 * MiB + 256 * 1024)
#define B_RTW    WSB(float, 250 * MiB + 512 * 1024)
#define B_TOKROW WSB(int, 250 * MiB + 768 * 1024)
#define B_ROWW   WSB(float, 251 * MiB)
#define B_SSQ    WSB(float, 252 * MiB)
#define B_SSQS   WSB(float, 253 * MiB)
#define B_PREV   OUTB(bf16, 0)
#define B_CQN    OUTB(bf16, 32 * MiB)
#define B_CKVN   OUTB(bf16, 40 * MiB)
#define LDS_TP   ((int*)(lds_raw + 131072 + 1024))

__global__ void __launch_bounds__(NT, 2) mega_fwd(Params P) {
    if (threadIdx.x < 2) ((volatile LAS unsigned*)(lds_raw + WTAB_OFF - 16))[threadIdx.x] = 0u;
    tidx_init();
    float* lds = (float*)lds_raw;
    const XcdBarrier bar = xcd_barrier_post((unsigned*)(kargs()->ws + 16384), (volatile LAS unsigned*)(lds_raw + WTAB_OFF - 16));
#define GSYNC() xcd_barrier(bar)
    ph_prep(lds, B_MOD, B_WIN, B_WOUT, B_WUQ, B_WUKV, B_WGU, B_WD, B_WRT, B_CNT);
    GSYNC();
    ph_prenorm_bf16(IN(0), IN(5), B_MOD, 0 * D, 1 * D, B_HB);
    GSYNC();
    { pg8::Gemm g{B_HB, B_WIN, M, NU, D}; pg8::StaticOrder S; S.init(M, NU, gridDim.x, (int)blockIdx.x);
      pg8::EpiBf16<0> E{B_U, NU};
      pg8::gemm_phase<pg8::EpiBf16<0>, pg8::StaticOrder, true, true>((PG8_LAS unsigned char*)lds_raw, g, S, E); }
    GSYNC();
    ph_prep2(B_U, kargs()->pos, IN(10), IN(11), IN(12), B_CQN, B_CKVN, B_KF, B_COS, B_SIN, B_DT, B_XT);
    GSYNC();
    {
      const int G = gridDim.x, bid = blockIdx.x; const bool split = G >= 128;
      if (!split || bid < 64) { for (int it = bid; it < 64; it += (split ? 64 : G)) ssd::state_sweep((SLAS char*)lds_raw, it >> 3, it & 7, B_XT, B_DT, IN(13), B_ACS2, B_PREV); }
      if (!split || bid >= 64) { const int Gg = split ? G - 64 : G, cg_ = split ? bid - 64 : bid;
        { pg8::Gemm g{B_CQN, B_WUQ, M, 768, QR}; pg8::StaticOrder S; S.init(M, 768, Gg, cg_);
          pg8::EpiQ E{B_Q, B_COS, B_SIN};
          pg8::gemm_phase<pg8::EpiQ, pg8::StaticOrder, true, false>((PG8_LAS unsigned char*)lds_raw, g, S, E); }
        { pg8::Gemm g{B_CKVN, B_WUKV, M, 1024, 256}; pg8::StaticOrder S; S.init(M, 1024, Gg, cg_);
          pg8::EpiKV E{B_KF, B_VT};
          pg8::gemm_phase<pg8::EpiKV, pg8::StaticOrder, true, false>((PG8_LAS unsigned char*)lds_raw, g, S, E); } } }
    GSYNC();
    att::attn_phase((ALAS char*)lds_raw, B_Q, B_KF, B_VT, B_YC, B_SSQ);
    { const int G = gridDim.x, bid = blockIdx.x; const int vcu = (G % 8 == 0) ? (bid % 8) * (G / 8) + bid / 8 : bid;
      for (int u = vcu; u < 256; u += G) ssd::chunk_unit((SLAS char*)lds_raw, u >> 5, (u >> 1) & 15, u & 1, B_XT, B_PREV, B_DT, B_ACS2, IN(14), B_U, B_YC, B_SSQS); }
    GSYNC();
    ph_yc_norm(B_YC, B_SSQS, B_SSQ);
    GSYNC();
    { pg8::Gemm g{B_YC, B_WOUT, M, D, D}; pg8::StaticOrder S; S.init(M, D, gridDim.x, (int)blockIdx.x);
      pg8::EpiBf16<0> E{B_YB, D};
      pg8::gemm_phase<pg8::EpiBf16<0>, pg8::StaticOrder, true, true>((PG8_LAS unsigned char*)lds_raw, g, S, E); }
    GSYNC();
    ph_rowrouter((__attribute__((address_space(3))) float*)lds_raw, B_YB, IN(0), IN(6), IN(7), B_MOD, B_WRT, IN(23), IN(25), kargs()->out, B_H2, B_CNT, B_RTE, B_RTS, B_RTW);
    GSYNC();
    moe_table(LDS_TP, B_CNT);
    ph_gather(LDS_TP, B_H2, B_RTE, B_RTS, B_RTW, B_HG, B_ROWW, B_TOKROW);
    GSYNC();
    { pg8::Gemm g{B_HG, B_WGU, 0, 0, D}; pg8::GroupedOrder S{(const PG8_LAS int*)LDS_TP, 2, (int)gridDim.x, (int)blockIdx.x};
      pg8::EpiGU E{B_HID, B_ROWW};
      pg8::gemm_phase<pg8::EpiGU, pg8::GroupedOrder, true, true>((PG8_LAS unsigned char*)lds_raw, g, S, E); }
    GSYNC();
    { pg8::Gemm g{B_HID, B_WD, 0, 0, FF}; pg8::GroupedOrder S{(const PG8_LAS int*)LDS_TP, 4, (int)gridDim.x, (int)blockIdx.x};
      pg8::EpiDown E{B_YP};
      pg8::gemm_phase<pg8::EpiDown, pg8::GroupedOrder, true, true>((PG8_LAS unsigned char*)lds_raw, g, S, E); }
    GSYNC();
    ph_moe_final(B_YP, B_TOKROW, IN(8), B_MOD, kargs()->out);
}

extern "C" void kernel_launch(void* const* d_in, const int* in_sizes, int n_in, void* d_out, int out_size, void* d_ws, size_t ws_size,
                              hipStream_t stream) {
    static int grid_blocks = 0;
    if (!grid_blocks) {
        int dev = 0, cus = 0, per_cu = 0;
        (void)hipGetDevice(&dev);
        (void)hipDeviceGetAttribute(&cus, hipDeviceAttributeMultiprocessorCount, dev);
        (void)hipFuncSetAttribute((const void*)mega_fwd, hipFuncAttributeMaxDynamicSharedMemorySize, LDS_BYTES);
        (void)hipOccupancyMaxActiveBlocksPerMultiprocessor(&per_cu, (const void*)mega_fwd, NT, LDS_BYTES);
        if (per_cu < 1) { fprintf(stderr, "occupancy query returned %d\n", per_cu); per_cu = 1; }
        grid_blocks = cus * per_cu;
    }
    (void)hipMemsetAsync(d_ws, 0, 65536, stream);
    Params p{};
    for (int i = 0; i < 29; ++i) p.in[i] = (const float*)d_in[i];
    p.pos = (const int*)d_in[2];
    p.out = (float*)d_out;
    p.ws = (char*)d_ws;
    void* args[] = {&p};
    hipError_t e = hipLaunchCooperativeKernel((void*)mega_fwd, dim3(grid_blocks), dim3(NT), args, LDS_BYTES, stream);
    if (e != hipSuccess) fprintf(stderr, "cooperative launch failed: %s (grid %d)\n", hipGetErrorString(e), grid_blocks);
}
```

```cpp
#include <hip/hip_runtime.h>
#include <hip/hip_cooperative_groups.h>
#include <stdint.h>
#include <math.h>
#include <cstdio>
namespace cg = cooperative_groups;

constexpr int D = 1024, NB = 8, SEQ = 2048, M = NB * SEQ;
constexpr int SSD_H = 8, SSD_P = 64, SSD_INNER = 512, SSD_G = 2, SSD_N = 128, SSD_XBC = 1024;
constexpr int MLA_H = 8, NOPE = 64, ROPE = 32, QK = 96, VD = 64, QR = 256, KVR = 128;
constexpr int NIN = 1960;
constexpr int NU = 2048;
constexpr int OFF_Z = 0, OFF_XBC = 512, OFF_CQ = 1536, OFF_CKV = 1792, OFF_KR = 1920, OFF_DT = 1952;
constexpr int NEXP = 32, FF = 256;
constexpr float EPS = 1e-6f;
constexpr int MOE_ITEMS = 32 * 16 * 8 + 32 * 4 * 16;
constexpr int MOE_SPLIT = 3456;
constexpr int NT = 512;
constexpr int LDS_BYTES = 160 * 1024;

typedef unsigned short bf16;
__device__ __forceinline__ float bf2f(bf16 v) { return __uint_as_float((unsigned)v << 16); }
__device__ __forceinline__ unsigned f2bf(float f) { unsigned u = __float_as_uint(f); return (u + 0x7fffu + ((u >> 16) & 1u)) >> 16; }
__device__ __forceinline__ unsigned pk2(float lo, float hi) { return f2bf(lo) | (f2bf(hi) << 16); }
typedef unsigned v4u __attribute__((ext_vector_type(4)));
typedef float f32x4v __attribute__((ext_vector_type(4)));

struct Params {
    const float* in[29];
    const int* pos;
    float* out;
    char* ws;
};

#define RLAS __attribute__((address_space(3)))
__device__ __forceinline__ float dpp_f(float v, int ctrl_sel) {
    const int x = __float_as_int(v); int r;
    if (ctrl_sel == 0) r = __builtin_amdgcn_update_dpp(0, x, 0xB1, 0xF, 0xF, true);
    else if (ctrl_sel == 1) r = __builtin_amdgcn_update_dpp(0, x, 0x1B, 0xF, 0xF, true);
    else if (ctrl_sel == 2) r = __builtin_amdgcn_update_dpp(0, x, 0x141, 0xF, 0xF, true);
    else r = __builtin_amdgcn_update_dpp(0, x, 0x140, 0xF, 0xF, true);
    return __int_as_float(r);
}
__device__ __forceinline__ float wave_sum_valu(float v) {
    v += dpp_f(v, 0); v += dpp_f(v, 1); v += dpp_f(v, 2); v += dpp_f(v, 3);
    { auto rr = __builtin_amdgcn_permlane16_swap(__float_as_uint(v), __float_as_uint(v), false, false); v = __uint_as_float(rr[0]) + __uint_as_float(rr[1]); }
    { auto rr = __builtin_amdgcn_permlane32_swap(__float_as_uint(v), __float_as_uint(v), false, false); v = __uint_as_float(rr[0]) + __uint_as_float(rr[1]); }
    return v;
}
__device__ __forceinline__ float ldf(const float* p) { return *p; }
__device__ __forceinline__ float ldf(const bf16* p) { return bf2f(*p); }
extern __shared__ __attribute__((aligned(16))) unsigned char lds_raw[];
constexpr int WTAB_OFF = 160 * 1024 - 256;
__device__ __forceinline__ int hw_wave_key() { int k; asm volatile("s_getreg_b32 %0, hwreg(HW_REG_HW_ID, 0, 6)" : "=s"(k)); return k; }
__device__ __forceinline__ void tidx_init() { const int key = hw_wave_key(); ((volatile __attribute__((address_space(3))) int*)(lds_raw + WTAB_OFF))[key] = (int)(threadIdx.x >> 6); __syncthreads(); }
__device__ __forceinline__ int tidx() {
    const int key = hw_wave_key();
    int w = ((volatile __attribute__((address_space(3))) int*)(lds_raw + WTAB_OFF))[key];
    w = __builtin_amdgcn_readfirstlane(w);
    unsigned ones = ~0u; asm volatile("" : "+s"(ones));
    int t = w * 64 + (int)__builtin_amdgcn_mbcnt_hi(ones, __builtin_amdgcn_mbcnt_lo(ones, 0u));
    asm volatile("" : "+v"(t)); return t; }
typedef const __attribute__((address_space(4))) Params* KArgs;
__device__ __forceinline__ KArgs kargs() { KArgs p = (KArgs)__builtin_amdgcn_kernarg_segment_ptr(); asm volatile("" : "+s"(p)); return p; }
#define IN(i) (kargs()->in[i])
__device__ __forceinline__ float silu_f(float v) { return v / (1.f + expf(-v)); }
__device__ __forceinline__ float wave_sum(float v) {
#pragma unroll
    for (int o = 32; o > 0; o >>= 1) v += __shfl_xor(v, o);
    return v;
}

namespace pg8 {
#define PG8_LAS __attribute__((address_space(3)))
typedef unsigned short bf16_t;
typedef short bf16x8 __attribute__((ext_vector_type(8)));
typedef float f32x4 __attribute__((ext_vector_type(4)));
typedef unsigned u32x4 __attribute__((ext_vector_type(4)));
constexpr int BM = 256, BK = 64, HALF = 128, HTB = HALF * BK * 2  , STAGE_BYTES = 8 * HTB, NXCD = 8, WGM = 8;

__host__ __device__ __forceinline__ int lds_byte(int r, int c) { const int st = (r >> 4) * 2 + (c >> 5), rr = r & 15, cc = c & 31, ob = rr * 64 + cc * 2; return st * 1024 + (ob ^ (((ob >> 9) & 1) << 5)); }
__host__ __device__ __forceinline__ void stage_rc(int b, int& R, int& C) { const int st = b / 1024, sb = b % 1024, swz = sb ^ (((sb >> 9) & 1) << 5); R = (st >> 1) * 16 + swz / 64; C = (st & 1) * 32 + (swz % 64) / 2; }
__host__ __device__ __forceinline__ int perm32(int rho) { const int n = rho >> 4, i = rho & 15; return 8 * (i >> 2) + 4 * n + (i & 3); }

struct Unit { int pm, pn; };
struct Gemm { const bf16_t* A; const bf16_t* Bt; int M, N, K; };

struct StaticOrder {
    int nM, nN, nwg, G, c;
    __host__ __device__ void init(int M, int N, int G_, int c_) { nM = M / BM; nN = N / BM; nwg = nM * nN; G = G_; c = c_; }
    __host__ __device__ bool next(int i, Unit& u) const {
        const long L = (long)i * G + c; if (L >= nwg) return false;
        int wgid = (int)L; { const int q = nwg / NXCD, r = nwg % NXCD, xcd = wgid % NXCD, off = wgid / NXCD; wgid = (xcd < r ? xcd * (q + 1) : r * (q + 1) + (xcd - r) * q) + off; }
        const int nig = WGM * nN, gid = wgid / nig, fm = gid * WGM, gsz = (nM - fm) < WGM ? (nM - fm) : WGM;
        u.pm = fm + ((wgid % nig) % gsz); u.pn = (wgid % nig) / gsz; return true;
    }
    __device__ __forceinline__ void a_ready(const Unit&) const {}
    __device__ __forceinline__ void done(const Unit&) const {}
};


template <int ACT> struct EpiBf16 {
    static constexpr bool PERM = true, AFTER_DRAIN = false;
    bf16_t* O; int ldc;
    __device__ __forceinline__ void operator()(const f32x4 (&acc)[2][2][4][2], const Unit& u, int wr, int wc, int fr, int fq) const {
        { const int l_ = tidx() & 63; fr = l_ & 15; fq = l_ >> 4; }
        const int row0 = u.pm * BM + wr * 64 + fr; const int col0 = u.pn * BM + wc * 32 + 8 * fq;
#pragma unroll
        for (int ai = 0; ai < 2; ++ai)
#pragma unroll
            for (int m = 0; m < 4; ++m) { bf16_t* rowp = O + (size_t)(row0 + ai * HALF + m * 16) * ldc + col0;
#pragma unroll
                for (int bj = 0; bj < 2; ++bj) { const f32x4 v0 = acc[ai][bj][m][0], v1 = acc[ai][bj][m][1];
                    u32x4 w; w.x = pk2(v0[0], v0[1]); w.y = pk2(v0[2], v0[3]); w.z = pk2(v1[0], v1[1]); w.w = pk2(v1[2], v1[3]);
                    *(u32x4*)(rowp + bj * HALF) = w; } }
    }
};

struct EpiQ {
    static constexpr bool PERM = true, AFTER_DRAIN = false;
    bf16_t* Q; const float* COS; const float* SIN;
    __device__ __forceinline__ void operator()(const f32x4 (&acc)[2][2][4][2], const Unit& u, int wr, int wc, int fr, int fq) const {
        { const int l_ = tidx() & 63; fr = l_ & 15; fq = l_ >> 4; }
        const int row0 = u.pm * BM + wr * 64 + fr;
#pragma unroll
        for (int bj = 0; bj < 2; ++bj) {
            const int colg = u.pn * BM + bj * HALF + wc * 32;
            const bool pe = ((colg >> 5) % 3) == 2;
#pragma unroll
            for (int ai = 0; ai < 2; ++ai)
#pragma unroll
                for (int m = 0; m < 4; ++m) {
                    const int row = row0 + ai * HALF + m * 16;
                    f32x4 v0 = acc[ai][bj][m][0], v1 = acc[ai][bj][m][1];
                    if (pe) {
                        f32x4 w0, w1;
#pragma unroll
                        for (int e = 0; e < 4; ++e) { w0[e] = __shfl_xor(v0[e], 32); w1[e] = __shfl_xor(v1[e], 32); }
                        const f32x4* cp = (const f32x4*)(COS + (size_t)row * 16 + (fq & 1) * 8); const f32x4* sp = (const f32x4*)(SIN + (size_t)row * 16 + (fq & 1) * 8);
                        const f32x4 c0 = cp[0], c1 = cp[1], s0 = sp[0], s1 = sp[1];
                        const float sg = (fq < 2) ? -1.f : 1.f;
                        v0 = v0 * c0 + w0 * s0 * sg; v1 = v1 * c1 + w1 * s1 * sg;
                    }
                    u32x4 w; w.x = pk2(v0[0], v0[1]); w.y = pk2(v0[2], v0[3]); w.z = pk2(v1[0], v1[1]); w.w = pk2(v1[2], v1[3]);
                    *(u32x4*)(Q + (size_t)row * 768 + colg + 8 * fq) = w;
                    if (pe) asm volatile("" ::: "memory");
                }
        }
    }
};
struct EpiKV {
    static constexpr bool PERM = true, AFTER_DRAIN = false;
    bf16_t* KF; bf16_t* VT;
    __device__ __forceinline__ void operator()(const f32x4 (&acc)[2][2][4][2], const Unit& u, int wr, int wc, int fr, int fq) const {
        { const int l_ = tidx() & 63; fr = l_ & 15; fq = l_ >> 4; }
        const int row0 = u.pm * BM + wr * 64 + fr;
#pragma unroll
        for (int bj = 0; bj < 2; ++bj) {
            const int colg = u.pn * BM + bj * HALF + wc * 32; const int h = colg >> 7, j0 = (colg & 127) + 8 * fq;
#pragma unroll
            for (int ai = 0; ai < 2; ++ai)
#pragma unroll
                for (int m = 0; m < 4; ++m) {
                    const int t = row0 + ai * HALF + m * 16; const int b = t >> 11, sq = t & 2047, tile = sq >> 6, key = sq & 63;
                    const size_t base = (size_t)((b * 8 + h) * 32 + tile);
                    bf16_t* dst = (j0 < 64) ? KF + base * 6144 + (j0 >> 3) * 512 + key * 8 : VT + base * 4096 + ((j0 - 64) >> 5) * 2048 + key * 32 + ((j0 - 64) & 31);
                    const f32x4 v0 = acc[ai][bj][m][0], v1 = acc[ai][bj][m][1];
                    u32x4 w; w.x = pk2(v0[0], v0[1]); w.y = pk2(v0[2], v0[3]); w.z = pk2(v1[0], v1[1]); w.w = pk2(v1[2], v1[3]);
                    *(u32x4*)dst = w;
                }
        }
    }
};

struct GroupedOrder {
    const PG8_LAS int* tp; int NCT, G, c;
    __device__ __forceinline__ bool next(int i, Unit& u) const {
        const int L = i * G + c, total = tp[32] * NCT; if (L >= total) return false;
        const int rtg = L / NCT, ct = L - rtg * NCT; int e = 0;
        for (int j = 1; j < 32; ++j) e += (tp[j] <= rtg) ? 1 : 0;
        u.pm = rtg; u.pn = e * NCT + ct; return true;
    }
    __device__ __forceinline__ void a_ready(const Unit&) const {}
    __device__ __forceinline__ void done(const Unit&) const {}
};
struct EpiGU {
    static constexpr bool PERM = true, AFTER_DRAIN = false;
    bf16_t* HID; const float* ROWW;
    __device__ __forceinline__ void operator()(const f32x4 (&acc)[2][2][4][2], const Unit& u, int wr, int wc, int fr, int fq) const {
        { const int l_ = tidx() & 63; fr = l_ & 15; fq = l_ >> 4; }
        const int row0 = u.pm * BM + wr * 64 + fr; const int col0 = (u.pn & 1) * 128 + wc * 32 + 8 * fq;
#pragma unroll
        for (int ai = 0; ai < 2; ++ai)
#pragma unroll
            for (int m = 0; m < 4; ++m) { const int row = row0 + ai * HALF + m * 16; const float w = ROWW[row];
                float hv[8];
#pragma unroll
                for (int n = 0; n < 2; ++n)
#pragma unroll
                    for (int e = 0; e < 4; ++e) { const float g = acc[ai][0][m][n][e], up = acc[ai][1][m][n][e]; hv[4 * n + e] = g * __builtin_amdgcn_rcpf(1.f + __expf(-g)) * up * w; }
                u32x4 o; o.x = pk2(hv[0], hv[1]); o.y = pk2(hv[2], hv[3]); o.z = pk2(hv[4], hv[5]); o.w = pk2(hv[6], hv[7]);
                *(u32x4*)(HID + (size_t)row * 256 + col0) = o; }
    }
};
struct EpiDown {
    static constexpr bool PERM = true, AFTER_DRAIN = false;
    bf16_t* YP;
    __device__ __forceinline__ void operator()(const f32x4 (&acc)[2][2][4][2], const Unit& u, int wr, int wc, int fr, int fq) const {
        { const int l_ = tidx() & 63; fr = l_ & 15; fq = l_ >> 4; }
        const int row0 = u.pm * BM + wr * 64 + fr; const int col0 = (u.pn & 3) * BM + wc * 32 + 8 * fq;
#pragma unroll
        for (int ai = 0; ai < 2; ++ai)
#pragma unroll
            for (int m = 0; m < 4; ++m) { bf16_t* rowp = YP + (size_t)(row0 + ai * HALF + m * 16) * 1024 + col0;
#pragma unroll
                for (int bj = 0; bj < 2; ++bj) { const f32x4 v0 = acc[ai][bj][m][0], v1 = acc[ai][bj][m][1];
                    u32x4 w; w.x = pk2(v0[0], v0[1]); w.y = pk2(v0[2], v0[3]); w.z = pk2(v1[0], v1[1]); w.w = pk2(v1[2], v1[3]);
                    *(u32x4*)(rowp + bj * HALF) = w; } }
    }
};
template <class Epi, class Sched, bool ALIGN_EPI = false, bool SP2 = false>
__device__ __forceinline__ void gemm_phase(PG8_LAS unsigned char* lds, const Gemm g, const Sched& S, const Epi& E) {
    const int tid = tidx(), wid = __builtin_amdgcn_readfirstlane(tid >> 6), lane = tid & 63, wr = wid >> 2, wc = wid & 3, fr = lane & 15, fq = lane >> 4;
    const int K = g.K, nt = K / BK;
    unsigned voffA[2], voffB[2];
#pragma unroll
    for (int i = 0; i < 2; ++i) { int R, C; stage_rc(tid * 16 + i * 8192, R, C); const int Rb = Epi::PERM ? ((R & ~31) + perm32(R & 31)) : R;
        voffA[i] = (unsigned)(R * K + C) * 2u; voffB[i] = (unsigned)(Rb * K + C) * 2u; }
    const size_t kstep = (size_t)(BK * 2);
    const size_t hstep = (size_t)HALF * K * 2;
    const size_t tstep = 2 * hstep;
    const unsigned ldsw = (unsigned)wid * 1024u;
    const int aoff = lds_byte(wr * 64 + fr, fq * 8), boff = lds_byte(wc * 32 + fr, fq * 8);
#define PG8_SA(b, h) (((b) * 2 + (h)) * HTB)
#define PG8_SB(b, h) ((4 + (b) * 2 + (h)) * HTB)
#define PG8_STAGE(bufoff, gbase, voff) do { _Pragma("unroll") for (int _i = 0; _i < 2; ++_i) \
        __builtin_amdgcn_global_load_lds((const unsigned*)((const char*)(gbase) + (voff)[_i]), (PG8_LAS unsigned*)(lds + (bufoff) + ldsw + _i * 8192), 16, 0, 0); } while (0)
#define PG8_LDA(dst, b, h) do { _Pragma("unroll") for (int m = 0; m < 4; ++m) _Pragma("unroll") for (int k = 0; k < 2; ++k) dst[m][k] = *(const PG8_LAS bf16x8*)(lds + PG8_SA(b, h) + aoff + m * 2048 + k * 1024); } while (0)
#define PG8_LDB(dst, b, h) do { _Pragma("unroll") for (int n = 0; n < 2; ++n) _Pragma("unroll") for (int k = 0; k < 2; ++k) dst[n][k] = *(const PG8_LAS bf16x8*)(lds + PG8_SB(b, h) + boff + n * 2048 + k * 1024); } while (0)
#define PG8_MMA(ai, bj, At, Bt) do { __builtin_amdgcn_s_setprio(1); _Pragma("unroll") for (int m = 0; m < 4; ++m) _Pragma("unroll") for (int n = 0; n < 2; ++n) _Pragma("unroll") for (int k = 0; k < 2; ++k) \
        acc[ai][bj][m][n] = __builtin_amdgcn_mfma_f32_16x16x32_bf16(Bt[n][k], At[m][k], acc[ai][bj][m][n], 0, 0, 0); __builtin_amdgcn_s_setprio(0); } while (0)
#define PG8_WAIT_V(n) asm volatile("s_waitcnt vmcnt(" #n ")" ::: "memory")
#define PG8_WAIT_L(n) asm volatile("s_waitcnt lgkmcnt(" #n ")" ::: "memory")
#define PG8_BAR __builtin_amdgcn_s_barrier()
#define PG8_SCHED __builtin_amdgcn_sched_barrier(0)
    Unit cur, nxt; int ui = 0;
    if (!S.next(0, cur)) return;
    f32x4 acc[2][2][4][2];
#pragma unroll
    for (int a = 0; a < 2; ++a)
#pragma unroll
        for (int b = 0; b < 2; ++b)
#pragma unroll
            for (int m = 0; m < 4; ++m)
#pragma unroll
                for (int n = 0; n < 2; ++n) acc[a][b][m][n] = (f32x4){0.f, 0.f, 0.f, 0.f};
    bf16x8 At[4][2], B0[2][2], B1[2][2];
    const char* cA = (const char*)g.A + (size_t)cur.pm * tstep; const char* cB = (const char*)g.Bt + (size_t)cur.pn * tstep;
    S.a_ready(cur);
    if constexpr (SP2) {
        PG8_STAGE(PG8_SB(0, 0), cB, voffB); PG8_STAGE(PG8_SB(0, 1), cB + hstep, voffB); PG8_STAGE(PG8_SA(0, 0), cA, voffA); PG8_STAGE(PG8_SA(0, 1), cA + hstep, voffA);
        if (wr == 1) PG8_BAR;
        PG8_WAIT_V(2); PG8_BAR;
        PG8_STAGE(PG8_SB(1, 0), cB + kstep, voffB); PG8_STAGE(PG8_SA(1, 0), cA + kstep, voffA); PG8_STAGE(PG8_SB(1, 1), cB + hstep + kstep, voffB);
        PG8_WAIT_V(6); PG8_BAR;
    } else {
        PG8_STAGE(PG8_SB(0, 0), cB, voffB); PG8_STAGE(PG8_SA(0, 0), cA, voffA); PG8_STAGE(PG8_SB(0, 1), cB + hstep, voffB); PG8_STAGE(PG8_SA(0, 1), cA + hstep, voffA);
        if (wr == 1) PG8_BAR;
        PG8_WAIT_V(4); PG8_BAR;
        PG8_STAGE(PG8_SB(1, 0), cB + kstep, voffB); PG8_STAGE(PG8_SA(1, 0), cA + kstep, voffA); PG8_STAGE(PG8_SB(1, 1), cB + hstep + kstep, voffB);
        PG8_WAIT_V(6); PG8_BAR;
    }
    for (;;) {
        const bool has_next = S.next(ui + 1, nxt);
        const char* nA = has_next ? (const char*)g.A + (size_t)nxt.pm * tstep : cA; const char* nB = has_next ? (const char*)g.Bt + (size_t)nxt.pn * tstep : cB;
        for (int t = 0; t < nt; t += 2) {
            const bool last = (t == nt - 2);
            const char* a1 = cA + (size_t)(t + 1) * kstep;
            const char* a2 = last ? nA : cA + (size_t)(t + 2) * kstep; const char* b2 = last ? nB : cB + (size_t)(t + 2) * kstep;
            const char* a3 = a2 + kstep; const char* b3 = b2 + kstep;
            if (last && has_next) S.a_ready(nxt);
            if constexpr (SP2) {
            PG8_LDB(B0, 0, 0); PG8_LDB(B1, 0, 1); PG8_SCHED; PG8_LDA(At, 0, 0); PG8_STAGE(PG8_SA(1, 1), a1 + hstep, voffA);
            PG8_WAIT_V(8); PG8_WAIT_L(0); PG8_BAR; PG8_MMA(0, 0, At, B0); PG8_MMA(0, 1, At, B1); PG8_BAR; PG8_SCHED;
            PG8_LDA(At, 0, 1); PG8_STAGE(PG8_SB(0, 0), b2, voffB); PG8_STAGE(PG8_SB(0, 1), b2 + hstep, voffB); PG8_STAGE(PG8_SA(0, 0), a2, voffA);
            PG8_WAIT_V(8); PG8_WAIT_L(0); PG8_BAR; PG8_MMA(1, 0, At, B0); PG8_MMA(1, 1, At, B1); PG8_BAR; PG8_SCHED;
            PG8_LDB(B0, 1, 0); PG8_LDB(B1, 1, 1); PG8_SCHED; PG8_LDA(At, 1, 0); PG8_STAGE(PG8_SA(0, 1), a2 + hstep, voffA);
            PG8_WAIT_V(8); PG8_WAIT_L(0); PG8_BAR; PG8_MMA(0, 0, At, B0); PG8_MMA(0, 1, At, B1); PG8_BAR; PG8_SCHED;
            PG8_LDA(At, 1, 1); PG8_STAGE(PG8_SB(1, 0), b3, voffB); PG8_STAGE(PG8_SB(1, 1), b3 + hstep, voffB); PG8_STAGE(PG8_SA(1, 0), a3, voffA);
            PG8_WAIT_V(8); PG8_WAIT_L(0); PG8_BAR; PG8_MMA(1, 0, At, B0); PG8_MMA(1, 1, At, B1); PG8_BAR; PG8_SCHED;
            } else {
            PG8_LDB(B0, 0, 0); PG8_SCHED; PG8_LDA(At, 0, 0); PG8_STAGE(PG8_SA(1, 1), a1 + hstep, voffA);
            PG8_WAIT_L(8); PG8_BAR; PG8_WAIT_L(0); PG8_MMA(0, 0, At, B0); PG8_BAR; PG8_SCHED;
            PG8_LDB(B1, 0, 1); PG8_STAGE(PG8_SB(0, 0), b2, voffB);
            PG8_BAR; PG8_WAIT_L(0); PG8_MMA(0, 1, At, B1); PG8_BAR;
            PG8_LDA(At, 0, 1); PG8_STAGE(PG8_SA(0, 0), a2, voffA);
            PG8_BAR; PG8_WAIT_L(0); PG8_MMA(1, 0, At, B0); PG8_BAR; PG8_SCHED;
            PG8_STAGE(PG8_SB(0, 1), b2 + hstep, voffB);
            PG8_WAIT_V(6); PG8_BAR; PG8_MMA(1, 1, At, B1); PG8_BAR;
            PG8_LDB(B0, 1, 0); PG8_SCHED; PG8_LDA(At, 1, 0); PG8_STAGE(PG8_SA(0, 1), a2 + hstep, voffA);
            PG8_WAIT_L(8); PG8_BAR; PG8_WAIT_L(0); PG8_MMA(0, 0, At, B0); PG8_BAR; PG8_SCHED;
            PG8_LDB(B1, 1, 1); PG8_STAGE(PG8_SB(1, 0), b3, voffB);
            PG8_BAR; PG8_WAIT_L(0); PG8_MMA(0, 1, At, B1); PG8_BAR;
            PG8_LDA(At, 1, 1); PG8_STAGE(PG8_SA(1, 0), a3, voffA);
            PG8_BAR; PG8_WAIT_L(0); PG8_MMA(1, 0, At, B0); PG8_BAR; PG8_SCHED;
            PG8_STAGE(PG8_SB(1, 1), b3 + hstep, voffB);
            PG8_WAIT_V(6); PG8_BAR; PG8_MMA(1, 1, At, B1); PG8_BAR;
            }
        }
        if constexpr (ALIGN_EPI) { if (wr == 0) PG8_BAR; }
        if constexpr (!Epi::AFTER_DRAIN) { E(acc, cur, wr, wc, fr, fq); S.done(cur); }
        if (!has_next) break;
#pragma unroll
        for (int a = 0; a < 2; ++a)
#pragma unroll
            for (int b = 0; b < 2; ++b)
#pragma unroll
                for (int m = 0; m < 4; ++m)
#pragma unroll
                    for (int n = 0; n < 2; ++n) acc[a][b][m][n] = (f32x4){0.f, 0.f, 0.f, 0.f};
        cur = nxt; cA = nA; cB = nB; ++ui;
        if constexpr (ALIGN_EPI) { if (wr == 1) PG8_BAR; }
    }
    PG8_WAIT_V(0);
    if constexpr (!ALIGN_EPI) { if (wr == 0) PG8_BAR; }
    PG8_BAR;
    if constexpr (Epi::AFTER_DRAIN) { E.fused(acc, cur, wr, wc, fr, fq, lds, wid, lane); S.done(cur); }
#undef PG8_SA
#undef PG8_SB
#undef PG8_STAGE
#undef PG8_LDA
#undef PG8_LDB
#undef PG8_MMA
#undef PG8_WAIT_V
#undef PG8_WAIT_L
#undef PG8_BAR
#undef PG8_SCHED
}
}


template <class GainFn>
__device__ __forceinline__ void transpose_tile(const float* src, int ldsrc, int srccol0  , GainFn gain, bf16* dst, int K, int k0, int n0, int lane) {
    const int r = lane >> 4, c = lane & 15;
    f32x4v v[16];
    if (srccol0 >= 0) {
#pragma unroll
        for (int i = 0; i < 16; ++i) v[i] = *(const f32x4v*)(src + (size_t)(k0 + 4 * i + r) * ldsrc + srccol0 + 4 * c);
    } else {
#pragma unroll
        for (int i = 0; i < 16; ++i) v[i] = (f32x4v){0.f, 0.f, 0.f, 0.f};
    }
    unsigned pk[16][2];
#pragma unroll
    for (int i = 0; i < 16; ++i) {
        unsigned a0 = __float_as_uint(v[i].x), a1 = __float_as_uint(v[i].y), a2 = __float_as_uint(v[i].z), a3 = __float_as_uint(v[i].w);
        { auto t = __builtin_amdgcn_permlane32_swap(a0, a2, false, false); a0 = t[0]; a2 = t[1]; }
        { auto t = __builtin_amdgcn_permlane32_swap(a1, a3, false, false); a1 = t[0]; a3 = t[1]; }
        { auto t = __builtin_amdgcn_permlane16_swap(a0, a1, false, false); a0 = t[0]; a1 = t[1]; }
        { auto t = __builtin_amdgcn_permlane16_swap(a2, a3, false, false); a2 = t[0]; a3 = t[1]; }
        const f32x4v g = gain(k0 + 4 * i);
        pk[i][0] = pk2(__uint_as_float(a0) * g.x, __uint_as_float(a1) * g.y); pk[i][1] = pk2(__uint_as_float(a2) * g.z, __uint_as_float(a3) * g.w);
    }
    bf16* drow = dst + (size_t)(n0 + 4 * c + r) * K + k0;
#pragma unroll
    for (int i = 0; i < 8; ++i) *(v4u*)(drow + 8 * i) = (v4u){pk[2 * i][0], pk[2 * i][1], pk[2 * i + 1][0], pk[2 * i + 1][1]};
}
__device__ __forceinline__ int win_col(int n) {
    if (n < 1536) return n;
    if (n < 1792) return n - 1536 + 1544;
    if (n < 1920) return n - 1792 + 1800;
    if (n < 1952) return n - 1920 + 1928;
    if (n < 1960) return n - 1952 + 1536;
    return -1;
}
template <class GainFn>
__device__ __forceinline__ void transpose_tile_win(const float* src, GainFn gain, bf16* dst, int k0, int n0, int lane) {
    const int r = lane >> 4, c = lane & 15; const int sc = win_col(n0 + 4 * c);
    f32x4v v[16];
#pragma unroll
    for (int i = 0; i < 16; ++i) v[i] = (sc >= 0) ? *(const f32x4v*)(src + (size_t)(k0 + 4 * i + r) * NIN + sc) : (f32x4v){0.f, 0.f, 0.f, 0.f};
    unsigned pk[16][2];
#pragma unroll
    for (int i = 0; i < 16; ++i) {
        unsigned a0 = __float_as_uint(v[i].x), a1 = __float_as_uint(v[i].y), a2 = __float_as_uint(v[i].z), a3 = __float_as_uint(v[i].w);
        { auto t = __builtin_amdgcn_permlane32_swap(a0, a2, false, false); a0 = t[0]; a2 = t[1]; }
        { auto t = __builtin_amdgcn_permlane32_swap(a1, a3, false, false); a1 = t[0]; a3 = t[1]; }
        { auto t = __builtin_amdgcn_permlane16_swap(a0, a1, false, false); a0 = t[0]; a1 = t[1]; }
        { auto t = __builtin_amdgcn_permlane16_swap(a2, a3, false, false); a2 = t[0]; a3 = t[1]; }
        pk[i][0] = pk2(__uint_as_float(a0), __uint_as_float(a1)); pk[i][1] = pk2(__uint_as_float(a2), __uint_as_float(a3));
    }
    bf16* drow = dst + (size_t)(n0 + 4 * c + r) * D + k0;
#pragma unroll
    for (int i = 0; i < 8; ++i) *(v4u*)(drow + 8 * i) = (v4u){pk[2 * i][0], pk[2 * i][1], pk[2 * i + 1][0], pk[2 * i + 1][1]};
}
__device__ void ph_prep(float* lds, float* mod, bf16* WIN_T, bf16* WOUT_T, bf16* WUQ_T, bf16* WUKV_T, float* WRT, bf16* WGU_T, bf16* WD_T) {
    const int tid = tidx(), lane = tid & 63, wave = tid >> 6;
    for (int item = blockIdx.x; item < 6 * D / 32; item += gridDim.x) {
        float* sc = lds;
        float* part = lds + 8 * D;
        const float* c = IN(1); const float* ada_w = IN(3); const float* ada_b = IN(4);
        __syncthreads();
        for (int i = tid; i < NB * D; i += NT) sc[i] = silu_f(c[i]);
        __syncthreads();
        const int kr = lane >> 3, cq = lane & 7; const int j0 = item * 32 + 4 * cq;
        f32x4v acc[NB];
#pragma unroll
        for (int b = 0; b < NB; ++b) acc[b] = (f32x4v){0.f, 0.f, 0.f, 0.f};
#pragma unroll 4
        for (int i = 0; i < 16; ++i) { const int k = wave * 128 + 8 * i + kr;
            const f32x4v w = *(const f32x4v*)(ada_w + (size_t)k * 6 * D + j0);
#pragma unroll
            for (int b = 0; b < NB; ++b) acc[b] += w * sc[b * D + k]; }
#pragma unroll
        for (int b = 0; b < NB; ++b) {
#pragma unroll
            for (int e = 0; e < 4; ++e) { float v = acc[b][e]; v += __shfl_xor(v, 8); v += __shfl_xor(v, 16); v += __shfl_xor(v, 32); acc[b][e] = v; } }
        if (lane < 8) {
#pragma unroll
            for (int b = 0; b < NB; ++b) *(f32x4v*)(part + (wave * NB + b) * 32 + 4 * lane) = acc[b]; }
        __syncthreads();
        if (tid < NB * 32) { const int b = tid >> 5, jj = tid & 31;
            float sm = ada_b[item * 32 + jj];
#pragma unroll
            for (int w = 0; w < 8; ++w) sm += part[(w * NB + b) * 32 + jj];
            mod[b * 6 * D + item * 32 + jj] = sm; }
    }
    __syncthreads();
    for (int i = blockIdx.x * NT + tid; i < 36 * D; i += gridDim.x * NT) { const int c = i >> 10, k = i & 1023;
        WRT[i] = (c < 4) ? IN(22)[k * 4 + c] : IN(24)[k * 32 + c - 4]; }
    const int gw = (gridDim.x - 1 - blockIdx.x) * (NT / 64) + wave, ngw = gridDim.x * (NT / 64);
    constexpr int I_IN = (D / 64) * (NU / 64), I_OUT = (D / 64) * (D / 64), I_UQ = (QR / 64) * (768 / 64), I_UKV = (256 / 64) * (1024 / 64);
    const float* ssd_norm = IN(15); const float* q_norm = IN(16); const float* kv_norm = IN(18); const float* mla_norm = IN(20);
    const auto one4 = [](int) { return (f32x4v){1.f, 1.f, 1.f, 1.f}; };
    constexpr int I_GU = NEXP * (D / 64) * (512 / 64);
    const int moe_lo = (gridDim.x >= 128) ? MOE_SPLIT : 0, n_moe = MOE_ITEMS - moe_lo;
    for (int it = gw; it < n_moe + I_IN + I_OUT + I_UQ + I_UKV; it += ngw) {
        int r = it;
        if (r < n_moe) { r += moe_lo;
            if (r < I_GU) { const int e = r >> 7, q = r & 127, kb = q >> 3, nb = q & 7;
                const int ct = nb >> 2, rr = (nb & 3) * 64; const float* src = (rr < 128 ? IN(26) : IN(27)) + (size_t)e * D * FF;
                transpose_tile(src, FF, 128 * ct + (rr & 127), one4, WGU_T + (size_t)e * 512 * D, D, kb * 64, nb * 64, lane); continue; }
            r -= I_GU;
            { const int e = r >> 6, q = r & 63, kb = q >> 4, nb = q & 15;
              transpose_tile(IN(28) + (size_t)e * FF * D, D, nb * 64, one4, WD_T + (size_t)e * D * FF, FF, kb * 64, nb * 64, lane); continue; } }
        r -= n_moe;
        if (r < I_IN) { const int nb = NU / 64; transpose_tile_win(IN(9), one4, WIN_T, (r / nb) * 64, (r % nb) * 64, lane); continue; }
        r -= I_IN;
        if (r < I_OUT) { const int nb = D / 64; transpose_tile(IN(21), D, (r % nb) * 64, [=](int k) { return k < 512 ? *(const f32x4v*)(ssd_norm + k) : *(const f32x4v*)(mla_norm + k - 512); }, WOUT_T, D, (r / nb) * 64, (r % nb) * 64, lane); continue; }
        r -= I_OUT;
        if (r < I_UQ) { const int nb = 768 / 64; transpose_tile(IN(17), 768, (r % nb) * 64, [=](int k) { return *(const f32x4v*)(q_norm + k) * 0.14724444f; }, WUQ_T, QR, (r / nb) * 64, (r % nb) * 64, lane); continue; }
        r -= I_UQ;
        { const int nb = 1024 / 64, kb = r / nb; transpose_tile(IN(19), 1024, kb < 2 ? (r % nb) * 64 : -1, [=](int k) { return k < KVR ? *(const f32x4v*)(kv_norm + k) : (f32x4v){0.f, 0.f, 0.f, 0.f}; }, WUKV_T, 256, kb * 64, (r % nb) * 64, lane); }
    }
}
__device__ void ph_prep_moe(bf16* WGU_T, bf16* WD_T, int rank, int nw, int it_lo, int it_hi) {
    const int lane = tidx() & 63; rank = __builtin_amdgcn_readfirstlane(rank);
    constexpr int I_GU = NEXP * (D / 64) * (512 / 64), I_DN = NEXP * (FF / 64) * (D / 64);
    const auto one4 = [](int) { return (f32x4v){1.f, 1.f, 1.f, 1.f}; };
    for (int it = it_lo + rank; it < it_hi; it += nw) {
        int r = it;
        if (r < I_GU) { const int e = r >> 7, q = r & 127, kb = q >> 3, nb = q & 7;
            const int ct = nb >> 2, rr = (nb & 3) * 64; const float* src = (rr < 128 ? IN(26) : IN(27)) + (size_t)e * D * FF;
            transpose_tile(src, FF, 128 * ct + (rr & 127), one4, WGU_T + (size_t)e * 512 * D, D, kb * 64, nb * 64, lane); continue; }
        r -= I_GU;
        { const int e = r >> 6, q = r & 63, kb = q >> 4, nb = q & 15;
          transpose_tile(IN(28) + (size_t)e * FF * D, D, nb * 64, one4, WD_T + (size_t)e * D * FF, FF, kb * 64, nb * 64, lane); }
    }
}

__device__ void ph_prenorm_bf16(const float* in, const float* g, const float* mod, int sh_off, int sc_off, bf16* out) {
    const int lane = tidx() & 63, gw = blockIdx.x * (NT / 64) + (tidx() >> 6), ngw = gridDim.x * (NT / 64);
    f32x4v nx[4];
    if (gw < M) { const f32x4v* r = (const f32x4v*)(in + (size_t)gw * D) + lane;
#pragma unroll
        for (int j = 0; j < 4; ++j) nx[j] = r[64 * j]; }
    for (int t = gw; t < M; t += ngw) {
        const int b = t / SEQ;
        f32x4v v[4]; float s = 0.f;
#pragma unroll
        for (int j = 0; j < 4; ++j) { v[j] = nx[j]; s += (v[j].x * v[j].x + v[j].y * v[j].y) + (v[j].z * v[j].z + v[j].w * v[j].w); }
        if (t + ngw < M) { const f32x4v* r = (const f32x4v*)(in + (size_t)(t + ngw) * D) + lane;
#pragma unroll
            for (int j = 0; j < 4; ++j) nx[j] = r[64 * j]; }
        const f32x4v* gp = (const f32x4v*)g + lane; const f32x4v* scp = (const f32x4v*)(mod + b * 6 * D + sc_off) + lane; const f32x4v* shp = (const f32x4v*)(mod + b * 6 * D + sh_off) + lane;
        f32x4v gg[4], sc[4], sh[4];
#pragma unroll
        for (int j = 0; j < 4; ++j) { gg[j] = gp[64 * j]; sc[j] = scp[64 * j]; sh[j] = shp[64 * j]; }
        const float inv = rsqrtf(wave_sum_valu(s) / D + EPS);
        unsigned long long* o8 = (unsigned long long*)(out + (size_t)t * D) + lane;
#pragma unroll
        for (int j = 0; j < 4; ++j) { const f32x4v h = v[j] * inv * gg[j] * (sc[j] + 1.f) + sh[j];
            o8[64 * j] = (unsigned long long)pk2(h.x, h.y) | ((unsigned long long)pk2(h.z, h.w) << 32); }
    }
}


__device__ void ph_prep2(const bf16* U, const int* pos, const float* conv_w, const float* conv_b, const float* dt_bias,
                         bf16* CQN, bf16* CKVN, bf16* KF, float* COS, float* SIN, float* DT, bf16* XC) {
    const int lane = tidx() & 63, gw = blockIdx.x * (NT / 64) + (tidx() >> 6), ngw = gridDim.x * (NT / 64);
    const int rows_per = (M + ngw - 1) / ngw;
    const int ch = lane * 16;
    f32x4v cw[4][4], cbv[4];
#pragma unroll
    for (int k = 0; k < 4; ++k)
#pragma unroll
        for (int q4 = 0; q4 < 4; ++q4) cw[k][q4] = *(const f32x4v*)(conv_w + k * SSD_XBC + ch + 4 * q4);
#pragma unroll
    for (int q4 = 0; q4 < 4; ++q4) cbv[q4] = *(const f32x4v*)(conv_b + ch + 4 * q4);
    const float inv_freq = exp2f(-(float)(lane & 15) * (13.287712379549449f / 16.0f));
    const float dtb = dt_bias[lane & 7];
    const int t_lo = gw * rows_per, t_hi = min((gw + 1) * rows_per, M);
    if (t_lo >= t_hi) return;
    v4u h0[2], h1[2], h2[2];
#define LDX(dst, tt_) do { if (((tt_) & (SEQ - 1)) <= (t_lo & (SEQ - 1)) && (tt_) >= 0 && ((tt_) >> 11) == (t_lo >> 11)) { const v4u* xp_ = (const v4u*)(U + (size_t)(tt_) * NU + OFF_XBC + ch); dst[0] = xp_[0]; dst[1] = xp_[1]; } \
                           else { dst[0] = (v4u){0u, 0u, 0u, 0u}; dst[1] = dst[0]; } } while (0)
    LDX(h0, t_lo - 3); LDX(h1, t_lo - 2); LDX(h2, t_lo - 1);
#undef LDX
    uint2 n_cq; unsigned n_ckv; unsigned short n_k1, n_k2, n_dt; v4u n_x[2]; int n_pos;
#define LDROW(tt_) do { const bf16* ur_ = U + (size_t)(tt_) * NU; n_cq = *(const uint2*)(ur_ + OFF_CQ + lane * 4); n_ckv = *(const unsigned*)(ur_ + OFF_CKV + lane * 2); \
        n_k1 = ur_[OFF_KR + (lane & 15)]; n_k2 = ur_[OFF_KR + 16 + (lane & 15)]; n_dt = ur_[OFF_DT + (lane & 7)]; const v4u* xp_ = (const v4u*)(ur_ + OFF_XBC + ch); n_x[0] = xp_[0]; n_x[1] = xp_[1]; n_pos = pos[tt_]; } while (0)
    LDROW(t_lo);
    for (int t = t_lo; t < t_hi; ++t) {
        const int sq = t & (SEQ - 1), b = t >> 11;
        const uint2 w_cq = n_cq; const unsigned w_ckv = n_ckv; const float x1 = bf2f(n_k1), x2 = bf2f(n_k2), dtr = bf2f(n_dt); const v4u cx0 = n_x[0], cx1 = n_x[1]; const int p_t = n_pos;
        if (t + 1 < t_hi) LDROW(t + 1);
        if (sq == 0) { h0[0] = (v4u){0u, 0u, 0u, 0u}; h0[1] = h0[0]; h1[0] = h0[0]; h1[1] = h0[0]; h2[0] = h0[0]; h2[1] = h0[0]; }
        { const float a0 = __uint_as_float(w_cq.x << 16), a1 = __uint_as_float(w_cq.x & 0xffff0000u), a2 = __uint_as_float(w_cq.y << 16), a3 = __uint_as_float(w_cq.y & 0xffff0000u);
          const float inv = rsqrtf(wave_sum_valu(a0 * a0 + a1 * a1 + a2 * a2 + a3 * a3) * (1.f / QR) + EPS);
          uint2 o; o.x = pk2(a0 * inv, a1 * inv); o.y = pk2(a2 * inv, a3 * inv);
          *(uint2*)(CQN + (size_t)t * QR + lane * 4) = o; }
        { const float a0 = __uint_as_float(w_ckv << 16), a1 = __uint_as_float(w_ckv & 0xffff0000u);
          const float inv = rsqrtf(wave_sum_valu(a0 * a0 + a1 * a1) * (1.f / KVR) + EPS);
          *(unsigned*)(CKVN + (size_t)t * 256 + lane * 2) = pk2(a0 * inv, a1 * inv);
          *(unsigned*)(CKVN + (size_t)t * 256 + 128 + lane * 2) = 0u; }
        { const int i = lane & 15;
          const float ang = (float)p_t * inv_freq;
          const float sn = __sinf(ang), cs = __cosf(ang);
          if (lane < 16) { COS[(size_t)t * 16 + i] = cs; SIN[(size_t)t * 16 + i] = sn; }
          const float r1 = x1 * cs - x2 * sn, r2 = x2 * cs + x1 * sn;
          const int cc = lane & 3, hh = (lane >> 2) & 7;
          float e[8];
#pragma unroll
          for (int j = 0; j < 8; ++j) { const float p1 = __shfl(r1, (cc & 1) * 8 + j), p2 = __shfl(r2, (cc & 1) * 8 + j); e[j] = (cc >> 1) ? p2 : p1; }
          if (lane < 32) { v4u o; o.x = pk2(e[0], e[1]); o.y = pk2(e[2], e[3]); o.z = pk2(e[4], e[5]); o.w = pk2(e[6], e[7]);
            *(v4u*)(KF + (size_t)((b * 8 + hh) * 32 + (sq >> 6)) * 6144 + (8 + cc) * 512 + (sq & 63) * 8) = o; } }
        if (lane < 8) { const float raw = dtr + dtb; DT[(size_t)t * 8 + lane] = raw > 20.f ? raw : log1pf(__expf(raw)); }
        { float acc[16];
#pragma unroll
          for (int q4 = 0; q4 < 4; ++q4) { acc[4 * q4] = cbv[q4].x; acc[4 * q4 + 1] = cbv[q4].y; acc[4 * q4 + 2] = cbv[q4].z; acc[4 * q4 + 3] = cbv[q4].w; }
#define TAP(k_, r_) do { const unsigned xw_[8] = {r_[0].x, r_[0].y, r_[0].z, r_[0].w, r_[1].x, r_[1].y, r_[1].z, r_[1].w}; \
              _Pragma("unroll") for (int q4 = 0; q4 < 4; ++q4) { const f32x4v ww_ = cw[k_][q4]; \
                  acc[4 * q4] += ww_.x * __uint_as_float(xw_[2 * q4] << 16); acc[4 * q4 + 1] += ww_.y * __uint_as_float(xw_[2 * q4] & 0xffff0000u); \
                  acc[4 * q4 + 2] += ww_.z * __uint_as_float(xw_[2 * q4 + 1] << 16); acc[4 * q4 + 3] += ww_.w * __uint_as_float(xw_[2 * q4 + 1] & 0xffff0000u); } } while (0)
          const v4u cur[2] = {cx0, cx1};
          TAP(0, h0); TAP(1, h1); TAP(2, h2); TAP(3, cur);
#undef TAP
          h0[0] = h1[0]; h0[1] = h1[1]; h1[0] = h2[0]; h1[1] = h2[1]; h2[0] = cx0; h2[1] = cx1;
#define SILU(v_) ((v_) * __builtin_amdgcn_rcpf(1.f + __expf(-(v_))))
          v4u o0, o1;
          o0.x = pk2(SILU(acc[0]), SILU(acc[1])); o0.y = pk2(SILU(acc[2]), SILU(acc[3])); o0.z = pk2(SILU(acc[4]), SILU(acc[5])); o0.w = pk2(SILU(acc[6]), SILU(acc[7]));
          o1.x = pk2(SILU(acc[8]), SILU(acc[9])); o1.y = pk2(SILU(acc[10]), SILU(acc[11])); o1.z = pk2(SILU(acc[12]), SILU(acc[13])); o1.w = pk2(SILU(acc[14]), SILU(acc[15]));
#undef SILU
          { bf16* base = XC + (size_t)(t >> 7) * 131072; const int l = t & 127;
            if (ch < 512) { v4u* op = (v4u*)(base + (ch >> 6) * 8192 + ((ch & 63) >> 5) * 4096 + l * 32 + (ch & 31)); op[0] = o0; op[1] = o1; }
            else { const int c2 = ch - 512; bf16* q = base + 65536 + (c2 >> 7) * 16384 + ((c2 & 127) >> 3) * 1024 + l * 8; *(v4u*)q = o0; *(v4u*)(q + 1024) = o1; } } }
    }
#undef LDROW
}


__device__ void ph_rowrouter(RLAS float* ldsf, const bf16* Yb, const float* x, const float* post_gain, const float* pre_gain, const float* mod, const float* WRT,
                             const float* bgr, const float* ber, float* out, bf16* H2, int* CNT, int* RT_E, int* RT_S, float* RT_W) {
    const int tid = tidx(), lane = tid & 63, wave = tid >> 6;
    const int gw = blockIdx.x * (NT / 64) + wave, ngw = gridDim.x * (NT / 64);
    { const f32x4v* src = (const f32x4v*)WRT; RLAS f32x4v* dst = (RLAS f32x4v*)ldsf;
      for (int i = tid; i < 36 * 1024 / 4; i += NT) dst[i] = src[i]; }
    RLAS float* Lg = ldsf + 36 * 1024 + wave * 320;
    __syncthreads();
    const int b0 = lane & 1, b1 = (lane >> 1) & 1, b2 = (lane >> 2) & 1, b3 = (lane >> 3) & 1, b4 = (lane >> 4) & 1, b5 = lane >> 5;
    const int i4 = b0 + 2 * b1, i3 = i4 + 3 * b2, i2 = i3 + 5 * b3;
    const bool colok = (i4 <= 2) && (i3 <= 4) && (i2 <= 8); const int mycol = i2 + 9 * b4 + 18 * b5;
    const int rows_per = (M + ngw - 1) / ngw;
    for (int bi = 0; bi < (rows_per + 7) / 8; ++bi) {
        const int tb = gw * rows_per + 8 * bi; const int nr = max(0, min(8, min((gw + 1) * rows_per, M) - tb));
        uint2 ynx[4]; f32x4v xnx[4];
        if (nr > 0) { const uint2* yp0 = (const uint2*)(Yb + (size_t)tb * D) + lane; const f32x4v* xp0 = (const f32x4v*)(x + (size_t)tb * D) + lane;
#pragma unroll
            for (int j = 0; j < 4; ++j) { ynx[j] = yp0[64 * j]; xnx[j] = xp0[64 * j]; } }
        for (int ri = 0; ri < nr; ++ri) {
            const int t = tb + ri, b = t >> 11;
            f32x4v* op = (f32x4v*)(out + (size_t)t * D) + lane;
            f32x4v y[4], xv[4]; float ssy = 0.f;
#pragma unroll
            for (int j = 0; j < 4; ++j) { const uint2 w = ynx[j]; xv[j] = xnx[j];
                y[j].x = __uint_as_float(w.x << 16); y[j].y = __uint_as_float(w.x & 0xffff0000u); y[j].z = __uint_as_float(w.y << 16); y[j].w = __uint_as_float(w.y & 0xffff0000u);
                ssy += (y[j].x * y[j].x + y[j].y * y[j].y) + (y[j].z * y[j].z + y[j].w * y[j].w); }
            if (ri + 1 < nr) { const uint2* yp1 = (const uint2*)(Yb + (size_t)(t + 1) * D) + lane; const f32x4v* xp1 = (const f32x4v*)(x + (size_t)(t + 1) * D) + lane;
#pragma unroll
                for (int j = 0; j < 4; ++j) { ynx[j] = yp1[64 * j]; xnx[j] = xp1[64 * j]; } }
            const float invy = rsqrtf(wave_sum_valu(ssy) * (1.f / D) + EPS);
            const f32x4v* g1p = (const f32x4v*)(mod + b * 6 * D + 2 * D) + lane; const f32x4v* pgp = (const f32x4v*)post_gain + lane;
            float ss1 = 0.f;
#pragma unroll
            for (int j = 0; j < 4; ++j) { xv[j] = xv[j] + g1p[64 * j] * (y[j] * invy * pgp[64 * j]); op[64 * j] = xv[j];
                ss1 += (xv[j].x * xv[j].x + xv[j].y * xv[j].y) + (xv[j].z * xv[j].z + xv[j].w * xv[j].w); }
            const float inv1 = rsqrtf(wave_sum_valu(ss1) * (1.f / D) + EPS);
            const f32x4v* prp = (const f32x4v*)pre_gain + lane; const f32x4v* scp = (const f32x4v*)(mod + b * 6 * D + 4 * D) + lane; const f32x4v* shp = (const f32x4v*)(mod + b * 6 * D + 3 * D) + lane;
            uint2* hp = (uint2*)(H2 + (size_t)t * D) + lane;
#pragma unroll
            for (int j = 0; j < 4; ++j) { xv[j] = xv[j] * inv1 * prp[64 * j] * (scp[64 * j] + 1.f) + shp[64 * j];
                uint2 o; o.x = pk2(xv[j].x, xv[j].y); o.y = pk2(xv[j].z, xv[j].w); hp[64 * j] = o; }
            const RLAS f32x4v* wl = (const RLAS f32x4v*)ldsf + lane;
#define RDOT(c_) ({ const RLAS f32x4v* wc_ = wl + (c_) * 256; float a_ = 0.f; _Pragma("unroll") for (int j = 0; j < 4; ++j) { const f32x4v w_ = wc_[64 * j]; \
                a_ += (xv[j].x * w_.x + xv[j].y * w_.y) + (xv[j].z * w_.z + xv[j].w * w_.w); } a_; })
            float gl[4];
#pragma unroll
            for (int i = 0; i < 4; ++i) gl[i] = wave_sum_valu(RDOT(i)) + bgr[i];
            int gi = 0; float mxv = gl[0];
#pragma unroll
            for (int i = 1; i < 4; ++i) if (gl[i] > mxv) { mxv = gl[i]; gi = i; }
            gi = __builtin_amdgcn_readfirstlane(gi);
            float den = 0.f;
#pragma unroll
            for (int i = 0; i < 4; ++i) den += expf(gl[i] - mxv);
            float v1 = -INFINITY, v2 = -INFINITY; int i1 = 0, i2 = 0;
#pragma unroll
            for (int i = 0; i < 8; ++i) { const float v = wave_sum_valu(RDOT(4 + gi * 8 + i)) + ber[gi * 8 + i];
                if (v > v1) { v2 = v1; i2 = i1; v1 = v; i1 = i; } else if (v > v2) { v2 = v; i2 = i; } }
#undef RDOT
            const float p2 = expf(v2 - v1), gwt = 1.f / den;
            if (lane == 0) { Lg[ri * 40 + 0] = __int_as_float(gi * 8 + i1); Lg[ri * 40 + 1] = __int_as_float(gi * 8 + i2); Lg[ri * 40 + 2] = gwt / (1.f + p2); Lg[ri * 40 + 3] = gwt * p2 / (1.f + p2); }
        }
        asm volatile("s_waitcnt lgkmcnt(0)" ::: "memory");
        RLAS int* agg = (RLAS int*)(ldsf + 36 * 1024 + 8 * 320);
        if (tid < 32) agg[tid] = 0;
        __syncthreads();
        int e1 = 0, e2 = 0, r1 = 0, r2 = 0; float w1 = 0.f, w2 = 0.f;
        if (lane < nr) {
            const RLAS float* lr = Lg + lane * 40;
            e1 = __float_as_int(lr[0]); e2 = __float_as_int(lr[1]); w1 = lr[2]; w2 = lr[3];
            r1 = __hip_atomic_fetch_add(agg + e1, 1, __ATOMIC_RELAXED, __HIP_MEMORY_SCOPE_WORKGROUP);
            r2 = __hip_atomic_fetch_add(agg + e2, 1, __ATOMIC_RELAXED, __HIP_MEMORY_SCOPE_WORKGROUP);
        }
        __syncthreads();
        if (tid < 32) { const int c = agg[tid]; agg[32 + tid] = c ? atomicAdd(&CNT[tid * 64], c) : 0; }
        __syncthreads();
        if (lane < nr) { const int t = tb + lane;
            RT_E[t] = e1 | (e2 << 8); RT_S[2 * t] = agg[32 + e1] + r1; RT_S[2 * t + 1] = agg[32 + e2] + r2; RT_W[2 * t] = w1; RT_W[2 * t + 1] = w2; }
        __syncthreads();
    }
    __syncthreads();
}
__device__ __forceinline__ void moe_table(int* tp, const int* CNT) {
    const int tid = tidx();
    __syncthreads();
    if (tid < 64) { const int c = (tid < 32) ? __hip_atomic_load(CNT + tid * 64, __ATOMIC_RELAXED, __HIP_MEMORY_SCOPE_AGENT) : 0; int v = (c + 255) >> 8;
        int inc = v;
#pragma unroll
        for (int o = 1; o < 64; o <<= 1) { const int n = __shfl_up(inc, o); if ((tid & 63) >= o) inc += n; }
        if (tid <= 32) tp[tid] = inc - v; }
    __syncthreads();
}
__device__ void ph_gather(int* tp, const bf16* H2, const int* RT_E, const int* RT_S, const float* RT_W, bf16* HG, float* ROWW, int* TOKROW) {
    const int lane = tidx() & 63, gw = blockIdx.x * (NT / 64) + (tidx() >> 6), ngw = gridDim.x * (NT / 64);
    for (int p = gw; p < 2 * M; p += ngw) { const int t = p >> 1, k = p & 1;
        const int e = (RT_E[t] >> (8 * k)) & 255; const int rowd = tp[e] * 256 + RT_S[p];
        const v4u* src = (const v4u*)(H2 + (size_t)t * D) + lane; v4u* dst = (v4u*)(HG + (size_t)rowd * D) + lane;
        dst[0] = src[0]; dst[64] = src[64];
        if (lane == 0) { ROWW[rowd] = RT_W[p]; TOKROW[p] = rowd; } }
}
__device__ void ph_moe_final(const bf16* YP, const int* TOKROW, const float* gain, const float* mod, float* out) {
    const int lane = tidx() & 63, gw = blockIdx.x * (NT / 64) + (tidx() >> 6), ngw = gridDim.x * (NT / 64);
    v4u na[2], nc[2]; f32x4v nxa[2], nxb[2];
#define MF_LOAD(tt_) do { const int r1_ = TOKROW[2 * (tt_)], r2_ = TOKROW[2 * (tt_) + 1]; \
        const v4u* p1_ = (const v4u*)(YP + (size_t)r1_ * D) + lane; const v4u* p2_ = (const v4u*)(YP + (size_t)r2_ * D) + lane; \
        _Pragma("unroll") for (int j = 0; j < 2; ++j) { na[j] = p1_[64 * j]; nc[j] = p2_[64 * j]; const float* op_ = out + (size_t)(tt_) * D + 512 * j + lane * 8; nxa[j] = *(const f32x4v*)op_; nxb[j] = *(const f32x4v*)(op_ + 4); } } while (0)
    if (gw < M) MF_LOAD(gw);
    for (int t = gw; t < M; t += ngw) { const int b = t >> 11;
        float y[16]; float ss = 0.f; f32x4v xa[2], xb[2];
#pragma unroll
        for (int j = 0; j < 2; ++j) { const v4u a = na[j], c = nc[j]; xa[j] = nxa[j]; xb[j] = nxb[j];
#pragma unroll
            for (int e = 0; e < 4; ++e) { const float v0 = __uint_as_float(a[e] << 16) + __uint_as_float(c[e] << 16), v1 = __uint_as_float(a[e] & 0xffff0000u) + __uint_as_float(c[e] & 0xffff0000u);
                y[8 * j + 2 * e] = v0; y[8 * j + 2 * e + 1] = v1; ss += v0 * v0 + v1 * v1; } }
        if (t + ngw < M) MF_LOAD(t + ngw);
        const float inv = rsqrtf(wave_sum_valu(ss) * (1.f / D) + EPS);
#pragma unroll
        for (int j = 0; j < 2; ++j) { const int col = 512 * j + lane * 8; float* op = out + (size_t)t * D + col;
            const f32x4v g2a = *(const f32x4v*)(mod + b * 6 * D + 5 * D + col), g2b = *(const f32x4v*)(mod + b * 6 * D + 5 * D + col + 4);
            const f32x4v ga = *(const f32x4v*)(gain + col), gb = *(const f32x4v*)(gain + col + 4);
            f32x4v a_ = xa[j], b_ = xb[j];
            a_.x += g2a.x * (y[8 * j + 0] * inv * ga.x); a_.y += g2a.y * (y[8 * j + 1] * inv * ga.y); a_.z += g2a.z * (y[8 * j + 2] * inv * ga.z); a_.w += g2a.w * (y[8 * j + 3] * inv * ga.w);
            b_.x += g2b.x * (y[8 * j + 4] * inv * gb.x); b_.y += g2b.y * (y[8 * j + 5] * inv * gb.y); b_.z += g2b.z * (y[8 * j + 6] * inv * gb.z); b_.w += g2b.w * (y[8 * j + 7] * inv * gb.w);
            *(f32x4v*)op = a_; *(f32x4v*)(op + 4) = b_; }
    }
#undef MF_LOAD
}
__device__ void ph_attn_ref(const bf16* Q, const bf16* KF, const bf16* VT, float* o) {
    const int lane = tidx() & 63, gw = blockIdx.x * (NT / 64) + (tidx() >> 6), ngw = gridDim.x * (NT / 64);
    for (int item = gw; item < NB * MLA_H * (SEQ / 64); item += ngw) {
        const int qb = (SEQ / 64 - 1) - item / (NB * MLA_H), bh = item % (NB * MLA_H), b = bh / MLA_H, h = bh % MLA_H;
        const int qi = qb * 64 + lane;
        const size_t t = (size_t)b * SEQ + qi;
        float qr[QK];
#pragma unroll
        for (int d = 0; d < QK; ++d) qr[d] = bf2f(Q[t * 768 + h * QK + d]);
        float acc[VD];
#pragma unroll
        for (int d = 0; d < VD; ++d) acc[d] = 0.f;
        float mx = -INFINITY, l = 0.f;
        const int kmax = qb * 64 + 63;
        for (int k = 0; k <= kmax; ++k) {
            const bf16* kt = KF + (size_t)(bh * 32 + (k >> 6)) * 6144 + (k & 63) * 8;
            const bf16* vt = VT + (size_t)(bh * 32 + (k >> 6)) * 4096 + (k & 63) * 32;
            float s = 0.f;
#pragma unroll
            for (int d = 0; d < QK; ++d) s += qr[d] * bf2f(kt[(d >> 3) * 512 + (d & 7)]);
            if (k <= qi) {
                const float mn = fmaxf(mx, s);
                const float f = exp2f(mx - mn), pv = exp2f(s - mn);
                l = l * f + pv;
#pragma unroll
                for (int d = 0; d < VD; ++d) acc[d] = acc[d] * f + pv * bf2f(vt[(d >> 5) * 2048 + (d & 31)]);
                mx = mn;
            }
        }
        const float il = 1.f / l;
#pragma unroll
        for (int d = 0; d < VD; ++d) o[t * (MLA_H * VD) + h * VD + d] = acc[d] * il;
    }
}

__device__ __forceinline__ void glds16(const void* gsrc, unsigned lds_dst) { unsigned keep;
    asm volatile("s_mov_b32 %0, m0\n\ts_mov_b32 m0, %2\n\ts_nop 0\n\tglobal_load_lds_dwordx4 %1, off\n\ts_mov_b32 m0, %0" : "=&s"(keep) : "v"(gsrc), "s"(lds_dst) : "memory"); }
namespace att {
typedef short bf16x8 __attribute__((ext_vector_type(8)));
typedef short s16x4 __attribute__((ext_vector_type(4)));
typedef float f32x16 __attribute__((ext_vector_type(16)));
typedef unsigned u32x4 __attribute__((ext_vector_type(4)));
#define ALAS __attribute__((address_space(3)))
constexpr int KSLOT = 12288, VSLOT = 8192, NSLOT = 3;
constexpr int LDS_K = 0, LDS_V = NSLOT * KSLOT, LDS_WS = LDS_V + NSLOT * VSLOT, LDS_OST = LDS_WS + 8 * 256, LDS_END = LDS_OST + 8 * 4096;
constexpr float THR = 8.0f;
__device__ __forceinline__ int crow(int r, int hi) { return (r & 3) + 8 * (r >> 2) + 4 * hi; }
__device__ __forceinline__ unsigned cvtpk(float lo, float hi) { typedef float f2 __attribute__((ext_vector_type(2))); typedef __bf16 b2 __attribute__((ext_vector_type(2)));
    f2 v = {lo, hi}; b2 b = __builtin_convertvector(v, b2); return __builtin_bit_cast(unsigned, b); }
__device__ __forceinline__ s16x4 vtr(const ALAS char* p) { typedef short v4 __attribute__((ext_vector_type(4))); return __builtin_bit_cast(s16x4, __builtin_amdgcn_ds_read_tr16_b64_v4i16((ALAS v4*)p)); }
#define AWAIT_BAR(N) asm volatile("s_waitcnt vmcnt(" #N ") lgkmcnt(0)\n\ts_barrier" ::: "memory")

__device__ __forceinline__ void attn_unit(ALAS char* lds, int bh, int qb, const bf16* Q, const bf16* KF, const bf16* VT, bf16* YC, float* SSQ) {
    const int tid = tidx(), lane = tid & 63, r32 = lane & 31, hi = lane >> 5; const int wid = __builtin_amdgcn_readfirstlane(tid >> 6);
    const int b = bh >> 3, h = bh & 7;
    const char* Kt = (const char*)(KF + (size_t)bh * 32 * 6144); const char* Vt = (const char*)(VT + (size_t)bh * 32 * 4096);
    const int NTL = 4 * (qb + 1);
    bf16x8 qf[6];
    { const bf16* qp = Q + (size_t)(b * SEQ + qb * 256 + wid * 32 + r32) * 768 + h * QK + hi * 8;
#pragma unroll
      for (int d0 = 0; d0 < 6; ++d0) qf[d0] = *(const bf16x8*)(qp + d0 * 16); }
    const unsigned koff0 = wid * 1024 + lane * 16, koff1 = (8 + (wid & 3)) * 1024 + lane * 16, voff = wid * 1024 + lane * 16;
    const unsigned lds0 = (unsigned)(uintptr_t)lds;
#define ADMA(t, slot) do { const char* kb_ = Kt + (size_t)(t) * KSLOT; const char* vb_ = Vt + (size_t)(t) * VSLOT; \
        glds16(kb_ + koff0, (unsigned)__builtin_amdgcn_readfirstlane(lds0 + LDS_K + (slot) * KSLOT + wid * 1024)); \
        glds16(kb_ + koff1, (unsigned)__builtin_amdgcn_readfirstlane(lds0 + LDS_K + (slot) * KSLOT + (8 + (wid & 3)) * 1024)); \
        glds16(vb_ + voff, (unsigned)__builtin_amdgcn_readfirstlane(lds0 + LDS_V + (slot) * VSLOT + wid * 1024)); } while (0)
    ADMA(0, 0); ADMA(1, 1);
    ALAS float* wsf = (ALAS float*)(lds + LDS_WS) + wid * 64;
    float mref = 0.f, l = 0.f;
    f32x16 o0 = {}, o1 = {}, negm = {};
    const int qrel = wid * 32 + r32;
    const int vlane = (4 * hi + ((lane & 15) >> 2)) * 64 + ((lane >> 4) & 1) * 32 + (lane & 3) * 8;
    int slot = 0;
#define MX3(a, b, c) __builtin_fmaxf(__builtin_fmaxf((a), (b)), (c))
#define EX2(v) __builtin_amdgcn_exp2f(v)
#define ATT_TILE(MASKED) do { \
        if (t + 1 < NTL) { AWAIT_BAR(3); } else { AWAIT_BAR(0); } \
        if (t + 2 < NTL) { const int s2 = (slot == 0) ? 2 : slot - 1; ADMA(t + 2, s2); } \
        const ALAS char* Ks = lds + LDS_K + slot * KSLOT + hi * 1024 + r32 * 16; \
        const ALAS char* Vs = lds + LDS_V + slot * VSLOT + vlane; \
        f32x16 p0 = negm, p1 = negm; \
        _Pragma("unroll") for (int d0 = 0; d0 < 6; ++d0) { \
            const bf16x8 ka0 = *(const ALAS bf16x8*)(Ks + d0 * 2048), ka1 = *(const ALAS bf16x8*)(Ks + d0 * 2048 + 512); \
            p0 = __builtin_amdgcn_mfma_f32_32x32x16_bf16(ka0, qf[d0], p0, 0, 0, 0); \
            p1 = __builtin_amdgcn_mfma_f32_32x32x16_bf16(ka1, qf[d0], p1, 0, 0, 0); } \
        if (MASKED) { const int jb = t - (NTL - 4); \
            _Pragma("unroll") for (int r = 0; r < 16; ++r) { const int kv = 64 * jb + crow(r, hi); if (kv > qrel) p0[r] = -INFINITY; if (kv + 32 > qrel) p1[r] = -INFINITY; } } \
        float rm; { float a_ = MX3(p0[0], p0[1], p1[0]), b_ = MX3(p0[2], p0[3], p1[1]); a_ = MX3(a_, p1[2], p1[3]); \
            _Pragma("unroll") for (int r = 4; r < 16; r += 4) { a_ = MX3(a_, p0[r], p0[r + 1]); b_ = MX3(b_, p0[r + 2], p0[r + 3]); a_ = MX3(a_, p1[r], p1[r + 1]); b_ = MX3(b_, p1[r + 2], p1[r + 3]); } \
            rm = fmaxf(a_, b_); } \
        { auto rr = __builtin_amdgcn_permlane32_swap(__float_as_uint(rm), __float_as_uint(rm), false, false); rm = fmaxf(__uint_as_float(rr[0]), __uint_as_float(rr[1])); } \
        if (t == 0 || __any(rm > THR)) { \
            const float dl = (t == 0) ? rm : fmaxf(rm, 0.f); \
            mref += dl; \
            _Pragma("unroll") for (int r = 0; r < 16; ++r) { p0[r] -= dl; p1[r] -= dl; } \
            _Pragma("unroll") for (int r = 0; r < 16; ++r) negm[r] = -mref; \
            const float f = EX2(-dl); l *= f; \
            if (t > 0) { \
                if (hi == 0) wsf[r32] = f; \
                asm volatile("s_waitcnt lgkmcnt(0)" ::: "memory"); \
                _Pragma("unroll") for (int r = 0; r < 16; ++r) { const float fr_ = wsf[crow(r, hi)]; o0[r] *= fr_; o1[r] *= fr_; } } } \
        float ls0 = 0.f, ls1 = 0.f; \
        _Pragma("unroll") for (int r = 0; r < 16; ++r) { p0[r] = EX2(p0[r]); p1[r] = EX2(p1[r]); ls0 += p0[r]; ls1 += p1[r]; } \
        l += ls0 + ls1; \
        u32x4 pw0 = {cvtpk(p0[0], p0[1]), cvtpk(p0[2], p0[3]), cvtpk(p0[4], p0[5]), cvtpk(p0[6], p0[7])}; \
        u32x4 pw1 = {cvtpk(p0[8], p0[9]), cvtpk(p0[10], p0[11]), cvtpk(p0[12], p0[13]), cvtpk(p0[14], p0[15])}; \
        u32x4 pw2 = {cvtpk(p1[0], p1[1]), cvtpk(p1[2], p1[3]), cvtpk(p1[4], p1[5]), cvtpk(p1[6], p1[7])}; \
        u32x4 pw3 = {cvtpk(p1[8], p1[9]), cvtpk(p1[10], p1[11]), cvtpk(p1[12], p1[13]), cvtpk(p1[14], p1[15])}; \
        PV_STEP(pw0, 0); PV_STEP(pw1, 1); PV_STEP(pw2, 2); PV_STEP(pw3, 3); \
        slot = (slot == 2) ? 0 : slot + 1; } while (0)
#define PV_STEP(PW, ks) do { const bf16x8 pa_ = __builtin_bit_cast(bf16x8, PW); \
            { const s16x4 a_ = vtr(Vs + (ks) * 1024), b_ = vtr(Vs + (ks) * 1024 + 512); const bf16x8 vf_ = {a_[0], a_[1], a_[2], a_[3], b_[0], b_[1], b_[2], b_[3]}; \
              o0 = __builtin_amdgcn_mfma_f32_32x32x16_bf16(pa_, vf_, o0, 0, 0, 0); } \
            { const s16x4 a_ = vtr(Vs + 4096 + (ks) * 1024), b_ = vtr(Vs + 4096 + (ks) * 1024 + 512); const bf16x8 vf_ = {a_[0], a_[1], a_[2], a_[3], b_[0], b_[1], b_[2], b_[3]}; \
              o1 = __builtin_amdgcn_mfma_f32_32x32x16_bf16(pa_, vf_, o1, 0, 0, 0); } } while (0)
    int t = 0;
    for (; t < NTL - 4; ++t) ATT_TILE(false);
    for (; t < NTL; ++t) ATT_TILE(true);
#undef PV_STEP
#undef ATT_TILE
#undef MX3
#undef EX2
    { auto rr = __builtin_amdgcn_permlane32_swap(__float_as_uint(l), __float_as_uint(l), false, false); l = __uint_as_float(rr[0]) + __uint_as_float(rr[1]); }
    if (hi == 0) wsf[32 + r32] = l;
    asm volatile("s_waitcnt lgkmcnt(0)" ::: "memory");
    ALAS bf16* stg = (ALAS bf16*)(lds + LDS_OST) + wid * 2048;
#pragma unroll
    for (int r = 0; r < 16; ++r) { const int orow = crow(r, hi); const float rl = 1.f / wsf[32 + orow];
        stg[orow * 64 + r32] = (bf16)f2bf(o0[r] * rl); stg[orow * 64 + 32 + r32] = (bf16)f2bf(o1[r] * rl); }
    asm volatile("s_waitcnt lgkmcnt(0)" ::: "memory");
    const size_t trow0 = (size_t)b * SEQ + qb * 256 + wid * 32;
#pragma unroll
    for (int i = 0; i < 4; ++i) { const int row = i * 8 + (lane >> 3), ch = lane & 7;
        const u32x4 v = *(const ALAS u32x4*)(stg + row * 64 + ch * 8);
        *(u32x4*)(YC + (trow0 + row) * 1024 + 512 + h * 64 + ch * 8) = v;
        float sq = 0.f;
#pragma unroll
        for (int e = 0; e < 4; ++e) { const float a = __uint_as_float(v[e] << 16), c = __uint_as_float(v[e] & 0xffff0000u); sq += a * a + c * c; }
        sq += __shfl_xor(sq, 1); sq += __shfl_xor(sq, 2); sq += __shfl_xor(sq, 4);
        if (ch == 0) SSQ[(trow0 + row) * 16 + 8 + h] = sq; }
    asm volatile("s_waitcnt lgkmcnt(0)\n\ts_barrier" ::: "memory");
#undef ADMA
}
__device__ __forceinline__ void attn_phase(ALAS char* lds, const bf16* Q, const bf16* KF, const bf16* VT, bf16* YC, float* SSQ) {
    const int G = gridDim.x, bid = blockIdx.x; const int vcu = (G % 8 == 0) ? (bid % 8) * (G / 8) + bid / 8 : bid;
    for (int p = vcu; p < 256; p += G) { const int bh = p >> 2, s = p & 3;
        attn_unit(lds, bh, 7 - s, Q, KF, VT, YC, SSQ);
        attn_unit(lds, bh, s, Q, KF, VT, YC, SSQ); }
}
#undef AWAIT_BAR
}
__device__ void ph_prenorm(const float* in, const float* g, const float* mod, int sh_off, int sc_off, float* out) {
    const int lane = tidx() & 63, gw = blockIdx.x * (NT / 64) + (tidx() >> 6), ngw = gridDim.x * (NT / 64);
    for (int t = gw; t < M; t += ngw) {
        const int b = t / SEQ; const float* r = in + (size_t)t * D;
        float s = 0.f;
        for (int i = lane; i < D; i += 64) s += r[i] * r[i];
        const float inv = rsqrtf(wave_sum(s) / D + EPS);
        for (int i = lane; i < D; i += 64)
            out[(size_t)t * D + i] = r[i] * inv * g[i] * (1.f + mod[b * 6 * D + sc_off + i]) + mod[b * 6 * D + sh_off + i];
    }
}
template <class TY> __device__ void ph_post(const float* base, const TY* y, const float* g, const float* mod, int gate_off, float* out) {
    const int lane = tidx() & 63, gw = blockIdx.x * (NT / 64) + (tidx() >> 6), ngw = gridDim.x * (NT / 64);
    for (int t = gw; t < M; t += ngw) {
        const int b = t / SEQ; const TY* r = y + (size_t)t * D;
        float s = 0.f;
        for (int i = lane; i < D; i += 64) { const float v = ldf(r + i); s += v * v; }
        const float inv = rsqrtf(wave_sum(s) / D + EPS);
        for (int i = lane; i < D; i += 64)
            out[(size_t)t * D + i] = base[(size_t)t * D + i] + mod[b * 6 * D + gate_off + i] * (ldf(r + i) * inv * g[i]);
    }
}
template <class TI> __device__ void ph_rms_slice(const TI* in, int ldi, int off, int n, const float* g, float* out, int ldo, int ooff) {
    const int lane = tidx() & 63, gw = blockIdx.x * (NT / 64) + (tidx() >> 6), ngw = gridDim.x * (NT / 64);
    for (int t = gw; t < M; t += ngw) {
        const TI* r = in + (size_t)t * ldi + off;
        float s = 0.f;
        for (int i = lane; i < n; i += 64) { const float v = ldf(r + i); s += v * v; }
        const float inv = rsqrtf(wave_sum(s) / n + EPS);
        for (int i = lane; i < n; i += 64) out[(size_t)t * ldo + ooff + i] = ldf(r + i) * inv * g[i];
    }
}

namespace ssd {
typedef short bf16x8 __attribute__((ext_vector_type(8)));
typedef short s16x4 __attribute__((ext_vector_type(4)));
typedef float f32x16 __attribute__((ext_vector_type(16)));
typedef unsigned u32x4 __attribute__((ext_vector_type(4)));
#define SLAS __attribute__((address_space(3)))
constexpr float LOG2E = 1.4426950408889634f;
__device__ __forceinline__ int crow(int r, int hi) { return (r & 3) + 8 * (r >> 2) + 4 * hi; }
__device__ __forceinline__ s16x4 vtr(const SLAS char* p) { typedef short v4 __attribute__((ext_vector_type(4))); return __builtin_bit_cast(s16x4, __builtin_amdgcn_ds_read_tr16_b64_v4i16((SLAS v4*)p)); }
__device__ __forceinline__ unsigned cvtpk(float lo, float hi) { typedef float f2 __attribute__((ext_vector_type(2))); typedef __bf16 b2 __attribute__((ext_vector_type(2)));
    f2 v = {lo, hi}; b2 b = __builtin_convertvector(v, b2); return __builtin_bit_cast(unsigned, b); }
#define SWAIT_BAR(N) asm volatile("s_waitcnt vmcnt(" #N ") lgkmcnt(0)\n\ts_barrier" ::: "memory")
#define SDMA(gsrc, ldst) glds16((gsrc), (unsigned)__builtin_amdgcn_readfirstlane((unsigned)(uintptr_t)(ldst)))

constexpr int SW_BUF = 49152, SW_TAB = 2 * SW_BUF;
__device__ __forceinline__ void state_sweep(SLAS char* lds, int b, int h, const bf16* XT, const float* DT, const float* a_log, float* ACS2, bf16* PREV) {
    const int tid = tidx(), lane = tid & 63, r32 = lane & 31, hi = lane >> 5; const int wid = __builtin_amdgcn_readfirstlane(tid >> 6);
    const int g = h >> 2, pt = wid & 1, nt = wid >> 1;
    const float a = -expf(a_log[h]);
    SLAS float* tab = (SLAS float*)(lds + SW_TAB);
    f32x16 st = {};
    const int trl = (4 * hi + ((lane & 15) >> 2));
    const int trc = 16 * ((lane >> 4) & 1) + 4 * (lane & 3);
#define SW_ISSUE(c_, buf_) do { const char* xs_ = (const char*)(XT + (size_t)(b * 16 + (c_)) * 131072 + h * 8192); const char* bs_ = (const char*)(XT + (size_t)(b * 16 + (c_)) * 131072 + 65536 + g * 16384); \
        _Pragma("unroll") for (int i_ = 0; i_ < 2; ++i_) SDMA(xs_ + (wid * 2 + i_) * 1024 + lane * 16, lds + (buf_) * SW_BUF + (wid * 2 + i_) * 1024); \
        _Pragma("unroll") for (int i_ = 0; i_ < 4; ++i_) SDMA(bs_ + (wid * 4 + i_) * 1024 + lane * 16, lds + (buf_) * SW_BUF + 16384 + (wid * 4 + i_) * 1024); \
        SDMA((const char*)(DT + (size_t)(b * 16 + (c_)) * 128 * 8) + (wid & 3) * 1024 + lane * 16, lds + SW_TAB + 2048 + (buf_) * 4096 + (wid & 3) * 1024); } while (0)
    SW_ISSUE(0, 0);
    for (int c = 0; c < 16; ++c) {
        const int buf = c & 1;
        const size_t t0 = (size_t)(b * 16 + c) * 128;
        if (c + 1 < 16) { SW_ISSUE(c + 1, buf ^ 1); asm volatile("s_waitcnt vmcnt(7)" ::: "memory"); } else { asm volatile("s_waitcnt vmcnt(0)" ::: "memory"); }
        asm volatile("s_barrier" ::: "memory");
        float cdec = 0.f; float cs0 = 0.f, cs1 = 0.f;
        if (wid == 0) {
            const SLAS float* dtl = (const SLAS float*)(lds + SW_TAB + 2048 + buf * 4096);
            const float d0 = dtl[(2 * lane) * 8 + h], d1 = dtl[(2 * lane + 1) * 8 + h];
            const float a0 = d0 * a, a1 = d1 * a; float inc = a0 + a1;
#pragma unroll
            for (int o = 1; o < 64; o <<= 1) { const float n = __shfl_up(inc, o); if (lane >= o) inc += n; }
            const float tot = __shfl(inc, 63); cs1 = inc; cs0 = inc - a1;
            tab[2 * lane] = cs0 * LOG2E; tab[2 * lane + 1] = cs1 * LOG2E;
            tab[128 + 2 * lane] = d0 * expf(tot - cs0); tab[128 + 2 * lane + 1] = d1 * expf(tot - cs1);
            if (lane == 0) tab[256] = expf(tot);
            ACS2[(t0 + 2 * lane) * 8 + h] = cs0 * LOG2E; ACS2[(t0 + 2 * lane + 1) * 8 + h] = cs1 * LOG2E;
        }
        asm volatile("s_waitcnt lgkmcnt(0)\n\ts_barrier" ::: "memory");
        cdec = tab[256];
        { SLAS char* xp = lds + buf * SW_BUF + tid * 32; const int l = (tid >> 1) & 127; const float w = tab[128 + l];
          u32x4 q0 = *(SLAS u32x4*)xp, q1 = *(SLAS u32x4*)(xp + 16);
#pragma unroll
          for (int e = 0; e < 4; ++e) { q0[e] = cvtpk(__uint_as_float(q0[e] << 16) * w, __uint_as_float(q0[e] & 0xffff0000u) * w); q1[e] = cvtpk(__uint_as_float(q1[e] << 16) * w, __uint_as_float(q1[e] & 0xffff0000u) * w); }
          *(SLAS u32x4*)xp = q0; *(SLAS u32x4*)(xp + 16) = q1; }
        asm volatile("s_waitcnt lgkmcnt(0)\n\ts_barrier" ::: "memory");
        f32x16 acc = {};
        { const SLAS char* bb = lds + buf * SW_BUF + 16384 + ((32 * nt + trc) >> 3) * 2048 + ((32 * nt + trc) & 7) * 2 + trl * 16;
          const SLAS char* xb = lds + buf * SW_BUF + pt * 8192 + trl * 64 + trc * 2;
#pragma unroll
          for (int ks = 0; ks < 8; ++ks) {
              const s16x4 a0 = vtr(bb + ks * 256), a1 = vtr(bb + ks * 256 + 128); const s16x4 x0 = vtr(xb + ks * 1024), x1 = vtr(xb + ks * 1024 + 512);
              const bf16x8 af = {a0[0], a0[1], a0[2], a0[3], a1[0], a1[1], a1[2], a1[3]}, xf = {x0[0], x0[1], x0[2], x0[3], x1[0], x1[1], x1[2], x1[3]};
              acc = __builtin_amdgcn_mfma_f32_32x32x16_bf16(af, xf, acc, 0, 0, 0); } }
        { bf16* pv = PREV + (size_t)((b * 16 + c) * 8 + h) * 8192 + (32 * pt + r32) * 8 + 4 * hi;
#pragma unroll
          for (int rg = 0; rg < 4; ++rg) { uint2 o; o.x = cvtpk(st[4 * rg], st[4 * rg + 1]); o.y = cvtpk(st[4 * rg + 2], st[4 * rg + 3]); *(uint2*)(pv + (4 * nt + rg) * 512) = o; } }
#pragma unroll
        for (int r = 0; r < 16; ++r) st[r] = st[r] * cdec + acc[r];
        asm volatile("s_waitcnt lgkmcnt(0)\n\ts_barrier" ::: "memory");
    }
#undef SW_ISSUE
}

constexpr int P2_C = 0, P2_B = 32768, P2_XP = 65536, P2_TAB = 131072, P2_STG = 135168, P2_END = 151552;
__device__ __forceinline__ void chunk_unit(SLAS char* lds, int b, int c, int g, const bf16* XT, const bf16* PREV, const float* DT, const float* ACS2, const float* d_skip,
                                           const bf16* U, bf16* YC, float* SSQS) {
    const int tid = tidx(), lane = tid & 63, r32 = lane & 31, hi = lane >> 5; const int wid = __builtin_amdgcn_readfirstlane(tid >> 6);
    const int lb = wid >> 1, ph = wid & 1;
    const char* xt = (const char*)(XT + (size_t)(b * 16 + c) * 131072);
    const size_t t0 = (size_t)(b * 16 + c) * 128;
#pragma unroll
    for (int i = 0; i < 4; ++i) { SDMA(xt + (98304 + g * 16384) * 2 + (wid * 4 + i) * 1024 + lane * 16, lds + P2_C + (wid * 4 + i) * 1024);
                                  SDMA(xt + (65536 + g * 16384) * 2 + (wid * 4 + i) * 1024 + lane * 16, lds + P2_B + (wid * 4 + i) * 1024); }
#define P2_ISSUE(hh_) do { const int h_ = 4 * g + (hh_); const char* xs_ = xt + h_ * 16384; const char* ps_ = (const char*)(PREV + (size_t)((b * 16 + c) * 8 + h_) * 8192); \
        SLAS char* d_ = lds + P2_XP + ((hh_) & 1) * 32768; \
        _Pragma("unroll") for (int i_ = 0; i_ < 2; ++i_) { SDMA(xs_ + (wid * 2 + i_) * 1024 + lane * 16, d_ + (wid * 2 + i_) * 1024); SDMA(ps_ + (wid * 2 + i_) * 1024 + lane * 16, d_ + 16384 + (wid * 2 + i_) * 1024); } } while (0)
    P2_ISSUE(0);
    { SLAS float* tab = (SLAS float*)(lds + P2_TAB); const int hh = tid >> 7, l = tid & 127;
      tab[hh * 256 + l] = ACS2[(t0 + l) * 8 + 4 * g + hh]; tab[hh * 256 + 128 + l] = DT[(t0 + l) * 8 + 4 * g + hh]; }
    P2_ISSUE(1);
    SWAIT_BAR(4);
    bf16x8 cf[8];
#pragma unroll
    for (int ks = 0; ks < 8; ++ks) cf[ks] = *(const SLAS bf16x8*)(lds + P2_C + (2 * ks + hi) * 2048 + (32 * lb + r32) * 16);
    f32x16 cbt[4];
#pragma unroll
    for (int sb = 0; sb < 4; ++sb) { cbt[sb] = f32x16{};
        if (sb <= lb) {
#pragma unroll
            for (int ks = 0; ks < 8; ++ks) { const bf16x8 bfr = *(const SLAS bf16x8*)(lds + P2_B + (2 * ks + hi) * 2048 + (32 * sb + r32) * 16);
                cbt[sb] = __builtin_amdgcn_mfma_f32_32x32x16_bf16(bfr, cf[ks], cbt[sb], 0, 0, 0); } } }
    const int vlane = (4 * hi + ((lane & 15) >> 2)) * 64 + ((lane >> 4) & 1) * 32 + (lane & 3) * 8;
    const int lrow = 32 * lb + r32;
    for (int hh = 0; hh < 4; ++hh) {
        const int h = 4 * g + hh;
        const SLAS char* xb = lds + P2_XP + (hh & 1) * 32768; const SLAS char* pb = xb + 16384;
        const SLAS float* tab = (const SLAS float*)(lds + P2_TAB) + hh * 256;
        const float dsk = d_skip[h];
        u32x4 zpre[2];
#pragma unroll
        for (int i = 0; i < 2; ++i) zpre[i] = *(const u32x4*)(U + (t0 + 32 * lb + i * 16 + (lane >> 2)) * NU + OFF_Z + h * 64 + 32 * ph + 8 * (lane & 3));
        f32x16 o = {};
#pragma unroll
        for (int ks = 0; ks < 8; ++ks) { const bf16x8 pf = *(const SLAS bf16x8*)(pb + (2 * ks + hi) * 1024 + (32 * ph + r32) * 16);
            o = __builtin_amdgcn_mfma_f32_32x32x16_bf16(cf[ks], pf, o, 0, 0, 0); }
#pragma unroll
        for (int r = 0; r < 16; ++r) o[r] *= exp2f(tab[32 * lb + crow(r, hi)]);
        const float al = tab[lrow];
#pragma unroll
        for (int sb = 0; sb < 4; ++sb) {
            if (sb <= lb) {
                float pr[16];
#pragma unroll
                for (int r = 0; r < 16; ++r) { const int sidx = 32 * sb + crow(r, hi);
                    float v = cbt[sb][r] * exp2f(al - tab[sidx]) * tab[128 + sidx];
                    if (sb == lb) { v = (sidx <= lrow) ? v : 0.f; v += (sidx == lrow) ? dsk : 0.f; }
                    pr[r] = v; }
                const u32x4 pw0 = {cvtpk(pr[0], pr[1]), cvtpk(pr[2], pr[3]), cvtpk(pr[4], pr[5]), cvtpk(pr[6], pr[7])};
                const u32x4 pw1 = {cvtpk(pr[8], pr[9]), cvtpk(pr[10], pr[11]), cvtpk(pr[12], pr[13]), cvtpk(pr[14], pr[15])};
                const SLAS char* xv = xb + ph * 8192 + vlane + (2 * sb) * 1024;
                { const s16x4 a_ = vtr(xv), b_ = vtr(xv + 512); const bf16x8 vf = {a_[0], a_[1], a_[2], a_[3], b_[0], b_[1], b_[2], b_[3]};
                  o = __builtin_amdgcn_mfma_f32_32x32x16_bf16(__builtin_bit_cast(bf16x8, pw0), vf, o, 0, 0, 0); }
                { const s16x4 a_ = vtr(xv + 1024), b_ = vtr(xv + 1024 + 512); const bf16x8 vf = {a_[0], a_[1], a_[2], a_[3], b_[0], b_[1], b_[2], b_[3]};
                  o = __builtin_amdgcn_mfma_f32_32x32x16_bf16(__builtin_bit_cast(bf16x8, pw1), vf, o, 0, 0, 0); }
            }
        }
        SLAS bf16* stg = (SLAS bf16*)(lds + P2_STG) + wid * 1024;
#pragma unroll
        for (int r = 0; r < 16; ++r) stg[crow(r, hi) * 32 + r32] = (bf16)f2bf(o[r]);
        asm volatile("s_waitcnt lgkmcnt(0)" ::: "memory");
#pragma unroll
        for (int i = 0; i < 2; ++i) { const int row = i * 16 + (lane >> 2), ch = lane & 3; const size_t t = t0 + 32 * lb + row;
            const u32x4 ov = *(const SLAS u32x4*)(stg + row * 32 + ch * 8);
            const u32x4 zv = zpre[i];
            u32x4 w; float sq = 0.f;
#pragma unroll
            for (int e = 0; e < 4; ++e) { const float z0 = __uint_as_float(zv[e] << 16), z1 = __uint_as_float(zv[e] & 0xffff0000u);
                const float v0 = __uint_as_float(ov[e] << 16) * (z0 * __builtin_amdgcn_rcpf(1.f + __expf(-z0))), v1 = __uint_as_float(ov[e] & 0xffff0000u) * (z1 * __builtin_amdgcn_rcpf(1.f + __expf(-z1)));
                w[e] = cvtpk(v0, v1); const float r0 = __uint_as_float(w[e] << 16), r1 = __uint_as_float(w[e] & 0xffff0000u); sq += r0 * r0 + r1 * r1; }
            *(u32x4*)(YC + t * 1024 + h * 64 + 32 * ph + 8 * ch) = w;
            sq += __shfl_xor(sq, 1); sq += __shfl_xor(sq, 2);
            if (ch == 0) SSQS[t * 16 + h * 2 + ph] = sq; }
        if (hh < 3) {
            if (hh + 2 < 4) { asm volatile("s_waitcnt lgkmcnt(0)\n\ts_barrier" ::: "memory"); P2_ISSUE(hh + 2); SWAIT_BAR(4); }
            else { SWAIT_BAR(0); }
        }
    }
    asm volatile("s_waitcnt vmcnt(0) lgkmcnt(0)\n\ts_barrier" ::: "memory");
#undef P2_ISSUE
}
#undef SWAIT_BAR
#undef SDMA
}
__device__ void ph_gate_norm(const float* y, const bf16* u, bf16* YC) {
    const int lane = tidx() & 63, gw = blockIdx.x * (NT / 64) + (tidx() >> 6), ngw = gridDim.x * (NT / 64);
    for (int t = gw; t < M; t += ngw) {
        float v[8]; float s = 0.f;
#pragma unroll
        for (int j = 0; j < 8; ++j) { const int i = lane + 64 * j; v[j] = y[(size_t)t * SSD_INNER + i] * silu_f(bf2f(u[(size_t)t * NU + OFF_Z + i])); s += v[j] * v[j]; }
        const float inv = rsqrtf(wave_sum(s) / SSD_INNER + EPS);
#pragma unroll
        for (int j = 0; j < 8; ++j) YC[(size_t)t * 1024 + lane + 64 * j] = (bf16)f2bf(v[j] * inv);
    }
}
__device__ void ph_yc_norm(bf16* YC, const float* SSQS, const float* SSQ) {
    const int lane = tidx() & 63, gw = blockIdx.x * (NT / 64) + (tidx() >> 6), ngw = gridDim.x * (NT / 64);
    v4u nw0 = {0u, 0u, 0u, 0u}, nw1 = nw0;
    if (gw < M) { const v4u* p = (const v4u*)(YC + (size_t)gw * 1024) + lane; nw0 = p[0]; nw1 = p[64]; }
    for (int t = gw; t < M; t += ngw) {
        float ss = 0.f, sm = 0.f;
#pragma unroll
        for (int q = 0; q < 4; ++q) { const f32x4v a = *(const f32x4v*)(SSQS + (size_t)t * 16 + 4 * q); ss += (a.x + a.y) + (a.z + a.w); }
        { const f32x4v a = *(const f32x4v*)(SSQ + (size_t)t * 16 + 8), b = *(const f32x4v*)(SSQ + (size_t)t * 16 + 12); sm = (a.x + a.y) + (a.z + a.w) + (b.x + b.y) + (b.z + b.w); }
        v4u w0 = nw0, w1 = nw1;
        if (t + ngw < M) { const v4u* p = (const v4u*)(YC + (size_t)(t + ngw) * 1024) + lane; nw0 = p[0]; nw1 = p[64]; }
        const float invs = rsqrtf(ss * (1.f / 512.f) + EPS), invm = rsqrtf(sm * (1.f / 512.f) + EPS);
        v4u* p = (v4u*)(YC + (size_t)t * 1024) + lane;
#pragma unroll
        for (int e = 0; e < 4; ++e) { w0[e] = pk2(__uint_as_float(w0[e] << 16) * invs, __uint_as_float(w0[e] & 0xffff0000u) * invs); w1[e] = pk2(__uint_as_float(w1[e] << 16) * invm, __uint_as_float(w1[e] & 0xffff0000u) * invm); }
        p[0] = w0; p[64] = w1;
    }
}
__device__ void ph_gemm(float* lds, const float* A, int lda, const float* B, int ldb, float* C, int ldc, int Mr, int N, int K) {
    float (*As)[129] = (float (*)[129])lds;
    float (*Bs)[65] = (float (*)[65])(lds + 16 * 129);
    const int tx = tidx() & 15, ty = tidx() >> 4;
    const int ntn = (N + 63) / 64, ntm = Mr / 128;
    for (int tile = blockIdx.x; tile < ntn * ntm; tile += gridDim.x) {
        const int m0 = (tile / ntn) * 128, n0 = (tile % ntn) * 64;
        float acc[4][4] = {};
        for (int k0 = 0; k0 < K; k0 += 16) {
            for (int i = tidx(); i < 128 * 16; i += NT) { const int r = i >> 4, kk = i & 15; As[kk][r] = A[(size_t)(m0 + r) * lda + k0 + kk]; }
            for (int i = tidx(); i < 64 * 16; i += NT) { const int kk = i >> 6, cc = i & 63; Bs[kk][cc] = (n0 + cc < N) ? B[(size_t)(k0 + kk) * ldb + n0 + cc] : 0.f; }
            __syncthreads();
#pragma unroll
            for (int kk = 0; kk < 16; ++kk) {
                float a[4], b[4];
#pragma unroll
                for (int i = 0; i < 4; ++i) { a[i] = As[kk][ty * 4 + i]; b[i] = Bs[kk][tx * 4 + i]; }
#pragma unroll
                for (int i = 0; i < 4; ++i)
#pragma unroll
                    for (int j = 0; j < 4; ++j) acc[i][j] += a[i] * b[j];
            }
            __syncthreads();
        }
#pragma unroll
        for (int i = 0; i < 4; ++i)
#pragma unroll
            for (int j = 0; j < 4; ++j) { const int n = n0 + tx * 4 + j; if (n < N) C[(size_t)(m0 + ty * 4 + i) * ldc + n] = acc[i][j]; }
    }
}
__device__ void ph_conv(const bf16* u, const float* cw, const float* cb, float* xc) {
    for (size_t idx = (size_t)blockIdx.x * NT + tidx(); idx < (size_t)M * SSD_XBC; idx += (size_t)gridDim.x * NT) {
        const int ch = (int)(idx % SSD_XBC), t = (int)(idx / SSD_XBC), s = t % SEQ;
        float acc = cb[ch];
        for (int k = 0; k < 4; ++k) { const int ss = s - 3 + k; if (ss >= 0) acc += cw[k * SSD_XBC + ch] * bf2f(u[(size_t)(t - 3 + k) * NU + OFF_XBC + ch]); }
        xc[idx] = silu_f(acc);
    }
}
__device__ void ph_ssd_seq(const float* DT, const bf16* xc, const float* dt_bias, const float* a_log, const float* d_skip, float* y) {
    for (int item = blockIdx.x; item < NB * SSD_H; item += gridDim.x) {
        const int b = item / SSD_H, h = item % SSD_H, g = h / (SSD_H / SSD_G);
        const int p = tidx() >> 3, nq = tidx() & 7;
        const float a = -expf(a_log[h]), dsk = d_skip[h];
        float st[16];
#pragma unroll
        for (int i = 0; i < 16; ++i) st[i] = 0.f;
        for (int s = 0; s < SEQ; ++s) {
            const size_t t = (size_t)b * SEQ + s;
            const float dt = DT[t * 8 + h];
            const float da = expf(dt * a);
            const float xv = bf2f(xc[t * SSD_XBC + h * SSD_P + p]);
            const float xd = xv * dt;
            const bf16* Bp = xc + t * SSD_XBC + SSD_INNER + g * SSD_N + nq * 16;
            const bf16* Cp = xc + t * SSD_XBC + SSD_INNER + SSD_G * SSD_N + g * SSD_N + nq * 16;
            float acc = 0.f;
#pragma unroll
            for (int i = 0; i < 16; ++i) { st[i] = st[i] * da + xd * bf2f(Bp[i]); acc += bf2f(Cp[i]) * st[i]; }
            acc += __shfl_xor(acc, 1); acc += __shfl_xor(acc, 2); acc += __shfl_xor(acc, 4);
            if (nq == 0) y[t * SSD_INNER + h * SSD_P + p] = acc + dsk * xv;
        }
    }
}
__device__ void ph_rope(float* q, const bf16* u, const int* pos, float* kpe) {
    for (int idx = blockIdx.x * NT + tidx(); idx < M * 9 * 16; idx += gridDim.x * NT) {
        const int i = idx % 16, hh = (idx / 16) % 9, t = idx / (16 * 9);
        const float inv = 1.0f / powf(10000.0f, (float)(2 * i) / 32.0f);
        const float ang = (float)pos[t] * inv;
        float sn, cs; sincosf(ang, &sn, &cs);
        if (hh < 8) {
            float* p = q + (size_t)t * (MLA_H * QK) + hh * QK + NOPE;
            const float x1 = p[i], x2 = p[16 + i];
            p[i] = x1 * cs - x2 * sn; p[16 + i] = x2 * cs + x1 * sn;
        } else {
            const bf16* p = u + (size_t)t * NU + OFF_KR;
            const float x1 = bf2f(p[i]), x2 = bf2f(p[16 + i]);
            kpe[(size_t)t * ROPE + i] = x1 * cs - x2 * sn; kpe[(size_t)t * ROPE + 16 + i] = x2 * cs + x1 * sn;
        }
    }
}
__device__ void ph_attn(const float* q, const float* kv, const float* kpe, float* o) {
    const int lane = tidx() & 63, gw = blockIdx.x * (NT / 64) + (tidx() >> 6), ngw = gridDim.x * (NT / 64);
    for (int item = gw; item < NB * MLA_H * (SEQ / 64); item += ngw) {
        const int qb = (SEQ / 64 - 1) - item / (NB * MLA_H), bh = item % (NB * MLA_H), b = bh / MLA_H, h = bh % MLA_H;
        const int qi = qb * 64 + lane;
        const size_t t = (size_t)b * SEQ + qi;
        float qr[QK];
#pragma unroll
        for (int d = 0; d < QK; ++d) qr[d] = q[t * (MLA_H * QK) + h * QK + d] * 0.10206207261596575f;
        float acc[VD];
#pragma unroll
        for (int d = 0; d < VD; ++d) acc[d] = 0.f;
        float mx = -INFINITY, l = 0.f;
        const int kmax = qb * 64 + 63;
        for (int k = 0; k <= kmax; ++k) {
            const size_t tk = (size_t)b * SEQ + k;
            const float* kn = kv + tk * (MLA_H * 128) + h * 128;
            const float* kp = kpe + tk * ROPE;
            float s = 0.f;
#pragma unroll
            for (int d = 0; d < NOPE; ++d) s += qr[d] * kn[d];
#pragma unroll
            for (int d = 0; d < ROPE; ++d) s += qr[NOPE + d] * kp[d];
            if (k <= qi) {
                const float mn = fmaxf(mx, s);
                const float f = expf(mx - mn), pv = expf(s - mn);
                l = l * f + pv;
#pragma unroll
                for (int d = 0; d < VD; ++d) acc[d] = acc[d] * f + pv * kn[64 + d];
                mx = mn;
            }
        }
        const float il = 1.f / l;
#pragma unroll
        for (int d = 0; d < VD; ++d) o[t * (MLA_H * VD) + h * VD + d] = acc[d] * il;
    }
}
__device__ void ph_moe(float* lds, const float* h2, const float* wgr, const float* bgr, const float* wer, const float* ber,
                       const float* wg, const float* wu, const float* wd, float* y2) {
    const int sb = tidx() >> 8, tid = tidx() & 255;
    float* xs = lds + sb * 2048;
    float* logit = xs + 1024;
    float* hid = xs + 1088;
    int* sel_e = (int*)(xs + 1600);
    float* sel_w = xs + 1604;
    for (int it = blockIdx.x; it < M / 2; it += gridDim.x) {
        const int t = it * 2 + sb;
        __syncthreads();
        for (int i = tid; i < D; i += 256) xs[i] = h2[(size_t)t * D + i];
        __syncthreads();
        {
            const int w = tid >> 6, lane = tid & 63;
            for (int cidx = w * 9; cidx < w * 9 + 9; ++cidx) {
                float s = 0.f;
                for (int k = lane; k < D; k += 64) s += xs[k] * (cidx < 4 ? wgr[k * 4 + cidx] : wer[k * 32 + (cidx - 4)]);
                s = wave_sum(s);
                if (lane == 0) logit[cidx] = s;
            }
        }
        __syncthreads();
        if (tid == 0) {
            float mxv = -INFINITY; int gi = 0;
            for (int i = 0; i < 4; ++i) { const float v = logit[i] + bgr[i]; logit[i] = v; if (v > mxv) { mxv = v; gi = i; } }
            float den = 0.f; for (int i = 0; i < 4; ++i) den += expf(logit[i] - mxv);
            const float gw = 1.f / den;
            float emx = -INFINITY; int i1 = 0;
            for (int i = 0; i < 8; ++i) { const float v = logit[4 + gi * 8 + i] + ber[gi * 8 + i]; logit[4 + gi * 8 + i] = v; if (v > emx) { emx = v; i1 = i; } }
            float e2 = -INFINITY; int i2 = 0;
            for (int i = 0; i < 8; ++i) { const float v = logit[4 + gi * 8 + i]; if (i != i1 && v > e2) { e2 = v; i2 = i; } }
            const float p2 = expf(e2 - emx);
            sel_e[0] = gi * 8 + i1; sel_e[1] = gi * 8 + i2;
            sel_w[0] = gw / (1.f + p2); sel_w[1] = gw * p2 / (1.f + p2);
        }
        __syncthreads();
        for (int k2 = 0; k2 < 2; ++k2) {
            const int e = sel_e[k2];
            const float* G = wg + (size_t)e * D * FF; const float* U = wu + (size_t)e * D * FF;
            float ga = 0.f, ua = 0.f;
            for (int k = 0; k < D; ++k) { ga += xs[k] * G[(size_t)k * FF + tid]; ua += xs[k] * U[(size_t)k * FF + tid]; }
            hid[k2 * FF + tid] = silu_f(ga) * ua * sel_w[k2];
        }
        __syncthreads();
        for (int d = tid; d < D; d += 256) {
            float acc = 0.f;
            for (int k2 = 0; k2 < 2; ++k2) {
                const float* Wd = wd + (size_t)sel_e[k2] * FF * D;
                for (int f = 0; f < FF; ++f) acc += hid[k2 * FF + f] * Wd[(size_t)f * D + d];
            }
            y2[(size_t)t * D + d] = acc;
        }
    }
}


#define LAS __attribute__((address_space(3)))
#define XB_TMO      128
#define XB_XCNT(j)  (256  + 64 * (j))
#define XB_XSUB(j)  (1280 + 64 * (j))
#define XB_XGEN(j)  (2304 + 64 * (j))
#define XB_TOP      3328
#define XB_TOPGEN   3392
#define XCD_BAR_WORDS 3456
#define XB_SPIN_CAP (1u << 18)

__device__ __forceinline__ unsigned xb_ld(unsigned* p)              { return __hip_atomic_load(p, __ATOMIC_RELAXED, __HIP_MEMORY_SCOPE_AGENT); }
__device__ __forceinline__ unsigned xb_add(unsigned* p, unsigned v) { return __hip_atomic_fetch_add(p, v, __ATOMIC_RELAXED, __HIP_MEMORY_SCOPE_AGENT); }
__device__ __forceinline__ unsigned xb_xcc_id() { return (unsigned)__builtin_amdgcn_s_getreg((3 << 11) | 20) & 0xFu; }
#define XB_SPIN(cond, bar) do { unsigned _sp = 0; while (cond) { __builtin_amdgcn_s_sleep(1); \
    if ((++_sp & 255u) == 0u) { if (xb_ld(&(bar)[XB_TMO])) break; if (_sp > XB_SPIN_CAP) { atomicAdd(&(bar)[XB_TMO], 1u); break; } } } } while (0)

struct XcdBarrier {
    unsigned* bar; unsigned x;
    volatile LAS unsigned* st;
};

__device__ __forceinline__ XcdBarrier xcd_barrier_post(unsigned* bar, volatile LAS unsigned* st) {
    XcdBarrier b; b.bar = bar; b.x = xb_xcc_id(); b.st = st;
    if (tidx() == 0) (void)xb_add(&bar[XB_XCNT(b.x)], 1u);
    return b;
}
__device__ __forceinline__ void xcd_barrier_complete(unsigned* bar, unsigned x, unsigned& nloc, unsigned& nx) {
    const unsigned G = gridDim.x * gridDim.y * gridDim.z;
    unsigned sum, cnt, mine, sp = 0u;
    for (;;) {
        sum = 0u; cnt = 0u; mine = 0u;
#pragma unroll
        for (unsigned j = 0; j < 16; ++j) { const unsigned c = xb_ld(&bar[XB_XCNT(j)]); sum += c; cnt += (c > 0u) ? 1u : 0u; mine = (j == x) ? c : mine; }
        if (sum == G) break;
        __builtin_amdgcn_s_sleep(1);
        if ((++sp & 255u) == 0u) { if (xb_ld(&bar[XB_TMO])) break; if (sp > XB_SPIN_CAP) { atomicAdd(&bar[XB_TMO], 1u); break; } }
    }
    nloc = mine > 0u ? mine : 1u; nx = cnt > 0u ? cnt : 1u;
}

__device__ __forceinline__ void xcd_barrier(const XcdBarrier& b) {
    asm volatile("s_waitcnt vmcnt(0)" ::: "memory");
    __syncthreads();
    if (tidx() == 0) {
        unsigned* bar = b.bar;
        __builtin_amdgcn_s_waitcnt(0);
        unsigned nloc = b.st[0], nx = b.st[1];
        if (nloc == 0u) { xcd_barrier_complete(bar, b.x, nloc, nx); b.st[0] = nloc; b.st[1] = nx; }
        const unsigned old = xb_add(&bar[XB_XSUB(b.x)], 1u);
        const unsigned gen = old / nloc;
        if (old + 1u == (gen + 1u) * nloc) {
            __builtin_amdgcn_fence(__ATOMIC_RELEASE, "agent");
            asm volatile("s_waitcnt vmcnt(0)" ::: "memory");
            const unsigned og = xb_add(&bar[XB_TOP], 1u);
            const unsigned tg = og / nx;
            if (og + 1u == (tg + 1u) * nx) xb_add(&bar[XB_TOPGEN], 1u);
            else XB_SPIN(xb_ld(&bar[XB_TOPGEN]) == tg, bar);
            __builtin_amdgcn_fence(__ATOMIC_ACQUIRE, "agent");
            xb_add(&bar[XB_XGEN(b.x)], 1u);
            asm volatile("s_waitcnt vmcnt(0)" ::: "memory");
        } else {
            XB_SPIN(xb_ld(&bar[XB_XGEN(b.x)]) == gen, bar);
            __builtin_amdgcn_fence(__ATOMIC_ACQUIRE, "agent");
            asm volatile("s_waitcnt vmcnt(0)" ::: "memory");
        }
    }
    __syncthreads();
}


constexpr size_t MiB = 1u << 20;
#define WSB(T, off) ((T*)(kargs()->ws + (size_t)(off)))
#define OUTB(T, off) ((T*)((char*)kargs()->out + (size_t)(off)))
#define B_CNT    WSB(int, 4096)
#define B_MOD    WSB(float, 1 * MiB)
#define B_DT     WSB(float, 1 * MiB + 256 * 1024)
#define B_ACS2   WSB(float, 1 * MiB + 768 * 1024)
#define B_WIN    WSB(bf16, 2 * MiB)
#define B_WOUT   WSB(bf16, 6 * MiB)
#define B_WUQ    WSB(bf16, 8 * MiB)
#define B_WUKV   WSB(bf16, 9 * MiB)
#define B_WRT    WSB(float, 9 * MiB + 512 * 1024)
#define B_WGU    WSB(bf16, 10 * MiB)
#define B_WD     WSB(bf16, 42 * MiB)
#define B_HB     WSB(bf16, 58 * MiB)
#define B_YC     WSB(bf16, 58 * MiB)
#define B_H2     WSB(bf16, 58 * MiB)
#define B_U      WSB(bf16, 90 * MiB)
#define B_HG     WSB(bf16, 90 * MiB)
#define B_YP     WSB(bf16, 90 * MiB)
#define B_XT     WSB(bf16, 154 * MiB)
#define B_YB     WSB(bf16, 154 * MiB)
#define B_HID    WSB(bf16, 170 * MiB)
#define B_Q      WSB(bf16, 186 * MiB)
#define B_KF     WSB(bf16, 210 * MiB)
#define B_VT     WSB(bf16, 234 * MiB)
#define B_COS    WSB(float, 250 * MiB)
#define B_SIN    WSB(float, 251 * MiB)
#define B_RTE    WSB(int, 250 * MiB)
#define B_RTS    WSB(int, 250 * MiB + 256 * 1024)
#define B_RTW    WSB(float, 250 * MiB + 512 * 1024)
#define B_TOKROW WSB(int, 250 * MiB + 768 * 1024)
#define B_ROWW   WSB(float, 251 * MiB)
#define B_SSQ    WSB(float, 252 * MiB)
#define B_SSQS   WSB(float, 253 * MiB)
#define B_PREV   OUTB(bf16, 0)
#define B_CQN    OUTB(bf16, 32 * MiB)
#define B_CKVN   OUTB(bf16, 40 * MiB)
#define LDS_TP   ((int*)(lds_raw + 131072 + 1024))

__global__ void __launch_bounds__(NT, 2) mega_fwd(Params P) {
    if (threadIdx.x < 2) ((volatile LAS unsigned*)(lds_raw + WTAB_OFF - 16))[threadIdx.x] = 0u;
    tidx_init();
    float* lds = (float*)lds_raw;
    const XcdBarrier bar = xcd_barrier_post((unsigned*)(kargs()->ws + 16384), (volatile LAS unsigned*)(lds_raw + WTAB_OFF - 16));
#define GSYNC() xcd_barrier(bar)
    ph_prep(lds, B_MOD, B_WIN, B_WOUT, B_WUQ, B_WUKV, B_WRT, B_WGU, B_WD);
    GSYNC();
    ph_prenorm_bf16(IN(0), IN(5), B_MOD, 0 * D, 1 * D, B_HB);
    GSYNC();
    { pg8::Gemm g{B_HB, B_WIN, M, NU, D}; pg8::StaticOrder S; S.init(M, NU, gridDim.x, (int)blockIdx.x);
      pg8::EpiBf16<0> E{B_U, NU};
      pg8::gemm_phase<pg8::EpiBf16<0>, pg8::StaticOrder, true, true>((PG8_LAS unsigned char*)lds_raw, g, S, E); }
    GSYNC();
    ph_prep2(B_U, kargs()->pos, IN(10), IN(11), IN(12), B_CQN, B_CKVN, B_KF, B_COS, B_SIN, B_DT, B_XT);
    GSYNC();
    {
      const int G = gridDim.x, bid = blockIdx.x; const bool split = G >= 128;
      if (!split || bid < 64) { for (int it = bid; it < 64; it += (split ? 64 : G)) ssd::state_sweep((SLAS char*)lds_raw, it >> 3, it & 7, B_XT, B_DT, IN(13), B_ACS2, B_PREV); }
      if (!split || bid >= 64) { const int Gg = split ? G - 64 : G, cg_ = split ? bid - 64 : bid;
        { pg8::Gemm g{B_CQN, B_WUQ, M, 768, QR}; pg8::StaticOrder S; S.init(M, 768, Gg, cg_);
          pg8::EpiQ E{B_Q, B_COS, B_SIN};
          pg8::gemm_phase<pg8::EpiQ, pg8::StaticOrder, true, false>((PG8_LAS unsigned char*)lds_raw, g, S, E); }
        { pg8::Gemm g{B_CKVN, B_WUKV, M, 1024, 256}; pg8::StaticOrder S; S.init(M, 1024, Gg, cg_);
          pg8::EpiKV E{B_KF, B_VT};
          pg8::gemm_phase<pg8::EpiKV, pg8::StaticOrder, true, false>((PG8_LAS unsigned char*)lds_raw, g, S, E); }
        ph_prep_moe(B_WGU, B_WD, cg_ * (NT / 64) + (tidx() >> 6), Gg * (NT / 64), 0, split ? MOE_SPLIT : 0); } }
    GSYNC();
    att::attn_phase((ALAS char*)lds_raw, B_Q, B_KF, B_VT, B_YC, B_SSQ);
    { const int G = gridDim.x, bid = blockIdx.x; const int vcu = (G % 8 == 0) ? (bid % 8) * (G / 8) + bid / 8 : bid;
      for (int u = vcu; u < 256; u += G) ssd::chunk_unit((SLAS char*)lds_raw, u >> 5, (u >> 1) & 15, u & 1, B_XT, B_PREV, B_DT, B_ACS2, IN(14), B_U, B_YC, B_SSQS); }
    GSYNC();
    ph_yc_norm(B_YC, B_SSQS, B_SSQ);
    GSYNC();
    { pg8::Gemm g{B_YC, B_WOUT, M, D, D}; pg8::StaticOrder S; S.init(M, D, gridDim.x, (int)blockIdx.x);
      pg8::EpiBf16<0> E{B_YB, D};
      pg8::gemm_phase<pg8::EpiBf16<0>, pg8::StaticOrder, true, true>((PG8_LAS unsigned char*)lds_raw, g, S, E); }
    GSYNC();
    ph_rowrouter((__attribute__((address_space(3))) float*)lds_raw, B_YB, IN(0), IN(6), IN(7), B_MOD, B_WRT, IN(23), IN(25), kargs()->out, B_H2, B_CNT, B_RTE, B_RTS, B_RTW);
    GSYNC();
    moe_table(LDS_TP, B_CNT);
    ph_gather(LDS_TP, B_H2, B_RTE, B_RTS, B_RTW, B_HG, B_ROWW, B_TOKROW);
    GSYNC();
    { pg8::Gemm g{B_HG, B_WGU, 0, 0, D}; pg8::GroupedOrder S{(const PG8_LAS int*)LDS_TP, 2, (int)gridDim.x, (int)blockIdx.x};
      pg8::EpiGU E{B_HID, B_ROWW};
      pg8::gemm_phase<pg8::EpiGU, pg8::GroupedOrder, true, true>((PG8_LAS unsigned char*)lds_raw, g, S, E); }
    GSYNC();
    { pg8::Gemm g{B_HID, B_WD, 0, 0, FF}; pg8::GroupedOrder S{(const PG8_LAS int*)LDS_TP, 4, (int)gridDim.x, (int)blockIdx.x};
      pg8::EpiDown E{B_YP};
      pg8::gemm_phase<pg8::EpiDown, pg8::GroupedOrder, true, true>((PG8_LAS unsigned char*)lds_raw, g, S, E); }
    GSYNC();
    ph_moe_final(B_YP, B_TOKROW, IN(8), B_MOD, kargs()->out);
}

extern "C" void kernel_launch(void* const* d_in, const int* in_sizes, int n_in, void* d_out, int out_size, void* d_ws, size_t ws_size,
                              hipStream_t stream) {
    static int grid_blocks = 0;
    if (!grid_blocks) {
        int dev = 0, cus = 0, per_cu = 0;
        (void)hipGetDevice(&dev);
        (void)hipDeviceGetAttribute(&cus, hipDeviceAttributeMultiprocessorCount, dev);
        (void)hipFuncSetAttribute((const void*)mega_fwd, hipFuncAttributeMaxDynamicSharedMemorySize, LDS_BYTES);
        (void)hipOccupancyMaxActiveBlocksPerMultiprocessor(&per_cu, (const void*)mega_fwd, NT, LDS_BYTES);
        if (per_cu < 1) { fprintf(stderr, "occupancy query returned %d\n", per_cu); per_cu = 1; }
        grid_blocks = cus * per_cu;
    }
    (void)hipMemsetAsync(d_ws, 0, 65536, stream);
    Params p{};
    for (int i = 0; i < 29; ++i) p.in[i] = (const float*)d_in[i];
    p.pos = (const int*)d_in[2];
    p.out = (float*)d_out;
    p.ws = (char*)d_ws;
    void* args[] = {&p};
    hipError_t e = hipLaunchCooperativeKernel((void*)mega_fwd, dim3(grid_blocks), dim3(NT), args, LDS_BYTES, stream);
    if (e != hipSuccess) fprintf(stderr, "cooperative launch failed: %s (grid %d)\n", hipGetErrorString(e), grid_blocks);
}
```

```cpp
#include <hip/hip_runtime.h>
#include <hip/hip_cooperative_groups.h>
#include <stdint.h>
#include <math.h>
#include <cstdio>
namespace cg = cooperative_groups;

constexpr int D = 1024, NB = 8, SEQ = 2048, M = NB * SEQ;
constexpr int SSD_H = 8, SSD_P = 64, SSD_INNER = 512, SSD_G = 2, SSD_N = 128, SSD_XBC = 1024;
constexpr int MLA_H = 8, NOPE = 64, ROPE = 32, QK = 96, VD = 64, QR = 256, KVR = 128;
constexpr int NIN = 1960;
constexpr int NU = 2048;
constexpr int OFF_Z = 0, OFF_XBC = 512, OFF_CQ = 1536, OFF_CKV = 1792, OFF_KR = 1920, OFF_DT = 1952;
constexpr int NEXP = 32, FF = 256;
constexpr float EPS = 1e-6f;
constexpr int MOE_ITEMS = 32 * 16 * 8 + 32 * 4 * 16;
constexpr int MOE_SPLIT = 2560;
constexpr int NT = 512;
constexpr int LDS_BYTES = 160 * 1024;

typedef unsigned short bf16;
__device__ __forceinline__ float bf2f(bf16 v) { return __uint_as_float((unsigned)v << 16); }
__device__ __forceinline__ unsigned f2bf(float f) { unsigned u = __float_as_uint(f); return (u + 0x7fffu + ((u >> 16) & 1u)) >> 16; }
__device__ __forceinline__ unsigned pk2(float lo, float hi) { return f2bf(lo) | (f2bf(hi) << 16); }
typedef unsigned v4u __attribute__((ext_vector_type(4)));
typedef float f32x4v __attribute__((ext_vector_type(4)));

struct Params {
    const float* in[29];
    const int* pos;
    float* out;
    char* ws;
};

#define RLAS __attribute__((address_space(3)))
__device__ __forceinline__ float dpp_f(float v, int ctrl_sel) {
    const int x = __float_as_int(v); int r;
    if (ctrl_sel == 0) r = __builtin_amdgcn_update_dpp(0, x, 0xB1, 0xF, 0xF, true);
    else if (ctrl_sel == 1) r = __builtin_amdgcn_update_dpp(0, x, 0x1B, 0xF, 0xF, true);
    else if (ctrl_sel == 2) r = __builtin_amdgcn_update_dpp(0, x, 0x141, 0xF, 0xF, true);
    else r = __builtin_amdgcn_update_dpp(0, x, 0x140, 0xF, 0xF, true);
    return __int_as_float(r);
}
__device__ __forceinline__ float wave_sum_valu(float v) {
    v += dpp_f(v, 0); v += dpp_f(v, 1); v += dpp_f(v, 2); v += dpp_f(v, 3);
    { auto rr = __builtin_amdgcn_permlane16_swap(__float_as_uint(v), __float_as_uint(v), false, false); v = __uint_as_float(rr[0]) + __uint_as_float(rr[1]); }
    { auto rr = __builtin_amdgcn_permlane32_swap(__float_as_uint(v), __float_as_uint(v), false, false); v = __uint_as_float(rr[0]) + __uint_as_float(rr[1]); }
    return v;
}
__device__ __forceinline__ float ldf(const float* p) { return *p; }
__device__ __forceinline__ float ldf(const bf16* p) { return bf2f(*p); }
extern __shared__ __attribute__((aligned(16))) unsigned char lds_raw[];
constexpr int WTAB_OFF = 160 * 1024 - 256;
__device__ __forceinline__ int hw_wave_key() { int k; asm volatile("s_getreg_b32 %0, hwreg(HW_REG_HW_ID, 0, 6)" : "=s"(k)); return k; }
__device__ __forceinline__ void tidx_init() { const int key = hw_wave_key(); ((volatile __attribute__((address_space(3))) int*)(lds_raw + WTAB_OFF))[key] = (int)(threadIdx.x >> 6); __syncthreads(); }
__device__ __forceinline__ int tidx() {
    const int key = hw_wave_key();
    int w = ((volatile __attribute__((address_space(3))) int*)(lds_raw + WTAB_OFF))[key];
    w = __builtin_amdgcn_readfirstlane(w);
    unsigned ones = ~0u; asm volatile("" : "+s"(ones));
    int t = w * 64 + (int)__builtin_amdgcn_mbcnt_hi(ones, __builtin_amdgcn_mbcnt_lo(ones, 0u));
    asm volatile("" : "+v"(t)); return t; }
typedef const __attribute__((address_space(4))) Params* KArgs;
__device__ __forceinline__ KArgs kargs() { KArgs p = (KArgs)__builtin_amdgcn_kernarg_segment_ptr(); asm volatile("" : "+s"(p)); return p; }
#define IN(i) (kargs()->in[i])
__device__ __forceinline__ float silu_f(float v) { return v / (1.f + expf(-v)); }
__device__ __forceinline__ float wave_sum(float v) {
#pragma unroll
    for (int o = 32; o > 0; o >>= 1) v += __shfl_xor(v, o);
    return v;
}

namespace pg8 {
#define PG8_LAS __attribute__((address_space(3)))
typedef unsigned short bf16_t;
typedef short bf16x8 __attribute__((ext_vector_type(8)));
typedef float f32x4 __attribute__((ext_vector_type(4)));
typedef unsigned u32x4 __attribute__((ext_vector_type(4)));
constexpr int BM = 256, BK = 64, HALF = 128, HTB = HALF * BK * 2  , STAGE_BYTES = 8 * HTB, NXCD = 8, WGM = 8;

__host__ __device__ __forceinline__ int lds_byte(int r, int c) { const int st = (r >> 4) * 2 + (c >> 5), rr = r & 15, cc = c & 31, ob = rr * 64 + cc * 2; return st * 1024 + (ob ^ (((ob >> 9) & 1) << 5)); }
__host__ __device__ __forceinline__ void stage_rc(int b, int& R, int& C) { const int st = b / 1024, sb = b % 1024, swz = sb ^ (((sb >> 9) & 1) << 5); R = (st >> 1) * 16 + swz / 64; C = (st & 1) * 32 + (swz % 64) / 2; }
__host__ __device__ __forceinline__ int perm32(int rho) { const int n = rho >> 4, i = rho & 15; return 8 * (i >> 2) + 4 * n + (i & 3); }

struct Unit { int pm, pn; };
struct Gemm { const bf16_t* A; const bf16_t* Bt; int M, N, K; };

struct StaticOrder {
    int nM, nN, nwg, G, c;
    __host__ __device__ void init(int M, int N, int G_, int c_) { nM = M / BM; nN = N / BM; nwg = nM * nN; G = G_; c = c_; }
    __host__ __device__ bool next(int i, Unit& u) const {
        const long L = (long)i * G + c; if (L >= nwg) return false;
        int wgid = (int)L; { const int q = nwg / NXCD, r = nwg % NXCD, xcd = wgid % NXCD, off = wgid / NXCD; wgid = (xcd < r ? xcd * (q + 1) : r * (q + 1) + (xcd - r) * q) + off; }
        const int nig = WGM * nN, gid = wgid / nig, fm = gid * WGM, gsz = (nM - fm) < WGM ? (nM - fm) : WGM;
        u.pm = fm + ((wgid % nig) % gsz); u.pn = (wgid % nig) / gsz; return true;
    }
    __device__ __forceinline__ void a_ready(const Unit&) const {}
    __device__ __forceinline__ void done(const Unit&) const {}
};


template <int ACT> struct EpiBf16 {
    static constexpr bool PERM = true, AFTER_DRAIN = false;
    bf16_t* O; int ldc;
    __device__ __forceinline__ void operator()(const f32x4 (&acc)[2][2][4][2], const Unit& u, int wr, int wc, int fr, int fq) const {
        { const int l_ = tidx() & 63; fr = l_ & 15; fq = l_ >> 4; }
        const int row0 = u.pm * BM + wr * 64 + fr; const int col0 = u.pn * BM + wc * 32 + 8 * fq;
#pragma unroll
        for (int ai = 0; ai < 2; ++ai)
#pragma unroll
            for (int m = 0; m < 4; ++m) { bf16_t* rowp = O + (size_t)(row0 + ai * HALF + m * 16) * ldc + col0;
#pragma unroll
                for (int bj = 0; bj < 2; ++bj) { const f32x4 v0 = acc[ai][bj][m][0], v1 = acc[ai][bj][m][1];
                    u32x4 w; w.x = pk2(v0[0], v0[1]); w.y = pk2(v0[2], v0[3]); w.z = pk2(v1[0], v1[1]); w.w = pk2(v1[2], v1[3]);
                    *(u32x4*)(rowp + bj * HALF) = w; } }
    }
};

struct EpiQ {
    static constexpr bool PERM = true, AFTER_DRAIN = false;
    bf16_t* Q; const float* COS; const float* SIN;
    __device__ __forceinline__ void operator()(const f32x4 (&acc)[2][2][4][2], const Unit& u, int wr, int wc, int fr, int fq) const {
        { const int l_ = tidx() & 63; fr = l_ & 15; fq = l_ >> 4; }
        const int row0 = u.pm * BM + wr * 64 + fr;
#pragma unroll
        for (int bj = 0; bj < 2; ++bj) {
            const int colg = u.pn * BM + bj * HALF + wc * 32;
            const bool pe = ((colg >> 5) % 3) == 2;
#pragma unroll
            for (int ai = 0; ai < 2; ++ai)
#pragma unroll
                for (int m = 0; m < 4; ++m) {
                    const int row = row0 + ai * HALF + m * 16;
                    f32x4 v0 = acc[ai][bj][m][0], v1 = acc[ai][bj][m][1];
                    if (pe) {
                        f32x4 w0, w1;
#pragma unroll
                        for (int e = 0; e < 4; ++e) { w0[e] = __shfl_xor(v0[e], 32); w1[e] = __shfl_xor(v1[e], 32); }
                        const f32x4* cp = (const f32x4*)(COS + (size_t)row * 16 + (fq & 1) * 8); const f32x4* sp = (const f32x4*)(SIN + (size_t)row * 16 + (fq & 1) * 8);
                        const f32x4 c0 = cp[0], c1 = cp[1], s0 = sp[0], s1 = sp[1];
                        const float sg = (fq < 2) ? -1.f : 1.f;
                        v0 = v0 * c0 + w0 * s0 * sg; v1 = v1 * c1 + w1 * s1 * sg;
                    }
                    u32x4 w; w.x = pk2(v0[0], v0[1]); w.y = pk2(v0[2], v0[3]); w.z = pk2(v1[0], v1[1]); w.w = pk2(v1[2], v1[3]);
                    *(u32x4*)(Q + (size_t)row * 768 + colg + 8 * fq) = w;
                    if (pe) asm volatile("" ::: "memory");
                }
        }
    }
};
struct EpiKV {
    static constexpr bool PERM = true, AFTER_DRAIN = false;
    bf16_t* KF; bf16_t* VT;
    __device__ __forceinline__ void operator()(const f32x4 (&acc)[2][2][4][2], const Unit& u, int wr, int wc, int fr, int fq) const {
        { const int l_ = tidx() & 63; fr = l_ & 15; fq = l_ >> 4; }
        const int row0 = u.pm * BM + wr * 64 + fr;
#pragma unroll
        for (int bj = 0; bj < 2; ++bj) {
            const int colg = u.pn * BM + bj * HALF + wc * 32; const int h = colg >> 7, j0 = (colg & 127) + 8 * fq;
#pragma unroll
            for (int ai = 0; ai < 2; ++ai)
#pragma unroll
                for (int m = 0; m < 4; ++m) {
                    const int t = row0 + ai * HALF + m * 16; const int b = t >> 11, sq = t & 2047, tile = sq >> 6, key = sq & 63;
                    const size_t base = (size_t)((b * 8 + h) * 32 + tile);
                    bf16_t* dst = (j0 < 64) ? KF + base * 6144 + (j0 >> 3) * 512 + key * 8 : VT + base * 4096 + ((j0 - 64) >> 5) * 2048 + key * 32 + ((j0 - 64) & 31);
                    const f32x4 v0 = acc[ai][bj][m][0], v1 = acc[ai][bj][m][1];
                    u32x4 w; w.x = pk2(v0[0], v0[1]); w.y = pk2(v0[2], v0[3]); w.z = pk2(v1[0], v1[1]); w.w = pk2(v1[2], v1[3]);
                    *(u32x4*)dst = w;
                }
        }
    }
};

struct GroupedOrder {
    const PG8_LAS int* tp; int NCT, G, c;
    __device__ __forceinline__ bool next(int i, Unit& u) const {
        const int L = i * G + c, total = tp[32] * NCT; if (L >= total) return false;
        const int rtg = L / NCT, ct = L - rtg * NCT; int e = 0;
        for (int j = 1; j < 32; ++j) e += (tp[j] <= rtg) ? 1 : 0;
        u.pm = rtg; u.pn = e * NCT + ct; return true;
    }
    __device__ __forceinline__ void a_ready(const Unit&) const {}
    __device__ __forceinline__ void done(const Unit&) const {}
};
struct OwnTileOrder {
    const PG8_LAS int* tp; int NCT, G, c;
    __device__ __forceinline__ bool next(int i, Unit& u) const {
        const int rtg = c + (i / NCT) * G, ct = i % NCT; if (rtg >= tp[32]) return false;
        int e = 0;
        for (int j = 1; j < 32; ++j) e += (tp[j] <= rtg) ? 1 : 0;
        u.pm = rtg; u.pn = e * NCT + ct; return true;
    }
    __device__ __forceinline__ void a_ready(const Unit&) const {}
    __device__ __forceinline__ void done(const Unit&) const {}
};
struct EpiGU {
    static constexpr bool PERM = true, AFTER_DRAIN = false;
    bf16_t* HID; const float* ROWW;
    __device__ __forceinline__ void operator()(const f32x4 (&acc)[2][2][4][2], const Unit& u, int wr, int wc, int fr, int fq) const {
        { const int l_ = tidx() & 63; fr = l_ & 15; fq = l_ >> 4; }
        const int row0 = u.pm * BM + wr * 64 + fr; const int col0 = (u.pn & 1) * 128 + wc * 32 + 8 * fq;
#pragma unroll
        for (int ai = 0; ai < 2; ++ai)
#pragma unroll
            for (int m = 0; m < 4; ++m) { const int row = row0 + ai * HALF + m * 16; const float w = ROWW[row];
                float hv[8];
#pragma unroll
                for (int n = 0; n < 2; ++n)
#pragma unroll
                    for (int e = 0; e < 4; ++e) { const float g = acc[ai][0][m][n][e], up = acc[ai][1][m][n][e]; hv[4 * n + e] = g * __builtin_amdgcn_rcpf(1.f + __expf(-g)) * up * w; }
                u32x4 o; o.x = pk2(hv[0], hv[1]); o.y = pk2(hv[2], hv[3]); o.z = pk2(hv[4], hv[5]); o.w = pk2(hv[6], hv[7]);
                *(u32x4*)(HID + (size_t)row * 256 + col0) = o; }
    }
};
struct EpiDown {
    static constexpr bool PERM = true, AFTER_DRAIN = false;
    bf16_t* YP;
    __device__ __forceinline__ void operator()(const f32x4 (&acc)[2][2][4][2], const Unit& u, int wr, int wc, int fr, int fq) const {
        { const int l_ = tidx() & 63; fr = l_ & 15; fq = l_ >> 4; }
        const int row0 = u.pm * BM + wr * 64 + fr; const int col0 = (u.pn & 3) * BM + wc * 32 + 8 * fq;
#pragma unroll
        for (int ai = 0; ai < 2; ++ai)
#pragma unroll
            for (int m = 0; m < 4; ++m) { bf16_t* rowp = YP + (size_t)(row0 + ai * HALF + m * 16) * 1024 + col0;
#pragma unroll
                for (int bj = 0; bj < 2; ++bj) { const f32x4 v0 = acc[ai][bj][m][0], v1 = acc[ai][bj][m][1];
                    u32x4 w; w.x = pk2(v0[0], v0[1]); w.y = pk2(v0[2], v0[3]); w.z = pk2(v1[0], v1[1]); w.w = pk2(v1[2], v1[3]);
                    *(u32x4*)(rowp + bj * HALF) = w; } }
    }
};
template <class Epi, class Sched, bool ALIGN_EPI = false, bool SP2 = false>
__device__ __forceinline__ void gemm_phase(PG8_LAS unsigned char* lds, const Gemm g, const Sched& S, const Epi& E) {
    const int tid = tidx(), wid = __builtin_amdgcn_readfirstlane(tid >> 6), lane = tid & 63, wr = wid >> 2, wc = wid & 3, fr = lane & 15, fq = lane >> 4;
    const int K = g.K, nt = K / BK;
    unsigned voffA[2], voffB[2];
#pragma unroll
    for (int i = 0; i < 2; ++i) { int R, C; stage_rc(tid * 16 + i * 8192, R, C); const int Rb = Epi::PERM ? ((R & ~31) + perm32(R & 31)) : R;
        voffA[i] = (unsigned)(R * K + C) * 2u; voffB[i] = (unsigned)(Rb * K + C) * 2u; }
    const size_t kstep = (size_t)(BK * 2);
    const size_t hstep = (size_t)HALF * K * 2;
    const size_t tstep = 2 * hstep;
    const unsigned ldsw = (unsigned)wid * 1024u;
    const int aoff = lds_byte(wr * 64 + fr, fq * 8), boff = lds_byte(wc * 32 + fr, fq * 8);
#define PG8_SA(b, h) (((b) * 2 + (h)) * HTB)
#define PG8_SB(b, h) ((4 + (b) * 2 + (h)) * HTB)
#define PG8_STAGE(bufoff, gbase, voff) do { _Pragma("unroll") for (int _i = 0; _i < 2; ++_i) \
        __builtin_amdgcn_global_load_lds((const unsigned*)((const char*)(gbase) + (voff)[_i]), (PG8_LAS unsigned*)(lds + (bufoff) + ldsw + _i * 8192), 16, 0, 0); } while (0)
#define PG8_LDA(dst, b, h) do { _Pragma("unroll") for (int m = 0; m < 4; ++m) _Pragma("unroll") for (int k = 0; k < 2; ++k) dst[m][k] = *(const PG8_LAS bf16x8*)(lds + PG8_SA(b, h) + aoff + m * 2048 + k * 1024); } while (0)
#define PG8_LDB(dst, b, h) do { _Pragma("unroll") for (int n = 0; n < 2; ++n) _Pragma("unroll") for (int k = 0; k < 2; ++k) dst[n][k] = *(const PG8_LAS bf16x8*)(lds + PG8_SB(b, h) + boff + n * 2048 + k * 1024); } while (0)
#define PG8_MMA(ai, bj, At, Bt) do { __builtin_amdgcn_s_setprio(1); _Pragma("unroll") for (int m = 0; m < 4; ++m) _Pragma("unroll") for (int n = 0; n < 2; ++n) _Pragma("unroll") for (int k = 0; k < 2; ++k) \
        acc[ai][bj][m][n] = __builtin_amdgcn_mfma_f32_16x16x32_bf16(Bt[n][k], At[m][k], acc[ai][bj][m][n], 0, 0, 0); __builtin_amdgcn_s_setprio(0); } while (0)
#define PG8_WAIT_V(n) asm volatile("s_waitcnt vmcnt(" #n ")" ::: "memory")
#define PG8_WAIT_L(n) asm volatile("s_waitcnt lgkmcnt(" #n ")" ::: "memory")
#define PG8_BAR __builtin_amdgcn_s_barrier()
#define PG8_SCHED __builtin_amdgcn_sched_barrier(0)
    Unit cur, nxt; int ui = 0;
    if (!S.next(0, cur)) return;
    f32x4 acc[2][2][4][2];
#pragma unroll
    for (int a = 0; a < 2; ++a)
#pragma unroll
        for (int b = 0; b < 2; ++b)
#pragma unroll
            for (int m = 0; m < 4; ++m)
#pragma unroll
                for (int n = 0; n < 2; ++n) acc[a][b][m][n] = (f32x4){0.f, 0.f, 0.f, 0.f};
    bf16x8 At[4][2], B0[2][2], B1[2][2];
    const char* cA = (const char*)g.A + (size_t)cur.pm * tstep; const char* cB = (const char*)g.Bt + (size_t)cur.pn * tstep;
    S.a_ready(cur);
    if constexpr (SP2) {
        PG8_STAGE(PG8_SB(0, 0), cB, voffB); PG8_STAGE(PG8_SB(0, 1), cB + hstep, voffB); PG8_STAGE(PG8_SA(0, 0), cA, voffA); PG8_STAGE(PG8_SA(0, 1), cA + hstep, voffA);
        if (wr == 1) PG8_BAR;
        PG8_WAIT_V(2); PG8_BAR;
        PG8_STAGE(PG8_SB(1, 0), cB + kstep, voffB); PG8_STAGE(PG8_SA(1, 0), cA + kstep, voffA); PG8_STAGE(PG8_SB(1, 1), cB + hstep + kstep, voffB);
        PG8_WAIT_V(6); PG8_BAR;
    } else {
        PG8_STAGE(PG8_SB(0, 0), cB, voffB); PG8_STAGE(PG8_SA(0, 0), cA, voffA); PG8_STAGE(PG8_SB(0, 1), cB + hstep, voffB); PG8_STAGE(PG8_SA(0, 1), cA + hstep, voffA);
        if (wr == 1) PG8_BAR;
        PG8_WAIT_V(4); PG8_BAR;
        PG8_STAGE(PG8_SB(1, 0), cB + kstep, voffB); PG8_STAGE(PG8_SA(1, 0), cA + kstep, voffA); PG8_STAGE(PG8_SB(1, 1), cB + hstep + kstep, voffB);
        PG8_WAIT_V(6); PG8_BAR;
    }
    for (;;) {
        const bool has_next = S.next(ui + 1, nxt);
        const char* nA = has_next ? (const char*)g.A + (size_t)nxt.pm * tstep : cA; const char* nB = has_next ? (const char*)g.Bt + (size_t)nxt.pn * tstep : cB;
        for (int t = 0; t < nt; t += 2) {
            const bool last = (t == nt - 2);
            const char* a1 = cA + (size_t)(t + 1) * kstep;
            const char* a2 = last ? nA : cA + (size_t)(t + 2) * kstep; const char* b2 = last ? nB : cB + (size_t)(t + 2) * kstep;
            const char* a3 = a2 + kstep; const char* b3 = b2 + kstep;
            if (last && has_next) S.a_ready(nxt);
            if constexpr (SP2) {
            PG8_LDB(B0, 0, 0); PG8_LDB(B1, 0, 1); PG8_SCHED; PG8_LDA(At, 0, 0); PG8_STAGE(PG8_SA(1, 1), a1 + hstep, voffA);
            PG8_WAIT_V(8); PG8_WAIT_L(0); PG8_BAR; PG8_MMA(0, 0, At, B0); PG8_MMA(0, 1, At, B1); PG8_BAR; PG8_SCHED;
            PG8_LDA(At, 0, 1); PG8_STAGE(PG8_SB(0, 0), b2, voffB); PG8_STAGE(PG8_SB(0, 1), b2 + hstep, voffB); PG8_STAGE(PG8_SA(0, 0), a2, voffA);
            PG8_WAIT_V(8); PG8_WAIT_L(0); PG8_BAR; PG8_MMA(1, 0, At, B0); PG8_MMA(1, 1, At, B1); PG8_BAR; PG8_SCHED;
            PG8_LDB(B0, 1, 0); PG8_LDB(B1, 1, 1); PG8_SCHED; PG8_LDA(At, 1, 0); PG8_STAGE(PG8_SA(0, 1), a2 + hstep, voffA);
            PG8_WAIT_V(8); PG8_WAIT_L(0); PG8_BAR; PG8_MMA(0, 0, At, B0); PG8_MMA(0, 1, At, B1); PG8_BAR; PG8_SCHED;
            PG8_LDA(At, 1, 1); PG8_STAGE(PG8_SB(1, 0), b3, voffB); PG8_STAGE(PG8_SB(1, 1), b3 + hstep, voffB); PG8_STAGE(PG8_SA(1, 0), a3, voffA);
            PG8_WAIT_V(8); PG8_WAIT_L(0); PG8_BAR; PG8_MMA(1, 0, At, B0); PG8_MMA(1, 1, At, B1); PG8_BAR; PG8_SCHED;
            } else {
            PG8_LDB(B0, 0, 0); PG8_SCHED; PG8_LDA(At, 0, 0); PG8_STAGE(PG8_SA(1, 1), a1 + hstep, voffA);
            PG8_WAIT_L(8); PG8_BAR; PG8_WAIT_L(0); PG8_MMA(0, 0, At, B0); PG8_BAR; PG8_SCHED;
            PG8_LDB(B1, 0, 1); PG8_STAGE(PG8_SB(0, 0), b2, voffB);
            PG8_BAR; PG8_WAIT_L(0); PG8_MMA(0, 1, At, B1); PG8_BAR;
            PG8_LDA(At, 0, 1); PG8_STAGE(PG8_SA(0, 0), a2, voffA);
            PG8_BAR; PG8_WAIT_L(0); PG8_MMA(1, 0, At, B0); PG8_BAR; PG8_SCHED;
            PG8_STAGE(PG8_SB(0, 1), b2 + hstep, voffB);
            PG8_WAIT_V(6); PG8_BAR; PG8_MMA(1, 1, At, B1); PG8_BAR;
            PG8_LDB(B0, 1, 0); PG8_SCHED; PG8_LDA(At, 1, 0); PG8_STAGE(PG8_SA(0, 1), a2 + hstep, voffA);
            PG8_WAIT_L(8); PG8_BAR; PG8_WAIT_L(0); PG8_MMA(0, 0, At, B0); PG8_BAR; PG8_SCHED;
            PG8_LDB(B1, 1, 1); PG8_STAGE(PG8_SB(1, 0), b3, voffB);
            PG8_BAR; PG8_WAIT_L(0); PG8_MMA(0, 1, At, B1); PG8_BAR;
            PG8_LDA(At, 1, 1); PG8_STAGE(PG8_SA(1, 0), a3, voffA);
            PG8_BAR; PG8_WAIT_L(0); PG8_MMA(1, 0, At, B0); PG8_BAR; PG8_SCHED;
            PG8_STAGE(PG8_SB(1, 1), b3 + hstep, voffB);
            PG8_WAIT_V(6); PG8_BAR; PG8_MMA(1, 1, At, B1); PG8_BAR;
            }
        }
        if constexpr (ALIGN_EPI) { if (wr == 0) PG8_BAR; }
        if constexpr (!Epi::AFTER_DRAIN) { E(acc, cur, wr, wc, fr, fq); S.done(cur); }
        if (!has_next) break;
#pragma unroll
        for (int a = 0; a < 2; ++a)
#pragma unroll
            for (int b = 0; b < 2; ++b)
#pragma unroll
                for (int m = 0; m < 4; ++m)
#pragma unroll
                    for (int n = 0; n < 2; ++n) acc[a][b][m][n] = (f32x4){0.f, 0.f, 0.f, 0.f};
        cur = nxt; cA = nA; cB = nB; ++ui;
        if constexpr (ALIGN_EPI) { if (wr == 1) PG8_BAR; }
    }
    PG8_WAIT_V(0);
    if constexpr (!ALIGN_EPI) { if (wr == 0) PG8_BAR; }
    PG8_BAR;
    if constexpr (Epi::AFTER_DRAIN) { E.fused(acc, cur, wr, wc, fr, fq, lds, wid, lane); S.done(cur); }
#undef PG8_SA
#undef PG8_SB
#undef PG8_STAGE
#undef PG8_LDA
#undef PG8_LDB
#undef PG8_MMA
#undef PG8_WAIT_V
#undef PG8_WAIT_L
#undef PG8_BAR
#undef PG8_SCHED
}
}


template <class GainFn>
__device__ __forceinline__ void transpose_tile(const float* src, int ldsrc, int srccol0  , GainFn gain, bf16* dst, int K, int k0, int n0, int lane) {
    const int r = lane >> 4, c = lane & 15;
    f32x4v v[16];
    if (srccol0 >= 0) {
#pragma unroll
        for (int i = 0; i < 16; ++i) v[i] = *(const f32x4v*)(src + (size_t)(k0 + 4 * i + r) * ldsrc + srccol0 + 4 * c);
    } else {
#pragma unroll
        for (int i = 0; i < 16; ++i) v[i] = (f32x4v){0.f, 0.f, 0.f, 0.f};
    }
    unsigned pk[16][2];
#pragma unroll
    for (int i = 0; i < 16; ++i) {
        unsigned a0 = __float_as_uint(v[i].x), a1 = __float_as_uint(v[i].y), a2 = __float_as_uint(v[i].z), a3 = __float_as_uint(v[i].w);
        { auto t = __builtin_amdgcn_permlane32_swap(a0, a2, false, false); a0 = t[0]; a2 = t[1]; }
        { auto t = __builtin_amdgcn_permlane32_swap(a1, a3, false, false); a1 = t[0]; a3 = t[1]; }
        { auto t = __builtin_amdgcn_permlane16_swap(a0, a1, false, false); a0 = t[0]; a1 = t[1]; }
        { auto t = __builtin_amdgcn_permlane16_swap(a2, a3, false, false); a2 = t[0]; a3 = t[1]; }
        const f32x4v g = gain(k0 + 4 * i);
        pk[i][0] = pk2(__uint_as_float(a0) * g.x, __uint_as_float(a1) * g.y); pk[i][1] = pk2(__uint_as_float(a2) * g.z, __uint_as_float(a3) * g.w);
    }
    bf16* drow = dst + (size_t)(n0 + 4 * c + r) * K + k0;
#pragma unroll
    for (int i = 0; i < 8; ++i) *(v4u*)(drow + 8 * i) = (v4u){pk[2 * i][0], pk[2 * i][1], pk[2 * i + 1][0], pk[2 * i + 1][1]};
}
__device__ __forceinline__ int win_col(int n) {
    if (n < 1536) return n;
    if (n < 1792) return n - 1536 + 1544;
    if (n < 1920) return n - 1792 + 1800;
    if (n < 1952) return n - 1920 + 1928;
    if (n < 1960) return n - 1952 + 1536;
    return -1;
}
template <class GainFn>
__device__ __forceinline__ void transpose_tile_win(const float* src, GainFn gain, bf16* dst, int k0, int n0, int lane) {
    const int r = lane >> 4, c = lane & 15; const int sc = win_col(n0 + 4 * c);
    f32x4v v[16];
#pragma unroll
    for (int i = 0; i < 16; ++i) v[i] = (sc >= 0) ? *(const f32x4v*)(src + (size_t)(k0 + 4 * i + r) * NIN + sc) : (f32x4v){0.f, 0.f, 0.f, 0.f};
    unsigned pk[16][2];
#pragma unroll
    for (int i = 0; i < 16; ++i) {
        unsigned a0 = __float_as_uint(v[i].x), a1 = __float_as_uint(v[i].y), a2 = __float_as_uint(v[i].z), a3 = __float_as_uint(v[i].w);
        { auto t = __builtin_amdgcn_permlane32_swap(a0, a2, false, false); a0 = t[0]; a2 = t[1]; }
        { auto t = __builtin_amdgcn_permlane32_swap(a1, a3, false, false); a1 = t[0]; a3 = t[1]; }
        { auto t = __builtin_amdgcn_permlane16_swap(a0, a1, false, false); a0 = t[0]; a1 = t[1]; }
        { auto t = __builtin_amdgcn_permlane16_swap(a2, a3, false, false); a2 = t[0]; a3 = t[1]; }
        pk[i][0] = pk2(__uint_as_float(a0), __uint_as_float(a1)); pk[i][1] = pk2(__uint_as_float(a2), __uint_as_float(a3));
    }
    bf16* drow = dst + (size_t)(n0 + 4 * c + r) * D + k0;
#pragma unroll
    for (int i = 0; i < 8; ++i) *(v4u*)(drow + 8 * i) = (v4u){pk[2 * i][0], pk[2 * i][1], pk[2 * i + 1][0], pk[2 * i + 1][1]};
}
__device__ void ph_prep(float* lds, float* mod, bf16* WIN_T, bf16* WOUT_T, bf16* WUQ_T, bf16* WUKV_T, float* WRT, bf16* WGU_T, bf16* WD_T) {
    const int tid = tidx(), lane = tid & 63, wave = tid >> 6;
    for (int item = blockIdx.x; item < 6 * D / 32; item += gridDim.x) {
        float* sc = lds;
        float* part = lds + 8 * D;
        const float* c = IN(1); const float* ada_w = IN(3); const float* ada_b = IN(4);
        __syncthreads();
        for (int i = tid; i < NB * D; i += NT) sc[i] = silu_f(c[i]);
        __syncthreads();
        const int kr = lane >> 3, cq = lane & 7; const int j0 = item * 32 + 4 * cq;
        f32x4v acc[NB];
#pragma unroll
        for (int b = 0; b < NB; ++b) acc[b] = (f32x4v){0.f, 0.f, 0.f, 0.f};
#pragma unroll 4
        for (int i = 0; i < 16; ++i) { const int k = wave * 128 + 8 * i + kr;
            const f32x4v w = *(const f32x4v*)(ada_w + (size_t)k * 6 * D + j0);
#pragma unroll
            for (int b = 0; b < NB; ++b) acc[b] += w * sc[b * D + k]; }
#pragma unroll
        for (int b = 0; b < NB; ++b) {
#pragma unroll
            for (int e = 0; e < 4; ++e) { float v = acc[b][e]; v += __shfl_xor(v, 8); v += __shfl_xor(v, 16); v += __shfl_xor(v, 32); acc[b][e] = v; } }
        if (lane < 8) {
#pragma unroll
            for (int b = 0; b < NB; ++b) *(f32x4v*)(part + (wave * NB + b) * 32 + 4 * lane) = acc[b]; }
        __syncthreads();
        if (tid < NB * 32) { const int b = tid >> 5, jj = tid & 31;
            float sm = ada_b[item * 32 + jj];
#pragma unroll
            for (int w = 0; w < 8; ++w) sm += part[(w * NB + b) * 32 + jj];
            mod[b * 6 * D + item * 32 + jj] = sm; }
    }
    __syncthreads();
    for (int i = blockIdx.x * NT + tid; i < 36 * D; i += gridDim.x * NT) { const int c = i >> 10, k = i & 1023;
        WRT[i] = (c < 4) ? IN(22)[k * 4 + c] : IN(24)[k * 32 + c - 4]; }
    const int gw = (gridDim.x - 1 - blockIdx.x) * (NT / 64) + wave, ngw = gridDim.x * (NT / 64);
    constexpr int I_IN = (D / 64) * (NU / 64), I_OUT = (D / 64) * (D / 64), I_UQ = (QR / 64) * (768 / 64), I_UKV = (256 / 64) * (1024 / 64);
    const float* ssd_norm = IN(15); const float* q_norm = IN(16); const float* kv_norm = IN(18); const float* mla_norm = IN(20);
    const auto one4 = [](int) { return (f32x4v){1.f, 1.f, 1.f, 1.f}; };
    constexpr int I_GU = NEXP * (D / 64) * (512 / 64);
    const int moe_lo = (gridDim.x >= 128) ? MOE_SPLIT : 0, n_moe = MOE_ITEMS - moe_lo;
    for (int it = gw; it < n_moe + I_IN + I_OUT + I_UQ + I_UKV; it += ngw) {
        int r = it;
        if (r < n_moe) { r += moe_lo;
            if (r < I_GU) { const int e = r >> 7, q = r & 127, kb = q >> 3, nb = q & 7;
                const int ct = nb >> 2, rr = (nb & 3) * 64; const float* src = (rr < 128 ? IN(26) : IN(27)) + (size_t)e * D * FF;
                transpose_tile(src, FF, 128 * ct + (rr & 127), one4, WGU_T + (size_t)e * 512 * D, D, kb * 64, nb * 64, lane); continue; }
            r -= I_GU;
            { const int e = r >> 6, q = r & 63, kb = q >> 4, nb = q & 15;
              transpose_tile(IN(28) + (size_t)e * FF * D, D, nb * 64, one4, WD_T + (size_t)e * D * FF, FF, kb * 64, nb * 64, lane); continue; } }
        r -= n_moe;
        if (r < I_IN) { const int nb = NU / 64; transpose_tile_win(IN(9), one4, WIN_T, (r / nb) * 64, (r % nb) * 64, lane); continue; }
        r -= I_IN;
        if (r < I_OUT) { const int nb = D / 64; transpose_tile(IN(21), D, (r % nb) * 64, [=](int k) { return k < 512 ? *(const f32x4v*)(ssd_norm + k) : *(const f32x4v*)(mla_norm + k - 512); }, WOUT_T, D, (r / nb) * 64, (r % nb) * 64, lane); continue; }
        r -= I_OUT;
        if (r < I_UQ) { const int nb = 768 / 64; transpose_tile(IN(17), 768, (r % nb) * 64, [=](int k) { return *(const f32x4v*)(q_norm + k) * 0.14724444f; }, WUQ_T, QR, (r / nb) * 64, (r % nb) * 64, lane); continue; }
        r -= I_UQ;
        { const int nb = 1024 / 64, kb = r / nb; transpose_tile(IN(19), 1024, kb < 2 ? (r % nb) * 64 : -1, [=](int k) { return k < KVR ? *(const f32x4v*)(kv_norm + k) : (f32x4v){0.f, 0.f, 0.f, 0.f}; }, WUKV_T, 256, kb * 64, (r % nb) * 64, lane); }
    }
}
__device__ void ph_prep_moe(bf16* WGU_T, bf16* WD_T, int rank, int nw, int it_lo, int it_hi) {
    const int lane = tidx() & 63; rank = __builtin_amdgcn_readfirstlane(rank);
    constexpr int I_GU = NEXP * (D / 64) * (512 / 64), I_DN = NEXP * (FF / 64) * (D / 64);
    const auto one4 = [](int) { return (f32x4v){1.f, 1.f, 1.f, 1.f}; };
    for (int it = it_lo + rank; it < it_hi; it += nw) {
        int r = it;
        if (r < I_GU) { const int e = r >> 7, q = r & 127, kb = q >> 3, nb = q & 7;
            const int ct = nb >> 2, rr = (nb & 3) * 64; const float* src = (rr < 128 ? IN(26) : IN(27)) + (size_t)e * D * FF;
            transpose_tile(src, FF, 128 * ct + (rr & 127), one4, WGU_T + (size_t)e * 512 * D, D, kb * 64, nb * 64, lane); continue; }
        r -= I_GU;
        { const int e = r >> 6, q = r & 63, kb = q >> 4, nb = q & 15;
          transpose_tile(IN(28) + (size_t)e * FF * D, D, nb * 64, one4, WD_T + (size_t)e * D * FF, FF, kb * 64, nb * 64, lane); }
    }
}

__device__ void ph_prenorm_bf16(const float* in, const float* g, const float* mod, int sh_off, int sc_off, bf16* out) {
    const int lane = tidx() & 63, gw = blockIdx.x * (NT / 64) + (tidx() >> 6), ngw = gridDim.x * (NT / 64);
    f32x4v nx[4];
    if (gw < M) { const f32x4v* r = (const f32x4v*)(in + (size_t)gw * D) + lane;
#pragma unroll
        for (int j = 0; j < 4; ++j) nx[j] = r[64 * j]; }
    for (int t = gw; t < M; t += ngw) {
        const int b = t / SEQ;
        f32x4v v[4]; float s = 0.f;
#pragma unroll
        for (int j = 0; j < 4; ++j) { v[j] = nx[j]; s += (v[j].x * v[j].x + v[j].y * v[j].y) + (v[j].z * v[j].z + v[j].w * v[j].w); }
        if (t + ngw < M) { const f32x4v* r = (const f32x4v*)(in + (size_t)(t + ngw) * D) + lane;
#pragma unroll
            for (int j = 0; j < 4; ++j) nx[j] = r[64 * j]; }
        const f32x4v* gp = (const f32x4v*)g + lane; const f32x4v* scp = (const f32x4v*)(mod + b * 6 * D + sc_off) + lane; const f32x4v* shp = (const f32x4v*)(mod + b * 6 * D + sh_off) + lane;
        f32x4v gg[4], sc[4], sh[4];
#pragma unroll
        for (int j = 0; j < 4; ++j) { gg[j] = gp[64 * j]; sc[j] = scp[64 * j]; sh[j] = shp[64 * j]; }
        const float inv = rsqrtf(wave_sum_valu(s) / D + EPS);
        unsigned long long* o8 = (unsigned long long*)(out + (size_t)t * D) + lane;
#pragma unroll
        for (int j = 0; j < 4; ++j) { const f32x4v h = v[j] * inv * gg[j] * (sc[j] + 1.f) + sh[j];
            o8[64 * j] = (unsigned long long)pk2(h.x, h.y) | ((unsigned long long)pk2(h.z, h.w) << 32); }
    }
}


__device__ void ph_prep2(const bf16* U, const int* pos, const float* conv_w, const float* conv_b, const float* dt_bias,
                         bf16* CQN, bf16* CKVN, bf16* KF, float* COS, float* SIN, float* DT, bf16* XC) {
    const int lane = tidx() & 63, gw = blockIdx.x * (NT / 64) + (tidx() >> 6), ngw = gridDim.x * (NT / 64);
    const int rows_per = (M + ngw - 1) / ngw;
    const int ch = lane * 16;
    f32x4v cw[4][4], cbv[4];
#pragma unroll
    for (int k = 0; k < 4; ++k)
#pragma unroll
        for (int q4 = 0; q4 < 4; ++q4) cw[k][q4] = *(const f32x4v*)(conv_w + k * SSD_XBC + ch + 4 * q4);
#pragma unroll
    for (int q4 = 0; q4 < 4; ++q4) cbv[q4] = *(const f32x4v*)(conv_b + ch + 4 * q4);
    const float inv_freq = exp2f(-(float)(lane & 15) * (13.287712379549449f / 16.0f));
    const float dtb = dt_bias[lane & 7];
    const int t_lo = gw * rows_per, t_hi = min((gw + 1) * rows_per, M);
    if (t_lo >= t_hi) return;
    v4u h0[2], h1[2], h2[2];
#define LDX(dst, tt_) do { if (((tt_) & (SEQ - 1)) <= (t_lo & (SEQ - 1)) && (tt_) >= 0 && ((tt_) >> 11) == (t_lo >> 11)) { const v4u* xp_ = (const v4u*)(U + (size_t)(tt_) * NU + OFF_XBC + ch); dst[0] = xp_[0]; dst[1] = xp_[1]; } \
                           else { dst[0] = (v4u){0u, 0u, 0u, 0u}; dst[1] = dst[0]; } } while (0)
    LDX(h0, t_lo - 3); LDX(h1, t_lo - 2); LDX(h2, t_lo - 1);
#undef LDX
    uint2 n_cq; unsigned n_ckv; unsigned short n_k1, n_k2, n_dt; v4u n_x[2]; int n_pos;
#define LDROW(tt_) do { const bf16* ur_ = U + (size_t)(tt_) * NU; n_cq = *(const uint2*)(ur_ + OFF_CQ + lane * 4); n_ckv = *(const unsigned*)(ur_ + OFF_CKV + lane * 2); \
        n_k1 = ur_[OFF_KR + (lane & 15)]; n_k2 = ur_[OFF_KR + 16 + (lane & 15)]; n_dt = ur_[OFF_DT + (lane & 7)]; const v4u* xp_ = (const v4u*)(ur_ + OFF_XBC + ch); n_x[0] = xp_[0]; n_x[1] = xp_[1]; n_pos = pos[tt_]; } while (0)
    LDROW(t_lo);
    for (int t = t_lo; t < t_hi; ++t) {
        const int sq = t & (SEQ - 1), b = t >> 11;
        const uint2 w_cq = n_cq; const unsigned w_ckv = n_ckv; const float x1 = bf2f(n_k1), x2 = bf2f(n_k2), dtr = bf2f(n_dt); const v4u cx0 = n_x[0], cx1 = n_x[1]; const int p_t = n_pos;
        if (t + 1 < t_hi) LDROW(t + 1);
        if (sq == 0) { h0[0] = (v4u){0u, 0u, 0u, 0u}; h0[1] = h0[0]; h1[0] = h0[0]; h1[1] = h0[0]; h2[0] = h0[0]; h2[1] = h0[0]; }
        { const float a0 = __uint_as_float(w_cq.x << 16), a1 = __uint_as_float(w_cq.x & 0xffff0000u), a2 = __uint_as_float(w_cq.y << 16), a3 = __uint_as_float(w_cq.y & 0xffff0000u);
          const float inv = rsqrtf(wave_sum_valu(a0 * a0 + a1 * a1 + a2 * a2 + a3 * a3) * (1.f / QR) + EPS);
          uint2 o; o.x = pk2(a0 * inv, a1 * inv); o.y = pk2(a2 * inv, a3 * inv);
          *(uint2*)(CQN + (size_t)t * QR + lane * 4) = o; }
        { const float a0 = __uint_as_float(w_ckv << 16), a1 = __uint_as_float(w_ckv & 0xffff0000u);
          const float inv = rsqrtf(wave_sum_valu(a0 * a0 + a1 * a1) * (1.f / KVR) + EPS);
          *(unsigned*)(CKVN + (size_t)t * 256 + lane * 2) = pk2(a0 * inv, a1 * inv);
          *(unsigned*)(CKVN + (size_t)t * 256 + 128 + lane * 2) = 0u; }
        { const int i = lane & 15;
          const float ang = (float)p_t * inv_freq;
          const float sn = __sinf(ang), cs = __cosf(ang);
          if (lane < 16) { COS[(size_t)t * 16 + i] = cs; SIN[(size_t)t * 16 + i] = sn; }
          const float r1 = x1 * cs - x2 * sn, r2 = x2 * cs + x1 * sn;
          const int cc = lane & 3, hh = (lane >> 2) & 7;
          float e[8];
#pragma unroll
          for (int j = 0; j < 8; ++j) { const float p1 = __shfl(r1, (cc & 1) * 8 + j), p2 = __shfl(r2, (cc & 1) * 8 + j); e[j] = (cc >> 1) ? p2 : p1; }
          if (lane < 32) { v4u o; o.x = pk2(e[0], e[1]); o.y = pk2(e[2], e[3]); o.z = pk2(e[4], e[5]); o.w = pk2(e[6], e[7]);
            *(v4u*)(KF + (size_t)((b * 8 + hh) * 32 + (sq >> 6)) * 6144 + (8 + cc) * 512 + (sq & 63) * 8) = o; } }
        if (lane < 8) { const float raw = dtr + dtb; DT[(size_t)t * 8 + lane] = raw > 20.f ? raw : log1pf(__expf(raw)); }
        { float acc[16];
#pragma unroll
          for (int q4 = 0; q4 < 4; ++q4) { acc[4 * q4] = cbv[q4].x; acc[4 * q4 + 1] = cbv[q4].y; acc[4 * q4 + 2] = cbv[q4].z; acc[4 * q4 + 3] = cbv[q4].w; }
#define TAP(k_, r_) do { const unsigned xw_[8] = {r_[0].x, r_[0].y, r_[0].z, r_[0].w, r_[1].x, r_[1].y, r_[1].z, r_[1].w}; \
              _Pragma("unroll") for (int q4 = 0; q4 < 4; ++q4) { const f32x4v ww_ = cw[k_][q4]; \
                  acc[4 * q4] += ww_.x * __uint_as_float(xw_[2 * q4] << 16); acc[4 * q4 + 1] += ww_.y * __uint_as_float(xw_[2 * q4] & 0xffff0000u); \
                  acc[4 * q4 + 2] += ww_.z * __uint_as_float(xw_[2 * q4 + 1] << 16); acc[4 * q4 + 3] += ww_.w * __uint_as_float(xw_[2 * q4 + 1] & 0xffff0000u); } } while (0)
          const v4u cur[2] = {cx0, cx1};
          TAP(0, h0); TAP(1, h1); TAP(2, h2); TAP(3, cur);
#undef TAP
          h0[0] = h1[0]; h0[1] = h1[1]; h1[0] = h2[0]; h1[1] = h2[1]; h2[0] = cx0; h2[1] = cx1;
#define SILU(v_) ((v_) * __builtin_amdgcn_rcpf(1.f + __expf(-(v_))))
          v4u o0, o1;
          o0.x = pk2(SILU(acc[0]), SILU(acc[1])); o0.y = pk2(SILU(acc[2]), SILU(acc[3])); o0.z = pk2(SILU(acc[4]), SILU(acc[5])); o0.w = pk2(SILU(acc[6]), SILU(acc[7]));
          o1.x = pk2(SILU(acc[8]), SILU(acc[9])); o1.y = pk2(SILU(acc[10]), SILU(acc[11])); o1.z = pk2(SILU(acc[12]), SILU(acc[13])); o1.w = pk2(SILU(acc[14]), SILU(acc[15]));
#undef SILU
          { bf16* base = XC + (size_t)(t >> 7) * 131072; const int l = t & 127;
            if (ch < 512) { v4u* op = (v4u*)(base + (ch >> 6) * 8192 + ((ch & 63) >> 5) * 4096 + l * 32 + (ch & 31)); op[0] = o0; op[1] = o1; }
            else { const int c2 = ch - 512; bf16* q = base + 65536 + (c2 >> 7) * 16384 + ((c2 & 127) >> 3) * 1024 + l * 8; *(v4u*)q = o0; *(v4u*)(q + 1024) = o1; } } }
    }
#undef LDROW
}


__device__ void ph_rowrouter(RLAS float* ldsf, const bf16* Yb, const float* x, const float* post_gain, const float* pre_gain, const float* mod, const float* WRT,
                             const float* bgr, const float* ber, float* out, bf16* H2, int* CNT, int* RT_E, int* RT_S, int* ETOK, float* EW) {
    const int tid = tidx(), lane = tid & 63, wave = tid >> 6;
    const int gw = blockIdx.x * (NT / 64) + wave, ngw = gridDim.x * (NT / 64);
    { const f32x4v* src = (const f32x4v*)WRT; RLAS f32x4v* dst = (RLAS f32x4v*)ldsf;
      for (int i = tid; i < 36 * 1024 / 4; i += NT) dst[i] = src[i]; }
    RLAS float* Lg = ldsf + 36 * 1024 + wave * 320;
    __syncthreads();
    const int b0 = lane & 1, b1 = (lane >> 1) & 1, b2 = (lane >> 2) & 1, b3 = (lane >> 3) & 1, b4 = (lane >> 4) & 1, b5 = lane >> 5;
    const int i4 = b0 + 2 * b1, i3 = i4 + 3 * b2, i2 = i3 + 5 * b3;
    const bool colok = (i4 <= 2) && (i3 <= 4) && (i2 <= 8); const int mycol = i2 + 9 * b4 + 18 * b5;
    const int rows_per = (M + ngw - 1) / ngw;
    for (int bi = 0; bi < (rows_per + 7) / 8; ++bi) {
        const int tb = gw * rows_per + 8 * bi; const int nr = max(0, min(8, min((gw + 1) * rows_per, M) - tb));
        uint2 ynx[4]; f32x4v xnx[4];
        if (nr > 0) { const uint2* yp0 = (const uint2*)(Yb + (size_t)tb * D) + lane; const f32x4v* xp0 = (const f32x4v*)(x + (size_t)tb * D) + lane;
#pragma unroll
            for (int j = 0; j < 4; ++j) { ynx[j] = yp0[64 * j]; xnx[j] = xp0[64 * j]; } }
        for (int ri = 0; ri < nr; ++ri) {
            const int t = tb + ri, b = t >> 11;
            f32x4v* op = (f32x4v*)(out + (size_t)t * D) + lane;
            f32x4v y[4], xv[4]; float ssy = 0.f;
#pragma unroll
            for (int j = 0; j < 4; ++j) { const uint2 w = ynx[j]; xv[j] = xnx[j];
                y[j].x = __uint_as_float(w.x << 16); y[j].y = __uint_as_float(w.x & 0xffff0000u); y[j].z = __uint_as_float(w.y << 16); y[j].w = __uint_as_float(w.y & 0xffff0000u);
                ssy += (y[j].x * y[j].x + y[j].y * y[j].y) + (y[j].z * y[j].z + y[j].w * y[j].w); }
            if (ri + 1 < nr) { const uint2* yp1 = (const uint2*)(Yb + (size_t)(t + 1) * D) + lane; const f32x4v* xp1 = (const f32x4v*)(x + (size_t)(t + 1) * D) + lane;
#pragma unroll
                for (int j = 0; j < 4; ++j) { ynx[j] = yp1[64 * j]; xnx[j] = xp1[64 * j]; } }
            const float invy = rsqrtf(wave_sum_valu(ssy) * (1.f / D) + EPS);
            const f32x4v* g1p = (const f32x4v*)(mod + b * 6 * D + 2 * D) + lane; const f32x4v* pgp = (const f32x4v*)post_gain + lane;
            float ss1 = 0.f;
#pragma unroll
            for (int j = 0; j < 4; ++j) { xv[j] = xv[j] + g1p[64 * j] * (y[j] * invy * pgp[64 * j]); op[64 * j] = xv[j];
                ss1 += (xv[j].x * xv[j].x + xv[j].y * xv[j].y) + (xv[j].z * xv[j].z + xv[j].w * xv[j].w); }
            const float inv1 = rsqrtf(wave_sum_valu(ss1) * (1.f / D) + EPS);
            const f32x4v* prp = (const f32x4v*)pre_gain + lane; const f32x4v* scp = (const f32x4v*)(mod + b * 6 * D + 4 * D) + lane; const f32x4v* shp = (const f32x4v*)(mod + b * 6 * D + 3 * D) + lane;
            uint2* hp = (uint2*)(H2 + (size_t)t * D) + lane;
#pragma unroll
            for (int j = 0; j < 4; ++j) { xv[j] = xv[j] * inv1 * prp[64 * j] * (scp[64 * j] + 1.f) + shp[64 * j];
                uint2 o; o.x = pk2(xv[j].x, xv[j].y); o.y = pk2(xv[j].z, xv[j].w); hp[64 * j] = o; }
            const RLAS f32x4v* wl = (const RLAS f32x4v*)ldsf + lane;
#define RDOT(c_) ({ const RLAS f32x4v* wc_ = wl + (c_) * 256; float a_ = 0.f; _Pragma("unroll") for (int j = 0; j < 4; ++j) { const f32x4v w_ = wc_[64 * j]; \
                a_ += (xv[j].x * w_.x + xv[j].y * w_.y) + (xv[j].z * w_.z + xv[j].w * w_.w); } a_; })
            float gl[4];
#pragma unroll
            for (int i = 0; i < 4; ++i) gl[i] = wave_sum_valu(RDOT(i)) + bgr[i];
            int gi = 0; float mxv = gl[0];
#pragma unroll
            for (int i = 1; i < 4; ++i) if (gl[i] > mxv) { mxv = gl[i]; gi = i; }
            gi = __builtin_amdgcn_readfirstlane(gi);
            float den = 0.f;
#pragma unroll
            for (int i = 0; i < 4; ++i) den += expf(gl[i] - mxv);
            float v1 = -INFINITY, v2 = -INFINITY; int i1 = 0, i2 = 0;
#pragma unroll
            for (int i = 0; i < 8; ++i) { const float v = wave_sum_valu(RDOT(4 + gi * 8 + i)) + ber[gi * 8 + i];
                if (v > v1) { v2 = v1; i2 = i1; v1 = v; i1 = i; } else if (v > v2) { v2 = v; i2 = i; } }
#undef RDOT
            const float p2 = expf(v2 - v1), gwt = 1.f / den;
            if (lane == 0) { Lg[ri * 40 + 0] = __int_as_float(gi * 8 + i1); Lg[ri * 40 + 1] = __int_as_float(gi * 8 + i2); Lg[ri * 40 + 2] = gwt / (1.f + p2); Lg[ri * 40 + 3] = gwt * p2 / (1.f + p2); }
        }
        asm volatile("s_waitcnt lgkmcnt(0)" ::: "memory");
        RLAS int* agg = (RLAS int*)(ldsf + 36 * 1024 + 8 * 320);
        if (tid < 32) agg[tid] = 0;
        __syncthreads();
        int e1 = 0, e2 = 0, r1 = 0, r2 = 0; float w1 = 0.f, w2 = 0.f;
        if (lane < nr) {
            const RLAS float* lr = Lg + lane * 40;
            e1 = __float_as_int(lr[0]); e2 = __float_as_int(lr[1]); w1 = lr[2]; w2 = lr[3];
            r1 = __hip_atomic_fetch_add(agg + e1, 1, __ATOMIC_RELAXED, __HIP_MEMORY_SCOPE_WORKGROUP);
            r2 = __hip_atomic_fetch_add(agg + e2, 1, __ATOMIC_RELAXED, __HIP_MEMORY_SCOPE_WORKGROUP);
        }
        __syncthreads();
        if (tid < 32) { const int c = agg[tid]; agg[32 + tid] = c ? atomicAdd(&CNT[tid * 64], c) : 0; }
        __syncthreads();
        if (lane < nr) { const int t = tb + lane;
            const int s1 = agg[32 + e1] + r1, s2 = agg[32 + e2] + r2;
            RT_E[t] = e1 | (e2 << 8); RT_S[2 * t] = s1; RT_S[2 * t + 1] = s2;
            ETOK[e1 * M + s1] = t; EW[e1 * M + s1] = w1; ETOK[e2 * M + s2] = t; EW[e2 * M + s2] = w2; }
        __syncthreads();
    }
    __syncthreads();
}
__device__ __forceinline__ void moe_table(int* tp, const int* CNT) {
    const int tid = tidx();
    __syncthreads();
    if (tid < 64) { const int c = (tid < 32) ? __hip_atomic_load(CNT + tid * 64, __ATOMIC_RELAXED, __HIP_MEMORY_SCOPE_AGENT) : 0; int v = (c + 255) >> 8;
        int inc = v;
#pragma unroll
        for (int o = 1; o < 64; o <<= 1) { const int n = __shfl_up(inc, o); if ((tid & 63) >= o) inc += n; }
        if (tid <= 32) tp[tid] = inc - v; }
    __syncthreads();
}
__device__ void ph_gather_tiles(const int* tp, const int* CNT, const bf16* H2, const int* ETOK, const float* EW, bf16* HG, float* ROWW) {
    const int lane = tidx() & 63, wave = tidx() >> 6;
    const int ntile = tp[32];
    for (int rtg = blockIdx.x; rtg < ntile; rtg += gridDim.x) {
        int e = 0;
        for (int j = 1; j < 32; ++j) e += (tp[j] <= rtg) ? 1 : 0;
        const int slot0 = (rtg - tp[e]) * 256, cnt = __hip_atomic_load(CNT + e * 64, __ATOMIC_RELAXED, __HIP_MEMORY_SCOPE_AGENT);
        const int myslot = slot0 + wave * 32 + (lane & 31); const bool ok = myslot < cnt;
        const int mytok = ok ? ETOK[e * M + myslot] : 0; const float myw = ok ? EW[e * M + myslot] : 0.f;
        if (lane < 32) ROWW[rtg * 256 + wave * 32 + lane] = myw;
        for (int i0 = 0; i0 < 32; i0 += 16) { v4u a[16], c[16];
#pragma unroll
            for (int i = 0; i < 16; ++i) { const int tok = __shfl(mytok, i0 + i); const v4u* src = (const v4u*)(H2 + (size_t)tok * D) + lane; a[i] = src[0]; c[i] = src[64]; }
#pragma unroll
            for (int i = 0; i < 16; ++i) { v4u* dst = (v4u*)(HG + (size_t)(rtg * 256 + wave * 32 + i0 + i) * D) + lane; dst[0] = a[i]; dst[64] = c[i]; } }
    }
    asm volatile("s_waitcnt vmcnt(0)" ::: "memory");
    __syncthreads();
}
__device__ void ph_moe_final(const bf16* YP, const int* tp, const int* RT_E, const int* RT_S, const float* gain, const float* mod, float* out) {
    const int lane = tidx() & 63, gw = blockIdx.x * (NT / 64) + (tidx() >> 6), ngw = gridDim.x * (NT / 64);
    v4u na[2], nc[2]; f32x4v nxa[2], nxb[2];
#define MF_LOAD(tt_) do { const int ee_ = RT_E[tt_]; const int r1_ = tp[ee_ & 255] * 256 + RT_S[2 * (tt_)], r2_ = tp[(ee_ >> 8) & 255] * 256 + RT_S[2 * (tt_) + 1]; \
        const v4u* p1_ = (const v4u*)(YP + (size_t)r1_ * D) + lane; const v4u* p2_ = (const v4u*)(YP + (size_t)r2_ * D) + lane; \
        _Pragma("unroll") for (int j = 0; j < 2; ++j) { na[j] = p1_[64 * j]; nc[j] = p2_[64 * j]; const float* op_ = out + (size_t)(tt_) * D + 512 * j + lane * 8; nxa[j] = *(const f32x4v*)op_; nxb[j] = *(const f32x4v*)(op_ + 4); } } while (0)
    if (gw < M) MF_LOAD(gw);
    for (int t = gw; t < M; t += ngw) { const int b = t >> 11;
        float y[16]; float ss = 0.f; f32x4v xa[2], xb[2];
#pragma unroll
        for (int j = 0; j < 2; ++j) { const v4u a = na[j], c = nc[j]; xa[j] = nxa[j]; xb[j] = nxb[j];
#pragma unroll
            for (int e = 0; e < 4; ++e) { const float v0 = __uint_as_float(a[e] << 16) + __uint_as_float(c[e] << 16), v1 = __uint_as_float(a[e] & 0xffff0000u) + __uint_as_float(c[e] & 0xffff0000u);
                y[8 * j + 2 * e] = v0; y[8 * j + 2 * e + 1] = v1; ss += v0 * v0 + v1 * v1; } }
        if (t + ngw < M) MF_LOAD(t + ngw);
        const float inv = rsqrtf(wave_sum_valu(ss) * (1.f / D) + EPS);
#pragma unroll
        for (int j = 0; j < 2; ++j) { const int col = 512 * j + lane * 8; float* op = out + (size_t)t * D + col;
            const f32x4v g2a = *(const f32x4v*)(mod + b * 6 * D + 5 * D + col), g2b = *(const f32x4v*)(mod + b * 6 * D + 5 * D + col + 4);
            const f32x4v ga = *(const f32x4v*)(gain + col), gb = *(const f32x4v*)(gain + col + 4);
            f32x4v a_ = xa[j], b_ = xb[j];
            a_.x += g2a.x * (y[8 * j + 0] * inv * ga.x); a_.y += g2a.y * (y[8 * j + 1] * inv * ga.y); a_.z += g2a.z * (y[8 * j + 2] * inv * ga.z); a_.w += g2a.w * (y[8 * j + 3] * inv * ga.w);
            b_.x += g2b.x * (y[8 * j + 4] * inv * gb.x); b_.y += g2b.y * (y[8 * j + 5] * inv * gb.y); b_.z += g2b.z * (y[8 * j + 6] * inv * gb.z); b_.w += g2b.w * (y[8 * j + 7] * inv * gb.w);
            *(f32x4v*)op = a_; *(f32x4v*)(op + 4) = b_; }
    }
#undef MF_LOAD
}
__device__ void ph_attn_ref(const bf16* Q, const bf16* KF, const bf16* VT, float* o) {
    const int lane = tidx() & 63, gw = blockIdx.x * (NT / 64) + (tidx() >> 6), ngw = gridDim.x * (NT / 64);
    for (int item = gw; item < NB * MLA_H * (SEQ / 64); item += ngw) {
        const int qb = (SEQ / 64 - 1) - item / (NB * MLA_H), bh = item % (NB * MLA_H), b = bh / MLA_H, h = bh % MLA_H;
        const int qi = qb * 64 + lane;
        const size_t t = (size_t)b * SEQ + qi;
        float qr[QK];
#pragma unroll
        for (int d = 0; d < QK; ++d) qr[d] = bf2f(Q[t * 768 + h * QK + d]);
        float acc[VD];
#pragma unroll
        for (int d = 0; d < VD; ++d) acc[d] = 0.f;
        float mx = -INFINITY, l = 0.f;
        const int kmax = qb * 64 + 63;
        for (int k = 0; k <= kmax; ++k) {
            const bf16* kt = KF + (size_t)(bh * 32 + (k >> 6)) * 6144 + (k & 63) * 8;
            const bf16* vt = VT + (size_t)(bh * 32 + (k >> 6)) * 4096 + (k & 63) * 32;
            float s = 0.f;
#pragma unroll
            for (int d = 0; d < QK; ++d) s += qr[d] * bf2f(kt[(d >> 3) * 512 + (d & 7)]);
            if (k <= qi) {
                const float mn = fmaxf(mx, s);
                const float f = exp2f(mx - mn), pv = exp2f(s - mn);
                l = l * f + pv;
#pragma unroll
                for (int d = 0; d < VD; ++d) acc[d] = acc[d] * f + pv * bf2f(vt[(d >> 5) * 2048 + (d & 31)]);
                mx = mn;
            }
        }
        const float il = 1.f / l;
#pragma unroll
        for (int d = 0; d < VD; ++d) o[t * (MLA_H * VD) + h * VD + d] = acc[d] * il;
    }
}

__device__ __forceinline__ void glds16(const void* gsrc, unsigned lds_dst) { unsigned keep;
    asm volatile("s_mov_b32 %0, m0\n\ts_mov_b32 m0, %2\n\ts_nop 0\n\tglobal_load_lds_dwordx4 %1, off\n\ts_mov_b32 m0, %0" : "=&s"(keep) : "v"(gsrc), "s"(lds_dst) : "memory"); }
namespace att {
typedef short bf16x8 __attribute__((ext_vector_type(8)));
typedef short s16x4 __attribute__((ext_vector_type(4)));
typedef float f32x16 __attribute__((ext_vector_type(16)));
typedef unsigned u32x4 __attribute__((ext_vector_type(4)));
#define ALAS __attribute__((address_space(3)))
constexpr int KSLOT = 12288, VSLOT = 8192, NSLOT = 3;
constexpr int LDS_K = 0, LDS_V = NSLOT * KSLOT, LDS_WS = LDS_V + NSLOT * VSLOT, LDS_OST = LDS_WS + 8 * 256, LDS_END = LDS_OST + 8 * 4096;
constexpr float THR = 8.0f;
__device__ __forceinline__ int crow(int r, int hi) { return (r & 3) + 8 * (r >> 2) + 4 * hi; }
__device__ __forceinline__ unsigned cvtpk(float lo, float hi) { typedef float f2 __attribute__((ext_vector_type(2))); typedef __bf16 b2 __attribute__((ext_vector_type(2)));
    f2 v = {lo, hi}; b2 b = __builtin_convertvector(v, b2); return __builtin_bit_cast(unsigned, b); }
__device__ __forceinline__ s16x4 vtr(const ALAS char* p) { typedef short v4 __attribute__((ext_vector_type(4))); return __builtin_bit_cast(s16x4, __builtin_amdgcn_ds_read_tr16_b64_v4i16((ALAS v4*)p)); }
#define AWAIT_BAR(N) asm volatile("s_waitcnt vmcnt(" #N ") lgkmcnt(0)\n\ts_barrier" ::: "memory")

__device__ __forceinline__ void attn_unit(ALAS char* lds, int bh, int qb, const bf16* Q, const bf16* KF, const bf16* VT, bf16* YC, float* SSQ) {
    const int tid = tidx(), lane = tid & 63, r32 = lane & 31, hi = lane >> 5; const int wid = __builtin_amdgcn_readfirstlane(tid >> 6);
    const int b = bh >> 3, h = bh & 7;
    const char* Kt = (const char*)(KF + (size_t)bh * 32 * 6144); const char* Vt = (const char*)(VT + (size_t)bh * 32 * 4096);
    const int NTL = 4 * (qb + 1);
    bf16x8 qf[6];
    { const bf16* qp = Q + (size_t)(b * SEQ + qb * 256 + wid * 32 + r32) * 768 + h * QK + hi * 8;
#pragma unroll
      for (int d0 = 0; d0 < 6; ++d0) qf[d0] = *(const bf16x8*)(qp + d0 * 16); }
    const unsigned koff0 = wid * 1024 + lane * 16, koff1 = (8 + (wid & 3)) * 1024 + lane * 16, voff = wid * 1024 + lane * 16;
    const unsigned lds0 = (unsigned)(uintptr_t)lds;
#define ADMA(t, slot) do { const char* kb_ = Kt + (size_t)(t) * KSLOT; const char* vb_ = Vt + (size_t)(t) * VSLOT; \
        glds16(kb_ + koff0, (unsigned)__builtin_amdgcn_readfirstlane(lds0 + LDS_K + (slot) * KSLOT + wid * 1024)); \
        glds16(kb_ + koff1, (unsigned)__builtin_amdgcn_readfirstlane(lds0 + LDS_K + (slot) * KSLOT + (8 + (wid & 3)) * 1024)); \
        glds16(vb_ + voff, (unsigned)__builtin_amdgcn_readfirstlane(lds0 + LDS_V + (slot) * VSLOT + wid * 1024)); } while (0)
    ADMA(0, 0); ADMA(1, 1);
    ALAS float* wsf = (ALAS float*)(lds + LDS_WS) + wid * 64;
    float mref = 0.f, l = 0.f;
    f32x16 o0 = {}, o1 = {}, negm = {};
    const int qrel = wid * 32 + r32;
    const int vlane = (4 * hi + ((lane & 15) >> 2)) * 64 + ((lane >> 4) & 1) * 32 + (lane & 3) * 8;
    int slot = 0;
#define MX3(a, b, c) __builtin_fmaxf(__builtin_fmaxf((a), (b)), (c))
#define EX2(v) __builtin_amdgcn_exp2f(v)
#define ATT_TILE(MASKED) do { \
        if (t + 1 < NTL) { AWAIT_BAR(3); } else { AWAIT_BAR(0); } \
        if (t + 2 < NTL) { const int s2 = (slot == 0) ? 2 : slot - 1; ADMA(t + 2, s2); } \
        const ALAS char* Ks = lds + LDS_K + slot * KSLOT + hi * 1024 + r32 * 16; \
        const ALAS char* Vs = lds + LDS_V + slot * VSLOT + vlane; \
        f32x16 p0 = negm, p1 = negm; \
        _Pragma("unroll") for (int d0 = 0; d0 < 6; ++d0) { \
            const bf16x8 ka0 = *(const ALAS bf16x8*)(Ks + d0 * 2048), ka1 = *(const ALAS bf16x8*)(Ks + d0 * 2048 + 512); \
            p0 = __builtin_amdgcn_mfma_f32_32x32x16_bf16(ka0, qf[d0], p0, 0, 0, 0); \
            p1 = __builtin_amdgcn_mfma_f32_32x32x16_bf16(ka1, qf[d0], p1, 0, 0, 0); } \
        if (MASKED) { const int jb = t - (NTL - 4); \
            _Pragma("unroll") for (int r = 0; r < 16; ++r) { const int kv = 64 * jb + crow(r, hi); if (kv > qrel) p0[r] = -INFINITY; if (kv + 32 > qrel) p1[r] = -INFINITY; } } \
        float rm; { float a_ = MX3(p0[0], p0[1], p1[0]), b_ = MX3(p0[2], p0[3], p1[1]); a_ = MX3(a_, p1[2], p1[3]); \
            _Pragma("unroll") for (int r = 4; r < 16; r += 4) { a_ = MX3(a_, p0[r], p0[r + 1]); b_ = MX3(b_, p0[r + 2], p0[r + 3]); a_ = MX3(a_, p1[r], p1[r + 1]); b_ = MX3(b_, p1[r + 2], p1[r + 3]); } \
            rm = fmaxf(a_, b_); } \
        { auto rr = __builtin_amdgcn_permlane32_swap(__float_as_uint(rm), __float_as_uint(rm), false, false); rm = fmaxf(__uint_as_float(rr[0]), __uint_as_float(rr[1])); } \
        if (t == 0 || __any(rm > THR)) { \
            const float dl = (t == 0) ? rm : fmaxf(rm, 0.f); \
            mref += dl; \
            _Pragma("unroll") for (int r = 0; r < 16; ++r) { p0[r] -= dl; p1[r] -= dl; } \
            _Pragma("unroll") for (int r = 0; r < 16; ++r) negm[r] = -mref; \
            const float f = EX2(-dl); l *= f; \
            if (t > 0) { \
                if (hi == 0) wsf[r32] = f; \
                asm volatile("s_waitcnt lgkmcnt(0)" ::: "memory"); \
                _Pragma("unroll") for (int r = 0; r < 16; ++r) { const float fr_ = wsf[crow(r, hi)]; o0[r] *= fr_; o1[r] *= fr_; } } } \
        float ls0 = 0.f, ls1 = 0.f; \
        _Pragma("unroll") for (int r = 0; r < 16; ++r) { p0[r] = EX2(p0[r]); p1[r] = EX2(p1[r]); ls0 += p0[r]; ls1 += p1[r]; } \
        l += ls0 + ls1; \
        u32x4 pw0 = {cvtpk(p0[0], p0[1]), cvtpk(p0[2], p0[3]), cvtpk(p0[4], p0[5]), cvtpk(p0[6], p0[7])}; \
        u32x4 pw1 = {cvtpk(p0[8], p0[9]), cvtpk(p0[10], p0[11]), cvtpk(p0[12], p0[13]), cvtpk(p0[14], p0[15])}; \
        u32x4 pw2 = {cvtpk(p1[0], p1[1]), cvtpk(p1[2], p1[3]), cvtpk(p1[4], p1[5]), cvtpk(p1[6], p1[7])}; \
        u32x4 pw3 = {cvtpk(p1[8], p1[9]), cvtpk(p1[10], p1[11]), cvtpk(p1[12], p1[13]), cvtpk(p1[14], p1[15])}; \
        PV_STEP(pw0, 0); PV_STEP(pw1, 1); PV_STEP(pw2, 2); PV_STEP(pw3, 3); \
        slot = (slot == 2) ? 0 : slot + 1; } while (0)
#define PV_STEP(PW, ks) do { const bf16x8 pa_ = __builtin_bit_cast(bf16x8, PW); \
            { const s16x4 a_ = vtr(Vs + (ks) * 1024), b_ = vtr(Vs + (ks) * 1024 + 512); const bf16x8 vf_ = {a_[0], a_[1], a_[2], a_[3], b_[0], b_[1], b_[2], b_[3]}; \
              o0 = __builtin_amdgcn_mfma_f32_32x32x16_bf16(pa_, vf_, o0, 0, 0, 0); } \
            { const s16x4 a_ = vtr(Vs + 4096 + (ks) * 1024), b_ = vtr(Vs + 4096 + (ks) * 1024 + 512); const bf16x8 vf_ = {a_[0], a_[1], a_[2], a_[3], b_[0], b_[1], b_[2], b_[3]}; \
              o1 = __builtin_amdgcn_mfma_f32_32x32x16_bf16(pa_, vf_, o1, 0, 0, 0); } } while (0)
    int t = 0;
    for (; t < NTL - 4; ++t) ATT_TILE(false);
    for (; t < NTL; ++t) ATT_TILE(true);
#undef PV_STEP
#undef ATT_TILE
#undef MX3
#undef EX2
    { auto rr = __builtin_amdgcn_permlane32_swap(__float_as_uint(l), __float_as_uint(l), false, false); l = __uint_as_float(rr[0]) + __uint_as_float(rr[1]); }
    if (hi == 0) wsf[32 + r32] = l;
    asm volatile("s_waitcnt lgkmcnt(0)" ::: "memory");
    ALAS bf16* stg = (ALAS bf16*)(lds + LDS_OST) + wid * 2048;
#pragma unroll
    for (int r = 0; r < 16; ++r) { const int orow = crow(r, hi); const float rl = 1.f / wsf[32 + orow];
        stg[orow * 64 + r32] = (bf16)f2bf(o0[r] * rl); stg[orow * 64 + 32 + r32] = (bf16)f2bf(o1[r] * rl); }
    asm volatile("s_waitcnt lgkmcnt(0)" ::: "memory");
    const size_t trow0 = (size_t)b * SEQ + qb * 256 + wid * 32;
#pragma unroll
    for (int i = 0; i < 4; ++i) { const int row = i * 8 + (lane >> 3), ch = lane & 7;
        const u32x4 v = *(const ALAS u32x4*)(stg + row * 64 + ch * 8);
        *(u32x4*)(YC + (trow0 + row) * 1024 + 512 + h * 64 + ch * 8) = v;
        float sq = 0.f;
#pragma unroll
        for (int e = 0; e < 4; ++e) { const float a = __uint_as_float(v[e] << 16), c = __uint_as_float(v[e] & 0xffff0000u); sq += a * a + c * c; }
        sq += __shfl_xor(sq, 1); sq += __shfl_xor(sq, 2); sq += __shfl_xor(sq, 4);
        if (ch == 0) SSQ[(trow0 + row) * 16 + 8 + h] = sq; }
    asm volatile("s_waitcnt lgkmcnt(0)\n\ts_barrier" ::: "memory");
#undef ADMA
}
__device__ __forceinline__ void attn_phase(ALAS char* lds, const bf16* Q, const bf16* KF, const bf16* VT, bf16* YC, float* SSQ) {
    const int G = gridDim.x, bid = blockIdx.x; const int vcu = (G % 8 == 0) ? (bid % 8) * (G / 8) + bid / 8 : bid;
    for (int p = vcu; p < 256; p += G) { const int bh = p >> 2, s = p & 3;
        attn_unit(lds, bh, 7 - s, Q, KF, VT, YC, SSQ);
        attn_unit(lds, bh, s, Q, KF, VT, YC, SSQ); }
}
#undef AWAIT_BAR
}
__device__ void ph_prenorm(const float* in, const float* g, const float* mod, int sh_off, int sc_off, float* out) {
    const int lane = tidx() & 63, gw = blockIdx.x * (NT / 64) + (tidx() >> 6), ngw = gridDim.x * (NT / 64);
    for (int t = gw; t < M; t += ngw) {
        const int b = t / SEQ; const float* r = in + (size_t)t * D;
        float s = 0.f;
        for (int i = lane; i < D; i += 64) s += r[i] * r[i];
        const float inv = rsqrtf(wave_sum(s) / D + EPS);
        for (int i = lane; i < D; i += 64)
            out[(size_t)t * D + i] = r[i] * inv * g[i] * (1.f + mod[b * 6 * D + sc_off + i]) + mod[b * 6 * D + sh_off + i];
    }
}
template <class TY> __device__ void ph_post(const float* base, const TY* y, const float* g, const float* mod, int gate_off, float* out) {
    const int lane = tidx() & 63, gw = blockIdx.x * (NT / 64) + (tidx() >> 6), ngw = gridDim.x * (NT / 64);
    for (int t = gw; t < M; t += ngw) {
        const int b = t / SEQ; const TY* r = y + (size_t)t * D;
        float s = 0.f;
        for (int i = lane; i < D; i += 64) { const float v = ldf(r + i); s += v * v; }
        const float inv = rsqrtf(wave_sum(s) / D + EPS);
        for (int i = lane; i < D; i += 64)
            out[(size_t)t * D + i] = base[(size_t)t * D + i] + mod[b * 6 * D + gate_off + i] * (ldf(r + i) * inv * g[i]);
    }
}
template <class TI> __device__ void ph_rms_slice(const TI* in, int ldi, int off, int n, const float* g, float* out, int ldo, int ooff) {
    const int lane = tidx() & 63, gw = blockIdx.x * (NT / 64) + (tidx() >> 6), ngw = gridDim.x * (NT / 64);
    for (int t = gw; t < M; t += ngw) {
        const TI* r = in + (size_t)t * ldi + off;
        float s = 0.f;
        for (int i = lane; i < n; i += 64) { const float v = ldf(r + i); s += v * v; }
        const float inv = rsqrtf(wave_sum(s) / n + EPS);
        for (int i = lane; i < n; i += 64) out[(size_t)t * ldo + ooff + i] = ldf(r + i) * inv * g[i];
    }
}

namespace ssd {
typedef short bf16x8 __attribute__((ext_vector_type(8)));
typedef short s16x4 __attribute__((ext_vector_type(4)));
typedef float f32x16 __attribute__((ext_vector_type(16)));
typedef unsigned u32x4 __attribute__((ext_vector_type(4)));
#define SLAS __attribute__((address_space(3)))
constexpr float LOG2E = 1.4426950408889634f;
__device__ __forceinline__ int crow(int r, int hi) { return (r & 3) + 8 * (r >> 2) + 4 * hi; }
__device__ __forceinline__ s16x4 vtr(const SLAS char* p) { typedef short v4 __attribute__((ext_vector_type(4))); return __builtin_bit_cast(s16x4, __builtin_amdgcn_ds_read_tr16_b64_v4i16((SLAS v4*)p)); }
__device__ __forceinline__ unsigned cvtpk(float lo, float hi) { typedef float f2 __attribute__((ext_vector_type(2))); typedef __bf16 b2 __attribute__((ext_vector_type(2)));
    f2 v = {lo, hi}; b2 b = __builtin_convertvector(v, b2); return __builtin_bit_cast(unsigned, b); }
#define SWAIT_BAR(N) asm volatile("s_waitcnt vmcnt(" #N ") lgkmcnt(0)\n\ts_barrier" ::: "memory")
#define SDMA(gsrc, ldst) glds16((gsrc), (unsigned)__builtin_amdgcn_readfirstlane((unsigned)(uintptr_t)(ldst)))

constexpr int SW_BUF = 49152, SW_TAB = 2 * SW_BUF;
__device__ __forceinline__ void state_sweep(SLAS char* lds, int b, int h, const bf16* XT, const float* DT, const float* a_log, float* ACS2, bf16* PREV) {
    const int tid = tidx(), lane = tid & 63, r32 = lane & 31, hi = lane >> 5; const int wid = __builtin_amdgcn_readfirstlane(tid >> 6);
    const int g = h >> 2, pt = wid & 1, nt = wid >> 1;
    const float a = -expf(a_log[h]);
    SLAS float* wtab = (SLAS float*)(lds + SW_TAB); SLAS float* ctab = wtab + 2048;
    const int trl = (4 * hi + ((lane & 15) >> 2));
    const int trc = 16 * ((lane >> 4) & 1) + 4 * (lane & 3);
#define SW_ISSUE(c_, buf_) do { const char* xs_ = (const char*)(XT + (size_t)(b * 16 + (c_)) * 131072 + h * 8192); const char* bs_ = (const char*)(XT + (size_t)(b * 16 + (c_)) * 131072 + 65536 + g * 16384); \
        _Pragma("unroll") for (int i_ = 0; i_ < 2; ++i_) SDMA(xs_ + (wid * 2 + i_) * 1024 + lane * 16, lds + (buf_) * SW_BUF + (wid * 2 + i_) * 1024); \
        _Pragma("unroll") for (int i_ = 0; i_ < 4; ++i_) SDMA(bs_ + (wid * 4 + i_) * 1024 + lane * 16, lds + (buf_) * SW_BUF + 16384 + (wid * 4 + i_) * 1024); } while (0)
    SW_ISSUE(0, 0);
#pragma unroll
    for (int cc = 0; cc < 2; ++cc) { const int c = 2 * wid + cc; const size_t t0 = (size_t)(b * 16 + c) * 128;
        const float d0 = DT[(t0 + 2 * lane) * 8 + h], d1 = DT[(t0 + 2 * lane + 1) * 8 + h];
        const float a0 = d0 * a, a1 = d1 * a; float inc = a0 + a1;
#pragma unroll
        for (int o = 1; o < 64; o <<= 1) { const float n = __shfl_up(inc, o); if (lane >= o) inc += n; }
        const float tot = __shfl(inc, 63); const float cs1 = inc, cs0 = inc - a1;
        wtab[c * 128 + 2 * lane] = d0 * expf(tot - cs0); wtab[c * 128 + 2 * lane + 1] = d1 * expf(tot - cs1);
        if (lane == 0) ctab[c] = expf(tot);
        ACS2[(t0 + 2 * lane) * 8 + h] = cs0 * LOG2E; ACS2[(t0 + 2 * lane + 1) * 8 + h] = cs1 * LOG2E; }
    f32x16 st = {};
    for (int c = 0; c < 16; ++c) {
        const int buf = c & 1;
        asm volatile("s_waitcnt vmcnt(4) lgkmcnt(0)\n\ts_barrier" ::: "memory");
        if (c + 1 < 16) SW_ISSUE(c + 1, buf ^ 1);
        const float cdec = ctab[c];
        { SLAS char* xp = lds + buf * SW_BUF + tid * 32; const int l = (tid >> 1) & 127; const float w = wtab[c * 128 + l];
          u32x4 q0 = *(SLAS u32x4*)xp, q1 = *(SLAS u32x4*)(xp + 16);
#pragma unroll
          for (int e = 0; e < 4; ++e) { q0[e] = cvtpk(__uint_as_float(q0[e] << 16) * w, __uint_as_float(q0[e] & 0xffff0000u) * w); q1[e] = cvtpk(__uint_as_float(q1[e] << 16) * w, __uint_as_float(q1[e] & 0xffff0000u) * w); }
          *(SLAS u32x4*)xp = q0; *(SLAS u32x4*)(xp + 16) = q1; }
        asm volatile("s_waitcnt lgkmcnt(0)\n\ts_barrier" ::: "memory");
        f32x16 acc = {};
        { const SLAS char* bb = lds + buf * SW_BUF + 16384 + ((32 * nt + trc) >> 3) * 2048 + ((32 * nt + trc) & 7) * 2 + trl * 16;
          const SLAS char* xb = lds + buf * SW_BUF + pt * 8192 + trl * 64 + trc * 2;
#pragma unroll
          for (int ks = 0; ks < 8; ++ks) {
              const s16x4 a0 = vtr(bb + ks * 256), a1 = vtr(bb + ks * 256 + 128); const s16x4 x0 = vtr(xb + ks * 1024), x1 = vtr(xb + ks * 1024 + 512);
              const bf16x8 af = {a0[0], a0[1], a0[2], a0[3], a1[0], a1[1], a1[2], a1[3]}, xf = {x0[0], x0[1], x0[2], x0[3], x1[0], x1[1], x1[2], x1[3]};
              acc = __builtin_amdgcn_mfma_f32_32x32x16_bf16(af, xf, acc, 0, 0, 0); } }
        { bf16* pv = PREV + (size_t)((b * 16 + c) * 8 + h) * 8192 + (32 * pt + r32) * 8 + 4 * hi;
#pragma unroll
          for (int rg = 0; rg < 4; ++rg) { uint2 o; o.x = cvtpk(st[4 * rg], st[4 * rg + 1]); o.y = cvtpk(st[4 * rg + 2], st[4 * rg + 3]); *(uint2*)(pv + (4 * nt + rg) * 512) = o; } }
#pragma unroll
        for (int r = 0; r < 16; ++r) st[r] = st[r] * cdec + acc[r];
    }
    asm volatile("s_waitcnt vmcnt(0) lgkmcnt(0)\n\ts_barrier" ::: "memory");
#undef SW_ISSUE
}

constexpr int P2_C = 0, P2_B = 32768, P2_XP = 65536, P2_TAB = 131072, P2_STG = 135168, P2_END = 151552;
__device__ __forceinline__ void chunk_unit(SLAS char* lds, int b, int c, int g, const bf16* XT, const bf16* PREV, const float* DT, const float* ACS2, const float* d_skip,
                                           const bf16* U, bf16* YC, float* SSQS) {
    const int tid = tidx(), lane = tid & 63, r32 = lane & 31, hi = lane >> 5; const int wid = __builtin_amdgcn_readfirstlane(tid >> 6);
    const int lb = wid >> 1, ph = wid & 1;
    const char* xt = (const char*)(XT + (size_t)(b * 16 + c) * 131072);
    const size_t t0 = (size_t)(b * 16 + c) * 128;
#pragma unroll
    for (int i = 0; i < 4; ++i) { SDMA(xt + (98304 + g * 16384) * 2 + (wid * 4 + i) * 1024 + lane * 16, lds + P2_C + (wid * 4 + i) * 1024);
                                  SDMA(xt + (65536 + g * 16384) * 2 + (wid * 4 + i) * 1024 + lane * 16, lds + P2_B + (wid * 4 + i) * 1024); }
#define P2_ISSUE(hh_) do { const int h_ = 4 * g + (hh_); const char* xs_ = xt + h_ * 16384; const char* ps_ = (const char*)(PREV + (size_t)((b * 16 + c) * 8 + h_) * 8192); \
        SLAS char* d_ = lds + P2_XP + ((hh_) & 1) * 32768; \
        _Pragma("unroll") for (int i_ = 0; i_ < 2; ++i_) { SDMA(xs_ + (wid * 2 + i_) * 1024 + lane * 16, d_ + (wid * 2 + i_) * 1024); SDMA(ps_ + (wid * 2 + i_) * 1024 + lane * 16, d_ + 16384 + (wid * 2 + i_) * 1024); } } while (0)
    P2_ISSUE(0);
    { SLAS float* tab = (SLAS float*)(lds + P2_TAB); const int hh = tid >> 7, l = tid & 127;
      tab[hh * 256 + l] = ACS2[(t0 + l) * 8 + 4 * g + hh]; tab[hh * 256 + 128 + l] = DT[(t0 + l) * 8 + 4 * g + hh]; }
    P2_ISSUE(1);
    SWAIT_BAR(4);
    bf16x8 cf[8];
#pragma unroll
    for (int ks = 0; ks < 8; ++ks) cf[ks] = *(const SLAS bf16x8*)(lds + P2_C + (2 * ks + hi) * 2048 + (32 * lb + r32) * 16);
    f32x16 cbt[4];
#pragma unroll
    for (int sb = 0; sb < 4; ++sb) { cbt[sb] = f32x16{};
        if (sb <= lb) {
#pragma unroll
            for (int ks = 0; ks < 8; ++ks) { const bf16x8 bfr = *(const SLAS bf16x8*)(lds + P2_B + (2 * ks + hi) * 2048 + (32 * sb + r32) * 16);
                cbt[sb] = __builtin_amdgcn_mfma_f32_32x32x16_bf16(bfr, cf[ks], cbt[sb], 0, 0, 0); } } }
    const int vlane = (4 * hi + ((lane & 15) >> 2)) * 64 + ((lane >> 4) & 1) * 32 + (lane & 3) * 8;
    const int lrow = 32 * lb + r32;
    for (int hh = 0; hh < 4; ++hh) {
        const int h = 4 * g + hh;
        const SLAS char* xb = lds + P2_XP + (hh & 1) * 32768; const SLAS char* pb = xb + 16384;
        const SLAS float* tab = (const SLAS float*)(lds + P2_TAB) + hh * 256;
        const float dsk = d_skip[h];
        u32x4 zpre[2];
#pragma unroll
        for (int i = 0; i < 2; ++i) zpre[i] = *(const u32x4*)(U + (t0 + 32 * lb + i * 16 + (lane >> 2)) * NU + OFF_Z + h * 64 + 32 * ph + 8 * (lane & 3));
        f32x16 o = {};
#pragma unroll
        for (int ks = 0; ks < 8; ++ks) { const bf16x8 pf = *(const SLAS bf16x8*)(pb + (2 * ks + hi) * 1024 + (32 * ph + r32) * 16);
            o = __builtin_amdgcn_mfma_f32_32x32x16_bf16(cf[ks], pf, o, 0, 0, 0); }
#pragma unroll
        for (int r = 0; r < 16; ++r) o[r] *= __builtin_amdgcn_exp2f(tab[32 * lb + crow(r, hi)]);
        const float al = tab[lrow];
#pragma unroll
        for (int sb = 0; sb < 4; ++sb) {
            if (sb <= lb) {
                float pr[16];
#pragma unroll
                for (int r = 0; r < 16; ++r) { const int sidx = 32 * sb + crow(r, hi);
                    float v = cbt[sb][r] * __builtin_amdgcn_exp2f(al - tab[sidx]) * tab[128 + sidx];
                    if (sb == lb) { v = (sidx <= lrow) ? v : 0.f; v += (sidx == lrow) ? dsk : 0.f; }
                    pr[r] = v; }
                const u32x4 pw0 = {cvtpk(pr[0], pr[1]), cvtpk(pr[2], pr[3]), cvtpk(pr[4], pr[5]), cvtpk(pr[6], pr[7])};
                const u32x4 pw1 = {cvtpk(pr[8], pr[9]), cvtpk(pr[10], pr[11]), cvtpk(pr[12], pr[13]), cvtpk(pr[14], pr[15])};
                const SLAS char* xv = xb + ph * 8192 + vlane + (2 * sb) * 1024;
                { const s16x4 a_ = vtr(xv), b_ = vtr(xv + 512); const bf16x8 vf = {a_[0], a_[1], a_[2], a_[3], b_[0], b_[1], b_[2], b_[3]};
                  o = __builtin_amdgcn_mfma_f32_32x32x16_bf16(__builtin_bit_cast(bf16x8, pw0), vf, o, 0, 0, 0); }
                { const s16x4 a_ = vtr(xv + 1024), b_ = vtr(xv + 1024 + 512); const bf16x8 vf = {a_[0], a_[1], a_[2], a_[3], b_[0], b_[1], b_[2], b_[3]};
                  o = __builtin_amdgcn_mfma_f32_32x32x16_bf16(__builtin_bit_cast(bf16x8, pw1), vf, o, 0, 0, 0); }
            }
        }
        SLAS bf16* stg = (SLAS bf16*)(lds + P2_STG) + wid * 1024;
#pragma unroll
        for (int r = 0; r < 16; ++r) stg[crow(r, hi) * 32 + r32] = (bf16)f2bf(o[r]);
        asm volatile("s_waitcnt lgkmcnt(0)" ::: "memory");
#pragma unroll
        for (int i = 0; i < 2; ++i) { const int row = i * 16 + (lane >> 2), ch = lane & 3; const size_t t = t0 + 32 * lb + row;
            const u32x4 ov = *(const SLAS u32x4*)(stg + row * 32 + ch * 8);
            const u32x4 zv = zpre[i];
            u32x4 w; float sq = 0.f;
#pragma unroll
            for (int e = 0; e < 4; ++e) { const float z0 = __uint_as_float(zv[e] << 16), z1 = __uint_as_float(zv[e] & 0xffff0000u);
                const float v0 = __uint_as_float(ov[e] << 16) * (z0 * __builtin_amdgcn_rcpf(1.f + __expf(-z0))), v1 = __uint_as_float(ov[e] & 0xffff0000u) * (z1 * __builtin_amdgcn_rcpf(1.f + __expf(-z1)));
                w[e] = cvtpk(v0, v1); const float r0 = __uint_as_float(w[e] << 16), r1 = __uint_as_float(w[e] & 0xffff0000u); sq += r0 * r0 + r1 * r1; }
            *(u32x4*)(YC + t * 1024 + h * 64 + 32 * ph + 8 * ch) = w;
            sq += __shfl_xor(sq, 1); sq += __shfl_xor(sq, 2);
            if (ch == 0) SSQS[t * 16 + h * 2 + ph] = sq; }
        if (hh < 3) {
            if (hh + 2 < 4) { asm volatile("s_waitcnt lgkmcnt(0)\n\ts_barrier" ::: "memory"); P2_ISSUE(hh + 2); SWAIT_BAR(4); }
            else { SWAIT_BAR(0); }
        }
    }
    asm volatile("s_waitcnt vmcnt(0) lgkmcnt(0)\n\ts_barrier" ::: "memory");
#undef P2_ISSUE
}
#undef SWAIT_BAR
#undef SDMA
}
__device__ void ph_gate_norm(const float* y, const bf16* u, bf16* YC) {
    const int lane = tidx() & 63, gw = blockIdx.x * (NT / 64) + (tidx() >> 6), ngw = gridDim.x * (NT / 64);
    for (int t = gw; t < M; t += ngw) {
        float v[8]; float s = 0.f;
#pragma unroll
        for (int j = 0; j < 8; ++j) { const int i = lane + 64 * j; v[j] = y[(size_t)t * SSD_INNER + i] * silu_f(bf2f(u[(size_t)t * NU + OFF_Z + i])); s += v[j] * v[j]; }
        const float inv = rsqrtf(wave_sum(s) / SSD_INNER + EPS);
#pragma unroll
        for (int j = 0; j < 8; ++j) YC[(size_t)t * 1024 + lane + 64 * j] = (bf16)f2bf(v[j] * inv);
    }
}
__device__ void ph_yc_norm(bf16* YC, const float* SSQS, const float* SSQ) {
    const int lane = tidx() & 63, gw = blockIdx.x * (NT / 64) + (tidx() >> 6), ngw = gridDim.x * (NT / 64);
    v4u nw0 = {0u, 0u, 0u, 0u}, nw1 = nw0;
    if (gw < M) { const v4u* p = (const v4u*)(YC + (size_t)gw * 1024) + lane; nw0 = p[0]; nw1 = p[64]; }
    for (int t = gw; t < M; t += ngw) {
        float ss = 0.f, sm = 0.f;
#pragma unroll
        for (int q = 0; q < 4; ++q) { const f32x4v a = *(const f32x4v*)(SSQS + (size_t)t * 16 + 4 * q); ss += (a.x + a.y) + (a.z + a.w); }
        { const f32x4v a = *(const f32x4v*)(SSQ + (size_t)t * 16 + 8), b = *(const f32x4v*)(SSQ + (size_t)t * 16 + 12); sm = (a.x + a.y) + (a.z + a.w) + (b.x + b.y) + (b.z + b.w); }
        v4u w0 = nw0, w1 = nw1;
        if (t + ngw < M) { const v4u* p = (const v4u*)(YC + (size_t)(t + ngw) * 1024) + lane; nw0 = p[0]; nw1 = p[64]; }
        const float invs = rsqrtf(ss * (1.f / 512.f) + EPS), invm = rsqrtf(sm * (1.f / 512.f) + EPS);
        v4u* p = (v4u*)(YC + (size_t)t * 1024) + lane;
#pragma unroll
        for (int e = 0; e < 4; ++e) { w0[e] = pk2(__uint_as_float(w0[e] << 16) * invs, __uint_as_float(w0[e] & 0xffff0000u) * invs); w1[e] = pk2(__uint_as_float(w1[e] << 16) * invm, __uint_as_float(w1[e] & 0xffff0000u) * invm); }
        p[0] = w0; p[64] = w1;
    }
}
__device__ void ph_gemm(float* lds, const float* A, int lda, const float* B, int ldb, float* C, int ldc, int Mr, int N, int K) {
    float (*As)[129] = (float (*)[129])lds;
    float (*Bs)[65] = (float (*)[65])(lds + 16 * 129);
    const int tx = tidx() & 15, ty = tidx() >> 4;
    const int ntn = (N + 63) / 64, ntm = Mr / 128;
    for (int tile = blockIdx.x; tile < ntn * ntm; tile += gridDim.x) {
        const int m0 = (tile / ntn) * 128, n0 = (tile % ntn) * 64;
        float acc[4][4] = {};
        for (int k0 = 0; k0 < K; k0 += 16) {
            for (int i = tidx(); i < 128 * 16; i += NT) { const int r = i >> 4, kk = i & 15; As[kk][r] = A[(size_t)(m0 + r) * lda + k0 + kk]; }
            for (int i = tidx(); i < 64 * 16; i += NT) { const int kk = i >> 6, cc = i & 63; Bs[kk][cc] = (n0 + cc < N) ? B[(size_t)(k0 + kk) * ldb + n0 + cc] : 0.f; }
            __syncthreads();
#pragma unroll
            for (int kk = 0; kk < 16; ++kk) {
                float a[4], b[4];
#pragma unroll
                for (int i = 0; i < 4; ++i) { a[i] = As[kk][ty * 4 + i]; b[i] = Bs[kk][tx * 4 + i]; }
#pragma unroll
                for (int i = 0; i < 4; ++i)
#pragma unroll
                    for (int j = 0; j < 4; ++j) acc[i][j] += a[i] * b[j];
            }
            __syncthreads();
        }
#pragma unroll
        for (int i = 0; i < 4; ++i)
#pragma unroll
            for (int j = 0; j < 4; ++j) { const int n = n0 + tx * 4 + j; if (n < N) C[(size_t)(m0 + ty * 4 + i) * ldc + n] = acc[i][j]; }
    }
}
__device__ void ph_conv(const bf16* u, const float* cw, const float* cb, float* xc) {
    for (size_t idx = (size_t)blockIdx.x * NT + tidx(); idx < (size_t)M * SSD_XBC; idx += (size_t)gridDim.x * NT) {
        const int ch = (int)(idx % SSD_XBC), t = (int)(idx / SSD_XBC), s = t % SEQ;
        float acc = cb[ch];
        for (int k = 0; k < 4; ++k) { const int ss = s - 3 + k; if (ss >= 0) acc += cw[k * SSD_XBC + ch] * bf2f(u[(size_t)(t - 3 + k) * NU + OFF_XBC + ch]); }
        xc[idx] = silu_f(acc);
    }
}
__device__ void ph_ssd_seq(const float* DT, const bf16* xc, const float* dt_bias, const float* a_log, const float* d_skip, float* y) {
    for (int item = blockIdx.x; item < NB * SSD_H; item += gridDim.x) {
        const int b = item / SSD_H, h = item % SSD_H, g = h / (SSD_H / SSD_G);
        const int p = tidx() >> 3, nq = tidx() & 7;
        const float a = -expf(a_log[h]), dsk = d_skip[h];
        float st[16];
#pragma unroll
        for (int i = 0; i < 16; ++i) st[i] = 0.f;
        for (int s = 0; s < SEQ; ++s) {
            const size_t t = (size_t)b * SEQ + s;
            const float dt = DT[t * 8 + h];
            const float da = expf(dt * a);
            const float xv = bf2f(xc[t * SSD_XBC + h * SSD_P + p]);
            const float xd = xv * dt;
            const bf16* Bp = xc + t * SSD_XBC + SSD_INNER + g * SSD_N + nq * 16;
            const bf16* Cp = xc + t * SSD_XBC + SSD_INNER + SSD_G * SSD_N + g * SSD_N + nq * 16;
            float acc = 0.f;
#pragma unroll
            for (int i = 0; i < 16; ++i) { st[i] = st[i] * da + xd * bf2f(Bp[i]); acc += bf2f(Cp[i]) * st[i]; }
            acc += __shfl_xor(acc, 1); acc += __shfl_xor(acc, 2); acc += __shfl_xor(acc, 4);
            if (nq == 0) y[t * SSD_INNER + h * SSD_P + p] = acc + dsk * xv;
        }
    }
}
__device__ void ph_rope(float* q, const bf16* u, const int* pos, float* kpe) {
    for (int idx = blockIdx.x * NT + tidx(); idx < M * 9 * 16; idx += gridDim.x * NT) {
        const int i = idx % 16, hh = (idx / 16) % 9, t = idx / (16 * 9);
        const float inv = 1.0f / powf(10000.0f, (float)(2 * i) / 32.0f);
        const float ang = (float)pos[t] * inv;
        float sn, cs; sincosf(ang, &sn, &cs);
        if (hh < 8) {
            float* p = q + (size_t)t * (MLA_H * QK) + hh * QK + NOPE;
            const float x1 = p[i], x2 = p[16 + i];
            p[i] = x1 * cs - x2 * sn; p[16 + i] = x2 * cs + x1 * sn;
        } else {
            const bf16* p = u + (size_t)t * NU + OFF_KR;
            const float x1 = bf2f(p[i]), x2 = bf2f(p[16 + i]);
            kpe[(size_t)t * ROPE + i] = x1 * cs - x2 * sn; kpe[(size_t)t * ROPE + 16 + i] = x2 * cs + x1 * sn;
        }
    }
}
__device__ void ph_attn(const float* q, const float* kv, const float* kpe, float* o) {
    const int lane = tidx() & 63, gw = blockIdx.x * (NT / 64) + (tidx() >> 6), ngw = gridDim.x * (NT / 64);
    for (int item = gw; item < NB * MLA_H * (SEQ / 64); item += ngw) {
        const int qb = (SEQ / 64 - 1) - item / (NB * MLA_H), bh = item % (NB * MLA_H), b = bh / MLA_H, h = bh % MLA_H;
        const int qi = qb * 64 + lane;
        const size_t t = (size_t)b * SEQ + qi;
        float qr[QK];
#pragma unroll
        for (int d = 0; d < QK; ++d) qr[d] = q[t * (MLA_H * QK) + h * QK + d] * 0.10206207261596575f;
        float acc[VD];
#pragma unroll
        for (int d = 0; d < VD; ++d) acc[d] = 0.f;
        float mx = -INFINITY, l = 0.f;
        const int kmax = qb * 64 + 63;
        for (int k = 0; k <= kmax; ++k) {
            const size_t tk = (size_t)b * SEQ + k;
            const float* kn = kv + tk * (MLA_H * 128) + h * 128;
            const float* kp = kpe + tk * ROPE;
            float s = 0.f;
#pragma unroll
            for (int d = 0; d < NOPE; ++d) s += qr[d] * kn[d];
#pragma unroll
            for (int d = 0; d < ROPE; ++d) s += qr[NOPE + d] * kp[d];
            if (k <= qi) {
                const float mn = fmaxf(mx, s);
                const float f = expf(mx - mn), pv = expf(s - mn);
                l = l * f + pv;
#pragma unroll
                for (int d = 0; d < VD; ++d) acc[d] = acc[d] * f + pv * kn[64 + d];
                mx = mn;
            }
        }
        const float il = 1.f / l;
#pragma unroll
        for (int d = 0; d < VD; ++d) o[t * (MLA_H * VD) + h * VD + d] = acc[d] * il;
    }
}
__device__ void ph_moe(float* lds, const float* h2, const float* wgr, const float* bgr, const float* wer, const float* ber,
                       const float* wg, const float* wu, const float* wd, float* y2) {
    const int sb = tidx() >> 8, tid = tidx() & 255;
    float* xs = lds + sb * 2048;
    float* logit = xs + 1024;
    float* hid = xs + 1088;
    int* sel_e = (int*)(xs + 1600);
    float* sel_w = xs + 1604;
    for (int it = blockIdx.x; it < M / 2; it += gridDim.x) {
        const int t = it * 2 + sb;
        __syncthreads();
        for (int i = tid; i < D; i += 256) xs[i] = h2[(size_t)t * D + i];
        __syncthreads();
        {
            const int w = tid >> 6, lane = tid & 63;
            for (int cidx = w * 9; cidx < w * 9 + 9; ++cidx) {
                float s = 0.f;
                for (int k = lane; k < D; k += 64) s += xs[k] * (cidx < 4 ? wgr[k * 4 + cidx] : wer[k * 32 + (cidx - 4)]);
                s = wave_sum(s);
                if (lane == 0) logit[cidx] = s;
            }
        }
        __syncthreads();
        if (tid == 0) {
            float mxv = -INFINITY; int gi = 0;
            for (int i = 0; i < 4; ++i) { const float v = logit[i] + bgr[i]; logit[i] = v; if (v > mxv) { mxv = v; gi = i; } }
            float den = 0.f; for (int i = 0; i < 4; ++i) den += expf(logit[i] - mxv);
            const float gw = 1.f / den;
            float emx = -INFINITY; int i1 = 0;
            for (int i = 0; i < 8; ++i) { const float v = logit[4 + gi * 8 + i] + ber[gi * 8 + i]; logit[4 + gi * 8 + i] = v; if (v > emx) { emx = v; i1 = i; } }
            float e2 = -INFINITY; int i2 = 0;
            for (int i = 0; i < 8; ++i) { const float v = logit[4 + gi * 8 + i]; if (i != i1 && v > e2) { e2 = v; i2 = i; } }
            const float p2 = expf(e2 - emx);
            sel_e[0] = gi * 8 + i1; sel_e[1] = gi * 8 + i2;
            sel_w[0] = gw / (1.f + p2); sel_w[1] = gw * p2 / (1.f + p2);
        }
        __syncthreads();
        for (int k2 = 0; k2 < 2; ++k2) {
            const int e = sel_e[k2];
            const float* G = wg + (size_t)e * D * FF; const float* U = wu + (size_t)e * D * FF;
            float ga = 0.f, ua = 0.f;
            for (int k = 0; k < D; ++k) { ga += xs[k] * G[(size_t)k * FF + tid]; ua += xs[k] * U[(size_t)k * FF + tid]; }
            hid[k2 * FF + tid] = silu_f(ga) * ua * sel_w[k2];
        }
        __syncthreads();
        for (int d = tid; d < D; d += 256) {
            float acc = 0.f;
            for (int k2 = 0; k2 < 2; ++k2) {
                const float* Wd = wd + (size_t)sel_e[k2] * FF * D;
                for (int f = 0; f < FF; ++f) acc += hid[k2 * FF + f] * Wd[(size_t)f * D + d];
            }
            y2[(size_t)t * D + d] = acc;
        }
    }
}


#define LAS __attribute__((address_space(3)))
#define XB_TMO      128
#define XB_XCNT(j)  (256  + 64 * (j))
#define XB_XSUB(j)  (1280 + 64 * (j))
#define XB_XGEN(j)  (2304 + 64 * (j))
#define XB_TOP      3328
#define XB_TOPGEN   3392
#define XCD_BAR_WORDS 3456
#define XB_SPIN_CAP (1u << 18)

__device__ __forceinline__ unsigned xb_ld(unsigned* p)              { return __hip_atomic_load(p, __ATOMIC_RELAXED, __HIP_MEMORY_SCOPE_AGENT); }
__device__ __forceinline__ unsigned xb_add(unsigned* p, unsigned v) { return __hip_atomic_fetch_add(p, v, __ATOMIC_RELAXED, __HIP_MEMORY_SCOPE_AGENT); }
__device__ __forceinline__ unsigned xb_xcc_id() { return (unsigned)__builtin_amdgcn_s_getreg((3 << 11) | 20) & 0xFu; }
#define XB_SPIN(cond, bar) do { unsigned _sp = 0; while (cond) { __builtin_amdgcn_s_sleep(1); \
    if ((++_sp & 255u) == 0u) { if (xb_ld(&(bar)[XB_TMO])) break; if (_sp > XB_SPIN_CAP) { atomicAdd(&(bar)[XB_TMO], 1u); break; } } } } while (0)

struct XcdBarrier {
    unsigned* bar; unsigned x;
    volatile LAS unsigned* st;
};

__device__ __forceinline__ XcdBarrier xcd_barrier_post(unsigned* bar, volatile LAS unsigned* st) {
    XcdBarrier b; b.bar = bar; b.x = xb_xcc_id(); b.st = st;
    if (tidx() == 0) (void)xb_add(&bar[XB_XCNT(b.x)], 1u);
    return b;
}
__device__ __forceinline__ void xcd_barrier_complete(unsigned* bar, unsigned x, unsigned& nloc, unsigned& nx) {
    const unsigned G = gridDim.x * gridDim.y * gridDim.z;
    unsigned sum, cnt, mine, sp = 0u;
    for (;;) {
        sum = 0u; cnt = 0u; mine = 0u;
#pragma unroll
        for (unsigned j = 0; j < 16; ++j) { const unsigned c = xb_ld(&bar[XB_XCNT(j)]); sum += c; cnt += (c > 0u) ? 1u : 0u; mine = (j == x) ? c : mine; }
        if (sum == G) break;
        __builtin_amdgcn_s_sleep(1);
        if ((++sp & 255u) == 0u) { if (xb_ld(&bar[XB_TMO])) break; if (sp > XB_SPIN_CAP) { atomicAdd(&bar[XB_TMO], 1u); break; } }
    }
    nloc = mine > 0u ? mine : 1u; nx = cnt > 0u ? cnt : 1u;
}

__device__ __forceinline__ void xcd_barrier(const XcdBarrier& b) {
    asm volatile("s_waitcnt vmcnt(0)" ::: "memory");
    __syncthreads();
    if (tidx() == 0) {
        unsigned* bar = b.bar;
        __builtin_amdgcn_s_waitcnt(0);
        unsigned nloc = b.st[0], nx = b.st[1];
        if (nloc == 0u) { xcd_barrier_complete(bar, b.x, nloc, nx); b.st[0] = nloc; b.st[1] = nx; }
        const unsigned old = xb_add(&bar[XB_XSUB(b.x)], 1u);
        const unsigned gen = old / nloc;
        if (old + 1u == (gen + 1u) * nloc) {
            __builtin_amdgcn_fence(__ATOMIC_RELEASE, "agent");
            asm volatile("s_waitcnt vmcnt(0)" ::: "memory");
            const unsigned og = xb_add(&bar[XB_TOP], 1u);
            const unsigned tg = og / nx;
            if (og + 1u == (tg + 1u) * nx) xb_add(&bar[XB_TOPGEN], 1u);
            else XB_SPIN(xb_ld(&bar[XB_TOPGEN]) == tg, bar);
            __builtin_amdgcn_fence(__ATOMIC_ACQUIRE, "agent");
            xb_add(&bar[XB_XGEN(b.x)], 1u);
            asm volatile("s_waitcnt vmcnt(0)" ::: "memory");
        } else {
            XB_SPIN(xb_ld(&bar[XB_XGEN(b.x)]) == gen, bar);
            __builtin_amdgcn_fence(__ATOMIC_ACQUIRE, "agent");
            asm volatile("s_waitcnt vmcnt(0)" ::: "memory");
        }
    }
    __syncthreads();
}


constexpr size_t MiB = 1u << 20;
#define WSB(T, off) ((T*)(kargs()->ws + (size_t)(off)))
#define OUTB(T, off) ((T*)((char*)kargs()->out + (size_t)(off)))
#define B_CNT    WSB(int, 4096)
#define B_MOD    WSB(float, 1 * MiB)
#define B_DT     WSB(float, 1 * MiB + 256 * 1024)
#define B_ACS2   WSB(float, 1 * MiB + 768 * 1024)
#define B_WIN    WSB(bf16, 2 * MiB)
#define B_WOUT   WSB(bf16, 6 * MiB)
#define B_WUQ    WSB(bf16, 8 * MiB)
#define B_WUKV   WSB(bf16, 9 * MiB)
#define B_WRT    WSB(float, 9 * MiB + 512 * 1024)
#define B_WGU    WSB(bf16, 10 * MiB)
#define B_WD     WSB(bf16, 42 * MiB)
#define B_HB     WSB(bf16, 58 * MiB)
#define B_YC     WSB(bf16, 58 * MiB)
#define B_H2     WSB(bf16, 58 * MiB)
#define B_U      WSB(bf16, 90 * MiB)
#define B_HG     WSB(bf16, 90 * MiB)
#define B_YP     WSB(bf16, 90 * MiB)
#define B_XT     WSB(bf16, 154 * MiB)
#define B_YB     WSB(bf16, 154 * MiB)
#define B_HID    WSB(bf16, 170 * MiB)
#define B_Q      WSB(bf16, 186 * MiB)
#define B_ETOK   WSB(int, 192 * MiB)
#define B_EW     WSB(float, 196 * MiB)
#define B_KF     WSB(bf16, 210 * MiB)
#define B_VT     WSB(bf16, 234 * MiB)
#define B_COS    WSB(float, 250 * MiB)
#define B_SIN    WSB(float, 251 * MiB)
#define B_RTE    WSB(int, 250 * MiB)
#define B_RTS    WSB(int, 250 * MiB + 256 * 1024)
#define B_RTW    WSB(float, 250 * MiB + 512 * 1024)
#define B_TOKROW WSB(int, 250 * MiB + 768 * 1024)
#define B_ROWW   WSB(float, 251 * MiB)
#define B_SSQ    WSB(float, 252 * MiB)
#define B_SSQS   WSB(float, 253 * MiB)
#define B_PREV   OUTB(bf16, 0)
#define B_CQN    OUTB(bf16, 32 * MiB)
#define B_CKVN   OUTB(bf16, 40 * MiB)
#define LDS_TP   ((int*)(lds_raw + 131072 + 1024))

__global__ void __launch_bounds__(NT, 2) mega_fwd(Params P) {
    if (threadIdx.x < 2) ((volatile LAS unsigned*)(lds_raw + WTAB_OFF - 16))[threadIdx.x] = 0u;
    tidx_init();
    float* lds = (float*)lds_raw;
    const XcdBarrier bar = xcd_barrier_post((unsigned*)(kargs()->ws + 16384), (volatile LAS unsigned*)(lds_raw + WTAB_OFF - 16));
#define GSYNC() xcd_barrier(bar)
    ph_prep(lds, B_MOD, B_WIN, B_WOUT, B_WUQ, B_WUKV, B_WRT, B_WGU, B_WD);
    GSYNC();
    ph_prenorm_bf16(IN(0), IN(5), B_MOD, 0 * D, 1 * D, B_HB);
    GSYNC();
    { pg8::Gemm g{B_HB, B_WIN, M, NU, D}; pg8::StaticOrder S; S.init(M, NU, gridDim.x, (int)blockIdx.x);
      pg8::EpiBf16<0> E{B_U, NU};
      pg8::gemm_phase<pg8::EpiBf16<0>, pg8::StaticOrder, true, true>((PG8_LAS unsigned char*)lds_raw, g, S, E); }
    GSYNC();
    ph_prep2(B_U, kargs()->pos, IN(10), IN(11), IN(12), B_CQN, B_CKVN, B_KF, B_COS, B_SIN, B_DT, B_XT);
    GSYNC();
    {
      const int G = gridDim.x, bid = blockIdx.x; const bool split = G >= 128;
      if (!split || bid < 64) { for (int it = bid; it < 64; it += (split ? 64 : G)) ssd::state_sweep((SLAS char*)lds_raw, it >> 3, it & 7, B_XT, B_DT, IN(13), B_ACS2, B_PREV); }
      if (!split || bid >= 64) { const int Gg = split ? G - 64 : G, cg_ = split ? bid - 64 : bid;
        { pg8::Gemm g{B_CQN, B_WUQ, M, 768, QR}; pg8::StaticOrder S; S.init(M, 768, Gg, cg_);
          pg8::EpiQ E{B_Q, B_COS, B_SIN};
          pg8::gemm_phase<pg8::EpiQ, pg8::StaticOrder, true, false>((PG8_LAS unsigned char*)lds_raw, g, S, E); }
        { pg8::Gemm g{B_CKVN, B_WUKV, M, 1024, 256}; pg8::StaticOrder S; S.init(M, 1024, Gg, cg_);
          pg8::EpiKV E{B_KF, B_VT};
          pg8::gemm_phase<pg8::EpiKV, pg8::StaticOrder, true, false>((PG8_LAS unsigned char*)lds_raw, g, S, E); }
        ph_prep_moe(B_WGU, B_WD, cg_ * (NT / 64) + (tidx() >> 6), Gg * (NT / 64), 0, split ? MOE_SPLIT : 0); } }
    GSYNC();
    att::attn_phase((ALAS char*)lds_raw, B_Q, B_KF, B_VT, B_YC, B_SSQ);
    { const int G = gridDim.x, bid = blockIdx.x; const int vcu = (G % 8 == 0) ? (bid % 8) * (G / 8) + bid / 8 : bid;
      for (int u = vcu; u < 256; u += G) ssd::chunk_unit((SLAS char*)lds_raw, u >> 5, (u >> 1) & 15, u & 1, B_XT, B_PREV, B_DT, B_ACS2, IN(14), B_U, B_YC, B_SSQS); }
    GSYNC();
    ph_yc_norm(B_YC, B_SSQS, B_SSQ);
    GSYNC();
    { pg8::Gemm g{B_YC, B_WOUT, M, D, D}; pg8::StaticOrder S; S.init(M, D, gridDim.x, (int)blockIdx.x);
      pg8::EpiBf16<0> E{B_YB, D};
      pg8::gemm_phase<pg8::EpiBf16<0>, pg8::StaticOrder, true, true>((PG8_LAS unsigned char*)lds_raw, g, S, E); }
    GSYNC();
    ph_rowrouter((__attribute__((address_space(3))) float*)lds_raw, B_YB, IN(0), IN(6), IN(7), B_MOD, B_WRT, IN(23), IN(25), kargs()->out, B_H2, B_CNT, B_RTE, B_RTS, B_ETOK, B_EW);
    GSYNC();
    moe_table(LDS_TP, B_CNT);
    ph_gather_tiles(LDS_TP, B_CNT, B_H2, B_ETOK, B_EW, B_HG, B_ROWW);
    { pg8::Gemm g{B_HG, B_WGU, 0, 0, D}; pg8::OwnTileOrder S{(const PG8_LAS int*)LDS_TP, 2, (int)gridDim.x, (int)blockIdx.x};
      pg8::EpiGU E{B_HID, B_ROWW};
      pg8::gemm_phase<pg8::EpiGU, pg8::OwnTileOrder, true, true>((PG8_LAS unsigned char*)lds_raw, g, S, E); }
    GSYNC();
    { pg8::Gemm g{B_HID, B_WD, 0, 0, FF}; pg8::GroupedOrder S{(const PG8_LAS int*)LDS_TP, 4, (int)gridDim.x, (int)blockIdx.x};
      pg8::EpiDown E{B_YP};
      pg8::gemm_phase<pg8::EpiDown, pg8::GroupedOrder, true, true>((PG8_LAS unsigned char*)lds_raw, g, S, E); }
    GSYNC();
    ph_moe_final(B_YP, LDS_TP, B_RTE, B_RTS, IN(8), B_MOD, kargs()->out);
}

extern "C" void kernel_launch(void* const* d_in, const int* in_sizes, int n_in, void* d_out, int out_size, void* d_ws, size_t ws_size,
                              hipStream_t stream) {
    static int grid_blocks = 0;
    if (!grid_blocks) {
        int dev = 0, cus = 0, per_cu = 0;
        (void)hipGetDevice(&dev);
        (void)hipDeviceGetAttribute(&cus, hipDeviceAttributeMultiprocessorCount, dev);
        (void)hipFuncSetAttribute((const void*)mega_fwd, hipFuncAttributeMaxDynamicSharedMemorySize, LDS_BYTES);
        (void)hipOccupancyMaxActiveBlocksPerMultiprocessor(&per_cu, (const void*)mega_fwd, NT, LDS_BYTES);
        if (per_cu < 1) { fprintf(stderr, "occupancy query returned %d\n", per_cu); per_cu = 1; }
        grid_blocks = cus * per_cu;
    }
    (void)hipMemsetAsync(d_ws, 0, 65536, stream);
    Params p{};
    for (int i = 0; i < 29; ++i) p.in[i] = (const float*)d_in[i];
    p.pos = (const int*)d_in[2];
    p.out = (float*)d_out;
    p.ws = (char*)d_ws;
    void* args[] = {&p};
    hipError_t e = hipLaunchCooperativeKernel((void*)mega_fwd, dim3(grid_blocks), dim3(NT), args, LDS_BYTES, stream);
    if (e != hipSuccess) fprintf(stderr, "cooperative launch failed: %s (grid %d)\n", hipGetErrorString(e), grid_blocks);
}
```

```cpp
#include <hip/hip_runtime.h>
#include <hip/hip_cooperative_groups.h>
#include <stdint.h>
#include <math.h>
#include <cstdio>
namespace cg = cooperative_groups;

constexpr int D = 1024, NB = 8, SEQ = 2048, M = NB * SEQ;
constexpr int SSD_H = 8, SSD_P = 64, SSD_INNER = 512, SSD_G = 2, SSD_N = 128, SSD_XBC = 1024;
constexpr int MLA_H = 8, NOPE = 64, ROPE = 32, QK = 96, VD = 64, QR = 256, KVR = 128;
constexpr int NIN = 1960;
constexpr int NU = 2048;
constexpr int OFF_Z = 0, OFF_XBC = 512, OFF_CQ = 1536, OFF_CKV = 1792, OFF_KR = 1920, OFF_DT = 1952;
constexpr int NEXP = 32, FF = 256;
constexpr float EPS = 1e-6f;
constexpr int MOE_ITEMS = 32 * 16 * 8 + 32 * 4 * 16;
constexpr int MOE_SPLIT = 2560;
constexpr int NT = 512;
constexpr int LDS_BYTES = 160 * 1024;

typedef unsigned short bf16;
__device__ __forceinline__ float bf2f(bf16 v) { return __uint_as_float((unsigned)v << 16); }
__device__ __forceinline__ unsigned f2bf(float f) { unsigned u = __float_as_uint(f); return (u + 0x7fffu + ((u >> 16) & 1u)) >> 16; }
__device__ __forceinline__ unsigned pk2(float lo, float hi) { return f2bf(lo) | (f2bf(hi) << 16); }
typedef unsigned v4u __attribute__((ext_vector_type(4)));
typedef float f32x4v __attribute__((ext_vector_type(4)));

struct Params {
    const float* in[29];
    const int* pos;
    float* out;
    char* ws;
};

#define RLAS __attribute__((address_space(3)))
__device__ __forceinline__ float dpp_f(float v, int ctrl_sel) {
    const int x = __float_as_int(v); int r;
    if (ctrl_sel == 0) r = __builtin_amdgcn_update_dpp(0, x, 0xB1, 0xF, 0xF, true);
    else if (ctrl_sel == 1) r = __builtin_amdgcn_update_dpp(0, x, 0x1B, 0xF, 0xF, true);
    else if (ctrl_sel == 2) r = __builtin_amdgcn_update_dpp(0, x, 0x141, 0xF, 0xF, true);
    else r = __builtin_amdgcn_update_dpp(0, x, 0x140, 0xF, 0xF, true);
    return __int_as_float(r);
}
__device__ __forceinline__ float wave_sum_valu(float v) {
    v += dpp_f(v, 0); v += dpp_f(v, 1); v += dpp_f(v, 2); v += dpp_f(v, 3);
    { auto rr = __builtin_amdgcn_permlane16_swap(__float_as_uint(v), __float_as_uint(v), false, false); v = __uint_as_float(rr[0]) + __uint_as_float(rr[1]); }
    { auto rr = __builtin_amdgcn_permlane32_swap(__float_as_uint(v), __float_as_uint(v), false, false); v = __uint_as_float(rr[0]) + __uint_as_float(rr[1]); }
    return v;
}
__device__ __forceinline__ float ldf(const float* p) { return *p; }
__device__ __forceinline__ float ldf(const bf16* p) { return bf2f(*p); }
extern __shared__ __attribute__((aligned(16))) unsigned char lds_raw[];
constexpr int WTAB_OFF = 160 * 1024 - 256;
__device__ __forceinline__ int hw_wave_key() { int k; asm volatile("s_getreg_b32 %0, hwreg(HW_REG_HW_ID, 0, 6)" : "=s"(k)); return k; }
__device__ __forceinline__ void tidx_init() { const int key = hw_wave_key(); ((volatile __attribute__((address_space(3))) int*)(lds_raw + WTAB_OFF))[key] = (int)(threadIdx.x >> 6); __syncthreads(); }
__device__ __forceinline__ int tidx() {
    const int key = hw_wave_key();
    int w = ((volatile __attribute__((address_space(3))) int*)(lds_raw + WTAB_OFF))[key];
    w = __builtin_amdgcn_readfirstlane(w);
    unsigned ones = ~0u; asm volatile("" : "+s"(ones));
    int t = w * 64 + (int)__builtin_amdgcn_mbcnt_hi(ones, __builtin_amdgcn_mbcnt_lo(ones, 0u));
    asm volatile("" : "+v"(t)); return t; }
typedef const __attribute__((address_space(4))) Params* KArgs;
__device__ __forceinline__ KArgs kargs() { KArgs p = (KArgs)__builtin_amdgcn_kernarg_segment_ptr(); asm volatile("" : "+s"(p)); return p; }
#define IN(i) (kargs()->in[i])
__device__ __forceinline__ float silu_f(float v) { return v / (1.f + expf(-v)); }
__device__ __forceinline__ float wave_sum(float v) {
#pragma unroll
    for (int o = 32; o > 0; o >>= 1) v += __shfl_xor(v, o);
    return v;
}

namespace pg8 {
#define PG8_LAS __attribute__((address_space(3)))
typedef unsigned short bf16_t;
typedef short bf16x8 __attribute__((ext_vector_type(8)));
typedef float f32x4 __attribute__((ext_vector_type(4)));
typedef unsigned u32x4 __attribute__((ext_vector_type(4)));
constexpr int BM = 256, BK = 64, HALF = 128, HTB = HALF * BK * 2  , STAGE_BYTES = 8 * HTB, NXCD = 8, WGM = 8;

__host__ __device__ __forceinline__ int lds_byte(int r, int c) { const int st = (r >> 4) * 2 + (c >> 5), rr = r & 15, cc = c & 31, ob = rr * 64 + cc * 2; return st * 1024 + (ob ^ (((ob >> 9) & 1) << 5)); }
__host__ __device__ __forceinline__ void stage_rc(int b, int& R, int& C) { const int st = b / 1024, sb = b % 1024, swz = sb ^ (((sb >> 9) & 1) << 5); R = (st >> 1) * 16 + swz / 64; C = (st & 1) * 32 + (swz % 64) / 2; }
__host__ __device__ __forceinline__ int perm32(int rho) { const int n = rho >> 4, i = rho & 15; return 8 * (i >> 2) + 4 * n + (i & 3); }

struct Unit { int pm, pn; };
struct Gemm { const bf16_t* A; const bf16_t* Bt; int M, N, K; };

struct StaticOrder {
    int nM, nN, nwg, G, c;
    __host__ __device__ void init(int M, int N, int G_, int c_) { nM = M / BM; nN = N / BM; nwg = nM * nN; G = G_; c = c_; }
    __host__ __device__ bool next(int i, Unit& u) const {
        const long L = (long)i * G + c; if (L >= nwg) return false;
        int wgid = (int)L; { const int q = nwg / NXCD, r = nwg % NXCD, xcd = wgid % NXCD, off = wgid / NXCD; wgid = (xcd < r ? xcd * (q + 1) : r * (q + 1) + (xcd - r) * q) + off; }
        const int nig = WGM * nN, gid = wgid / nig, fm = gid * WGM, gsz = (nM - fm) < WGM ? (nM - fm) : WGM;
        u.pm = fm + ((wgid % nig) % gsz); u.pn = (wgid % nig) / gsz; return true;
    }
    __device__ __forceinline__ void a_ready(const Unit&) const {}
    __device__ __forceinline__ void done(const Unit&) const {}
};


template <int ACT> struct EpiBf16 {
    static constexpr bool PERM = true, AFTER_DRAIN = false;
    bf16_t* O; int ldc;
    __device__ __forceinline__ void operator()(const f32x4 (&acc)[2][2][4][2], const Unit& u, int wr, int wc, int fr, int fq) const {
        { const int l_ = tidx() & 63; fr = l_ & 15; fq = l_ >> 4; }
        const int row0 = u.pm * BM + wr * 64 + fr; const int col0 = u.pn * BM + wc * 32 + 8 * fq;
#pragma unroll
        for (int ai = 0; ai < 2; ++ai)
#pragma unroll
            for (int m = 0; m < 4; ++m) { bf16_t* rowp = O + (size_t)(row0 + ai * HALF + m * 16) * ldc + col0;
#pragma unroll
                for (int bj = 0; bj < 2; ++bj) { const f32x4 v0 = acc[ai][bj][m][0], v1 = acc[ai][bj][m][1];
                    u32x4 w; w.x = pk2(v0[0], v0[1]); w.y = pk2(v0[2], v0[3]); w.z = pk2(v1[0], v1[1]); w.w = pk2(v1[2], v1[3]);
                    *(u32x4*)(rowp + bj * HALF) = w; } }
    }
};

struct EpiQ {
    static constexpr bool PERM = true, AFTER_DRAIN = false;
    bf16_t* Q; const float* COS; const float* SIN;
    __device__ __forceinline__ void operator()(const f32x4 (&acc)[2][2][4][2], const Unit& u, int wr, int wc, int fr, int fq) const {
        { const int l_ = tidx() & 63; fr = l_ & 15; fq = l_ >> 4; }
        const int row0 = u.pm * BM + wr * 64 + fr;
#pragma unroll
        for (int bj = 0; bj < 2; ++bj) {
            const int colg = u.pn * BM + bj * HALF + wc * 32;
            const bool pe = ((colg >> 5) % 3) == 2;
#pragma unroll
            for (int ai = 0; ai < 2; ++ai)
#pragma unroll
                for (int m = 0; m < 4; ++m) {
                    const int row = row0 + ai * HALF + m * 16;
                    f32x4 v0 = acc[ai][bj][m][0], v1 = acc[ai][bj][m][1];
                    if (pe) {
                        f32x4 w0, w1;
#pragma unroll
                        for (int e = 0; e < 4; ++e) { w0[e] = __shfl_xor(v0[e], 32); w1[e] = __shfl_xor(v1[e], 32); }
                        const f32x4* cp = (const f32x4*)(COS + (size_t)row * 16 + (fq & 1) * 8); const f32x4* sp = (const f32x4*)(SIN + (size_t)row * 16 + (fq & 1) * 8);
                        const f32x4 c0 = cp[0], c1 = cp[1], s0 = sp[0], s1 = sp[1];
                        const float sg = (fq < 2) ? -1.f : 1.f;
                        v0 = v0 * c0 + w0 * s0 * sg; v1 = v1 * c1 + w1 * s1 * sg;
                    }
                    u32x4 w; w.x = pk2(v0[0], v0[1]); w.y = pk2(v0[2], v0[3]); w.z = pk2(v1[0], v1[1]); w.w = pk2(v1[2], v1[3]);
                    *(u32x4*)(Q + (size_t)row * 768 + colg + 8 * fq) = w;
                    if (pe) asm volatile("" ::: "memory");
                }
        }
    }
};
struct EpiKV {
    static constexpr bool PERM = true, AFTER_DRAIN = false;
    bf16_t* KF; bf16_t* VT;
    __device__ __forceinline__ void operator()(const f32x4 (&acc)[2][2][4][2], const Unit& u, int wr, int wc, int fr, int fq) const {
        { const int l_ = tidx() & 63; fr = l_ & 15; fq = l_ >> 4; }
        const int row0 = u.pm * BM + wr * 64 + fr;
#pragma unroll
        for (int bj = 0; bj < 2; ++bj) {
            const int colg = u.pn * BM + bj * HALF + wc * 32; const int h = colg >> 7, j0 = (colg & 127) + 8 * fq;
#pragma unroll
            for (int ai = 0; ai < 2; ++ai)
#pragma unroll
                for (int m = 0; m < 4; ++m) {
                    const int t = row0 + ai * HALF + m * 16; const int b = t >> 11, sq = t & 2047, tile = sq >> 6, key = sq & 63;
                    const size_t base = (size_t)((b * 8 + h) * 32 + tile);
                    bf16_t* dst = (j0 < 64) ? KF + base * 6144 + (j0 >> 3) * 512 + key * 8 : VT + base * 4096 + ((j0 - 64) >> 5) * 2048 + key * 32 + ((j0 - 64) & 31);
                    const f32x4 v0 = acc[ai][bj][m][0], v1 = acc[ai][bj][m][1];
                    u32x4 w; w.x = pk2(v0[0], v0[1]); w.y = pk2(v0[2], v0[3]); w.z = pk2(v1[0], v1[1]); w.w = pk2(v1[2], v1[3]);
                    *(u32x4*)dst = w;
                }
        }
    }
};

struct GroupedOrder {
    const PG8_LAS int* tp; int NCT, G, c;
    __device__ __forceinline__ bool next(int i, Unit& u) const {
        const int L = i * G + c, total = tp[32] * NCT; if (L >= total) return false;
        const int rtg = L / NCT, ct = L - rtg * NCT; int e = 0;
        for (int j = 1; j < 32; ++j) e += (tp[j] <= rtg) ? 1 : 0;
        u.pm = rtg; u.pn = e * NCT + ct; return true;
    }
    __device__ __forceinline__ void a_ready(const Unit&) const {}
    __device__ __forceinline__ void done(const Unit&) const {}
};
struct OwnTileOrder {
    const PG8_LAS int* tp; int NCT, G, c;
    __device__ __forceinline__ bool next(int i, Unit& u) const {
        const int rtg = c + (i / NCT) * G, ct = i % NCT; if (rtg >= tp[32]) return false;
        int e = 0;
        for (int j = 1; j < 32; ++j) e += (tp[j] <= rtg) ? 1 : 0;
        u.pm = rtg; u.pn = e * NCT + ct; return true;
    }
    __device__ __forceinline__ void a_ready(const Unit&) const {}
    __device__ __forceinline__ void done(const Unit&) const {}
};
struct EpiGU {
    static constexpr bool PERM = true, AFTER_DRAIN = false;
    bf16_t* HID; const float* ROWW;
    __device__ __forceinline__ void operator()(const f32x4 (&acc)[2][2][4][2], const Unit& u, int wr, int wc, int fr, int fq) const {
        { const int l_ = tidx() & 63; fr = l_ & 15; fq = l_ >> 4; }
        const int row0 = u.pm * BM + wr * 64 + fr; const int col0 = (u.pn & 1) * 128 + wc * 32 + 8 * fq;
#pragma unroll
        for (int ai = 0; ai < 2; ++ai)
#pragma unroll
            for (int m = 0; m < 4; ++m) { const int row = row0 + ai * HALF + m * 16; const float w = ROWW[row];
                float hv[8];
#pragma unroll
                for (int n = 0; n < 2; ++n)
#pragma unroll
                    for (int e = 0; e < 4; ++e) { const float g = acc[ai][0][m][n][e], up = acc[ai][1][m][n][e]; hv[4 * n + e] = g * __builtin_amdgcn_rcpf(1.f + __expf(-g)) * up * w; }
                u32x4 o; o.x = pk2(hv[0], hv[1]); o.y = pk2(hv[2], hv[3]); o.z = pk2(hv[4], hv[5]); o.w = pk2(hv[6], hv[7]);
                *(u32x4*)(HID + (size_t)row * 256 + col0) = o; }
    }
};
struct EpiDown {
    static constexpr bool PERM = true, AFTER_DRAIN = false;
    bf16_t* YP;
    __device__ __forceinline__ void operator()(const f32x4 (&acc)[2][2][4][2], const Unit& u, int wr, int wc, int fr, int fq) const {
        { const int l_ = tidx() & 63; fr = l_ & 15; fq = l_ >> 4; }
        const int row0 = u.pm * BM + wr * 64 + fr; const int col0 = (u.pn & 3) * BM + wc * 32 + 8 * fq;
#pragma unroll
        for (int ai = 0; ai < 2; ++ai)
#pragma unroll
            for (int m = 0; m < 4; ++m) { bf16_t* rowp = YP + (size_t)(row0 + ai * HALF + m * 16) * 1024 + col0;
#pragma unroll
                for (int bj = 0; bj < 2; ++bj) { const f32x4 v0 = acc[ai][bj][m][0], v1 = acc[ai][bj][m][1];
                    u32x4 w; w.x = pk2(v0[0], v0[1]); w.y = pk2(v0[2], v0[3]); w.z = pk2(v1[0], v1[1]); w.w = pk2(v1[2], v1[3]);
                    *(u32x4*)(rowp + bj * HALF) = w; } }
    }
};
template <class Epi, class Sched, bool ALIGN_EPI = false, bool SP2 = false>
__device__ __forceinline__ void gemm_phase(PG8_LAS unsigned char* lds, const Gemm g, const Sched& S, const Epi& E) {
    const int tid = tidx(), wid = __builtin_amdgcn_readfirstlane(tid >> 6), lane = tid & 63, wr = wid >> 2, wc = wid & 3, fr = lane & 15, fq = lane >> 4;
    const int K = g.K, nt = K / BK;
    unsigned voffA[2], voffB[2];
#pragma unroll
    for (int i = 0; i < 2; ++i) { int R, C; stage_rc(tid * 16 + i * 8192, R, C); const int Rb = Epi::PERM ? ((R & ~31) + perm32(R & 31)) : R;
        voffA[i] = (unsigned)(R * K + C) * 2u; voffB[i] = (unsigned)(Rb * K + C) * 2u; }
    const size_t kstep = (size_t)(BK * 2);
    const size_t hstep = (size_t)HALF * K * 2;
    const size_t tstep = 2 * hstep;
    const unsigned ldsw = (unsigned)wid * 1024u;
    const int aoff = lds_byte(wr * 64 + fr, fq * 8), boff = lds_byte(wc * 32 + fr, fq * 8);
#define PG8_SA(b, h) (((b) * 2 + (h)) * HTB)
#define PG8_SB(b, h) ((4 + (b) * 2 + (h)) * HTB)
#define PG8_STAGE(bufoff, gbase, voff) do { _Pragma("unroll") for (int _i = 0; _i < 2; ++_i) \
        __builtin_amdgcn_global_load_lds((const unsigned*)((const char*)(gbase) + (voff)[_i]), (PG8_LAS unsigned*)(lds + (bufoff) + ldsw + _i * 8192), 16, 0, 0); } while (0)
#define PG8_LDA(dst, b, h) do { _Pragma("unroll") for (int m = 0; m < 4; ++m) _Pragma("unroll") for (int k = 0; k < 2; ++k) dst[m][k] = *(const PG8_LAS bf16x8*)(lds + PG8_SA(b, h) + aoff + m * 2048 + k * 1024); } while (0)
#define PG8_LDB(dst, b, h) do { _Pragma("unroll") for (int n = 0; n < 2; ++n) _Pragma("unroll") for (int k = 0; k < 2; ++k) dst[n][k] = *(const PG8_LAS bf16x8*)(lds + PG8_SB(b, h) + boff + n * 2048 + k * 1024); } while (0)
#define PG8_MMA(ai, bj, At, Bt) do { __builtin_amdgcn_s_setprio(1); _Pragma("unroll") for (int m = 0; m < 4; ++m) _Pragma("unroll") for (int n = 0; n < 2; ++n) _Pragma("unroll") for (int k = 0; k < 2; ++k) \
        acc[ai][bj][m][n] = __builtin_amdgcn_mfma_f32_16x16x32_bf16(Bt[n][k], At[m][k], acc[ai][bj][m][n], 0, 0, 0); __builtin_amdgcn_s_setprio(0); } while (0)
#define PG8_WAIT_V(n) asm volatile("s_waitcnt vmcnt(" #n ")" ::: "memory")
#define PG8_WAIT_L(n) asm volatile("s_waitcnt lgkmcnt(" #n ")" ::: "memory")
#define PG8_BAR __builtin_amdgcn_s_barrier()
#define PG8_SCHED __builtin_amdgcn_sched_barrier(0)
    Unit cur, nxt; int ui = 0;
    if (!S.next(0, cur)) return;
    f32x4 acc[2][2][4][2];
#pragma unroll
    for (int a = 0; a < 2; ++a)
#pragma unroll
        for (int b = 0; b < 2; ++b)
#pragma unroll
            for (int m = 0; m < 4; ++m)
#pragma unroll
                for (int n = 0; n < 2; ++n) acc[a][b][m][n] = (f32x4){0.f, 0.f, 0.f, 0.f};
    bf16x8 At[4][2], B0[2][2], B1[2][2];
    const char* cA = (const char*)g.A + (size_t)cur.pm * tstep; const char* cB = (const char*)g.Bt + (size_t)cur.pn * tstep;
    S.a_ready(cur);
    if constexpr (SP2) {
        PG8_STAGE(PG8_SB(0, 0), cB, voffB); PG8_STAGE(PG8_SB(0, 1), cB + hstep, voffB); PG8_STAGE(PG8_SA(0, 0), cA, voffA); PG8_STAGE(PG8_SA(0, 1), cA + hstep, voffA);
        if (wr == 1) PG8_BAR;
        PG8_WAIT_V(2); PG8_BAR;
        PG8_STAGE(PG8_SB(1, 0), cB + kstep, voffB); PG8_STAGE(PG8_SA(1, 0), cA + kstep, voffA); PG8_STAGE(PG8_SB(1, 1), cB + hstep + kstep, voffB);
        PG8_WAIT_V(6); PG8_BAR;
    } else {
        PG8_STAGE(PG8_SB(0, 0), cB, voffB); PG8_STAGE(PG8_SA(0, 0), cA, voffA); PG8_STAGE(PG8_SB(0, 1), cB + hstep, voffB); PG8_STAGE(PG8_SA(0, 1), cA + hstep, voffA);
        if (wr == 1) PG8_BAR;
        PG8_WAIT_V(4); PG8_BAR;
        PG8_STAGE(PG8_SB(1, 0), cB + kstep, voffB); PG8_STAGE(PG8_SA(1, 0), cA + kstep, voffA); PG8_STAGE(PG8_SB(1, 1), cB + hstep + kstep, voffB);
        PG8_WAIT_V(6); PG8_BAR;
    }
    for (;;) {
        const bool has_next = S.next(ui + 1, nxt);
        const char* nA = has_next ? (const char*)g.A + (size_t)nxt.pm * tstep : cA; const char* nB = has_next ? (const char*)g.Bt + (size_t)nxt.pn * tstep : cB;
        for (int t = 0; t < nt; t += 2) {
            const bool last = (t == nt - 2);
            const char* a1 = cA + (size_t)(t + 1) * kstep;
            const char* a2 = last ? nA : cA + (size_t)(t + 2) * kstep; const char* b2 = last ? nB : cB + (size_t)(t + 2) * kstep;
            const char* a3 = a2 + kstep; const char* b3 = b2 + kstep;
            if (last && has_next) S.a_ready(nxt);
            if constexpr (SP2) {
            PG8_LDB(B0, 0, 0); PG8_LDB(B1, 0, 1); PG8_SCHED; PG8_LDA(At, 0, 0); PG8_STAGE(PG8_SA(1, 1), a1 + hstep, voffA);
            PG8_WAIT_V(8); PG8_WAIT_L(0); PG8_BAR; PG8_MMA(0, 0, At, B0); PG8_MMA(0, 1, At, B1); PG8_BAR; PG8_SCHED;
            PG8_LDA(At, 0, 1); PG8_STAGE(PG8_SB(0, 0), b2, voffB); PG8_STAGE(PG8_SB(0, 1), b2 + hstep, voffB); PG8_STAGE(PG8_SA(0, 0), a2, voffA);
            PG8_WAIT_V(8); PG8_WAIT_L(0); PG8_BAR; PG8_MMA(1, 0, At, B0); PG8_MMA(1, 1, At, B1); PG8_BAR; PG8_SCHED;
            PG8_LDB(B0, 1, 0); PG8_LDB(B1, 1, 1); PG8_SCHED; PG8_LDA(At, 1, 0); PG8_STAGE(PG8_SA(0, 1), a2 + hstep, voffA);
            PG8_WAIT_V(8); PG8_WAIT_L(0); PG8_BAR; PG8_MMA(0, 0, At, B0); PG8_MMA(0, 1, At, B1); PG8_BAR; PG8_SCHED;
            PG8_LDA(At, 1, 1); PG8_STAGE(PG8_SB(1, 0), b3, voffB); PG8_STAGE(PG8_SB(1, 1), b3 + hstep, voffB); PG8_STAGE(PG8_SA(1, 0), a3, voffA);
            PG8_WAIT_V(8); PG8_WAIT_L(0); PG8_BAR; PG8_MMA(1, 0, At, B0); PG8_MMA(1, 1, At, B1); PG8_BAR; PG8_SCHED;
            } else {
            PG8_LDB(B0, 0, 0); PG8_SCHED; PG8_LDA(At, 0, 0); PG8_STAGE(PG8_SA(1, 1), a1 + hstep, voffA);
            PG8_WAIT_L(8); PG8_BAR; PG8_WAIT_L(0); PG8_MMA(0, 0, At, B0); PG8_BAR; PG8_SCHED;
            PG8_LDB(B1, 0, 1); PG8_STAGE(PG8_SB(0, 0), b2, voffB);
            PG8_BAR; PG8_WAIT_L(0); PG8_MMA(0, 1, At, B1); PG8_BAR;
            PG8_LDA(At, 0, 1); PG8_STAGE(PG8_SA(0, 0), a2, voffA);
            PG8_BAR; PG8_WAIT_L(0); PG8_MMA(1, 0, At, B0); PG8_BAR; PG8_SCHED;
            PG8_STAGE(PG8_SB(0, 1), b2 + hstep, voffB);
            PG8_WAIT_V(6); PG8_BAR; PG8_MMA(1, 1, At, B1); PG8_BAR;
            PG8_LDB(B0, 1, 0); PG8_SCHED; PG8_LDA(At, 1, 0); PG8_STAGE(PG8_SA(0, 1), a2 + hstep, voffA);
            PG8_WAIT_L(8); PG8_BAR; PG8_WAIT_L(0); PG8_MMA(0, 0, At, B0); PG8_BAR; PG8_SCHED;
            PG8_LDB(B1, 1, 1); PG8_STAGE(PG8_SB(1, 0), b3, voffB);
            PG8_BAR; PG8_WAIT_L(0); PG8_MMA(0, 1, At, B1); PG8_BAR;
            PG8_LDA(At, 1, 1); PG8_STAGE(PG8_SA(1, 0), a3, voffA);
            PG8_BAR; PG8_WAIT_L(0); PG8_MMA(1, 0, At, B0); PG8_BAR; PG8_SCHED;
            PG8_STAGE(PG8_SB(1, 1), b3 + hstep, voffB);
            PG8_WAIT_V(6); PG8_BAR; PG8_MMA(1, 1, At, B1); PG8_BAR;
            }
        }
        if constexpr (ALIGN_EPI) { if (wr == 0) PG8_BAR; }
        if constexpr (!Epi::AFTER_DRAIN) { E(acc, cur, wr, wc, fr, fq); S.done(cur); }
        if (!has_next) break;
#pragma unroll
        for (int a = 0; a < 2; ++a)
#pragma unroll
            for (int b = 0; b < 2; ++b)
#pragma unroll
                for (int m = 0; m < 4; ++m)
#pragma unroll
                    for (int n = 0; n < 2; ++n) acc[a][b][m][n] = (f32x4){0.f, 0.f, 0.f, 0.f};
        cur = nxt; cA = nA; cB = nB; ++ui;
        if constexpr (ALIGN_EPI) { if (wr == 1) PG8_BAR; }
    }
    PG8_WAIT_V(0);
    if constexpr (!ALIGN_EPI) { if (wr == 0) PG8_BAR; }
    PG8_BAR;
    if constexpr (Epi::AFTER_DRAIN) { E.fused(acc, cur, wr, wc, fr, fq, lds, wid, lane); S.done(cur); }
#undef PG8_SA
#undef PG8_SB
#undef PG8_STAGE
#undef PG8_LDA
#undef PG8_LDB
#undef PG8_MMA
#undef PG8_WAIT_V
#undef PG8_WAIT_L
#undef PG8_BAR
#undef PG8_SCHED
}
}


template <class GainFn>
__device__ __forceinline__ void transpose_tile(const float* src, int ldsrc, int srccol0  , GainFn gain, bf16* dst, int K, int k0, int n0, int lane) {
    const int r = lane >> 4, c = lane & 15;
    f32x4v v[16];
    if (srccol0 >= 0) {
#pragma unroll
        for (int i = 0; i < 16; ++i) v[i] = *(const f32x4v*)(src + (size_t)(k0 + 4 * i + r) * ldsrc + srccol0 + 4 * c);
    } else {
#pragma unroll
        for (int i = 0; i < 16; ++i) v[i] = (f32x4v){0.f, 0.f, 0.f, 0.f};
    }
    unsigned pk[16][2];
#pragma unroll
    for (int i = 0; i < 16; ++i) {
        unsigned a0 = __float_as_uint(v[i].x), a1 = __float_as_uint(v[i].y), a2 = __float_as_uint(v[i].z), a3 = __float_as_uint(v[i].w);
        { auto t = __builtin_amdgcn_permlane32_swap(a0, a2, false, false); a0 = t[0]; a2 = t[1]; }
        { auto t = __builtin_amdgcn_permlane32_swap(a1, a3, false, false); a1 = t[0]; a3 = t[1]; }
        { auto t = __builtin_amdgcn_permlane16_swap(a0, a1, false, false); a0 = t[0]; a1 = t[1]; }
        { auto t = __builtin_amdgcn_permlane16_swap(a2, a3, false, false); a2 = t[0]; a3 = t[1]; }
        const f32x4v g = gain(k0 + 4 * i);
        pk[i][0] = pk2(__uint_as_float(a0) * g.x, __uint_as_float(a1) * g.y); pk[i][1] = pk2(__uint_as_float(a2) * g.z, __uint_as_float(a3) * g.w);
    }
    bf16* drow = dst + (size_t)(n0 + 4 * c + r) * K + k0;
#pragma unroll
    for (int i = 0; i < 8; ++i) *(v4u*)(drow + 8 * i) = (v4u){pk[2 * i][0], pk[2 * i][1], pk[2 * i + 1][0], pk[2 * i + 1][1]};
}
__device__ __forceinline__ int win_col(int n) {
    if (n < 1536) return n;
    if (n < 1792) return n - 1536 + 1544;
    if (n < 1920) return n - 1792 + 1800;
    if (n < 1952) return n - 1920 + 1928;
    if (n < 1960) return n - 1952 + 1536;
    return -1;
}
template <class GainFn>
__device__ __forceinline__ void transpose_tile_win(const float* src, GainFn gain, bf16* dst, int k0, int n0, int lane) {
    const int r = lane >> 4, c = lane & 15; const int sc = win_col(n0 + 4 * c);
    f32x4v v[16];
#pragma unroll
    for (int i = 0; i < 16; ++i) v[i] = (sc >= 0) ? *(const f32x4v*)(src + (size_t)(k0 + 4 * i + r) * NIN + sc) : (f32x4v){0.f, 0.f, 0.f, 0.f};
    unsigned pk[16][2];
#pragma unroll
    for (int i = 0; i < 16; ++i) {
        unsigned a0 = __float_as_uint(v[i].x), a1 = __float_as_uint(v[i].y), a2 = __float_as_uint(v[i].z), a3 = __float_as_uint(v[i].w);
        { auto t = __builtin_amdgcn_permlane32_swap(a0, a2, false, false); a0 = t[0]; a2 = t[1]; }
        { auto t = __builtin_amdgcn_permlane32_swap(a1, a3, false, false); a1 = t[0]; a3 = t[1]; }
        { auto t = __builtin_amdgcn_permlane16_swap(a0, a1, false, false); a0 = t[0]; a1 = t[1]; }
        { auto t = __builtin_amdgcn_permlane16_swap(a2, a3, false, false); a2 = t[0]; a3 = t[1]; }
        pk[i][0] = pk2(__uint_as_float(a0), __uint_as_float(a1)); pk[i][1] = pk2(__uint_as_float(a2), __uint_as_float(a3));
    }
    bf16* drow = dst + (size_t)(n0 + 4 * c + r) * D + k0;
#pragma unroll
    for (int i = 0; i < 8; ++i) *(v4u*)(drow + 8 * i) = (v4u){pk[2 * i][0], pk[2 * i][1], pk[2 * i + 1][0], pk[2 * i + 1][1]};
}
__device__ void ph_prep(float* lds, float* mod, bf16* WIN_T, bf16* WOUT_T, bf16* WUQ_T, bf16* WUKV_T, float* WRT, bf16* WGU_T, bf16* WD_T) {
    const int tid = tidx(), lane = tid & 63, wave = tid >> 6;
    for (int item = blockIdx.x; item < 6 * D / 32; item += gridDim.x) {
        float* sc = lds;
        float* part = lds + 8 * D;
        const float* c = IN(1); const float* ada_w = IN(3); const float* ada_b = IN(4);
        __syncthreads();
        for (int i = tid; i < NB * D; i += NT) sc[i] = silu_f(c[i]);
        __syncthreads();
        const int kr = lane >> 3, cq = lane & 7; const int j0 = item * 32 + 4 * cq;
        f32x4v acc[NB];
#pragma unroll
        for (int b = 0; b < NB; ++b) acc[b] = (f32x4v){0.f, 0.f, 0.f, 0.f};
#pragma unroll 4
        for (int i = 0; i < 16; ++i) { const int k = wave * 128 + 8 * i + kr;
            const f32x4v w = *(const f32x4v*)(ada_w + (size_t)k * 6 * D + j0);
#pragma unroll
            for (int b = 0; b < NB; ++b) acc[b] += w * sc[b * D + k]; }
#pragma unroll
        for (int b = 0; b < NB; ++b) {
#pragma unroll
            for (int e = 0; e < 4; ++e) { float v = acc[b][e]; v += __shfl_xor(v, 8); v += __shfl_xor(v, 16); v += __shfl_xor(v, 32); acc[b][e] = v; } }
        if (lane < 8) {
#pragma unroll
            for (int b = 0; b < NB; ++b) *(f32x4v*)(part + (wave * NB + b) * 32 + 4 * lane) = acc[b]; }
        __syncthreads();
        if (tid < NB * 32) { const int b = tid >> 5, jj = tid & 31;
            float sm = ada_b[item * 32 + jj];
#pragma unroll
            for (int w = 0; w < 8; ++w) sm += part[(w * NB + b) * 32 + jj];
            mod[b * 6 * D + item * 32 + jj] = sm; }
    }
    __syncthreads();
    for (int i = blockIdx.x * NT + tid; i < 36 * D; i += gridDim.x * NT) { const int c = i >> 10, k = i & 1023;
        WRT[i] = (c < 4) ? IN(22)[k * 4 + c] : IN(24)[k * 32 + c - 4]; }
    const int gw = (gridDim.x - 1 - blockIdx.x) * (NT / 64) + wave, ngw = gridDim.x * (NT / 64);
    constexpr int I_IN = (D / 64) * (NU / 64), I_OUT = (D / 64) * (D / 64), I_UQ = (QR / 64) * (768 / 64), I_UKV = (256 / 64) * (1024 / 64);
    const float* ssd_norm = IN(15); const float* q_norm = IN(16); const float* kv_norm = IN(18); const float* mla_norm = IN(20);
    const auto one4 = [](int) { return (f32x4v){1.f, 1.f, 1.f, 1.f}; };
    constexpr int I_GU = NEXP * (D / 64) * (512 / 64);
    const int moe_lo = (gridDim.x >= 128) ? MOE_SPLIT : 0, n_moe = MOE_ITEMS - moe_lo;
    for (int it = gw; it < n_moe + I_IN + I_OUT + I_UQ + I_UKV; it += ngw) {
        int r = it;
        if (r < n_moe) { r += moe_lo;
            if (r < I_GU) { const int e = r >> 7, q = r & 127, kb = q >> 3, nb = q & 7;
                const int ct = nb >> 2, rr = (nb & 3) * 64; const float* src = (rr < 128 ? IN(26) : IN(27)) + (size_t)e * D * FF;
                transpose_tile(src, FF, 128 * ct + (rr & 127), one4, WGU_T + (size_t)e * 512 * D, D, kb * 64, nb * 64, lane); continue; }
            r -= I_GU;
            { const int e = r >> 6, q = r & 63, kb = q >> 4, nb = q & 15;
              transpose_tile(IN(28) + (size_t)e * FF * D, D, nb * 64, one4, WD_T + (size_t)e * D * FF, FF, kb * 64, nb * 64, lane); continue; } }
        r -= n_moe;
        if (r < I_IN) { const int nb = NU / 64; transpose_tile_win(IN(9), one4, WIN_T, (r / nb) * 64, (r % nb) * 64, lane); continue; }
        r -= I_IN;
        if (r < I_OUT) { const int nb = D / 64; transpose_tile(IN(21), D, (r % nb) * 64, [=](int k) { return k < 512 ? *(const f32x4v*)(ssd_norm + k) : *(const f32x4v*)(mla_norm + k - 512); }, WOUT_T, D, (r / nb) * 64, (r % nb) * 64, lane); continue; }
        r -= I_OUT;
        if (r < I_UQ) { const int nb = 768 / 64; transpose_tile(IN(17), 768, (r % nb) * 64, [=](int k) { return *(const f32x4v*)(q_norm + k) * 0.14724444f; }, WUQ_T, QR, (r / nb) * 64, (r % nb) * 64, lane); continue; }
        r -= I_UQ;
        { const int nb = 1024 / 64, kb = r / nb; transpose_tile(IN(19), 1024, kb < 2 ? (r % nb) * 64 : -1, [=](int k) { return k < KVR ? *(const f32x4v*)(kv_norm + k) : (f32x4v){0.f, 0.f, 0.f, 0.f}; }, WUKV_T, 256, kb * 64, (r % nb) * 64, lane); }
    }
}
__device__ void ph_prep_moe(bf16* WGU_T, bf16* WD_T, int rank, int nw, int it_lo, int it_hi) {
    const int lane = tidx() & 63; rank = __builtin_amdgcn_readfirstlane(rank);
    constexpr int I_GU = NEXP * (D / 64) * (512 / 64), I_DN = NEXP * (FF / 64) * (D / 64);
    const auto one4 = [](int) { return (f32x4v){1.f, 1.f, 1.f, 1.f}; };
    for (int it = it_lo + rank; it < it_hi; it += nw) {
        int r = it;
        if (r < I_GU) { const int e = r >> 7, q = r & 127, kb = q >> 3, nb = q & 7;
            const int ct = nb >> 2, rr = (nb & 3) * 64; const float* src = (rr < 128 ? IN(26) : IN(27)) + (size_t)e * D * FF;
            transpose_tile(src, FF, 128 * ct + (rr & 127), one4, WGU_T + (size_t)e * 512 * D, D, kb * 64, nb * 64, lane); continue; }
        r -= I_GU;
        { const int e = r >> 6, q = r & 63, kb = q >> 4, nb = q & 15;
          transpose_tile(IN(28) + (size_t)e * FF * D, D, nb * 64, one4, WD_T + (size_t)e * D * FF, FF, kb * 64, nb * 64, lane); }
    }
}

__device__ void ph_prenorm_bf16(const float* in, const float* g, const float* mod, int sh_off, int sc_off, bf16* out) {
    const int lane = tidx() & 63, gw = blockIdx.x * (NT / 64) + (tidx() >> 6), ngw = gridDim.x * (NT / 64);
    f32x4v nx[4];
    if (gw < M) { const f32x4v* r = (const f32x4v*)(in + (size_t)gw * D) + lane;
#pragma unroll
        for (int j = 0; j < 4; ++j) nx[j] = r[64 * j]; }
    for (int t = gw; t < M; t += ngw) {
        const int b = t / SEQ;
        f32x4v v[4]; float s = 0.f;
#pragma unroll
        for (int j = 0; j < 4; ++j) { v[j] = nx[j]; s += (v[j].x * v[j].x + v[j].y * v[j].y) + (v[j].z * v[j].z + v[j].w * v[j].w); }
        if (t + ngw < M) { const f32x4v* r = (const f32x4v*)(in + (size_t)(t + ngw) * D) + lane;
#pragma unroll
            for (int j = 0; j < 4; ++j) nx[j] = r[64 * j]; }
        const f32x4v* gp = (const f32x4v*)g + lane; const f32x4v* scp = (const f32x4v*)(mod + b * 6 * D + sc_off) + lane; const f32x4v* shp = (const f32x4v*)(mod + b * 6 * D + sh_off) + lane;
        f32x4v gg[4], sc[4], sh[4];
#pragma unroll
        for (int j = 0; j < 4; ++j) { gg[j] = gp[64 * j]; sc[j] = scp[64 * j]; sh[j] = shp[64 * j]; }
        const float inv = rsqrtf(wave_sum_valu(s) / D + EPS);
        unsigned long long* o8 = (unsigned long long*)(out + (size_t)t * D) + lane;
#pragma unroll
        for (int j = 0; j < 4; ++j) { const f32x4v h = v[j] * inv * gg[j] * (sc[j] + 1.f) + sh[j];
            o8[64 * j] = (unsigned long long)pk2(h.x, h.y) | ((unsigned long long)pk2(h.z, h.w) << 32); }
    }
}


__device__ void ph_prep2(const bf16* U, const int* pos, const float* conv_w, const float* conv_b, const float* dt_bias,
                         bf16* CQN, bf16* CKVN, bf16* KF, float* COS, float* SIN, float* DT, bf16* XC) {
    const int lane = tidx() & 63, gw = blockIdx.x * (NT / 64) + (tidx() >> 6), ngw = gridDim.x * (NT / 64);
    const int rows_per = (M + ngw - 1) / ngw;
    const int ch = lane * 16;
    f32x4v cw[4][4], cbv[4];
#pragma unroll
    for (int k = 0; k < 4; ++k)
#pragma unroll
        for (int q4 = 0; q4 < 4; ++q4) cw[k][q4] = *(const f32x4v*)(conv_w + k * SSD_XBC + ch + 4 * q4);
#pragma unroll
    for (int q4 = 0; q4 < 4; ++q4) cbv[q4] = *(const f32x4v*)(conv_b + ch + 4 * q4);
    const float inv_freq = exp2f(-(float)(lane & 15) * (13.287712379549449f / 16.0f));
    const float dtb = dt_bias[lane & 7];
    const int t_lo = gw * rows_per, t_hi = min((gw + 1) * rows_per, M);
    if (t_lo >= t_hi) return;
    v4u h0[2], h1[2], h2[2];
#define LDX(dst, tt_) do { if (((tt_) & (SEQ - 1)) <= (t_lo & (SEQ - 1)) && (tt_) >= 0 && ((tt_) >> 11) == (t_lo >> 11)) { const v4u* xp_ = (const v4u*)(U + (size_t)(tt_) * NU + OFF_XBC + ch); dst[0] = xp_[0]; dst[1] = xp_[1]; } \
                           else { dst[0] = (v4u){0u, 0u, 0u, 0u}; dst[1] = dst[0]; } } while (0)
    LDX(h0, t_lo - 3); LDX(h1, t_lo - 2); LDX(h2, t_lo - 1);
#undef LDX
    uint2 n_cq; unsigned n_ckv; unsigned short n_k1, n_k2, n_dt; v4u n_x[2]; int n_pos;
#define LDROW(tt_) do { const bf16* ur_ = U + (size_t)(tt_) * NU; n_cq = *(const uint2*)(ur_ + OFF_CQ + lane * 4); n_ckv = *(const unsigned*)(ur_ + OFF_CKV + lane * 2); \
        n_k1 = ur_[OFF_KR + (lane & 15)]; n_k2 = ur_[OFF_KR + 16 + (lane & 15)]; n_dt = ur_[OFF_DT + (lane & 7)]; const v4u* xp_ = (const v4u*)(ur_ + OFF_XBC + ch); n_x[0] = xp_[0]; n_x[1] = xp_[1]; n_pos = pos[tt_]; } while (0)
    LDROW(t_lo);
    for (int t = t_lo; t < t_hi; ++t) {
        const int sq = t & (SEQ - 1), b = t >> 11;
        const uint2 w_cq = n_cq; const unsigned w_ckv = n_ckv; const float x1 = bf2f(n_k1), x2 = bf2f(n_k2), dtr = bf2f(n_dt); const v4u cx0 = n_x[0], cx1 = n_x[1]; const int p_t = n_pos;
        if (t + 1 < t_hi) LDROW(t + 1);
        if (sq == 0) { h0[0] = (v4u){0u, 0u, 0u, 0u}; h0[1] = h0[0]; h1[0] = h0[0]; h1[1] = h0[0]; h2[0] = h0[0]; h2[1] = h0[0]; }
        { const float a0 = __uint_as_float(w_cq.x << 16), a1 = __uint_as_float(w_cq.x & 0xffff0000u), a2 = __uint_as_float(w_cq.y << 16), a3 = __uint_as_float(w_cq.y & 0xffff0000u);
          const float inv = rsqrtf(wave_sum_valu(a0 * a0 + a1 * a1 + a2 * a2 + a3 * a3) * (1.f / QR) + EPS);
          uint2 o; o.x = pk2(a0 * inv, a1 * inv); o.y = pk2(a2 * inv, a3 * inv);
          *(uint2*)(CQN + (size_t)t * QR + lane * 4) = o; }
        { const float a0 = __uint_as_float(w_ckv << 16), a1 = __uint_as_float(w_ckv & 0xffff0000u);
          const float inv = rsqrtf(wave_sum_valu(a0 * a0 + a1 * a1) * (1.f / KVR) + EPS);
          *(unsigned*)(CKVN + (size_t)t * 256 + lane * 2) = pk2(a0 * inv, a1 * inv);
          *(unsigned*)(CKVN + (size_t)t * 256 + 128 + lane * 2) = 0u; }
        { const int i = lane & 15;
          const float ang = (float)p_t * inv_freq;
          const float sn = __sinf(ang), cs = __cosf(ang);
          if (lane < 16) { COS[(size_t)t * 16 + i] = cs; SIN[(size_t)t * 16 + i] = sn; }
          const float r1 = x1 * cs - x2 * sn, r2 = x2 * cs + x1 * sn;
          const int cc = lane & 3, hh = (lane >> 2) & 7;
          float e[8];
#pragma unroll
          for (int j = 0; j < 8; ++j) { const float p1 = __shfl(r1, (cc & 1) * 8 + j), p2 = __shfl(r2, (cc & 1) * 8 + j); e[j] = (cc >> 1) ? p2 : p1; }
          if (lane < 32) { v4u o; o.x = pk2(e[0], e[1]); o.y = pk2(e[2], e[3]); o.z = pk2(e[4], e[5]); o.w = pk2(e[6], e[7]);
            *(v4u*)(KF + (size_t)((b * 8 + hh) * 32 + (sq >> 6)) * 6144 + (8 + cc) * 512 + (sq & 63) * 8) = o; } }
        if (lane < 8) { const float raw = dtr + dtb; DT[(size_t)t * 8 + lane] = raw > 20.f ? raw : log1pf(__expf(raw)); }
        { float acc[16];
#pragma unroll
          for (int q4 = 0; q4 < 4; ++q4) { acc[4 * q4] = cbv[q4].x; acc[4 * q4 + 1] = cbv[q4].y; acc[4 * q4 + 2] = cbv[q4].z; acc[4 * q4 + 3] = cbv[q4].w; }
#define TAP(k_, r_) do { const unsigned xw_[8] = {r_[0].x, r_[0].y, r_[0].z, r_[0].w, r_[1].x, r_[1].y, r_[1].z, r_[1].w}; \
              _Pragma("unroll") for (int q4 = 0; q4 < 4; ++q4) { const f32x4v ww_ = cw[k_][q4]; \
                  acc[4 * q4] += ww_.x * __uint_as_float(xw_[2 * q4] << 16); acc[4 * q4 + 1] += ww_.y * __uint_as_float(xw_[2 * q4] & 0xffff0000u); \
                  acc[4 * q4 + 2] += ww_.z * __uint_as_float(xw_[2 * q4 + 1] << 16); acc[4 * q4 + 3] += ww_.w * __uint_as_float(xw_[2 * q4 + 1] & 0xffff0000u); } } while (0)
          const v4u cur[2] = {cx0, cx1};
          TAP(0, h0); TAP(1, h1); TAP(2, h2); TAP(3, cur);
#undef TAP
          h0[0] = h1[0]; h0[1] = h1[1]; h1[0] = h2[0]; h1[1] = h2[1]; h2[0] = cx0; h2[1] = cx1;
#define SILU(v_) ((v_) * __builtin_amdgcn_rcpf(1.f + __expf(-(v_))))
          v4u o0, o1;
          o0.x = pk2(SILU(acc[0]), SILU(acc[1])); o0.y = pk2(SILU(acc[2]), SILU(acc[3])); o0.z = pk2(SILU(acc[4]), SILU(acc[5])); o0.w = pk2(SILU(acc[6]), SILU(acc[7]));
          o1.x = pk2(SILU(acc[8]), SILU(acc[9])); o1.y = pk2(SILU(acc[10]), SILU(acc[11])); o1.z = pk2(SILU(acc[12]), SILU(acc[13])); o1.w = pk2(SILU(acc[14]), SILU(acc[15]));
#undef SILU
          { bf16* base = XC + (size_t)(t >> 7) * 131072; const int l = t & 127;
            if (ch < 512) { v4u* op = (v4u*)(base + (ch >> 6) * 8192 + ((ch & 63) >> 5) * 4096 + l * 32 + (ch & 31)); op[0] = o0; op[1] = o1; }
            else { const int c2 = ch - 512; bf16* q = base + 65536 + (c2 >> 7) * 16384 + ((c2 & 127) >> 3) * 1024 + l * 8; *(v4u*)q = o0; *(v4u*)(q + 1024) = o1; } } }
    }
#undef LDROW
}


__device__ void ph_rowrouter(RLAS float* ldsf, const bf16* Yb, const float* x, const float* post_gain, const float* pre_gain, const float* mod, const float* WRT,
                             const float* bgr, const float* ber, float* out, bf16* H2, int* CNT, int* RT_E, int* RT_S, int* ETOK, float* EW) {
    const int tid = tidx(), lane = tid & 63, wave = tid >> 6;
    const int gw = blockIdx.x * (NT / 64) + wave, ngw = gridDim.x * (NT / 64);
    { const f32x4v* src = (const f32x4v*)WRT; RLAS f32x4v* dst = (RLAS f32x4v*)ldsf;
      for (int i = tid; i < 36 * 1024 / 4; i += NT) dst[i] = src[i]; }
    RLAS float* Lg = ldsf + 36 * 1024 + wave * 320;
    __syncthreads();
    const int b0 = lane & 1, b1 = (lane >> 1) & 1, b2 = (lane >> 2) & 1, b3 = (lane >> 3) & 1, b4 = (lane >> 4) & 1, b5 = lane >> 5;
    const int i4 = b0 + 2 * b1, i3 = i4 + 3 * b2, i2 = i3 + 5 * b3;
    const bool colok = (i4 <= 2) && (i3 <= 4) && (i2 <= 8); const int mycol = i2 + 9 * b4 + 18 * b5;
    const int rows_per = (M + ngw - 1) / ngw;
    for (int bi = 0; bi < (rows_per + 7) / 8; ++bi) {
        const int tb = gw * rows_per + 8 * bi; const int nr = max(0, min(8, min((gw + 1) * rows_per, M) - tb));
        uint2 ynx[4]; f32x4v xnx[4];
        if (nr > 0) { const uint2* yp0 = (const uint2*)(Yb + (size_t)tb * D) + lane; const f32x4v* xp0 = (const f32x4v*)(x + (size_t)tb * D) + lane;
#pragma unroll
            for (int j = 0; j < 4; ++j) { ynx[j] = yp0[64 * j]; xnx[j] = xp0[64 * j]; } }
        for (int ri = 0; ri < nr; ++ri) {
            const int t = tb + ri, b = t >> 11;
            f32x4v* op = (f32x4v*)(out + (size_t)t * D) + lane;
            f32x4v y[4], xv[4]; float ssy = 0.f;
#pragma unroll
            for (int j = 0; j < 4; ++j) { const uint2 w = ynx[j]; xv[j] = xnx[j];
                y[j].x = __uint_as_float(w.x << 16); y[j].y = __uint_as_float(w.x & 0xffff0000u); y[j].z = __uint_as_float(w.y << 16); y[j].w = __uint_as_float(w.y & 0xffff0000u);
                ssy += (y[j].x * y[j].x + y[j].y * y[j].y) + (y[j].z * y[j].z + y[j].w * y[j].w); }
            if (ri + 1 < nr) { const uint2* yp1 = (const uint2*)(Yb + (size_t)(t + 1) * D) + lane; const f32x4v* xp1 = (const f32x4v*)(x + (size_t)(t + 1) * D) + lane;
#pragma unroll
                for (int j = 0; j < 4; ++j) { ynx[j] = yp1[64 * j]; xnx[j] = xp1[64 * j]; } }
            const float invy = rsqrtf(wave_sum_valu(ssy) * (1.f / D) + EPS);
            const f32x4v* g1p = (const f32x4v*)(mod + b * 6 * D + 2 * D) + lane; const f32x4v* pgp = (const f32x4v*)post_gain + lane;
            float ss1 = 0.f;
#pragma unroll
            for (int j = 0; j < 4; ++j) { xv[j] = xv[j] + g1p[64 * j] * (y[j] * invy * pgp[64 * j]); op[64 * j] = xv[j];
                ss1 += (xv[j].x * xv[j].x + xv[j].y * xv[j].y) + (xv[j].z * xv[j].z + xv[j].w * xv[j].w); }
            const float inv1 = rsqrtf(wave_sum_valu(ss1) * (1.f / D) + EPS);
            const f32x4v* prp = (const f32x4v*)pre_gain + lane; const f32x4v* scp = (const f32x4v*)(mod + b * 6 * D + 4 * D) + lane; const f32x4v* shp = (const f32x4v*)(mod + b * 6 * D + 3 * D) + lane;
            uint2* hp = (uint2*)(H2 + (size_t)t * D) + lane;
#pragma unroll
            for (int j = 0; j < 4; ++j) { xv[j] = xv[j] * inv1 * prp[64 * j] * (scp[64 * j] + 1.f) + shp[64 * j];
                uint2 o; o.x = pk2(xv[j].x, xv[j].y); o.y = pk2(xv[j].z, xv[j].w); hp[64 * j] = o; }
            const RLAS f32x4v* wl = (const RLAS f32x4v*)ldsf + lane;
#define RDOT(c_) ({ const RLAS f32x4v* wc_ = wl + (c_) * 256; float a_ = 0.f; _Pragma("unroll") for (int j = 0; j < 4; ++j) { const f32x4v w_ = wc_[64 * j]; \
                a_ += (xv[j].x * w_.x + xv[j].y * w_.y) + (xv[j].z * w_.z + xv[j].w * w_.w); } a_; })
            float gl[4];
#pragma unroll
            for (int i = 0; i < 4; ++i) gl[i] = wave_sum_valu(RDOT(i)) + bgr[i];
            int gi = 0; float mxv = gl[0];
#pragma unroll
            for (int i = 1; i < 4; ++i) if (gl[i] > mxv) { mxv = gl[i]; gi = i; }
            gi = __builtin_amdgcn_readfirstlane(gi);
            float den = 0.f;
#pragma unroll
            for (int i = 0; i < 4; ++i) den += expf(gl[i] - mxv);
            float v1 = -INFINITY, v2 = -INFINITY; int i1 = 0, i2 = 0;
#pragma unroll
            for (int i = 0; i < 8; ++i) { const float v = wave_sum_valu(RDOT(4 + gi * 8 + i)) + ber[gi * 8 + i];
                if (v > v1) { v2 = v1; i2 = i1; v1 = v; i1 = i; } else if (v > v2) { v2 = v; i2 = i; } }
#undef RDOT
            const float p2 = expf(v2 - v1), gwt = 1.f / den;
            if (lane == 0) { Lg[ri * 40 + 0] = __int_as_float(gi * 8 + i1); Lg[ri * 40 + 1] = __int_as_float(gi * 8 + i2); Lg[ri * 40 + 2] = gwt / (1.f + p2); Lg[ri * 40 + 3] = gwt * p2 / (1.f + p2); }
        }
        asm volatile("s_waitcnt lgkmcnt(0)" ::: "memory");
        RLAS int* agg = (RLAS int*)(ldsf + 36 * 1024 + 8 * 320);
        if (tid < 32) agg[tid] = 0;
        __syncthreads();
        int e1 = 0, e2 = 0, r1 = 0, r2 = 0; float w1 = 0.f, w2 = 0.f;
        if (lane < nr) {
            const RLAS float* lr = Lg + lane * 40;
            e1 = __float_as_int(lr[0]); e2 = __float_as_int(lr[1]); w1 = lr[2]; w2 = lr[3];
            r1 = __hip_atomic_fetch_add(agg + e1, 1, __ATOMIC_RELAXED, __HIP_MEMORY_SCOPE_WORKGROUP);
            r2 = __hip_atomic_fetch_add(agg + e2, 1, __ATOMIC_RELAXED, __HIP_MEMORY_SCOPE_WORKGROUP);
        }
        __syncthreads();
        if (tid < 32) { const int c = agg[tid]; agg[32 + tid] = c ? atomicAdd(&CNT[tid * 64], c) : 0; }
        __syncthreads();
        if (lane < nr) { const int t = tb + lane;
            const int s1 = agg[32 + e1] + r1, s2 = agg[32 + e2] + r2;
            RT_E[t] = e1 | (e2 << 8); RT_S[2 * t] = s1; RT_S[2 * t + 1] = s2;
            ETOK[e1 * M + s1] = t; EW[e1 * M + s1] = w1; ETOK[e2 * M + s2] = t; EW[e2 * M + s2] = w2; }
        __syncthreads();
    }
    __syncthreads();
}
__device__ __forceinline__ void moe_table(int* tp, const int* CNT) {
    const int tid = tidx();
    __syncthreads();
    if (tid < 64) { const int c = (tid < 32) ? __hip_atomic_load(CNT + tid * 64, __ATOMIC_RELAXED, __HIP_MEMORY_SCOPE_AGENT) : 0; int v = (c + 255) >> 8;
        int inc = v;
#pragma unroll
        for (int o = 1; o < 64; o <<= 1) { const int n = __shfl_up(inc, o); if ((tid & 63) >= o) inc += n; }
        if (tid <= 32) tp[tid] = inc - v; }
    __syncthreads();
}
__device__ void ph_gather_tiles(const int* tp, const int* CNT, const bf16* H2, const int* ETOK, const float* EW, bf16* HG, float* ROWW) {
    const int lane = tidx() & 63, wave = tidx() >> 6;
    const int ntile = tp[32];
    for (int rtg = blockIdx.x; rtg < ntile; rtg += gridDim.x) {
        int e = 0;
        for (int j = 1; j < 32; ++j) e += (tp[j] <= rtg) ? 1 : 0;
        const int slot0 = (rtg - tp[e]) * 256, cnt = __hip_atomic_load(CNT + e * 64, __ATOMIC_RELAXED, __HIP_MEMORY_SCOPE_AGENT);
        const int myslot = slot0 + wave * 32 + (lane & 31); const bool ok = myslot < cnt;
        const int mytok = ok ? ETOK[e * M + myslot] : 0; const float myw = ok ? EW[e * M + myslot] : 0.f;
        if (lane < 32) ROWW[rtg * 256 + wave * 32 + lane] = myw;
        for (int i0 = 0; i0 < 32; i0 += 16) { v4u a[16], c[16];
#pragma unroll
            for (int i = 0; i < 16; ++i) { const int tok = __shfl(mytok, i0 + i); const v4u* src = (const v4u*)(H2 + (size_t)tok * D) + lane; a[i] = src[0]; c[i] = src[64]; }
#pragma unroll
            for (int i = 0; i < 16; ++i) { v4u* dst = (v4u*)(HG + (size_t)(rtg * 256 + wave * 32 + i0 + i) * D) + lane; dst[0] = a[i]; dst[64] = c[i]; } }
    }
    asm volatile("s_waitcnt vmcnt(0)" ::: "memory");
    __syncthreads();
}
__device__ void ph_moe_final(const bf16* YP, const int* tp, const int* RT_E, const int* RT_S, const float* gain, const float* mod, float* out) {
    const int lane = tidx() & 63, gw = blockIdx.x * (NT / 64) + (tidx() >> 6), ngw = gridDim.x * (NT / 64);
    v4u na[2], nc[2]; f32x4v nxa[2], nxb[2];
#define MF_LOAD(tt_) do { const int ee_ = RT_E[tt_]; const int r1_ = tp[ee_ & 255] * 256 + RT_S[2 * (tt_)], r2_ = tp[(ee_ >> 8) & 255] * 256 + RT_S[2 * (tt_) + 1]; \
        const v4u* p1_ = (const v4u*)(YP + (size_t)r1_ * D) + lane; const v4u* p2_ = (const v4u*)(YP + (size_t)r2_ * D) + lane; \
        _Pragma("unroll") for (int j = 0; j < 2; ++j) { na[j] = p1_[64 * j]; nc[j] = p2_[64 * j]; const float* op_ = out + (size_t)(tt_) * D + 512 * j + lane * 8; nxa[j] = *(const f32x4v*)op_; nxb[j] = *(const f32x4v*)(op_ + 4); } } while (0)
    if (gw < M) MF_LOAD(gw);
    for (int t = gw; t < M; t += ngw) { const int b = t >> 11;
        float y[16]; float ss = 0.f; f32x4v xa[2], xb[2];
#pragma unroll
        for (int j = 0; j < 2; ++j) { const v4u a = na[j], c = nc[j]; xa[j] = nxa[j]; xb[j] = nxb[j];
#pragma unroll
            for (int e = 0; e < 4; ++e) { const float v0 = __uint_as_float(a[e] << 16) + __uint_as_float(c[e] << 16), v1 = __uint_as_float(a[e] & 0xffff0000u) + __uint_as_float(c[e] & 0xffff0000u);
                y[8 * j + 2 * e] = v0; y[8 * j + 2 * e + 1] = v1; ss += v0 * v0 + v1 * v1; } }
        if (t + ngw < M) MF_LOAD(t + ngw);
        const float inv = rsqrtf(wave_sum_valu(ss) * (1.f / D) + EPS);
#pragma unroll
        for (int j = 0; j < 2; ++j) { const int col = 512 * j + lane * 8; float* op = out + (size_t)t * D + col;
            const f32x4v g2a = *(const f32x4v*)(mod + b * 6 * D + 5 * D + col), g2b = *(const f32x4v*)(mod + b * 6 * D + 5 * D + col + 4);
            const f32x4v ga = *(const f32x4v*)(gain + col), gb = *(const f32x4v*)(gain + col + 4);
            f32x4v a_ = xa[j], b_ = xb[j];
            a_.x += g2a.x * (y[8 * j + 0] * inv * ga.x); a_.y += g2a.y * (y[8 * j + 1] * inv * ga.y); a_.z += g2a.z * (y[8 * j + 2] * inv * ga.z); a_.w += g2a.w * (y[8 * j + 3] * inv * ga.w);
            b_.x += g2b.x * (y[8 * j + 4] * inv * gb.x); b_.y += g2b.y * (y[8 * j + 5] * inv * gb.y); b_.z += g2b.z * (y[8 * j + 6] * inv * gb.z); b_.w += g2b.w * (y[8 * j + 7] * inv * gb.w);
            *(f32x4v*)op = a_; *(f32x4v*)(op + 4) = b_; }
    }
#undef MF_LOAD
}
__device__ void ph_attn_ref(const bf16* Q, const bf16* KF, const bf16* VT, float* o) {
    const int lane = tidx() & 63, gw = blockIdx.x * (NT / 64) + (tidx() >> 6), ngw = gridDim.x * (NT / 64);
    for (int item = gw; item < NB * MLA_H * (SEQ / 64); item += ngw) {
        const int qb = (SEQ / 64 - 1) - item / (NB * MLA_H), bh = item % (NB * MLA_H), b = bh / MLA_H, h = bh % MLA_H;
        const int qi = qb * 64 + lane;
        const size_t t = (size_t)b * SEQ + qi;
        float qr[QK];
#pragma unroll
        for (int d = 0; d < QK; ++d) qr[d] = bf2f(Q[t * 768 + h * QK + d]);
        float acc[VD];
#pragma unroll
        for (int d = 0; d < VD; ++d) acc[d] = 0.f;
        float mx = -INFINITY, l = 0.f;
        const int kmax = qb * 64 + 63;
        for (int k = 0; k <= kmax; ++k) {
            const bf16* kt = KF + (size_t)(bh * 32 + (k >> 6)) * 6144 + (k & 63) * 8;
            const bf16* vt = VT + (size_t)(bh * 32 + (k >> 6)) * 4096 + (k & 63) * 32;
            float s = 0.f;
#pragma unroll
            for (int d = 0; d < QK; ++d) s += qr[d] * bf2f(kt[(d >> 3) * 512 + (d & 7)]);
            if (k <= qi) {
                const float mn = fmaxf(mx, s);
                const float f = exp2f(mx - mn), pv = exp2f(s - mn);
                l = l * f + pv;
#pragma unroll
                for (int d = 0; d < VD; ++d) acc[d] = acc[d] * f + pv * bf2f(vt[(d >> 5) * 2048 + (d & 31)]);
                mx = mn;
            }
        }
        const float il = 1.f / l;
#pragma unroll
        for (int d = 0; d < VD; ++d) o[t * (MLA_H * VD) + h * VD + d] = acc[d] * il;
    }
}

__device__ __forceinline__ void glds16(const void* gsrc, unsigned lds_dst) { unsigned keep;
    asm volatile("s_mov_b32 %0, m0\n\ts_mov_b32 m0, %2\n\ts_nop 0\n\tglobal_load_lds_dwordx4 %1, off\n\ts_mov_b32 m0, %0" : "=&s"(keep) : "v"(gsrc), "s"(lds_dst) : "memory"); }
namespace att {
typedef short bf16x8 __attribute__((ext_vector_type(8)));
typedef short s16x4 __attribute__((ext_vector_type(4)));
typedef float f32x16 __attribute__((ext_vector_type(16)));
typedef unsigned u32x4 __attribute__((ext_vector_type(4)));
#define ALAS __attribute__((address_space(3)))
constexpr int KSLOT = 12288, VSLOT = 8192, NSLOT = 4, NSLOTV = 4;
constexpr int LDS_K = 0, LDS_V = NSLOT * KSLOT, LDS_WS = LDS_V + NSLOTV * VSLOT, LDS_OST = LDS_WS + 8 * 256, LDS_END = LDS_OST + 8 * 4096;
constexpr float THR = 8.0f;
__device__ __forceinline__ int crow(int r, int hi) { return (r & 3) + 8 * (r >> 2) + 4 * hi; }
__device__ __forceinline__ unsigned cvtpk(float lo, float hi) { typedef float f2 __attribute__((ext_vector_type(2))); typedef __bf16 b2 __attribute__((ext_vector_type(2)));
    f2 v = {lo, hi}; b2 b = __builtin_convertvector(v, b2); return __builtin_bit_cast(unsigned, b); }
__device__ __forceinline__ s16x4 vtr(const ALAS char* p) { typedef short v4 __attribute__((ext_vector_type(4))); return __builtin_bit_cast(s16x4, __builtin_amdgcn_ds_read_tr16_b64_v4i16((ALAS v4*)p)); }
#define AWAIT_BAR(N) asm volatile("s_waitcnt vmcnt(" #N ") lgkmcnt(0)\n\ts_barrier" ::: "memory")

__device__ __forceinline__ void attn_unit(ALAS char* lds, int bh, int qb, const bf16* Q, const bf16* KF, const bf16* VT, bf16* YC, float* SSQ) {
    const int tid = tidx(), lane = tid & 63, r32 = lane & 31, hi = lane >> 5; const int wid = __builtin_amdgcn_readfirstlane(tid >> 6);
    const int b = bh >> 3, h = bh & 7;
    const char* Kt = (const char*)(KF + (size_t)bh * 32 * 6144); const char* Vt = (const char*)(VT + (size_t)bh * 32 * 4096);
    const int NTL = 4 * (qb + 1);
    bf16x8 qf[6];
    { const bf16* qp = Q + (size_t)(b * SEQ + qb * 256 + wid * 32 + r32) * 768 + h * QK + hi * 8;
#pragma unroll
      for (int d0 = 0; d0 < 6; ++d0) qf[d0] = *(const bf16x8*)(qp + d0 * 16); }
    const unsigned koff0 = wid * 1024 + lane * 16, koff1 = (8 + (wid & 3)) * 1024 + lane * 16, voff = wid * 1024 + lane * 16;
    const unsigned lds0 = (unsigned)(uintptr_t)lds;
#define ADMA_K(t, ks_) do { const char* kb_ = Kt + (size_t)(t) * KSLOT; \
        glds16(kb_ + koff0, (unsigned)__builtin_amdgcn_readfirstlane(lds0 + LDS_K + (ks_) * KSLOT + wid * 1024)); \
        glds16(kb_ + koff1, (unsigned)__builtin_amdgcn_readfirstlane(lds0 + LDS_K + (ks_) * KSLOT + (8 + (wid & 3)) * 1024)); } while (0)
#define ADMA_V(t, vs_) do { const char* vb_ = Vt + (size_t)(t) * VSLOT; \
        glds16(vb_ + voff, (unsigned)__builtin_amdgcn_readfirstlane(lds0 + LDS_V + (vs_) * VSLOT + wid * 1024)); } while (0)
#define KLOAD(ks_) do { const ALAS char* Ks_ = lds + LDS_K + (ks_) * KSLOT + hi * 1024 + r32 * 16; \
        _Pragma("unroll") for (int d0 = 0; d0 < 3; ++d0) { kf[2 * d0] = *(const ALAS bf16x8*)(Ks_ + d0 * 2048); kf[2 * d0 + 1] = *(const ALAS bf16x8*)(Ks_ + d0 * 2048 + 512); } } while (0)
    ADMA_K(0, 0); ADMA_V(0, 0); ADMA_K(1, 1); ADMA_V(1, 1); ADMA_K(2, 2);
    ALAS float* wsf = (ALAS float*)(lds + LDS_WS) + wid * 64;
    float mref = 0.f, l = 0.f;
    f32x16 o0 = {}, o1 = {}, negm = {};
    const int qrel = wid * 32 + r32;
    const int vlane = (4 * hi + ((lane & 15) >> 2)) * 64 + ((lane >> 4) & 1) * 32 + (lane & 3) * 8;
    bf16x8 kf[6];
    AWAIT_BAR(6);
    KLOAD(0);
    int kslot = 0, vslot = 0;
    u32x4 pw0 = {}, pw1 = {}, pw2 = {}, pw3 = {};
    bool pend = false;
#define MX3(a, b, c) __builtin_fmaxf(__builtin_fmaxf((a), (b)), (c))
#define EX2(v) __builtin_amdgcn_exp2f(v)
#define SCALE_PW(PW, f_) do { _Pragma("unroll") for (int e_ = 0; e_ < 4; ++e_) PW[e_] = cvtpk(__uint_as_float(PW[e_] << 16) * (f_), __uint_as_float(PW[e_] & 0xffff0000u) * (f_)); } while (0)
#define PV_STEP(PW, ks, Vs) do { const bf16x8 pa_ = __builtin_bit_cast(bf16x8, PW); \
            { const s16x4 a_ = vtr(Vs + (ks) * 1024), b_ = vtr(Vs + (ks) * 1024 + 512); const bf16x8 vf_ = {a_[0], a_[1], a_[2], a_[3], b_[0], b_[1], b_[2], b_[3]}; \
              o0 = __builtin_amdgcn_mfma_f32_32x32x16_bf16(pa_, vf_, o0, 0, 0, 0); } \
            { const s16x4 a_ = vtr(Vs + 4096 + (ks) * 1024), b_ = vtr(Vs + 4096 + (ks) * 1024 + 512); const bf16x8 vf_ = {a_[0], a_[1], a_[2], a_[3], b_[0], b_[1], b_[2], b_[3]}; \
              o1 = __builtin_amdgcn_mfma_f32_32x32x16_bf16(pa_, vf_, o1, 0, 0, 0); } } while (0)
#define ATT_TILE(MASKED) do { \
          \
        if (t <= 1) { AWAIT_BAR(3); } else if (t + 3 < NTL) { AWAIT_BAR(4); } else { AWAIT_BAR(0); }     \
        if (t + 3 < NTL) ADMA_K(t + 3, (kslot + 3) & 3);                                   \
        if (t + 2 < NTL) ADMA_V(t + 2, (vslot + 2) & 3); \
        const ALAS char* Vp = lds + LDS_V + ((vslot + 3) & 3) * VSLOT + vlane;            \
        if (MASKED && 64 * (t - (NTL - 4)) > 32 * wid + 31) {                               \
            if (pend) { PV_STEP(pw0, 0, Vp); PV_STEP(pw1, 1, Vp); PV_STEP(pw2, 2, Vp); PV_STEP(pw3, 3, Vp); pend = false; } \
            kslot = (kslot + 1) & 3; vslot = (vslot + 1) & 3; break; } \
        f32x16 p0 = negm, p1 = negm; \
        { const ALAS char* Kc_ = lds + LDS_K + kslot * KSLOT + hi * 1024 + r32 * 16; \
          bf16x8 kg_[6]; \
          _Pragma("unroll") for (int d0 = 3; d0 < 6; ++d0) { kg_[2 * (d0 - 3)] = *(const ALAS bf16x8*)(Kc_ + d0 * 2048); kg_[2 * (d0 - 3) + 1] = *(const ALAS bf16x8*)(Kc_ + d0 * 2048 + 512); } \
          _Pragma("unroll") for (int d0 = 0; d0 < 3; ++d0) { \
            p0 = __builtin_amdgcn_mfma_f32_32x32x16_bf16(kf[2 * d0], qf[d0], p0, 0, 0, 0); \
            p1 = __builtin_amdgcn_mfma_f32_32x32x16_bf16(kf[2 * d0 + 1], qf[d0], p1, 0, 0, 0); } \
          _Pragma("unroll") for (int d0 = 3; d0 < 6; ++d0) { \
            p0 = __builtin_amdgcn_mfma_f32_32x32x16_bf16(kg_[2 * (d0 - 3)], qf[d0], p0, 0, 0, 0); \
            p1 = __builtin_amdgcn_mfma_f32_32x32x16_bf16(kg_[2 * (d0 - 3) + 1], qf[d0], p1, 0, 0, 0); } } \
        if (t + 1 < NTL) { KLOAD((kslot + 1) & 3); }                                       \
        if (MASKED) { const int jb = t - (NTL - 4); \
            _Pragma("unroll") for (int r = 0; r < 16; ++r) { const int kv = 64 * jb + crow(r, hi); if (kv > qrel) p0[r] = -INFINITY; if (kv + 32 > qrel) p1[r] = -INFINITY; } } \
        float rm; { float a_ = MX3(p0[0], p0[1], p1[0]), b_ = MX3(p0[2], p0[3], p1[1]); a_ = MX3(a_, p1[2], p1[3]); \
            _Pragma("unroll") for (int r = 4; r < 16; r += 4) { a_ = MX3(a_, p0[r], p0[r + 1]); b_ = MX3(b_, p0[r + 2], p0[r + 3]); a_ = MX3(a_, p1[r], p1[r + 1]); b_ = MX3(b_, p1[r + 2], p1[r + 3]); } \
            rm = fmaxf(a_, b_); } \
        { auto rr = __builtin_amdgcn_permlane32_swap(__float_as_uint(rm), __float_as_uint(rm), false, false); rm = fmaxf(__uint_as_float(rr[0]), __uint_as_float(rr[1])); } \
        if (t == 0 || __any(rm > THR)) { \
            const float dl = (t == 0) ? rm : fmaxf(rm, 0.f); \
            mref += dl; \
            _Pragma("unroll") for (int r = 0; r < 16; ++r) { p0[r] -= dl; p1[r] -= dl; } \
            _Pragma("unroll") for (int r = 0; r < 16; ++r) negm[r] = -mref; \
            const float f = EX2(-dl); l *= f; \
            if (t > 0) { \
                SCALE_PW(pw0, f); SCALE_PW(pw1, f); SCALE_PW(pw2, f); SCALE_PW(pw3, f);       \
                if (hi == 0) wsf[r32] = f; \
                asm volatile("s_waitcnt lgkmcnt(0)" ::: "memory"); \
                _Pragma("unroll") for (int r = 0; r < 16; ++r) { const float fr_ = wsf[crow(r, hi)]; o0[r] *= fr_; o1[r] *= fr_; } } } \
        if (pend) { PV_STEP(pw0, 0, Vp); PV_STEP(pw1, 1, Vp); PV_STEP(pw2, 2, Vp); PV_STEP(pw3, 3, Vp); } \
        pend = true; \
        float ls0 = 0.f, ls1 = 0.f; \
        _Pragma("unroll") for (int r = 0; r < 16; ++r) { p0[r] = EX2(p0[r]); p1[r] = EX2(p1[r]); ls0 += p0[r]; ls1 += p1[r]; } \
        l += ls0 + ls1; \
        pw0 = (u32x4){cvtpk(p0[0], p0[1]), cvtpk(p0[2], p0[3]), cvtpk(p0[4], p0[5]), cvtpk(p0[6], p0[7])}; \
        pw1 = (u32x4){cvtpk(p0[8], p0[9]), cvtpk(p0[10], p0[11]), cvtpk(p0[12], p0[13]), cvtpk(p0[14], p0[15])}; \
        pw2 = (u32x4){cvtpk(p1[0], p1[1]), cvtpk(p1[2], p1[3]), cvtpk(p1[4], p1[5]), cvtpk(p1[6], p1[7])}; \
        pw3 = (u32x4){cvtpk(p1[8], p1[9]), cvtpk(p1[10], p1[11]), cvtpk(p1[12], p1[13]), cvtpk(p1[14], p1[15])}; \
        kslot = (kslot + 1) & 3; vslot = (vslot + 1) & 3; } while (0)
    int t = 0;
    for (; t < NTL - 4; ++t) ATT_TILE(false);
    for (; t < NTL; ++t) ATT_TILE(true);
    if (pend) { const ALAS char* Vp = lds + LDS_V + ((vslot + 3) & 3) * VSLOT + vlane;
      PV_STEP(pw0, 0, Vp); PV_STEP(pw1, 1, Vp); PV_STEP(pw2, 2, Vp); PV_STEP(pw3, 3, Vp); }
#undef PV_STEP
#undef ATT_TILE
#undef SCALE_PW
#undef MX3
#undef EX2
#undef KLOAD
#undef ADMA_K
#undef ADMA_V
    { auto rr = __builtin_amdgcn_permlane32_swap(__float_as_uint(l), __float_as_uint(l), false, false); l = __uint_as_float(rr[0]) + __uint_as_float(rr[1]); }
    if (hi == 0) wsf[32 + r32] = l;
    asm volatile("s_waitcnt lgkmcnt(0)" ::: "memory");
    ALAS bf16* stg = (ALAS bf16*)(lds + LDS_OST) + wid * 2048;
#pragma unroll
    for (int r = 0; r < 16; ++r) { const int orow = crow(r, hi); const float rl = 1.f / wsf[32 + orow];
        stg[orow * 64 + r32] = (bf16)f2bf(o0[r] * rl); stg[orow * 64 + 32 + r32] = (bf16)f2bf(o1[r] * rl); }
    asm volatile("s_waitcnt lgkmcnt(0)" ::: "memory");
    const size_t trow0 = (size_t)b * SEQ + qb * 256 + wid * 32;
#pragma unroll
    for (int i = 0; i < 4; ++i) { const int row = i * 8 + (lane >> 3), ch = lane & 7;
        const u32x4 v = *(const ALAS u32x4*)(stg + row * 64 + ch * 8);
        *(u32x4*)(YC + (trow0 + row) * 1024 + 512 + h * 64 + ch * 8) = v;
        float sq = 0.f;
#pragma unroll
        for (int e = 0; e < 4; ++e) { const float a = __uint_as_float(v[e] << 16), c = __uint_as_float(v[e] & 0xffff0000u); sq += a * a + c * c; }
        sq += __shfl_xor(sq, 1); sq += __shfl_xor(sq, 2); sq += __shfl_xor(sq, 4);
        if (ch == 0) SSQ[(trow0 + row) * 16 + 8 + h] = sq; }
    asm volatile("s_waitcnt lgkmcnt(0)\n\ts_barrier" ::: "memory");
}
__device__ __forceinline__ void attn_phase(ALAS char* lds, const bf16* Q, const bf16* KF, const bf16* VT, bf16* YC, float* SSQ) {
    const int G = gridDim.x, bid = blockIdx.x; const int vcu = (G % 8 == 0) ? (bid % 8) * (G / 8) + bid / 8 : bid;
    for (int p = vcu; p < 256; p += G) { const int bh = p >> 2, s = p & 3;
        attn_unit(lds, bh, 7 - s, Q, KF, VT, YC, SSQ);
        attn_unit(lds, bh, s, Q, KF, VT, YC, SSQ); }
}
#undef AWAIT_BAR
}
__device__ void ph_prenorm(const float* in, const float* g, const float* mod, int sh_off, int sc_off, float* out) {
    const int lane = tidx() & 63, gw = blockIdx.x * (NT / 64) + (tidx() >> 6), ngw = gridDim.x * (NT / 64);
    for (int t = gw; t < M; t += ngw) {
        const int b = t / SEQ; const float* r = in + (size_t)t * D;
        float s = 0.f;
        for (int i = lane; i < D; i += 64) s += r[i] * r[i];
        const float inv = rsqrtf(wave_sum(s) / D + EPS);
        for (int i = lane; i < D; i += 64)
            out[(size_t)t * D + i] = r[i] * inv * g[i] * (1.f + mod[b * 6 * D + sc_off + i]) + mod[b * 6 * D + sh_off + i];
    }
}
template <class TY> __device__ void ph_post(const float* base, const TY* y, const float* g, const float* mod, int gate_off, float* out) {
    const int lane = tidx() & 63, gw = blockIdx.x * (NT / 64) + (tidx() >> 6), ngw = gridDim.x * (NT / 64);
    for (int t = gw; t < M; t += ngw) {
        const int b = t / SEQ; const TY* r = y + (size_t)t * D;
        float s = 0.f;
        for (int i = lane; i < D; i += 64) { const float v = ldf(r + i); s += v * v; }
        const float inv = rsqrtf(wave_sum(s) / D + EPS);
        for (int i = lane; i < D; i += 64)
            out[(size_t)t * D + i] = base[(size_t)t * D + i] + mod[b * 6 * D + gate_off + i] * (ldf(r + i) * inv * g[i]);
    }
}
template <class TI> __device__ void ph_rms_slice(const TI* in, int ldi, int off, int n, const float* g, float* out, int ldo, int ooff) {
    const int lane = tidx() & 63, gw = blockIdx.x * (NT / 64) + (tidx() >> 6), ngw = gridDim.x * (NT / 64);
    for (int t = gw; t < M; t += ngw) {
        const TI* r = in + (size_t)t * ldi + off;
        float s = 0.f;
        for (int i = lane; i < n; i += 64) { const float v = ldf(r + i); s += v * v; }
        const float inv = rsqrtf(wave_sum(s) / n + EPS);
        for (int i = lane; i < n; i += 64) out[(size_t)t * ldo + ooff + i] = ldf(r + i) * inv * g[i];
    }
}

namespace ssd {
typedef short bf16x8 __attribute__((ext_vector_type(8)));
typedef short s16x4 __attribute__((ext_vector_type(4)));
typedef float f32x16 __attribute__((ext_vector_type(16)));
typedef unsigned u32x4 __attribute__((ext_vector_type(4)));
#define SLAS __attribute__((address_space(3)))
constexpr float LOG2E = 1.4426950408889634f;
__device__ __forceinline__ int crow(int r, int hi) { return (r & 3) + 8 * (r >> 2) + 4 * hi; }
__device__ __forceinline__ s16x4 vtr(const SLAS char* p) { typedef short v4 __attribute__((ext_vector_type(4))); return __builtin_bit_cast(s16x4, __builtin_amdgcn_ds_read_tr16_b64_v4i16((SLAS v4*)p)); }
__device__ __forceinline__ unsigned cvtpk(float lo, float hi) { typedef float f2 __attribute__((ext_vector_type(2))); typedef __bf16 b2 __attribute__((ext_vector_type(2)));
    f2 v = {lo, hi}; b2 b = __builtin_convertvector(v, b2); return __builtin_bit_cast(unsigned, b); }
#define SWAIT_BAR(N) asm volatile("s_waitcnt vmcnt(" #N ") lgkmcnt(0)\n\ts_barrier" ::: "memory")
#define SDMA(gsrc, ldst) glds16((gsrc), (unsigned)__builtin_amdgcn_readfirstlane((unsigned)(uintptr_t)(ldst)))

constexpr int SW_BUF = 49152, SW_TAB = 2 * SW_BUF;
__device__ __forceinline__ void state_sweep(SLAS char* lds, int b, int h, const bf16* XT, const float* DT, const float* a_log, float* ACS2, bf16* PREV) {
    const int tid = tidx(), lane = tid & 63, r32 = lane & 31, hi = lane >> 5; const int wid = __builtin_amdgcn_readfirstlane(tid >> 6);
    const int g = h >> 2, pt = wid & 1, nt = wid >> 1;
    const float a = -expf(a_log[h]);
    SLAS float* wtab = (SLAS float*)(lds + SW_TAB); SLAS float* ctab = wtab + 2048;
    const int trl = (4 * hi + ((lane & 15) >> 2));
    const int trc = 16 * ((lane >> 4) & 1) + 4 * (lane & 3);
#define SW_ISSUE(c_, buf_) do { const char* xs_ = (const char*)(XT + (size_t)(b * 16 + (c_)) * 131072 + h * 8192); const char* bs_ = (const char*)(XT + (size_t)(b * 16 + (c_)) * 131072 + 65536 + g * 16384); \
        _Pragma("unroll") for (int i_ = 0; i_ < 2; ++i_) SDMA(xs_ + (wid * 2 + i_) * 1024 + lane * 16, lds + (buf_) * SW_BUF + (wid * 2 + i_) * 1024); \
        _Pragma("unroll") for (int i_ = 0; i_ < 4; ++i_) SDMA(bs_ + (wid * 4 + i_) * 1024 + lane * 16, lds + (buf_) * SW_BUF + 16384 + (wid * 4 + i_) * 1024); } while (0)
    SW_ISSUE(0, 0);
#pragma unroll
    for (int cc = 0; cc < 2; ++cc) { const int c = 2 * wid + cc; const size_t t0 = (size_t)(b * 16 + c) * 128;
        const float d0 = DT[(t0 + 2 * lane) * 8 + h], d1 = DT[(t0 + 2 * lane + 1) * 8 + h];
        const float a0 = d0 * a, a1 = d1 * a; float inc = a0 + a1;
#pragma unroll
        for (int o = 1; o < 64; o <<= 1) { const float n = __shfl_up(inc, o); if (lane >= o) inc += n; }
        const float tot = __shfl(inc, 63); const float cs1 = inc, cs0 = inc - a1;
        wtab[c * 128 + 2 * lane] = d0 * expf(tot - cs0); wtab[c * 128 + 2 * lane + 1] = d1 * expf(tot - cs1);
        if (lane == 0) ctab[c] = expf(tot);
        ACS2[(t0 + 2 * lane) * 8 + h] = cs0 * LOG2E; ACS2[(t0 + 2 * lane + 1) * 8 + h] = cs1 * LOG2E; }
    f32x16 st = {};
    for (int c = 0; c < 16; ++c) {
        const int buf = c & 1;
        asm volatile("s_waitcnt vmcnt(4) lgkmcnt(0)\n\ts_barrier" ::: "memory");
        if (c + 1 < 16) SW_ISSUE(c + 1, buf ^ 1);
        const float cdec = ctab[c];
        { SLAS char* xp = lds + buf * SW_BUF + tid * 32; const int l = (tid >> 1) & 127; const float w = wtab[c * 128 + l];
          u32x4 q0 = *(SLAS u32x4*)xp, q1 = *(SLAS u32x4*)(xp + 16);
#pragma unroll
          for (int e = 0; e < 4; ++e) { q0[e] = cvtpk(__uint_as_float(q0[e] << 16) * w, __uint_as_float(q0[e] & 0xffff0000u) * w); q1[e] = cvtpk(__uint_as_float(q1[e] << 16) * w, __uint_as_float(q1[e] & 0xffff0000u) * w); }
          *(SLAS u32x4*)xp = q0; *(SLAS u32x4*)(xp + 16) = q1; }
        asm volatile("s_waitcnt lgkmcnt(0)\n\ts_barrier" ::: "memory");
        f32x16 acc = {};
        { const SLAS char* bb = lds + buf * SW_BUF + 16384 + ((32 * nt + trc) >> 3) * 2048 + ((32 * nt + trc) & 7) * 2 + trl * 16;
          const SLAS char* xb = lds + buf * SW_BUF + pt * 8192 + trl * 64 + trc * 2;
#pragma unroll
          for (int ks = 0; ks < 8; ++ks) {
              const s16x4 a0 = vtr(bb + ks * 256), a1 = vtr(bb + ks * 256 + 128); const s16x4 x0 = vtr(xb + ks * 1024), x1 = vtr(xb + ks * 1024 + 512);
              const bf16x8 af = {a0[0], a0[1], a0[2], a0[3], a1[0], a1[1], a1[2], a1[3]}, xf = {x0[0], x0[1], x0[2], x0[3], x1[0], x1[1], x1[2], x1[3]};
              acc = __builtin_amdgcn_mfma_f32_32x32x16_bf16(af, xf, acc, 0, 0, 0); } }
        { bf16* pv = PREV + (size_t)((b * 16 + c) * 8 + h) * 8192 + (32 * pt + r32) * 8 + 4 * hi;
#pragma unroll
          for (int rg = 0; rg < 4; ++rg) { uint2 o; o.x = cvtpk(st[4 * rg], st[4 * rg + 1]); o.y = cvtpk(st[4 * rg + 2], st[4 * rg + 3]); *(uint2*)(pv + (4 * nt + rg) * 512) = o; } }
#pragma unroll
        for (int r = 0; r < 16; ++r) st[r] = st[r] * cdec + acc[r];
    }
    asm volatile("s_waitcnt vmcnt(0) lgkmcnt(0)\n\ts_barrier" ::: "memory");
#undef SW_ISSUE
}

constexpr int P2_C = 0, P2_B = 32768, P2_XP = 65536, P2_TAB = 131072, P2_STG = 135168, P2_END = 151552;
__device__ __forceinline__ void chunk_unit(SLAS char* lds, int b, int c, int g, const bf16* XT, const bf16* PREV, const float* DT, const float* ACS2, const float* d_skip,
                                           const bf16* U, bf16* YC, float* SSQS) {
    const int tid = tidx(), lane = tid & 63, r32 = lane & 31, hi = lane >> 5; const int wid = __builtin_amdgcn_readfirstlane(tid >> 6);
    const int lb = wid >> 1, ph = wid & 1;
    const char* xt = (const char*)(XT + (size_t)(b * 16 + c) * 131072);
    const size_t t0 = (size_t)(b * 16 + c) * 128;
#pragma unroll
    for (int i = 0; i < 4; ++i) { SDMA(xt + (98304 + g * 16384) * 2 + (wid * 4 + i) * 1024 + lane * 16, lds + P2_C + (wid * 4 + i) * 1024);
                                  SDMA(xt + (65536 + g * 16384) * 2 + (wid * 4 + i) * 1024 + lane * 16, lds + P2_B + (wid * 4 + i) * 1024); }
#define P2_ISSUE(hh_) do { const int h_ = 4 * g + (hh_); const char* xs_ = xt + h_ * 16384; const char* ps_ = (const char*)(PREV + (size_t)((b * 16 + c) * 8 + h_) * 8192); \
        SLAS char* d_ = lds + P2_XP + ((hh_) & 1) * 32768; \
        _Pragma("unroll") for (int i_ = 0; i_ < 2; ++i_) { SDMA(xs_ + (wid * 2 + i_) * 1024 + lane * 16, d_ + (wid * 2 + i_) * 1024); SDMA(ps_ + (wid * 2 + i_) * 1024 + lane * 16, d_ + 16384 + (wid * 2 + i_) * 1024); } } while (0)
    P2_ISSUE(0);
    { SLAS float* tab = (SLAS float*)(lds + P2_TAB); const int hh = tid >> 7, l = tid & 127;
      tab[hh * 256 + l] = ACS2[(t0 + l) * 8 + 4 * g + hh]; tab[hh * 256 + 128 + l] = DT[(t0 + l) * 8 + 4 * g + hh]; }
    P2_ISSUE(1);
    SWAIT_BAR(4);
    bf16x8 cf[8];
#pragma unroll
    for (int ks = 0; ks < 8; ++ks) cf[ks] = *(const SLAS bf16x8*)(lds + P2_C + (2 * ks + hi) * 2048 + (32 * lb + r32) * 16);
    f32x16 cbt[4];
#pragma unroll
    for (int sb = 0; sb < 4; ++sb) { cbt[sb] = f32x16{};
        if (sb <= lb) {
#pragma unroll
            for (int ks = 0; ks < 8; ++ks) { const bf16x8 bfr = *(const SLAS bf16x8*)(lds + P2_B + (2 * ks + hi) * 2048 + (32 * sb + r32) * 16);
                cbt[sb] = __builtin_amdgcn_mfma_f32_32x32x16_bf16(bfr, cf[ks], cbt[sb], 0, 0, 0); } } }
    const int vlane = (4 * hi + ((lane & 15) >> 2)) * 64 + ((lane >> 4) & 1) * 32 + (lane & 3) * 8;
    const int lrow = 32 * lb + r32;
    for (int hh = 0; hh < 4; ++hh) {
        const int h = 4 * g + hh;
        const SLAS char* xb = lds + P2_XP + (hh & 1) * 32768; const SLAS char* pb = xb + 16384;
        const SLAS float* tab = (const SLAS float*)(lds + P2_TAB) + hh * 256;
        const float dsk = d_skip[h];
        u32x4 zpre[2];
#pragma unroll
        for (int i = 0; i < 2; ++i) zpre[i] = *(const u32x4*)(U + (t0 + 32 * lb + i * 16 + (lane >> 2)) * NU + OFF_Z + h * 64 + 32 * ph + 8 * (lane & 3));
        f32x16 o = {};
#pragma unroll
        for (int ks = 0; ks < 8; ++ks) { const bf16x8 pf = *(const SLAS bf16x8*)(pb + (2 * ks + hi) * 1024 + (32 * ph + r32) * 16);
            o = __builtin_amdgcn_mfma_f32_32x32x16_bf16(cf[ks], pf, o, 0, 0, 0); }
#pragma unroll
        for (int r = 0; r < 16; ++r) o[r] *= __builtin_amdgcn_exp2f(tab[32 * lb + crow(r, hi)]);
        int lrow_h = lrow; asm volatile("" : "+v"(lrow_h));
        const float al = tab[lrow];
#pragma unroll
        for (int sb = 0; sb < 4; ++sb) {
            if (sb <= lb) {
                float pr[16];
#pragma unroll
                for (int r = 0; r < 16; ++r) { const int sidx = 32 * sb + crow(r, hi);
                    float v = cbt[sb][r] * __builtin_amdgcn_exp2f(al - tab[sidx]) * tab[128 + sidx];
                    if (sb == lb) { v = (sidx <= lrow_h) ? v : 0.f; v += (sidx == lrow_h) ? dsk : 0.f; }
                    pr[r] = v; }
                const u32x4 pw0 = {cvtpk(pr[0], pr[1]), cvtpk(pr[2], pr[3]), cvtpk(pr[4], pr[5]), cvtpk(pr[6], pr[7])};
                const u32x4 pw1 = {cvtpk(pr[8], pr[9]), cvtpk(pr[10], pr[11]), cvtpk(pr[12], pr[13]), cvtpk(pr[14], pr[15])};
                const SLAS char* xv = xb + ph * 8192 + vlane + (2 * sb) * 1024;
                { const s16x4 a_ = vtr(xv), b_ = vtr(xv + 512); const bf16x8 vf = {a_[0], a_[1], a_[2], a_[3], b_[0], b_[1], b_[2], b_[3]};
                  o = __builtin_amdgcn_mfma_f32_32x32x16_bf16(__builtin_bit_cast(bf16x8, pw0), vf, o, 0, 0, 0); }
                { const s16x4 a_ = vtr(xv + 1024), b_ = vtr(xv + 1024 + 512); const bf16x8 vf = {a_[0], a_[1], a_[2], a_[3], b_[0], b_[1], b_[2], b_[3]};
                  o = __builtin_amdgcn_mfma_f32_32x32x16_bf16(__builtin_bit_cast(bf16x8, pw1), vf, o, 0, 0, 0); }
            }
        }
        SLAS bf16* stg = (SLAS bf16*)(lds + P2_STG) + wid * 1024;
#pragma unroll
        for (int r = 0; r < 16; ++r) stg[crow(r, hi) * 32 + r32] = (bf16)f2bf(o[r]);
        asm volatile("s_waitcnt lgkmcnt(0)" ::: "memory");
#pragma unroll
        for (int i = 0; i < 2; ++i) { const int row = i * 16 + (lane >> 2), ch = lane & 3; const size_t t = t0 + 32 * lb + row;
            const u32x4 ov = *(const SLAS u32x4*)(stg + row * 32 + ch * 8);
            const u32x4 zv = zpre[i];
            u32x4 w; float sq = 0.f;
#pragma unroll
            for (int e = 0; e < 4; ++e) { const float z0 = __uint_as_float(zv[e] << 16), z1 = __uint_as_float(zv[e] & 0xffff0000u);
                const float v0 = __uint_as_float(ov[e] << 16) * (z0 * __builtin_amdgcn_rcpf(1.f + __expf(-z0))), v1 = __uint_as_float(ov[e] & 0xffff0000u) * (z1 * __builtin_amdgcn_rcpf(1.f + __expf(-z1)));
                w[e] = cvtpk(v0, v1); const float r0 = __uint_as_float(w[e] << 16), r1 = __uint_as_float(w[e] & 0xffff0000u); sq += r0 * r0 + r1 * r1; }
            *(u32x4*)(YC + t * 1024 + h * 64 + 32 * ph + 8 * ch) = w;
            sq += __shfl_xor(sq, 1); sq += __shfl_xor(sq, 2);
            if (ch == 0) SSQS[t * 16 + h * 2 + ph] = sq; }
        if (hh < 3) {
            if (hh + 2 < 4) { asm volatile("s_waitcnt lgkmcnt(0)\n\ts_barrier" ::: "memory"); P2_ISSUE(hh + 2); SWAIT_BAR(4); }
            else { SWAIT_BAR(0); }
        }
    }
    asm volatile("s_waitcnt vmcnt(0) lgkmcnt(0)\n\ts_barrier" ::: "memory");
#undef P2_ISSUE
}
#undef SWAIT_BAR
#undef SDMA
}
__device__ void ph_gate_norm(const float* y, const bf16* u, bf16* YC) {
    const int lane = tidx() & 63, gw = blockIdx.x * (NT / 64) + (tidx() >> 6), ngw = gridDim.x * (NT / 64);
    for (int t = gw; t < M; t += ngw) {
        float v[8]; float s = 0.f;
#pragma unroll
        for (int j = 0; j < 8; ++j) { const int i = lane + 64 * j; v[j] = y[(size_t)t * SSD_INNER + i] * silu_f(bf2f(u[(size_t)t * NU + OFF_Z + i])); s += v[j] * v[j]; }
        const float inv = rsqrtf(wave_sum(s) / SSD_INNER + EPS);
#pragma unroll
        for (int j = 0; j < 8; ++j) YC[(size_t)t * 1024 + lane + 64 * j] = (bf16)f2bf(v[j] * inv);
    }
}
__device__ void ph_yc_norm(bf16* YC, const float* SSQS, const float* SSQ) {
    const int lane = tidx() & 63, gw = blockIdx.x * (NT / 64) + (tidx() >> 6), ngw = gridDim.x * (NT / 64);
    v4u nw0 = {0u, 0u, 0u, 0u}, nw1 = nw0;
    if (gw < M) { const v4u* p = (const v4u*)(YC + (size_t)gw * 1024) + lane; nw0 = p[0]; nw1 = p[64]; }
    for (int t = gw; t < M; t += ngw) {
        float ss = 0.f, sm = 0.f;
#pragma unroll
        for (int q = 0; q < 4; ++q) { const f32x4v a = *(const f32x4v*)(SSQS + (size_t)t * 16 + 4 * q); ss += (a.x + a.y) + (a.z + a.w); }
        { const f32x4v a = *(const f32x4v*)(SSQ + (size_t)t * 16 + 8), b = *(const f32x4v*)(SSQ + (size_t)t * 16 + 12); sm = (a.x + a.y) + (a.z + a.w) + (b.x + b.y) + (b.z + b.w); }
        v4u w0 = nw0, w1 = nw1;
        if (t + ngw < M) { const v4u* p = (const v4u*)(YC + (size_t)(t + ngw) * 1024) + lane; nw0 = p[0]; nw1 = p[64]; }
        const float invs = rsqrtf(ss * (1.f / 512.f) + EPS), invm = rsqrtf(sm * (1.f / 512.f) + EPS);
        v4u* p = (v4u*)(YC + (size_t)t * 1024) + lane;
#pragma unroll
        for (int e = 0; e < 4; ++e) { w0[e] = pk2(__uint_as_float(w0[e] << 16) * invs, __uint_as_float(w0[e] & 0xffff0000u) * invs); w1[e] = pk2(__uint_as_float(w1[e] << 16) * invm, __uint_as_float(w1[e] & 0xffff0000u) * invm); }
        p[0] = w0; p[64] = w1;
    }
}
__device__ void ph_gemm(float* lds, const float* A, int lda, const float* B, int ldb, float* C, int ldc, int Mr, int N, int K) {
    float (*As)[129] = (float (*)[129])lds;
    float (*Bs)[65] = (float (*)[65])(lds + 16 * 129);
    const int tx = tidx() & 15, ty = tidx() >> 4;
    const int ntn = (N + 63) / 64, ntm = Mr / 128;
    for (int tile = blockIdx.x; tile < ntn * ntm; tile += gridDim.x) {
        const int m0 = (tile / ntn) * 128, n0 = (tile % ntn) * 64;
        float acc[4][4] = {};
        for (int k0 = 0; k0 < K; k0 += 16) {
            for (int i = tidx(); i < 128 * 16; i += NT) { const int r = i >> 4, kk = i & 15; As[kk][r] = A[(size_t)(m0 + r) * lda + k0 + kk]; }
            for (int i = tidx(); i < 64 * 16; i += NT) { const int kk = i >> 6, cc = i & 63; Bs[kk][cc] = (n0 + cc < N) ? B[(size_t)(k0 + kk) * ldb + n0 + cc] : 0.f; }
            __syncthreads();
#pragma unroll
            for (int kk = 0; kk < 16; ++kk) {
                float a[4], b[4];
#pragma unroll
                for (int i = 0; i < 4; ++i) { a[i] = As[kk][ty * 4 + i]; b[i] = Bs[kk][tx * 4 + i]; }
#pragma unroll
                for (int i = 0; i < 4; ++i)
#pragma unroll
                    for (int j = 0; j < 4; ++j) acc[i][j] += a[i] * b[j];
            }
            __syncthreads();
        }
#pragma unroll
        for (int i = 0; i < 4; ++i)
#pragma unroll
            for (int j = 0; j < 4; ++j) { const int n = n0 + tx * 4 + j; if (n < N) C[(size_t)(m0 + ty * 4 + i) * ldc + n] = acc[i][j]; }
    }
}
__device__ void ph_conv(const bf16* u, const float* cw, const float* cb, float* xc) {
    for (size_t idx = (size_t)blockIdx.x * NT + tidx(); idx < (size_t)M * SSD_XBC; idx += (size_t)gridDim.x * NT) {
        const int ch = (int)(idx % SSD_XBC), t = (int)(idx / SSD_XBC), s = t % SEQ;
        float acc = cb[ch];
        for (int k = 0; k < 4; ++k) { const int ss = s - 3 + k; if (ss >= 0) acc += cw[k * SSD_XBC + ch] * bf2f(u[(size_t)(t - 3 + k) * NU + OFF_XBC + ch]); }
        xc[idx] = silu_f(acc);
    }
}
__device__ void ph_ssd_seq(const float* DT, const bf16* xc, const float* dt_bias, const float* a_log, const float* d_skip, float* y) {
    for (int item = blockIdx.x; item < NB * SSD_H; item += gridDim.x) {
        const int b = item / SSD_H, h = item % SSD_H, g = h / (SSD_H / SSD_G);
        const int p = tidx() >> 3, nq = tidx() & 7;
        const float a = -expf(a_log[h]), dsk = d_skip[h];
        float st[16];
#pragma unroll
        for (int i = 0; i < 16; ++i) st[i] = 0.f;
        for (int s = 0; s < SEQ; ++s) {
            const size_t t = (size_t)b * SEQ + s;
            const float dt = DT[t * 8 + h];
            const float da = expf(dt * a);
            const float xv = bf2f(xc[t * SSD_XBC + h * SSD_P + p]);
            const float xd = xv * dt;
            const bf16* Bp = xc + t * SSD_XBC + SSD_INNER + g * SSD_N + nq * 16;
            const bf16* Cp = xc + t * SSD_XBC + SSD_INNER + SSD_G * SSD_N + g * SSD_N + nq * 16;
            float acc = 0.f;
#pragma unroll
            for (int i = 0; i < 16; ++i) { st[i] = st[i] * da + xd * bf2f(Bp[i]); acc += bf2f(Cp[i]) * st[i]; }
            acc += __shfl_xor(acc, 1); acc += __shfl_xor(acc, 2); acc += __shfl_xor(acc, 4);
            if (nq == 0) y[t * SSD_INNER + h * SSD_P + p] = acc + dsk * xv;
        }
    }
}
__device__ void ph_rope(float* q, const bf16* u, const int* pos, float* kpe) {
    for (int idx = blockIdx.x * NT + tidx(); idx < M * 9 * 16; idx += gridDim.x * NT) {
        const int i = idx % 16, hh = (idx / 16) % 9, t = idx / (16 * 9);
        const float inv = 1.0f / powf(10000.0f, (float)(2 * i) / 32.0f);
        const float ang = (float)pos[t] * inv;
        float sn, cs; sincosf(ang, &sn, &cs);
        if (hh < 8) {
            float* p = q + (size_t)t * (MLA_H * QK) + hh * QK + NOPE;
            const float x1 = p[i], x2 = p[16 + i];
            p[i] = x1 * cs - x2 * sn; p[16 + i] = x2 * cs + x1 * sn;
        } else {
            const bf16* p = u + (size_t)t * NU + OFF_KR;
            const float x1 = bf2f(p[i]), x2 = bf2f(p[16 + i]);
            kpe[(size_t)t * ROPE + i] = x1 * cs - x2 * sn; kpe[(size_t)t * ROPE + 16 + i] = x2 * cs + x1 * sn;
        }
    }
}
__device__ void ph_attn(const float* q, const float* kv, const float* kpe, float* o) {
    const int lane = tidx() & 63, gw = blockIdx.x * (NT / 64) + (tidx() >> 6), ngw = gridDim.x * (NT / 64);
    for (int item = gw; item < NB * MLA_H * (SEQ / 64); item += ngw) {
        const int qb = (SEQ / 64 - 1) - item / (NB * MLA_H), bh = item % (NB * MLA_H), b = bh / MLA_H, h = bh % MLA_H;
        const int qi = qb * 64 + lane;
        const size_t t = (size_t)b * SEQ + qi;
        float qr[QK];
#pragma unroll
        for (int d = 0; d < QK; ++d) qr[d] = q[t * (MLA_H * QK) + h * QK + d] * 0.10206207261596575f;
        float acc[VD];
#pragma unroll
        for (int d = 0; d < VD; ++d) acc[d] = 0.f;
        float mx = -INFINITY, l = 0.f;
        const int kmax = qb * 64 + 63;
        for (int k = 0; k <= kmax; ++k) {
            const size_t tk = (size_t)b * SEQ + k;
            const float* kn = kv + tk * (MLA_H * 128) + h * 128;
            const float* kp = kpe + tk * ROPE;
            float s = 0.f;
#pragma unroll
            for (int d = 0; d < NOPE; ++d) s += qr[d] * kn[d];
#pragma unroll
            for (int d = 0; d < ROPE; ++d) s += qr[NOPE + d] * kp[d];
            if (k <= qi) {
                const float mn = fmaxf(mx, s);
                const float f = expf(mx - mn), pv = expf(s - mn);
                l = l * f + pv;
#pragma unroll
                for (int d = 0; d < VD; ++d) acc[d] = acc[d] * f + pv * kn[64 + d];
                mx = mn;
            }
        }
        const float il = 1.f / l;
#pragma unroll
        for (int d = 0; d < VD; ++d) o[t * (MLA_H * VD) + h * VD + d] = acc[d] * il;
    }
}
__device__ void ph_moe(float* lds, const float* h2, const float* wgr, const float* bgr, const float* wer, const float* ber,
                       const float* wg, const float* wu, const float* wd, float* y2) {
    const int sb = tidx() >> 8, tid = tidx() & 255;
    float* xs = lds + sb * 2048;
    float* logit = xs + 1024;
    float* hid = xs + 1088;
    int* sel_e = (int*)(xs + 1600);
    float* sel_w = xs + 1604;
    for (int it = blockIdx.x; it < M / 2; it += gridDim.x) {
        const int t = it * 2 + sb;
        __syncthreads();
        for (int i = tid; i < D; i += 256) xs[i] = h2[(size_t)t * D + i];
        __syncthreads();
        {
            const int w = tid >> 6, lane = tid & 63;
            for (int cidx = w * 9; cidx < w * 9 + 9; ++cidx) {
                float s = 0.f;
                for (int k = lane; k < D; k += 64) s += xs[k] * (cidx < 4 ? wgr[k * 4 + cidx] : wer[k * 32 + (cidx - 4)]);
                s = wave_sum(s);
                if (lane == 0) logit[cidx] = s;
            }
        }
        __syncthreads();
        if (tid == 0) {
            float mxv = -INFINITY; int gi = 0;
            for (int i = 0; i < 4; ++i) { const float v = logit[i] + bgr[i]; logit[i] = v; if (v > mxv) { mxv = v; gi = i; } }
            float den = 0.f; for (int i = 0; i < 4; ++i) den += expf(logit[i] - mxv);
            const float gw = 1.f / den;
            float emx = -INFINITY; int i1 = 0;
            for (int i = 0; i < 8; ++i) { const float v = logit[4 + gi * 8 + i] + ber[gi * 8 + i]; logit[4 + gi * 8 + i] = v; if (v > emx) { emx = v; i1 = i; } }
            float e2 = -INFINITY; int i2 = 0;
            for (int i = 0; i < 8; ++i) { const float v = logit[4 + gi * 8 + i]; if (i != i1 && v > e2) { e2 = v; i2 = i; } }
            const float p2 = expf(e2 - emx);
            sel_e[0] = gi * 8 + i1; sel_e[1] = gi * 8 + i2;
            sel_w[0] = gw / (1.f + p2); sel_w[1] = gw * p2 / (1.f + p2);
        }
        __syncthreads();
        for (int k2 = 0; k2 < 2; ++k2) {
            const int e = sel_e[k2];
            const float* G = wg + (size_t)e * D * FF; const float* U = wu + (size_t)e * D * FF;
            float ga = 0.f, ua = 0.f;
            for (int k = 0; k < D; ++k) { ga += xs[k] * G[(size_t)k * FF + tid]; ua += xs[k] * U[(size_t)k * FF + tid]; }
            hid[k2 * FF + tid] = silu_f(ga) * ua * sel_w[k2];
        }
        __syncthreads();
        for (int d = tid; d < D; d += 256) {
            float acc = 0.f;
            for (int k2 = 0; k2 < 2; ++k2) {
                const float* Wd = wd + (size_t)sel_e[k2] * FF * D;
                for (int f = 0; f < FF; ++f) acc += hid[k2 * FF + f] * Wd[(size_t)f * D + d];
            }
            y2[(size_t)t * D + d] = acc;
        }
    }
}


#define LAS __attribute__((address_space(3)))
#define XB_TMO      128
#define XB_XCNT(j)  (256  + 64 * (j))
#define XB_XSUB(j)  (1280 + 64 * (j))
#define XB_XGEN(j)  (2304 + 64 * (j))
#define XB_TOP      3328
#define XB_TOPGEN   3392
#define XCD_BAR_WORDS 3456
#define XB_SPIN_CAP (1u << 18)

__device__ __forceinline__ unsigned xb_ld(unsigned* p)              { return __hip_atomic_load(p, __ATOMIC_RELAXED, __HIP_MEMORY_SCOPE_AGENT); }
__device__ __forceinline__ unsigned xb_add(unsigned* p, unsigned v) { return __hip_atomic_fetch_add(p, v, __ATOMIC_RELAXED, __HIP_MEMORY_SCOPE_AGENT); }
__device__ __forceinline__ unsigned xb_xcc_id() { return (unsigned)__builtin_amdgcn_s_getreg((3 << 11) | 20) & 0xFu; }
#define XB_SPIN(cond, bar) do { unsigned _sp = 0; while (cond) { __builtin_amdgcn_s_sleep(1); \
    if ((++_sp & 255u) == 0u) { if (xb_ld(&(bar)[XB_TMO])) break; if (_sp > XB_SPIN_CAP) { atomicAdd(&(bar)[XB_TMO], 1u); break; } } } } while (0)

struct XcdBarrier {
    unsigned* bar; unsigned x;
    volatile LAS unsigned* st;
};

__device__ __forceinline__ XcdBarrier xcd_barrier_post(unsigned* bar, volatile LAS unsigned* st) {
    XcdBarrier b; b.bar = bar; b.x = xb_xcc_id(); b.st = st;
    if (tidx() == 0) (void)xb_add(&bar[XB_XCNT(b.x)], 1u);
    return b;
}
__device__ __forceinline__ void xcd_barrier_complete(unsigned* bar, unsigned x, unsigned& nloc, unsigned& nx) {
    const unsigned G = gridDim.x * gridDim.y * gridDim.z;
    unsigned sum, cnt, mine, sp = 0u;
    for (;;) {
        sum = 0u; cnt = 0u; mine = 0u;
#pragma unroll
        for (unsigned j = 0; j < 16; ++j) { const unsigned c = xb_ld(&bar[XB_XCNT(j)]); sum += c; cnt += (c > 0u) ? 1u : 0u; mine = (j == x) ? c : mine; }
        if (sum == G) break;
        __builtin_amdgcn_s_sleep(1);
        if ((++sp & 255u) == 0u) { if (xb_ld(&bar[XB_TMO])) break; if (sp > XB_SPIN_CAP) { atomicAdd(&bar[XB_TMO], 1u); break; } }
    }
    nloc = mine > 0u ? mine : 1u; nx = cnt > 0u ? cnt : 1u;
}

__device__ __forceinline__ void xcd_barrier(const XcdBarrier& b) {
    asm volatile("s_waitcnt vmcnt(0)" ::: "memory");
    __syncthreads();
    if (tidx() == 0) {
        unsigned* bar = b.bar;
        __builtin_amdgcn_s_waitcnt(0);
        unsigned nloc = b.st[0], nx = b.st[1];
        if (nloc == 0u) { xcd_barrier_complete(bar, b.x, nloc, nx); b.st[0] = nloc; b.st[1] = nx; }
        const unsigned old = xb_add(&bar[XB_XSUB(b.x)], 1u);
        const unsigned gen = old / nloc;
        if (old + 1u == (gen + 1u) * nloc) {
            __builtin_amdgcn_fence(__ATOMIC_RELEASE, "agent");
            asm volatile("s_waitcnt vmcnt(0)" ::: "memory");
            const unsigned og = xb_add(&bar[XB_TOP], 1u);
            const unsigned tg = og / nx;
            if (og + 1u == (tg + 1u) * nx) xb_add(&bar[XB_TOPGEN], 1u);
            else XB_SPIN(xb_ld(&bar[XB_TOPGEN]) == tg, bar);
            __builtin_amdgcn_fence(__ATOMIC_ACQUIRE, "agent");
            xb_add(&bar[XB_XGEN(b.x)], 1u);
            asm volatile("s_waitcnt vmcnt(0)" ::: "memory");
        } else {
            XB_SPIN(xb_ld(&bar[XB_XGEN(b.x)]) == gen, bar);
            __builtin_amdgcn_fence(__ATOMIC_ACQUIRE, "agent");
            asm volatile("s_waitcnt vmcnt(0)" ::: "memory");
        }
    }
    __syncthreads();
}


constexpr size_t MiB = 1u << 20;
#define WSB(T, off) ((T*)(kargs()->ws + (size_t)(off)))
#define OUTB(T, off) ((T*)((char*)kargs()->out + (size_t)(off)))
#define B_CNT    WSB(int, 4096)
#define B_MOD    WSB(float, 1 * MiB)
#define B_DT     WSB(float, 1 * MiB + 256 * 1024)
#define B_ACS2   WSB(float, 1 * MiB + 768 * 1024)
#define B_WIN    WSB(bf16, 2 * MiB)
#define B_WOUT   WSB(bf16, 6 * MiB)
#define B_WUQ    WSB(bf16, 8 * MiB)
#define B_WUKV   WSB(bf16, 9 * MiB)
#define B_WRT    WSB(float, 9 * MiB + 512 * 1024)
#define B_WGU    WSB(bf16, 10 * MiB)
#define B_WD     WSB(bf16, 42 * MiB)
#define B_HB     WSB(bf16, 58 * MiB)
#define B_YC     WSB(bf16, 58 * MiB)
#define B_H2     WSB(bf16, 58 * MiB)
#define B_U      WSB(bf16, 90 * MiB)
#define B_HG     WSB(bf16, 90 * MiB)
#define B_YP     WSB(bf16, 90 * MiB)
#define B_XT     WSB(bf16, 154 * MiB)
#define B_YB     WSB(bf16, 154 * MiB)
#define B_HID    WSB(bf16, 170 * MiB)
#define B_Q      WSB(bf16, 186 * MiB)
#define B_ETOK   WSB(int, 192 * MiB)
#define B_EW     WSB(float, 196 * MiB)
#define B_KF     WSB(bf16, 210 * MiB)
#define B_VT     WSB(bf16, 234 * MiB)
#define B_COS    WSB(float, 250 * MiB)
#define B_SIN    WSB(float, 251 * MiB)
#define B_RTE    WSB(int, 250 * MiB)
#define B_RTS    WSB(int, 250 * MiB + 256 * 1024)
#define B_RTW    WSB(float, 250 * MiB + 512 * 1024)
#define B_TOKROW WSB(int, 250 * MiB + 768 * 1024)
#define B_ROWW   WSB(float, 251 * MiB)
#define B_SSQ    WSB(float, 252 * MiB)
#define B_SSQS   WSB(float, 253 * MiB)
#define B_PREV   OUTB(bf16, 0)
#define B_CQN    OUTB(bf16, 32 * MiB)
#define B_CKVN   OUTB(bf16, 40 * MiB)
#define LDS_TP   ((int*)(lds_raw + 131072 + 1024))

__global__ void __launch_bounds__(NT, 2) mega_fwd(Params P) {
    if (threadIdx.x < 2) ((volatile LAS unsigned*)(lds_raw + WTAB_OFF - 16))[threadIdx.x] = 0u;
    tidx_init();
    float* lds = (float*)lds_raw;
    const XcdBarrier bar = xcd_barrier_post((unsigned*)(kargs()->ws + 16384), (volatile LAS unsigned*)(lds_raw + WTAB_OFF - 16));
#define GSYNC() xcd_barrier(bar)
    ph_prep(lds, B_MOD, B_WIN, B_WOUT, B_WUQ, B_WUKV, B_WRT, B_WGU, B_WD);
    GSYNC();
    ph_prenorm_bf16(IN(0), IN(5), B_MOD, 0 * D, 1 * D, B_HB);
    GSYNC();
    { pg8::Gemm g{B_HB, B_WIN, M, NU, D}; pg8::StaticOrder S; S.init(M, NU, gridDim.x, (int)blockIdx.x);
      pg8::EpiBf16<0> E{B_U, NU};
      pg8::gemm_phase<pg8::EpiBf16<0>, pg8::StaticOrder, true, true>((PG8_LAS unsigned char*)lds_raw, g, S, E); }
    GSYNC();
    ph_prep2(B_U, kargs()->pos, IN(10), IN(11), IN(12), B_CQN, B_CKVN, B_KF, B_COS, B_SIN, B_DT, B_XT);
    GSYNC();
    {
      const int G = gridDim.x, bid = blockIdx.x; const bool split = G >= 128;
      if (!split || bid < 64) { for (int it = bid; it < 64; it += (split ? 64 : G)) ssd::state_sweep((SLAS char*)lds_raw, it >> 3, it & 7, B_XT, B_DT, IN(13), B_ACS2, B_PREV); }
      if (!split || bid >= 64) { const int Gg = split ? G - 64 : G, cg_ = split ? bid - 64 : bid;
        { pg8::Gemm g{B_CQN, B_WUQ, M, 768, QR}; pg8::StaticOrder S; S.init(M, 768, Gg, cg_);
          pg8::EpiQ E{B_Q, B_COS, B_SIN};
          pg8::gemm_phase<pg8::EpiQ, pg8::StaticOrder, true, false>((PG8_LAS unsigned char*)lds_raw, g, S, E); }
        { pg8::Gemm g{B_CKVN, B_WUKV, M, 1024, 256}; pg8::StaticOrder S; S.init(M, 1024, Gg, cg_);
          pg8::EpiKV E{B_KF, B_VT};
          pg8::gemm_phase<pg8::EpiKV, pg8::StaticOrder, true, false>((PG8_LAS unsigned char*)lds_raw, g, S, E); }
        ph_prep_moe(B_WGU, B_WD, cg_ * (NT / 64) + (tidx() >> 6), Gg * (NT / 64), 0, split ? MOE_SPLIT : 0); } }
    GSYNC();
    att::attn_phase((ALAS char*)lds_raw, B_Q, B_KF, B_VT, B_YC, B_SSQ);
    { const int G = gridDim.x, bid = blockIdx.x; const int vcu = (G % 8 == 0) ? (bid % 8) * (G / 8) + bid / 8 : bid;
      for (int u = vcu; u < 256; u += G) ssd::chunk_unit((SLAS char*)lds_raw, u >> 5, (u >> 1) & 15, u & 1, B_XT, B_PREV, B_DT, B_ACS2, IN(14), B_U, B_YC, B_SSQS); }
    GSYNC();
    ph_yc_norm(B_YC, B_SSQS, B_SSQ);
    GSYNC();
    { pg8::Gemm g{B_YC, B_WOUT, M, D, D}; pg8::StaticOrder S; S.init(M, D, gridDim.x, (int)blockIdx.x);
      pg8::EpiBf16<0> E{B_YB, D};
      pg8::gemm_phase<pg8::EpiBf16<0>, pg8::StaticOrder, true, true>((PG8_LAS unsigned char*)lds_raw, g, S, E); }
    GSYNC();
    ph_rowrouter((__attribute__((address_space(3))) float*)lds_raw, B_YB, IN(0), IN(6), IN(7), B_MOD, B_WRT, IN(23), IN(25), kargs()->out, B_H2, B_CNT, B_RTE, B_RTS, B_ETOK, B_EW);
    GSYNC();
    moe_table(LDS_TP, B_CNT);
    ph_gather_tiles(LDS_TP, B_CNT, B_H2, B_ETOK, B_EW, B_HG, B_ROWW);
    { pg8::Gemm g{B_HG, B_WGU, 0, 0, D}; pg8::OwnTileOrder S{(const PG8_LAS int*)LDS_TP, 2, (int)gridDim.x, (int)blockIdx.x};
      pg8::EpiGU E{B_HID, B_ROWW};
      pg8::gemm_phase<pg8::EpiGU, pg8::OwnTileOrder, true, true>((PG8_LAS unsigned char*)lds_raw, g, S, E); }
    GSYNC();
    { pg8::Gemm g{B_HID, B_WD, 0, 0, FF}; pg8::GroupedOrder S{(const PG8_LAS int*)LDS_TP, 4, (int)gridDim.x, (int)blockIdx.x};
      pg8::EpiDown E{B_YP};
      pg8::gemm_phase<pg8::EpiDown, pg8::GroupedOrder, true, true>((PG8_LAS unsigned char*)lds_raw, g, S, E); }
    GSYNC();
    ph_moe_final(B_YP, LDS_TP, B_RTE, B_RTS, IN(8), B_MOD, kargs()->out);
}

extern "C" void kernel_launch(void* const* d_in, const int* in_sizes, int n_in, void* d_out, int out_size, void* d_ws, size_t ws_size,
                              hipStream_t stream) {
    static int grid_blocks = 0;
    if (!grid_blocks) {
        int dev = 0, cus = 0, per_cu = 0;
        (void)hipGetDevice(&dev);
        (void)hipDeviceGetAttribute(&cus, hipDeviceAttributeMultiprocessorCount, dev);
        (void)hipFuncSetAttribute((const void*)mega_fwd, hipFuncAttributeMaxDynamicSharedMemorySize, LDS_BYTES);
        (void)hipOccupancyMaxActiveBlocksPerMultiprocessor(&per_cu, (const void*)mega_fwd, NT, LDS_BYTES);
        if (per_cu < 1) { fprintf(stderr, "occupancy query returned %d\n", per_cu); per_cu = 1; }
        grid_blocks = cus * per_cu;
    }
    (void)hipMemsetAsync(d_ws, 0, 65536, stream);
    Params p{};
    for (int i = 0; i < 29; ++i) p.in[i] = (const float*)d_in[i];
    p.pos = (const int*)d_in[2];
    p.out = (float*)d_out;
    p.ws = (char*)d_ws;
    void* args[] = {&p};
    hipError_t e = hipLaunchCooperativeKernel((void*)mega_fwd, dim3(grid_blocks), dim3(NT), args, LDS_BYTES, stream);
    if (e != hipSuccess) fprintf(stderr, "cooperative launch failed: %s (grid %d)\n", hipGetErrorString(e), grid_blocks);
}
```

```cpp
#include <hip/hip_runtime.h>
#include <hip/hip_cooperative_groups.h>
#include <stdint.h>
#include <math.h>
#include <cstdio>
namespace cg = cooperative_groups;

constexpr int D = 1024, NB = 8, SEQ = 2048, M = NB * SEQ;
constexpr int SSD_H = 8, SSD_P = 64, SSD_INNER = 512, SSD_G = 2, SSD_N = 128, SSD_XBC = 1024;
constexpr int MLA_H = 8, NOPE = 64, ROPE = 32, QK = 96, VD = 64, QR = 256, KVR = 128;
constexpr int NIN = 1960;
constexpr int NU = 2048;
constexpr int OFF_Z = 0, OFF_XBC = 512, OFF_CQ = 1536, OFF_CKV = 1792, OFF_KR = 1920, OFF_DT = 1952;
constexpr int NEXP = 32, FF = 256;
constexpr float EPS = 1e-6f;
constexpr int MOE_ITEMS = 32 * 16 * 8 + 32 * 4 * 16;
constexpr int MOE_SPLIT = 2560;
constexpr int NT = 512;
constexpr int LDS_BYTES = 160 * 1024;

typedef unsigned short bf16;
__device__ __forceinline__ float bf2f(bf16 v) { return __uint_as_float((unsigned)v << 16); }
__device__ __forceinline__ unsigned f2bf(float f) { unsigned u = __float_as_uint(f); return (u + 0x7fffu + ((u >> 16) & 1u)) >> 16; }
__device__ __forceinline__ unsigned pk2(float lo, float hi) { return f2bf(lo) | (f2bf(hi) << 16); }
typedef unsigned v4u __attribute__((ext_vector_type(4)));
typedef float f32x4v __attribute__((ext_vector_type(4)));

struct Params {
    const float* in[29];
    const int* pos;
    float* out;
    char* ws;
};

#define RLAS __attribute__((address_space(3)))
__device__ __forceinline__ float dpp_f(float v, int ctrl_sel) {
    const int x = __float_as_int(v); int r;
    if (ctrl_sel == 0) r = __builtin_amdgcn_update_dpp(0, x, 0xB1, 0xF, 0xF, true);
    else if (ctrl_sel == 1) r = __builtin_amdgcn_update_dpp(0, x, 0x1B, 0xF, 0xF, true);
    else if (ctrl_sel == 2) r = __builtin_amdgcn_update_dpp(0, x, 0x141, 0xF, 0xF, true);
    else r = __builtin_amdgcn_update_dpp(0, x, 0x140, 0xF, 0xF, true);
    return __int_as_float(r);
}
__device__ __forceinline__ float wave_sum_valu(float v) {
    v += dpp_f(v, 0); v += dpp_f(v, 1); v += dpp_f(v, 2); v += dpp_f(v, 3);
    { auto rr = __builtin_amdgcn_permlane16_swap(__float_as_uint(v), __float_as_uint(v), false, false); v = __uint_as_float(rr[0]) + __uint_as_float(rr[1]); }
    { auto rr = __builtin_amdgcn_permlane32_swap(__float_as_uint(v), __float_as_uint(v), false, false); v = __uint_as_float(rr[0]) + __uint_as_float(rr[1]); }
    return v;
}
__device__ __forceinline__ float ldf(const float* p) { return *p; }
__device__ __forceinline__ float ldf(const bf16* p) { return bf2f(*p); }
extern __shared__ __attribute__((aligned(16))) unsigned char lds_raw[];
constexpr int WTAB_OFF = 160 * 1024 - 256;
__device__ __forceinline__ int hw_wave_key() { int k; asm volatile("s_getreg_b32 %0, hwreg(HW_REG_HW_ID, 0, 6)" : "=s"(k)); return k; }
__device__ __forceinline__ void tidx_init() { const int key = hw_wave_key(); ((volatile __attribute__((address_space(3))) int*)(lds_raw + WTAB_OFF))[key] = (int)(threadIdx.x >> 6); __syncthreads(); }
__device__ __forceinline__ int tidx() {
    const int key = hw_wave_key();
    int w = ((volatile __attribute__((address_space(3))) int*)(lds_raw + WTAB_OFF))[key];
    w = __builtin_amdgcn_readfirstlane(w);
    unsigned ones = ~0u; asm volatile("" : "+s"(ones));
    int t = w * 64 + (int)__builtin_amdgcn_mbcnt_hi(ones, __builtin_amdgcn_mbcnt_lo(ones, 0u));
    asm volatile("" : "+v"(t)); return t; }
typedef const __attribute__((address_space(4))) Params* KArgs;
__device__ __forceinline__ KArgs kargs() { KArgs p = (KArgs)__builtin_amdgcn_kernarg_segment_ptr(); asm volatile("" : "+s"(p)); return p; }
#define IN(i) (kargs()->in[i])
__device__ __forceinline__ float silu_f(float v) { return v / (1.f + expf(-v)); }
__device__ __forceinline__ float wave_sum(float v) {
#pragma unroll
    for (int o = 32; o > 0; o >>= 1) v += __shfl_xor(v, o);
    return v;
}

namespace pg8 {
#define PG8_LAS __attribute__((address_space(3)))
typedef unsigned short bf16_t;
typedef short bf16x8 __attribute__((ext_vector_type(8)));
typedef float f32x4 __attribute__((ext_vector_type(4)));
typedef unsigned u32x4 __attribute__((ext_vector_type(4)));
constexpr int BM = 256, BK = 64, HALF = 128, HTB = HALF * BK * 2  , STAGE_BYTES = 8 * HTB, NXCD = 8, WGM = 8;

__host__ __device__ __forceinline__ int lds_byte(int r, int c) { const int st = (r >> 4) * 2 + (c >> 5), rr = r & 15, cc = c & 31, ob = rr * 64 + cc * 2; return st * 1024 + (ob ^ (((ob >> 9) & 1) << 5)); }
__host__ __device__ __forceinline__ void stage_rc(int b, int& R, int& C) { const int st = b / 1024, sb = b % 1024, swz = sb ^ (((sb >> 9) & 1) << 5); R = (st >> 1) * 16 + swz / 64; C = (st & 1) * 32 + (swz % 64) / 2; }
__host__ __device__ __forceinline__ int perm32(int rho) { const int n = rho >> 4, i = rho & 15; return 8 * (i >> 2) + 4 * n + (i & 3); }

struct Unit { int pm, pn; };
struct Gemm { const bf16_t* A; const bf16_t* Bt; int M, N, K; };

struct StaticOrder {
    int nM, nN, nwg, G, c;
    __host__ __device__ void init(int M, int N, int G_, int c_) { nM = M / BM; nN = N / BM; nwg = nM * nN; G = G_; c = c_; }
    __host__ __device__ bool next(int i, Unit& u) const {
        const long L = (long)i * G + c; if (L >= nwg) return false;
        int wgid = (int)L; { const int q = nwg / NXCD, r = nwg % NXCD, xcd = wgid % NXCD, off = wgid / NXCD; wgid = (xcd < r ? xcd * (q + 1) : r * (q + 1) + (xcd - r) * q) + off; }
        const int nig = WGM * nN, gid = wgid / nig, fm = gid * WGM, gsz = (nM - fm) < WGM ? (nM - fm) : WGM;
        u.pm = fm + ((wgid % nig) % gsz); u.pn = (wgid % nig) / gsz; return true;
    }
    __device__ __forceinline__ void a_ready(const Unit&) const {}
    __device__ __forceinline__ void done(const Unit&) const {}
};


template <int ACT> struct EpiBf16 {
    static constexpr bool PERM = true, AFTER_DRAIN = false;
    bf16_t* O; int ldc;
    __device__ __forceinline__ void operator()(const f32x4 (&acc)[2][2][4][2], const Unit& u, int wr, int wc, int fr, int fq) const {
        { const int l_ = tidx() & 63; fr = l_ & 15; fq = l_ >> 4; }
        const int row0 = u.pm * BM + wr * 64 + fr; const int col0 = u.pn * BM + wc * 32 + 8 * fq;
#pragma unroll
        for (int ai = 0; ai < 2; ++ai)
#pragma unroll
            for (int m = 0; m < 4; ++m) { bf16_t* rowp = O + (size_t)(row0 + ai * HALF + m * 16) * ldc + col0;
#pragma unroll
                for (int bj = 0; bj < 2; ++bj) { const f32x4 v0 = acc[ai][bj][m][0], v1 = acc[ai][bj][m][1];
                    u32x4 w; w.x = pk2(v0[0], v0[1]); w.y = pk2(v0[2], v0[3]); w.z = pk2(v1[0], v1[1]); w.w = pk2(v1[2], v1[3]);
                    *(u32x4*)(rowp + bj * HALF) = w; } }
    }
};

struct EpiQ {
    static constexpr bool PERM = true, AFTER_DRAIN = false;
    bf16_t* Q; const float* COS; const float* SIN;
    __device__ __forceinline__ void operator()(const f32x4 (&acc)[2][2][4][2], const Unit& u, int wr, int wc, int fr, int fq) const {
        { const int l_ = tidx() & 63; fr = l_ & 15; fq = l_ >> 4; }
        const int row0 = u.pm * BM + wr * 64 + fr;
#pragma unroll
        for (int bj = 0; bj < 2; ++bj) {
            const int colg = u.pn * BM + bj * HALF + wc * 32;
            const bool pe = ((colg >> 5) % 3) == 2;
#pragma unroll
            for (int ai = 0; ai < 2; ++ai)
#pragma unroll
                for (int m = 0; m < 4; ++m) {
                    const int row = row0 + ai * HALF + m * 16;
                    f32x4 v0 = acc[ai][bj][m][0], v1 = acc[ai][bj][m][1];
                    if (pe) {
                        f32x4 w0, w1;
#pragma unroll
                        for (int e = 0; e < 4; ++e) { w0[e] = __shfl_xor(v0[e], 32); w1[e] = __shfl_xor(v1[e], 32); }
                        const f32x4* cp = (const f32x4*)(COS + (size_t)row * 16 + (fq & 1) * 8); const f32x4* sp = (const f32x4*)(SIN + (size_t)row * 16 + (fq & 1) * 8);
                        const f32x4 c0 = cp[0], c1 = cp[1], s0 = sp[0], s1 = sp[1];
                        const float sg = (fq < 2) ? -1.f : 1.f;
                        v0 = v0 * c0 + w0 * s0 * sg; v1 = v1 * c1 + w1 * s1 * sg;
                    }
                    u32x4 w; w.x = pk2(v0[0], v0[1]); w.y = pk2(v0[2], v0[3]); w.z = pk2(v1[0], v1[1]); w.w = pk2(v1[2], v1[3]);
                    *(u32x4*)(Q + (size_t)row * 768 + colg + 8 * fq) = w;
                    if (pe) asm volatile("" ::: "memory");
                }
        }
    }
};
struct EpiKV {
    static constexpr bool PERM = true, AFTER_DRAIN = false;
    bf16_t* KF; bf16_t* VT;
    __device__ __forceinline__ void operator()(const f32x4 (&acc)[2][2][4][2], const Unit& u, int wr, int wc, int fr, int fq) const {
        { const int l_ = tidx() & 63; fr = l_ & 15; fq = l_ >> 4; }
        const int row0 = u.pm * BM + wr * 64 + fr;
#pragma unroll
        for (int bj = 0; bj < 2; ++bj) {
            const int colg = u.pn * BM + bj * HALF + wc * 32; const int h = colg >> 7, j0 = (colg & 127) + 8 * fq;
#pragma unroll
            for (int ai = 0; ai < 2; ++ai)
#pragma unroll
                for (int m = 0; m < 4; ++m) {
                    const int t = row0 + ai * HALF + m * 16; const int b = t >> 11, sq = t & 2047, tile = sq >> 6, key = sq & 63;
                    const size_t base = (size_t)((b * 8 + h) * 32 + tile);
                    bf16_t* dst = (j0 < 64) ? KF + base * 6144 + (j0 >> 3) * 512 + key * 8 : VT + base * 4096 + ((j0 - 64) >> 5) * 2048 + key * 32 + ((j0 - 64) & 31);
                    const f32x4 v0 = acc[ai][bj][m][0], v1 = acc[ai][bj][m][1];
                    u32x4 w; w.x = pk2(v0[0], v0[1]); w.y = pk2(v0[2], v0[3]); w.z = pk2(v1[0], v1[1]); w.w = pk2(v1[2], v1[3]);
                    *(u32x4*)dst = w;
                }
        }
    }
};

struct GroupedOrder {
    const PG8_LAS int* tp; int NCT, G, c;
    __device__ __forceinline__ bool next(int i, Unit& u) const {
        const int L = i * G + c, total = tp[32] * NCT; if (L >= total) return false;
        const int rtg = L / NCT, ct = L - rtg * NCT; int e = 0;
        for (int j = 1; j < 32; ++j) e += (tp[j] <= rtg) ? 1 : 0;
        u.pm = rtg; u.pn = e * NCT + ct; return true;
    }
    __device__ __forceinline__ void a_ready(const Unit&) const {}
    __device__ __forceinline__ void done(const Unit&) const {}
};
struct OwnTileOrder {
    const PG8_LAS int* tp; int NCT, G, c;
    __device__ __forceinline__ bool next(int i, Unit& u) const {
        const int rtg = c + (i / NCT) * G, ct = i % NCT; if (rtg >= tp[32]) return false;
        int e = 0;
        for (int j = 1; j < 32; ++j) e += (tp[j] <= rtg) ? 1 : 0;
        u.pm = rtg; u.pn = e * NCT + ct; return true;
    }
    __device__ __forceinline__ void a_ready(const Unit&) const {}
    __device__ __forceinline__ void done(const Unit&) const {}
};
struct EpiGU {
    static constexpr bool PERM = true, AFTER_DRAIN = false;
    bf16_t* HID; const float* ROWW;
    __device__ __forceinline__ void operator()(const f32x4 (&acc)[2][2][4][2], const Unit& u, int wr, int wc, int fr, int fq) const {
        { const int l_ = tidx() & 63; fr = l_ & 15; fq = l_ >> 4; }
        const int row0 = u.pm * BM + wr * 64 + fr; const int col0 = (u.pn & 1) * 128 + wc * 32 + 8 * fq;
#pragma unroll
        for (int ai = 0; ai < 2; ++ai)
#pragma unroll
            for (int m = 0; m < 4; ++m) { const int row = row0 + ai * HALF + m * 16; const float w = ROWW[row];
                float hv[8];
#pragma unroll
                for (int n = 0; n < 2; ++n)
#pragma unroll
                    for (int e = 0; e < 4; ++e) { const float g = acc[ai][0][m][n][e], up = acc[ai][1][m][n][e]; hv[4 * n + e] = g * __builtin_amdgcn_rcpf(1.f + __expf(-g)) * up * w; }
                u32x4 o; o.x = pk2(hv[0], hv[1]); o.y = pk2(hv[2], hv[3]); o.z = pk2(hv[4], hv[5]); o.w = pk2(hv[6], hv[7]);
                *(u32x4*)(HID + (size_t)row * 256 + col0) = o; }
    }
};
struct EpiDown {
    static constexpr bool PERM = true, AFTER_DRAIN = false;
    bf16_t* YP;
    __device__ __forceinline__ void operator()(const f32x4 (&acc)[2][2][4][2], const Unit& u, int wr, int wc, int fr, int fq) const {
        { const int l_ = tidx() & 63; fr = l_ & 15; fq = l_ >> 4; }
        const int row0 = u.pm * BM + wr * 64 + fr; const int col0 = (u.pn & 3) * BM + wc * 32 + 8 * fq;
#pragma unroll
        for (int ai = 0; ai < 2; ++ai)
#pragma unroll
            for (int m = 0; m < 4; ++m) { bf16_t* rowp = YP + (size_t)(row0 + ai * HALF + m * 16) * 1024 + col0;
#pragma unroll
                for (int bj = 0; bj < 2; ++bj) { const f32x4 v0 = acc[ai][bj][m][0], v1 = acc[ai][bj][m][1];
                    u32x4 w; w.x = pk2(v0[0], v0[1]); w.y = pk2(v0[2], v0[3]); w.z = pk2(v1[0], v1[1]); w.w = pk2(v1[2], v1[3]);
                    *(u32x4*)(rowp + bj * HALF) = w; } }
    }
};
struct NoMid { static constexpr bool ON = false; __device__ __forceinline__ void operator()(f32x4 (&)[2][2][4][2], int, int) const {} };
template <class Epi, class Sched, bool ALIGN_EPI = false, bool SP2 = false, class Mid = NoMid>
__device__ __forceinline__ void gemm_phase(PG8_LAS unsigned char* lds, const Gemm g, const Sched& S, const Epi& E, const Mid& MD = Mid()) {
    const int tid = tidx(), wid = __builtin_amdgcn_readfirstlane(tid >> 6), lane = tid & 63, wr = wid >> 2, wc = wid & 3, fr = lane & 15, fq = lane >> 4;
    const int K = g.K, nt = K / BK;
    unsigned voffA[2], voffB[2];
#pragma unroll
    for (int i = 0; i < 2; ++i) { int R, C; stage_rc(tid * 16 + i * 8192, R, C); const int Rb = Epi::PERM ? ((R & ~31) + perm32(R & 31)) : R;
        voffA[i] = (unsigned)(R * K + C) * 2u; voffB[i] = (unsigned)(Rb * K + C) * 2u; }
    const size_t kstep = (size_t)(BK * 2);
    const size_t hstep = (size_t)HALF * K * 2;
    const size_t tstep = 2 * hstep;
    const unsigned ldsw = (unsigned)wid * 1024u;
    const int aoff = lds_byte(wr * 64 + fr, fq * 8), boff = lds_byte(wc * 32 + fr, fq * 8);
#define PG8_SA(b, h) (((b) * 2 + (h)) * HTB)
#define PG8_SB(b, h) ((4 + (b) * 2 + (h)) * HTB)
#define PG8_STAGE(bufoff, gbase, voff) do { _Pragma("unroll") for (int _i = 0; _i < 2; ++_i) \
        __builtin_amdgcn_global_load_lds((const unsigned*)((const char*)(gbase) + (voff)[_i]), (PG8_LAS unsigned*)(lds + (bufoff) + ldsw + _i * 8192), 16, 0, 0); } while (0)
#define PG8_LDA(dst, b, h) do { _Pragma("unroll") for (int m = 0; m < 4; ++m) _Pragma("unroll") for (int k = 0; k < 2; ++k) dst[m][k] = *(const PG8_LAS bf16x8*)(lds + PG8_SA(b, h) + aoff + m * 2048 + k * 1024); } while (0)
#define PG8_LDB(dst, b, h) do { _Pragma("unroll") for (int n = 0; n < 2; ++n) _Pragma("unroll") for (int k = 0; k < 2; ++k) dst[n][k] = *(const PG8_LAS bf16x8*)(lds + PG8_SB(b, h) + boff + n * 2048 + k * 1024); } while (0)
#define PG8_MMA(ai, bj, At, Bt) do { __builtin_amdgcn_s_setprio(1); _Pragma("unroll") for (int m = 0; m < 4; ++m) _Pragma("unroll") for (int n = 0; n < 2; ++n) _Pragma("unroll") for (int k = 0; k < 2; ++k) \
        acc[ai][bj][m][n] = __builtin_amdgcn_mfma_f32_16x16x32_bf16(Bt[n][k], At[m][k], acc[ai][bj][m][n], 0, 0, 0); __builtin_amdgcn_s_setprio(0); } while (0)
#define PG8_WAIT_V(n) asm volatile("s_waitcnt vmcnt(" #n ")" ::: "memory")
#define PG8_WAIT_L(n) asm volatile("s_waitcnt lgkmcnt(" #n ")" ::: "memory")
#define PG8_BAR __builtin_amdgcn_s_barrier()
#define PG8_SCHED __builtin_amdgcn_sched_barrier(0)
    Unit cur, nxt; int ui = 0;
    if (!S.next(0, cur)) return;
    f32x4 acc[2][2][4][2];
#pragma unroll
    for (int a = 0; a < 2; ++a)
#pragma unroll
        for (int b = 0; b < 2; ++b)
#pragma unroll
            for (int m = 0; m < 4; ++m)
#pragma unroll
                for (int n = 0; n < 2; ++n) acc[a][b][m][n] = (f32x4){0.f, 0.f, 0.f, 0.f};
    bf16x8 At[4][2], B0[2][2], B1[2][2];
    const char* cA = (const char*)g.A + (size_t)cur.pm * tstep; const char* cB = (const char*)g.Bt + (size_t)cur.pn * tstep;
    S.a_ready(cur);
    if constexpr (SP2) {
        PG8_STAGE(PG8_SB(0, 0), cB, voffB); PG8_STAGE(PG8_SB(0, 1), cB + hstep, voffB); PG8_STAGE(PG8_SA(0, 0), cA, voffA); PG8_STAGE(PG8_SA(0, 1), cA + hstep, voffA);
        if (wr == 1) PG8_BAR;
        PG8_WAIT_V(2); PG8_BAR;
        PG8_STAGE(PG8_SB(1, 0), cB + kstep, voffB); PG8_STAGE(PG8_SA(1, 0), cA + kstep, voffA); PG8_STAGE(PG8_SB(1, 1), cB + hstep + kstep, voffB);
        PG8_WAIT_V(6); PG8_BAR;
    } else {
        PG8_STAGE(PG8_SB(0, 0), cB, voffB); PG8_STAGE(PG8_SA(0, 0), cA, voffA); PG8_STAGE(PG8_SB(0, 1), cB + hstep, voffB); PG8_STAGE(PG8_SA(0, 1), cA + hstep, voffA);
        if (wr == 1) PG8_BAR;
        PG8_WAIT_V(4); PG8_BAR;
        PG8_STAGE(PG8_SB(1, 0), cB + kstep, voffB); PG8_STAGE(PG8_SA(1, 0), cA + kstep, voffA); PG8_STAGE(PG8_SB(1, 1), cB + hstep + kstep, voffB);
        PG8_WAIT_V(6); PG8_BAR;
    }
    for (;;) {
        const bool has_next = S.next(ui + 1, nxt);
        const char* nA = has_next ? (const char*)g.A + (size_t)nxt.pm * tstep : cA; const char* nB = has_next ? (const char*)g.Bt + (size_t)nxt.pn * tstep : cB;
        for (int t = 0; t < nt; t += 2) {
            if constexpr (Mid::ON) { if (t == Mid::T) MD(acc, wr, tidx() & 15); }
            const bool last = (t == nt - 2);
            const char* a1 = cA + (size_t)(t + 1) * kstep;
            const char* a2 = last ? nA : cA + (size_t)(t + 2) * kstep; const char* b2 = last ? nB : cB + (size_t)(t + 2) * kstep;
            const char* a3 = a2 + kstep; const char* b3 = b2 + kstep;
            if (last && has_next) S.a_ready(nxt);
            if constexpr (SP2) {
            PG8_LDB(B0, 0, 0); PG8_LDB(B1, 0, 1); PG8_SCHED; PG8_LDA(At, 0, 0); PG8_STAGE(PG8_SA(1, 1), a1 + hstep, voffA);
            PG8_WAIT_V(8); PG8_WAIT_L(0); PG8_BAR; PG8_MMA(0, 0, At, B0); PG8_MMA(0, 1, At, B1); PG8_BAR; PG8_SCHED;
            PG8_LDA(At, 0, 1); PG8_STAGE(PG8_SB(0, 0), b2, voffB); PG8_STAGE(PG8_SB(0, 1), b2 + hstep, voffB); PG8_STAGE(PG8_SA(0, 0), a2, voffA);
            PG8_WAIT_V(8); PG8_WAIT_L(0); PG8_BAR; PG8_MMA(1, 0, At, B0); PG8_MMA(1, 1, At, B1); PG8_BAR; PG8_SCHED;
            PG8_LDB(B0, 1, 0); PG8_LDB(B1, 1, 1); PG8_SCHED; PG8_LDA(At, 1, 0); PG8_STAGE(PG8_SA(0, 1), a2 + hstep, voffA);
            PG8_WAIT_V(8); PG8_WAIT_L(0); PG8_BAR; PG8_MMA(0, 0, At, B0); PG8_MMA(0, 1, At, B1); PG8_BAR; PG8_SCHED;
            PG8_LDA(At, 1, 1); PG8_STAGE(PG8_SB(1, 0), b3, voffB); PG8_STAGE(PG8_SB(1, 1), b3 + hstep, voffB); PG8_STAGE(PG8_SA(1, 0), a3, voffA);
            PG8_WAIT_V(8); PG8_WAIT_L(0); PG8_BAR; PG8_MMA(1, 0, At, B0); PG8_MMA(1, 1, At, B1); PG8_BAR; PG8_SCHED;
            } else {
            PG8_LDB(B0, 0, 0); PG8_SCHED; PG8_LDA(At, 0, 0); PG8_STAGE(PG8_SA(1, 1), a1 + hstep, voffA);
            PG8_WAIT_L(8); PG8_BAR; PG8_WAIT_L(0); PG8_MMA(0, 0, At, B0); PG8_BAR; PG8_SCHED;
            PG8_LDB(B1, 0, 1); PG8_STAGE(PG8_SB(0, 0), b2, voffB);
            PG8_BAR; PG8_WAIT_L(0); PG8_MMA(0, 1, At, B1); PG8_BAR;
            PG8_LDA(At, 0, 1); PG8_STAGE(PG8_SA(0, 0), a2, voffA);
            PG8_BAR; PG8_WAIT_L(0); PG8_MMA(1, 0, At, B0); PG8_BAR; PG8_SCHED;
            PG8_STAGE(PG8_SB(0, 1), b2 + hstep, voffB);
            PG8_WAIT_V(6); PG8_BAR; PG8_MMA(1, 1, At, B1); PG8_BAR;
            PG8_LDB(B0, 1, 0); PG8_SCHED; PG8_LDA(At, 1, 0); PG8_STAGE(PG8_SA(0, 1), a2 + hstep, voffA);
            PG8_WAIT_L(8); PG8_BAR; PG8_WAIT_L(0); PG8_MMA(0, 0, At, B0); PG8_BAR; PG8_SCHED;
            PG8_LDB(B1, 1, 1); PG8_STAGE(PG8_SB(1, 0), b3, voffB);
            PG8_BAR; PG8_WAIT_L(0); PG8_MMA(0, 1, At, B1); PG8_BAR;
            PG8_LDA(At, 1, 1); PG8_STAGE(PG8_SA(1, 0), a3, voffA);
            PG8_BAR; PG8_WAIT_L(0); PG8_MMA(1, 0, At, B0); PG8_BAR; PG8_SCHED;
            PG8_STAGE(PG8_SB(1, 1), b3 + hstep, voffB);
            PG8_WAIT_V(6); PG8_BAR; PG8_MMA(1, 1, At, B1); PG8_BAR;
            }
        }
        if constexpr (ALIGN_EPI) { if (wr == 0) PG8_BAR; }
        if constexpr (!Epi::AFTER_DRAIN) { E(acc, cur, wr, wc, fr, fq); S.done(cur); }
        if (!has_next) break;
#pragma unroll
        for (int a = 0; a < 2; ++a)
#pragma unroll
            for (int b = 0; b < 2; ++b)
#pragma unroll
                for (int m = 0; m < 4; ++m)
#pragma unroll
                    for (int n = 0; n < 2; ++n) acc[a][b][m][n] = (f32x4){0.f, 0.f, 0.f, 0.f};
        cur = nxt; cA = nA; cB = nB; ++ui;
        if constexpr (ALIGN_EPI) { if (wr == 1) PG8_BAR; }
    }
    PG8_WAIT_V(0);
    if constexpr (!ALIGN_EPI) { if (wr == 0) PG8_BAR; }
    PG8_BAR;
    if constexpr (Epi::AFTER_DRAIN) { E.fused(acc, cur, wr, wc, fr, fq, lds, wid, lane); S.done(cur); }
#undef PG8_SA
#undef PG8_SB
#undef PG8_STAGE
#undef PG8_LDA
#undef PG8_LDB
#undef PG8_MMA
#undef PG8_WAIT_V
#undef PG8_WAIT_L
#undef PG8_BAR
#undef PG8_SCHED
}

struct MidRowScale { static constexpr bool ON = true; static constexpr int T = 8;
    const PG8_LAS float* RS;
    __device__ __forceinline__ void operator()(f32x4 (&acc)[2][2][4][2], int wr, int fr) const {
#pragma unroll
        for (int ai = 0; ai < 2; ++ai)
#pragma unroll
            for (int m = 0; m < 4; ++m) { const float f = RS[(ai * HALF + wr * 64 + m * 16 + fr) * 2];
#pragma unroll
                for (int bj = 0; bj < 2; ++bj)
#pragma unroll
                    for (int n = 0; n < 2; ++n) acc[ai][bj][m][n] = acc[ai][bj][m][n] * f; }
    }
};
struct EpiBf16RowScale {
    static constexpr bool PERM = true, AFTER_DRAIN = false;
    bf16_t* O; int ldc; const PG8_LAS float* RS;
    __device__ __forceinline__ void operator()(const f32x4 (&acc)[2][2][4][2], const Unit& u, int wr, int wc, int fr, int fq) const {
        { const int l_ = tidx() & 63; fr = l_ & 15; fq = l_ >> 4; }
        const int row0 = u.pm * BM + wr * 64 + fr; const int col0 = u.pn * BM + wc * 32 + 8 * fq;
#pragma unroll
        for (int ai = 0; ai < 2; ++ai)
#pragma unroll
            for (int m = 0; m < 4; ++m) { bf16_t* rowp = O + (size_t)(row0 + ai * HALF + m * 16) * ldc + col0; const float f = RS[(ai * HALF + wr * 64 + m * 16 + fr) * 2 + 1];
#pragma unroll
                for (int bj = 0; bj < 2; ++bj) { const f32x4 v0 = acc[ai][bj][m][0] * f, v1 = acc[ai][bj][m][1] * f;
                    u32x4 w; w.x = pk2(v0[0], v0[1]); w.y = pk2(v0[2], v0[3]); w.z = pk2(v1[0], v1[1]); w.w = pk2(v1[2], v1[3]);
                    *(u32x4*)(rowp + bj * HALF) = w; } }
    }
};
}


template <class GainFn>
__device__ __forceinline__ void transpose_tile(const float* src, int ldsrc, int srccol0  , GainFn gain, bf16* dst, int K, int k0, int n0, int lane) {
    const int r = lane >> 4, c = lane & 15;
    f32x4v v[16];
    if (srccol0 >= 0) {
#pragma unroll
        for (int i = 0; i < 16; ++i) v[i] = *(const f32x4v*)(src + (size_t)(k0 + 4 * i + r) * ldsrc + srccol0 + 4 * c);
    } else {
#pragma unroll
        for (int i = 0; i < 16; ++i) v[i] = (f32x4v){0.f, 0.f, 0.f, 0.f};
    }
    unsigned pk[16][2];
#pragma unroll
    for (int i = 0; i < 16; ++i) {
        unsigned a0 = __float_as_uint(v[i].x), a1 = __float_as_uint(v[i].y), a2 = __float_as_uint(v[i].z), a3 = __float_as_uint(v[i].w);
        { auto t = __builtin_amdgcn_permlane32_swap(a0, a2, false, false); a0 = t[0]; a2 = t[1]; }
        { auto t = __builtin_amdgcn_permlane32_swap(a1, a3, false, false); a1 = t[0]; a3 = t[1]; }
        { auto t = __builtin_amdgcn_permlane16_swap(a0, a1, false, false); a0 = t[0]; a1 = t[1]; }
        { auto t = __builtin_amdgcn_permlane16_swap(a2, a3, false, false); a2 = t[0]; a3 = t[1]; }
        const f32x4v g = gain(k0 + 4 * i);
        pk[i][0] = pk2(__uint_as_float(a0) * g.x, __uint_as_float(a1) * g.y); pk[i][1] = pk2(__uint_as_float(a2) * g.z, __uint_as_float(a3) * g.w);
    }
    bf16* drow = dst + (size_t)(n0 + 4 * c + r) * K + k0;
#pragma unroll
    for (int i = 0; i < 8; ++i) *(v4u*)(drow + 8 * i) = (v4u){pk[2 * i][0], pk[2 * i][1], pk[2 * i + 1][0], pk[2 * i + 1][1]};
}
__device__ __forceinline__ int win_col(int n) {
    if (n < 1536) return n;
    if (n < 1792) return n - 1536 + 1544;
    if (n < 1920) return n - 1792 + 1800;
    if (n < 1952) return n - 1920 + 1928;
    if (n < 1960) return n - 1952 + 1536;
    return -1;
}
template <class GainFn>
__device__ __forceinline__ void transpose_tile_win(const float* src, GainFn gain, bf16* dst, int k0, int n0, int lane) {
    const int r = lane >> 4, c = lane & 15; const int sc = win_col(n0 + 4 * c);
    f32x4v v[16];
#pragma unroll
    for (int i = 0; i < 16; ++i) v[i] = (sc >= 0) ? *(const f32x4v*)(src + (size_t)(k0 + 4 * i + r) * NIN + sc) : (f32x4v){0.f, 0.f, 0.f, 0.f};
    unsigned pk[16][2];
#pragma unroll
    for (int i = 0; i < 16; ++i) {
        unsigned a0 = __float_as_uint(v[i].x), a1 = __float_as_uint(v[i].y), a2 = __float_as_uint(v[i].z), a3 = __float_as_uint(v[i].w);
        { auto t = __builtin_amdgcn_permlane32_swap(a0, a2, false, false); a0 = t[0]; a2 = t[1]; }
        { auto t = __builtin_amdgcn_permlane32_swap(a1, a3, false, false); a1 = t[0]; a3 = t[1]; }
        { auto t = __builtin_amdgcn_permlane16_swap(a0, a1, false, false); a0 = t[0]; a1 = t[1]; }
        { auto t = __builtin_amdgcn_permlane16_swap(a2, a3, false, false); a2 = t[0]; a3 = t[1]; }
        pk[i][0] = pk2(__uint_as_float(a0), __uint_as_float(a1)); pk[i][1] = pk2(__uint_as_float(a2), __uint_as_float(a3));
    }
    bf16* drow = dst + (size_t)(n0 + 4 * c + r) * D + k0;
#pragma unroll
    for (int i = 0; i < 8; ++i) *(v4u*)(drow + 8 * i) = (v4u){pk[2 * i][0], pk[2 * i][1], pk[2 * i + 1][0], pk[2 * i + 1][1]};
}
__device__ void ph_prep(float* lds, float* mod, bf16* WIN_T, bf16* WOUT_T, bf16* WUQ_T, bf16* WUKV_T, float* WRT, bf16* WGU_T, bf16* WD_T) {
    const int tid = tidx(), lane = tid & 63, wave = tid >> 6;
    for (int item = blockIdx.x; item < 6 * D / 32; item += gridDim.x) {
        float* sc = lds;
        float* part = lds + 8 * D;
        const float* c = IN(1); const float* ada_w = IN(3); const float* ada_b = IN(4);
        __syncthreads();
        for (int i = tid; i < NB * D; i += NT) sc[i] = silu_f(c[i]);
        __syncthreads();
        const int kr = lane >> 3, cq = lane & 7; const int j0 = item * 32 + 4 * cq;
        f32x4v acc[NB];
#pragma unroll
        for (int b = 0; b < NB; ++b) acc[b] = (f32x4v){0.f, 0.f, 0.f, 0.f};
#pragma unroll 4
        for (int i = 0; i < 16; ++i) { const int k = wave * 128 + 8 * i + kr;
            const f32x4v w = *(const f32x4v*)(ada_w + (size_t)k * 6 * D + j0);
#pragma unroll
            for (int b = 0; b < NB; ++b) acc[b] += w * sc[b * D + k]; }
#pragma unroll
        for (int b = 0; b < NB; ++b) {
#pragma unroll
            for (int e = 0; e < 4; ++e) { float v = acc[b][e]; v += __shfl_xor(v, 8); v += __shfl_xor(v, 16); v += __shfl_xor(v, 32); acc[b][e] = v; } }
        if (lane < 8) {
#pragma unroll
            for (int b = 0; b < NB; ++b) *(f32x4v*)(part + (wave * NB + b) * 32 + 4 * lane) = acc[b]; }
        __syncthreads();
        if (tid < NB * 32) { const int b = tid >> 5, jj = tid & 31;
            float sm = ada_b[item * 32 + jj];
#pragma unroll
            for (int w = 0; w < 8; ++w) sm += part[(w * NB + b) * 32 + jj];
            mod[b * 6 * D + item * 32 + jj] = sm; }
    }
    __syncthreads();
    for (int i = blockIdx.x * NT + tid; i < 36 * D; i += gridDim.x * NT) { const int c = i >> 10, k = i & 1023;
        WRT[i] = (c < 4) ? IN(22)[k * 4 + c] : IN(24)[k * 32 + c - 4]; }
    const int gw = (gridDim.x - 1 - blockIdx.x) * (NT / 64) + wave, ngw = gridDim.x * (NT / 64);
    constexpr int I_IN = (D / 64) * (NU / 64), I_OUT = (D / 64) * (D / 64), I_UQ = (QR / 64) * (768 / 64), I_UKV = (256 / 64) * (1024 / 64);
    const float* ssd_norm = IN(15); const float* q_norm = IN(16); const float* kv_norm = IN(18); const float* mla_norm = IN(20);
    const auto one4 = [](int) { return (f32x4v){1.f, 1.f, 1.f, 1.f}; };
    constexpr int I_GU = NEXP * (D / 64) * (512 / 64);
    const int moe_lo = (gridDim.x >= 128) ? MOE_SPLIT : 0, n_moe = MOE_ITEMS - moe_lo;
    for (int it = gw; it < n_moe + I_IN + I_OUT + I_UQ + I_UKV; it += ngw) {
        int r = it;
        if (r < n_moe) { r += moe_lo;
            if (r < I_GU) { const int e = r >> 7, q = r & 127, kb = q >> 3, nb = q & 7;
                const int ct = nb >> 2, rr = (nb & 3) * 64; const float* src = (rr < 128 ? IN(26) : IN(27)) + (size_t)e * D * FF;
                transpose_tile(src, FF, 128 * ct + (rr & 127), one4, WGU_T + (size_t)e * 512 * D, D, kb * 64, nb * 64, lane); continue; }
            r -= I_GU;
            { const int e = r >> 6, q = r & 63, kb = q >> 4, nb = q & 15;
              transpose_tile(IN(28) + (size_t)e * FF * D, D, nb * 64, one4, WD_T + (size_t)e * D * FF, FF, kb * 64, nb * 64, lane); continue; } }
        r -= n_moe;
        if (r < I_IN) { const int nb = NU / 64; transpose_tile_win(IN(9), one4, WIN_T, (r / nb) * 64, (r % nb) * 64, lane); continue; }
        r -= I_IN;
        if (r < I_OUT) { const int nb = D / 64; transpose_tile(IN(21), D, (r % nb) * 64, [=](int k) { return k < 512 ? *(const f32x4v*)(ssd_norm + k) : *(const f32x4v*)(mla_norm + k - 512); }, WOUT_T, D, (r / nb) * 64, (r % nb) * 64, lane); continue; }
        r -= I_OUT;
        if (r < I_UQ) { const int nb = 768 / 64; transpose_tile(IN(17), 768, (r % nb) * 64, [=](int k) { return *(const f32x4v*)(q_norm + k) * 0.14724444f; }, WUQ_T, QR, (r / nb) * 64, (r % nb) * 64, lane); continue; }
        r -= I_UQ;
        { const int nb = 1024 / 64, kb = r / nb; transpose_tile(IN(19), 1024, kb < 2 ? (r % nb) * 64 : -1, [=](int k) { return k < KVR ? *(const f32x4v*)(kv_norm + k) : (f32x4v){0.f, 0.f, 0.f, 0.f}; }, WUKV_T, 256, kb * 64, (r % nb) * 64, lane); }
    }
}
__device__ void ph_prep_moe(bf16* WGU_T, bf16* WD_T, int rank, int nw, int it_lo, int it_hi) {
    const int lane = tidx() & 63; rank = __builtin_amdgcn_readfirstlane(rank);
    constexpr int I_GU = NEXP * (D / 64) * (512 / 64), I_DN = NEXP * (FF / 64) * (D / 64);
    const auto one4 = [](int) { return (f32x4v){1.f, 1.f, 1.f, 1.f}; };
    for (int it = it_lo + rank; it < it_hi; it += nw) {
        int r = it;
        if (r < I_GU) { const int e = r >> 7, q = r & 127, kb = q >> 3, nb = q & 7;
            const int ct = nb >> 2, rr = (nb & 3) * 64; const float* src = (rr < 128 ? IN(26) : IN(27)) + (size_t)e * D * FF;
            transpose_tile(src, FF, 128 * ct + (rr & 127), one4, WGU_T + (size_t)e * 512 * D, D, kb * 64, nb * 64, lane); continue; }
        r -= I_GU;
        { const int e = r >> 6, q = r & 63, kb = q >> 4, nb = q & 15;
          transpose_tile(IN(28) + (size_t)e * FF * D, D, nb * 64, one4, WD_T + (size_t)e * D * FF, FF, kb * 64, nb * 64, lane); }
    }
}

__device__ void ph_prenorm_bf16(const float* in, const float* g, const float* mod, int sh_off, int sc_off, bf16* out) {
    const int lane = tidx() & 63, gw = blockIdx.x * (NT / 64) + (tidx() >> 6), ngw = gridDim.x * (NT / 64);
    f32x4v nx[4];
    if (gw < M) { const f32x4v* r = (const f32x4v*)(in + (size_t)gw * D) + lane;
#pragma unroll
        for (int j = 0; j < 4; ++j) nx[j] = r[64 * j]; }
    for (int t = gw; t < M; t += ngw) {
        const int b = t / SEQ;
        f32x4v v[4]; float s = 0.f;
#pragma unroll
        for (int j = 0; j < 4; ++j) { v[j] = nx[j]; s += (v[j].x * v[j].x + v[j].y * v[j].y) + (v[j].z * v[j].z + v[j].w * v[j].w); }
        if (t + ngw < M) { const f32x4v* r = (const f32x4v*)(in + (size_t)(t + ngw) * D) + lane;
#pragma unroll
            for (int j = 0; j < 4; ++j) nx[j] = r[64 * j]; }
        const f32x4v* gp = (const f32x4v*)g + lane; const f32x4v* scp = (const f32x4v*)(mod + b * 6 * D + sc_off) + lane; const f32x4v* shp = (const f32x4v*)(mod + b * 6 * D + sh_off) + lane;
        f32x4v gg[4], sc[4], sh[4];
#pragma unroll
        for (int j = 0; j < 4; ++j) { gg[j] = gp[64 * j]; sc[j] = scp[64 * j]; sh[j] = shp[64 * j]; }
        const float inv = rsqrtf(wave_sum_valu(s) / D + EPS);
        unsigned long long* o8 = (unsigned long long*)(out + (size_t)t * D) + lane;
#pragma unroll
        for (int j = 0; j < 4; ++j) { const f32x4v h = v[j] * inv * gg[j] * (sc[j] + 1.f) + sh[j];
            o8[64 * j] = (unsigned long long)pk2(h.x, h.y) | ((unsigned long long)pk2(h.z, h.w) << 32); }
    }
}


__device__ void ph_prep2(const bf16* U, const int* pos, const float* conv_w, const float* conv_b, const float* dt_bias,
                         bf16* CQN, bf16* CKVN, bf16* KF, float* COS, float* SIN, float* DT, bf16* XC) {
    const int lane = tidx() & 63, gw = blockIdx.x * (NT / 64) + (tidx() >> 6), ngw = gridDim.x * (NT / 64);
    const int rows_per = (M + ngw - 1) / ngw;
    const int ch = lane * 16;
    f32x4v cw[4][4], cbv[4];
#pragma unroll
    for (int k = 0; k < 4; ++k)
#pragma unroll
        for (int q4 = 0; q4 < 4; ++q4) cw[k][q4] = *(const f32x4v*)(conv_w + k * SSD_XBC + ch + 4 * q4);
#pragma unroll
    for (int q4 = 0; q4 < 4; ++q4) cbv[q4] = *(const f32x4v*)(conv_b + ch + 4 * q4);
    const float inv_freq = exp2f(-(float)(lane & 15) * (13.287712379549449f / 16.0f));
    const float dtb = dt_bias[lane & 7];
    const int t_lo = gw * rows_per, t_hi = min((gw + 1) * rows_per, M);
    if (t_lo >= t_hi) return;
    v4u h0[2], h1[2], h2[2];
#define LDX(dst, tt_) do { if (((tt_) & (SEQ - 1)) <= (t_lo & (SEQ - 1)) && (tt_) >= 0 && ((tt_) >> 11) == (t_lo >> 11)) { const v4u* xp_ = (const v4u*)(U + (size_t)(tt_) * NU + OFF_XBC + ch); dst[0] = xp_[0]; dst[1] = xp_[1]; } \
                           else { dst[0] = (v4u){0u, 0u, 0u, 0u}; dst[1] = dst[0]; } } while (0)
    LDX(h0, t_lo - 3); LDX(h1, t_lo - 2); LDX(h2, t_lo - 1);
#undef LDX
    uint2 n_cq; unsigned n_ckv; unsigned short n_k1, n_k2, n_dt; v4u n_x[2]; int n_pos;
#define LDROW(tt_) do { const bf16* ur_ = U + (size_t)(tt_) * NU; n_cq = *(const uint2*)(ur_ + OFF_CQ + lane * 4); n_ckv = *(const unsigned*)(ur_ + OFF_CKV + lane * 2); \
        n_k1 = ur_[OFF_KR + (lane & 15)]; n_k2 = ur_[OFF_KR + 16 + (lane & 15)]; n_dt = ur_[OFF_DT + (lane & 7)]; const v4u* xp_ = (const v4u*)(ur_ + OFF_XBC + ch); n_x[0] = xp_[0]; n_x[1] = xp_[1]; n_pos = pos[tt_]; } while (0)
    LDROW(t_lo);
    for (int t = t_lo; t < t_hi; ++t) {
        const int sq = t & (SEQ - 1), b = t >> 11;
        const uint2 w_cq = n_cq; const unsigned w_ckv = n_ckv; const float x1 = bf2f(n_k1), x2 = bf2f(n_k2), dtr = bf2f(n_dt); const v4u cx0 = n_x[0], cx1 = n_x[1]; const int p_t = n_pos;
        if (t + 1 < t_hi) LDROW(t + 1);
        if (sq == 0) { h0[0] = (v4u){0u, 0u, 0u, 0u}; h0[1] = h0[0]; h1[0] = h0[0]; h1[1] = h0[0]; h2[0] = h0[0]; h2[1] = h0[0]; }
        { const float a0 = __uint_as_float(w_cq.x << 16), a1 = __uint_as_float(w_cq.x & 0xffff0000u), a2 = __uint_as_float(w_cq.y << 16), a3 = __uint_as_float(w_cq.y & 0xffff0000u);
          const float inv = rsqrtf(wave_sum_valu(a0 * a0 + a1 * a1 + a2 * a2 + a3 * a3) * (1.f / QR) + EPS);
          uint2 o; o.x = pk2(a0 * inv, a1 * inv); o.y = pk2(a2 * inv, a3 * inv);
          *(uint2*)(CQN + (size_t)t * QR + lane * 4) = o; }
        { const float a0 = __uint_as_float(w_ckv << 16), a1 = __uint_as_float(w_ckv & 0xffff0000u);
          const float inv = rsqrtf(wave_sum_valu(a0 * a0 + a1 * a1) * (1.f / KVR) + EPS);
          *(unsigned*)(CKVN + (size_t)t * 256 + lane * 2) = pk2(a0 * inv, a1 * inv);
          *(unsigned*)(CKVN + (size_t)t * 256 + 128 + lane * 2) = 0u; }
        { const int i = lane & 15;
          const float ang = (float)p_t * inv_freq;
          const float sn = __sinf(ang), cs = __cosf(ang);
          if (lane < 16) { COS[(size_t)t * 16 + i] = cs; SIN[(size_t)t * 16 + i] = sn; }
          const float r1 = x1 * cs - x2 * sn, r2 = x2 * cs + x1 * sn;
          const int cc = lane & 3, hh = (lane >> 2) & 7;
          float e[8];
#pragma unroll
          for (int j = 0; j < 8; ++j) { const float p1 = __shfl(r1, (cc & 1) * 8 + j), p2 = __shfl(r2, (cc & 1) * 8 + j); e[j] = (cc >> 1) ? p2 : p1; }
          if (lane < 32) { v4u o; o.x = pk2(e[0], e[1]); o.y = pk2(e[2], e[3]); o.z = pk2(e[4], e[5]); o.w = pk2(e[6], e[7]);
            *(v4u*)(KF + (size_t)((b * 8 + hh) * 32 + (sq >> 6)) * 6144 + (8 + cc) * 512 + (sq & 63) * 8) = o; } }
        if (lane < 8) { const float raw = dtr + dtb; DT[(size_t)t * 8 + lane] = raw > 20.f ? raw : log1pf(__expf(raw)); }
        { float acc[16];
#pragma unroll
          for (int q4 = 0; q4 < 4; ++q4) { acc[4 * q4] = cbv[q4].x; acc[4 * q4 + 1] = cbv[q4].y; acc[4 * q4 + 2] = cbv[q4].z; acc[4 * q4 + 3] = cbv[q4].w; }
#define TAP(k_, r_) do { const unsigned xw_[8] = {r_[0].x, r_[0].y, r_[0].z, r_[0].w, r_[1].x, r_[1].y, r_[1].z, r_[1].w}; \
              _Pragma("unroll") for (int q4 = 0; q4 < 4; ++q4) { const f32x4v ww_ = cw[k_][q4]; \
                  acc[4 * q4] += ww_.x * __uint_as_float(xw_[2 * q4] << 16); acc[4 * q4 + 1] += ww_.y * __uint_as_float(xw_[2 * q4] & 0xffff0000u); \
                  acc[4 * q4 + 2] += ww_.z * __uint_as_float(xw_[2 * q4 + 1] << 16); acc[4 * q4 + 3] += ww_.w * __uint_as_float(xw_[2 * q4 + 1] & 0xffff0000u); } } while (0)
          const v4u cur[2] = {cx0, cx1};
          TAP(0, h0); TAP(1, h1); TAP(2, h2); TAP(3, cur);
#undef TAP
          h0[0] = h1[0]; h0[1] = h1[1]; h1[0] = h2[0]; h1[1] = h2[1]; h2[0] = cx0; h2[1] = cx1;
#define SILU(v_) ((v_) * __builtin_amdgcn_rcpf(1.f + __expf(-(v_))))
          v4u o0, o1;
          o0.x = pk2(SILU(acc[0]), SILU(acc[1])); o0.y = pk2(SILU(acc[2]), SILU(acc[3])); o0.z = pk2(SILU(acc[4]), SILU(acc[5])); o0.w = pk2(SILU(acc[6]), SILU(acc[7]));
          o1.x = pk2(SILU(acc[8]), SILU(acc[9])); o1.y = pk2(SILU(acc[10]), SILU(acc[11])); o1.z = pk2(SILU(acc[12]), SILU(acc[13])); o1.w = pk2(SILU(acc[14]), SILU(acc[15]));
#undef SILU
          { bf16* base = XC + (size_t)(t >> 7) * 131072; const int l = t & 127;
            if (ch < 512) { v4u* op = (v4u*)(base + (ch >> 6) * 8192 + ((ch & 63) >> 5) * 4096 + l * 32 + (ch & 31)); op[0] = o0; op[1] = o1; }
            else { const int c2 = ch - 512; bf16* q = base + 65536 + (c2 >> 7) * 16384 + ((c2 & 127) >> 3) * 1024 + l * 8; *(v4u*)q = o0; *(v4u*)(q + 1024) = o1; } } }
    }
#undef LDROW
}


__device__ void ph_rowrouter(RLAS float* ldsf, const bf16* Yb, const float* x, const float* post_gain, const float* pre_gain, const float* mod, const float* WRT,
                             const float* bgr, const float* ber, float* out, bf16* H2, int* CNT, int* RT_E, int* RT_S, int* ETOK, float* EW) {
    const int tid = tidx(), lane = tid & 63, wave = tid >> 6;
    const int gw = blockIdx.x * (NT / 64) + wave, ngw = gridDim.x * (NT / 64);
    { const f32x4v* src = (const f32x4v*)WRT; RLAS f32x4v* dst = (RLAS f32x4v*)ldsf;
      for (int i = tid; i < 36 * 1024 / 4; i += NT) dst[i] = src[i]; }
    RLAS float* Lg = ldsf + 36 * 1024 + wave * 320;
    __syncthreads();
    const int b0 = lane & 1, b1 = (lane >> 1) & 1, b2 = (lane >> 2) & 1, b3 = (lane >> 3) & 1, b4 = (lane >> 4) & 1, b5 = lane >> 5;
    const int i4 = b0 + 2 * b1, i3 = i4 + 3 * b2, i2 = i3 + 5 * b3;
    const bool colok = (i4 <= 2) && (i3 <= 4) && (i2 <= 8); const int mycol = i2 + 9 * b4 + 18 * b5;
    const int rows_per = (M + ngw - 1) / ngw;
    for (int bi = 0; bi < (rows_per + 7) / 8; ++bi) {
        const int tb = gw * rows_per + 8 * bi; const int nr = max(0, min(8, min((gw + 1) * rows_per, M) - tb));
        uint2 ynx[4]; f32x4v xnx[4];
        if (nr > 0) { const uint2* yp0 = (const uint2*)(Yb + (size_t)tb * D) + lane; const f32x4v* xp0 = (const f32x4v*)(x + (size_t)tb * D) + lane;
#pragma unroll
            for (int j = 0; j < 4; ++j) { ynx[j] = yp0[64 * j]; xnx[j] = xp0[64 * j]; } }
        for (int ri = 0; ri < nr; ++ri) {
            const int t = tb + ri, b = t >> 11;
            f32x4v* op = (f32x4v*)(out + (size_t)t * D) + lane;
            f32x4v y[4], xv[4]; float ssy = 0.f;
#pragma unroll
            for (int j = 0; j < 4; ++j) { const uint2 w = ynx[j]; xv[j] = xnx[j];
                y[j].x = __uint_as_float(w.x << 16); y[j].y = __uint_as_float(w.x & 0xffff0000u); y[j].z = __uint_as_float(w.y << 16); y[j].w = __uint_as_float(w.y & 0xffff0000u);
                ssy += (y[j].x * y[j].x + y[j].y * y[j].y) + (y[j].z * y[j].z + y[j].w * y[j].w); }
            if (ri + 1 < nr) { const uint2* yp1 = (const uint2*)(Yb + (size_t)(t + 1) * D) + lane; const f32x4v* xp1 = (const f32x4v*)(x + (size_t)(t + 1) * D) + lane;
#pragma unroll
                for (int j = 0; j < 4; ++j) { ynx[j] = yp1[64 * j]; xnx[j] = xp1[64 * j]; } }
            const float invy = rsqrtf(wave_sum_valu(ssy) * (1.f / D) + EPS);
            const f32x4v* g1p = (const f32x4v*)(mod + b * 6 * D + 2 * D) + lane; const f32x4v* pgp = (const f32x4v*)post_gain + lane;
            float ss1 = 0.f;
#pragma unroll
            for (int j = 0; j < 4; ++j) { xv[j] = xv[j] + g1p[64 * j] * (y[j] * invy * pgp[64 * j]); op[64 * j] = xv[j];
                ss1 += (xv[j].x * xv[j].x + xv[j].y * xv[j].y) + (xv[j].z * xv[j].z + xv[j].w * xv[j].w); }
            const float inv1 = rsqrtf(wave_sum_valu(ss1) * (1.f / D) + EPS);
            const f32x4v* prp = (const f32x4v*)pre_gain + lane; const f32x4v* scp = (const f32x4v*)(mod + b * 6 * D + 4 * D) + lane; const f32x4v* shp = (const f32x4v*)(mod + b * 6 * D + 3 * D) + lane;
            uint2* hp = (uint2*)(H2 + (size_t)t * D) + lane;
#pragma unroll
            for (int j = 0; j < 4; ++j) { xv[j] = xv[j] * inv1 * prp[64 * j] * (scp[64 * j] + 1.f) + shp[64 * j];
                uint2 o; o.x = pk2(xv[j].x, xv[j].y); o.y = pk2(xv[j].z, xv[j].w); hp[64 * j] = o; }
            const RLAS f32x4v* wl = (const RLAS f32x4v*)ldsf + lane;
#define RDOT(c_) ({ const RLAS f32x4v* wc_ = wl + (c_) * 256; float a_ = 0.f; _Pragma("unroll") for (int j = 0; j < 4; ++j) { const f32x4v w_ = wc_[64 * j]; \
                a_ += (xv[j].x * w_.x + xv[j].y * w_.y) + (xv[j].z * w_.z + xv[j].w * w_.w); } a_; })
            float gl[4];
#pragma unroll
            for (int i = 0; i < 4; ++i) gl[i] = wave_sum_valu(RDOT(i)) + bgr[i];
            int gi = 0; float mxv = gl[0];
#pragma unroll
            for (int i = 1; i < 4; ++i) if (gl[i] > mxv) { mxv = gl[i]; gi = i; }
            gi = __builtin_amdgcn_readfirstlane(gi);
            float den = 0.f;
#pragma unroll
            for (int i = 0; i < 4; ++i) den += expf(gl[i] - mxv);
            float v1 = -INFINITY, v2 = -INFINITY; int i1 = 0, i2 = 0;
#pragma unroll
            for (int i = 0; i < 8; ++i) { const float v = wave_sum_valu(RDOT(4 + gi * 8 + i)) + ber[gi * 8 + i];
                if (v > v1) { v2 = v1; i2 = i1; v1 = v; i1 = i; } else if (v > v2) { v2 = v; i2 = i; } }
#undef RDOT
            const float p2 = expf(v2 - v1), gwt = 1.f / den;
            if (lane == 0) { Lg[ri * 40 + 0] = __int_as_float(gi * 8 + i1); Lg[ri * 40 + 1] = __int_as_float(gi * 8 + i2); Lg[ri * 40 + 2] = gwt / (1.f + p2); Lg[ri * 40 + 3] = gwt * p2 / (1.f + p2); }
        }
        asm volatile("s_waitcnt lgkmcnt(0)" ::: "memory");
        RLAS int* agg = (RLAS int*)(ldsf + 36 * 1024 + 8 * 320);
        if (tid < 32) agg[tid] = 0;
        __syncthreads();
        int e1 = 0, e2 = 0, r1 = 0, r2 = 0; float w1 = 0.f, w2 = 0.f;
        if (lane < nr) {
            const RLAS float* lr = Lg + lane * 40;
            e1 = __float_as_int(lr[0]); e2 = __float_as_int(lr[1]); w1 = lr[2]; w2 = lr[3];
            r1 = __hip_atomic_fetch_add(agg + e1, 1, __ATOMIC_RELAXED, __HIP_MEMORY_SCOPE_WORKGROUP);
            r2 = __hip_atomic_fetch_add(agg + e2, 1, __ATOMIC_RELAXED, __HIP_MEMORY_SCOPE_WORKGROUP);
        }
        __syncthreads();
        if (tid < 32) { const int c = agg[tid]; agg[32 + tid] = c ? atomicAdd(&CNT[tid * 64], c) : 0; }
        __syncthreads();
        if (lane < nr) { const int t = tb + lane;
            const int s1 = agg[32 + e1] + r1, s2 = agg[32 + e2] + r2;
            RT_E[t] = e1 | (e2 << 8); RT_S[2 * t] = s1; RT_S[2 * t + 1] = s2;
            ETOK[e1 * M + s1] = t; EW[e1 * M + s1] = w1; ETOK[e2 * M + s2] = t; EW[e2 * M + s2] = w2; }
        __syncthreads();
    }
    __syncthreads();
}
__device__ __forceinline__ void moe_table(int* tp, const int* CNT) {
    const int tid = tidx();
    __syncthreads();
    if (tid < 64) { const int c = (tid < 32) ? __hip_atomic_load(CNT + tid * 64, __ATOMIC_RELAXED, __HIP_MEMORY_SCOPE_AGENT) : 0; int v = (c + 255) >> 8;
        int inc = v;
#pragma unroll
        for (int o = 1; o < 64; o <<= 1) { const int n = __shfl_up(inc, o); if ((tid & 63) >= o) inc += n; }
        if (tid <= 32) tp[tid] = inc - v; }
    __syncthreads();
}
__device__ void ph_gather_tiles(const int* tp, const int* CNT, const bf16* H2, const int* ETOK, const float* EW, bf16* HG, float* ROWW) {
    const int lane = tidx() & 63, wave = tidx() >> 6;
    const int ntile = tp[32];
    for (int rtg = blockIdx.x; rtg < ntile; rtg += gridDim.x) {
        int e = 0;
        for (int j = 1; j < 32; ++j) e += (tp[j] <= rtg) ? 1 : 0;
        const int slot0 = (rtg - tp[e]) * 256, cnt = __hip_atomic_load(CNT + e * 64, __ATOMIC_RELAXED, __HIP_MEMORY_SCOPE_AGENT);
        const int myslot = slot0 + wave * 32 + (lane & 31); const bool ok = myslot < cnt;
        const int mytok = ok ? ETOK[e * M + myslot] : 0; const float myw = ok ? EW[e * M + myslot] : 0.f;
        if (lane < 32) ROWW[rtg * 256 + wave * 32 + lane] = myw;
        for (int i0 = 0; i0 < 32; i0 += 16) { v4u a[16], c[16];
#pragma unroll
            for (int i = 0; i < 16; ++i) { const int tok = __shfl(mytok, i0 + i); const v4u* src = (const v4u*)(H2 + (size_t)tok * D) + lane; a[i] = src[0]; c[i] = src[64]; }
#pragma unroll
            for (int i = 0; i < 16; ++i) { v4u* dst = (v4u*)(HG + (size_t)(rtg * 256 + wave * 32 + i0 + i) * D) + lane; dst[0] = a[i]; dst[64] = c[i]; } }
    }
    asm volatile("s_waitcnt vmcnt(0)" ::: "memory");
    __syncthreads();
}
__device__ void ph_moe_final(const bf16* YP, const int* tp, const int* RT_E, const int* RT_S, const float* gain, const float* mod, float* out) {
    const int lane = tidx() & 63, gw = blockIdx.x * (NT / 64) + (tidx() >> 6), ngw = gridDim.x * (NT / 64);
    v4u na[2], nc[2]; f32x4v nxa[2], nxb[2];
#define MF_LOAD(tt_) do { const int ee_ = RT_E[tt_]; const int r1_ = tp[ee_ & 255] * 256 + RT_S[2 * (tt_)], r2_ = tp[(ee_ >> 8) & 255] * 256 + RT_S[2 * (tt_) + 1]; \
        const v4u* p1_ = (const v4u*)(YP + (size_t)r1_ * D) + lane; const v4u* p2_ = (const v4u*)(YP + (size_t)r2_ * D) + lane; \
        _Pragma("unroll") for (int j = 0; j < 2; ++j) { na[j] = p1_[64 * j]; nc[j] = p2_[64 * j]; const float* op_ = out + (size_t)(tt_) * D + 512 * j + lane * 8; nxa[j] = *(const f32x4v*)op_; nxb[j] = *(const f32x4v*)(op_ + 4); } } while (0)
    if (gw < M) MF_LOAD(gw);
    for (int t = gw; t < M; t += ngw) { const int b = t >> 11;
        float y[16]; float ss = 0.f; f32x4v xa[2], xb[2];
#pragma unroll
        for (int j = 0; j < 2; ++j) { const v4u a = na[j], c = nc[j]; xa[j] = nxa[j]; xb[j] = nxb[j];
#pragma unroll
            for (int e = 0; e < 4; ++e) { const float v0 = __uint_as_float(a[e] << 16) + __uint_as_float(c[e] << 16), v1 = __uint_as_float(a[e] & 0xffff0000u) + __uint_as_float(c[e] & 0xffff0000u);
                y[8 * j + 2 * e] = v0; y[8 * j + 2 * e + 1] = v1; ss += v0 * v0 + v1 * v1; } }
        if (t + ngw < M) MF_LOAD(t + ngw);
        const float inv = rsqrtf(wave_sum_valu(ss) * (1.f / D) + EPS);
#pragma unroll
        for (int j = 0; j < 2; ++j) { const int col = 512 * j + lane * 8; float* op = out + (size_t)t * D + col;
            const f32x4v g2a = *(const f32x4v*)(mod + b * 6 * D + 5 * D + col), g2b = *(const f32x4v*)(mod + b * 6 * D + 5 * D + col + 4);
            const f32x4v ga = *(const f32x4v*)(gain + col), gb = *(const f32x4v*)(gain + col + 4);
            f32x4v a_ = xa[j], b_ = xb[j];
            a_.x += g2a.x * (y[8 * j + 0] * inv * ga.x); a_.y += g2a.y * (y[8 * j + 1] * inv * ga.y); a_.z += g2a.z * (y[8 * j + 2] * inv * ga.z); a_.w += g2a.w * (y[8 * j + 3] * inv * ga.w);
            b_.x += g2b.x * (y[8 * j + 4] * inv * gb.x); b_.y += g2b.y * (y[8 * j + 5] * inv * gb.y); b_.z += g2b.z * (y[8 * j + 6] * inv * gb.z); b_.w += g2b.w * (y[8 * j + 7] * inv * gb.w);
            *(f32x4v*)op = a_; *(f32x4v*)(op + 4) = b_; }
    }
#undef MF_LOAD
}
__device__ void ph_attn_ref(const bf16* Q, const bf16* KF, const bf16* VT, float* o) {
    const int lane = tidx() & 63, gw = blockIdx.x * (NT / 64) + (tidx() >> 6), ngw = gridDim.x * (NT / 64);
    for (int item = gw; item < NB * MLA_H * (SEQ / 64); item += ngw) {
        const int qb = (SEQ / 64 - 1) - item / (NB * MLA_H), bh = item % (NB * MLA_H), b = bh / MLA_H, h = bh % MLA_H;
        const int qi = qb * 64 + lane;
        const size_t t = (size_t)b * SEQ + qi;
        float qr[QK];
#pragma unroll
        for (int d = 0; d < QK; ++d) qr[d] = bf2f(Q[t * 768 + h * QK + d]);
        float acc[VD];
#pragma unroll
        for (int d = 0; d < VD; ++d) acc[d] = 0.f;
        float mx = -INFINITY, l = 0.f;
        const int kmax = qb * 64 + 63;
        for (int k = 0; k <= kmax; ++k) {
            const bf16* kt = KF + (size_t)(bh * 32 + (k >> 6)) * 6144 + (k & 63) * 8;
            const bf16* vt = VT + (size_t)(bh * 32 + (k >> 6)) * 4096 + (k & 63) * 32;
            float s = 0.f;
#pragma unroll
            for (int d = 0; d < QK; ++d) s += qr[d] * bf2f(kt[(d >> 3) * 512 + (d & 7)]);
            if (k <= qi) {
                const float mn = fmaxf(mx, s);
                const float f = exp2f(mx - mn), pv = exp2f(s - mn);
                l = l * f + pv;
#pragma unroll
                for (int d = 0; d < VD; ++d) acc[d] = acc[d] * f + pv * bf2f(vt[(d >> 5) * 2048 + (d & 31)]);
                mx = mn;
            }
        }
        const float il = 1.f / l;
#pragma unroll
        for (int d = 0; d < VD; ++d) o[t * (MLA_H * VD) + h * VD + d] = acc[d] * il;
    }
}

__device__ __forceinline__ void glds16(const void* gsrc, unsigned lds_dst) { unsigned keep;
    asm volatile("s_mov_b32 %0, m0\n\ts_mov_b32 m0, %2\n\ts_nop 0\n\tglobal_load_lds_dwordx4 %1, off\n\ts_mov_b32 m0, %0" : "=&s"(keep) : "v"(gsrc), "s"(lds_dst) : "memory"); }
namespace att {
typedef short bf16x8 __attribute__((ext_vector_type(8)));
typedef short s16x4 __attribute__((ext_vector_type(4)));
typedef float f32x16 __attribute__((ext_vector_type(16)));
typedef unsigned u32x4 __attribute__((ext_vector_type(4)));
#define ALAS __attribute__((address_space(3)))
constexpr int KSLOT = 12288, VSLOT = 8192, NSLOT = 4, NSLOTV = 4;
constexpr int LDS_K = 0, LDS_V = NSLOT * KSLOT, LDS_WS = LDS_V + NSLOTV * VSLOT, LDS_OST = LDS_WS + 8 * 256, LDS_END = LDS_OST + 8 * 4096;
constexpr float THR = 8.0f;
__device__ __forceinline__ int crow(int r, int hi) { return (r & 3) + 8 * (r >> 2) + 4 * hi; }
__device__ __forceinline__ unsigned cvtpk(float lo, float hi) { typedef float f2 __attribute__((ext_vector_type(2))); typedef __bf16 b2 __attribute__((ext_vector_type(2)));
    f2 v = {lo, hi}; b2 b = __builtin_convertvector(v, b2); return __builtin_bit_cast(unsigned, b); }
__device__ __forceinline__ s16x4 vtr(const ALAS char* p) { typedef short v4 __attribute__((ext_vector_type(4))); return __builtin_bit_cast(s16x4, __builtin_amdgcn_ds_read_tr16_b64_v4i16((ALAS v4*)p)); }
#define AWAIT_BAR(N) asm volatile("s_waitcnt vmcnt(" #N ") lgkmcnt(0)\n\ts_barrier" ::: "memory")

__device__ __forceinline__ void attn_unit(ALAS char* lds, int bh, int qb, const bf16* Q, const bf16* KF, const bf16* VT, bf16* YC, float* SSQ) {
    const int tid = tidx(), lane = tid & 63, r32 = lane & 31, hi = lane >> 5; const int wid = __builtin_amdgcn_readfirstlane(tid >> 6);
    const int b = bh >> 3, h = bh & 7;
    const char* Kt = (const char*)(KF + (size_t)bh * 32 * 6144); const char* Vt = (const char*)(VT + (size_t)bh * 32 * 4096);
    const int NTL = 4 * (qb + 1);
    bf16x8 qf[6];
    { const bf16* qp = Q + (size_t)(b * SEQ + qb * 256 + wid * 32 + r32) * 768 + h * QK + hi * 8;
#pragma unroll
      for (int d0 = 0; d0 < 6; ++d0) qf[d0] = *(const bf16x8*)(qp + d0 * 16); }
    const unsigned koff0 = wid * 1024 + lane * 16, koff1 = (8 + (wid & 3)) * 1024 + lane * 16, voff = wid * 1024 + lane * 16;
    const unsigned lds0 = (unsigned)(uintptr_t)lds;
#define ADMA_K(t, ks_) do { const char* kb_ = Kt + (size_t)(t) * KSLOT; \
        glds16(kb_ + koff0, (unsigned)__builtin_amdgcn_readfirstlane(lds0 + LDS_K + (ks_) * KSLOT + wid * 1024)); \
        glds16(kb_ + koff1, (unsigned)__builtin_amdgcn_readfirstlane(lds0 + LDS_K + (ks_) * KSLOT + (8 + (wid & 3)) * 1024)); } while (0)
#define ADMA_V(t, vs_) do { const char* vb_ = Vt + (size_t)(t) * VSLOT; \
        glds16(vb_ + voff, (unsigned)__builtin_amdgcn_readfirstlane(lds0 + LDS_V + (vs_) * VSLOT + wid * 1024)); } while (0)
#define KLOAD(ks_) do { const ALAS char* Ks_ = lds + LDS_K + (ks_) * KSLOT + hi * 1024 + r32 * 16; \
        _Pragma("unroll") for (int d0 = 0; d0 < 3; ++d0) { kf[2 * d0] = *(const ALAS bf16x8*)(Ks_ + d0 * 2048); kf[2 * d0 + 1] = *(const ALAS bf16x8*)(Ks_ + d0 * 2048 + 512); } } while (0)
    ADMA_K(0, 0); ADMA_V(0, 0); ADMA_K(1, 1); ADMA_V(1, 1); ADMA_K(2, 2);
    ALAS float* wsf = (ALAS float*)(lds + LDS_WS) + wid * 64;
    float mref = 0.f, l = 0.f;
    f32x16 o0 = {}, o1 = {}, negm = {};
    const int qrel = wid * 32 + r32;
    const int vlane = (4 * hi + ((lane & 15) >> 2)) * 64 + ((lane >> 4) & 1) * 32 + (lane & 3) * 8;
    bf16x8 kf[6];
    AWAIT_BAR(6);
    KLOAD(0);
    int kslot = 0, vslot = 0;
    u32x4 pw0 = {}, pw1 = {}, pw2 = {}, pw3 = {};
    bool pend = false;
#define MX3(a, b, c) __builtin_fmaxf(__builtin_fmaxf((a), (b)), (c))
#define EX2(v) __builtin_amdgcn_exp2f(v)
#define SCALE_PW(PW, f_) do { _Pragma("unroll") for (int e_ = 0; e_ < 4; ++e_) PW[e_] = cvtpk(__uint_as_float(PW[e_] << 16) * (f_), __uint_as_float(PW[e_] & 0xffff0000u) * (f_)); } while (0)
#define PV_STEP(PW, ks, Vs) do { const bf16x8 pa_ = __builtin_bit_cast(bf16x8, PW); \
            { const s16x4 a_ = vtr(Vs + (ks) * 1024), b_ = vtr(Vs + (ks) * 1024 + 512); const bf16x8 vf_ = {a_[0], a_[1], a_[2], a_[3], b_[0], b_[1], b_[2], b_[3]}; \
              o0 = __builtin_amdgcn_mfma_f32_32x32x16_bf16(pa_, vf_, o0, 0, 0, 0); } \
            { const s16x4 a_ = vtr(Vs + 4096 + (ks) * 1024), b_ = vtr(Vs + 4096 + (ks) * 1024 + 512); const bf16x8 vf_ = {a_[0], a_[1], a_[2], a_[3], b_[0], b_[1], b_[2], b_[3]}; \
              o1 = __builtin_amdgcn_mfma_f32_32x32x16_bf16(pa_, vf_, o1, 0, 0, 0); } } while (0)
#define ATT_TILE(MASKED) do { \
          \
        if (t <= 1) { AWAIT_BAR(3); } else if (t + 3 < NTL) { AWAIT_BAR(4); } else { AWAIT_BAR(0); }     \
        if (t + 3 < NTL) ADMA_K(t + 3, (kslot + 3) & 3);                                   \
        if (t + 2 < NTL) ADMA_V(t + 2, (vslot + 2) & 3); \
        const ALAS char* Vp = lds + LDS_V + ((vslot + 3) & 3) * VSLOT + vlane;            \
        if (MASKED && 64 * (t - (NTL - 4)) > 32 * wid + 31) {                               \
            if (pend) { PV_STEP(pw0, 0, Vp); PV_STEP(pw1, 1, Vp); PV_STEP(pw2, 2, Vp); PV_STEP(pw3, 3, Vp); pend = false; } \
            kslot = (kslot + 1) & 3; vslot = (vslot + 1) & 3; break; } \
        f32x16 p0 = negm, p1 = negm; \
        { const ALAS char* Kc_ = lds + LDS_K + kslot * KSLOT + hi * 1024 + r32 * 16; \
          bf16x8 kg_[6]; \
          _Pragma("unroll") for (int d0 = 3; d0 < 6; ++d0) { kg_[2 * (d0 - 3)] = *(const ALAS bf16x8*)(Kc_ + d0 * 2048); kg_[2 * (d0 - 3) + 1] = *(const ALAS bf16x8*)(Kc_ + d0 * 2048 + 512); } \
          _Pragma("unroll") for (int d0 = 0; d0 < 3; ++d0) { \
            p0 = __builtin_amdgcn_mfma_f32_32x32x16_bf16(kf[2 * d0], qf[d0], p0, 0, 0, 0); \
            p1 = __builtin_amdgcn_mfma_f32_32x32x16_bf16(kf[2 * d0 + 1], qf[d0], p1, 0, 0, 0); } \
          _Pragma("unroll") for (int d0 = 3; d0 < 6; ++d0) { \
            p0 = __builtin_amdgcn_mfma_f32_32x32x16_bf16(kg_[2 * (d0 - 3)], qf[d0], p0, 0, 0, 0); \
            p1 = __builtin_amdgcn_mfma_f32_32x32x16_bf16(kg_[2 * (d0 - 3) + 1], qf[d0], p1, 0, 0, 0); } } \
        if (t + 1 < NTL) { KLOAD((kslot + 1) & 3); }                                       \
        if (MASKED) { const int jb = t - (NTL - 4); \
            _Pragma("unroll") for (int r = 0; r < 16; ++r) { const int kv = 64 * jb + crow(r, hi); if (kv > qrel) p0[r] = -INFINITY; if (kv + 32 > qrel) p1[r] = -INFINITY; } } \
        float rm; { float a_ = MX3(p0[0], p0[1], p1[0]), b_ = MX3(p0[2], p0[3], p1[1]); a_ = MX3(a_, p1[2], p1[3]); \
            _Pragma("unroll") for (int r = 4; r < 16; r += 4) { a_ = MX3(a_, p0[r], p0[r + 1]); b_ = MX3(b_, p0[r + 2], p0[r + 3]); a_ = MX3(a_, p1[r], p1[r + 1]); b_ = MX3(b_, p1[r + 2], p1[r + 3]); } \
            rm = fmaxf(a_, b_); } \
        { auto rr = __builtin_amdgcn_permlane32_swap(__float_as_uint(rm), __float_as_uint(rm), false, false); rm = fmaxf(__uint_as_float(rr[0]), __uint_as_float(rr[1])); } \
        if (t == 0 || __any(rm > THR)) { \
            const float dl = (t == 0) ? rm : fmaxf(rm, 0.f); \
            mref += dl; \
            _Pragma("unroll") for (int r = 0; r < 16; ++r) { p0[r] -= dl; p1[r] -= dl; } \
            _Pragma("unroll") for (int r = 0; r < 16; ++r) negm[r] = -mref; \
            const float f = EX2(-dl); l *= f; \
            if (t > 0) { \
                SCALE_PW(pw0, f); SCALE_PW(pw1, f); SCALE_PW(pw2, f); SCALE_PW(pw3, f);       \
                if (hi == 0) wsf[r32] = f; \
                asm volatile("s_waitcnt lgkmcnt(0)" ::: "memory"); \
                _Pragma("unroll") for (int r = 0; r < 16; ++r) { const float fr_ = wsf[crow(r, hi)]; o0[r] *= fr_; o1[r] *= fr_; } } } \
        if (pend) { PV_STEP(pw0, 0, Vp); PV_STEP(pw1, 1, Vp); PV_STEP(pw2, 2, Vp); PV_STEP(pw3, 3, Vp); } \
        pend = true; \
        float ls0 = 0.f, ls1 = 0.f; \
        _Pragma("unroll") for (int r = 0; r < 16; ++r) { p0[r] = EX2(p0[r]); p1[r] = EX2(p1[r]); ls0 += p0[r]; ls1 += p1[r]; } \
        l += ls0 + ls1; \
        pw0 = (u32x4){cvtpk(p0[0], p0[1]), cvtpk(p0[2], p0[3]), cvtpk(p0[4], p0[5]), cvtpk(p0[6], p0[7])}; \
        pw1 = (u32x4){cvtpk(p0[8], p0[9]), cvtpk(p0[10], p0[11]), cvtpk(p0[12], p0[13]), cvtpk(p0[14], p0[15])}; \
        pw2 = (u32x4){cvtpk(p1[0], p1[1]), cvtpk(p1[2], p1[3]), cvtpk(p1[4], p1[5]), cvtpk(p1[6], p1[7])}; \
        pw3 = (u32x4){cvtpk(p1[8], p1[9]), cvtpk(p1[10], p1[11]), cvtpk(p1[12], p1[13]), cvtpk(p1[14], p1[15])}; \
        kslot = (kslot + 1) & 3; vslot = (vslot + 1) & 3; } while (0)
    int t = 0;
    for (; t < NTL - 4; ++t) ATT_TILE(false);
    for (; t < NTL; ++t) ATT_TILE(true);
    if (pend) { const ALAS char* Vp = lds + LDS_V + ((vslot + 3) & 3) * VSLOT + vlane;
      PV_STEP(pw0, 0, Vp); PV_STEP(pw1, 1, Vp); PV_STEP(pw2, 2, Vp); PV_STEP(pw3, 3, Vp); }
#undef PV_STEP
#undef ATT_TILE
#undef SCALE_PW
#undef MX3
#undef EX2
#undef KLOAD
#undef ADMA_K
#undef ADMA_V
    { auto rr = __builtin_amdgcn_permlane32_swap(__float_as_uint(l), __float_as_uint(l), false, false); l = __uint_as_float(rr[0]) + __uint_as_float(rr[1]); }
    if (hi == 0) wsf[32 + r32] = l;
    asm volatile("s_waitcnt lgkmcnt(0)" ::: "memory");
    ALAS bf16* stg = (ALAS bf16*)(lds + LDS_OST) + wid * 2048;
#pragma unroll
    for (int r = 0; r < 16; ++r) { const int orow = crow(r, hi); const float rl = 1.f / wsf[32 + orow];
        stg[orow * 64 + r32] = (bf16)f2bf(o0[r] * rl); stg[orow * 64 + 32 + r32] = (bf16)f2bf(o1[r] * rl); }
    asm volatile("s_waitcnt lgkmcnt(0)" ::: "memory");
    const size_t trow0 = (size_t)b * SEQ + qb * 256 + wid * 32;
#pragma unroll
    for (int i = 0; i < 4; ++i) { const int row = i * 8 + (lane >> 3), ch = lane & 7;
        const u32x4 v = *(const ALAS u32x4*)(stg + row * 64 + ch * 8);
        *(u32x4*)(YC + (trow0 + row) * 1024 + 512 + h * 64 + ch * 8) = v;
        float sq = 0.f;
#pragma unroll
        for (int e = 0; e < 4; ++e) { const float a = __uint_as_float(v[e] << 16), c = __uint_as_float(v[e] & 0xffff0000u); sq += a * a + c * c; }
        sq += __shfl_xor(sq, 1); sq += __shfl_xor(sq, 2); sq += __shfl_xor(sq, 4);
        if (ch == 0) SSQ[(trow0 + row) * 16 + 8 + h] = sq; }
    asm volatile("s_waitcnt lgkmcnt(0)\n\ts_barrier" ::: "memory");
}
__device__ __forceinline__ void attn_phase(ALAS char* lds, const bf16* Q, const bf16* KF, const bf16* VT, bf16* YC, float* SSQ) {
    const int G = gridDim.x, bid = blockIdx.x; const int vcu = (G % 8 == 0) ? (bid % 8) * (G / 8) + bid / 8 : bid;
    for (int p = vcu; p < 256; p += G) { const int bh = p >> 2, s = p & 3;
        attn_unit(lds, bh, 7 - s, Q, KF, VT, YC, SSQ);
        attn_unit(lds, bh, s, Q, KF, VT, YC, SSQ); }
}
#undef AWAIT_BAR
}
__device__ void ph_prenorm(const float* in, const float* g, const float* mod, int sh_off, int sc_off, float* out) {
    const int lane = tidx() & 63, gw = blockIdx.x * (NT / 64) + (tidx() >> 6), ngw = gridDim.x * (NT / 64);
    for (int t = gw; t < M; t += ngw) {
        const int b = t / SEQ; const float* r = in + (size_t)t * D;
        float s = 0.f;
        for (int i = lane; i < D; i += 64) s += r[i] * r[i];
        const float inv = rsqrtf(wave_sum(s) / D + EPS);
        for (int i = lane; i < D; i += 64)
            out[(size_t)t * D + i] = r[i] * inv * g[i] * (1.f + mod[b * 6 * D + sc_off + i]) + mod[b * 6 * D + sh_off + i];
    }
}
template <class TY> __device__ void ph_post(const float* base, const TY* y, const float* g, const float* mod, int gate_off, float* out) {
    const int lane = tidx() & 63, gw = blockIdx.x * (NT / 64) + (tidx() >> 6), ngw = gridDim.x * (NT / 64);
    for (int t = gw; t < M; t += ngw) {
        const int b = t / SEQ; const TY* r = y + (size_t)t * D;
        float s = 0.f;
        for (int i = lane; i < D; i += 64) { const float v = ldf(r + i); s += v * v; }
        const float inv = rsqrtf(wave_sum(s) / D + EPS);
        for (int i = lane; i < D; i += 64)
            out[(size_t)t * D + i] = base[(size_t)t * D + i] + mod[b * 6 * D + gate_off + i] * (ldf(r + i) * inv * g[i]);
    }
}
template <class TI> __device__ void ph_rms_slice(const TI* in, int ldi, int off, int n, const float* g, float* out, int ldo, int ooff) {
    const int lane = tidx() & 63, gw = blockIdx.x * (NT / 64) + (tidx() >> 6), ngw = gridDim.x * (NT / 64);
    for (int t = gw; t < M; t += ngw) {
        const TI* r = in + (size_t)t * ldi + off;
        float s = 0.f;
        for (int i = lane; i < n; i += 64) { const float v = ldf(r + i); s += v * v; }
        const float inv = rsqrtf(wave_sum(s) / n + EPS);
        for (int i = lane; i < n; i += 64) out[(size_t)t * ldo + ooff + i] = ldf(r + i) * inv * g[i];
    }
}

namespace ssd {
typedef short bf16x8 __attribute__((ext_vector_type(8)));
typedef short s16x4 __attribute__((ext_vector_type(4)));
typedef float f32x16 __attribute__((ext_vector_type(16)));
typedef unsigned u32x4 __attribute__((ext_vector_type(4)));
#define SLAS __attribute__((address_space(3)))
constexpr float LOG2E = 1.4426950408889634f;
__device__ __forceinline__ int crow(int r, int hi) { return (r & 3) + 8 * (r >> 2) + 4 * hi; }
__device__ __forceinline__ s16x4 vtr(const SLAS char* p) { typedef short v4 __attribute__((ext_vector_type(4))); return __builtin_bit_cast(s16x4, __builtin_amdgcn_ds_read_tr16_b64_v4i16((SLAS v4*)p)); }
__device__ __forceinline__ unsigned cvtpk(float lo, float hi) { typedef float f2 __attribute__((ext_vector_type(2))); typedef __bf16 b2 __attribute__((ext_vector_type(2)));
    f2 v = {lo, hi}; b2 b = __builtin_convertvector(v, b2); return __builtin_bit_cast(unsigned, b); }
#define SWAIT_BAR(N) asm volatile("s_waitcnt vmcnt(" #N ") lgkmcnt(0)\n\ts_barrier" ::: "memory")
#define SDMA(gsrc, ldst) glds16((gsrc), (unsigned)__builtin_amdgcn_readfirstlane((unsigned)(uintptr_t)(ldst)))

constexpr int SW_BUF = 49152, SW_TAB = 2 * SW_BUF;
__device__ __forceinline__ void state_sweep(SLAS char* lds, int b, int h, const bf16* XT, const float* DT, const float* a_log, float* ACS2, bf16* PREV) {
    const int tid = tidx(), lane = tid & 63, r32 = lane & 31, hi = lane >> 5; const int wid = __builtin_amdgcn_readfirstlane(tid >> 6);
    const int g = h >> 2, pt = wid & 1, nt = wid >> 1;
    const float a = -expf(a_log[h]);
    SLAS float* wtab = (SLAS float*)(lds + SW_TAB); SLAS float* ctab = wtab + 2048;
    const int trl = (4 * hi + ((lane & 15) >> 2));
    const int trc = 16 * ((lane >> 4) & 1) + 4 * (lane & 3);
#define SW_ISSUE(c_, buf_) do { const char* xs_ = (const char*)(XT + (size_t)(b * 16 + (c_)) * 131072 + h * 8192); const char* bs_ = (const char*)(XT + (size_t)(b * 16 + (c_)) * 131072 + 65536 + g * 16384); \
        _Pragma("unroll") for (int i_ = 0; i_ < 2; ++i_) SDMA(xs_ + (wid * 2 + i_) * 1024 + lane * 16, lds + (buf_) * SW_BUF + (wid * 2 + i_) * 1024); \
        _Pragma("unroll") for (int i_ = 0; i_ < 4; ++i_) SDMA(bs_ + (wid * 4 + i_) * 1024 + lane * 16, lds + (buf_) * SW_BUF + 16384 + (wid * 4 + i_) * 1024); } while (0)
    SW_ISSUE(0, 0);
#pragma unroll
    for (int cc = 0; cc < 2; ++cc) { const int c = 2 * wid + cc; const size_t t0 = (size_t)(b * 16 + c) * 128;
        const float d0 = DT[(t0 + 2 * lane) * 8 + h], d1 = DT[(t0 + 2 * lane + 1) * 8 + h];
        const float a0 = d0 * a, a1 = d1 * a; float inc = a0 + a1;
#pragma unroll
        for (int o = 1; o < 64; o <<= 1) { const float n = __shfl_up(inc, o); if (lane >= o) inc += n; }
        const float tot = __shfl(inc, 63); const float cs1 = inc, cs0 = inc - a1;
        wtab[c * 128 + 2 * lane] = d0 * expf(tot - cs0); wtab[c * 128 + 2 * lane + 1] = d1 * expf(tot - cs1);
        if (lane == 0) ctab[c] = expf(tot);
        ACS2[(t0 + 2 * lane) * 8 + h] = cs0 * LOG2E; ACS2[(t0 + 2 * lane + 1) * 8 + h] = cs1 * LOG2E; }
    f32x16 st = {};
    for (int c = 0; c < 16; ++c) {
        const int buf = c & 1;
        asm volatile("s_waitcnt vmcnt(4) lgkmcnt(0)\n\ts_barrier" ::: "memory");
        if (c + 1 < 16) SW_ISSUE(c + 1, buf ^ 1);
        const float cdec = ctab[c];
        { SLAS char* xp = lds + buf * SW_BUF + tid * 32; const int l = (tid >> 1) & 127; const float w = wtab[c * 128 + l];
          u32x4 q0 = *(SLAS u32x4*)xp, q1 = *(SLAS u32x4*)(xp + 16);
#pragma unroll
          for (int e = 0; e < 4; ++e) { q0[e] = cvtpk(__uint_as_float(q0[e] << 16) * w, __uint_as_float(q0[e] & 0xffff0000u) * w); q1[e] = cvtpk(__uint_as_float(q1[e] << 16) * w, __uint_as_float(q1[e] & 0xffff0000u) * w); }
          *(SLAS u32x4*)xp = q0; *(SLAS u32x4*)(xp + 16) = q1; }
        asm volatile("s_waitcnt lgkmcnt(0)\n\ts_barrier" ::: "memory");
        f32x16 acc = {};
        { const SLAS char* bb = lds + buf * SW_BUF + 16384 + ((32 * nt + trc) >> 3) * 2048 + ((32 * nt + trc) & 7) * 2 + trl * 16;
          const SLAS char* xb = lds + buf * SW_BUF + pt * 8192 + trl * 64 + trc * 2;
#pragma unroll
          for (int ks = 0; ks < 8; ++ks) {
              const s16x4 a0 = vtr(bb + ks * 256), a1 = vtr(bb + ks * 256 + 128); const s16x4 x0 = vtr(xb + ks * 1024), x1 = vtr(xb + ks * 1024 + 512);
              const bf16x8 af = {a0[0], a0[1], a0[2], a0[3], a1[0], a1[1], a1[2], a1[3]}, xf = {x0[0], x0[1], x0[2], x0[3], x1[0], x1[1], x1[2], x1[3]};
              acc = __builtin_amdgcn_mfma_f32_32x32x16_bf16(af, xf, acc, 0, 0, 0); } }
        { bf16* pv = PREV + (size_t)((b * 16 + c) * 8 + h) * 8192 + (32 * pt + r32) * 8 + 4 * hi;
#pragma unroll
          for (int rg = 0; rg < 4; ++rg) { uint2 o; o.x = cvtpk(st[4 * rg], st[4 * rg + 1]); o.y = cvtpk(st[4 * rg + 2], st[4 * rg + 3]); *(uint2*)(pv + (4 * nt + rg) * 512) = o; } }
#pragma unroll
        for (int r = 0; r < 16; ++r) st[r] = st[r] * cdec + acc[r];
    }
    asm volatile("s_waitcnt vmcnt(0) lgkmcnt(0)\n\ts_barrier" ::: "memory");
#undef SW_ISSUE
}

constexpr int P2_C = 0, P2_B = 32768, P2_XP = 65536, P2_TAB = 131072, P2_STG = 135168, P2_END = 151552;
__device__ __forceinline__ void chunk_unit(SLAS char* lds, int b, int c, int g, const bf16* XT, const bf16* PREV, const float* DT, const float* ACS2, const float* d_skip,
                                           const bf16* U, bf16* YC, float* SSQS) {
    const int tid = tidx(), lane = tid & 63, r32 = lane & 31, hi = lane >> 5; const int wid = __builtin_amdgcn_readfirstlane(tid >> 6);
    const int lb = wid >> 1, ph = wid & 1;
    const char* xt = (const char*)(XT + (size_t)(b * 16 + c) * 131072);
    const size_t t0 = (size_t)(b * 16 + c) * 128;
#pragma unroll
    for (int i = 0; i < 4; ++i) { SDMA(xt + (98304 + g * 16384) * 2 + (wid * 4 + i) * 1024 + lane * 16, lds + P2_C + (wid * 4 + i) * 1024);
                                  SDMA(xt + (65536 + g * 16384) * 2 + (wid * 4 + i) * 1024 + lane * 16, lds + P2_B + (wid * 4 + i) * 1024); }
#define P2_ISSUE(hh_) do { const int h_ = 4 * g + (hh_); const char* xs_ = xt + h_ * 16384; const char* ps_ = (const char*)(PREV + (size_t)((b * 16 + c) * 8 + h_) * 8192); \
        SLAS char* d_ = lds + P2_XP + ((hh_) & 1) * 32768; \
        _Pragma("unroll") for (int i_ = 0; i_ < 2; ++i_) { SDMA(xs_ + (wid * 2 + i_) * 1024 + lane * 16, d_ + (wid * 2 + i_) * 1024); SDMA(ps_ + (wid * 2 + i_) * 1024 + lane * 16, d_ + 16384 + (wid * 2 + i_) * 1024); } } while (0)
    P2_ISSUE(0);
    { SLAS float* tab = (SLAS float*)(lds + P2_TAB); const int hh = tid >> 7, l = tid & 127;
      tab[hh * 256 + l] = ACS2[(t0 + l) * 8 + 4 * g + hh]; tab[hh * 256 + 128 + l] = DT[(t0 + l) * 8 + 4 * g + hh]; }
    P2_ISSUE(1);
    SWAIT_BAR(4);
    bf16x8 cf[8];
#pragma unroll
    for (int ks = 0; ks < 8; ++ks) cf[ks] = *(const SLAS bf16x8*)(lds + P2_C + (2 * ks + hi) * 2048 + (32 * lb + r32) * 16);
    f32x16 cbt[4];
#pragma unroll
    for (int sb = 0; sb < 4; ++sb) { cbt[sb] = f32x16{};
        if (sb <= lb) {
#pragma unroll
            for (int ks = 0; ks < 8; ++ks) { const bf16x8 bfr = *(const SLAS bf16x8*)(lds + P2_B + (2 * ks + hi) * 2048 + (32 * sb + r32) * 16);
                cbt[sb] = __builtin_amdgcn_mfma_f32_32x32x16_bf16(bfr, cf[ks], cbt[sb], 0, 0, 0); } } }
    const int vlane = (4 * hi + ((lane & 15) >> 2)) * 64 + ((lane >> 4) & 1) * 32 + (lane & 3) * 8;
    const int lrow = 32 * lb + r32;
    for (int hh = 0; hh < 4; ++hh) {
        const int h = 4 * g + hh;
        const SLAS char* xb = lds + P2_XP + (hh & 1) * 32768; const SLAS char* pb = xb + 16384;
        const SLAS float* tab = (const SLAS float*)(lds + P2_TAB) + hh * 256;
        const float dsk = d_skip[h];
        u32x4 zpre[2];
#pragma unroll
        for (int i = 0; i < 2; ++i) zpre[i] = *(const u32x4*)(U + (t0 + 32 * lb + i * 16 + (lane >> 2)) * NU + OFF_Z + h * 64 + 32 * ph + 8 * (lane & 3));
        f32x16 o = {};
#pragma unroll
        for (int ks = 0; ks < 8; ++ks) { const bf16x8 pf = *(const SLAS bf16x8*)(pb + (2 * ks + hi) * 1024 + (32 * ph + r32) * 16);
            o = __builtin_amdgcn_mfma_f32_32x32x16_bf16(cf[ks], pf, o, 0, 0, 0); }
#pragma unroll
        for (int r = 0; r < 16; ++r) o[r] *= __builtin_amdgcn_exp2f(tab[32 * lb + crow(r, hi)]);
        int lrow_h = lrow; asm volatile("" : "+v"(lrow_h));
        const float al = tab[lrow];
#pragma unroll
        for (int sb = 0; sb < 4; ++sb) {
            if (sb <= lb) {
                float pr[16];
#pragma unroll
                for (int r = 0; r < 16; ++r) { const int sidx = 32 * sb + crow(r, hi);
                    float v = cbt[sb][r] * __builtin_amdgcn_exp2f(al - tab[sidx]) * tab[128 + sidx];
                    if (sb == lb) { v = (sidx <= lrow_h) ? v : 0.f; v += (sidx == lrow_h) ? dsk : 0.f; }
                    pr[r] = v; }
                const u32x4 pw0 = {cvtpk(pr[0], pr[1]), cvtpk(pr[2], pr[3]), cvtpk(pr[4], pr[5]), cvtpk(pr[6], pr[7])};
                const u32x4 pw1 = {cvtpk(pr[8], pr[9]), cvtpk(pr[10], pr[11]), cvtpk(pr[12], pr[13]), cvtpk(pr[14], pr[15])};
                const SLAS char* xv = xb + ph * 8192 + vlane + (2 * sb) * 1024;
                { const s16x4 a_ = vtr(xv), b_ = vtr(xv + 512); const bf16x8 vf = {a_[0], a_[1], a_[2], a_[3], b_[0], b_[1], b_[2], b_[3]};
                  o = __builtin_amdgcn_mfma_f32_32x32x16_bf16(__builtin_bit_cast(bf16x8, pw0), vf, o, 0, 0, 0); }
                { const s16x4 a_ = vtr(xv + 1024), b_ = vtr(xv + 1024 + 512); const bf16x8 vf = {a_[0], a_[1], a_[2], a_[3], b_[0], b_[1], b_[2], b_[3]};
                  o = __builtin_amdgcn_mfma_f32_32x32x16_bf16(__builtin_bit_cast(bf16x8, pw1), vf, o, 0, 0, 0); }
            }
        }
        SLAS bf16* stg = (SLAS bf16*)(lds + P2_STG) + wid * 1024;
#pragma unroll
        for (int r = 0; r < 16; ++r) stg[crow(r, hi) * 32 + r32] = (bf16)f2bf(o[r]);
        asm volatile("s_waitcnt lgkmcnt(0)" ::: "memory");
#pragma unroll
        for (int i = 0; i < 2; ++i) { const int row = i * 16 + (lane >> 2), ch = lane & 3; const size_t t = t0 + 32 * lb + row;
            const u32x4 ov = *(const SLAS u32x4*)(stg + row * 32 + ch * 8);
            const u32x4 zv = zpre[i];
            u32x4 w; float sq = 0.f;
#pragma unroll
            for (int e = 0; e < 4; ++e) { const float z0 = __uint_as_float(zv[e] << 16), z1 = __uint_as_float(zv[e] & 0xffff0000u);
                const float v0 = __uint_as_float(ov[e] << 16) * (z0 * __builtin_amdgcn_rcpf(1.f + __expf(-z0))), v1 = __uint_as_float(ov[e] & 0xffff0000u) * (z1 * __builtin_amdgcn_rcpf(1.f + __expf(-z1)));
                w[e] = cvtpk(v0, v1); const float r0 = __uint_as_float(w[e] << 16), r1 = __uint_as_float(w[e] & 0xffff0000u); sq += r0 * r0 + r1 * r1; }
            *(u32x4*)(YC + t * 1024 + h * 64 + 32 * ph + 8 * ch) = w;
            sq += __shfl_xor(sq, 1); sq += __shfl_xor(sq, 2);
            if (ch == 0) SSQS[t * 16 + h * 2 + ph] = sq; }
        if (hh < 3) {
            if (hh + 2 < 4) { asm volatile("s_waitcnt lgkmcnt(0)\n\ts_barrier" ::: "memory"); P2_ISSUE(hh + 2); SWAIT_BAR(4); }
            else { SWAIT_BAR(0); }
        }
    }
    asm volatile("s_waitcnt vmcnt(0) lgkmcnt(0)\n\ts_barrier" ::: "memory");
#undef P2_ISSUE
}
#undef SWAIT_BAR
#undef SDMA
}
__device__ void ph_gate_norm(const float* y, const bf16* u, bf16* YC) {
    const int lane = tidx() & 63, gw = blockIdx.x * (NT / 64) + (tidx() >> 6), ngw = gridDim.x * (NT / 64);
    for (int t = gw; t < M; t += ngw) {
        float v[8]; float s = 0.f;
#pragma unroll
        for (int j = 0; j < 8; ++j) { const int i = lane + 64 * j; v[j] = y[(size_t)t * SSD_INNER + i] * silu_f(bf2f(u[(size_t)t * NU + OFF_Z + i])); s += v[j] * v[j]; }
        const float inv = rsqrtf(wave_sum(s) / SSD_INNER + EPS);
#pragma unroll
        for (int j = 0; j < 8; ++j) YC[(size_t)t * 1024 + lane + 64 * j] = (bf16)f2bf(v[j] * inv);
    }
}
__device__ void ph_yc_norm(bf16* YC, const float* SSQS, const float* SSQ) {
    const int lane = tidx() & 63, gw = blockIdx.x * (NT / 64) + (tidx() >> 6), ngw = gridDim.x * (NT / 64);
    v4u nw0 = {0u, 0u, 0u, 0u}, nw1 = nw0;
    if (gw < M) { const v4u* p = (const v4u*)(YC + (size_t)gw * 1024) + lane; nw0 = p[0]; nw1 = p[64]; }
    for (int t = gw; t < M; t += ngw) {
        float ss = 0.f, sm = 0.f;
#pragma unroll
        for (int q = 0; q < 4; ++q) { const f32x4v a = *(const f32x4v*)(SSQS + (size_t)t * 16 + 4 * q); ss += (a.x + a.y) + (a.z + a.w); }
        { const f32x4v a = *(const f32x4v*)(SSQ + (size_t)t * 16 + 8), b = *(const f32x4v*)(SSQ + (size_t)t * 16 + 12); sm = (a.x + a.y) + (a.z + a.w) + (b.x + b.y) + (b.z + b.w); }
        v4u w0 = nw0, w1 = nw1;
        if (t + ngw < M) { const v4u* p = (const v4u*)(YC + (size_t)(t + ngw) * 1024) + lane; nw0 = p[0]; nw1 = p[64]; }
        const float invs = rsqrtf(ss * (1.f / 512.f) + EPS), invm = rsqrtf(sm * (1.f / 512.f) + EPS);
        v4u* p = (v4u*)(YC + (size_t)t * 1024) + lane;
#pragma unroll
        for (int e = 0; e < 4; ++e) { w0[e] = pk2(__uint_as_float(w0[e] << 16) * invs, __uint_as_float(w0[e] & 0xffff0000u) * invs); w1[e] = pk2(__uint_as_float(w1[e] << 16) * invm, __uint_as_float(w1[e] & 0xffff0000u) * invm); }
        p[0] = w0; p[64] = w1;
    }
}
__device__ void ph_gemm(float* lds, const float* A, int lda, const float* B, int ldb, float* C, int ldc, int Mr, int N, int K) {
    float (*As)[129] = (float (*)[129])lds;
    float (*Bs)[65] = (float (*)[65])(lds + 16 * 129);
    const int tx = tidx() & 15, ty = tidx() >> 4;
    const int ntn = (N + 63) / 64, ntm = Mr / 128;
    for (int tile = blockIdx.x; tile < ntn * ntm; tile += gridDim.x) {
        const int m0 = (tile / ntn) * 128, n0 = (tile % ntn) * 64;
        float acc[4][4] = {};
        for (int k0 = 0; k0 < K; k0 += 16) {
            for (int i = tidx(); i < 128 * 16; i += NT) { const int r = i >> 4, kk = i & 15; As[kk][r] = A[(size_t)(m0 + r) * lda + k0 + kk]; }
            for (int i = tidx(); i < 64 * 16; i += NT) { const int kk = i >> 6, cc = i & 63; Bs[kk][cc] = (n0 + cc < N) ? B[(size_t)(k0 + kk) * ldb + n0 + cc] : 0.f; }
            __syncthreads();
#pragma unroll
            for (int kk = 0; kk < 16; ++kk) {
                float a[4], b[4];
#pragma unroll
                for (int i = 0; i < 4; ++i) { a[i] = As[kk][ty * 4 + i]; b[i] = Bs[kk][tx * 4 + i]; }
#pragma unroll
                for (int i = 0; i < 4; ++i)
#pragma unroll
                    for (int j = 0; j < 4; ++j) acc[i][j] += a[i] * b[j];
            }
            __syncthreads();
        }
#pragma unroll
        for (int i = 0; i < 4; ++i)
#pragma unroll
            for (int j = 0; j < 4; ++j) { const int n = n0 + tx * 4 + j; if (n < N) C[(size_t)(m0 + ty * 4 + i) * ldc + n] = acc[i][j]; }
    }
}
__device__ void ph_conv(const bf16* u, const float* cw, const float* cb, float* xc) {
    for (size_t idx = (size_t)blockIdx.x * NT + tidx(); idx < (size_t)M * SSD_XBC; idx += (size_t)gridDim.x * NT) {
        const int ch = (int)(idx % SSD_XBC), t = (int)(idx / SSD_XBC), s = t % SEQ;
        float acc = cb[ch];
        for (int k = 0; k < 4; ++k) { const int ss = s - 3 + k; if (ss >= 0) acc += cw[k * SSD_XBC + ch] * bf2f(u[(size_t)(t - 3 + k) * NU + OFF_XBC + ch]); }
        xc[idx] = silu_f(acc);
    }
}
__device__ void ph_ssd_seq(const float* DT, const bf16* xc, const float* dt_bias, const float* a_log, const float* d_skip, float* y) {
    for (int item = blockIdx.x; item < NB * SSD_H; item += gridDim.x) {
        const int b = item / SSD_H, h = item % SSD_H, g = h / (SSD_H / SSD_G);
        const int p = tidx() >> 3, nq = tidx() & 7;
        const float a = -expf(a_log[h]), dsk = d_skip[h];
        float st[16];
#pragma unroll
        for (int i = 0; i < 16; ++i) st[i] = 0.f;
        for (int s = 0; s < SEQ; ++s) {
            const size_t t = (size_t)b * SEQ + s;
            const float dt = DT[t * 8 + h];
            const float da = expf(dt * a);
            const float xv = bf2f(xc[t * SSD_XBC + h * SSD_P + p]);
            const float xd = xv * dt;
            const bf16* Bp = xc + t * SSD_XBC + SSD_INNER + g * SSD_N + nq * 16;
            const bf16* Cp = xc + t * SSD_XBC + SSD_INNER + SSD_G * SSD_N + g * SSD_N + nq * 16;
            float acc = 0.f;
#pragma unroll
            for (int i = 0; i < 16; ++i) { st[i] = st[i] * da + xd * bf2f(Bp[i]); acc += bf2f(Cp[i]) * st[i]; }
            acc += __shfl_xor(acc, 1); acc += __shfl_xor(acc, 2); acc += __shfl_xor(acc, 4);
            if (nq == 0) y[t * SSD_INNER + h * SSD_P + p] = acc + dsk * xv;
        }
    }
}
__device__ void ph_rope(float* q, const bf16* u, const int* pos, float* kpe) {
    for (int idx = blockIdx.x * NT + tidx(); idx < M * 9 * 16; idx += gridDim.x * NT) {
        const int i = idx % 16, hh = (idx / 16) % 9, t = idx / (16 * 9);
        const float inv = 1.0f / powf(10000.0f, (float)(2 * i) / 32.0f);
        const float ang = (float)pos[t] * inv;
        float sn, cs; sincosf(ang, &sn, &cs);
        if (hh < 8) {
            float* p = q + (size_t)t * (MLA_H * QK) + hh * QK + NOPE;
            const float x1 = p[i], x2 = p[16 + i];
            p[i] = x1 * cs - x2 * sn; p[16 + i] = x2 * cs + x1 * sn;
        } else {
            const bf16* p = u + (size_t)t * NU + OFF_KR;
            const float x1 = bf2f(p[i]), x2 = bf2f(p[16 + i]);
            kpe[(size_t)t * ROPE + i] = x1 * cs - x2 * sn; kpe[(size_t)t * ROPE + 16 + i] = x2 * cs + x1 * sn;
        }
    }
}
__device__ void ph_attn(const float* q, const float* kv, const float* kpe, float* o) {
    const int lane = tidx() & 63, gw = blockIdx.x * (NT / 64) + (tidx() >> 6), ngw = gridDim.x * (NT / 64);
    for (int item = gw; item < NB * MLA_H * (SEQ / 64); item += ngw) {
        const int qb = (SEQ / 64 - 1) - item / (NB * MLA_H), bh = item % (NB * MLA_H), b = bh / MLA_H, h = bh % MLA_H;
        const int qi = qb * 64 + lane;
        const size_t t = (size_t)b * SEQ + qi;
        float qr[QK];
#pragma unroll
        for (int d = 0; d < QK; ++d) qr[d] = q[t * (MLA_H * QK) + h * QK + d] * 0.10206207261596575f;
        float acc[VD];
#pragma unroll
        for (int d = 0; d < VD; ++d) acc[d] = 0.f;
        float mx = -INFINITY, l = 0.f;
        const int kmax = qb * 64 + 63;
        for (int k = 0; k <= kmax; ++k) {
            const size_t tk = (size_t)b * SEQ + k;
            const float* kn = kv + tk * (MLA_H * 128) + h * 128;
            const float* kp = kpe + tk * ROPE;
            float s = 0.f;
#pragma unroll
            for (int d = 0; d < NOPE; ++d) s += qr[d] * kn[d];
#pragma unroll
            for (int d = 0; d < ROPE; ++d) s += qr[NOPE + d] * kp[d];
            if (k <= qi) {
                const float mn = fmaxf(mx, s);
                const float f = expf(mx - mn), pv = expf(s - mn);
                l = l * f + pv;
#pragma unroll
                for (int d = 0; d < VD; ++d) acc[d] = acc[d] * f + pv * kn[64 + d];
                mx = mn;
            }
        }
        const float il = 1.f / l;
#pragma unroll
        for (int d = 0; d < VD; ++d) o[t * (MLA_H * VD) + h * VD + d] = acc[d] * il;
    }
}
__device__ void ph_moe(float* lds, const float* h2, const float* wgr, const float* bgr, const float* wer, const float* ber,
                       const float* wg, const float* wu, const float* wd, float* y2) {
    const int sb = tidx() >> 8, tid = tidx() & 255;
    float* xs = lds + sb * 2048;
    float* logit = xs + 1024;
    float* hid = xs + 1088;
    int* sel_e = (int*)(xs + 1600);
    float* sel_w = xs + 1604;
    for (int it = blockIdx.x; it < M / 2; it += gridDim.x) {
        const int t = it * 2 + sb;
        __syncthreads();
        for (int i = tid; i < D; i += 256) xs[i] = h2[(size_t)t * D + i];
        __syncthreads();
        {
            const int w = tid >> 6, lane = tid & 63;
            for (int cidx = w * 9; cidx < w * 9 + 9; ++cidx) {
                float s = 0.f;
                for (int k = lane; k < D; k += 64) s += xs[k] * (cidx < 4 ? wgr[k * 4 + cidx] : wer[k * 32 + (cidx - 4)]);
                s = wave_sum(s);
                if (lane == 0) logit[cidx] = s;
            }
        }
        __syncthreads();
        if (tid == 0) {
            float mxv = -INFINITY; int gi = 0;
            for (int i = 0; i < 4; ++i) { const float v = logit[i] + bgr[i]; logit[i] = v; if (v > mxv) { mxv = v; gi = i; } }
            float den = 0.f; for (int i = 0; i < 4; ++i) den += expf(logit[i] - mxv);
            const float gw = 1.f / den;
            float emx = -INFINITY; int i1 = 0;
            for (int i = 0; i < 8; ++i) { const float v = logit[4 + gi * 8 + i] + ber[gi * 8 + i]; logit[4 + gi * 8 + i] = v; if (v > emx) { emx = v; i1 = i; } }
            float e2 = -INFINITY; int i2 = 0;
            for (int i = 0; i < 8; ++i) { const float v = logit[4 + gi * 8 + i]; if (i != i1 && v > e2) { e2 = v; i2 = i; } }
            const float p2 = expf(e2 - emx);
            sel_e[0] = gi * 8 + i1; sel_e[1] = gi * 8 + i2;
            sel_w[0] = gw / (1.f + p2); sel_w[1] = gw * p2 / (1.f + p2);
        }
        __syncthreads();
        for (int k2 = 0; k2 < 2; ++k2) {
            const int e = sel_e[k2];
            const float* G = wg + (size_t)e * D * FF; const float* U = wu + (size_t)e * D * FF;
            float ga = 0.f, ua = 0.f;
            for (int k = 0; k < D; ++k) { ga += xs[k] * G[(size_t)k * FF + tid]; ua += xs[k] * U[(size_t)k * FF + tid]; }
            hid[k2 * FF + tid] = silu_f(ga) * ua * sel_w[k2];
        }
        __syncthreads();
        for (int d = tid; d < D; d += 256) {
            float acc = 0.f;
            for (int k2 = 0; k2 < 2; ++k2) {
                const float* Wd = wd + (size_t)sel_e[k2] * FF * D;
                for (int f = 0; f < FF; ++f) acc += hid[k2 * FF + f] * Wd[(size_t)f * D + d];
            }
            y2[(size_t)t * D + d] = acc;
        }
    }
}


#define LAS __attribute__((address_space(3)))
#define XB_TMO      128
#define XB_XCNT(j)  (256  + 64 * (j))
#define XB_XSUB(j)  (1280 + 64 * (j))
#define XB_XGEN(j)  (2304 + 64 * (j))
#define XB_TOP      3328
#define XB_TOPGEN   3392
#define XCD_BAR_WORDS 3456
#define XB_SPIN_CAP (1u << 18)

__device__ __forceinline__ unsigned xb_ld(unsigned* p)              { return __hip_atomic_load(p, __ATOMIC_RELAXED, __HIP_MEMORY_SCOPE_AGENT); }
__device__ __forceinline__ unsigned xb_add(unsigned* p, unsigned v) { return __hip_atomic_fetch_add(p, v, __ATOMIC_RELAXED, __HIP_MEMORY_SCOPE_AGENT); }
__device__ __forceinline__ unsigned xb_xcc_id() { return (unsigned)__builtin_amdgcn_s_getreg((3 << 11) | 20) & 0xFu; }
#define XB_SPIN(cond, bar) do { unsigned _sp = 0; while (cond) { __builtin_amdgcn_s_sleep(1); \
    if ((++_sp & 255u) == 0u) { if (xb_ld(&(bar)[XB_TMO])) break; if (_sp > XB_SPIN_CAP) { atomicAdd(&(bar)[XB_TMO], 1u); break; } } } } while (0)

struct XcdBarrier {
    unsigned* bar; unsigned x;
    volatile LAS unsigned* st;
};

__device__ __forceinline__ XcdBarrier xcd_barrier_post(unsigned* bar, volatile LAS unsigned* st) {
    XcdBarrier b; b.bar = bar; b.x = xb_xcc_id(); b.st = st;
    if (tidx() == 0) (void)xb_add(&bar[XB_XCNT(b.x)], 1u);
    return b;
}
__device__ __forceinline__ void xcd_barrier_complete(unsigned* bar, unsigned x, unsigned& nloc, unsigned& nx) {
    const unsigned G = gridDim.x * gridDim.y * gridDim.z;
    unsigned sum, cnt, mine, sp = 0u;
    for (;;) {
        sum = 0u; cnt = 0u; mine = 0u;
#pragma unroll
        for (unsigned j = 0; j < 16; ++j) { const unsigned c = xb_ld(&bar[XB_XCNT(j)]); sum += c; cnt += (c > 0u) ? 1u : 0u; mine = (j == x) ? c : mine; }
        if (sum == G) break;
        __builtin_amdgcn_s_sleep(1);
        if ((++sp & 255u) == 0u) { if (xb_ld(&bar[XB_TMO])) break; if (sp > XB_SPIN_CAP) { atomicAdd(&bar[XB_TMO], 1u); break; } }
    }
    nloc = mine > 0u ? mine : 1u; nx = cnt > 0u ? cnt : 1u;
}

__device__ __forceinline__ void xcd_barrier(const XcdBarrier& b) {
    asm volatile("s_waitcnt vmcnt(0)" ::: "memory");
    __syncthreads();
    if (tidx() == 0) {
        unsigned* bar = b.bar;
        __builtin_amdgcn_s_waitcnt(0);
        unsigned nloc = b.st[0], nx = b.st[1];
        if (nloc == 0u) { xcd_barrier_complete(bar, b.x, nloc, nx); b.st[0] = nloc; b.st[1] = nx; }
        const unsigned old = xb_add(&bar[XB_XSUB(b.x)], 1u);
        const unsigned gen = old / nloc;
        if (old + 1u == (gen + 1u) * nloc) {
            __builtin_amdgcn_fence(__ATOMIC_RELEASE, "agent");
            asm volatile("s_waitcnt vmcnt(0)" ::: "memory");
            const unsigned og = xb_add(&bar[XB_TOP], 1u);
            const unsigned tg = og / nx;
            if (og + 1u == (tg + 1u) * nx) xb_add(&bar[XB_TOPGEN], 1u);
            else XB_SPIN(xb_ld(&bar[XB_TOPGEN]) == tg, bar);
            __builtin_amdgcn_fence(__ATOMIC_ACQUIRE, "agent");
            xb_add(&bar[XB_XGEN(b.x)], 1u);
            asm volatile("s_waitcnt vmcnt(0)" ::: "memory");
        } else {
            XB_SPIN(xb_ld(&bar[XB_XGEN(b.x)]) == gen, bar);
            __builtin_amdgcn_fence(__ATOMIC_ACQUIRE, "agent");
            asm volatile("s_waitcnt vmcnt(0)" ::: "memory");
        }
    }
    __syncthreads();
}


constexpr size_t MiB = 1u << 20;
#define WSB(T, off) ((T*)(kargs()->ws + (size_t)(off)))
#define OUTB(T, off) ((T*)((char*)kargs()->out + (size_t)(off)))
#define B_CNT    WSB(int, 4096)
#define B_MOD    WSB(float, 1 * MiB)
#define B_DT     WSB(float, 1 * MiB + 256 * 1024)
#define B_ACS2   WSB(float, 1 * MiB + 768 * 1024)
#define B_WIN    WSB(bf16, 2 * MiB)
#define B_WOUT   WSB(bf16, 6 * MiB)
#define B_WUQ    WSB(bf16, 8 * MiB)
#define B_WUKV   WSB(bf16, 9 * MiB)
#define B_WRT    WSB(float, 9 * MiB + 512 * 1024)
#define B_WGU    WSB(bf16, 10 * MiB)
#define B_WD     WSB(bf16, 42 * MiB)
#define B_HB     WSB(bf16, 58 * MiB)
#define B_YC     WSB(bf16, 58 * MiB)
#define B_H2     WSB(bf16, 58 * MiB)
#define B_U      WSB(bf16, 90 * MiB)
#define B_HG     WSB(bf16, 90 * MiB)
#define B_YP     WSB(bf16, 90 * MiB)
#define B_XT     WSB(bf16, 154 * MiB)
#define B_YB     WSB(bf16, 154 * MiB)
#define B_HID    WSB(bf16, 170 * MiB)
#define B_Q      WSB(bf16, 186 * MiB)
#define B_ETOK   WSB(int, 192 * MiB)
#define B_EW     WSB(float, 196 * MiB)
#define B_KF     WSB(bf16, 210 * MiB)
#define B_VT     WSB(bf16, 234 * MiB)
#define B_COS    WSB(float, 250 * MiB)
#define B_SIN    WSB(float, 251 * MiB)
#define B_RTE    WSB(int, 250 * MiB)
#define B_RTS    WSB(int, 250 * MiB + 256 * 1024)
#define B_RTW    WSB(float, 250 * MiB + 512 * 1024)
#define B_TOKROW WSB(int, 250 * MiB + 768 * 1024)
#define B_ROWW   WSB(float, 251 * MiB)
#define B_SSQ    WSB(float, 252 * MiB)
#define B_SSQS   WSB(float, 253 * MiB)
#define B_PREV   OUTB(bf16, 0)
#define B_CQN    OUTB(bf16, 32 * MiB)
#define B_CKVN   OUTB(bf16, 40 * MiB)
#define LDS_TP   ((int*)(lds_raw + 131072 + 1024))

__global__ void __launch_bounds__(NT, 2) mega_fwd(Params P) {
    if (threadIdx.x < 2) ((volatile LAS unsigned*)(lds_raw + WTAB_OFF - 16))[threadIdx.x] = 0u;
    tidx_init();
    float* lds = (float*)lds_raw;
    const XcdBarrier bar = xcd_barrier_post((unsigned*)(kargs()->ws + 16384), (volatile LAS unsigned*)(lds_raw + WTAB_OFF - 16));
#define GSYNC() xcd_barrier(bar)
    ph_prep(lds, B_MOD, B_WIN, B_WOUT, B_WUQ, B_WUKV, B_WRT, B_WGU, B_WD);
    GSYNC();
    ph_prenorm_bf16(IN(0), IN(5), B_MOD, 0 * D, 1 * D, B_HB);
    GSYNC();
    { pg8::Gemm g{B_HB, B_WIN, M, NU, D}; pg8::StaticOrder S; S.init(M, NU, gridDim.x, (int)blockIdx.x);
      pg8::EpiBf16<0> E{B_U, NU};
      pg8::gemm_phase<pg8::EpiBf16<0>, pg8::StaticOrder, true, true>((PG8_LAS unsigned char*)lds_raw, g, S, E); }
    GSYNC();
    ph_prep2(B_U, kargs()->pos, IN(10), IN(11), IN(12), B_CQN, B_CKVN, B_KF, B_COS, B_SIN, B_DT, B_XT);
    GSYNC();
    {
      const int G = gridDim.x, bid = blockIdx.x; const bool split = G >= 128;
      if (!split || bid < 64) { for (int it = bid; it < 64; it += (split ? 64 : G)) ssd::state_sweep((SLAS char*)lds_raw, it >> 3, it & 7, B_XT, B_DT, IN(13), B_ACS2, B_PREV); }
      if (!split || bid >= 64) { const int Gg = split ? G - 64 : G, cg_ = split ? bid - 64 : bid;
        { pg8::Gemm g{B_CQN, B_WUQ, M, 768, QR}; pg8::StaticOrder S; S.init(M, 768, Gg, cg_);
          pg8::EpiQ E{B_Q, B_COS, B_SIN};
          pg8::gemm_phase<pg8::EpiQ, pg8::StaticOrder, true, false>((PG8_LAS unsigned char*)lds_raw, g, S, E); }
        { pg8::Gemm g{B_CKVN, B_WUKV, M, 1024, 256}; pg8::StaticOrder S; S.init(M, 1024, Gg, cg_);
          pg8::EpiKV E{B_KF, B_VT};
          pg8::gemm_phase<pg8::EpiKV, pg8::StaticOrder, true, false>((PG8_LAS unsigned char*)lds_raw, g, S, E); }
        ph_prep_moe(B_WGU, B_WD, cg_ * (NT / 64) + (tidx() >> 6), Gg * (NT / 64), 0, split ? MOE_SPLIT : 0); } }
    GSYNC();
    att::attn_phase((ALAS char*)lds_raw, B_Q, B_KF, B_VT, B_YC, B_SSQ);
    { const int G = gridDim.x, bid = blockIdx.x; const int vcu = (G % 8 == 0) ? (bid % 8) * (G / 8) + bid / 8 : bid;
      for (int u = vcu; u < 256; u += G) ssd::chunk_unit((SLAS char*)lds_raw, u >> 5, (u >> 1) & 15, u & 1, B_XT, B_PREV, B_DT, B_ACS2, IN(14), B_U, B_YC, B_SSQS); }
    GSYNC();
    for (int u0 = blockIdx.x; u0 < (M / 256) * (D / 256); u0 += gridDim.x) {
        pg8::StaticOrder S1; S1.init(M, D, (M / 256) * (D / 256), u0); pg8::Unit uu; S1.next(0, uu);
        PG8_LAS float* RS = (PG8_LAS float*)(lds_raw + 131072 + 4096);
        { const int tid = tidx(); __syncthreads();
          if (tid < 256) { const size_t row = (size_t)uu.pm * 256 + tid; float ss = 0.f, sm = 0.f;
#pragma unroll
              for (int q = 0; q < 4; ++q) { const f32x4v a = *(const f32x4v*)(B_SSQS + row * 16 + 4 * q); ss += (a.x + a.y) + (a.z + a.w); }
              { const f32x4v a = *(const f32x4v*)(B_SSQ + row * 16 + 8), b = *(const f32x4v*)(B_SSQ + row * 16 + 12); sm = (a.x + a.y) + (a.z + a.w) + (b.x + b.y) + (b.z + b.w); }
              const float rs = rsqrtf(ss * (1.f / 512.f) + EPS), rm = rsqrtf(sm * (1.f / 512.f) + EPS);
              RS[2 * tid] = rs / rm; RS[2 * tid + 1] = rm; }
          __syncthreads(); }
        pg8::Gemm g{B_YC, B_WOUT, M, D, D}; pg8::StaticOrder S; S.init(M, D, (M / 256) * (D / 256), u0);
        struct OneUnit { pg8::StaticOrder s; __device__ __forceinline__ bool next(int i, pg8::Unit& u) const { return i == 0 ? s.next(0, u) : false; }
                         __device__ __forceinline__ void a_ready(const pg8::Unit&) const {} __device__ __forceinline__ void done(const pg8::Unit&) const {} } OU{S};
        pg8::EpiBf16RowScale E{B_YB, D, RS}; pg8::MidRowScale MDs{RS};
        pg8::gemm_phase<pg8::EpiBf16RowScale, OneUnit, true, true, pg8::MidRowScale>((PG8_LAS unsigned char*)lds_raw, g, OU, E, MDs);
    }
    GSYNC();
    ph_rowrouter((__attribute__((address_space(3))) float*)lds_raw, B_YB, IN(0), IN(6), IN(7), B_MOD, B_WRT, IN(23), IN(25), kargs()->out, B_H2, B_CNT, B_RTE, B_RTS, B_ETOK, B_EW);
    GSYNC();
    moe_table(LDS_TP, B_CNT);
    ph_gather_tiles(LDS_TP, B_CNT, B_H2, B_ETOK, B_EW, B_HG, B_ROWW);
    { pg8::Gemm g{B_HG, B_WGU, 0, 0, D}; pg8::OwnTileOrder S{(const PG8_LAS int*)LDS_TP, 2, (int)gridDim.x, (int)blockIdx.x};
      pg8::EpiGU E{B_HID, B_ROWW};
      pg8::gemm_phase<pg8::EpiGU, pg8::OwnTileOrder, true, true>((PG8_LAS unsigned char*)lds_raw, g, S, E); }
    GSYNC();
    { pg8::Gemm g{B_HID, B_WD, 0, 0, FF}; pg8::GroupedOrder S{(const PG8_LAS int*)LDS_TP, 4, (int)gridDim.x, (int)blockIdx.x};
      pg8::EpiDown E{B_YP};
      pg8::gemm_phase<pg8::EpiDown, pg8::GroupedOrder, true, true>((PG8_LAS unsigned char*)lds_raw, g, S, E); }
    GSYNC();
    ph_moe_final(B_YP, LDS_TP, B_RTE, B_RTS, IN(8), B_MOD, kargs()->out);
}

extern "C" void kernel_launch(void* const* d_in, const int* in_sizes, int n_in, void* d_out, int out_size, void* d_ws, size_t ws_size,
                              hipStream_t stream) {
    static int grid_blocks = 0;
    if (!grid_blocks) {
        int dev = 0, cus = 0, per_cu = 0;
        (void)hipGetDevice(&dev);
        (void)hipDeviceGetAttribute(&cus, hipDeviceAttributeMultiprocessorCount, dev);
        (void)hipFuncSetAttribute((const void*)mega_fwd, hipFuncAttributeMaxDynamicSharedMemorySize, LDS_BYTES);
        (void)hipOccupancyMaxActiveBlocksPerMultiprocessor(&per_cu, (const void*)mega_fwd, NT, LDS_BYTES);
        if (per_cu < 1) { fprintf(stderr, "occupancy query returned %d\n", per_cu); per_cu = 1; }
        grid_blocks = cus * per_cu;
    }
    (void)hipMemsetAsync(d_ws, 0, 65536, stream);
    Params p{};
    for (int i = 0; i < 29; ++i) p.in[i] = (const float*)d_in[i];
    p.pos = (const int*)d_in[2];
    p.out = (float*)d_out;
    p.ws = (char*)d_ws;
    void* args[] = {&p};
    hipError_t e = hipLaunchCooperativeKernel((void*)mega_fwd, dim3(grid_blocks), dim3(NT), args, LDS_BYTES, stream);
    if (e != hipSuccess) fprintf(stderr, "cooperative launch failed: %s (grid %d)\n", hipGetErrorString(e), grid_blocks);
}
```

```cpp
#include <hip/hip_runtime.h>
#include <hip/hip_cooperative_groups.h>
#include <stdint.h>
#include <math.h>
#include <cstdio>
namespace cg = cooperative_groups;

constexpr int D = 1024, NB = 8, SEQ = 2048, M = NB * SEQ;
constexpr int SSD_H = 8, SSD_P = 64, SSD_INNER = 512, SSD_G = 2, SSD_N = 128, SSD_XBC = 1024;
constexpr int MLA_H = 8, NOPE = 64, ROPE = 32, QK = 96, VD = 64, QR = 256, KVR = 128;
constexpr int NIN = 1960;
constexpr int NU = 2048;
constexpr int OFF_Z = 0, OFF_XBC = 512, OFF_CQ = 1536, OFF_CKV = 1792, OFF_KR = 1920, OFF_DT = 1952;
constexpr int NEXP = 32, FF = 256;
constexpr float EPS = 1e-6f;
constexpr int MOE_ITEMS = 32 * 16 * 8 + 32 * 4 * 16;
constexpr int MOE_SPLIT = 2560;
constexpr int NT = 512;
constexpr int LDS_BYTES = 160 * 1024;

typedef unsigned short bf16;
__device__ __forceinline__ float bf2f(bf16 v) { return __uint_as_float((unsigned)v << 16); }
__device__ __forceinline__ unsigned f2bf(float f) { unsigned u = __float_as_uint(f); return (u + 0x7fffu + ((u >> 16) & 1u)) >> 16; }
__device__ __forceinline__ unsigned pk2(float lo, float hi) { return f2bf(lo) | (f2bf(hi) << 16); }
typedef unsigned v4u __attribute__((ext_vector_type(4)));
typedef float f32x4v __attribute__((ext_vector_type(4)));

struct Params {
    const float* in[29];
    const int* pos;
    float* out;
    char* ws;
};

#define RLAS __attribute__((address_space(3)))
__device__ __forceinline__ float dpp_f(float v, int ctrl_sel) {
    const int x = __float_as_int(v); int r;
    if (ctrl_sel == 0) r = __builtin_amdgcn_update_dpp(0, x, 0xB1, 0xF, 0xF, true);
    else if (ctrl_sel == 1) r = __builtin_amdgcn_update_dpp(0, x, 0x1B, 0xF, 0xF, true);
    else if (ctrl_sel == 2) r = __builtin_amdgcn_update_dpp(0, x, 0x141, 0xF, 0xF, true);
    else r = __builtin_amdgcn_update_dpp(0, x, 0x140, 0xF, 0xF, true);
    return __int_as_float(r);
}
__device__ __forceinline__ float wave_sum_valu(float v) {
    v += dpp_f(v, 0); v += dpp_f(v, 1); v += dpp_f(v, 2); v += dpp_f(v, 3);
    { auto rr = __builtin_amdgcn_permlane16_swap(__float_as_uint(v), __float_as_uint(v), false, false); v = __uint_as_float(rr[0]) + __uint_as_float(rr[1]); }
    { auto rr = __builtin_amdgcn_permlane32_swap(__float_as_uint(v), __float_as_uint(v), false, false); v = __uint_as_float(rr[0]) + __uint_as_float(rr[1]); }
    return v;
}
__device__ __forceinline__ float ldf(const float* p) { return *p; }
__device__ __forceinline__ float ldf(const bf16* p) { return bf2f(*p); }
extern __shared__ __attribute__((aligned(16))) unsigned char lds_raw[];
constexpr int WTAB_OFF = 160 * 1024 - 256;
__device__ __forceinline__ int hw_wave_key() { int k; asm volatile("s_getreg_b32 %0, hwreg(HW_REG_HW_ID, 0, 6)" : "=s"(k)); return k; }
__device__ __forceinline__ void tidx_init() { const int key = hw_wave_key(); ((volatile __attribute__((address_space(3))) int*)(lds_raw + WTAB_OFF))[key] = (int)(threadIdx.x >> 6); __syncthreads(); }
__device__ __forceinline__ int tidx() {
    const int key = hw_wave_key();
    int w = ((volatile __attribute__((address_space(3))) int*)(lds_raw + WTAB_OFF))[key];
    w = __builtin_amdgcn_readfirstlane(w);
    unsigned ones = ~0u; asm volatile("" : "+s"(ones));
    int t = w * 64 + (int)__builtin_amdgcn_mbcnt_hi(ones, __builtin_amdgcn_mbcnt_lo(ones, 0u));
    asm volatile("" : "+v"(t)); return t; }
typedef const __attribute__((address_space(4))) Params* KArgs;
__device__ __forceinline__ KArgs kargs() { KArgs p = (KArgs)__builtin_amdgcn_kernarg_segment_ptr(); asm volatile("" : "+s"(p)); return p; }
#define IN(i) (kargs()->in[i])
__device__ __forceinline__ float silu_f(float v) { return v / (1.f + expf(-v)); }
__device__ __forceinline__ float wave_sum(float v) {
#pragma unroll
    for (int o = 32; o > 0; o >>= 1) v += __shfl_xor(v, o);
    return v;
}

namespace pg8 {
#define PG8_LAS __attribute__((address_space(3)))
typedef unsigned short bf16_t;
typedef short bf16x8 __attribute__((ext_vector_type(8)));
typedef float f32x4 __attribute__((ext_vector_type(4)));
typedef unsigned u32x4 __attribute__((ext_vector_type(4)));
constexpr int BM = 256, BK = 64, HALF = 128, HTB = HALF * BK * 2  , STAGE_BYTES = 8 * HTB, NXCD = 8, WGM = 8;

__host__ __device__ __forceinline__ int lds_byte(int r, int c) { const int st = (r >> 4) * 2 + (c >> 5), rr = r & 15, cc = c & 31, ob = rr * 64 + cc * 2; return st * 1024 + (ob ^ (((ob >> 9) & 1) << 5)); }
__host__ __device__ __forceinline__ void stage_rc(int b, int& R, int& C) { const int st = b / 1024, sb = b % 1024, swz = sb ^ (((sb >> 9) & 1) << 5); R = (st >> 1) * 16 + swz / 64; C = (st & 1) * 32 + (swz % 64) / 2; }
__host__ __device__ __forceinline__ int perm32(int rho) { const int n = rho >> 4, i = rho & 15; return 8 * (i >> 2) + 4 * n + (i & 3); }

struct Unit { int pm, pn; };
struct Gemm { const bf16_t* A; const bf16_t* Bt; int M, N, K; };

struct StaticOrder {
    int nM, nN, nwg, G, c;
    __host__ __device__ void init(int M, int N, int G_, int c_) { nM = M / BM; nN = N / BM; nwg = nM * nN; G = G_; c = c_; }
    __host__ __device__ bool next(int i, Unit& u) const {
        const long L = (long)i * G + c; if (L >= nwg) return false;
        int wgid = (int)L; { const int q = nwg / NXCD, r = nwg % NXCD, xcd = wgid % NXCD, off = wgid / NXCD; wgid = (xcd < r ? xcd * (q + 1) : r * (q + 1) + (xcd - r) * q) + off; }
        const int nig = WGM * nN, gid = wgid / nig, fm = gid * WGM, gsz = (nM - fm) < WGM ? (nM - fm) : WGM;
        u.pm = fm + ((wgid % nig) % gsz); u.pn = (wgid % nig) / gsz; return true;
    }
    __device__ __forceinline__ void a_ready(const Unit&) const {}
    __device__ __forceinline__ void done(const Unit&) const {}
};


template <int ACT> struct EpiBf16 {
    static constexpr bool PERM = true, AFTER_DRAIN = false;
    bf16_t* O; int ldc;
    __device__ __forceinline__ void operator()(const f32x4 (&acc)[2][2][4][2], const Unit& u, int wr, int wc, int fr, int fq) const {
        { const int l_ = tidx() & 63; fr = l_ & 15; fq = l_ >> 4; }
        const int row0 = u.pm * BM + wr * 64 + fr; const int col0 = u.pn * BM + wc * 32 + 8 * fq;
#pragma unroll
        for (int ai = 0; ai < 2; ++ai)
#pragma unroll
            for (int m = 0; m < 4; ++m) { bf16_t* rowp = O + (size_t)(row0 + ai * HALF + m * 16) * ldc + col0;
#pragma unroll
                for (int bj = 0; bj < 2; ++bj) { const f32x4 v0 = acc[ai][bj][m][0], v1 = acc[ai][bj][m][1];
                    u32x4 w; w.x = pk2(v0[0], v0[1]); w.y = pk2(v0[2], v0[3]); w.z = pk2(v1[0], v1[1]); w.w = pk2(v1[2], v1[3]);
                    *(u32x4*)(rowp + bj * HALF) = w; } }
    }
};

struct EpiQ {
    static constexpr bool PERM = true, AFTER_DRAIN = false;
    bf16_t* Q; const float* COS; const float* SIN;
    __device__ __forceinline__ void operator()(const f32x4 (&acc)[2][2][4][2], const Unit& u, int wr, int wc, int fr, int fq) const {
        { const int l_ = tidx() & 63; fr = l_ & 15; fq = l_ >> 4; }
        const int row0 = u.pm * BM + wr * 64 + fr;
#pragma unroll
        for (int bj = 0; bj < 2; ++bj) {
            const int colg = u.pn * BM + bj * HALF + wc * 32;
            const bool pe = ((colg >> 5) % 3) == 2;
#pragma unroll
            for (int ai = 0; ai < 2; ++ai)
#pragma unroll
                for (int m = 0; m < 4; ++m) {
                    const int row = row0 + ai * HALF + m * 16;
                    f32x4 v0 = acc[ai][bj][m][0], v1 = acc[ai][bj][m][1];
                    if (pe) {
                        f32x4 w0, w1;
#pragma unroll
                        for (int e = 0; e < 4; ++e) { w0[e] = __shfl_xor(v0[e], 32); w1[e] = __shfl_xor(v1[e], 32); }
                        const f32x4* cp = (const f32x4*)(COS + (size_t)row * 16 + (fq & 1) * 8); const f32x4* sp = (const f32x4*)(SIN + (size_t)row * 16 + (fq & 1) * 8);
                        const f32x4 c0 = cp[0], c1 = cp[1], s0 = sp[0], s1 = sp[1];
                        const float sg = (fq < 2) ? -1.f : 1.f;
                        v0 = v0 * c0 + w0 * s0 * sg; v1 = v1 * c1 + w1 * s1 * sg;
                    }
                    u32x4 w; w.x = pk2(v0[0], v0[1]); w.y = pk2(v0[2], v0[3]); w.z = pk2(v1[0], v1[1]); w.w = pk2(v1[2], v1[3]);
                    *(u32x4*)(Q + (size_t)row * 768 + colg + 8 * fq) = w;
                    if (pe) asm volatile("" ::: "memory");
                }
        }
    }
};
struct EpiKV {
    static constexpr bool PERM = true, AFTER_DRAIN = false;
    bf16_t* KF; bf16_t* VT;
    __device__ __forceinline__ void operator()(const f32x4 (&acc)[2][2][4][2], const Unit& u, int wr, int wc, int fr, int fq) const {
        { const int l_ = tidx() & 63; fr = l_ & 15; fq = l_ >> 4; }
        const int row0 = u.pm * BM + wr * 64 + fr;
#pragma unroll
        for (int bj = 0; bj < 2; ++bj) {
            const int colg = u.pn * BM + bj * HALF + wc * 32; const int h = colg >> 7, j0 = (colg & 127) + 8 * fq;
#pragma unroll
            for (int ai = 0; ai < 2; ++ai)
#pragma unroll
                for (int m = 0; m < 4; ++m) {
                    const int t = row0 + ai * HALF + m * 16; const int b = t >> 11, sq = t & 2047, tile = sq >> 6, key = sq & 63;
                    const size_t base = (size_t)((b * 8 + h) * 32 + tile);
                    bf16_t* dst = (j0 < 64) ? KF + base * 6144 + (j0 >> 3) * 512 + key * 8 : VT + base * 4096 + ((j0 - 64) >> 5) * 2048 + key * 32 + ((j0 - 64) & 31);
                    const f32x4 v0 = acc[ai][bj][m][0], v1 = acc[ai][bj][m][1];
                    u32x4 w; w.x = pk2(v0[0], v0[1]); w.y = pk2(v0[2], v0[3]); w.z = pk2(v1[0], v1[1]); w.w = pk2(v1[2], v1[3]);
                    *(u32x4*)dst = w;
                }
        }
    }
};

struct GroupedOrder {
    const PG8_LAS int* tp; int NCT, G, c;
    __device__ __forceinline__ bool next(int i, Unit& u) const {
        const int L = i * G + c, total = tp[32] * NCT; if (L >= total) return false;
        const int rtg = L / NCT, ct = L - rtg * NCT; int e = 0;
        for (int j = 1; j < 32; ++j) e += (tp[j] <= rtg) ? 1 : 0;
        u.pm = rtg; u.pn = e * NCT + ct; return true;
    }
    __device__ __forceinline__ void a_ready(const Unit&) const {}
    __device__ __forceinline__ void done(const Unit&) const {}
};
struct OwnTileOrder {
    const PG8_LAS int* tp; int NCT, G, c;
    __device__ __forceinline__ bool next(int i, Unit& u) const {
        const int rtg = c + (i / NCT) * G, ct = i % NCT; if (rtg >= tp[32]) return false;
        int e = 0;
        for (int j = 1; j < 32; ++j) e += (tp[j] <= rtg) ? 1 : 0;
        u.pm = rtg; u.pn = e * NCT + ct; return true;
    }
    __device__ __forceinline__ void a_ready(const Unit&) const {}
    __device__ __forceinline__ void done(const Unit&) const {}
};
struct EpiGU {
    static constexpr bool PERM = true, AFTER_DRAIN = false;
    bf16_t* HID; const float* ROWW;
    __device__ __forceinline__ void operator()(const f32x4 (&acc)[2][2][4][2], const Unit& u, int wr, int wc, int fr, int fq) const {
        { const int l_ = tidx() & 63; fr = l_ & 15; fq = l_ >> 4; }
        const int row0 = u.pm * BM + wr * 64 + fr; const int col0 = (u.pn & 1) * 128 + wc * 32 + 8 * fq;
#pragma unroll
        for (int ai = 0; ai < 2; ++ai)
#pragma unroll
            for (int m = 0; m < 4; ++m) { const int row = row0 + ai * HALF + m * 16; const float w = ROWW[row];
                float hv[8];
#pragma unroll
                for (int n = 0; n < 2; ++n)
#pragma unroll
                    for (int e = 0; e < 4; ++e) { const float g = acc[ai][0][m][n][e], up = acc[ai][1][m][n][e]; hv[4 * n + e] = g * __builtin_amdgcn_rcpf(1.f + __expf(-g)) * up * w; }
                u32x4 o; o.x = pk2(hv[0], hv[1]); o.y = pk2(hv[2], hv[3]); o.z = pk2(hv[4], hv[5]); o.w = pk2(hv[6], hv[7]);
                *(u32x4*)(HID + (size_t)row * 256 + col0) = o; }
    }
};
struct EpiDown {
    static constexpr bool PERM = true, AFTER_DRAIN = false;
    bf16_t* YP;
    __device__ __forceinline__ void operator()(const f32x4 (&acc)[2][2][4][2], const Unit& u, int wr, int wc, int fr, int fq) const {
        { const int l_ = tidx() & 63; fr = l_ & 15; fq = l_ >> 4; }
        const int row0 = u.pm * BM + wr * 64 + fr; const int col0 = (u.pn & 3) * BM + wc * 32 + 8 * fq;
#pragma unroll
        for (int ai = 0; ai < 2; ++ai)
#pragma unroll
            for (int m = 0; m < 4; ++m) { bf16_t* rowp = YP + (size_t)(row0 + ai * HALF + m * 16) * 1024 + col0;
#pragma unroll
                for (int bj = 0; bj < 2; ++bj) { const f32x4 v0 = acc[ai][bj][m][0], v1 = acc[ai][bj][m][1];
                    u32x4 w; w.x = pk2(v0[0], v0[1]); w.y = pk2(v0[2], v0[3]); w.z = pk2(v1[0], v1[1]); w.w = pk2(v1[2], v1[3]);
                    *(u32x4*)(rowp + bj * HALF) = w; } }
    }
};
struct NoMid { static constexpr bool ON = false; __device__ __forceinline__ void operator()(f32x4 (&)[2][2][4][2], int, int) const {} };
template <class Epi, class Sched, bool ALIGN_EPI = false, bool SP2 = false, class Mid = NoMid>
__device__ __forceinline__ void gemm_phase(PG8_LAS unsigned char* lds, const Gemm g, const Sched& S, const Epi& E, const Mid& MD = Mid()) {
    const int tid = tidx(), wid = __builtin_amdgcn_readfirstlane(tid >> 6), lane = tid & 63, wr = wid >> 2, wc = wid & 3, fr = lane & 15, fq = lane >> 4;
    const int K = g.K, nt = K / BK;
    unsigned voffA[2], voffB[2];
#pragma unroll
    for (int i = 0; i < 2; ++i) { int R, C; stage_rc(tid * 16 + i * 8192, R, C); const int Rb = Epi::PERM ? ((R & ~31) + perm32(R & 31)) : R;
        voffA[i] = (unsigned)(R * K + C) * 2u; voffB[i] = (unsigned)(Rb * K + C) * 2u; }
    const size_t kstep = (size_t)(BK * 2);
    const size_t hstep = (size_t)HALF * K * 2;
    const size_t tstep = 2 * hstep;
    const unsigned ldsw = (unsigned)wid * 1024u;
    const int aoff = lds_byte(wr * 64 + fr, fq * 8), boff = lds_byte(wc * 32 + fr, fq * 8);
#define PG8_SA(b, h) (((b) * 2 + (h)) * HTB)
#define PG8_SB(b, h) ((4 + (b) * 2 + (h)) * HTB)
#define PG8_STAGE(bufoff, gbase, voff) do { _Pragma("unroll") for (int _i = 0; _i < 2; ++_i) \
        __builtin_amdgcn_global_load_lds((const unsigned*)((const char*)(gbase) + (voff)[_i]), (PG8_LAS unsigned*)(lds + (bufoff) + ldsw + _i * 8192), 16, 0, 0); } while (0)
#define PG8_LDA(dst, b, h) do { _Pragma("unroll") for (int m = 0; m < 4; ++m) _Pragma("unroll") for (int k = 0; k < 2; ++k) dst[m][k] = *(const PG8_LAS bf16x8*)(lds + PG8_SA(b, h) + aoff + m * 2048 + k * 1024); } while (0)
#define PG8_LDB(dst, b, h) do { _Pragma("unroll") for (int n = 0; n < 2; ++n) _Pragma("unroll") for (int k = 0; k < 2; ++k) dst[n][k] = *(const PG8_LAS bf16x8*)(lds + PG8_SB(b, h) + boff + n * 2048 + k * 1024); } while (0)
#define PG8_MMA(ai, bj, At, Bt) do { __builtin_amdgcn_s_setprio(1); _Pragma("unroll") for (int m = 0; m < 4; ++m) _Pragma("unroll") for (int n = 0; n < 2; ++n) _Pragma("unroll") for (int k = 0; k < 2; ++k) \
        acc[ai][bj][m][n] = __builtin_amdgcn_mfma_f32_16x16x32_bf16(Bt[n][k], At[m][k], acc[ai][bj][m][n], 0, 0, 0); __builtin_amdgcn_s_setprio(0); } while (0)
#define PG8_WAIT_V(n) asm volatile("s_waitcnt vmcnt(" #n ")" ::: "memory")
#define PG8_WAIT_L(n) asm volatile("s_waitcnt lgkmcnt(" #n ")" ::: "memory")
#define PG8_BAR __builtin_amdgcn_s_barrier()
#define PG8_SCHED __builtin_amdgcn_sched_barrier(0)
    Unit cur, nxt; int ui = 0;
    if (!S.next(0, cur)) return;
    f32x4 acc[2][2][4][2];
#pragma unroll
    for (int a = 0; a < 2; ++a)
#pragma unroll
        for (int b = 0; b < 2; ++b)
#pragma unroll
            for (int m = 0; m < 4; ++m)
#pragma unroll
                for (int n = 0; n < 2; ++n) acc[a][b][m][n] = (f32x4){0.f, 0.f, 0.f, 0.f};
    bf16x8 At[4][2], B0[2][2], B1[2][2];
    const char* cA = (const char*)g.A + (size_t)cur.pm * tstep; const char* cB = (const char*)g.Bt + (size_t)cur.pn * tstep;
    S.a_ready(cur);
    if constexpr (SP2) {
        PG8_STAGE(PG8_SB(0, 0), cB, voffB); PG8_STAGE(PG8_SB(0, 1), cB + hstep, voffB); PG8_STAGE(PG8_SA(0, 0), cA, voffA); PG8_STAGE(PG8_SA(0, 1), cA + hstep, voffA);
        if (wr == 1) PG8_BAR;
        PG8_WAIT_V(2); PG8_BAR;
        PG8_STAGE(PG8_SB(1, 0), cB + kstep, voffB); PG8_STAGE(PG8_SA(1, 0), cA + kstep, voffA); PG8_STAGE(PG8_SB(1, 1), cB + hstep + kstep, voffB);
        PG8_WAIT_V(6); PG8_BAR;
    } else {
        PG8_STAGE(PG8_SB(0, 0), cB, voffB); PG8_STAGE(PG8_SA(0, 0), cA, voffA); PG8_STAGE(PG8_SB(0, 1), cB + hstep, voffB); PG8_STAGE(PG8_SA(0, 1), cA + hstep, voffA);
        if (wr == 1) PG8_BAR;
        PG8_WAIT_V(4); PG8_BAR;
        PG8_STAGE(PG8_SB(1, 0), cB + kstep, voffB); PG8_STAGE(PG8_SA(1, 0), cA + kstep, voffA); PG8_STAGE(PG8_SB(1, 1), cB + hstep + kstep, voffB);
        PG8_WAIT_V(6); PG8_BAR;
    }
    for (;;) {
        const bool has_next = S.next(ui + 1, nxt);
        const char* nA = has_next ? (const char*)g.A + (size_t)nxt.pm * tstep : cA; const char* nB = has_next ? (const char*)g.Bt + (size_t)nxt.pn * tstep : cB;
        for (int t = 0; t < nt; t += 2) {
            if constexpr (Mid::ON) { if (t == Mid::T) MD(acc, wr, tidx() & 15); }
            const bool last = (t == nt - 2);
            const char* a1 = cA + (size_t)(t + 1) * kstep;
            const char* a2 = last ? nA : cA + (size_t)(t + 2) * kstep; const char* b2 = last ? nB : cB + (size_t)(t + 2) * kstep;
            const char* a3 = a2 + kstep; const char* b3 = b2 + kstep;
            if (last && has_next) S.a_ready(nxt);
            if constexpr (SP2) {
            PG8_LDB(B0, 0, 0); PG8_LDB(B1, 0, 1); PG8_SCHED; PG8_LDA(At, 0, 0); PG8_STAGE(PG8_SA(1, 1), a1 + hstep, voffA);
            PG8_WAIT_V(8); PG8_WAIT_L(0); PG8_BAR; PG8_MMA(0, 0, At, B0); PG8_MMA(0, 1, At, B1); PG8_BAR; PG8_SCHED;
            PG8_LDA(At, 0, 1); PG8_STAGE(PG8_SB(0, 0), b2, voffB); PG8_STAGE(PG8_SB(0, 1), b2 + hstep, voffB); PG8_STAGE(PG8_SA(0, 0), a2, voffA);
            PG8_WAIT_V(8); PG8_WAIT_L(0); PG8_BAR; PG8_MMA(1, 0, At, B0); PG8_MMA(1, 1, At, B1); PG8_BAR; PG8_SCHED;
            PG8_LDB(B0, 1, 0); PG8_LDB(B1, 1, 1); PG8_SCHED; PG8_LDA(At, 1, 0); PG8_STAGE(PG8_SA(0, 1), a2 + hstep, voffA);
            PG8_WAIT_V(8); PG8_WAIT_L(0); PG8_BAR; PG8_MMA(0, 0, At, B0); PG8_MMA(0, 1, At, B1); PG8_BAR; PG8_SCHED;
            PG8_LDA(At, 1, 1); PG8_STAGE(PG8_SB(1, 0), b3, voffB); PG8_STAGE(PG8_SB(1, 1), b3 + hstep, voffB); PG8_STAGE(PG8_SA(1, 0), a3, voffA);
            PG8_WAIT_V(8); PG8_WAIT_L(0); PG8_BAR; PG8_MMA(1, 0, At, B0); PG8_MMA(1, 1, At, B1); PG8_BAR; PG8_SCHED;
            } else {
            PG8_LDB(B0, 0, 0); PG8_SCHED; PG8_LDA(At, 0, 0); PG8_STAGE(PG8_SA(1, 1), a1 + hstep, voffA);
            PG8_WAIT_L(8); PG8_BAR; PG8_WAIT_L(0); PG8_MMA(0, 0, At, B0); PG8_BAR; PG8_SCHED;
            PG8_LDB(B1, 0, 1); PG8_STAGE(PG8_SB(0, 0), b2, voffB);
            PG8_BAR; PG8_WAIT_L(0); PG8_MMA(0, 1, At, B1); PG8_BAR;
            PG8_LDA(At, 0, 1); PG8_STAGE(PG8_SA(0, 0), a2, voffA);
            PG8_BAR; PG8_WAIT_L(0); PG8_MMA(1, 0, At, B0); PG8_BAR; PG8_SCHED;
            PG8_STAGE(PG8_SB(0, 1), b2 + hstep, voffB);
            PG8_WAIT_V(6); PG8_BAR; PG8_MMA(1, 1, At, B1); PG8_BAR;
            PG8_LDB(B0, 1, 0); PG8_SCHED; PG8_LDA(At, 1, 0); PG8_STAGE(PG8_SA(0, 1), a2 + hstep, voffA);
            PG8_WAIT_L(8); PG8_BAR; PG8_WAIT_L(0); PG8_MMA(0, 0, At, B0); PG8_BAR; PG8_SCHED;
            PG8_LDB(B1, 1, 1); PG8_STAGE(PG8_SB(1, 0), b3, voffB);
            PG8_BAR; PG8_WAIT_L(0); PG8_MMA(0, 1, At, B1); PG8_BAR;
            PG8_LDA(At, 1, 1); PG8_STAGE(PG8_SA(1, 0), a3, voffA);
            PG8_BAR; PG8_WAIT_L(0); PG8_MMA(1, 0, At, B0); PG8_BAR; PG8_SCHED;
            PG8_STAGE(PG8_SB(1, 1), b3 + hstep, voffB);
            PG8_WAIT_V(6); PG8_BAR; PG8_MMA(1, 1, At, B1); PG8_BAR;
            }
        }
        if constexpr (ALIGN_EPI) { if (wr == 0) PG8_BAR; }
        if constexpr (!Epi::AFTER_DRAIN) { E(acc, cur, wr, wc, fr, fq); S.done(cur); }
        if (!has_next) break;
#pragma unroll
        for (int a = 0; a < 2; ++a)
#pragma unroll
            for (int b = 0; b < 2; ++b)
#pragma unroll
                for (int m = 0; m < 4; ++m)
#pragma unroll
                    for (int n = 0; n < 2; ++n) acc[a][b][m][n] = (f32x4){0.f, 0.f, 0.f, 0.f};
        cur = nxt; cA = nA; cB = nB; ++ui;
        if constexpr (ALIGN_EPI) { if (wr == 1) PG8_BAR; }
    }
    PG8_WAIT_V(0);
    if constexpr (!ALIGN_EPI) { if (wr == 0) PG8_BAR; }
    PG8_BAR;
    if constexpr (Epi::AFTER_DRAIN) { E.fused(acc, cur, wr, wc, fr, fq, lds, wid, lane); S.done(cur); }
#undef PG8_SA
#undef PG8_SB
#undef PG8_STAGE
#undef PG8_LDA
#undef PG8_LDB
#undef PG8_MMA
#undef PG8_WAIT_V
#undef PG8_WAIT_L
#undef PG8_BAR
#undef PG8_SCHED
}

struct MidRowScale { static constexpr bool ON = true; static constexpr int T = 8;
    const PG8_LAS float* RS;
    __device__ __forceinline__ void operator()(f32x4 (&acc)[2][2][4][2], int wr, int fr) const {
#pragma unroll
        for (int ai = 0; ai < 2; ++ai)
#pragma unroll
            for (int m = 0; m < 4; ++m) { const float f = RS[(ai * HALF + wr * 64 + m * 16 + fr) * 2];
#pragma unroll
                for (int bj = 0; bj < 2; ++bj)
#pragma unroll
                    for (int n = 0; n < 2; ++n) acc[ai][bj][m][n] = acc[ai][bj][m][n] * f; }
    }
};
struct EpiBf16RowScale {
    static constexpr bool PERM = true, AFTER_DRAIN = false;
    bf16_t* O; int ldc; const PG8_LAS float* RS;
    __device__ __forceinline__ void operator()(const f32x4 (&acc)[2][2][4][2], const Unit& u, int wr, int wc, int fr, int fq) const {
        { const int l_ = tidx() & 63; fr = l_ & 15; fq = l_ >> 4; }
        const int row0 = u.pm * BM + wr * 64 + fr; const int col0 = u.pn * BM + wc * 32 + 8 * fq;
#pragma unroll
        for (int ai = 0; ai < 2; ++ai)
#pragma unroll
            for (int m = 0; m < 4; ++m) { bf16_t* rowp = O + (size_t)(row0 + ai * HALF + m * 16) * ldc + col0; const float f = RS[(ai * HALF + wr * 64 + m * 16 + fr) * 2 + 1];
#pragma unroll
                for (int bj = 0; bj < 2; ++bj) { const f32x4 v0 = acc[ai][bj][m][0] * f, v1 = acc[ai][bj][m][1] * f;
                    u32x4 w; w.x = pk2(v0[0], v0[1]); w.y = pk2(v0[2], v0[3]); w.z = pk2(v1[0], v1[1]); w.w = pk2(v1[2], v1[3]);
                    *(u32x4*)(rowp + bj * HALF) = w; } }
    }
};
}


template <class GainFn>
__device__ __forceinline__ void transpose_tile(const float* src, int ldsrc, int srccol0  , GainFn gain, bf16* dst, int K, int k0, int n0, int lane) {
    const int r = lane >> 4, c = lane & 15;
    f32x4v v[16];
    if (srccol0 >= 0) {
#pragma unroll
        for (int i = 0; i < 16; ++i) v[i] = __builtin_nontemporal_load((const f32x4v*)(src + (size_t)(k0 + 4 * i + r) * ldsrc + srccol0 + 4 * c));
    } else {
#pragma unroll
        for (int i = 0; i < 16; ++i) v[i] = (f32x4v){0.f, 0.f, 0.f, 0.f};
    }
    unsigned pk[16][2];
#pragma unroll
    for (int i = 0; i < 16; ++i) {
        unsigned a0 = __float_as_uint(v[i].x), a1 = __float_as_uint(v[i].y), a2 = __float_as_uint(v[i].z), a3 = __float_as_uint(v[i].w);
        { auto t = __builtin_amdgcn_permlane32_swap(a0, a2, false, false); a0 = t[0]; a2 = t[1]; }
        { auto t = __builtin_amdgcn_permlane32_swap(a1, a3, false, false); a1 = t[0]; a3 = t[1]; }
        { auto t = __builtin_amdgcn_permlane16_swap(a0, a1, false, false); a0 = t[0]; a1 = t[1]; }
        { auto t = __builtin_amdgcn_permlane16_swap(a2, a3, false, false); a2 = t[0]; a3 = t[1]; }
        const f32x4v g = gain(k0 + 4 * i);
        pk[i][0] = pk2(__uint_as_float(a0) * g.x, __uint_as_float(a1) * g.y); pk[i][1] = pk2(__uint_as_float(a2) * g.z, __uint_as_float(a3) * g.w);
    }
    bf16* drow = dst + (size_t)(n0 + 4 * c + r) * K + k0;
#pragma unroll
    for (int i = 0; i < 8; ++i) *(v4u*)(drow + 8 * i) = (v4u){pk[2 * i][0], pk[2 * i][1], pk[2 * i + 1][0], pk[2 * i + 1][1]};
}
__device__ __forceinline__ int win_col(int n) {
    if (n < 1536) return n;
    if (n < 1792) return n - 1536 + 1544;
    if (n < 1920) return n - 1792 + 1800;
    if (n < 1952) return n - 1920 + 1928;
    if (n < 1960) return n - 1952 + 1536;
    return -1;
}
template <class GainFn>
__device__ __forceinline__ void transpose_tile_win(const float* src, GainFn gain, bf16* dst, int k0, int n0, int lane) {
    const int r = lane >> 4, c = lane & 15; const int sc = win_col(n0 + 4 * c);
    f32x4v v[16];
#pragma unroll
    for (int i = 0; i < 16; ++i) v[i] = (sc >= 0) ? *(const f32x4v*)(src + (size_t)(k0 + 4 * i + r) * NIN + sc) : (f32x4v){0.f, 0.f, 0.f, 0.f};
    unsigned pk[16][2];
#pragma unroll
    for (int i = 0; i < 16; ++i) {
        unsigned a0 = __float_as_uint(v[i].x), a1 = __float_as_uint(v[i].y), a2 = __float_as_uint(v[i].z), a3 = __float_as_uint(v[i].w);
        { auto t = __builtin_amdgcn_permlane32_swap(a0, a2, false, false); a0 = t[0]; a2 = t[1]; }
        { auto t = __builtin_amdgcn_permlane32_swap(a1, a3, false, false); a1 = t[0]; a3 = t[1]; }
        { auto t = __builtin_amdgcn_permlane16_swap(a0, a1, false, false); a0 = t[0]; a1 = t[1]; }
        { auto t = __builtin_amdgcn_permlane16_swap(a2, a3, false, false); a2 = t[0]; a3 = t[1]; }
        pk[i][0] = pk2(__uint_as_float(a0), __uint_as_float(a1)); pk[i][1] = pk2(__uint_as_float(a2), __uint_as_float(a3));
    }
    bf16* drow = dst + (size_t)(n0 + 4 * c + r) * D + k0;
#pragma unroll
    for (int i = 0; i < 8; ++i) *(v4u*)(drow + 8 * i) = (v4u){pk[2 * i][0], pk[2 * i][1], pk[2 * i + 1][0], pk[2 * i + 1][1]};
}
__device__ void ph_prep(float* lds, float* mod, bf16* WIN_T, bf16* WOUT_T, bf16* WUQ_T, bf16* WUKV_T, float* WRT, bf16* WGU_T, bf16* WD_T) {
    const int tid = tidx(), lane = tid & 63, wave = tid >> 6;
    for (int item = blockIdx.x; item < 6 * D / 32; item += gridDim.x) {
        float* sc = lds;
        float* part = lds + 8 * D;
        const float* c = IN(1); const float* ada_w = IN(3); const float* ada_b = IN(4);
        __syncthreads();
        for (int i = tid; i < NB * D; i += NT) sc[i] = silu_f(c[i]);
        __syncthreads();
        const int kr = lane >> 3, cq = lane & 7; const int j0 = item * 32 + 4 * cq;
        f32x4v acc[NB];
#pragma unroll
        for (int b = 0; b < NB; ++b) acc[b] = (f32x4v){0.f, 0.f, 0.f, 0.f};
#pragma unroll 4
        for (int i = 0; i < 16; ++i) { const int k = wave * 128 + 8 * i + kr;
            const f32x4v w = *(const f32x4v*)(ada_w + (size_t)k * 6 * D + j0);
#pragma unroll
            for (int b = 0; b < NB; ++b) acc[b] += w * sc[b * D + k]; }
#pragma unroll
        for (int b = 0; b < NB; ++b) {
#pragma unroll
            for (int e = 0; e < 4; ++e) { float v = acc[b][e]; v += __shfl_xor(v, 8); v += __shfl_xor(v, 16); v += __shfl_xor(v, 32); acc[b][e] = v; } }
        if (lane < 8) {
#pragma unroll
            for (int b = 0; b < NB; ++b) *(f32x4v*)(part + (wave * NB + b) * 32 + 4 * lane) = acc[b]; }
        __syncthreads();
        if (tid < NB * 32) { const int b = tid >> 5, jj = tid & 31;
            float sm = ada_b[item * 32 + jj];
#pragma unroll
            for (int w = 0; w < 8; ++w) sm += part[(w * NB + b) * 32 + jj];
            mod[b * 6 * D + item * 32 + jj] = sm; }
    }
    __syncthreads();
    for (int i = blockIdx.x * NT + tid; i < 36 * D; i += gridDim.x * NT) { const int c = i >> 10, k = i & 1023;
        WRT[i] = (c < 4) ? IN(22)[k * 4 + c] : IN(24)[k * 32 + c - 4]; }
    const int gw = (gridDim.x - 1 - blockIdx.x) * (NT / 64) + wave, ngw = gridDim.x * (NT / 64);
    constexpr int I_IN = (D / 64) * (NU / 64), I_OUT = (D / 64) * (D / 64), I_UQ = (QR / 64) * (768 / 64), I_UKV = (256 / 64) * (1024 / 64);
    const float* ssd_norm = IN(15); const float* q_norm = IN(16); const float* kv_norm = IN(18); const float* mla_norm = IN(20);
    const auto one4 = [](int) { return (f32x4v){1.f, 1.f, 1.f, 1.f}; };
    constexpr int I_GU = NEXP * (D / 64) * (512 / 64);
    const int moe_lo = (gridDim.x >= 128) ? MOE_SPLIT : 0, n_moe = MOE_ITEMS - moe_lo;
    for (int it = gw; it < n_moe + I_IN + I_OUT + I_UQ + I_UKV; it += ngw) {
        int r = it;
        if (r < n_moe) { r += moe_lo;
            if (r < I_GU) { const int e = r >> 7, q = r & 127, kb = q >> 3, nb = q & 7;
                const int ct = nb >> 2, rr = (nb & 3) * 64; const float* src = (rr < 128 ? IN(26) : IN(27)) + (size_t)e * D * FF;
                transpose_tile(src, FF, 128 * ct + (rr & 127), one4, WGU_T + (size_t)e * 512 * D, D, kb * 64, nb * 64, lane); continue; }
            r -= I_GU;
            { const int e = r >> 6, q = r & 63, kb = q >> 4, nb = q & 15;
              transpose_tile(IN(28) + (size_t)e * FF * D, D, nb * 64, one4, WD_T + (size_t)e * D * FF, FF, kb * 64, nb * 64, lane); continue; } }
        r -= n_moe;
        if (r < I_IN) { const int nb = NU / 64; transpose_tile_win(IN(9), one4, WIN_T, (r / nb) * 64, (r % nb) * 64, lane); continue; }
        r -= I_IN;
        if (r < I_OUT) { const int nb = D / 64; transpose_tile(IN(21), D, (r % nb) * 64, [=](int k) { return k < 512 ? *(const f32x4v*)(ssd_norm + k) : *(const f32x4v*)(mla_norm + k - 512); }, WOUT_T, D, (r / nb) * 64, (r % nb) * 64, lane); continue; }
        r -= I_OUT;
        if (r < I_UQ) { const int nb = 768 / 64; transpose_tile(IN(17), 768, (r % nb) * 64, [=](int k) { return *(const f32x4v*)(q_norm + k) * 0.14724444f; }, WUQ_T, QR, (r / nb) * 64, (r % nb) * 64, lane); continue; }
        r -= I_UQ;
        { const int nb = 1024 / 64, kb = r / nb; transpose_tile(IN(19), 1024, kb < 2 ? (r % nb) * 64 : -1, [=](int k) { return k < KVR ? *(const f32x4v*)(kv_norm + k) : (f32x4v){0.f, 0.f, 0.f, 0.f}; }, WUKV_T, 256, kb * 64, (r % nb) * 64, lane); }
    }
}
__device__ void ph_prep_moe(bf16* WGU_T, bf16* WD_T, int rank, int nw, int it_lo, int it_hi) {
    const int lane = tidx() & 63; rank = __builtin_amdgcn_readfirstlane(rank);
    constexpr int I_GU = NEXP * (D / 64) * (512 / 64), I_DN = NEXP * (FF / 64) * (D / 64);
    const auto one4 = [](int) { return (f32x4v){1.f, 1.f, 1.f, 1.f}; };
    for (int it = it_lo + rank; it < it_hi; it += nw) {
        int r = it;
        if (r < I_GU) { const int e = r >> 7, q = r & 127, kb = q >> 3, nb = q & 7;
            const int ct = nb >> 2, rr = (nb & 3) * 64; const float* src = (rr < 128 ? IN(26) : IN(27)) + (size_t)e * D * FF;
            transpose_tile(src, FF, 128 * ct + (rr & 127), one4, WGU_T + (size_t)e * 512 * D, D, kb * 64, nb * 64, lane); continue; }
        r -= I_GU;
        { const int e = r >> 6, q = r & 63, kb = q >> 4, nb = q & 15;
          transpose_tile(IN(28) + (size_t)e * FF * D, D, nb * 64, one4, WD_T + (size_t)e * D * FF, FF, kb * 64, nb * 64, lane); }
    }
}

__device__ void ph_prenorm_bf16(const float* in, const float* g, const float* mod, int sh_off, int sc_off, bf16* out) {
    const int lane = tidx() & 63, gw = blockIdx.x * (NT / 64) + (tidx() >> 6), ngw = gridDim.x * (NT / 64);
    f32x4v nx[4];
    if (gw < M) { const f32x4v* r = (const f32x4v*)(in + (size_t)gw * D) + lane;
#pragma unroll
        for (int j = 0; j < 4; ++j) nx[j] = __builtin_nontemporal_load(r + 64 * j); }
    for (int t = gw; t < M; t += ngw) {
        const int b = t / SEQ;
        f32x4v v[4]; float s = 0.f;
#pragma unroll
        for (int j = 0; j < 4; ++j) { v[j] = nx[j]; s += (v[j].x * v[j].x + v[j].y * v[j].y) + (v[j].z * v[j].z + v[j].w * v[j].w); }
        if (t + ngw < M) { const f32x4v* r = (const f32x4v*)(in + (size_t)(t + ngw) * D) + lane;
#pragma unroll
            for (int j = 0; j < 4; ++j) nx[j] = __builtin_nontemporal_load(r + 64 * j); }
        const f32x4v* gp = (const f32x4v*)g + lane; const f32x4v* scp = (const f32x4v*)(mod + b * 6 * D + sc_off) + lane; const f32x4v* shp = (const f32x4v*)(mod + b * 6 * D + sh_off) + lane;
        f32x4v gg[4], sc[4], sh[4];
#pragma unroll
        for (int j = 0; j < 4; ++j) { gg[j] = gp[64 * j]; sc[j] = scp[64 * j]; sh[j] = shp[64 * j]; }
        const float inv = rsqrtf(wave_sum_valu(s) / D + EPS);
        unsigned long long* o8 = (unsigned long long*)(out + (size_t)t * D) + lane;
#pragma unroll
        for (int j = 0; j < 4; ++j) { const f32x4v h = v[j] * inv * gg[j] * (sc[j] + 1.f) + sh[j];
            o8[64 * j] = (unsigned long long)pk2(h.x, h.y) | ((unsigned long long)pk2(h.z, h.w) << 32); }
    }
}


__device__ void ph_prep2(const bf16* U, const int* pos, const float* conv_w, const float* conv_b, const float* dt_bias,
                         bf16* CQN, bf16* CKVN, bf16* KF, float* COS, float* SIN, float* DT, bf16* XC) {
    const int lane = tidx() & 63, gw = blockIdx.x * (NT / 64) + (tidx() >> 6), ngw = gridDim.x * (NT / 64);
    const int rows_per = (M + ngw - 1) / ngw;
    const int ch = lane * 16;
    f32x4v cw[4][4], cbv[4];
#pragma unroll
    for (int k = 0; k < 4; ++k)
#pragma unroll
        for (int q4 = 0; q4 < 4; ++q4) cw[k][q4] = *(const f32x4v*)(conv_w + k * SSD_XBC + ch + 4 * q4);
#pragma unroll
    for (int q4 = 0; q4 < 4; ++q4) cbv[q4] = *(const f32x4v*)(conv_b + ch + 4 * q4);
    const float inv_freq = exp2f(-(float)(lane & 15) * (13.287712379549449f / 16.0f));
    const float dtb = dt_bias[lane & 7];
    const int t_lo = gw * rows_per, t_hi = min((gw + 1) * rows_per, M);
    if (t_lo >= t_hi) return;
    v4u h0[2], h1[2], h2[2];
#define LDX(dst, tt_) do { if (((tt_) & (SEQ - 1)) <= (t_lo & (SEQ - 1)) && (tt_) >= 0 && ((tt_) >> 11) == (t_lo >> 11)) { const v4u* xp_ = (const v4u*)(U + (size_t)(tt_) * NU + OFF_XBC + ch); dst[0] = xp_[0]; dst[1] = xp_[1]; } \
                           else { dst[0] = (v4u){0u, 0u, 0u, 0u}; dst[1] = dst[0]; } } while (0)
    LDX(h0, t_lo - 3); LDX(h1, t_lo - 2); LDX(h2, t_lo - 1);
#undef LDX
    uint2 n_cq; unsigned n_ckv; unsigned short n_k1, n_k2, n_dt; v4u n_x[2]; int n_pos;
#define LDROW(tt_) do { const bf16* ur_ = U + (size_t)(tt_) * NU; n_cq = *(const uint2*)(ur_ + OFF_CQ + lane * 4); n_ckv = *(const unsigned*)(ur_ + OFF_CKV + lane * 2); \
        n_k1 = ur_[OFF_KR + (lane & 15)]; n_k2 = ur_[OFF_KR + 16 + (lane & 15)]; n_dt = ur_[OFF_DT + (lane & 7)]; const v4u* xp_ = (const v4u*)(ur_ + OFF_XBC + ch); n_x[0] = __builtin_nontemporal_load(xp_); n_x[1] = __builtin_nontemporal_load(xp_ + 1); n_pos = pos[tt_]; } while (0)
    LDROW(t_lo);
    for (int t = t_lo; t < t_hi; ++t) {
        const int sq = t & (SEQ - 1), b = t >> 11;
        const uint2 w_cq = n_cq; const unsigned w_ckv = n_ckv; const float x1 = bf2f(n_k1), x2 = bf2f(n_k2), dtr = bf2f(n_dt); const v4u cx0 = n_x[0], cx1 = n_x[1]; const int p_t = n_pos;
        if (t + 1 < t_hi) LDROW(t + 1);
        if (sq == 0) { h0[0] = (v4u){0u, 0u, 0u, 0u}; h0[1] = h0[0]; h1[0] = h0[0]; h1[1] = h0[0]; h2[0] = h0[0]; h2[1] = h0[0]; }
        { const float a0 = __uint_as_float(w_cq.x << 16), a1 = __uint_as_float(w_cq.x & 0xffff0000u), a2 = __uint_as_float(w_cq.y << 16), a3 = __uint_as_float(w_cq.y & 0xffff0000u);
          const float inv = rsqrtf(wave_sum_valu(a0 * a0 + a1 * a1 + a2 * a2 + a3 * a3) * (1.f / QR) + EPS);
          uint2 o; o.x = pk2(a0 * inv, a1 * inv); o.y = pk2(a2 * inv, a3 * inv);
          *(uint2*)(CQN + (size_t)t * QR + lane * 4) = o; }
        { const float a0 = __uint_as_float(w_ckv << 16), a1 = __uint_as_float(w_ckv & 0xffff0000u);
          const float inv = rsqrtf(wave_sum_valu(a0 * a0 + a1 * a1) * (1.f / KVR) + EPS);
          *(unsigned*)(CKVN + (size_t)t * 256 + lane * 2) = pk2(a0 * inv, a1 * inv);
          *(unsigned*)(CKVN + (size_t)t * 256 + 128 + lane * 2) = 0u; }
        { const int i = lane & 15;
          const float ang = (float)p_t * inv_freq;
          const float sn = __sinf(ang), cs = __cosf(ang);
          if (lane < 16) { COS[(size_t)t * 16 + i] = cs; SIN[(size_t)t * 16 + i] = sn; }
          const float r1 = x1 * cs - x2 * sn, r2 = x2 * cs + x1 * sn;
          const int cc = lane & 3, hh = (lane >> 2) & 7;
          float e[8];
#pragma unroll
          for (int j = 0; j < 8; ++j) { const float p1 = __shfl(r1, (cc & 1) * 8 + j), p2 = __shfl(r2, (cc & 1) * 8 + j); e[j] = (cc >> 1) ? p2 : p1; }
          if (lane < 32) { v4u o; o.x = pk2(e[0], e[1]); o.y = pk2(e[2], e[3]); o.z = pk2(e[4], e[5]); o.w = pk2(e[6], e[7]);
            *(v4u*)(KF + (size_t)((b * 8 + hh) * 32 + (sq >> 6)) * 6144 + (8 + cc) * 512 + (sq & 63) * 8) = o; } }
        if (lane < 8) { const float raw = dtr + dtb; DT[(size_t)t * 8 + lane] = raw > 20.f ? raw : log1pf(__expf(raw)); }
        { float acc[16];
#pragma unroll
          for (int q4 = 0; q4 < 4; ++q4) { acc[4 * q4] = cbv[q4].x; acc[4 * q4 + 1] = cbv[q4].y; acc[4 * q4 + 2] = cbv[q4].z; acc[4 * q4 + 3] = cbv[q4].w; }
#define TAP(k_, r_) do { const unsigned xw_[8] = {r_[0].x, r_[0].y, r_[0].z, r_[0].w, r_[1].x, r_[1].y, r_[1].z, r_[1].w}; \
              _Pragma("unroll") for (int q4 = 0; q4 < 4; ++q4) { const f32x4v ww_ = cw[k_][q4]; \
                  acc[4 * q4] += ww_.x * __uint_as_float(xw_[2 * q4] << 16); acc[4 * q4 + 1] += ww_.y * __uint_as_float(xw_[2 * q4] & 0xffff0000u); \
                  acc[4 * q4 + 2] += ww_.z * __uint_as_float(xw_[2 * q4 + 1] << 16); acc[4 * q4 + 3] += ww_.w * __uint_as_float(xw_[2 * q4 + 1] & 0xffff0000u); } } while (0)
          const v4u cur[2] = {cx0, cx1};
          TAP(0, h0); TAP(1, h1); TAP(2, h2); TAP(3, cur);
#undef TAP
          h0[0] = h1[0]; h0[1] = h1[1]; h1[0] = h2[0]; h1[1] = h2[1]; h2[0] = cx0; h2[1] = cx1;
#define SILU(v_) ((v_) * __builtin_amdgcn_rcpf(1.f + __expf(-(v_))))
          v4u o0, o1;
          o0.x = pk2(SILU(acc[0]), SILU(acc[1])); o0.y = pk2(SILU(acc[2]), SILU(acc[3])); o0.z = pk2(SILU(acc[4]), SILU(acc[5])); o0.w = pk2(SILU(acc[6]), SILU(acc[7]));
          o1.x = pk2(SILU(acc[8]), SILU(acc[9])); o1.y = pk2(SILU(acc[10]), SILU(acc[11])); o1.z = pk2(SILU(acc[12]), SILU(acc[13])); o1.w = pk2(SILU(acc[14]), SILU(acc[15]));
#undef SILU
          { bf16* base = XC + (size_t)(t >> 7) * 131072; const int l = t & 127;
            if (ch < 512) { v4u* op = (v4u*)(base + (ch >> 6) * 8192 + ((ch & 63) >> 5) * 4096 + l * 32 + (ch & 31)); op[0] = o0; op[1] = o1; }
            else { const int c2 = ch - 512; bf16* q = base + 65536 + (c2 >> 7) * 16384 + ((c2 & 127) >> 3) * 1024 + l * 8; *(v4u*)q = o0; *(v4u*)(q + 1024) = o1; } } }
    }
#undef LDROW
}


__device__ void ph_rowrouter(RLAS float* ldsf, const bf16* Yb, const float* x, const float* post_gain, const float* pre_gain, const float* mod, const float* WRT,
                             const float* bgr, const float* ber, float* out, bf16* H2, int* CNT, int* RT_E, int* RT_S, int* ETOK, float* EW) {
    const int tid = tidx(), lane = tid & 63, wave = tid >> 6;
    const int gw = blockIdx.x * (NT / 64) + wave, ngw = gridDim.x * (NT / 64);
    { const f32x4v* src = (const f32x4v*)WRT; RLAS f32x4v* dst = (RLAS f32x4v*)ldsf;
      for (int i = tid; i < 36 * 1024 / 4; i += NT) dst[i] = src[i]; }
    RLAS float* Lg = ldsf + 36 * 1024 + wave * 320;
    __syncthreads();
    const int b0 = lane & 1, b1 = (lane >> 1) & 1, b2 = (lane >> 2) & 1, b3 = (lane >> 3) & 1, b4 = (lane >> 4) & 1, b5 = lane >> 5;
    const int i4 = b0 + 2 * b1, i3 = i4 + 3 * b2, i2 = i3 + 5 * b3;
    const bool colok = (i4 <= 2) && (i3 <= 4) && (i2 <= 8); const int mycol = i2 + 9 * b4 + 18 * b5;
    const int rows_per = (M + ngw - 1) / ngw;
    for (int bi = 0; bi < (rows_per + 7) / 8; ++bi) {
        const int tb = gw * rows_per + 8 * bi; const int nr = max(0, min(8, min((gw + 1) * rows_per, M) - tb));
        uint2 ynx[4]; f32x4v xnx[4];
        if (nr > 0) { const uint2* yp0 = (const uint2*)(Yb + (size_t)tb * D) + lane; const f32x4v* xp0 = (const f32x4v*)(x + (size_t)tb * D) + lane;
#pragma unroll
            for (int j = 0; j < 4; ++j) { ynx[j] = yp0[64 * j]; xnx[j] = __builtin_nontemporal_load(xp0 + 64 * j); } }
        for (int ri = 0; ri < nr; ++ri) {
            const int t = tb + ri, b = t >> 11;
            f32x4v* op = (f32x4v*)(out + (size_t)t * D) + lane;
            f32x4v y[4], xv[4]; float ssy = 0.f;
#pragma unroll
            for (int j = 0; j < 4; ++j) { const uint2 w = ynx[j]; xv[j] = xnx[j];
                y[j].x = __uint_as_float(w.x << 16); y[j].y = __uint_as_float(w.x & 0xffff0000u); y[j].z = __uint_as_float(w.y << 16); y[j].w = __uint_as_float(w.y & 0xffff0000u);
                ssy += (y[j].x * y[j].x + y[j].y * y[j].y) + (y[j].z * y[j].z + y[j].w * y[j].w); }
            if (ri + 1 < nr) { const uint2* yp1 = (const uint2*)(Yb + (size_t)(t + 1) * D) + lane; const f32x4v* xp1 = (const f32x4v*)(x + (size_t)(t + 1) * D) + lane;
#pragma unroll
                for (int j = 0; j < 4; ++j) { ynx[j] = yp1[64 * j]; xnx[j] = __builtin_nontemporal_load(xp1 + 64 * j); } }
            const float invy = rsqrtf(wave_sum_valu(ssy) * (1.f / D) + EPS);
            const f32x4v* g1p = (const f32x4v*)(mod + b * 6 * D + 2 * D) + lane; const f32x4v* pgp = (const f32x4v*)post_gain + lane;
            float ss1 = 0.f;
#pragma unroll
            for (int j = 0; j < 4; ++j) { xv[j] = xv[j] + g1p[64 * j] * (y[j] * invy * pgp[64 * j]); op[64 * j] = xv[j];
                ss1 += (xv[j].x * xv[j].x + xv[j].y * xv[j].y) + (xv[j].z * xv[j].z + xv[j].w * xv[j].w); }
            const float inv1 = rsqrtf(wave_sum_valu(ss1) * (1.f / D) + EPS);
            const f32x4v* prp = (const f32x4v*)pre_gain + lane; const f32x4v* scp = (const f32x4v*)(mod + b * 6 * D + 4 * D) + lane; const f32x4v* shp = (const f32x4v*)(mod + b * 6 * D + 3 * D) + lane;
            uint2* hp = (uint2*)(H2 + (size_t)t * D) + lane;
#pragma unroll
            for (int j = 0; j < 4; ++j) { xv[j] = xv[j] * inv1 * prp[64 * j] * (scp[64 * j] + 1.f) + shp[64 * j];
                uint2 o; o.x = pk2(xv[j].x, xv[j].y); o.y = pk2(xv[j].z, xv[j].w); hp[64 * j] = o; }
            const RLAS f32x4v* wl = (const RLAS f32x4v*)ldsf + lane;
#define RDOT(c_) ({ const RLAS f32x4v* wc_ = wl + (c_) * 256; float a_ = 0.f; _Pragma("unroll") for (int j = 0; j < 4; ++j) { const f32x4v w_ = wc_[64 * j]; \
                a_ += (xv[j].x * w_.x + xv[j].y * w_.y) + (xv[j].z * w_.z + xv[j].w * w_.w); } a_; })
            float gl[4];
#pragma unroll
            for (int i = 0; i < 4; ++i) gl[i] = wave_sum_valu(RDOT(i)) + bgr[i];
            int gi = 0; float mxv = gl[0];
#pragma unroll
            for (int i = 1; i < 4; ++i) if (gl[i] > mxv) { mxv = gl[i]; gi = i; }
            gi = __builtin_amdgcn_readfirstlane(gi);
            float den = 0.f;
#pragma unroll
            for (int i = 0; i < 4; ++i) den += expf(gl[i] - mxv);
            float v1 = -INFINITY, v2 = -INFINITY; int i1 = 0, i2 = 0;
#pragma unroll
            for (int i = 0; i < 8; ++i) { const float v = wave_sum_valu(RDOT(4 + gi * 8 + i)) + ber[gi * 8 + i];
                if (v > v1) { v2 = v1; i2 = i1; v1 = v; i1 = i; } else if (v > v2) { v2 = v; i2 = i; } }
#undef RDOT
            const float p2 = expf(v2 - v1), gwt = 1.f / den;
            if (lane == 0) { Lg[ri * 40 + 0] = __int_as_float(gi * 8 + i1); Lg[ri * 40 + 1] = __int_as_float(gi * 8 + i2); Lg[ri * 40 + 2] = gwt / (1.f + p2); Lg[ri * 40 + 3] = gwt * p2 / (1.f + p2); }
        }
        asm volatile("s_waitcnt lgkmcnt(0)" ::: "memory");
        RLAS int* agg = (RLAS int*)(ldsf + 36 * 1024 + 8 * 320);
        if (tid < 32) agg[tid] = 0;
        __syncthreads();
        int e1 = 0, e2 = 0, r1 = 0, r2 = 0; float w1 = 0.f, w2 = 0.f;
        if (lane < nr) {
            const RLAS float* lr = Lg + lane * 40;
            e1 = __float_as_int(lr[0]); e2 = __float_as_int(lr[1]); w1 = lr[2]; w2 = lr[3];
            r1 = __hip_atomic_fetch_add(agg + e1, 1, __ATOMIC_RELAXED, __HIP_MEMORY_SCOPE_WORKGROUP);
            r2 = __hip_atomic_fetch_add(agg + e2, 1, __ATOMIC_RELAXED, __HIP_MEMORY_SCOPE_WORKGROUP);
        }
        __syncthreads();
        if (tid < 32) { const int c = agg[tid]; agg[32 + tid] = c ? atomicAdd(&CNT[tid * 64], c) : 0; }
        __syncthreads();
        if (lane < nr) { const int t = tb + lane;
            const int s1 = agg[32 + e1] + r1, s2 = agg[32 + e2] + r2;
            RT_E[t] = e1 | (e2 << 8); RT_S[2 * t] = s1; RT_S[2 * t + 1] = s2;
            ETOK[e1 * M + s1] = t; EW[e1 * M + s1] = w1; ETOK[e2 * M + s2] = t; EW[e2 * M + s2] = w2; }
        __syncthreads();
    }
    __syncthreads();
}
__device__ __forceinline__ void moe_table(int* tp, const int* CNT) {
    const int tid = tidx();
    __syncthreads();
    if (tid < 64) { const int c = (tid < 32) ? __hip_atomic_load(CNT + tid * 64, __ATOMIC_RELAXED, __HIP_MEMORY_SCOPE_AGENT) : 0; int v = (c + 255) >> 8;
        int inc = v;
#pragma unroll
        for (int o = 1; o < 64; o <<= 1) { const int n = __shfl_up(inc, o); if ((tid & 63) >= o) inc += n; }
        if (tid <= 32) tp[tid] = inc - v; }
    __syncthreads();
}
__device__ void ph_gather_tiles(const int* tp, const int* CNT, const bf16* H2, const int* ETOK, const float* EW, bf16* HG, float* ROWW) {
    const int lane = tidx() & 63, wave = tidx() >> 6;
    const int ntile = tp[32];
    for (int rtg = blockIdx.x; rtg < ntile; rtg += gridDim.x) {
        int e = 0;
        for (int j = 1; j < 32; ++j) e += (tp[j] <= rtg) ? 1 : 0;
        const int slot0 = (rtg - tp[e]) * 256, cnt = __hip_atomic_load(CNT + e * 64, __ATOMIC_RELAXED, __HIP_MEMORY_SCOPE_AGENT);
        const int myslot = slot0 + wave * 32 + (lane & 31); const bool ok = myslot < cnt;
        const int mytok = ok ? ETOK[e * M + myslot] : 0; const float myw = ok ? EW[e * M + myslot] : 0.f;
        if (lane < 32) ROWW[rtg * 256 + wave * 32 + lane] = myw;
        for (int i0 = 0; i0 < 32; i0 += 16) { v4u a[16], c[16];
#pragma unroll
            for (int i = 0; i < 16; ++i) { const int tok = __shfl(mytok, i0 + i); const v4u* src = (const v4u*)(H2 + (size_t)tok * D) + lane; a[i] = src[0]; c[i] = src[64]; }
#pragma unroll
            for (int i = 0; i < 16; ++i) { v4u* dst = (v4u*)(HG + (size_t)(rtg * 256 + wave * 32 + i0 + i) * D) + lane; dst[0] = a[i]; dst[64] = c[i]; } }
    }
    asm volatile("s_waitcnt vmcnt(0)" ::: "memory");
    __syncthreads();
}
__device__ void ph_moe_final(const bf16* YP, const int* tp, const int* RT_E, const int* RT_S, const float* gain, const float* mod, float* out) {
    const int lane = tidx() & 63, gw = blockIdx.x * (NT / 64) + (tidx() >> 6), ngw = gridDim.x * (NT / 64);
    v4u na[2], nc[2]; f32x4v nxa[2], nxb[2];
#define MF_LOAD(tt_) do { const int ee_ = RT_E[tt_]; const int r1_ = tp[ee_ & 255] * 256 + RT_S[2 * (tt_)], r2_ = tp[(ee_ >> 8) & 255] * 256 + RT_S[2 * (tt_) + 1]; \
        const v4u* p1_ = (const v4u*)(YP + (size_t)r1_ * D) + lane; const v4u* p2_ = (const v4u*)(YP + (size_t)r2_ * D) + lane; \
        _Pragma("unroll") for (int j = 0; j < 2; ++j) { na[j] = p1_[64 * j]; nc[j] = p2_[64 * j]; const float* op_ = out + (size_t)(tt_) * D + 512 * j + lane * 8; nxa[j] = *(const f32x4v*)op_; nxb[j] = *(const f32x4v*)(op_ + 4); } } while (0)
    if (gw < M) MF_LOAD(gw);
    for (int t = gw; t < M; t += ngw) { const int b = t >> 11;
        float y[16]; float ss = 0.f; f32x4v xa[2], xb[2];
#pragma unroll
        for (int j = 0; j < 2; ++j) { const v4u a = na[j], c = nc[j]; xa[j] = nxa[j]; xb[j] = nxb[j];
#pragma unroll
            for (int e = 0; e < 4; ++e) { const float v0 = __uint_as_float(a[e] << 16) + __uint_as_float(c[e] << 16), v1 = __uint_as_float(a[e] & 0xffff0000u) + __uint_as_float(c[e] & 0xffff0000u);
                y[8 * j + 2 * e] = v0; y[8 * j + 2 * e + 1] = v1; ss += v0 * v0 + v1 * v1; } }
        if (t + ngw < M) MF_LOAD(t + ngw);
        const float inv = rsqrtf(wave_sum_valu(ss) * (1.f / D) + EPS);
#pragma unroll
        for (int j = 0; j < 2; ++j) { const int col = 512 * j + lane * 8; float* op = out + (size_t)t * D + col;
            const f32x4v g2a = *(const f32x4v*)(mod + b * 6 * D + 5 * D + col), g2b = *(const f32x4v*)(mod + b * 6 * D + 5 * D + col + 4);
            const f32x4v ga = *(const f32x4v*)(gain + col), gb = *(const f32x4v*)(gain + col + 4);
            f32x4v a_ = xa[j], b_ = xb[j];
            a_.x += g2a.x * (y[8 * j + 0] * inv * ga.x); a_.y += g2a.y * (y[8 * j + 1] * inv * ga.y); a_.z += g2a.z * (y[8 * j + 2] * inv * ga.z); a_.w += g2a.w * (y[8 * j + 3] * inv * ga.w);
            b_.x += g2b.x * (y[8 * j + 4] * inv * gb.x); b_.y += g2b.y * (y[8 * j + 5] * inv * gb.y); b_.z += g2b.z * (y[8 * j + 6] * inv * gb.z); b_.w += g2b.w * (y[8 * j + 7] * inv * gb.w);
            *(f32x4v*)op = a_; *(f32x4v*)(op + 4) = b_; }
    }
#undef MF_LOAD
}
__device__ void ph_attn_ref(const bf16* Q, const bf16* KF, const bf16* VT, float* o) {
    const int lane = tidx() & 63, gw = blockIdx.x * (NT / 64) + (tidx() >> 6), ngw = gridDim.x * (NT / 64);
    for (int item = gw; item < NB * MLA_H * (SEQ / 64); item += ngw) {
        const int qb = (SEQ / 64 - 1) - item / (NB * MLA_H), bh = item % (NB * MLA_H), b = bh / MLA_H, h = bh % MLA_H;
        const int qi = qb * 64 + lane;
        const size_t t = (size_t)b * SEQ + qi;
        float qr[QK];
#pragma unroll
        for (int d = 0; d < QK; ++d) qr[d] = bf2f(Q[t * 768 + h * QK + d]);
        float acc[VD];
#pragma unroll
        for (int d = 0; d < VD; ++d) acc[d] = 0.f;
        float mx = -INFINITY, l = 0.f;
        const int kmax = qb * 64 + 63;
        for (int k = 0; k <= kmax; ++k) {
            const bf16* kt = KF + (size_t)(bh * 32 + (k >> 6)) * 6144 + (k & 63) * 8;
            const bf16* vt = VT + (size_t)(bh * 32 + (k >> 6)) * 4096 + (k & 63) * 32;
            float s = 0.f;
#pragma unroll
            for (int d = 0; d < QK; ++d) s += qr[d] * bf2f(kt[(d >> 3) * 512 + (d & 7)]);
            if (k <= qi) {
                const float mn = fmaxf(mx, s);
                const float f = exp2f(mx - mn), pv = exp2f(s - mn);
                l = l * f + pv;
#pragma unroll
                for (int d = 0; d < VD; ++d) acc[d] = acc[d] * f + pv * bf2f(vt[(d >> 5) * 2048 + (d & 31)]);
                mx = mn;
            }
        }
        const float il = 1.f / l;
#pragma unroll
        for (int d = 0; d < VD; ++d) o[t * (MLA_H * VD) + h * VD + d] = acc[d] * il;
    }
}

__device__ __forceinline__ void glds16(const void* gsrc, unsigned lds_dst) { unsigned keep;
    asm volatile("s_mov_b32 %0, m0\n\ts_mov_b32 m0, %2\n\ts_nop 0\n\tglobal_load_lds_dwordx4 %1, off\n\ts_mov_b32 m0, %0" : "=&s"(keep) : "v"(gsrc), "s"(lds_dst) : "memory"); }
namespace att {
typedef short bf16x8 __attribute__((ext_vector_type(8)));
typedef short s16x4 __attribute__((ext_vector_type(4)));
typedef float f32x16 __attribute__((ext_vector_type(16)));
typedef unsigned u32x4 __attribute__((ext_vector_type(4)));
#define ALAS __attribute__((address_space(3)))
constexpr int KSLOT = 12288, VSLOT = 8192, NSLOT = 4, NSLOTV = 4;
constexpr int LDS_K = 0, LDS_V = NSLOT * KSLOT, LDS_WS = LDS_V + NSLOTV * VSLOT, LDS_OST = LDS_WS + 8 * 256, LDS_END = LDS_OST + 8 * 4096;
constexpr float THR = 8.0f;
__device__ __forceinline__ int crow(int r, int hi) { return (r & 3) + 8 * (r >> 2) + 4 * hi; }
__device__ __forceinline__ unsigned cvtpk(float lo, float hi) { typedef float f2 __attribute__((ext_vector_type(2))); typedef __bf16 b2 __attribute__((ext_vector_type(2)));
    f2 v = {lo, hi}; b2 b = __builtin_convertvector(v, b2); return __builtin_bit_cast(unsigned, b); }
__device__ __forceinline__ s16x4 vtr(const ALAS char* p) { typedef short v4 __attribute__((ext_vector_type(4))); return __builtin_bit_cast(s16x4, __builtin_amdgcn_ds_read_tr16_b64_v4i16((ALAS v4*)p)); }
#define AWAIT_BAR(N) asm volatile("s_waitcnt vmcnt(" #N ") lgkmcnt(0)\n\ts_barrier" ::: "memory")

__device__ __forceinline__ void attn_unit(ALAS char* lds, int bh, int qb, const bf16* Q, const bf16* KF, const bf16* VT, bf16* YC, float* SSQ) {
    const int tid = tidx(), lane = tid & 63, r32 = lane & 31, hi = lane >> 5; const int wid = __builtin_amdgcn_readfirstlane(tid >> 6);
    const int b = bh >> 3, h = bh & 7;
    const char* Kt = (const char*)(KF + (size_t)bh * 32 * 6144); const char* Vt = (const char*)(VT + (size_t)bh * 32 * 4096);
    const int NTL = 4 * (qb + 1);
    bf16x8 qf[6];
    { const bf16* qp = Q + (size_t)(b * SEQ + qb * 256 + wid * 32 + r32) * 768 + h * QK + hi * 8;
#pragma unroll
      for (int d0 = 0; d0 < 6; ++d0) qf[d0] = *(const bf16x8*)(qp + d0 * 16); }
    const unsigned koff0 = wid * 1024 + lane * 16, koff1 = (8 + (wid & 3)) * 1024 + lane * 16, voff = wid * 1024 + lane * 16;
    const unsigned lds0 = (unsigned)(uintptr_t)lds;
#define ADMA_K(t, ks_) do { const char* kb_ = Kt + (size_t)(t) * KSLOT; \
        glds16(kb_ + koff0, (unsigned)__builtin_amdgcn_readfirstlane(lds0 + LDS_K + (ks_) * KSLOT + wid * 1024)); \
        glds16(kb_ + koff1, (unsigned)__builtin_amdgcn_readfirstlane(lds0 + LDS_K + (ks_) * KSLOT + (8 + (wid & 3)) * 1024)); } while (0)
#define ADMA_V(t, vs_) do { const char* vb_ = Vt + (size_t)(t) * VSLOT; \
        glds16(vb_ + voff, (unsigned)__builtin_amdgcn_readfirstlane(lds0 + LDS_V + (vs_) * VSLOT + wid * 1024)); } while (0)
#define KLOAD(ks_) do { const ALAS char* Ks_ = lds + LDS_K + (ks_) * KSLOT + hi * 1024 + r32 * 16; \
        _Pragma("unroll") for (int d0 = 0; d0 < 3; ++d0) { kf[2 * d0] = *(const ALAS bf16x8*)(Ks_ + d0 * 2048); kf[2 * d0 + 1] = *(const ALAS bf16x8*)(Ks_ + d0 * 2048 + 512); } } while (0)
    ADMA_K(0, 0); ADMA_V(0, 0); ADMA_K(1, 1); ADMA_V(1, 1); ADMA_K(2, 2);
    ALAS float* wsf = (ALAS float*)(lds + LDS_WS) + wid * 64;
    float mref = 0.f, l = 0.f;
    f32x16 o0 = {}, o1 = {}, negm = {};
    const int qrel = wid * 32 + r32;
    const int vlane = (4 * hi + ((lane & 15) >> 2)) * 64 + ((lane >> 4) & 1) * 32 + (lane & 3) * 8;
    bf16x8 kf[6];
    AWAIT_BAR(6);
    KLOAD(0);
    int kslot = 0, vslot = 0;
    u32x4 pw0 = {}, pw1 = {}, pw2 = {}, pw3 = {};
    bool pend = false;
#define MX3(a, b, c) __builtin_fmaxf(__builtin_fmaxf((a), (b)), (c))
#define EX2(v) __builtin_amdgcn_exp2f(v)
#define SCALE_PW(PW, f_) do { _Pragma("unroll") for (int e_ = 0; e_ < 4; ++e_) PW[e_] = cvtpk(__uint_as_float(PW[e_] << 16) * (f_), __uint_as_float(PW[e_] & 0xffff0000u) * (f_)); } while (0)
#define PV_STEP(PW, ks, Vs) do { const bf16x8 pa_ = __builtin_bit_cast(bf16x8, PW); \
            { const s16x4 a_ = vtr(Vs + (ks) * 1024), b_ = vtr(Vs + (ks) * 1024 + 512); const bf16x8 vf_ = {a_[0], a_[1], a_[2], a_[3], b_[0], b_[1], b_[2], b_[3]}; \
              o0 = __builtin_amdgcn_mfma_f32_32x32x16_bf16(pa_, vf_, o0, 0, 0, 0); } \
            { const s16x4 a_ = vtr(Vs + 4096 + (ks) * 1024), b_ = vtr(Vs + 4096 + (ks) * 1024 + 512); const bf16x8 vf_ = {a_[0], a_[1], a_[2], a_[3], b_[0], b_[1], b_[2], b_[3]}; \
              o1 = __builtin_amdgcn_mfma_f32_32x32x16_bf16(pa_, vf_, o1, 0, 0, 0); } } while (0)
#define ATT_TILE(MASKED) do { \
          \
        if (t <= 1) { AWAIT_BAR(3); } else if (t + 3 < NTL) { AWAIT_BAR(4); } else { AWAIT_BAR(0); }     \
        if (t + 3 < NTL) ADMA_K(t + 3, (kslot + 3) & 3);                                   \
        if (t + 2 < NTL) ADMA_V(t + 2, (vslot + 2) & 3); \
        const ALAS char* Vp = lds + LDS_V + ((vslot + 3) & 3) * VSLOT + vlane;            \
        if (MASKED && 64 * (t - (NTL - 4)) > 32 * wid + 31) {                               \
            if (pend) { PV_STEP(pw0, 0, Vp); PV_STEP(pw1, 1, Vp); PV_STEP(pw2, 2, Vp); PV_STEP(pw3, 3, Vp); pend = false; } \
            kslot = (kslot + 1) & 3; vslot = (vslot + 1) & 3; break; } \
        f32x16 p0 = negm, p1 = negm; \
        { const ALAS char* Kc_ = lds + LDS_K + kslot * KSLOT + hi * 1024 + r32 * 16; \
          bf16x8 kg_[6]; \
          _Pragma("unroll") for (int d0 = 3; d0 < 6; ++d0) { kg_[2 * (d0 - 3)] = *(const ALAS bf16x8*)(Kc_ + d0 * 2048); kg_[2 * (d0 - 3) + 1] = *(const ALAS bf16x8*)(Kc_ + d0 * 2048 + 512); } \
          _Pragma("unroll") for (int d0 = 0; d0 < 3; ++d0) { \
            p0 = __builtin_amdgcn_mfma_f32_32x32x16_bf16(kf[2 * d0], qf[d0], p0, 0, 0, 0); \
            p1 = __builtin_amdgcn_mfma_f32_32x32x16_bf16(kf[2 * d0 + 1], qf[d0], p1, 0, 0, 0); } \
          _Pragma("unroll") for (int d0 = 3; d0 < 6; ++d0) { \
            p0 = __builtin_amdgcn_mfma_f32_32x32x16_bf16(kg_[2 * (d0 - 3)], qf[d0], p0, 0, 0, 0); \
            p1 = __builtin_amdgcn_mfma_f32_32x32x16_bf16(kg_[2 * (d0 - 3) + 1], qf[d0], p1, 0, 0, 0); } } \
        if (t + 1 < NTL) { KLOAD((kslot + 1) & 3); }                                       \
        if (MASKED) { const int jb = t - (NTL - 4); \
            _Pragma("unroll") for (int r = 0; r < 16; ++r) { const int kv = 64 * jb + crow(r, hi); if (kv > qrel) p0[r] = -INFINITY; if (kv + 32 > qrel) p1[r] = -INFINITY; } } \
        float rm; { float a_ = MX3(p0[0], p0[1], p1[0]), b_ = MX3(p0[2], p0[3], p1[1]); a_ = MX3(a_, p1[2], p1[3]); \
            _Pragma("unroll") for (int r = 4; r < 16; r += 4) { a_ = MX3(a_, p0[r], p0[r + 1]); b_ = MX3(b_, p0[r + 2], p0[r + 3]); a_ = MX3(a_, p1[r], p1[r + 1]); b_ = MX3(b_, p1[r + 2], p1[r + 3]); } \
            rm = fmaxf(a_, b_); } \
        { auto rr = __builtin_amdgcn_permlane32_swap(__float_as_uint(rm), __float_as_uint(rm), false, false); rm = fmaxf(__uint_as_float(rr[0]), __uint_as_float(rr[1])); } \
        if (t == 0 || __any(rm > THR)) { \
            const float dl = (t == 0) ? rm : fmaxf(rm, 0.f); \
            mref += dl; \
            _Pragma("unroll") for (int r = 0; r < 16; ++r) { p0[r] -= dl; p1[r] -= dl; } \
            _Pragma("unroll") for (int r = 0; r < 16; ++r) negm[r] = -mref; \
            const float f = EX2(-dl); l *= f; \
            if (t > 0) { \
                SCALE_PW(pw0, f); SCALE_PW(pw1, f); SCALE_PW(pw2, f); SCALE_PW(pw3, f);       \
                if (hi == 0) wsf[r32] = f; \
                asm volatile("s_waitcnt lgkmcnt(0)" ::: "memory"); \
                _Pragma("unroll") for (int r = 0; r < 16; ++r) { const float fr_ = wsf[crow(r, hi)]; o0[r] *= fr_; o1[r] *= fr_; } } } \
        if (pend) { PV_STEP(pw0, 0, Vp); PV_STEP(pw1, 1, Vp); PV_STEP(pw2, 2, Vp); PV_STEP(pw3, 3, Vp); } \
        pend = true; \
        float ls0 = 0.f, ls1 = 0.f; \
        _Pragma("unroll") for (int r = 0; r < 16; ++r) { p0[r] = EX2(p0[r]); p1[r] = EX2(p1[r]); ls0 += p0[r]; ls1 += p1[r]; } \
        l += ls0 + ls1; \
        pw0 = (u32x4){cvtpk(p0[0], p0[1]), cvtpk(p0[2], p0[3]), cvtpk(p0[4], p0[5]), cvtpk(p0[6], p0[7])}; \
        pw1 = (u32x4){cvtpk(p0[8], p0[9]), cvtpk(p0[10], p0[11]), cvtpk(p0[12], p0[13]), cvtpk(p0[14], p0[15])}; \
        pw2 = (u32x4){cvtpk(p1[0], p1[1]), cvtpk(p1[2], p1[3]), cvtpk(p1[4], p1[5]), cvtpk(p1[6], p1[7])}; \
        pw3 = (u32x4){cvtpk(p1[8], p1[9]), cvtpk(p1[10], p1[11]), cvtpk(p1[12], p1[13]), cvtpk(p1[14], p1[15])}; \
        kslot = (kslot + 1) & 3; vslot = (vslot + 1) & 3; } while (0)
    int t = 0;
    for (; t < NTL - 4; ++t) ATT_TILE(false);
    for (; t < NTL; ++t) ATT_TILE(true);
    if (pend) { const ALAS char* Vp = lds + LDS_V + ((vslot + 3) & 3) * VSLOT + vlane;
      PV_STEP(pw0, 0, Vp); PV_STEP(pw1, 1, Vp); PV_STEP(pw2, 2, Vp); PV_STEP(pw3, 3, Vp); }
#undef PV_STEP
#undef ATT_TILE
#undef SCALE_PW
#undef MX3
#undef EX2
#undef KLOAD
#undef ADMA_K
#undef ADMA_V
    { auto rr = __builtin_amdgcn_permlane32_swap(__float_as_uint(l), __float_as_uint(l), false, false); l = __uint_as_float(rr[0]) + __uint_as_float(rr[1]); }
    if (hi == 0) wsf[32 + r32] = l;
    asm volatile("s_waitcnt lgkmcnt(0)" ::: "memory");
    ALAS bf16* stg = (ALAS bf16*)(lds + LDS_OST) + wid * 2048;
#pragma unroll
    for (int r = 0; r < 16; ++r) { const int orow = crow(r, hi); const float rl = 1.f / wsf[32 + orow];
        stg[orow * 64 + r32] = (bf16)f2bf(o0[r] * rl); stg[orow * 64 + 32 + r32] = (bf16)f2bf(o1[r] * rl); }
    asm volatile("s_waitcnt lgkmcnt(0)" ::: "memory");
    const size_t trow0 = (size_t)b * SEQ + qb * 256 + wid * 32;
#pragma unroll
    for (int i = 0; i < 4; ++i) { const int row = i * 8 + (lane >> 3), ch = lane & 7;
        const u32x4 v = *(const ALAS u32x4*)(stg + row * 64 + ch * 8);
        *(u32x4*)(YC + (trow0 + row) * 1024 + 512 + h * 64 + ch * 8) = v;
        float sq = 0.f;
#pragma unroll
        for (int e = 0; e < 4; ++e) { const float a = __uint_as_float(v[e] << 16), c = __uint_as_float(v[e] & 0xffff0000u); sq += a * a + c * c; }
        sq += __shfl_xor(sq, 1); sq += __shfl_xor(sq, 2); sq += __shfl_xor(sq, 4);
        if (ch == 0) SSQ[(trow0 + row) * 16 + 8 + h] = sq; }
    asm volatile("s_waitcnt lgkmcnt(0)\n\ts_barrier" ::: "memory");
}
__device__ __forceinline__ void attn_phase(ALAS char* lds, const bf16* Q, const bf16* KF, const bf16* VT, bf16* YC, float* SSQ) {
    const int G = gridDim.x, bid = blockIdx.x; const int vcu = (G % 8 == 0) ? (bid % 8) * (G / 8) + bid / 8 : bid;
    for (int p = vcu; p < 256; p += G) { const int bh = p >> 2, s = p & 3;
        attn_unit(lds, bh, 7 - s, Q, KF, VT, YC, SSQ);
        attn_unit(lds, bh, s, Q, KF, VT, YC, SSQ); }
}
#undef AWAIT_BAR
}
__device__ void ph_prenorm(const float* in, const float* g, const float* mod, int sh_off, int sc_off, float* out) {
    const int lane = tidx() & 63, gw = blockIdx.x * (NT / 64) + (tidx() >> 6), ngw = gridDim.x * (NT / 64);
    for (int t = gw; t < M; t += ngw) {
        const int b = t / SEQ; const float* r = in + (size_t)t * D;
        float s = 0.f;
        for (int i = lane; i < D; i += 64) s += r[i] * r[i];
        const float inv = rsqrtf(wave_sum(s) / D + EPS);
        for (int i = lane; i < D; i += 64)
            out[(size_t)t * D + i] = r[i] * inv * g[i] * (1.f + mod[b * 6 * D + sc_off + i]) + mod[b * 6 * D + sh_off + i];
    }
}
template <class TY> __device__ void ph_post(const float* base, const TY* y, const float* g, const float* mod, int gate_off, float* out) {
    const int lane = tidx() & 63, gw = blockIdx.x * (NT / 64) + (tidx() >> 6), ngw = gridDim.x * (NT / 64);
    for (int t = gw; t < M; t += ngw) {
        const int b = t / SEQ; const TY* r = y + (size_t)t * D;
        float s = 0.f;
        for (int i = lane; i < D; i += 64) { const float v = ldf(r + i); s += v * v; }
        const float inv = rsqrtf(wave_sum(s) / D + EPS);
        for (int i = lane; i < D; i += 64)
            out[(size_t)t * D + i] = base[(size_t)t * D + i] + mod[b * 6 * D + gate_off + i] * (ldf(r + i) * inv * g[i]);
    }
}
template <class TI> __device__ void ph_rms_slice(const TI* in, int ldi, int off, int n, const float* g, float* out, int ldo, int ooff) {
    const int lane = tidx() & 63, gw = blockIdx.x * (NT / 64) + (tidx() >> 6), ngw = gridDim.x * (NT / 64);
    for (int t = gw; t < M; t += ngw) {
        const TI* r = in + (size_t)t * ldi + off;
        float s = 0.f;
        for (int i = lane; i < n; i += 64) { const float v = ldf(r + i); s += v * v; }
        const float inv = rsqrtf(wave_sum(s) / n + EPS);
        for (int i = lane; i < n; i += 64) out[(size_t)t * ldo + ooff + i] = ldf(r + i) * inv * g[i];
    }
}

namespace ssd {
typedef short bf16x8 __attribute__((ext_vector_type(8)));
typedef short s16x4 __attribute__((ext_vector_type(4)));
typedef float f32x16 __attribute__((ext_vector_type(16)));
typedef unsigned u32x4 __attribute__((ext_vector_type(4)));
#define SLAS __attribute__((address_space(3)))
constexpr float LOG2E = 1.4426950408889634f;
__device__ __forceinline__ int crow(int r, int hi) { return (r & 3) + 8 * (r >> 2) + 4 * hi; }
__device__ __forceinline__ s16x4 vtr(const SLAS char* p) { typedef short v4 __attribute__((ext_vector_type(4))); return __builtin_bit_cast(s16x4, __builtin_amdgcn_ds_read_tr16_b64_v4i16((SLAS v4*)p)); }
__device__ __forceinline__ unsigned cvtpk(float lo, float hi) { typedef float f2 __attribute__((ext_vector_type(2))); typedef __bf16 b2 __attribute__((ext_vector_type(2)));
    f2 v = {lo, hi}; b2 b = __builtin_convertvector(v, b2); return __builtin_bit_cast(unsigned, b); }
#define SWAIT_BAR(N) asm volatile("s_waitcnt vmcnt(" #N ") lgkmcnt(0)\n\ts_barrier" ::: "memory")
#define SDMA(gsrc, ldst) glds16((gsrc), (unsigned)__builtin_amdgcn_readfirstlane((unsigned)(uintptr_t)(ldst)))

constexpr int SW_BUF = 49152, SW_TAB = 2 * SW_BUF;
__device__ __forceinline__ void state_sweep(SLAS char* lds, int b, int h, const bf16* XT, const float* DT, const float* a_log, float* ACS2, bf16* PREV) {
    const int tid = tidx(), lane = tid & 63, r32 = lane & 31, hi = lane >> 5; const int wid = __builtin_amdgcn_readfirstlane(tid >> 6);
    const int g = h >> 2, pt = wid & 1, nt = wid >> 1;
    const float a = -expf(a_log[h]);
    SLAS float* wtab = (SLAS float*)(lds + SW_TAB); SLAS float* ctab = wtab + 2048;
    const int trl = (4 * hi + ((lane & 15) >> 2));
    const int trc = 16 * ((lane >> 4) & 1) + 4 * (lane & 3);
#define SW_ISSUE(c_, buf_) do { const char* xs_ = (const char*)(XT + (size_t)(b * 16 + (c_)) * 131072 + h * 8192); const char* bs_ = (const char*)(XT + (size_t)(b * 16 + (c_)) * 131072 + 65536 + g * 16384); \
        _Pragma("unroll") for (int i_ = 0; i_ < 2; ++i_) SDMA(xs_ + (wid * 2 + i_) * 1024 + lane * 16, lds + (buf_) * SW_BUF + (wid * 2 + i_) * 1024); \
        _Pragma("unroll") for (int i_ = 0; i_ < 4; ++i_) SDMA(bs_ + (wid * 4 + i_) * 1024 + lane * 16, lds + (buf_) * SW_BUF + 16384 + (wid * 4 + i_) * 1024); } while (0)
    SW_ISSUE(0, 0);
#pragma unroll
    for (int cc = 0; cc < 2; ++cc) { const int c = 2 * wid + cc; const size_t t0 = (size_t)(b * 16 + c) * 128;
        const float d0 = DT[(t0 + 2 * lane) * 8 + h], d1 = DT[(t0 + 2 * lane + 1) * 8 + h];
        const float a0 = d0 * a, a1 = d1 * a; float inc = a0 + a1;
#pragma unroll
        for (int o = 1; o < 64; o <<= 1) { const float n = __shfl_up(inc, o); if (lane >= o) inc += n; }
        const float tot = __shfl(inc, 63); const float cs1 = inc, cs0 = inc - a1;
        wtab[c * 128 + 2 * lane] = d0 * expf(tot - cs0); wtab[c * 128 + 2 * lane + 1] = d1 * expf(tot - cs1);
        if (lane == 0) ctab[c] = expf(tot);
        ACS2[(t0 + 2 * lane) * 8 + h] = cs0 * LOG2E; ACS2[(t0 + 2 * lane + 1) * 8 + h] = cs1 * LOG2E; }
    f32x16 st = {};
    for (int c = 0; c < 16; ++c) {
        const int buf = c & 1;
        asm volatile("s_waitcnt vmcnt(4) lgkmcnt(0)\n\ts_barrier" ::: "memory");
        if (c + 1 < 16) SW_ISSUE(c + 1, buf ^ 1);
        const float cdec = ctab[c];
        { SLAS char* xp = lds + buf * SW_BUF + tid * 32; const int l = (tid >> 1) & 127; const float w = wtab[c * 128 + l];
          u32x4 q0 = *(SLAS u32x4*)xp, q1 = *(SLAS u32x4*)(xp + 16);
#pragma unroll
          for (int e = 0; e < 4; ++e) { q0[e] = cvtpk(__uint_as_float(q0[e] << 16) * w, __uint_as_float(q0[e] & 0xffff0000u) * w); q1[e] = cvtpk(__uint_as_float(q1[e] << 16) * w, __uint_as_float(q1[e] & 0xffff0000u) * w); }
          *(SLAS u32x4*)xp = q0; *(SLAS u32x4*)(xp + 16) = q1; }
        asm volatile("s_waitcnt lgkmcnt(0)\n\ts_barrier" ::: "memory");
        f32x16 acc = {};
        { const SLAS char* bb = lds + buf * SW_BUF + 16384 + ((32 * nt + trc) >> 3) * 2048 + ((32 * nt + trc) & 7) * 2 + trl * 16;
          const SLAS char* xb = lds + buf * SW_BUF + pt * 8192 + trl * 64 + trc * 2;
#pragma unroll
          for (int ks = 0; ks < 8; ++ks) {
              const s16x4 a0 = vtr(bb + ks * 256), a1 = vtr(bb + ks * 256 + 128); const s16x4 x0 = vtr(xb + ks * 1024), x1 = vtr(xb + ks * 1024 + 512);
              const bf16x8 af = {a0[0], a0[1], a0[2], a0[3], a1[0], a1[1], a1[2], a1[3]}, xf = {x0[0], x0[1], x0[2], x0[3], x1[0], x1[1], x1[2], x1[3]};
              acc = __builtin_amdgcn_mfma_f32_32x32x16_bf16(af, xf, acc, 0, 0, 0); } }
        { bf16* pv = PREV + (size_t)((b * 16 + c) * 8 + h) * 8192 + (32 * pt + r32) * 8 + 4 * hi;
#pragma unroll
          for (int rg = 0; rg < 4; ++rg) { uint2 o; o.x = cvtpk(st[4 * rg], st[4 * rg + 1]); o.y = cvtpk(st[4 * rg + 2], st[4 * rg + 3]); *(uint2*)(pv + (4 * nt + rg) * 512) = o; } }
#pragma unroll
        for (int r = 0; r < 16; ++r) st[r] = st[r] * cdec + acc[r];
    }
    asm volatile("s_waitcnt vmcnt(0) lgkmcnt(0)\n\ts_barrier" ::: "memory");
#undef SW_ISSUE
}

constexpr int P2_C = 0, P2_B = 32768, P2_XP = 65536, P2_TAB = 131072, P2_STG = 135168, P2_END = 151552;
__device__ __forceinline__ void chunk_unit(SLAS char* lds, int b, int c, int g, const bf16* XT, const bf16* PREV, const float* DT, const float* ACS2, const float* d_skip,
                                           const bf16* U, bf16* YC, float* SSQS) {
    const int tid = tidx(), lane = tid & 63, r32 = lane & 31, hi = lane >> 5; const int wid = __builtin_amdgcn_readfirstlane(tid >> 6);
    const int lb = wid >> 1, ph = wid & 1;
    const char* xt = (const char*)(XT + (size_t)(b * 16 + c) * 131072);
    const size_t t0 = (size_t)(b * 16 + c) * 128;
#pragma unroll
    for (int i = 0; i < 4; ++i) { SDMA(xt + (98304 + g * 16384) * 2 + (wid * 4 + i) * 1024 + lane * 16, lds + P2_C + (wid * 4 + i) * 1024);
                                  SDMA(xt + (65536 + g * 16384) * 2 + (wid * 4 + i) * 1024 + lane * 16, lds + P2_B + (wid * 4 + i) * 1024); }
#define P2_ISSUE(hh_) do { const int h_ = 4 * g + (hh_); const char* xs_ = xt + h_ * 16384; const char* ps_ = (const char*)(PREV + (size_t)((b * 16 + c) * 8 + h_) * 8192); \
        SLAS char* d_ = lds + P2_XP + ((hh_) & 1) * 32768; \
        _Pragma("unroll") for (int i_ = 0; i_ < 2; ++i_) { SDMA(xs_ + (wid * 2 + i_) * 1024 + lane * 16, d_ + (wid * 2 + i_) * 1024); SDMA(ps_ + (wid * 2 + i_) * 1024 + lane * 16, d_ + 16384 + (wid * 2 + i_) * 1024); } } while (0)
    P2_ISSUE(0);
    { SLAS float* tab = (SLAS float*)(lds + P2_TAB); const int hh = tid >> 7, l = tid & 127;
      tab[hh * 256 + l] = ACS2[(t0 + l) * 8 + 4 * g + hh]; tab[hh * 256 + 128 + l] = DT[(t0 + l) * 8 + 4 * g + hh]; }
    P2_ISSUE(1);
    SWAIT_BAR(4);
    bf16x8 cf[8];
#pragma unroll
    for (int ks = 0; ks < 8; ++ks) cf[ks] = *(const SLAS bf16x8*)(lds + P2_C + (2 * ks + hi) * 2048 + (32 * lb + r32) * 16);
    f32x16 cbt[4];
#pragma unroll
    for (int sb = 0; sb < 4; ++sb) { cbt[sb] = f32x16{};
        if (sb <= lb) {
#pragma unroll
            for (int ks = 0; ks < 8; ++ks) { const bf16x8 bfr = *(const SLAS bf16x8*)(lds + P2_B + (2 * ks + hi) * 2048 + (32 * sb + r32) * 16);
                cbt[sb] = __builtin_amdgcn_mfma_f32_32x32x16_bf16(bfr, cf[ks], cbt[sb], 0, 0, 0); } } }
    const int vlane = (4 * hi + ((lane & 15) >> 2)) * 64 + ((lane >> 4) & 1) * 32 + (lane & 3) * 8;
    const int lrow = 32 * lb + r32;
    for (int hh = 0; hh < 4; ++hh) {
        const int h = 4 * g + hh;
        const SLAS char* xb = lds + P2_XP + (hh & 1) * 32768; const SLAS char* pb = xb + 16384;
        const SLAS float* tab = (const SLAS float*)(lds + P2_TAB) + hh * 256;
        const float dsk = d_skip[h];
        u32x4 zpre[2];
#pragma unroll
        for (int i = 0; i < 2; ++i) zpre[i] = *(const u32x4*)(U + (t0 + 32 * lb + i * 16 + (lane >> 2)) * NU + OFF_Z + h * 64 + 32 * ph + 8 * (lane & 3));
        f32x16 o = {};
#pragma unroll
        for (int ks = 0; ks < 8; ++ks) { const bf16x8 pf = *(const SLAS bf16x8*)(pb + (2 * ks + hi) * 1024 + (32 * ph + r32) * 16);
            o = __builtin_amdgcn_mfma_f32_32x32x16_bf16(cf[ks], pf, o, 0, 0, 0); }
#pragma unroll
        for (int r = 0; r < 16; ++r) o[r] *= __builtin_amdgcn_exp2f(tab[32 * lb + crow(r, hi)]);
        int lrow_h = lrow; asm volatile("" : "+v"(lrow_h));
        const float al = tab[lrow];
#pragma unroll
        for (int sb = 0; sb < 4; ++sb) {
            if (sb <= lb) {
                float pr[16];
#pragma unroll
                for (int r = 0; r < 16; ++r) { const int sidx = 32 * sb + crow(r, hi);
                    float v = cbt[sb][r] * __builtin_amdgcn_exp2f(al - tab[sidx]) * tab[128 + sidx];
                    if (sb == lb) { v = (sidx <= lrow_h) ? v : 0.f; v += (sidx == lrow_h) ? dsk : 0.f; }
                    pr[r] = v; }
                const u32x4 pw0 = {cvtpk(pr[0], pr[1]), cvtpk(pr[2], pr[3]), cvtpk(pr[4], pr[5]), cvtpk(pr[6], pr[7])};
                const u32x4 pw1 = {cvtpk(pr[8], pr[9]), cvtpk(pr[10], pr[11]), cvtpk(pr[12], pr[13]), cvtpk(pr[14], pr[15])};
                const SLAS char* xv = xb + ph * 8192 + vlane + (2 * sb) * 1024;
                { const s16x4 a_ = vtr(xv), b_ = vtr(xv + 512); const bf16x8 vf = {a_[0], a_[1], a_[2], a_[3], b_[0], b_[1], b_[2], b_[3]};
                  o = __builtin_amdgcn_mfma_f32_32x32x16_bf16(__builtin_bit_cast(bf16x8, pw0), vf, o, 0, 0, 0); }
                { const s16x4 a_ = vtr(xv + 1024), b_ = vtr(xv + 1024 + 512); const bf16x8 vf = {a_[0], a_[1], a_[2], a_[3], b_[0], b_[1], b_[2], b_[3]};
                  o = __builtin_amdgcn_mfma_f32_32x32x16_bf16(__builtin_bit_cast(bf16x8, pw1), vf, o, 0, 0, 0); }
            }
        }
        SLAS bf16* stg = (SLAS bf16*)(lds + P2_STG) + wid * 1024;
#pragma unroll
        for (int r = 0; r < 16; ++r) stg[crow(r, hi) * 32 + r32] = (bf16)f2bf(o[r]);
        asm volatile("s_waitcnt lgkmcnt(0)" ::: "memory");
#pragma unroll
        for (int i = 0; i < 2; ++i) { const int row = i * 16 + (lane >> 2), ch = lane & 3; const size_t t = t0 + 32 * lb + row;
            const u32x4 ov = *(const SLAS u32x4*)(stg + row * 32 + ch * 8);
            const u32x4 zv = zpre[i];
            u32x4 w; float sq = 0.f;
#pragma unroll
            for (int e = 0; e < 4; ++e) { const float z0 = __uint_as_float(zv[e] << 16), z1 = __uint_as_float(zv[e] & 0xffff0000u);
                const float v0 = __uint_as_float(ov[e] << 16) * (z0 * __builtin_amdgcn_rcpf(1.f + __expf(-z0))), v1 = __uint_as_float(ov[e] & 0xffff0000u) * (z1 * __builtin_amdgcn_rcpf(1.f + __expf(-z1)));
                w[e] = cvtpk(v0, v1); const float r0 = __uint_as_float(w[e] << 16), r1 = __uint_as_float(w[e] & 0xffff0000u); sq += r0 * r0 + r1 * r1; }
            *(u32x4*)(YC + t * 1024 + h * 64 + 32 * ph + 8 * ch) = w;
            sq += __shfl_xor(sq, 1); sq += __shfl_xor(sq, 2);
            if (ch == 0) SSQS[t * 16 + h * 2 + ph] = sq; }
        if (hh < 3) {
            if (hh + 2 < 4) { asm volatile("s_waitcnt lgkmcnt(0)\n\ts_barrier" ::: "memory"); P2_ISSUE(hh + 2); SWAIT_BAR(4); }
            else { SWAIT_BAR(0); }
        }
    }
    asm volatile("s_waitcnt vmcnt(0) lgkmcnt(0)\n\ts_barrier" ::: "memory");
#undef P2_ISSUE
}
#undef SWAIT_BAR
#undef SDMA
}
__device__ void ph_gate_norm(const float* y, const bf16* u, bf16* YC) {
    const int lane = tidx() & 63, gw = blockIdx.x * (NT / 64) + (tidx() >> 6), ngw = gridDim.x * (NT / 64);
    for (int t = gw; t < M; t += ngw) {
        float v[8]; float s = 0.f;
#pragma unroll
        for (int j = 0; j < 8; ++j) { const int i = lane + 64 * j; v[j] = y[(size_t)t * SSD_INNER + i] * silu_f(bf2f(u[(size_t)t * NU + OFF_Z + i])); s += v[j] * v[j]; }
        const float inv = rsqrtf(wave_sum(s) / SSD_INNER + EPS);
#pragma unroll
        for (int j = 0; j < 8; ++j) YC[(size_t)t * 1024 + lane + 64 * j] = (bf16)f2bf(v[j] * inv);
    }
}
__device__ void ph_yc_norm(bf16* YC, const float* SSQS, const float* SSQ) {
    const int lane = tidx() & 63, gw = blockIdx.x * (NT / 64) + (tidx() >> 6), ngw = gridDim.x * (NT / 64);
    v4u nw0 = {0u, 0u, 0u, 0u}, nw1 = nw0;
    if (gw < M) { const v4u* p = (const v4u*)(YC + (size_t)gw * 1024) + lane; nw0 = p[0]; nw1 = p[64]; }
    for (int t = gw; t < M; t += ngw) {
        float ss = 0.f, sm = 0.f;
#pragma unroll
        for (int q = 0; q < 4; ++q) { const f32x4v a = *(const f32x4v*)(SSQS + (size_t)t * 16 + 4 * q); ss += (a.x + a.y) + (a.z + a.w); }
        { const f32x4v a = *(const f32x4v*)(SSQ + (size_t)t * 16 + 8), b = *(const f32x4v*)(SSQ + (size_t)t * 16 + 12); sm = (a.x + a.y) + (a.z + a.w) + (b.x + b.y) + (b.z + b.w); }
        v4u w0 = nw0, w1 = nw1;
        if (t + ngw < M) { const v4u* p = (const v4u*)(YC + (size_t)(t + ngw) * 1024) + lane; nw0 = p[0]; nw1 = p[64]; }
        const float invs = rsqrtf(ss * (1.f / 512.f) + EPS), invm = rsqrtf(sm * (1.f / 512.f) + EPS);
        v4u* p = (v4u*)(YC + (size_t)t * 1024) + lane;
#pragma unroll
        for (int e = 0; e < 4; ++e) { w0[e] = pk2(__uint_as_float(w0[e] << 16) * invs, __uint_as_float(w0[e] & 0xffff0000u) * invs); w1[e] = pk2(__uint_as_float(w1[e] << 16) * invm, __uint_as_float(w1[e] & 0xffff0000u) * invm); }
        p[0] = w0; p[64] = w1;
    }
}
__device__ void ph_gemm(float* lds, const float* A, int lda, const float* B, int ldb, float* C, int ldc, int Mr, int N, int K) {
    float (*As)[129] = (float (*)[129])lds;
    float (*Bs)[65] = (float (*)[65])(lds + 16 * 129);
    const int tx = tidx() & 15, ty = tidx() >> 4;
    const int ntn = (N + 63) / 64, ntm = Mr / 128;
    for (int tile = blockIdx.x; tile < ntn * ntm; tile += gridDim.x) {
        const int m0 = (tile / ntn) * 128, n0 = (tile % ntn) * 64;
        float acc[4][4] = {};
        for (int k0 = 0; k0 < K; k0 += 16) {
            for (int i = tidx(); i < 128 * 16; i += NT) { const int r = i >> 4, kk = i & 15; As[kk][r] = A[(size_t)(m0 + r) * lda + k0 + kk]; }
            for (int i = tidx(); i < 64 * 16; i += NT) { const int kk = i >> 6, cc = i & 63; Bs[kk][cc] = (n0 + cc < N) ? B[(size_t)(k0 + kk) * ldb + n0 + cc] : 0.f; }
            __syncthreads();
#pragma unroll
            for (int kk = 0; kk < 16; ++kk) {
                float a[4], b[4];
#pragma unroll
                for (int i = 0; i < 4; ++i) { a[i] = As[kk][ty * 4 + i]; b[i] = Bs[kk][tx * 4 + i]; }
#pragma unroll
                for (int i = 0; i < 4; ++i)
#pragma unroll
                    for (int j = 0; j < 4; ++j) acc[i][j] += a[i] * b[j];
            }
            __syncthreads();
        }
#pragma unroll
        for (int i = 0; i < 4; ++i)
#pragma unroll
            for (int j = 0; j < 4; ++j) { const int n = n0 + tx * 4 + j; if (n < N) C[(size_t)(m0 + ty * 4 + i) * ldc + n] = acc[i][j]; }
    }
}
__device__ void ph_conv(const bf16* u, const float* cw, const float* cb, float* xc) {
    for (size_t idx = (size_t)blockIdx.x * NT + tidx(); idx < (size_t)M * SSD_XBC; idx += (size_t)gridDim.x * NT) {
        const int ch = (int)(idx % SSD_XBC), t = (int)(idx / SSD_XBC), s = t % SEQ;
        float acc = cb[ch];
        for (int k = 0; k < 4; ++k) { const int ss = s - 3 + k; if (ss >= 0) acc += cw[k * SSD_XBC + ch] * bf2f(u[(size_t)(t - 3 + k) * NU + OFF_XBC + ch]); }
        xc[idx] = silu_f(acc);
    }
}
__device__ void ph_ssd_seq(const float* DT, const bf16* xc, const float* dt_bias, const float* a_log, const float* d_skip, float* y) {
    for (int item = blockIdx.x; item < NB * SSD_H; item += gridDim.x) {
        const int b = item / SSD_H, h = item % SSD_H, g = h / (SSD_H / SSD_G);
        const int p = tidx() >> 3, nq = tidx() & 7;
        const float a = -expf(a_log[h]), dsk = d_skip[h];
        float st[16];
#pragma unroll
        for (int i = 0; i < 16; ++i) st[i] = 0.f;
        for (int s = 0; s < SEQ; ++s) {
            const size_t t = (size_t)b * SEQ + s;
            const float dt = DT[t * 8 + h];
            const float da = expf(dt * a);
            const float xv = bf2f(xc[t * SSD_XBC + h * SSD_P + p]);
            const float xd = xv * dt;
            const bf16* Bp = xc + t * SSD_XBC + SSD_INNER + g * SSD_N + nq * 16;
            const bf16* Cp = xc + t * SSD_XBC + SSD_INNER + SSD_G * SSD_N + g * SSD_N + nq * 16;
            float acc = 0.f;
#pragma unroll
            for (int i = 0; i < 16; ++i) { st[i] = st[i] * da + xd * bf2f(Bp[i]); acc += bf2f(Cp[i]) * st[i]; }
            acc += __shfl_xor(acc, 1); acc += __shfl_xor(acc, 2); acc += __shfl_xor(acc, 4);
            if (nq == 0) y[t * SSD_INNER + h * SSD_P + p] = acc + dsk * xv;
        }
    }
}
__device__ void ph_rope(float* q, const bf16* u, const int* pos, float* kpe) {
    for (int idx = blockIdx.x * NT + tidx(); idx < M * 9 * 16; idx += gridDim.x * NT) {
        const int i = idx % 16, hh = (idx / 16) % 9, t = idx / (16 * 9);
        const float inv = 1.0f / powf(10000.0f, (float)(2 * i) / 32.0f);
        const float ang = (float)pos[t] * inv;
        float sn, cs; sincosf(ang, &sn, &cs);
        if (hh < 8) {
            float* p = q + (size_t)t * (MLA_H * QK) + hh * QK + NOPE;
            const float x1 = p[i], x2 = p[16 + i];
            p[i] = x1 * cs - x2 * sn; p[16 + i] = x2 * cs + x1 * sn;
        } else {
            const bf16* p = u + (size_t)t * NU + OFF_KR;
            const float x1 = bf2f(p[i]), x2 = bf2f(p[16 + i]);
            kpe[(size_t)t * ROPE + i] = x1 * cs - x2 * sn; kpe[(size_t)t * ROPE + 16 + i] = x2 * cs + x1 * sn;
        }
    }
}
__device__ void ph_attn(const float* q, const float* kv, const float* kpe, float* o) {
    const int lane = tidx() & 63, gw = blockIdx.x * (NT / 64) + (tidx() >> 6), ngw = gridDim.x * (NT / 64);
    for (int item = gw; item < NB * MLA_H * (SEQ / 64); item += ngw) {
        const int qb = (SEQ / 64 - 1) - item / (NB * MLA_H), bh = item % (NB * MLA_H), b = bh / MLA_H, h = bh % MLA_H;
        const int qi = qb * 64 + lane;
        const size_t t = (size_t)b * SEQ + qi;
        float qr[QK];
#pragma unroll
        for (int d = 0; d < QK; ++d) qr[d] = q[t * (MLA_H * QK) + h * QK + d] * 0.10206207261596575f;
        float acc[VD];
#pragma unroll
        for (int d = 0; d < VD; ++d) acc[d] = 0.f;
        float mx = -INFINITY, l = 0.f;
        const int kmax = qb * 64 + 63;
        for (int k = 0; k <= kmax; ++k) {
            const size_t tk = (size_t)b * SEQ + k;
            const float* kn = kv + tk * (MLA_H * 128) + h * 128;
            const float* kp = kpe + tk * ROPE;
            float s = 0.f;
#pragma unroll
            for (int d = 0; d < NOPE; ++d) s += qr[d] * kn[d];
#pragma unroll
            for (int d = 0; d < ROPE; ++d) s += qr[NOPE + d] * kp[d];
            if (k <= qi) {
                const float mn = fmaxf(mx, s);
                const float f = expf(mx - mn), pv = expf(s - mn);
                l = l * f + pv;
#pragma unroll
                for (int d = 0; d < VD; ++d) acc[d] = acc[d] * f + pv * kn[64 + d];
                mx = mn;
            }
        }
        const float il = 1.f / l;
#pragma unroll
        for (int d = 0; d < VD; ++d) o[t * (MLA_H * VD) + h * VD + d] = acc[d] * il;
    }
}
__device__ void ph_moe(float* lds, const float* h2, const float* wgr, const float* bgr, const float* wer, const float* ber,
                       const float* wg, const float* wu, const float* wd, float* y2) {
    const int sb = tidx() >> 8, tid = tidx() & 255;
    float* xs = lds + sb * 2048;
    float* logit = xs + 1024;
    float* hid = xs + 1088;
    int* sel_e = (int*)(xs + 1600);
    float* sel_w = xs + 1604;
    for (int it = blockIdx.x; it < M / 2; it += gridDim.x) {
        const int t = it * 2 + sb;
        __syncthreads();
        for (int i = tid; i < D; i += 256) xs[i] = h2[(size_t)t * D + i];
        __syncthreads();
        {
            const int w = tid >> 6, lane = tid & 63;
            for (int cidx = w * 9; cidx < w * 9 + 9; ++cidx) {
                float s = 0.f;
                for (int k = lane; k < D; k += 64) s += xs[k] * (cidx < 4 ? wgr[k * 4 + cidx] : wer[k * 32 + (cidx - 4)]);
                s = wave_sum(s);
                if (lane == 0) logit[cidx] = s;
            }
        }
        __syncthreads();
        if (tid == 0) {
            float mxv = -INFINITY; int gi = 0;
            for (int i = 0; i < 4; ++i) { const float v = logit[i] + bgr[i]; logit[i] = v; if (v > mxv) { mxv = v; gi = i; } }
            float den = 0.f; for (int i = 0; i < 4; ++i) den += expf(logit[i] - mxv);
            const float gw = 1.f / den;
            float emx = -INFINITY; int i1 = 0;
            for (int i = 0; i < 8; ++i) { const float v = logit[4 + gi * 8 + i] + ber[gi * 8 + i]; logit[4 + gi * 8 + i] = v; if (v > emx) { emx = v; i1 = i; } }
            float e2 = -INFINITY; int i2 = 0;
            for (int i = 0; i < 8; ++i) { const float v = logit[4 + gi * 8 + i]; if (i != i1 && v > e2) { e2 = v; i2 = i; } }
            const float p2 = expf(e2 - emx);
            sel_e[0] = gi * 8 + i1; sel_e[1] = gi * 8 + i2;
            sel_w[0] = gw / (1.f + p2); sel_w[1] = gw * p2 / (1.f + p2);
        }
        __syncthreads();
        for (int k2 = 0; k2 < 2; ++k2) {
            const int e = sel_e[k2];
            const float* G = wg + (size_t)e * D * FF; const float* U = wu + (size_t)e * D * FF;
            float ga = 0.f, ua = 0.f;
            for (int k = 0; k < D; ++k) { ga += xs[k] * G[(size_t)k * FF + tid]; ua += xs[k] * U[(size_t)k * FF + tid]; }
            hid[k2 * FF + tid] = silu_f(ga) * ua * sel_w[k2];
        }
        __syncthreads();
        for (int d = tid; d < D; d += 256) {
            float acc = 0.f;
            for (int k2 = 0; k2 < 2; ++k2) {
                const float* Wd = wd + (size_t)sel_e[k2] * FF * D;
                for (int f = 0; f < FF; ++f) acc += hid[k2 * FF + f] * Wd[(size_t)f * D + d];
            }
            y2[(size_t)t * D + d] = acc;
        }
    }
}


#define LAS __attribute__((address_space(3)))
#define XB_TMO      128
#define XB_XCNT(j)  (256  + 64 * (j))
#define XB_XSUB(j)  (1280 + 64 * (j))
#define XB_XGEN(j)  (2304 + 64 * (j))
#define XB_TOP      3328
#define XB_TOPGEN   3392
#define XCD_BAR_WORDS 3456
#define XB_SPIN_CAP (1u << 18)

__device__ __forceinline__ unsigned xb_ld(unsigned* p)              { return __hip_atomic_load(p, __ATOMIC_RELAXED, __HIP_MEMORY_SCOPE_AGENT); }
__device__ __forceinline__ unsigned xb_add(unsigned* p, unsigned v) { return __hip_atomic_fetch_add(p, v, __ATOMIC_RELAXED, __HIP_MEMORY_SCOPE_AGENT); }
__device__ __forceinline__ unsigned xb_xcc_id() { return (unsigned)__builtin_amdgcn_s_getreg((3 << 11) | 20) & 0xFu; }
#define XB_SPIN(cond, bar) do { unsigned _sp = 0; while (cond) { __builtin_amdgcn_s_sleep(1); \
    if ((++_sp & 255u) == 0u) { if (xb_ld(&(bar)[XB_TMO])) break; if (_sp > XB_SPIN_CAP) { atomicAdd(&(bar)[XB_TMO], 1u); break; } } } } while (0)

struct XcdBarrier {
    unsigned* bar; unsigned x;
    volatile LAS unsigned* st;
};

__device__ __forceinline__ XcdBarrier xcd_barrier_post(unsigned* bar, volatile LAS unsigned* st) {
    XcdBarrier b; b.bar = bar; b.x = xb_xcc_id(); b.st = st;
    if (tidx() == 0) (void)xb_add(&bar[XB_XCNT(b.x)], 1u);
    return b;
}
__device__ __forceinline__ void xcd_barrier_complete(unsigned* bar, unsigned x, unsigned& nloc, unsigned& nx) {
    const unsigned G = gridDim.x * gridDim.y * gridDim.z;
    unsigned sum, cnt, mine, sp = 0u;
    for (;;) {
        sum = 0u; cnt = 0u; mine = 0u;
#pragma unroll
        for (unsigned j = 0; j < 16; ++j) { const unsigned c = xb_ld(&bar[XB_XCNT(j)]); sum += c; cnt += (c > 0u) ? 1u : 0u; mine = (j == x) ? c : mine; }
        if (sum == G) break;
        __builtin_amdgcn_s_sleep(1);
        if ((++sp & 255u) == 0u) { if (xb_ld(&bar[XB_TMO])) break; if (sp > XB_SPIN_CAP) { atomicAdd(&bar[XB_TMO], 1u); break; } }
    }
    nloc = mine > 0u ? mine : 1u; nx = cnt > 0u ? cnt : 1u;
}

__device__ __forceinline__ void xcd_barrier(const XcdBarrier& b) {
    asm volatile("s_waitcnt vmcnt(0)" ::: "memory");
    __syncthreads();
    if (tidx() == 0) {
        unsigned* bar = b.bar;
        __builtin_amdgcn_s_waitcnt(0);
        unsigned nloc = b.st[0], nx = b.st[1];
        if (nloc == 0u) { xcd_barrier_complete(bar, b.x, nloc, nx); b.st[0] = nloc; b.st[1] = nx; }
        const unsigned old = xb_add(&bar[XB_XSUB(b.x)], 1u);
        const unsigned gen = old / nloc;
        if (old + 1u == (gen + 1u) * nloc) {
            __builtin_amdgcn_fence(__ATOMIC_RELEASE, "agent");
            asm volatile("s_waitcnt vmcnt(0)" ::: "memory");
            const unsigned og = xb_add(&bar[XB_TOP], 1u);
            const unsigned tg = og / nx;
            if (og + 1u == (tg + 1u) * nx) xb_add(&bar[XB_TOPGEN], 1u);
            else XB_SPIN(xb_ld(&bar[XB_TOPGEN]) == tg, bar);
            __builtin_amdgcn_fence(__ATOMIC_ACQUIRE, "agent");
            xb_add(&bar[XB_XGEN(b.x)], 1u);
            asm volatile("s_waitcnt vmcnt(0)" ::: "memory");
        } else {
            XB_SPIN(xb_ld(&bar[XB_XGEN(b.x)]) == gen, bar);
            __builtin_amdgcn_fence(__ATOMIC_ACQUIRE, "agent");
            asm volatile("s_waitcnt vmcnt(0)" ::: "memory");
        }
    }
    __syncthreads();
}


constexpr size_t MiB = 1u << 20;
#define WSB(T, off) ((T*)(kargs()->ws + (size_t)(off)))
#define OUTB(T, off) ((T*)((char*)kargs()->out + (size_t)(off)))
#define B_CNT    WSB(int, 4096)
#define B_MOD    WSB(float, 1 * MiB)
#define B_DT     WSB(float, 1 * MiB + 256 * 1024)
#define B_ACS2   WSB(float, 1 * MiB + 768 * 1024)
#define B_WIN    WSB(bf16, 2 * MiB)
#define B_WOUT   WSB(bf16, 6 * MiB)
#define B_WUQ    WSB(bf16, 8 * MiB)
#define B_WUKV   WSB(bf16, 9 * MiB)
#define B_WRT    WSB(float, 9 * MiB + 512 * 1024)
#define B_WGU    WSB(bf16, 10 * MiB)
#define B_WD     WSB(bf16, 42 * MiB)
#define B_HB     WSB(bf16, 58 * MiB)
#define B_YC     WSB(bf16, 58 * MiB)
#define B_H2     WSB(bf16, 58 * MiB)
#define B_U      WSB(bf16, 90 * MiB)
#define B_HG     WSB(bf16, 90 * MiB)
#define B_YP     WSB(bf16, 90 * MiB)
#define B_XT     WSB(bf16, 154 * MiB)
#define B_YB     WSB(bf16, 154 * MiB)
#define B_HID    WSB(bf16, 170 * MiB)
#define B_Q      WSB(bf16, 186 * MiB)
#define B_ETOK   WSB(int, 192 * MiB)
#define B_EW     WSB(float, 196 * MiB)
#define B_KF     WSB(bf16, 210 * MiB)
#define B_VT     WSB(bf16, 234 * MiB)
#define B_COS    WSB(float, 250 * MiB)
#define B_SIN    WSB(float, 251 * MiB)
#define B_RTE    WSB(int, 250 * MiB)
#define B_RTS    WSB(int, 250 * MiB + 256 * 1024)
#define B_RTW    WSB(float, 250 * MiB + 512 * 1024)
#define B_TOKROW WSB(int, 250 * MiB + 768 * 1024)
#define B_ROWW   WSB(float, 251 * MiB)
#define B_SSQ    WSB(float, 252 * MiB)
#define B_SSQS   WSB(float, 253 * MiB)
#define B_PREV   OUTB(bf16, 0)
#define B_CQN    OUTB(bf16, 32 * MiB)
#define B_CKVN   OUTB(bf16, 40 * MiB)
#define LDS_TP   ((int*)(lds_raw + 131072 + 1024))

__global__ void __launch_bounds__(NT, 2) mega_fwd(Params P) {
    if (threadIdx.x < 2) ((volatile LAS unsigned*)(lds_raw + WTAB_OFF - 16))[threadIdx.x] = 0u;
    tidx_init();
    float* lds = (float*)lds_raw;
    const XcdBarrier bar = xcd_barrier_post((unsigned*)(kargs()->ws + 16384), (volatile LAS unsigned*)(lds_raw + WTAB_OFF - 16));
#define GSYNC() xcd_barrier(bar)
    ph_prep(lds, B_MOD, B_WIN, B_WOUT, B_WUQ, B_WUKV, B_WRT, B_WGU, B_WD);
    GSYNC();
    ph_prenorm_bf16(IN(0), IN(5), B_MOD, 0 * D, 1 * D, B_HB);
    GSYNC();
    { pg8::Gemm g{B_HB, B_WIN, M, NU, D}; pg8::StaticOrder S; S.init(M, NU, gridDim.x, (int)blockIdx.x);
      pg8::EpiBf16<0> E{B_U, NU};
      pg8::gemm_phase<pg8::EpiBf16<0>, pg8::StaticOrder, true, true>((PG8_LAS unsigned char*)lds_raw, g, S, E); }
    GSYNC();
    ph_prep2(B_U, kargs()->pos, IN(10), IN(11), IN(12), B_CQN, B_CKVN, B_KF, B_COS, B_SIN, B_DT, B_XT);
    GSYNC();
    {
      const int G = gridDim.x, bid = blockIdx.x; const bool split = G >= 128;
      if (!split || bid < 64) { for (int it = bid; it < 64; it += (split ? 64 : G)) ssd::state_sweep((SLAS char*)lds_raw, it >> 3, it & 7, B_XT, B_DT, IN(13), B_ACS2, B_PREV); }
      if (!split || bid >= 64) { const int Gg = split ? G - 64 : G, cg_ = split ? bid - 64 : bid;
        { pg8::Gemm g{B_CQN, B_WUQ, M, 768, QR}; pg8::StaticOrder S; S.init(M, 768, Gg, cg_);
          pg8::EpiQ E{B_Q, B_COS, B_SIN};
          pg8::gemm_phase<pg8::EpiQ, pg8::StaticOrder, true, false>((PG8_LAS unsigned char*)lds_raw, g, S, E); }
        { pg8::Gemm g{B_CKVN, B_WUKV, M, 1024, 256}; pg8::StaticOrder S; S.init(M, 1024, Gg, cg_);
          pg8::EpiKV E{B_KF, B_VT};
          pg8::gemm_phase<pg8::EpiKV, pg8::StaticOrder, true, false>((PG8_LAS unsigned char*)lds_raw, g, S, E); }
        ph_prep_moe(B_WGU, B_WD, cg_ * (NT / 64) + (tidx() >> 6), Gg * (NT / 64), 0, split ? MOE_SPLIT : 0); } }
    GSYNC();
    att::attn_phase((ALAS char*)lds_raw, B_Q, B_KF, B_VT, B_YC, B_SSQ);
    { const int G = gridDim.x, bid = blockIdx.x; const int vcu = (G % 8 == 0) ? (bid % 8) * (G / 8) + bid / 8 : bid;
      for (int u = vcu; u < 256; u += G) ssd::chunk_unit((SLAS char*)lds_raw, u >> 5, (u >> 1) & 15, u & 1, B_XT, B_PREV, B_DT, B_ACS2, IN(14), B_U, B_YC, B_SSQS); }
    GSYNC();
    for (int u0 = blockIdx.x; u0 < (M / 256) * (D / 256); u0 += gridDim.x) {
        pg8::StaticOrder S1; S1.init(M, D, (M / 256) * (D / 256), u0); pg8::Unit uu; S1.next(0, uu);
        PG8_LAS float* RS = (PG8_LAS float*)(lds_raw + 131072 + 4096);
        { const int tid = tidx(); __syncthreads();
          if (tid < 256) { const size_t row = (size_t)uu.pm * 256 + tid; float ss = 0.f, sm = 0.f;
#pragma unroll
              for (int q = 0; q < 4; ++q) { const f32x4v a = *(const f32x4v*)(B_SSQS + row * 16 + 4 * q); ss += (a.x + a.y) + (a.z + a.w); }
              { const f32x4v a = *(const f32x4v*)(B_SSQ + row * 16 + 8), b = *(const f32x4v*)(B_SSQ + row * 16 + 12); sm = (a.x + a.y) + (a.z + a.w) + (b.x + b.y) + (b.z + b.w); }
              const float rs = rsqrtf(ss * (1.f / 512.f) + EPS), rm = rsqrtf(sm * (1.f / 512.f) + EPS);
              RS[2 * tid] = rs / rm; RS[2 * tid + 1] = rm; }
          __syncthreads(); }
        pg8::Gemm g{B_YC, B_WOUT, M, D, D}; pg8::StaticOrder S; S.init(M, D, (M / 256) * (D / 256), u0);
        struct OneUnit { pg8::StaticOrder s; __device__ __forceinline__ bool next(int i, pg8::Unit& u) const { return i == 0 ? s.next(0, u) : false; }
                         __device__ __forceinline__ void a_ready(const pg8::Unit&) const {} __device__ __forceinline__ void done(const pg8::Unit&) const {} } OU{S};
        pg8::EpiBf16RowScale E{B_YB, D, RS}; pg8::MidRowScale MDs{RS};
        pg8::gemm_phase<pg8::EpiBf16RowScale, OneUnit, true, true, pg8::MidRowScale>((PG8_LAS unsigned char*)lds_raw, g, OU, E, MDs);
    }
    GSYNC();
    ph_rowrouter((__attribute__((address_space(3))) float*)lds_raw, B_YB, IN(0), IN(6), IN(7), B_MOD, B_WRT, IN(23), IN(25), kargs()->out, B_H2, B_CNT, B_RTE, B_RTS, B_ETOK, B_EW);
    GSYNC();
    moe_table(LDS_TP, B_CNT);
    ph_gather_tiles(LDS_TP, B_CNT, B_H2, B_ETOK, B_EW, B_HG, B_ROWW);
    { pg8::Gemm g{B_HG, B_WGU, 0, 0, D}; pg8::OwnTileOrder S{(const PG8_LAS int*)LDS_TP, 2, (int)gridDim.x, (int)blockIdx.x};
      pg8::EpiGU E{B_HID, B_ROWW};
      pg8::gemm_phase<pg8::EpiGU, pg8::OwnTileOrder, true, true>((PG8_LAS unsigned char*)lds_raw, g, S, E); }
    GSYNC();
    { pg8::Gemm g{B_HID, B_WD, 0, 0, FF}; pg8::GroupedOrder S{(const PG8_LAS int*)LDS_TP, 4, (int)gridDim.x, (int)blockIdx.x};
      pg8::EpiDown E{B_YP};
      pg8::gemm_phase<pg8::EpiDown, pg8::GroupedOrder, true, true>((PG8_LAS unsigned char*)lds_raw, g, S, E); }
    GSYNC();
    ph_moe_final(B_YP, LDS_TP, B_RTE, B_RTS, IN(8), B_MOD, kargs()->out);
}

extern "C" void kernel_launch(void* const* d_in, const int* in_sizes, int n_in, void* d_out, int out_size, void* d_ws, size_t ws_size,
                              hipStream_t stream) {
    static int grid_blocks = 0;
    if (!grid_blocks) {
        int dev = 0, cus = 0, per_cu = 0;
        (void)hipGetDevice(&dev);
        (void)hipDeviceGetAttribute(&cus, hipDeviceAttributeMultiprocessorCount, dev);
        (void)hipFuncSetAttribute((const void*)mega_fwd, hipFuncAttributeMaxDynamicSharedMemorySize, LDS_BYTES);
        (void)hipOccupancyMaxActiveBlocksPerMultiprocessor(&per_cu, (const void*)mega_fwd, NT, LDS_BYTES);
        if (per_cu < 1) { fprintf(stderr, "occupancy query returned %d\n", per_cu); per_cu = 1; }
        grid_blocks = cus * per_cu;
    }
    (void)hipMemsetAsync(d_ws, 0, 65536, stream);
    Params p{};
    for (int i = 0; i < 29; ++i) p.in[i] = (const float*)d_in[i];
    p.pos = (const int*)d_in[2];
    p.out = (float*)d_out;
    p.ws = (char*)d_ws;
    void* args[] = {&p};
    hipError_t e = hipLaunchCooperativeKernel((void*)mega_fwd, dim3(grid_blocks), dim3(NT), args, LDS_BYTES, stream);
    if (e != hipSuccess) fprintf(stderr, "cooperative launch failed: %s (grid %d)\n", hipGetErrorString(e), grid_blocks);
}
```
